# Optimizing an MI355X kernel written in HIP

```python
import math
import numpy as np
import jax
import jax.numpy as jnp
from jax import lax

D_MODEL = 1024
BATCH = 8
SEQ = 4096
DEPTH = 2

HEAD_DIM = 64
ROPE_THETA = 10000.0
EPS = 1e-6
F32 = jnp.float32

A_HEADS = 4
MOBA_BLOCK = 256
MOBA_TOPK = 3
MOBA_QCHUNK = 32

B_HEADS = 4
IDX_HEADS = 8
IDX_DIM = 64
DSA_TOPK_MAX = 256
DSA_QCHUNK = 64

C_HEADS = 4
C_VDIM = 2 * HEAD_DIM
DIFF_QCHUNK = 128

N_GROUPS = 4
EXPERTS_PER_GROUP = 8
N_EXPERTS = N_GROUPS * EXPERTS_PER_GROUP
EXPERT_TOPK = 2
D_EXPERT = 512
MOE_BLOCK = 256

A_W = A_HEADS * HEAD_DIM
B_W = B_HEADS * HEAD_DIM
C_QK_W = C_HEADS * HEAD_DIM
C_W = C_HEADS * C_VDIM

IN_SIZES = (A_W, A_W, A_W, B_W, B_W, B_W, IDX_HEADS * IDX_DIM, IDX_DIM, IDX_HEADS,
            C_QK_W, C_QK_W, C_QK_W, C_QK_W, C_W, D_MODEL, D_MODEL, D_MODEL)
D_IN = 3 * A_W + 3 * B_W + IDX_HEADS * IDX_DIM + IDX_DIM + IDX_HEADS + 4 * C_QK_W + C_W + 3 * D_MODEL

kernel_name = 'hybrid_moba_dsa_diffattn_hiermoe'


def rms_norm(x, gain):
    xf = x.astype(F32)
    y = xf * lax.rsqrt(jnp.mean(xf * xf, axis=-1, keepdims=True) + EPS)
    return (y * gain.astype(F32)).astype(x.dtype)


def rope_tables(seq_len):
    inv_freq = 1.0 / (ROPE_THETA ** (jnp.arange(0, HEAD_DIM, 2, dtype=F32) / HEAD_DIM))
    ang = jnp.arange(seq_len, dtype=F32)[:, None] * inv_freq[None, :]
    return jnp.cos(ang), jnp.sin(ang)


def apply_rope(x, cos, sin):
    half = x.shape[-1] // 2
    xf = x.astype(F32)
    x1, x2 = xf[..., :half], xf[..., half:]
    c = cos[:, None, :]
    s = sin[:, None, :]
    return jnp.concatenate([x1 * c - x2 * s, x2 * c + x1 * s], axis=-1).astype(x.dtype)


def norm_rope(t, gain, cos, sin):
    return apply_rope(rms_norm(t, gain), cos, sin)


def to_chunks(t, size):
    b, s = t.shape[:2]
    return jnp.moveaxis(t.reshape((b, s // size, size) + t.shape[2:]), 1, 0)


def from_chunks(t):
    t = jnp.moveaxis(t, 0, 1)
    return t.reshape((t.shape[0], t.shape[1] * t.shape[2]) + t.shape[3:])


def split_points():
    return [int(v) for v in np.cumsum(np.array(IN_SIZES))[:-1]]


def moba_attention(q, k, v):
    b, s, h, dh = q.shape
    nb = -(-s // MOBA_BLOCK)
    pad = nb * MOBA_BLOCK - s

    def blocks(t):
        t = jnp.pad(t, ((0, 0), (0, pad), (0, 0), (0, 0)))
        return t.reshape(b, nb, MOBA_BLOCK, h, dh).transpose(0, 3, 1, 2, 4)

    kb, vb = blocks(k), blocks(v)
    k_mean = jnp.mean(kb.astype(F32), axis=3)
    n_sel = min(MOBA_TOPK, nb - 1)
    scale = dh ** -0.5
    b_idx = jnp.arange(b)[:, None, None, None]
    h_idx = jnp.arange(h)[None, :, None, None]
    blk_pos = jnp.arange(MOBA_BLOCK)
    n_sk = n_sel * MOBA_BLOCK

    def chunk_fn(args):
        ci, qc = args
        qh = qc.transpose(0, 2, 1, 3)
        start = ci * MOBA_QCHUNK
        pos = start + jnp.arange(MOBA_QCHUNK)
        own = start // MOBA_BLOCK
        k_own = lax.dynamic_index_in_dim(kb, own, axis=2, keepdims=False)
        v_own = lax.dynamic_index_in_dim(vb, own, axis=2, keepdims=False)
        s_own = jnp.einsum('bhcd,bhkd->bhck', qh, k_own).astype(F32) * scale
        s_own = jnp.where((own * MOBA_BLOCK + blk_pos)[None, :] <= pos[:, None], s_own, -jnp.inf)
        if n_sel == 0:
            p = jax.nn.softmax(s_own, axis=-1).astype(v.dtype)
            return jnp.einsum('bhck,bhkd->bchd', p, v_own)
        gate = jnp.einsum('bhcd,bhnd->bhcn', qh.astype(F32), k_mean)
        gate = jnp.where(jnp.arange(nb) < own, gate, -jnp.inf)
        _, sel = lax.top_k(gate, n_sel)
        k_sel = kb[b_idx, h_idx, sel]
        v_sel = vb[b_idx, h_idx, sel]
        s_sel = jnp.einsum('bhcd,bhcnkd->bhcnk', qh, k_sel).astype(F32) * scale
        s_sel = jnp.where((jnp.arange(n_sel) < own)[:, None], s_sel, -jnp.inf)
        s_all = jnp.concatenate([s_sel.reshape(b, h, MOBA_QCHUNK, n_sk), s_own], axis=-1)
        p = jax.nn.softmax(s_all, axis=-1).astype(v.dtype)
        p_sel = p[..., :n_sk].reshape(b, h, MOBA_QCHUNK, n_sel, MOBA_BLOCK)
        return (jnp.einsum('bhcnk,bhcnkd->bchd', p_sel, v_sel)
                + jnp.einsum('bhck,bhkd->bchd', p[..., n_sk:], v_own))

    n = s // MOBA_QCHUNK
    out = lax.map(chunk_fn, (jnp.arange(n), to_chunks(q, MOBA_QCHUNK)))
    return from_chunks(out)


def dsa_attention(q, k, v, q_idx, k_idx, w_idx):
    b, s, h, dh = q.shape
    n_keep = min(DSA_TOPK_MAX, s // 4)
    scale = dh ** -0.5
    key_pos = jnp.arange(s)
    b_idx = jnp.arange(b)[:, None, None]
    k_idx_f = k_idx.astype(F32)

    def chunk_fn(args):
        ci, qc, qic, wc = args
        pos = ci * DSA_QCHUNK + jnp.arange(DSA_QCHUNK)
        logits = jnp.einsum('bchd,bsd->bchs', qic.astype(F32), k_idx_f) * (IDX_DIM ** -0.5)
        score = jnp.einsum('bch,bchs->bcs', wc.astype(F32), jax.nn.relu(logits))
        score = jnp.where(key_pos[None, None, :] <= pos[None, :, None], score, -jnp.inf)
        _, sel = lax.top_k(score, n_keep)
        k_sel = k[b_idx, sel]
        v_sel = v[b_idx, sel]
        sc = jnp.einsum('bchd,bckhd->bhck', qc, k_sel).astype(F32) * scale
        valid = (sel <= pos[None, :, None])[:, None]
        p = jax.nn.softmax(jnp.where(valid, sc, -jnp.inf), axis=-1).astype(v.dtype)
        return jnp.einsum('bhck,bckhd->bchd', p, v_sel)

    n = s // DSA_QCHUNK
    out = lax.map(chunk_fn, (jnp.arange(n), to_chunks(q, DSA_QCHUNK),
                             to_chunks(q_idx, DSA_QCHUNK), to_chunks(w_idx, DSA_QCHUNK)))
    return from_chunks(out)


def diff_attention(q1, q2, k1, k2, v, lam):
    b, s, h, dh = q1.shape
    scale = dh ** -0.5
    key_pos = jnp.arange(s)

    def chunk_fn(args):
        ci, q1c, q2c = args
        pos = ci * DIFF_QCHUNK + jnp.arange(DIFF_QCHUNK)
        causal = key_pos[None, :] <= pos[:, None]
        s1 = jnp.einsum('bchd,bshd->bhcs', q1c, k1).astype(F32) * scale
        s2 = jnp.einsum('bchd,bshd->bhcs', q2c, k2).astype(F32) * scale
        a1 = jax.nn.softmax(jnp.where(causal, s1, -jnp.inf), axis=-1)
        a2 = jax.nn.softmax(jnp.where(causal, s2, -jnp.inf), axis=-1)
        a = (a1 - lam * a2).astype(v.dtype)
        return jnp.einsum('bhcs,bshe->bche', a, v)

    n = s // DIFF_QCHUNK
    out = lax.map(chunk_fn, (jnp.arange(n), to_chunks(q1, DIFF_QCHUNK), to_chunks(q2, DIFF_QCHUNK)))
    return from_chunks(out)


def mixer_sublayer(x, cos, sin, layer_idx, norm_g, w_in, qk_gain, idx_k_gain, diff_lambda,
                   diff_subln_gain, w_proj_a, w_proj_b, w_proj_c, w_out):
    b, s, _ = x.shape
    hn = rms_norm(x, norm_g)
    proj = hn @ w_in
    (qa, ka, va, qb, kb, vb, qi, ki, wi, q1, q2, k1, k2, vc, ga, gb, gc) = jnp.split(proj, split_points(), axis=-1)

    qa = norm_rope(qa.reshape(b, s, A_HEADS, HEAD_DIM), qk_gain[0], cos, sin)
    ka = norm_rope(ka.reshape(b, s, A_HEADS, HEAD_DIM), qk_gain[1], cos, sin)
    o_a = moba_attention(qa, ka, va.reshape(b, s, A_HEADS, HEAD_DIM)).reshape(b, s, A_W)

    qb = norm_rope(qb.reshape(b, s, B_HEADS, HEAD_DIM), qk_gain[2], cos, sin)
    kb = norm_rope(kb.reshape(b, s, B_HEADS, HEAD_DIM), qk_gain[3], cos, sin)
    qi = apply_rope(qi.reshape(b, s, IDX_HEADS, IDX_DIM), cos, sin)
    ki = apply_rope(rms_norm(ki, idx_k_gain)[:, :, None, :], cos, sin)[:, :, 0, :]
    wi = wi * (IDX_HEADS ** -0.5)
    o_b = dsa_attention(qb, kb, vb.reshape(b, s, B_HEADS, HEAD_DIM), qi, ki, wi).reshape(b, s, B_W)

    q1 = norm_rope(q1.reshape(b, s, C_HEADS, HEAD_DIM), qk_gain[4], cos, sin)
    q2 = norm_rope(q2.reshape(b, s, C_HEADS, HEAD_DIM), qk_gain[4], cos, sin)
    k1 = norm_rope(k1.reshape(b, s, C_HEADS, HEAD_DIM), qk_gain[5], cos, sin)
    k2 = norm_rope(k2.reshape(b, s, C_HEADS, HEAD_DIM), qk_gain[5], cos, sin)
    lam_init = 0.8 - 0.6 * math.exp(-0.3 * layer_idx)
    dl = diff_lambda.astype(F32)
    lam = jnp.exp(jnp.sum(dl[0] * dl[1])) - jnp.exp(jnp.sum(dl[2] * dl[3])) + lam_init
    o_c = diff_attention(q1, q2, k1, k2, vc.reshape(b, s, C_HEADS, C_VDIM), lam)
    o_c = (rms_norm(o_c, diff_subln_gain) * (1.0 - lam_init)).reshape(b, s, C_W)

    merged = (jax.nn.sigmoid(ga) * (o_a @ w_proj_a)
              + jax.nn.sigmoid(gb) * (o_b @ w_proj_b)
              + jax.nn.sigmoid(gc) * (o_c @ w_proj_c))
    return x + merged @ w_out


def hier_moe(xn, w_group, b_group, w_router, b_router, w_e_gate, w_e_up, w_e_down):
    n, d = xn.shape
    xf = xn.astype(F32)
    g_logits = xf @ w_group.astype(F32) + b_group.astype(F32)
    g_prob = jax.nn.softmax(g_logits, axis=-1)
    _, g_idx = lax.top_k(g_logits, 1)
    g_w = jnp.take_along_axis(g_prob, g_idx, axis=1)[:, 0]
    e_logits = (xf @ w_router.astype(F32) + b_router.astype(F32)).reshape(n, N_GROUPS, EXPERTS_PER_GROUP)
    e_logits_g = jnp.take_along_axis(e_logits, g_idx[:, :, None], axis=1)[:, 0]
    e_top, e_idx = lax.top_k(e_logits_g, EXPERT_TOPK)
    weights = g_w[:, None] * jax.nn.softmax(e_top, axis=-1)
    expert = g_idx * EXPERTS_PER_GROUP + e_idx

    n_slots = n * EXPERT_TOPK
    flat_e = expert.reshape(-1)
    flat_tok = jnp.repeat(jnp.arange(n), EXPERT_TOPK)
    flat_w = weights.reshape(-1)
    order = jnp.argsort(flat_e)
    se, st, sw = flat_e[order], flat_tok[order], flat_w[order]
    counts = jax.ops.segment_sum(jnp.ones_like(flat_e), flat_e, num_segments=N_EXPERTS)
    padded = ((counts + MOE_BLOCK - 1) // MOE_BLOCK) * MOE_BLOCK
    start = jnp.cumsum(counts) - counts
    pend = jnp.cumsum(padded)
    pstart = pend - padded
    dest = pstart[se] + (jnp.arange(n_slots) - start[se])
    n_blocks = -(-(n_slots + N_EXPERTS * (MOE_BLOCK - 1)) // MOE_BLOCK)
    rows = n_blocks * MOE_BLOCK
    tok_pad = jnp.zeros((rows,), jnp.int32).at[dest].set(st)
    w_pad = jnp.zeros((rows,), F32).at[dest].set(sw)
    block_expert = jnp.clip(jnp.searchsorted(pend, jnp.arange(n_blocks) * MOE_BLOCK, side='right'),
                            0, N_EXPERTS - 1)
    xb = xn[tok_pad].reshape(n_blocks, MOE_BLOCK, d)

    def block_fn(args):
        xi, e = args
        hid = jax.nn.silu(xi @ w_e_gate[e]) * (xi @ w_e_up[e])
        return hid @ w_e_down[e]

    yb = lax.map(block_fn, (xb, block_expert)).reshape(rows, d)
    contrib = (yb.astype(F32) * w_pad[:, None]).astype(xn.dtype)
    return jnp.zeros((n, d), xn.dtype).at[tok_pad].add(contrib)


def setup_inputs(seed: int = 0) -> dict:
    key = jax.random.key(seed)
    ks = jax.random.split(key, 20)

    def nrm(k, shape, scale):
        return jax.random.normal(k, shape, F32) * scale

    return {
        'x': nrm(ks[0], (BATCH, SEQ, D_MODEL), 1.0),
        'norm_attn': 1.0 + nrm(ks[1], (DEPTH, D_MODEL), 0.02),
        'w_in': nrm(ks[2], (DEPTH, D_MODEL, D_IN), D_MODEL ** -0.5),
        'qk_gain': 1.0 + nrm(ks[3], (DEPTH, 6, HEAD_DIM), 0.02),
        'idx_k_gain': 1.0 + nrm(ks[4], (DEPTH, IDX_DIM), 0.02),
        'diff_lambda': nrm(ks[5], (DEPTH, 4, HEAD_DIM), 0.1),
        'diff_subln_gain': 1.0 + nrm(ks[6], (DEPTH, C_VDIM), 0.02),
        'w_proj_a': nrm(ks[7], (DEPTH, A_W, D_MODEL), A_W ** -0.5),
        'w_proj_b': nrm(ks[8], (DEPTH, B_W, D_MODEL), B_W ** -0.5),
        'w_proj_c': nrm(ks[9], (DEPTH, C_W, D_MODEL), C_W ** -0.5),
        'w_out': nrm(ks[10], (DEPTH, D_MODEL, D_MODEL), D_MODEL ** -0.5),
        'norm_ffn': 1.0 + nrm(ks[11], (DEPTH, D_MODEL), 0.02),
        'w_group': nrm(ks[12], (DEPTH, D_MODEL, N_GROUPS), D_MODEL ** -0.5),
        'b_group': nrm(ks[13], (DEPTH, N_GROUPS), 0.01),
        'w_router': nrm(ks[14], (DEPTH, D_MODEL, N_EXPERTS), D_MODEL ** -0.5),
        'b_router': nrm(ks[15], (DEPTH, N_EXPERTS), 0.01),
        'w_e_gate': nrm(ks[16], (DEPTH, N_EXPERTS, D_MODEL, D_EXPERT), D_MODEL ** -0.5),
        'w_e_up': nrm(ks[17], (DEPTH, N_EXPERTS, D_MODEL, D_EXPERT), D_MODEL ** -0.5),
        'w_e_down': nrm(ks[18], (DEPTH, N_EXPERTS, D_EXPERT, D_MODEL), D_EXPERT ** -0.5),
    }


def reference(x, norm_attn, w_in, qk_gain, idx_k_gain, diff_lambda, diff_subln_gain, w_proj_a,
              w_proj_b, w_proj_c, w_out, norm_ffn, w_group, b_group, w_router, b_router,
              w_e_gate, w_e_up, w_e_down):
    b, s, d = x.shape
    cos, sin = rope_tables(s)
    for l in range(DEPTH):
        x = mixer_sublayer(x, cos, sin, l, norm_attn[l], w_in[l], qk_gain[l], idx_k_gain[l],
                           diff_lambda[l], diff_subln_gain[l], w_proj_a[l], w_proj_b[l],
                           w_proj_c[l], w_out[l])
        hn = rms_norm(x, norm_ffn[l]).reshape(b * s, d)
        x = x + hier_moe(hn, w_group[l], b_group[l], w_router[l], b_router[l],
                         w_e_gate[l], w_e_up[l], w_e_down[l]).reshape(b, s, d)
    return x
```

```cpp
#include <hip/hip_runtime.h>
#include <cstdio>
#include <cstdint>

#define LAS __attribute__((address_space(3)))
#define GAS __attribute__((address_space(1)))
typedef unsigned short bf16_t;
typedef short bf16x8 __attribute__((ext_vector_type(8)));
typedef short s16x4 __attribute__((ext_vector_type(4)));
typedef float f32x4 __attribute__((ext_vector_type(4)));
typedef float f32x2 __attribute__((ext_vector_type(2)));
typedef float f32x16 __attribute__((ext_vector_type(16)));
typedef unsigned u32x4 __attribute__((ext_vector_type(4)));
typedef unsigned u32x2 __attribute__((ext_vector_type(2)));

constexpr int NBATCH = 8, SEQ = 4096, MTOK = NBATCH * SEQ, DM = 1024, NLAYER = 2;
constexpr int QP = 3656;
constexpr int C_QA = 0, C_KA = 256, C_VA = 512, C_QB = 768, C_KB = 1024, C_VB = 1280, C_QI = 1536, C_KI = 2048, C_WI = 2112,
              C_Q1 = 2120, C_Q2 = 2376, C_K1 = 2632, C_K2 = 2888, C_VC = 3144, C_G = 3656, D_IN = 6728;
constexpr int NT_IN = 27;
constexpr int NEXP = 32, DEXP = 512, MAXBLK = 288;
constexpr float C2 = 0.125f * 1.4426950408889634f;
constexpr float EPS = 1e-6f;

constexpr size_t MiB = 1u << 20;
constexpr size_t WS_CTL = 0, CTL_BYTES = 1 * MiB;
constexpr size_t WS_COS = 1 * MiB, WS_SIN = WS_COS + 512 * 1024;
constexpr size_t WS_SMALL = 2 * MiB;
constexpr size_t WS_KMEAN = WS_SMALL, WS_RT0 = WS_SMALL + 256 * 1024, WS_RT1 = WS_SMALL + 384 * 1024, WS_RTW = WS_SMALL + 512 * 1024, WS_WRT = WS_SMALL + 768 * 1024;
constexpr size_t WS_WIN = 3 * MiB;
constexpr size_t WS_WPA = 17 * MiB, WS_WPB = WS_WPA + 512 * 1024, WS_WPC = 18 * MiB;
constexpr size_t WS_WO = 19 * MiB;
constexpr size_t WS_WGU = 21 * MiB;
constexpr size_t WS_WD = 85 * MiB;
constexpr size_t WS_HN = 117 * MiB;
constexpr size_t WS_OA = WS_HN, WS_OB = WS_HN + 16 * MiB, WS_OC = WS_HN + 32 * MiB;
constexpr size_t WS_QKV = 181 * MiB;
constexpr size_t WS_MERGED = WS_QKV, WS_XB = WS_QKV, WS_Y = WS_QKV, WS_HID = WS_QKV + 144 * MiB;
constexpr size_t WS_SG = 410 * MiB;
constexpr size_t WS_MASK = 506 * MiB;
constexpr size_t WS_END = 522 * MiB;
static_assert((size_t)MTOK * QP * 2 <= 229 * MiB && (size_t)MAXBLK * 256 * 1024 * 2 <= 144 * MiB && (size_t)MAXBLK * 256 * 512 * 2 <= 72 * MiB, "ws map");
constexpr int CW_BAR = 4096;
constexpr int CW_QUEUE = 8192;
constexpr int CW_CNT = 16384;

constexpr int LDSX = 131072;
constexpr int LX_BAR = LDSX, LX_BC = LDSX + 16, LX_NBLK = LDSX + 32, LX_PSTART = LDSX + 64, LX_BLK2E = LDSX + 256;
constexpr int LDS_BYTES = 147456;

__device__ __forceinline__ unsigned cvt_pk_bf16(float lo, float hi) { unsigned r; asm volatile("v_cvt_pk_bf16_f32 %0, %1, %2" : "=v"(r) : "v"(lo), "v"(hi)); return r; }
__device__ __forceinline__ float bf_lo(unsigned w) { return __builtin_bit_cast(float, w << 16); }
__device__ __forceinline__ float bf_hi(unsigned w) { return __builtin_bit_cast(float, w & 0xffff0000u); }
__device__ __forceinline__ float wave_sum(float v) {
#pragma unroll
    for (int o = 1; o < 64; o <<= 1) v += __shfl_xor(v, o);
    return v;
}
__device__ __forceinline__ float fast_exp2(float x) { return __builtin_amdgcn_exp2f(x); }
__device__ __forceinline__ float fast_rcp(float x) { return __builtin_amdgcn_rcpf(x); }

namespace pg8 {
#define PG8_LAS __attribute__((address_space(3)))
typedef unsigned short bf16_t;
typedef short bf16x8 __attribute__((ext_vector_type(8)));
typedef float f32x4 __attribute__((ext_vector_type(4)));
typedef unsigned u32x4 __attribute__((ext_vector_type(4)));
constexpr int BM = 256, BK = 64, HALF = 128, HTB = HALF * BK * 2  , STAGE_BYTES = 8 * HTB, NXCD = 8, WGM = 8;

__host__ __device__ __forceinline__ int lds_byte(int r, int c) { const int st = (r >> 4) * 2 + (c >> 5), rr = r & 15, cc = c & 31, ob = rr * 64 + cc * 2; return st * 1024 + (ob ^ (((ob >> 9) & 1) << 5)); }
__host__ __device__ __forceinline__ void stage_rc(int b, int& R, int& C) { const int st = b / 1024, sb = b % 1024, swz = sb ^ (((sb >> 9) & 1) << 5); R = (st >> 1) * 16 + swz / 64; C = (st & 1) * 32 + (swz % 64) / 2; }
__host__ __device__ __forceinline__ int perm32(int rho) { const int n = rho >> 4, i = rho & 15; return 8 * (i >> 2) + 4 * n + (i & 3); }
struct Unit { int pm, pn; };
struct Gemm { const bf16_t* A; const bf16_t* Bt; int M, N, K; };

struct StaticOrder {
    int nM, nN, nwg, G, c;
    __host__ __device__ void init(int M, int N, int G_, int c_) { nM = M / BM; nN = N / BM; nwg = nM * nN; G = G_; c = c_; }
    __host__ __device__ bool next(int i, Unit& u) const {
        const long L = (long)i * G + c; if (L >= nwg) return false;
        int wgid = (int)L; { const int q = nwg / NXCD, r = nwg % NXCD, xcd = wgid % NXCD, off = wgid / NXCD; wgid = (xcd < r ? xcd * (q + 1) : r * (q + 1) + (xcd - r) * q) + off; }
        const int nig = WGM * nN, gid = wgid / nig, fm = gid * WGM, gsz = (nM - fm) < WGM ? (nM - fm) : WGM;
        u.pm = fm + ((wgid % nig) % gsz); u.pn = (wgid % nig) / gsz; return true;
    }
    __device__ __forceinline__ void a_ready(const Unit&) const {}
    __device__ __forceinline__ void done(const Unit&) const {}
};


struct EpiInProj {
    static constexpr bool PERM = false, AFTER_DRAIN = false;
    bf16_t* qkv; unsigned char* sg; const float* cosT; const float* sinT; const float* qkg; const float* ikg;
    __device__ __forceinline__ void operator()(const f32x4 (&acc)[2][2][4][2], const Unit& u, int wr, int wc, int fr, int fq) const {
        const int pn = u.pn, row0 = u.pm * BM + wr * 64 + fr;
        if (pn >= 15) {
            unsigned char* base = sg + (size_t)row0 * 3072 + (pn - 15) * 256 + wc * 32 + fq * 8;
#pragma unroll
            for (int ai = 0; ai < 2; ++ai)
#pragma unroll
                for (int m = 0; m < 4; ++m)
#pragma unroll
                    for (int bj = 0; bj < 2; ++bj) {
                        unsigned w[2];
#pragma unroll
                        for (int n = 0; n < 2; ++n) { unsigned pk = 0;
#pragma unroll
                            for (int i = 0; i < 4; ++i) { const float x = acc[ai][bj][m][n][i]; const float s = fast_rcp(1.0f + fast_exp2(-1.4426950408889634f * x));
                                unsigned q = (unsigned)(s * 255.0f + 0.5f); q = q > 255u ? 255u : q; pk |= q << (8 * i); }
                            w[n] = pk; }
                        *(u32x2*)(base + (size_t)(ai * HALF + m * 16) * 3072 + bj * HALF) = (u32x2){w[0], w[1]};
                    }
            return;
        }
        int type = 0, gi = 0; bool qscale = false;
        int ocol = (pn < 8 ? 256 * pn : C_Q1 + 256 * (pn - 9)) + 64 * wc;
        switch (pn) {
            case 0: type = 2; gi = 0; qscale = true; break;
            case 1: type = 2; gi = 1; break;
            case 3: type = 2; gi = 2; qscale = true; break;
            case 4: type = 2; gi = 3; break;
            case 6: case 7: type = 1; break;
            case 8: if (wc == 0) { type = 2; ocol = C_KI; } else if (wc == 1) { type = 3; ocol = C_WI; } else type = 4; break;
            case 9: case 10: type = 2; gi = 4; qscale = true; break;
            case 11: case 12: type = 2; gi = 5; break;
            default: type = 0; break;
        }
        if (type == 4) return;
        if (type == 3) {
            if (fq == 0) {
#pragma unroll
                for (int ai = 0; ai < 2; ++ai)
#pragma unroll
                    for (int m = 0; m < 4; ++m) { const f32x4 a = acc[ai][0][m][0] * 0.35355339059327373f, b = acc[ai][0][m][1] * 0.35355339059327373f;
                        *(u32x4*)(qkv + (size_t)(row0 + ai * HALF + m * 16) * QP + C_WI) = (u32x4){cvt_pk_bf16(a[0], a[1]), cvt_pk_bf16(a[2], a[3]), cvt_pk_bf16(b[0], b[1]), cvt_pk_bf16(b[2], b[3])}; }
            }
            return;
        }
        const float* gp = (pn == 8) ? ikg : qkg + 64 * gi;
        if (type == 2) { if (qscale) body<2, true>(acc, row0, ocol, gp, fq); else body<2, false>(acc, row0, ocol, gp, fq); }
        else if (type == 1) body<1, false>(acc, row0, ocol, gp, fq);
        else body<0, false>(acc, row0, ocol, gp, fq);
    }
    template <int TYPE, bool QS>
    __device__ __forceinline__ void body(const f32x4 (&acc)[2][2][4][2], int row0, int ocol, const float* gp, int fq) const {
#pragma unroll
        for (int ai = 0; ai < 2; ++ai)
#pragma unroll
            for (int m = 0; m < 4; ++m) {
                const int row = row0 + ai * HALF + m * 16;
                f32x4 x[2][2];
#pragma unroll
                for (int bj = 0; bj < 2; ++bj)
#pragma unroll
                    for (int n = 0; n < 2; ++n) x[bj][n] = acc[ai][bj][m][n];
                if (TYPE == 2) {
                    float ss = 0.f;
#pragma unroll
                    for (int bj = 0; bj < 2; ++bj)
#pragma unroll
                        for (int n = 0; n < 2; ++n) ss += (x[bj][n][0] * x[bj][n][0] + x[bj][n][1] * x[bj][n][1]) + (x[bj][n][2] * x[bj][n][2] + x[bj][n][3] * x[bj][n][3]);
                    ss += __shfl_xor(ss, 16); ss += __shfl_xor(ss, 32);
                    const float inv = (QS ? C2 : 1.0f) / sqrtf(ss * (1.0f / 64.0f) + EPS);
#pragma unroll
                    for (int bj = 0; bj < 2; ++bj)
#pragma unroll
                        for (int n = 0; n < 2; ++n) x[bj][n] = x[bj][n] * inv * *(const f32x4*)(gp + 32 * bj + 8 * fq + 4 * n);
                }
                if (TYPE >= 1) {
                    const int pos = row & (SEQ - 1);
#pragma unroll
                    for (int n = 0; n < 2; ++n) {
                        const f32x4 c = *(const f32x4*)(cosT + pos * 32 + 8 * fq + 4 * n), s = *(const f32x4*)(sinT + pos * 32 + 8 * fq + 4 * n);
                        const f32x4 a = x[0][n], b = x[1][n];
                        x[0][n] = a * c - b * s; x[1][n] = b * c + a * s;
                    }
                }
#pragma unroll
                for (int bj = 0; bj < 2; ++bj)
                    *(u32x4*)(qkv + (size_t)row * QP + ocol + 32 * bj + 8 * fq) = (u32x4){cvt_pk_bf16(x[bj][0][0], x[bj][0][1]), cvt_pk_bf16(x[bj][0][2], x[bj][0][3]), cvt_pk_bf16(x[bj][1][0], x[bj][1][1]), cvt_pk_bf16(x[bj][1][2], x[bj][1][3])};
                asm volatile("" ::: "memory");
            }
    }
};

template <int BR> struct EpiMerge {
    static constexpr bool PERM = false, AFTER_DRAIN = false;
    bf16_t* merged; const unsigned char* sg;
    __device__ __forceinline__ void operator()(const f32x4 (&acc)[2][2][4][2], const Unit& u, int wr, int wc, int fr, int fq) const {
        const int row0 = u.pm * BM + wr * 64 + fr, col0 = u.pn * BM + wc * 32 + fq * 8;
#pragma unroll
        for (int ai = 0; ai < 2; ++ai)
#pragma unroll
            for (int m = 0; m < 4; ++m) { const size_t row = (size_t)(row0 + ai * HALF + m * 16);
#pragma unroll
                for (int bj = 0; bj < 2; ++bj) {
                    const u32x2 gq = *(const u32x2*)(sg + row * 3072 + BR * 1024 + col0 + bj * HALF);
                    bf16_t* mp = merged + row * 1024 + col0 + bj * HALF;
                    float v[8];
#pragma unroll
                    for (int n = 0; n < 2; ++n)
#pragma unroll
                        for (int i = 0; i < 4; ++i) v[4 * n + i] = acc[ai][bj][m][n][i] * ((float)((gq[n] >> (8 * i)) & 255u) * (1.0f / 255.0f));
                    if (BR > 0) { const u32x4 o = *(const u32x4*)mp;
#pragma unroll
                        for (int k = 0; k < 4; ++k) { v[2 * k] += bf_lo(o[k]); v[2 * k + 1] += bf_hi(o[k]); } }
                    *(u32x4*)mp = (u32x4){cvt_pk_bf16(v[0], v[1]), cvt_pk_bf16(v[2], v[3]), cvt_pk_bf16(v[4], v[5]), cvt_pk_bf16(v[6], v[7])};
                }
                asm volatile("" ::: "memory"); }
    }
};

struct EpiResid {
    static constexpr bool PERM = false, AFTER_DRAIN = false;
    const float* res; float* out;
    __device__ __forceinline__ void operator()(const f32x4 (&acc)[2][2][4][2], const Unit& u, int wr, int wc, int fr, int fq) const {
        const int row0 = u.pm * BM + wr * 64 + fr, col0 = u.pn * BM + wc * 32 + fq * 8;
#pragma unroll
        for (int ai = 0; ai < 2; ++ai)
#pragma unroll
            for (int m = 0; m < 4; ++m) { const size_t off = (size_t)(row0 + ai * HALF + m * 16) * 1024 + col0;
#pragma unroll
                for (int bj = 0; bj < 2; ++bj)
#pragma unroll
                    for (int n = 0; n < 2; ++n) { const f32x4 r = *(const f32x4*)(res + off + bj * HALF + 4 * n); *(f32x4*)(out + off + bj * HALF + 4 * n) = r + acc[ai][bj][m][n]; }
                if (m & 1) asm volatile("" ::: "memory"); }
    }
};

struct EpiGateUp {
    static constexpr bool PERM = false, AFTER_DRAIN = false;
    bf16_t* hid;
    __device__ __forceinline__ void operator()(const f32x4 (&acc)[2][2][4][2], const Unit& u, int wr, int wc, int fr, int fq) const {
        const int row0 = u.pm * BM + wr * 64 + fr, col0 = (u.pn & 3) * HALF + wc * 32 + fq * 8;
#pragma unroll
        for (int ai = 0; ai < 2; ++ai)
#pragma unroll
            for (int m = 0; m < 4; ++m) { float v[8];
#pragma unroll
                for (int n = 0; n < 2; ++n)
#pragma unroll
                    for (int i = 0; i < 4; ++i) { const float gt = acc[ai][0][m][n][i], up = acc[ai][1][m][n][i]; v[4 * n + i] = gt * fast_rcp(1.0f + fast_exp2(-1.4426950408889634f * gt)) * up; }
                *(u32x4*)(hid + (size_t)(row0 + ai * HALF + m * 16) * DEXP + col0) = (u32x4){cvt_pk_bf16(v[0], v[1]), cvt_pk_bf16(v[2], v[3]), cvt_pk_bf16(v[4], v[5]), cvt_pk_bf16(v[6], v[7])}; }
    }
};

struct EpiDown {
    static constexpr bool PERM = false, AFTER_DRAIN = false;
    bf16_t* y;
    __device__ __forceinline__ void operator()(const f32x4 (&acc)[2][2][4][2], const Unit& u, int wr, int wc, int fr, int fq) const {
        const int row0 = u.pm * BM + wr * 64 + fr, col0 = (u.pn & 3) * BM + wc * 32 + fq * 8;
#pragma unroll
        for (int ai = 0; ai < 2; ++ai)
#pragma unroll
            for (int m = 0; m < 4; ++m)
#pragma unroll
                for (int bj = 0; bj < 2; ++bj) { const f32x4 a = acc[ai][bj][m][0], b = acc[ai][bj][m][1];
                    *(u32x4*)(y + (size_t)(row0 + ai * HALF + m * 16) * 1024 + col0 + bj * HALF) = (u32x4){cvt_pk_bf16(a[0], a[1]), cvt_pk_bf16(a[2], a[3]), cvt_pk_bf16(b[0], b[1]), cvt_pk_bf16(b[2], b[3])}; }
    }
};

struct MoeOrder {
    int nunits, G, c; const PG8_LAS int* blk2e;
    __device__ __forceinline__ bool next(int i, Unit& u) const { const int L = i * G + c; if (L >= nunits) return false; const int rb = L >> 2; u.pm = rb; u.pn = blk2e[rb] * 4 + (L & 3); return true; }
    __device__ __forceinline__ void a_ready(const Unit&) const {}
    __device__ __forceinline__ void done(const Unit&) const {}
};

template <class Epi, class Sched, bool ALIGN_EPI = false, bool SP2 = false>
__device__ __forceinline__ void gemm_phase(PG8_LAS unsigned char* lds, const Gemm g, const Sched& S, const Epi& E) {
    int tid_l = (int)threadIdx.x; asm volatile("" : "+v"(tid_l));
    const int tid = tid_l, wid = __builtin_amdgcn_readfirstlane(tid >> 6), lane = tid & 63, wr = wid >> 2, wc = wid & 3, fr = lane & 15, fq = lane >> 4;
    const int K = g.K, nt = K / BK;
    unsigned voffA[2], voffB[2];
#pragma unroll
    for (int i = 0; i < 2; ++i) { int R, C; stage_rc(tid * 16 + i * 8192, R, C); const int Rb = Epi::PERM ? ((R & ~31) + perm32(R & 31)) : R;
        voffA[i] = (unsigned)(R * K + C) * 2u; voffB[i] = (unsigned)(Rb * K + C) * 2u; }
    const size_t kstep = (size_t)(BK * 2);
    const size_t hstep = (size_t)HALF * K * 2;
    const size_t tstep = 2 * hstep;
    const unsigned ldsw = (unsigned)wid * 1024u;
    const int aoff = lds_byte(wr * 64 + fr, fq * 8), boff = lds_byte(wc * 32 + fr, fq * 8);
#define PG8_SA(b, h) (((b) * 2 + (h)) * HTB)
#define PG8_SB(b, h) ((4 + (b) * 2 + (h)) * HTB)
#define PG8_STAGE(bufoff, gbase, voff) do { _Pragma("unroll") for (int _i = 0; _i < 2; ++_i) \
        __builtin_amdgcn_global_load_lds((const unsigned*)((const char*)(gbase) + (voff)[_i]), (PG8_LAS unsigned*)(lds + (bufoff) + ldsw + _i * 8192), 16, 0, 0); } while (0)
#define PG8_LDA(dst, b, h) do { _Pragma("unroll") for (int m = 0; m < 4; ++m) _Pragma("unroll") for (int k = 0; k < 2; ++k) dst[m][k] = *(const PG8_LAS bf16x8*)(lds + PG8_SA(b, h) + aoff + m * 2048 + k * 1024); } while (0)
#define PG8_LDB(dst, b, h) do { _Pragma("unroll") for (int n = 0; n < 2; ++n) _Pragma("unroll") for (int k = 0; k < 2; ++k) dst[n][k] = *(const PG8_LAS bf16x8*)(lds + PG8_SB(b, h) + boff + n * 2048 + k * 1024); } while (0)
#define PG8_MMA(ai, bj, At, Bt) do { __builtin_amdgcn_s_setprio(1); _Pragma("unroll") for (int m = 0; m < 4; ++m) _Pragma("unroll") for (int n = 0; n < 2; ++n) _Pragma("unroll") for (int k = 0; k < 2; ++k) \
        acc[ai][bj][m][n] = __builtin_amdgcn_mfma_f32_16x16x32_bf16(Bt[n][k], At[m][k], acc[ai][bj][m][n], 0, 0, 0); __builtin_amdgcn_s_setprio(0); } while (0)
#define PG8_WAIT_V(n) asm volatile("s_waitcnt vmcnt(" #n ")" ::: "memory")
#define PG8_WAIT_L(n) asm volatile("s_waitcnt lgkmcnt(" #n ")" ::: "memory")
#define PG8_BAR __builtin_amdgcn_s_barrier()
#define PG8_SCHED __builtin_amdgcn_sched_barrier(0)
    Unit cur, nxt; int ui = 0;
    if (!S.next(0, cur)) return;
    f32x4 acc[2][2][4][2];
#pragma unroll
    for (int a = 0; a < 2; ++a)
#pragma unroll
        for (int b = 0; b < 2; ++b)
#pragma unroll
            for (int m = 0; m < 4; ++m)
#pragma unroll
                for (int n = 0; n < 2; ++n) acc[a][b][m][n] = (f32x4){0.f, 0.f, 0.f, 0.f};
    bf16x8 At[4][2], B0[2][2], B1[2][2];
    const char* cA = (const char*)g.A + (size_t)cur.pm * tstep; const char* cB = (const char*)g.Bt + (size_t)cur.pn * tstep;
    S.a_ready(cur);
    if constexpr (SP2) {
        PG8_STAGE(PG8_SB(0, 0), cB, voffB); PG8_STAGE(PG8_SB(0, 1), cB + hstep, voffB); PG8_STAGE(PG8_SA(0, 0), cA, voffA); PG8_STAGE(PG8_SA(0, 1), cA + hstep, voffA);
        if (wr == 1) PG8_BAR;
        PG8_WAIT_V(2); PG8_BAR;
        PG8_STAGE(PG8_SB(1, 0), cB + kstep, voffB); PG8_STAGE(PG8_SA(1, 0), cA + kstep, voffA); PG8_STAGE(PG8_SB(1, 1), cB + hstep + kstep, voffB);
        PG8_WAIT_V(6); PG8_BAR;
    } else {
        PG8_STAGE(PG8_SB(0, 0), cB, voffB); PG8_STAGE(PG8_SA(0, 0), cA, voffA); PG8_STAGE(PG8_SB(0, 1), cB + hstep, voffB); PG8_STAGE(PG8_SA(0, 1), cA + hstep, voffA);
        if (wr == 1) PG8_BAR;
        PG8_WAIT_V(4); PG8_BAR;
        PG8_STAGE(PG8_SB(1, 0), cB + kstep, voffB); PG8_STAGE(PG8_SA(1, 0), cA + kstep, voffA); PG8_STAGE(PG8_SB(1, 1), cB + hstep + kstep, voffB);
        PG8_WAIT_V(6); PG8_BAR;
    }
    for (;;) {
        const bool has_next = S.next(ui + 1, nxt);
        const char* nA = has_next ? (const char*)g.A + (size_t)nxt.pm * tstep : cA; const char* nB = has_next ? (const char*)g.Bt + (size_t)nxt.pn * tstep : cB;
#pragma unroll 1
        for (int t = 0; t < nt; t += 2) {
            const bool last = (t == nt - 2);
            const char* a1 = cA + (size_t)(t + 1) * kstep;
            const char* a2 = last ? nA : cA + (size_t)(t + 2) * kstep; const char* b2 = last ? nB : cB + (size_t)(t + 2) * kstep;
            const char* a3 = a2 + kstep; const char* b3 = b2 + kstep;
            if (last && has_next) S.a_ready(nxt);
            if constexpr (SP2) {
            PG8_LDB(B0, 0, 0); PG8_LDB(B1, 0, 1); PG8_SCHED; PG8_LDA(At, 0, 0); PG8_STAGE(PG8_SA(1, 1), a1 + hstep, voffA);
            PG8_WAIT_V(8); PG8_WAIT_L(0); PG8_BAR; PG8_MMA(0, 0, At, B0); PG8_MMA(0, 1, At, B1); PG8_BAR; PG8_SCHED;
            PG8_LDA(At, 0, 1); PG8_STAGE(PG8_SB(0, 0), b2, voffB); PG8_STAGE(PG8_SB(0, 1), b2 + hstep, voffB); PG8_STAGE(PG8_SA(0, 0), a2, voffA);
            PG8_WAIT_V(8); PG8_WAIT_L(0); PG8_BAR; PG8_MMA(1, 0, At, B0); PG8_MMA(1, 1, At, B1); PG8_BAR; PG8_SCHED;
            PG8_LDB(B0, 1, 0); PG8_LDB(B1, 1, 1); PG8_SCHED; PG8_LDA(At, 1, 0); PG8_STAGE(PG8_SA(0, 1), a2 + hstep, voffA);
            PG8_WAIT_V(8); PG8_WAIT_L(0); PG8_BAR; PG8_MMA(0, 0, At, B0); PG8_MMA(0, 1, At, B1); PG8_BAR; PG8_SCHED;
            PG8_LDA(At, 1, 1); PG8_STAGE(PG8_SB(1, 0), b3, voffB); PG8_STAGE(PG8_SB(1, 1), b3 + hstep, voffB); PG8_STAGE(PG8_SA(1, 0), a3, voffA);
            PG8_WAIT_V(8); PG8_WAIT_L(0); PG8_BAR; PG8_MMA(1, 0, At, B0); PG8_MMA(1, 1, At, B1); PG8_BAR; PG8_SCHED;
            } else {
            PG8_LDB(B0, 0, 0); PG8_SCHED; PG8_LDA(At, 0, 0); PG8_STAGE(PG8_SA(1, 1), a1 + hstep, voffA);
            PG8_WAIT_L(8); PG8_BAR; PG8_WAIT_L(0); PG8_MMA(0, 0, At, B0); PG8_BAR; PG8_SCHED;
            PG8_LDB(B1, 0, 1); PG8_STAGE(PG8_SB(0, 0), b2, voffB);
            PG8_BAR; PG8_WAIT_L(0); PG8_MMA(0, 1, At, B1); PG8_BAR;
            PG8_LDA(At, 0, 1); PG8_STAGE(PG8_SA(0, 0), a2, voffA);
            PG8_BAR; PG8_WAIT_L(0); PG8_MMA(1, 0, At, B0); PG8_BAR; PG8_SCHED;
            PG8_STAGE(PG8_SB(0, 1), b2 + hstep, voffB);
            PG8_WAIT_V(6); PG8_BAR; PG8_MMA(1, 1, At, B1); PG8_BAR;
            PG8_LDB(B0, 1, 0); PG8_SCHED; PG8_LDA(At, 1, 0); PG8_STAGE(PG8_SA(0, 1), a2 + hstep, voffA);
            PG8_WAIT_L(8); PG8_BAR; PG8_WAIT_L(0); PG8_MMA(0, 0, At, B0); PG8_BAR; PG8_SCHED;
            PG8_LDB(B1, 1, 1); PG8_STAGE(PG8_SB(1, 0), b3, voffB);
            PG8_BAR; PG8_WAIT_L(0); PG8_MMA(0, 1, At, B1); PG8_BAR;
            PG8_LDA(At, 1, 1); PG8_STAGE(PG8_SA(1, 0), a3, voffA);
            PG8_BAR; PG8_WAIT_L(0); PG8_MMA(1, 0, At, B0); PG8_BAR; PG8_SCHED;
            PG8_STAGE(PG8_SB(1, 1), b3 + hstep, voffB);
            PG8_WAIT_V(6); PG8_BAR; PG8_MMA(1, 1, At, B1); PG8_BAR;
            }
        }
        if constexpr (ALIGN_EPI) { if (wr == 0) PG8_BAR; }
        if constexpr (!Epi::AFTER_DRAIN) { E(acc, cur, wr, wc, fr, fq); S.done(cur); }
        if (!has_next) break;
#pragma unroll
        for (int a = 0; a < 2; ++a)
#pragma unroll
            for (int b = 0; b < 2; ++b)
#pragma unroll
                for (int m = 0; m < 4; ++m)
#pragma unroll
                    for (int n = 0; n < 2; ++n) acc[a][b][m][n] = (f32x4){0.f, 0.f, 0.f, 0.f};
        cur = nxt; cA = nA; cB = nB; ++ui;
        if constexpr (ALIGN_EPI) { if (wr == 1) PG8_BAR; }
    }
    PG8_WAIT_V(0);
    if constexpr (!ALIGN_EPI) { if (wr == 0) PG8_BAR; }
    PG8_BAR;
    if constexpr (Epi::AFTER_DRAIN) { E.fused(acc, cur, wr, wc, fr, fq, lds, wid, lane); S.done(cur); }
#undef PG8_SA
#undef PG8_SB
#undef PG8_STAGE
#undef PG8_LDA
#undef PG8_LDB
#undef PG8_MMA
#undef PG8_WAIT_V
#undef PG8_WAIT_L
#undef PG8_BAR
#undef PG8_SCHED
}
}
#define XB_TMO      128
#define XB_XCNT(j)  (256  + 64 * (j))
#define XB_XSUB(j)  (1280 + 64 * (j))
#define XB_XGEN(j)  (2304 + 64 * (j))
#define XB_TOP      3328
#define XB_TOPGEN   3392
#define XCD_BAR_WORDS 3456
#define XB_SPIN_CAP (1u << 21)

__device__ __forceinline__ unsigned xb_ld(unsigned* p)              { return __hip_atomic_load(p, __ATOMIC_RELAXED, __HIP_MEMORY_SCOPE_AGENT); }
__device__ __forceinline__ unsigned xb_add(unsigned* p, unsigned v) { return __hip_atomic_fetch_add(p, v, __ATOMIC_RELAXED, __HIP_MEMORY_SCOPE_AGENT); }
__device__ __forceinline__ unsigned xb_xcc_id() { return (unsigned)__builtin_amdgcn_s_getreg((3 << 11) | 20) & 0xFu; }
#define XB_SPIN(cond, bar) do { unsigned _sp = 0; while (cond) { __builtin_amdgcn_s_sleep(1); \
    if ((++_sp & 255u) == 0u) { if (xb_ld(&(bar)[XB_TMO])) break; if (_sp > XB_SPIN_CAP) { atomicAdd(&(bar)[XB_TMO], 1u); break; } } } } while (0)

struct XcdBarrier {
    unsigned* bar; unsigned x;
    volatile LAS unsigned* st;
};

__device__ __forceinline__ XcdBarrier xcd_barrier_post(unsigned* bar, volatile LAS unsigned* st) {
    XcdBarrier b; b.bar = bar; b.x = xb_xcc_id(); b.st = st;
    if (threadIdx.x == 0) (void)xb_add(&bar[XB_XCNT(b.x)], 1u);
    return b;
}
__device__ __forceinline__ void xcd_barrier_complete(unsigned* bar, unsigned x, unsigned& nloc, unsigned& nx) {
    const unsigned G = gridDim.x * gridDim.y * gridDim.z;
    unsigned sum, cnt, mine, sp = 0u;
    for (;;) {
        sum = 0u; cnt = 0u; mine = 0u;
#pragma unroll
        for (unsigned j = 0; j < 16; ++j) { const unsigned c = xb_ld(&bar[XB_XCNT(j)]); sum += c; cnt += (c > 0u) ? 1u : 0u; mine = (j == x) ? c : mine; }
        if (sum == G) break;
        __builtin_amdgcn_s_sleep(1);
        if ((++sp & 255u) == 0u) { if (xb_ld(&bar[XB_TMO])) break; if (sp > XB_SPIN_CAP) { atomicAdd(&bar[XB_TMO], 1u); break; } }
    }
    nloc = mine > 0u ? mine : 1u; nx = cnt > 0u ? cnt : 1u;
}

__device__ __forceinline__ void xcd_barrier(const XcdBarrier& b) {
    asm volatile("s_waitcnt vmcnt(0)" ::: "memory");
    __syncthreads();
    int tid_l = (int)threadIdx.x; asm volatile("" : "+v"(tid_l));
    if (tid_l == 0) {
        unsigned* bar = b.bar;
        __builtin_amdgcn_s_waitcnt(0);
        unsigned nloc = b.st[0], nx = b.st[1];
        if (nloc == 0u) { xcd_barrier_complete(bar, b.x, nloc, nx); b.st[0] = nloc; b.st[1] = nx; }
        const unsigned old = xb_add(&bar[XB_XSUB(b.x)], 1u);
        const unsigned gen = old / nloc;
        if (old + 1u == (gen + 1u) * nloc) {
            __builtin_amdgcn_fence(__ATOMIC_RELEASE, "agent");
            asm volatile("s_waitcnt vmcnt(0)" ::: "memory");
            const unsigned og = xb_add(&bar[XB_TOP], 1u);
            const unsigned tg = og / nx;
            if (og + 1u == (tg + 1u) * nx) xb_add(&bar[XB_TOPGEN], 1u);
            else XB_SPIN(xb_ld(&bar[XB_TOPGEN]) == tg, bar);
            __builtin_amdgcn_fence(__ATOMIC_ACQUIRE, "agent");
            xb_add(&bar[XB_XGEN(b.x)], 1u);
            asm volatile("s_waitcnt vmcnt(0)" ::: "memory");
        } else {
            XB_SPIN(xb_ld(&bar[XB_XGEN(b.x)]) == gen, bar);
            __builtin_amdgcn_fence(__ATOMIC_ACQUIRE, "agent");
            asm volatile("s_waitcnt vmcnt(0)" ::: "memory");
        }
    }
    __syncthreads();
}

enum { I_X = 0, I_NORM_ATTN, I_W_IN, I_QK_GAIN, I_IDX_K_GAIN, I_DIFF_LAMBDA, I_DIFF_SUBLN, I_W_PROJ_A, I_W_PROJ_B, I_W_PROJ_C, I_W_OUT, I_NORM_FFN, I_W_GROUP, I_B_GROUP, I_W_ROUTER, I_B_ROUTER,
       I_W_E_GATE, I_W_E_UP, I_W_E_DOWN, N_INPUTS };
struct Args { const float* in[N_INPUTS]; float* out; unsigned char* ws; };

#define LDS_WAIT() asm volatile("s_waitcnt lgkmcnt(0)" ::: "memory")

__device__ __forceinline__ int inproj_src_col(int d) {
    const int pn = d >> 8, s = d & 255;
    if (pn >= 15) return C_G + 256 * (pn - 15) + (s & ~31) + pg8::perm32(s & 31);
    const int u = (s >> 5) & 3, e = 32 * (s >> 7) + pg8::perm32(s & 31);
    if (pn < 8) return 256 * pn + 64 * u + e;
    if (pn == 8) { if (u == 0) return C_KI + e; if (u == 1) return e < 8 ? C_WI + e : -1; return -1; }
    return C_Q1 + 256 * (pn - 9) + 64 * u + e;
}
__device__ __forceinline__ void transpose_item(const float* W, int ldw, int K, bf16_t* WT, int drow0, int k0, int srccol, LAS float* scr, int lane) {
    const float* src = W + (size_t)k0 * ldw + (srccol >= 0 ? srccol : 0);
#pragma unroll 8
    for (int i = 0; i < 32; ++i) { const int kk = 2 * i + (lane >> 5); const float v = src[(size_t)kk * ldw]; scr[kk * 33 + (lane & 31)] = srccol >= 0 ? v : 0.f; }
    LDS_WAIT(); asm volatile("" ::: "memory");
    const int c = lane & 7;
#pragma unroll
    for (int j = 0; j < 4; ++j) { const int n = (lane >> 3) + 8 * j; const LAS float* s = scr + (8 * c) * 33 + n;
        u32x4 o; o.x = cvt_pk_bf16(s[0 * 33], s[1 * 33]); o.y = cvt_pk_bf16(s[2 * 33], s[3 * 33]); o.z = cvt_pk_bf16(s[4 * 33], s[5 * 33]); o.w = cvt_pk_bf16(s[6 * 33], s[7 * 33]);
        *(u32x4*)(WT + (size_t)(drow0 + n) * K + k0 + 8 * c) = o; }
    LDS_WAIT(); asm volatile("" ::: "memory");
}

template <bool COMBINE, bool WRITE_HN>
__device__ __forceinline__ void token_row(const float* src, float* dst, const bf16_t* y, const unsigned* rt0, const unsigned* rt1, const f32x2* rtw, const LAS int* pstart,
                                          const float* gain, bf16_t* hn, int m, int lane) {
    f32x4 v[4];
#pragma unroll
    for (int j = 0; j < 4; ++j) v[j] = ((const f32x4*)(src + (size_t)m * DM))[lane + 64 * j];
    if (COMBINE) {
        const unsigned a = rt0[m], b = rt1[m]; const f32x2 w = rtw[m];
        const size_t s0 = (size_t)(pstart[a >> 24] + (int)(a & 0xffffffu)), s1 = (size_t)(pstart[b >> 24] + (int)(b & 0xffffffu));
#pragma unroll
        for (int j = 0; j < 4; ++j) { const u32x2 p = ((const u32x2*)(y + s0 * DM))[lane + 64 * j], q = ((const u32x2*)(y + s1 * DM))[lane + 64 * j];
            v[j][0] += w[0] * bf_lo(p[0]) + w[1] * bf_lo(q[0]); v[j][1] += w[0] * bf_hi(p[0]) + w[1] * bf_hi(q[0]);
            v[j][2] += w[0] * bf_lo(p[1]) + w[1] * bf_lo(q[1]); v[j][3] += w[0] * bf_hi(p[1]) + w[1] * bf_hi(q[1]);
            ((f32x4*)(dst + (size_t)m * DM))[lane + 64 * j] = v[j]; }
    }
    if (WRITE_HN) {
        float ss = 0.f;
#pragma unroll
        for (int j = 0; j < 4; ++j) ss += (v[j][0] * v[j][0] + v[j][1] * v[j][1]) + (v[j][2] * v[j][2] + v[j][3] * v[j][3]);
        const float rstd = 1.0f / sqrtf(wave_sum(ss) * (1.0f / DM) + EPS);
#pragma unroll
        for (int j = 0; j < 4; ++j) { const f32x4 g = ((const f32x4*)gain)[lane + 64 * j]; const f32x4 o = v[j] * rstd * g;
            ((u32x2*)(hn + (size_t)m * DM))[lane + 64 * j] = (u32x2){cvt_pk_bf16(o[0], o[1]), cvt_pk_bf16(o[2], o[3])}; }
    }
}

__device__ __forceinline__ void p0_phase(const Args& a, unsigned char* ws, int l, LAS unsigned char* lds, int tid, int lane, int wave, int vcu, int G) {
    LAS float* scr = (LAS float*)(lds + wave * 16384);
    const int gw = vcu * 8 + wave, NGW = G * 8, gt = vcu * 512 + tid, NGT = G * 512;
    constexpr int I_IN = 216 * 16, I_PA = 32 * 4, I_PC = 32 * 8, I_WO = 32 * 16, I_GU = 32 * 32 * 16, I_DN = 32 * 32 * 8, NIT = I_IN + 2 * I_PA + I_PC + I_WO + I_GU + I_DN;
    for (int it = gw; it < NIT; it += NGW) {
        int r = it; const int d31 = lane & 31;
        if (r < I_IN) { const int nb = r >> 4, kb = r & 15; transpose_item(a.in[I_W_IN] + (size_t)l * DM * D_IN, D_IN, 1024, (bf16_t*)(ws + WS_WIN), nb * 32, kb * 64, inproj_src_col(nb * 32 + d31), scr, lane); continue; } r -= I_IN;
        const int pcol = pg8::perm32(d31);
        if (r < I_PA) { const int nb = r >> 2, kb = r & 3; transpose_item(a.in[I_W_PROJ_A] + (size_t)l * 256 * DM, DM, 256, (bf16_t*)(ws + WS_WPA), nb * 32, kb * 64, nb * 32 + pcol, scr, lane); continue; } r -= I_PA;
        if (r < I_PA) { const int nb = r >> 2, kb = r & 3; transpose_item(a.in[I_W_PROJ_B] + (size_t)l * 256 * DM, DM, 256, (bf16_t*)(ws + WS_WPB), nb * 32, kb * 64, nb * 32 + pcol, scr, lane); continue; } r -= I_PA;
        if (r < I_PC) { const int nb = r >> 3, kb = r & 7; transpose_item(a.in[I_W_PROJ_C] + (size_t)l * 512 * DM, DM, 512, (bf16_t*)(ws + WS_WPC), nb * 32, kb * 64, nb * 32 + pcol, scr, lane); continue; } r -= I_PC;
        if (r < I_WO) { const int nb = r >> 4, kb = r & 15; transpose_item(a.in[I_W_OUT] + (size_t)l * DM * DM, DM, 1024, (bf16_t*)(ws + WS_WO), nb * 32, kb * 64, nb * 32 + pcol, scr, lane); continue; } r -= I_WO;
        if (r < I_GU) { const int e = r >> 9, rr = r & 511, nb = rr >> 4, kb = rr & 15, dd = nb * 32, pn = dd >> 8, s = dd & 255, half = s >> 7;
            const float* src = (half ? a.in[I_W_E_UP] : a.in[I_W_E_GATE]) + (size_t)(l * NEXP + e) * DM * DEXP;
            transpose_item(src, DEXP, 1024, (bf16_t*)(ws + WS_WGU) + (size_t)e * 1024 * 1024, nb * 32, kb * 64, 128 * pn + (s & 127) + pcol, scr, lane); continue; } r -= I_GU;
        { const int e = r >> 8, rr = r & 255, nb = rr >> 3, kb = rr & 7;
            transpose_item(a.in[I_W_E_DOWN] + (size_t)(l * NEXP + e) * DEXP * DM, DM, 512, (bf16_t*)(ws + WS_WD) + (size_t)e * 1024 * 512, nb * 32, kb * 64, nb * 32 + pcol, scr, lane); }
    }
    if (l == 0) {
        float* cosT = (float*)(ws + WS_COS); float* sinT = (float*)(ws + WS_SIN);
        for (int idx = gt; idx < SEQ * 32; idx += NGT) { const int pos = idx >> 5, j = idx & 31;
            const float inv_freq = 1.0f / powf(10000.0f, (float)(2 * j) * (1.0f / 64.0f));
            const float ang = (float)pos * inv_freq;
            const double rev = (double)ang * 0.15915494309189533577; const float fr = (float)(rev - rint(rev));
            cosT[idx] = __builtin_amdgcn_cosf(fr); sinT[idx] = __builtin_amdgcn_sinf(fr); }
    }
    { float* wrt = (float*)(ws + WS_WRT); const float* wg = a.in[I_W_GROUP] + (size_t)l * DM * 4; const float* wr = a.in[I_W_ROUTER] + (size_t)l * DM * 32;
      for (int idx = gt; idx < 36 * DM; idx += NGT) { const int c = idx >> 10, k = idx & 1023; wrt[idx] = c < 4 ? wg[k * 4 + c] : wr[k * 32 + (c - 4)]; } }
    const float* gain = a.in[I_NORM_ATTN] + (size_t)l * DM; bf16_t* hn = (bf16_t*)(ws + WS_HN);
    const LAS int* pstart = (const LAS int*)(lds + LX_PSTART);
    if (l == 0) { for (int m = gw; m < MTOK; m += NGW) token_row<false, true>(a.in[I_X], nullptr, nullptr, nullptr, nullptr, nullptr, pstart, gain, hn, m, lane); }
    else { for (int m = gw; m < MTOK; m += NGW) token_row<true, true>(a.out, a.out, (const bf16_t*)(ws + WS_Y), (const unsigned*)(ws + WS_RT0), (const unsigned*)(ws + WS_RT1), (const f32x2*)(ws + WS_RTW), pstart, gain, hn, m, lane); }
}

__device__ __forceinline__ f32x16 mfma32(bf16x8 a, bf16x8 b, f32x16 c) { return __builtin_amdgcn_mfma_f32_32x32x16_bf16(a, b, c, 0, 0, 0); }
typedef short v4i16_t __attribute__((ext_vector_type(4)));
__device__ __forceinline__ s16x4 vtr(const LAS unsigned char* p) { return __builtin_bit_cast(s16x4, __builtin_amdgcn_ds_read_tr16_b64_v4i16((LAS v4i16_t*)p)); }
__device__ __forceinline__ int crow(int r, int hi) { return (r & 3) + 8 * (r >> 2) + 4 * hi; }
#define NEG_INF (-__builtin_inff())

__device__ __forceinline__ f32x16 splat16(float v) { f32x16 r;
#pragma unroll
    for (int i = 0; i < 16; ++i) r[i] = v;
    return r; }
struct QReg { const bf16x8 (&q)[4]; __device__ __forceinline__ bf16x8 operator()(int ks) const { return q[ks]; } };
struct QLds { const LAS unsigned char* p; __device__ __forceinline__ bf16x8 operator()(int ks) const { return *(const LAS bf16x8*)(p + ks * 1024); } };
template <int NDB, class QF, class MaskF>
__device__ __forceinline__ void flash_tile(float& m_run, float& l_run, f32x16 (&o)[NDB], const LAS unsigned char* kimg, const LAS unsigned char* vimg, const QF& qf, const MaskF& maskf, int r32, int hi, int vboff) {
    __builtin_amdgcn_sched_barrier(0);
    f32x16 p0 = splat16(0.f), p1 = splat16(0.f);
#pragma unroll
    for (int ks = 0; ks < 4; ++ks) {
        const bf16x8 a0 = *(const LAS bf16x8*)(kimg + (2 * ks + hi) * 1024 + r32 * 16);
        const bf16x8 a1 = *(const LAS bf16x8*)(kimg + (2 * ks + hi) * 1024 + 512 + r32 * 16);
        const bf16x8 qk = qf(ks);
        p0 = mfma32(a0, qk, p0); p1 = mfma32(a1, qk, p1);
        if (ks & 1) __builtin_amdgcn_sched_barrier(0);
    }
    maskf(p0, p1);
    float mx = fmaxf(p0[0], p1[0]);
#pragma unroll
    for (int r = 1; r < 16; ++r) mx = fmaxf(mx, fmaxf(p0[r], p1[r]));
    mx = fmaxf(mx, __shfl_xor(mx, 32));
    const float mnew = fmaxf(m_run, mx);
    const float alpha = fast_exp2(m_run - mnew);
    m_run = mnew;
    float sum = 0.f;
#pragma unroll
    for (int r = 0; r < 16; ++r) { p0[r] = fast_exp2(p0[r] - mnew); p1[r] = fast_exp2(p1[r] - mnew); sum += p0[r] + p1[r]; }
    l_run = l_run * alpha + sum;
#pragma unroll
    for (int db = 0; db < NDB; ++db) o[db] = o[db] * alpha;
    bf16x8 pa[4];
    pa[0] = __builtin_bit_cast(bf16x8, (u32x4){cvt_pk_bf16(p0[0], p0[1]), cvt_pk_bf16(p0[2], p0[3]), cvt_pk_bf16(p0[4], p0[5]), cvt_pk_bf16(p0[6], p0[7])});
    pa[1] = __builtin_bit_cast(bf16x8, (u32x4){cvt_pk_bf16(p0[8], p0[9]), cvt_pk_bf16(p0[10], p0[11]), cvt_pk_bf16(p0[12], p0[13]), cvt_pk_bf16(p0[14], p0[15])});
    pa[2] = __builtin_bit_cast(bf16x8, (u32x4){cvt_pk_bf16(p1[0], p1[1]), cvt_pk_bf16(p1[2], p1[3]), cvt_pk_bf16(p1[4], p1[5]), cvt_pk_bf16(p1[6], p1[7])});
    pa[3] = __builtin_bit_cast(bf16x8, (u32x4){cvt_pk_bf16(p1[8], p1[9]), cvt_pk_bf16(p1[10], p1[11]), cvt_pk_bf16(p1[12], p1[13]), cvt_pk_bf16(p1[14], p1[15])});
#pragma unroll
    for (int db = 0; db < NDB; ++db)
#pragma unroll
        for (int s = 0; s < 4; ++s) {
            const s16x4 lo = vtr(vimg + vboff + db * 4096 + s * 1024), h4 = vtr(vimg + vboff + db * 4096 + s * 1024 + 512);
            const bf16x8 vt = (bf16x8){lo[0], lo[1], lo[2], lo[3], h4[0], h4[1], h4[2], h4[3]};
            o[db] = mfma32(vt, pa[s], o[db]);
            if (s & 1) __builtin_amdgcn_sched_barrier(0);
        }    __builtin_amdgcn_sched_barrier(0);
}
struct MaskNone { __device__ __forceinline__ void operator()(f32x16&, f32x16&) const {} };
struct MaskCausal { int kb0, qloc, hi;
    __device__ __forceinline__ void operator()(f32x16& p0, f32x16& p1) const {
#pragma unroll
        for (int r = 0; r < 16; ++r) { const int kv = kb0 + crow(r, hi); p0[r] = kv > qloc ? NEG_INF : p0[r]; p1[r] = kv + 32 > qloc ? NEG_INF : p1[r]; } } };
struct MaskCausalIf { bool on; int kb0, qloc, hi;
    __device__ __forceinline__ void operator()(f32x16& p0, f32x16& p1) const { if (on) {
#pragma unroll
        for (int r = 0; r < 16; ++r) { const int kv = kb0 + crow(r, hi); p0[r] = kv > qloc ? NEG_INF : p0[r]; p1[r] = kv + 32 > qloc ? NEG_INF : p1[r]; } } } };
struct MaskLane { float ci;
    __device__ __forceinline__ void operator()(f32x16& p0, f32x16& p1) const {
#pragma unroll
        for (int r = 0; r < 16; ++r) { p0[r] += ci; p1[r] += ci; } } };
struct MaskBits { unsigned w0, w1; int hi;
    __device__ __forceinline__ void operator()(f32x16& p0, f32x16& p1) const {
#pragma unroll
        for (int r = 0; r < 16; ++r) { p0[r] = ((w0 >> crow(r, hi)) & 1u) ? p0[r] : NEG_INF; p1[r] = ((w1 >> crow(r, hi)) & 1u) ? p1[r] : NEG_INF; } } };
__device__ __forceinline__ void dma16(const void* g, LAS unsigned char* l) { __builtin_amdgcn_global_load_lds((const unsigned*)g, (LAS unsigned*)l, 16, 0, 0); }
#define DMA_WAIT_SYNC() do { asm volatile("s_waitcnt vmcnt(0)" ::: "memory"); __syncthreads(); } while (0)

template <int MODE>
__device__ __forceinline__ void attn_ab_unit(int b, int h, int qt, const bf16_t* qkv, bf16_t* obuf, const float* kmean, const unsigned* maskg, LAS unsigned char* lds, int tid, int lane, int w) {
    constexpr int CQ = MODE == 0 ? C_QA : C_QB, CK = MODE == 0 ? C_KA : C_KB, CV = MODE == 0 ? C_VA : C_VB;
    const int r32 = lane & 31, hi = lane >> 5;
    const size_t rowbase = (size_t)b * SEQ; const int q0 = 256 * qt, qloc = 32 * w + r32; const size_t qrow = rowbase + q0 + qloc;
    LAS float* kml = (LAS float*)(lds + 32768);
    bf16x8 qf[4];
#pragma unroll
    for (int ks = 0; ks < 4; ++ks) qf[ks] = *(const bf16x8*)(qkv + qrow * QP + CQ + 64 * h + 16 * ks + 8 * hi);
    const bf16_t* ksrc = qkv + (rowbase + lane) * QP + CK + 64 * h + 8 * w;
    const bf16_t* vsrc = qkv + (rowbase + 16 * (w & 3) + (lane >> 2)) * QP + CV + 64 * h + 32 * (w >> 2) + 8 * (lane & 3);
    __syncthreads();
    dma16(ksrc, lds + w * 1024); dma16(vsrc, lds + 8192 + w * 1024);
    unsigned selbits = 0;
    if (MODE == 0) {
        if (tid < 256) ((LAS f32x4*)kml)[tid] = ((const f32x4*)(kmean + (size_t)((b * 4 + h) * 16) * 64))[tid];
        __syncthreads();
        if (qt > 0) {
            float qv[32];
#pragma unroll
            for (int ks = 0; ks < 4; ++ks) { const u32x4 qq = __builtin_bit_cast(u32x4, qf[ks]);
#pragma unroll
                for (int k = 0; k < 4; ++k) { qv[8 * ks + 2 * k] = bf_lo(qq[k]); qv[8 * ks + 2 * k + 1] = bf_hi(qq[k]); } }
            float v1 = NEG_INF, v2 = NEG_INF, v3 = NEG_INF; int i1 = -1, i2 = -1, i3 = -1;
#pragma unroll 1
            for (int j = 0; j < qt; ++j) {
                float g = 0.f;
#pragma unroll
                for (int ks = 0; ks < 4; ++ks) { const f32x4 k0 = *(const LAS f32x4*)(kml + j * 64 + 16 * ks + 8 * hi), k1 = *(const LAS f32x4*)(kml + j * 64 + 16 * ks + 8 * hi + 4);
                    g += qv[8 * ks + 0] * k0[0] + qv[8 * ks + 1] * k0[1] + qv[8 * ks + 2] * k0[2] + qv[8 * ks + 3] * k0[3] + qv[8 * ks + 4] * k1[0] + qv[8 * ks + 5] * k1[1] + qv[8 * ks + 6] * k1[2] + qv[8 * ks + 7] * k1[3]; }
                g += __shfl_xor(g, 32);
                if (g > v1) { v3 = v2; i3 = i2; v2 = v1; i2 = i1; v1 = g; i1 = j; }
                else if (g > v2) { v3 = v2; i3 = i2; v2 = g; i2 = j; }
                else if (g > v3) { v3 = g; i3 = j; }
            }
            if (i1 >= 0) selbits |= 1u << i1; if (i2 >= 0) selbits |= 1u << i2; if (i3 >= 0) selbits |= 1u << i3;
        }
    }
    const int vboff = (4 * hi + ((lane & 15) >> 2)) * 64 + ((lane >> 4) & 1) * 32 + (lane & 3) * 8;
    const int NT = 4 * qt + 4, wlim = 4 * qt + (w >> 1);
    const unsigned* mrow = maskg + qrow * 128;
    float m_run = -1e30f, l_run = 0.f; f32x16 o[2]; o[0] = splat16(0.f); o[1] = splat16(0.f);
    unsigned mw0 = 0, mw1 = 0; if (MODE == 1) { mw0 = mrow[0]; mw1 = mrow[1]; }
    DMA_WAIT_SYNC();
#pragma unroll 1
    for (int kt = 0; kt < NT; ++kt) {
        LAS unsigned char* cur = lds + (kt & 1) * 16384; LAS unsigned char* nxt = lds + ((kt + 1) & 1) * 16384;
        const unsigned cw0 = mw0, cw1 = mw1;
        if (kt + 1 < NT) { dma16(ksrc + (size_t)(kt + 1) * 64 * QP, nxt + w * 1024); dma16(vsrc + (size_t)(kt + 1) * 64 * QP, nxt + 8192 + w * 1024);
            if (MODE == 1) { mw0 = mrow[2 * kt + 2]; mw1 = mrow[2 * kt + 3]; } }
        if (MODE == 0) {
            const int j = kt >> 2;
            if (j < qt) { const bool sel = (selbits >> j) & 1u; if (__ballot(sel) != 0ull) flash_tile<2>(m_run, l_run, o, cur, cur + 8192, QReg{qf}, MaskLane{sel ? 0.f : NEG_INF}, r32, hi, vboff); }
            else { const int kb0 = 64 * (kt & 3); if (kb0 <= 32 * w + 31) flash_tile<2>(m_run, l_run, o, cur, cur + 8192, QReg{qf}, MaskCausal{kb0, qloc, hi}, r32, hi, vboff); }
        } else {
            if (kt <= wlim) flash_tile<2>(m_run, l_run, o, cur, cur + 8192, QReg{qf}, MaskBits{cw0, cw1, hi}, r32, hi, vboff);
        }
        DMA_WAIT_SYNC();
    }
    const float inv = 1.0f / (l_run + __shfl_xor(l_run, 32));
    bf16_t* orow = obuf + qrow * 256 + 64 * h;
#pragma unroll
    for (int db = 0; db < 2; ++db)
#pragma unroll
        for (int g = 0; g < 4; ++g)
            *(u32x2*)(orow + 32 * db + 8 * g + 4 * hi) = (u32x2){cvt_pk_bf16(o[db][4 * g] * inv, o[db][4 * g + 1] * inv), cvt_pk_bf16(o[db][4 * g + 2] * inv, o[db][4 * g + 3] * inv)};
}

__device__ __forceinline__ void attn_c_unit(int b, int h, int qt, const bf16_t* qkv, bf16_t* oc, float lam, const float* subg, float coef, LAS unsigned char* lds, int tid, int lane, int w) {
    const int r32 = lane & 31, hi = lane >> 5;
    const size_t rowbase = (size_t)b * SEQ; const int q0 = 256 * qt, qloc = 32 * w + r32; const size_t qrow = rowbase + q0 + qloc;
    LAS unsigned char* qimg = lds + 65536 + w * 8192 + lane * 16;
    __syncthreads();
#pragma unroll
    for (int ks = 0; ks < 4; ++ks) { *(LAS bf16x8*)(qimg + ks * 1024) = *(const bf16x8*)(qkv + qrow * QP + C_Q1 + 64 * h + 16 * ks + 8 * hi); *(LAS bf16x8*)(qimg + 4096 + ks * 1024) = *(const bf16x8*)(qkv + qrow * QP + C_Q2 + 64 * h + 16 * ks + 8 * hi); }
    const bf16_t* k1src = qkv + (rowbase + lane) * QP + C_K1 + 64 * h + 8 * w;
    const bf16_t* k2src = k1src + (C_K2 - C_K1);
    const bf16_t* v0src = qkv + (rowbase + 16 * (w & 3) + (lane >> 2)) * QP + C_VC + 128 * h + 32 * (w >> 2) + 8 * (lane & 3);
    const bf16_t* v1src = v0src + 64;
    const int vboff = (4 * hi + ((lane & 15) >> 2)) * 64 + ((lane >> 4) & 1) * 32 + (lane & 3) * 8;
    const int NT = 4 * qt + 4;
    float m1 = -1e30f, l1 = 0.f, m2 = -1e30f, l2 = 0.f; f32x16 o1[4], o2[4];
#pragma unroll
    for (int i = 0; i < 4; ++i) { o1[i] = splat16(0.f); o2[i] = splat16(0.f); }
    dma16(k1src, lds + w * 1024); dma16(k2src, lds + 8192 + w * 1024); dma16(v0src, lds + 16384 + w * 1024); dma16(v1src, lds + 16384 + 8192 + w * 1024);
    DMA_WAIT_SYNC();
#pragma unroll 1
    for (int kt = 0; kt < NT; ++kt) {
        LAS unsigned char* cur = lds + (kt & 1) * 32768; LAS unsigned char* nxt = lds + ((kt + 1) & 1) * 32768;
        if (kt + 1 < NT) { const size_t adv = (size_t)(kt + 1) * 64 * QP;
            dma16(k1src + adv, nxt + w * 1024); dma16(k2src + adv, nxt + 8192 + w * 1024); dma16(v0src + adv, nxt + 16384 + w * 1024); dma16(v1src + adv, nxt + 16384 + 8192 + w * 1024); }
        const bool band = kt >= 4 * qt; const int kb0 = 64 * (kt & 3);
        if (!band || kb0 <= 32 * w + 31) { const MaskCausalIf mk{band, kb0, qloc, hi};
            flash_tile<4>(m1, l1, o1, cur, cur + 16384, QLds{qimg}, mk, r32, hi, vboff); flash_tile<4>(m2, l2, o2, cur + 8192, cur + 16384, QLds{qimg + 4096}, mk, r32, hi, vboff); }
        DMA_WAIT_SYNC();
    }
    const float i1 = 1.0f / (l1 + __shfl_xor(l1, 32)), i2 = lam / (l2 + __shfl_xor(l2, 32));
    float ss = 0.f;
#pragma unroll
    for (int db = 0; db < 4; ++db) { o1[db] = o1[db] * i1 - o2[db] * i2;
#pragma unroll
        for (int r = 0; r < 16; ++r) ss += o1[db][r] * o1[db][r]; }
    ss += __shfl_xor(ss, 32);
    const float rn = coef / sqrtf(ss * (1.0f / 128.0f) + EPS);
    bf16_t* orow = oc + qrow * 512 + 128 * h;
#pragma unroll
    for (int db = 0; db < 4; ++db)
#pragma unroll
        for (int g = 0; g < 4; ++g) { const int d = 32 * db + 8 * g + 4 * hi; const f32x4 gg = *(const f32x4*)(subg + d);
            *(u32x2*)(orow + d) = (u32x2){cvt_pk_bf16(o1[db][4 * g] * rn * gg[0], o1[db][4 * g + 1] * rn * gg[1]), cvt_pk_bf16(o1[db][4 * g + 2] * rn * gg[2], o1[db][4 * g + 3] * rn * gg[3])}; }
}

__device__ __forceinline__ void index_unit(int b, int i64, const bf16_t* qkv, unsigned* maskg, LAS unsigned char* lds, int tid, int lane, int w) {
    const int r32 = lane & 31, hi = lane >> 5;
    LAS unsigned* hist = (LAS unsigned*)lds; LAS unsigned char* kbuf = lds + 65536; LAS unsigned* mb = (LAS unsigned*)(lds + 81920);
    LAS int* thrB1 = (LAS int*)(lds + 114688); LAS int* thrRem = thrB1 + 64; LAS int* thrT = thrB1 + 128; LAS int* thrNeed = thrB1 + 192;
    const size_t rowbase = (size_t)b * SEQ; const int q0 = 64 * i64, NT = i64 + 1;
    const int hh = 4 * ((r32 >> 3) & 1) + (r32 & 3), qp = 2 * (r32 >> 4) + ((r32 >> 2) & 1);
    bf16x8 aq[2][4]; float wv[2][2][8];
#pragma unroll
    for (int rb = 0; rb < 2; ++rb) {
        const size_t row = rowbase + q0 + 8 * w + 4 * rb + qp;
#pragma unroll
        for (int ks = 0; ks < 4; ++ks) aq[rb][ks] = *(const bf16x8*)(qkv + row * QP + C_QI + 64 * hh + 16 * ks + 8 * hi);
#pragma unroll
        for (int hf = 0; hf < 2; ++hf) { const u32x4 ww = *(const u32x4*)(qkv + (rowbase + q0 + 8 * w + 4 * rb + 2 * hf + hi) * QP + C_WI);
#pragma unroll
            for (int k = 0; k < 4; ++k) { wv[rb][hf][2 * k] = bf_lo(ww[k]); wv[rb][hf][2 * k + 1] = bf_hi(ww[k]); } }
    }
    const bf16_t* ksrc = qkv + (rowbase + lane) * QP + C_KI + 8 * w;
    __syncthreads();
#pragma unroll 1
    for (int pass = 0; pass < 3; ++pass) {
        dma16(ksrc, kbuf + w * 1024);
        if (pass < 2) { for (int i = tid; i < 4096; i += 512) ((LAS u32x4*)hist)[i] = (u32x4){0u, 0u, 0u, 0u}; }
        int thr[2][2], need[2][2], tc[2][2];
#pragma unroll
        for (int rb = 0; rb < 2; ++rb)
#pragma unroll
            for (int hf = 0; hf < 2; ++hf) { const int q = 8 * w + 4 * rb + 2 * hf + hi; thr[rb][hf] = pass == 1 ? thrB1[q] : (pass == 2 ? thrT[q] : 0); need[rb][hf] = pass == 2 ? thrNeed[q] : 0; tc[rb][hf] = 0; }
        DMA_WAIT_SYNC();
#pragma unroll 1
        for (int kt = 0; kt < NT; ++kt) {
            const LAS unsigned char* kimg = kbuf + (kt & 1) * 8192;
            if (kt + 1 < NT) dma16(ksrc + (size_t)(kt + 1) * 64 * QP, kbuf + ((kt + 1) & 1) * 8192 + w * 1024);
#pragma unroll
            for (int rb = 0; rb < 2; ++rb)
#pragma unroll
                for (int kb = 0; kb < 2; ++kb) {
                    f32x16 d = splat16(0.f);
#pragma unroll
                    for (int ks = 0; ks < 4; ++ks) d = mfma32(aq[rb][ks], *(const LAS bf16x8*)(kimg + (2 * ks + hi) * 1024 + (32 * kb + r32) * 16), d);
                    const int kpos = 64 * kt + 32 * kb + r32;
#pragma unroll
                    for (int hf = 0; hf < 2; ++hf) {
                        float sc = 0.f;
#pragma unroll
                        for (int t = 0; t < 8; ++t) sc += wv[rb][hf][t] * fmaxf(d[8 * hf + t], 0.f);
                        const int ql = 8 * w + 4 * rb + 2 * hf + hi;
                        const unsigned short u = __builtin_bit_cast(unsigned short, (_Float16)sc);
                        unsigned key = (u & 0x8000u) ? ((~(unsigned)u) & 0xffffu) : ((unsigned)u | 0x8000u);
                        if (kpos > q0 + ql) key = 0u;
                        if (pass == 0) { if (key) __hip_atomic_fetch_add(&hist[ql * 256 + (key >> 8)], 1u, __ATOMIC_RELAXED, __HIP_MEMORY_SCOPE_WORKGROUP); }
                        else if (pass == 1) { if (key && (int)(key >> 8) == thr[rb][hf]) __hip_atomic_fetch_add(&hist[ql * 256 + (key & 255u)], 1u, __ATOMIC_RELAXED, __HIP_MEMORY_SCOPE_WORKGROUP); }
                        else {
                            bool sel = (int)key > thr[rb][hf];
                            const bool eq = (int)key == thr[rb][hf];
                            const unsigned long long bal = __ballot(eq);
                            if (bal != 0ull) { const unsigned mh = hi ? (unsigned)(bal >> 32) : (unsigned)bal;
                                const int rank = __popc(mh & ((1u << r32) - 1u));
                                sel = sel || (eq && (tc[rb][hf] + rank < need[rb][hf])); tc[rb][hf] += __popc(mh); }
                            const unsigned long long bs = __ballot(sel);
                            if (r32 == 0) mb[ql * 128 + 2 * kt + kb] = hi ? (unsigned)(bs >> 32) : (unsigned)bs;
                        }
                    }
                }
            DMA_WAIT_SYNC();
        }
        if (pass < 2) {
#pragma unroll 1
            for (int qq = 0; qq < 8; ++qq) { const int q = 8 * w + qq;
                int target;
                if (pass == 0) { if (q0 + q + 1 <= 256) { if (lane == 0) { thrB1[q] = 0x10000; thrRem[q] = 0; } continue; } target = 256; }
                else { if (thrB1[q] == 0x10000) { if (lane == 0) { thrT[q] = 0; thrNeed[q] = 0; } continue; } target = thrRem[q]; }
                const u32x4 h4 = *(const LAS u32x4*)(hist + q * 256 + 4 * lane);
                const int s = (int)(h4[0] + h4[1] + h4[2] + h4[3]);
                int P = s;
#pragma unroll
                for (int o = 1; o < 64; o <<= 1) { const int t = __shfl_up(P, o); if (lane >= o) P += t; }
                const int above = __shfl(P, 63) - P;
                const int c3 = above + (int)h4[3], c2 = c3 + (int)h4[2], c1 = c2 + (int)h4[1], c0 = c1 + (int)h4[0];
                int bin = -1, ab = 0;
                if (above < target && c3 >= target) { bin = 4 * lane + 3; ab = above; }
                else if (c3 < target && c2 >= target) { bin = 4 * lane + 2; ab = c3; }
                else if (c2 < target && c1 >= target) { bin = 4 * lane + 1; ab = c2; }
                else if (c1 < target && c0 >= target) { bin = 4 * lane; ab = c1; }
                if (bin >= 0) { if (pass == 0) { thrB1[q] = bin; thrRem[q] = target - ab; } else { thrT[q] = (thrB1[q] << 8) | bin; thrNeed[q] = target - ab; } }
            }
            __syncthreads();
        }
    }
    for (int idx = tid; idx < 64 * 2 * NT; idx += 512) { const int q = idx / (2 * NT), wd = idx - q * 2 * NT; maskg[(rowbase + q0 + q) * 128 + wd] = mb[q * 128 + wd]; }
}

__device__ __forceinline__ int next_unit(unsigned* ctr, LAS unsigned char* lds, int tid) {
    volatile LAS int* bc = (volatile LAS int*)(lds + LX_BC);
    __syncthreads();
    if (tid == 0) *bc = (int)__hip_atomic_fetch_add(ctr, 1u, __ATOMIC_RELAXED, __HIP_MEMORY_SCOPE_AGENT);
    __syncthreads();
    return *bc;
}

__device__ __forceinline__ void m1_phase(const Args& a, unsigned char* ws, int l, int lane, int wave, int vcu, int G) {
    const int gw = vcu * 8 + wave, NGW = G * 8;
    const float* gain = a.in[I_NORM_FFN] + (size_t)l * DM; const float* wrt = (const float*)(ws + WS_WRT);
    const float* bg = a.in[I_B_GROUP] + l * 4; const float* br = a.in[I_B_ROUTER] + l * 32;
    unsigned* cnt = (unsigned*)(ws + WS_CTL) + CW_CNT + 2048 * l;
    unsigned* rt0 = (unsigned*)(ws + WS_RT0); unsigned* rt1 = (unsigned*)(ws + WS_RT1); f32x2* rtw = (f32x2*)(ws + WS_RTW);
    const float bias = lane < 4 ? bg[lane] : (lane < 36 ? br[lane - 4] : 0.f);
#pragma unroll 1
    for (int m0 = gw * 2; m0 < MTOK; m0 += NGW * 2) {
        f32x4 v[2][4];
#pragma unroll
        for (int r = 0; r < 2; ++r) { float ss = 0.f;
#pragma unroll
            for (int j = 0; j < 4; ++j) { v[r][j] = ((const f32x4*)(a.out + (size_t)(m0 + r) * DM))[lane + 64 * j]; ss += (v[r][j][0] * v[r][j][0] + v[r][j][1] * v[r][j][1]) + (v[r][j][2] * v[r][j][2] + v[r][j][3] * v[r][j][3]); }
            const float rstd = 1.0f / sqrtf(wave_sum(ss) * (1.0f / DM) + EPS);
#pragma unroll
            for (int j = 0; j < 4; ++j) v[r][j] = v[r][j] * rstd * ((const f32x4*)gain)[lane + 64 * j]; }
        float lg0 = 0.f, lg1 = 0.f;
#pragma unroll 2
        for (int c = 0; c < 36; ++c) { float s0 = 0.f, s1 = 0.f;
#pragma unroll
            for (int j = 0; j < 4; ++j) { const f32x4 wq = ((const f32x4*)(wrt + c * DM))[lane + 64 * j];
                s0 += (v[0][j][0] * wq[0] + v[0][j][1] * wq[1]) + (v[0][j][2] * wq[2] + v[0][j][3] * wq[3]); s1 += (v[1][j][0] * wq[0] + v[1][j][1] * wq[1]) + (v[1][j][2] * wq[2] + v[1][j][3] * wq[3]); }
            s0 = wave_sum(s0); s1 = wave_sum(s1);
            if (lane == c) { lg0 = s0; lg1 = s1; } }
        lg0 += bias; lg1 += bias;
#pragma unroll
        for (int r = 0; r < 2; ++r) {
            const float lg = r == 0 ? lg0 : lg1;
            float gl[4];
#pragma unroll
            for (int c = 0; c < 4; ++c) gl[c] = __shfl(lg, c);
            int g = 0; float gm = gl[0];
#pragma unroll
            for (int c = 1; c < 4; ++c) if (gl[c] > gm) { gm = gl[c]; g = c; }
            float den = 0.f;
#pragma unroll
            for (int c = 0; c < 4; ++c) den += __expf(gl[c] - gm);
            const float gwt = 1.0f / den;
            float le[8];
#pragma unroll
            for (int e = 0; e < 8; ++e) le[e] = __shfl(lg, 4 + 8 * g + e);
            int i1 = 0; float v1 = le[0];
#pragma unroll
            for (int e = 1; e < 8; ++e) if (le[e] > v1) { v1 = le[e]; i1 = e; }
            int i2 = -1; float v2 = NEG_INF;
#pragma unroll
            for (int e = 0; e < 8; ++e) if (e != i1 && le[e] > v2) { v2 = le[e]; i2 = e; }
            const float ex = __expf(v2 - v1), w1 = 1.0f / (1.0f + ex), w2 = ex * w1;
            if (lane == 0) { const int e0 = g * 8 + i1, e1 = g * 8 + i2;
                const unsigned r0 = atomicAdd(cnt + 64 * e0, 1u), r1 = atomicAdd(cnt + 64 * e1, 1u);
                rt0[m0 + r] = ((unsigned)e0 << 24) | r0; rt1[m0 + r] = ((unsigned)e1 << 24) | r1; rtw[m0 + r] = (f32x2){gwt * w1, gwt * w2}; }
        }
    }
}
__device__ __forceinline__ void build_tables(const unsigned* cnt, LAS unsigned char* lds, int tid) {
    LAS int* pstart = (LAS int*)(lds + LX_PSTART); LAS int* blk2e = (LAS int*)(lds + LX_BLK2E);
    if (tid < 64) {
        const int c = tid < NEXP ? (int)cnt[64 * tid] : 0, nb = (c + 255) >> 8;
        int P = nb;
#pragma unroll
        for (int o = 1; o < 64; o <<= 1) { const int t = __shfl_up(P, o); if (tid >= o) P += t; }
        const int pb = P - nb;
        if (tid <= NEXP) pstart[tid] = pb * 256;
        if (tid == NEXP) *(LAS int*)(lds + LX_NBLK) = pb < MAXBLK ? pb : MAXBLK;
#pragma unroll 1
        for (int k = 0; k < nb; ++k) if (pb + k < MAXBLK) blk2e[pb + k] = tid;
    }
    __syncthreads();
}
__device__ __forceinline__ void m2_phase(const Args& a, unsigned char* ws, int l, LAS unsigned char* lds, int lane, int wave, int vcu, int G) {
    const int gw = vcu * 8 + wave, NGW = G * 8;
    const float* gain = a.in[I_NORM_FFN] + (size_t)l * DM; const LAS int* pstart = (const LAS int*)(lds + LX_PSTART);
    const unsigned* rt0 = (const unsigned*)(ws + WS_RT0); const unsigned* rt1 = (const unsigned*)(ws + WS_RT1); bf16_t* xb = (bf16_t*)(ws + WS_XB);
    for (int m = gw; m < MTOK; m += NGW) {
        f32x4 v[4]; float ss = 0.f;
#pragma unroll
        for (int j = 0; j < 4; ++j) { v[j] = ((const f32x4*)(a.out + (size_t)m * DM))[lane + 64 * j]; ss += (v[j][0] * v[j][0] + v[j][1] * v[j][1]) + (v[j][2] * v[j][2] + v[j][3] * v[j][3]); }
        const float rstd = 1.0f / sqrtf(wave_sum(ss) * (1.0f / DM) + EPS);
        const unsigned ua = rt0[m], ub = rt1[m];
        const size_t s0 = (size_t)(pstart[ua >> 24] + (int)(ua & 0xffffffu)), s1 = (size_t)(pstart[ub >> 24] + (int)(ub & 0xffffffu));
#pragma unroll
        for (int j = 0; j < 4; ++j) { const f32x4 o = v[j] * rstd * ((const f32x4*)gain)[lane + 64 * j]; const u32x2 pk = (u32x2){cvt_pk_bf16(o[0], o[1]), cvt_pk_bf16(o[2], o[3])};
            ((u32x2*)(xb + s0 * DM))[lane + 64 * j] = pk; ((u32x2*)(xb + s1 * DM))[lane + 64 * j] = pk; }
    }
}

#ifndef PHASES
#define PHASES 0xFFFF
#endif
#define PH(n) if constexpr (((PHASES) >> (n)) & 1)
#ifndef GEMM_ALIGN
#define GEMM_ALIGN true
#endif
#ifndef GEMM_SP2
#define GEMM_SP2 true
#endif
__global__ void __launch_bounds__(512, 2) fwd_kernel(Args args) {
    extern __shared__ __attribute__((aligned(16))) unsigned char lds_raw[];
    LAS unsigned char* lds = (LAS unsigned char*)lds_raw;
    for (int u = threadIdx.x; u < (LDS_BYTES - LDSX) / 4; u += 512) ((LAS unsigned*)(lds + LDSX))[u] = 0u;
    __syncthreads();
    const XcdBarrier bar0 = xcd_barrier_post((unsigned*)(args.ws + WS_CTL) + CW_BAR, (volatile LAS unsigned*)(lds + LX_BAR));
#define PHASE_ENV() unsigned long long wsi_ = (unsigned long long)args.ws; int G = (int)gridDim.x, bx = (int)blockIdx.x; asm volatile("" : "+s"(wsi_), "+s"(G), "+s"(bx)); \
    unsigned char* const ws = (unsigned char*)(GAS unsigned char*)wsi_; const int vcu = (G % 8 == 0) ? (bx % 8) * (G / 8) + bx / 8 : bx;   \
    int tid = (int)threadIdx.x; asm volatile("" : "+v"(tid)); const int lane = tid & 63, wave = __builtin_amdgcn_readfirstlane(tid >> 6); \
    unsigned* const ctl = (unsigned*)(ws + WS_CTL); bf16_t* const QKV = (bf16_t*)(ws + WS_QKV); unsigned char* const SG = ws + WS_SG; unsigned* const MASK = (unsigned*)(ws + WS_MASK); float* const KMEAN = (float*)(ws + WS_KMEAN); \
    (void)lane; (void)wave; (void)ctl; (void)QKV; (void)SG; (void)MASK; (void)KMEAN; (void)vcu
#define GRID_BAR() do { unsigned long long wb_ = (unsigned long long)args.ws; asm volatile("" : "+s"(wb_)); XcdBarrier b_ = bar0; b_.bar = (unsigned*)((GAS unsigned char*)wb_ + WS_CTL) + CW_BAR; asm volatile("" : "+s"(b_.x)); xcd_barrier(b_); } while (0)

#pragma unroll 1
    for (int l = 0; l < NLAYER; ++l) {
        PH(0) { PHASE_ENV(); p0_phase(args, ws, l, lds, tid, lane, wave, vcu, G); }
        GRID_BAR();
        PH(1) { PHASE_ENV();
            pg8::Gemm g{(const bf16_t*)(ws + WS_HN), (const bf16_t*)(ws + WS_WIN), MTOK, NT_IN * 256, DM}; pg8::StaticOrder S; S.init(MTOK, NT_IN * 256, G, bx);
            pg8::EpiInProj E{QKV, SG, (const float*)(ws + WS_COS), (const float*)(ws + WS_SIN), args.in[I_QK_GAIN] + l * 6 * 64, args.in[I_IDX_K_GAIN] + l * 64};
            pg8::gemm_phase<pg8::EpiInProj, pg8::StaticOrder, GEMM_ALIGN, GEMM_SP2>(lds, g, S, E);
        }
        GRID_BAR();
        { PHASE_ENV();
            LAS float* red = (LAS float*)lds;
            for (int it = bx; it < NBATCH * 4 * 16; it += G) { const int b = it >> 6, h = (it >> 4) & 3, blk = it & 15, d = tid & 63, rg = tid >> 6;
                const bf16_t* kp = QKV + ((size_t)b * SEQ + blk * 256 + rg * 32) * QP + C_KA + 64 * h + d; float s = 0.f;
#pragma unroll 8
                for (int r = 0; r < 32; ++r) s += __builtin_bit_cast(float, (unsigned)kp[(size_t)r * QP] << 16);
                __syncthreads(); red[tid] = s; __syncthreads();
                if (tid < 64) { float t = 0.f;
#pragma unroll
                    for (int k = 0; k < 8; ++k) t += red[k * 64 + tid];
                    KMEAN[(size_t)it * 64 + tid] = t * (1.0f / 256.0f); } }
            __syncthreads();
        }
        PH(2) { PHASE_ENV();
            const float* dl = args.in[I_DIFF_LAMBDA] + l * 256;
            const float lam_init = 0.8f - 0.6f * __expf(-0.3f * (float)l);
            const float lam = __expf(wave_sum(dl[lane] * dl[64 + lane])) - __expf(wave_sum(dl[128 + lane] * dl[192 + lane])) + lam_init;
            const float* subg = args.in[I_DIFF_SUBLN] + l * 128;
            unsigned* qc = ctl + CW_QUEUE + 64 * (l * 4 + 0);
            for (;;) { const int u = next_unit(qc, lds, tid); if (u >= 512) break; const int r = u & 31; attn_c_unit(r >> 2, r & 3, 15 - (u >> 5), QKV, (bf16_t*)(ws + WS_OC), lam, subg, 1.0f - lam_init, lds, tid, lane, wave); }
        }
        PH(3) { PHASE_ENV();
            unsigned* qi = ctl + CW_QUEUE + 64 * (l * 4 + 1);
            for (;;) { const int u = next_unit(qi, lds, tid); if (u >= 512) break; index_unit(u & 7, 63 - (u >> 3), QKV, MASK, lds, tid, lane, wave); }
        }
        GRID_BAR();
        PH(4) { PHASE_ENV();
            unsigned* qa = ctl + CW_QUEUE + 64 * (l * 4 + 2);
            for (;;) { const int u = next_unit(qa, lds, tid); if (u >= 512) break; const int r = u & 31; attn_ab_unit<0>(r >> 2, r & 3, 15 - (u >> 5), QKV, (bf16_t*)(ws + WS_OA), KMEAN, MASK, lds, tid, lane, wave); }
        }
        PH(5) { PHASE_ENV();
            unsigned* qb = ctl + CW_QUEUE + 64 * (l * 4 + 3);
            for (;;) { const int u = next_unit(qb, lds, tid); if (u >= 512) break; const int r = u & 31; attn_ab_unit<1>(r >> 2, r & 3, 15 - (u >> 5), QKV, (bf16_t*)(ws + WS_OB), KMEAN, MASK, lds, tid, lane, wave); }
        }
        GRID_BAR();
        PH(6) {
            { PHASE_ENV(); pg8::StaticOrder S; S.init(MTOK, DM, G, bx); pg8::Gemm g{(const bf16_t*)(ws + WS_OA), (const bf16_t*)(ws + WS_WPA), MTOK, DM, 256}; pg8::EpiMerge<0> E{(bf16_t*)(ws + WS_MERGED), SG}; pg8::gemm_phase<pg8::EpiMerge<0>, pg8::StaticOrder, GEMM_ALIGN, GEMM_SP2>(lds, g, S, E); }
            { PHASE_ENV(); pg8::StaticOrder S; S.init(MTOK, DM, G, bx); pg8::Gemm g{(const bf16_t*)(ws + WS_OB), (const bf16_t*)(ws + WS_WPB), MTOK, DM, 256}; pg8::EpiMerge<1> E{(bf16_t*)(ws + WS_MERGED), SG}; pg8::gemm_phase<pg8::EpiMerge<1>, pg8::StaticOrder, GEMM_ALIGN, GEMM_SP2>(lds, g, S, E); }
            { PHASE_ENV(); pg8::StaticOrder S; S.init(MTOK, DM, G, bx); pg8::Gemm g{(const bf16_t*)(ws + WS_OC), (const bf16_t*)(ws + WS_WPC), MTOK, DM, 512}; pg8::EpiMerge<2> E{(bf16_t*)(ws + WS_MERGED), SG}; pg8::gemm_phase<pg8::EpiMerge<2>, pg8::StaticOrder, GEMM_ALIGN, GEMM_SP2>(lds, g, S, E); }
        }
        GRID_BAR();
        PH(7) { PHASE_ENV();
            pg8::Gemm g{(const bf16_t*)(ws + WS_MERGED), (const bf16_t*)(ws + WS_WO), MTOK, DM, DM}; pg8::StaticOrder S; S.init(MTOK, DM, G, bx);
            pg8::EpiResid E{l == 0 ? args.in[I_X] : args.out, args.out};
            pg8::gemm_phase<pg8::EpiResid, pg8::StaticOrder, GEMM_ALIGN, GEMM_SP2>(lds, g, S, E);
        }
        GRID_BAR();
        PH(8) { PHASE_ENV(); m1_phase(args, ws, l, lane, wave, vcu, G); }
        GRID_BAR();
        { PHASE_ENV(); build_tables(ctl + CW_CNT + 2048 * l, lds, tid);
          PH(9) m2_phase(args, ws, l, lds, lane, wave, vcu, G); }
        GRID_BAR();
        PH(10) { PHASE_ENV();
            const int nblk = *(const LAS int*)(lds + LX_NBLK);
            pg8::Gemm g{(const bf16_t*)(ws + WS_XB), (const bf16_t*)(ws + WS_WGU), MAXBLK * 256, NEXP * 1024, DM};
            pg8::MoeOrder S{nblk * 4, G, vcu, (const LAS int*)(lds + LX_BLK2E)};
            pg8::EpiGateUp E{(bf16_t*)(ws + WS_HID)};
            pg8::gemm_phase<pg8::EpiGateUp, pg8::MoeOrder, GEMM_ALIGN, GEMM_SP2>(lds, g, S, E);
        }
        GRID_BAR();
        PH(11) { PHASE_ENV();
            const int nblk = *(const LAS int*)(lds + LX_NBLK);
            pg8::Gemm g{(const bf16_t*)(ws + WS_HID), (const bf16_t*)(ws + WS_WD), MAXBLK * 256, NEXP * 1024, DEXP};
            pg8::MoeOrder S{nblk * 4, G, vcu, (const LAS int*)(lds + LX_BLK2E)};
            pg8::EpiDown E{(bf16_t*)(ws + WS_Y)};
            pg8::gemm_phase<pg8::EpiDown, pg8::MoeOrder, GEMM_ALIGN, GEMM_SP2>(lds, g, S, E);
        }
        GRID_BAR();
    }
    { PHASE_ENV();
        const int gw = vcu * 8 + wave, NGW = G * 8; const LAS int* pstart = (const LAS int*)(lds + LX_PSTART);
        for (int m = gw; m < MTOK; m += NGW) token_row<true, false>(args.out, args.out, (const bf16_t*)(ws + WS_Y), (const unsigned*)(ws + WS_RT0), (const unsigned*)(ws + WS_RT1), (const f32x2*)(ws + WS_RTW), pstart, nullptr, nullptr, m, lane);
    }
}

extern "C" void kernel_launch(void* const* d_in, const int* in_sizes, int n_in, void* d_out, int out_size, void* d_ws, size_t ws_size, hipStream_t stream) {
    static int grid = 0;
    if (grid == 0) {
        if (n_in != N_INPUTS || in_sizes[0] != MTOK * DM || out_size != MTOK * DM || ws_size < WS_END) {
            fprintf(stderr, "kernel_launch: built for %d inputs, x/out of %d floats, >= %zu bytes of workspace; got n_in %d, in0 %d, out %d, ws %zu; nothing launched\n", (int)N_INPUTS, MTOK * DM, (size_t)WS_END, n_in, n_in > 0 ? in_sizes[0] : -1, out_size, ws_size);
            grid = -1; return; }
        int dev = 0, cus = 0;
        if (hipGetDevice(&dev) != hipSuccess || hipDeviceGetAttribute(&cus, hipDeviceAttributeMultiprocessorCount, dev) != hipSuccess) { fprintf(stderr, "kernel_launch: device query failed\n"); grid = -1; return; }
        if (hipFuncSetAttribute((const void*)fwd_kernel, hipFuncAttributeMaxDynamicSharedMemorySize, LDS_BYTES) != hipSuccess) { fprintf(stderr, "kernel_launch: hipFuncSetAttribute failed\n"); grid = -1; return; }
        int per_cu = 0;
        if (hipOccupancyMaxActiveBlocksPerMultiprocessor(&per_cu, (const void*)fwd_kernel, 512, LDS_BYTES) != hipSuccess || per_cu < 1) fprintf(stderr, "kernel_launch: note: occupancy query reports %d workgroups per CU\n", per_cu);
        (void)hipGetLastError();
        grid = cus;
    }
    if (grid < 0) return;
    if (hipMemsetAsync((char*)d_ws + WS_CTL, 0, CTL_BYTES, stream) != hipSuccess) { fprintf(stderr, "kernel_launch: memset failed\n"); return; }
    Args a{};
    for (int i = 0; i < N_INPUTS; ++i) a.in[i] = (const float*)d_in[i];
    a.out = (float*)d_out; a.ws = (unsigned char*)d_ws;
    hipLaunchKernelGGL(fwd_kernel, dim3(grid), dim3(512), LDS_BYTES, stream, a);
    const hipError_t le = hipPeekAtLastError();
    if (le != hipSuccess) fprintf(stderr, "kernel_launch: launch failed: %s\n", hipGetErrorName(le));
}
```

```cpp
#include <hip/hip_runtime.h>
#include <cstdio>
#include <cstdint>

#define LAS __attribute__((address_space(3)))
#define GAS __attribute__((address_space(1)))
typedef unsigned short bf16_t;
typedef short bf16x8 __attribute__((ext_vector_type(8)));
typedef short s16x4 __attribute__((ext_vector_type(4)));
typedef float f32x4 __attribute__((ext_vector_type(4)));
typedef float f32x2 __attribute__((ext_vector_type(2)));
typedef float f32x16 __attribute__((ext_vector_type(16)));
typedef unsigned u32x4 __attribute__((ext_vector_type(4)));
typedef unsigned u32x2 __attribute__((ext_vector_type(2)));

constexpr int NBATCH = 8, SEQ = 4096, MTOK = NBATCH * SEQ, DM = 1024, NLAYER = 2;
constexpr int QP = 3656;
constexpr int C_QA = 0, C_KA = 256, C_VA = 512, C_QB = 768, C_KB = 1024, C_VB = 1280, C_QI = 1536, C_KI = 2048, C_WI = 2112,
              C_Q1 = 2120, C_Q2 = 2376, C_K1 = 2632, C_K2 = 2888, C_VC = 3144, C_G = 3656, D_IN = 6728;
constexpr int NT_IN = 27;
constexpr int NEXP = 32, DEXP = 512, MAXBLK = 288;
constexpr float C2 = 0.125f * 1.4426950408889634f;
constexpr float EPS = 1e-6f;

constexpr size_t MiB = 1u << 20;
constexpr size_t WS_CTL = 0, CTL_BYTES = 1 * MiB;
constexpr size_t WS_COS = 1 * MiB, WS_SIN = WS_COS + 512 * 1024;
constexpr size_t WS_SMALL = 2 * MiB;
constexpr size_t WS_KMEAN = WS_SMALL, WS_RT0 = WS_SMALL + 256 * 1024, WS_RT1 = WS_SMALL + 384 * 1024, WS_RTW = WS_SMALL + 512 * 1024, WS_WRT = WS_SMALL + 768 * 1024;
constexpr size_t WS_WIN = 3 * MiB;
constexpr size_t WS_WPA = 17 * MiB, WS_WPB = WS_WPA + 512 * 1024, WS_WPC = 18 * MiB;
constexpr size_t WS_WO = 19 * MiB;
constexpr size_t WS_WGU = 21 * MiB;
constexpr size_t WS_WD = 85 * MiB;
constexpr size_t WS_HN = 117 * MiB;
constexpr size_t WS_OA = WS_HN, WS_OB = WS_HN + 16 * MiB, WS_OC = WS_HN + 32 * MiB;
constexpr size_t WS_QKV = 181 * MiB;
constexpr size_t WS_MERGED = WS_QKV, WS_XB = WS_QKV, WS_Y = WS_QKV, WS_HID = WS_QKV + 144 * MiB;
constexpr size_t WS_SG = 410 * MiB;
constexpr size_t WS_MASK = 506 * MiB;
constexpr size_t WS_END = 522 * MiB;
static_assert((size_t)MTOK * QP * 2 <= 229 * MiB && (size_t)MAXBLK * 256 * 1024 * 2 <= 144 * MiB && (size_t)MAXBLK * 256 * 512 * 2 <= 72 * MiB, "ws map");
constexpr int CW_BAR = 4096;
constexpr int CW_QUEUE = 8192;
constexpr int CW_CNT = 16384;

constexpr int LDSX = 131072;
constexpr int LX_BAR = LDSX, LX_BC = LDSX + 16, LX_NBLK = LDSX + 32, LX_PSTART = LDSX + 64, LX_BLK2E = LDSX + 256;
constexpr int LDS_BYTES = 147456;

__device__ __forceinline__ unsigned cvt_pk_bf16(float lo, float hi) { unsigned r; asm volatile("v_cvt_pk_bf16_f32 %0, %1, %2" : "=v"(r) : "v"(lo), "v"(hi)); return r; }
__device__ __forceinline__ float bf_lo(unsigned w) { return __builtin_bit_cast(float, w << 16); }
__device__ __forceinline__ float bf_hi(unsigned w) { return __builtin_bit_cast(float, w & 0xffff0000u); }
template <int M> __device__ __forceinline__ float xor_lane(float v) {
    return __builtin_bit_cast(float, __builtin_amdgcn_ds_swizzle(__builtin_bit_cast(int, v), (M << 10) | 0x1f)); }
__device__ __forceinline__ float sum_xor32(float v) {
    const unsigned u = __builtin_bit_cast(unsigned, v); const auto rr = __builtin_amdgcn_permlane32_swap(u, u, false, false);
    return __builtin_bit_cast(float, (unsigned)rr[0]) + __builtin_bit_cast(float, (unsigned)rr[1]); }
__device__ __forceinline__ float max_xor32(float v) {
    const unsigned u = __builtin_bit_cast(unsigned, v); const auto rr = __builtin_amdgcn_permlane32_swap(u, u, false, false);
    return fmaxf(__builtin_bit_cast(float, (unsigned)rr[0]), __builtin_bit_cast(float, (unsigned)rr[1])); }
__device__ __forceinline__ int lane_val(int v, int src_lane) { return __builtin_amdgcn_ds_bpermute(src_lane << 2, v); }
__device__ __forceinline__ float wave_sum(float v) {
    v += xor_lane<1>(v); v += xor_lane<2>(v); v += xor_lane<4>(v); v += xor_lane<8>(v); v += xor_lane<16>(v);
    return sum_xor32(v);
}
__device__ __forceinline__ float fast_exp2(float x) { return __builtin_amdgcn_exp2f(x); }
__device__ __forceinline__ float fast_rcp(float x) { return __builtin_amdgcn_rcpf(x); }

namespace pg8 {
#define PG8_LAS __attribute__((address_space(3)))
typedef unsigned short bf16_t;
typedef short bf16x8 __attribute__((ext_vector_type(8)));
typedef float f32x4 __attribute__((ext_vector_type(4)));
typedef unsigned u32x4 __attribute__((ext_vector_type(4)));
constexpr int BM = 256, BK = 64, HALF = 128, HTB = HALF * BK * 2  , STAGE_BYTES = 8 * HTB, NXCD = 8, WGM = 8;

__host__ __device__ __forceinline__ int lds_byte(int r, int c) { const int st = (r >> 4) * 2 + (c >> 5), rr = r & 15, cc = c & 31, ob = rr * 64 + cc * 2; return st * 1024 + (ob ^ (((ob >> 9) & 1) << 5)); }
__host__ __device__ __forceinline__ void stage_rc(int b, int& R, int& C) { const int st = b / 1024, sb = b % 1024, swz = sb ^ (((sb >> 9) & 1) << 5); R = (st >> 1) * 16 + swz / 64; C = (st & 1) * 32 + (swz % 64) / 2; }
__host__ __device__ __forceinline__ int perm32(int rho) { const int n = rho >> 4, i = rho & 15; return 8 * (i >> 2) + 4 * n + (i & 3); }
struct Unit { int pm, pn; };
struct Gemm { const bf16_t* A; const bf16_t* Bt; int M, N, K; };

struct StaticOrder {
    int nM, nN, nwg, G, c;
    __host__ __device__ void init(int M, int N, int G_, int c_) { nM = M / BM; nN = N / BM; nwg = nM * nN; G = G_; c = c_; }
    __host__ __device__ bool next(int i, Unit& u) const {
        const long L = (long)i * G + c; if (L >= nwg) return false;
        int wgid = (int)L; { const int q = nwg / NXCD, r = nwg % NXCD, xcd = wgid % NXCD, off = wgid / NXCD; wgid = (xcd < r ? xcd * (q + 1) : r * (q + 1) + (xcd - r) * q) + off; }
        const int nig = WGM * nN, gid = wgid / nig, fm = gid * WGM, gsz = (nM - fm) < WGM ? (nM - fm) : WGM;
        u.pm = fm + ((wgid % nig) % gsz); u.pn = (wgid % nig) / gsz; return true;
    }
    __device__ __forceinline__ void a_ready(const Unit&) const {}
    __device__ __forceinline__ void done(const Unit&) const {}
};


struct EpiInProj {
    static constexpr bool PERM = false, AFTER_DRAIN = false;
    bf16_t* qkv; unsigned char* sg; const float* cosT; const float* sinT; const float* qkg; const float* ikg;
    __device__ __forceinline__ void operator()(const f32x4 (&acc)[2][2][4][2], const Unit& u, int wr, int wc, int fr, int fq) const {
        const int pn = u.pn, row0 = u.pm * BM + wr * 64 + fr;
        if (pn >= 15) {
            unsigned char* base = sg + (size_t)row0 * 3072 + (pn - 15) * 256 + wc * 32 + fq * 8;
#pragma unroll
            for (int ai = 0; ai < 2; ++ai)
#pragma unroll
                for (int m = 0; m < 4; ++m)
#pragma unroll
                    for (int bj = 0; bj < 2; ++bj) {
                        unsigned w[2];
#pragma unroll
                        for (int n = 0; n < 2; ++n) { unsigned pk = 0;
#pragma unroll
                            for (int i = 0; i < 4; ++i) { const float x = acc[ai][bj][m][n][i]; const float s = fast_rcp(1.0f + fast_exp2(-1.4426950408889634f * x));
                                unsigned q = (unsigned)(s * 255.0f + 0.5f); q = q > 255u ? 255u : q; pk |= q << (8 * i); }
                            w[n] = pk; }
                        *(u32x2*)(base + (size_t)(ai * HALF + m * 16) * 3072 + bj * HALF) = (u32x2){w[0], w[1]};
                    }
            return;
        }
        int type = 0, gi = 0; bool qscale = false;
        int ocol = (pn < 8 ? 256 * pn : C_Q1 + 256 * (pn - 9)) + 64 * wc;
        switch (pn) {
            case 0: type = 2; gi = 0; qscale = true; break;
            case 1: type = 2; gi = 1; break;
            case 3: type = 2; gi = 2; qscale = true; break;
            case 4: type = 2; gi = 3; break;
            case 6: case 7: type = 1; break;
            case 8: if (wc == 0) { type = 2; ocol = C_KI; } else if (wc == 1) { type = 3; ocol = C_WI; } else type = 4; break;
            case 9: case 10: type = 2; gi = 4; qscale = true; break;
            case 11: case 12: type = 2; gi = 5; break;
            default: type = 0; break;
        }
        if (type == 4) return;
        if (type == 3) {
            if (fq == 0) {
#pragma unroll
                for (int ai = 0; ai < 2; ++ai)
#pragma unroll
                    for (int m = 0; m < 4; ++m) { const f32x4 a = acc[ai][0][m][0] * 0.35355339059327373f, b = acc[ai][0][m][1] * 0.35355339059327373f;
                        *(u32x4*)(qkv + (size_t)(row0 + ai * HALF + m * 16) * QP + C_WI) = (u32x4){cvt_pk_bf16(a[0], a[1]), cvt_pk_bf16(a[2], a[3]), cvt_pk_bf16(b[0], b[1]), cvt_pk_bf16(b[2], b[3])}; }
            }
            return;
        }
        const float* gp = (pn == 8) ? ikg : qkg + 64 * gi;
        if (type == 2) { if (qscale) body<2, true>(acc, row0, ocol, gp, fq); else body<2, false>(acc, row0, ocol, gp, fq); }
        else if (type == 1) body<1, false>(acc, row0, ocol, gp, fq);
        else body<0, false>(acc, row0, ocol, gp, fq);
    }
    template <int TYPE, bool QS>
    __device__ __forceinline__ void body(const f32x4 (&acc)[2][2][4][2], int row0, int ocol, const float* gp, int fq) const {
#pragma unroll
        for (int ai = 0; ai < 2; ++ai)
#pragma unroll
            for (int m = 0; m < 4; ++m) {
                const int row = row0 + ai * HALF + m * 16;
                f32x4 x[2][2];
#pragma unroll
                for (int bj = 0; bj < 2; ++bj)
#pragma unroll
                    for (int n = 0; n < 2; ++n) x[bj][n] = acc[ai][bj][m][n];
                if (TYPE == 2) {
                    float ss = 0.f;
#pragma unroll
                    for (int bj = 0; bj < 2; ++bj)
#pragma unroll
                        for (int n = 0; n < 2; ++n) ss += (x[bj][n][0] * x[bj][n][0] + x[bj][n][1] * x[bj][n][1]) + (x[bj][n][2] * x[bj][n][2] + x[bj][n][3] * x[bj][n][3]);
                    ss += xor_lane<16>(ss); ss = sum_xor32(ss);
                    const float inv = (QS ? C2 : 1.0f) / sqrtf(ss * (1.0f / 64.0f) + EPS);
#pragma unroll
                    for (int bj = 0; bj < 2; ++bj)
#pragma unroll
                        for (int n = 0; n < 2; ++n) x[bj][n] = x[bj][n] * inv * *(const f32x4*)(gp + 32 * bj + 8 * fq + 4 * n);
                }
                if (TYPE >= 1) {
                    const int pos = row & (SEQ - 1);
#pragma unroll
                    for (int n = 0; n < 2; ++n) {
                        const f32x4 c = *(const f32x4*)(cosT + pos * 32 + 8 * fq + 4 * n), s = *(const f32x4*)(sinT + pos * 32 + 8 * fq + 4 * n);
                        const f32x4 a = x[0][n], b = x[1][n];
                        x[0][n] = a * c - b * s; x[1][n] = b * c + a * s;
                    }
                }
#pragma unroll
                for (int bj = 0; bj < 2; ++bj)
                    *(u32x4*)(qkv + (size_t)row * QP + ocol + 32 * bj + 8 * fq) = (u32x4){cvt_pk_bf16(x[bj][0][0], x[bj][0][1]), cvt_pk_bf16(x[bj][0][2], x[bj][0][3]), cvt_pk_bf16(x[bj][1][0], x[bj][1][1]), cvt_pk_bf16(x[bj][1][2], x[bj][1][3])};
                asm volatile("" ::: "memory");
            }
    }
};

template <int BR> struct EpiMerge {
    static constexpr bool PERM = false, AFTER_DRAIN = false;
    bf16_t* merged; const unsigned char* sg;
    __device__ __forceinline__ void operator()(const f32x4 (&acc)[2][2][4][2], const Unit& u, int wr, int wc, int fr, int fq) const {
        const int row0 = u.pm * BM + wr * 64 + fr, col0 = u.pn * BM + wc * 32 + fq * 8;
#pragma unroll
        for (int ai = 0; ai < 2; ++ai)
#pragma unroll
            for (int m = 0; m < 4; ++m) { const size_t row = (size_t)(row0 + ai * HALF + m * 16);
#pragma unroll
                for (int bj = 0; bj < 2; ++bj) {
                    const u32x2 gq = *(const u32x2*)(sg + row * 3072 + BR * 1024 + col0 + bj * HALF);
                    bf16_t* mp = merged + row * 1024 + col0 + bj * HALF;
                    float v[8];
#pragma unroll
                    for (int n = 0; n < 2; ++n)
#pragma unroll
                        for (int i = 0; i < 4; ++i) v[4 * n + i] = acc[ai][bj][m][n][i] * ((float)((gq[n] >> (8 * i)) & 255u) * (1.0f / 255.0f));
                    if (BR > 0) { const u32x4 o = *(const u32x4*)mp;
#pragma unroll
                        for (int k = 0; k < 4; ++k) { v[2 * k] += bf_lo(o[k]); v[2 * k + 1] += bf_hi(o[k]); } }
                    *(u32x4*)mp = (u32x4){cvt_pk_bf16(v[0], v[1]), cvt_pk_bf16(v[2], v[3]), cvt_pk_bf16(v[4], v[5]), cvt_pk_bf16(v[6], v[7])};
                }
                asm volatile("" ::: "memory"); }
    }
};

struct EpiResid {
    static constexpr bool PERM = false, AFTER_DRAIN = false;
    const float* res; float* out;
    __device__ __forceinline__ void operator()(const f32x4 (&acc)[2][2][4][2], const Unit& u, int wr, int wc, int fr, int fq) const {
        const int row0 = u.pm * BM + wr * 64 + fr, col0 = u.pn * BM + wc * 32 + fq * 8;
#pragma unroll
        for (int ai = 0; ai < 2; ++ai)
#pragma unroll
            for (int m = 0; m < 4; ++m) { const size_t off = (size_t)(row0 + ai * HALF + m * 16) * 1024 + col0;
#pragma unroll
                for (int bj = 0; bj < 2; ++bj)
#pragma unroll
                    for (int n = 0; n < 2; ++n) { const f32x4 r = *(const f32x4*)(res + off + bj * HALF + 4 * n); *(f32x4*)(out + off + bj * HALF + 4 * n) = r + acc[ai][bj][m][n]; }
                if (m & 1) asm volatile("" ::: "memory"); }
    }
};

struct EpiGateUp {
    static constexpr bool PERM = false, AFTER_DRAIN = false;
    bf16_t* hid;
    __device__ __forceinline__ void operator()(const f32x4 (&acc)[2][2][4][2], const Unit& u, int wr, int wc, int fr, int fq) const {
        const int row0 = u.pm * BM + wr * 64 + fr, col0 = (u.pn & 3) * HALF + wc * 32 + fq * 8;
#pragma unroll
        for (int ai = 0; ai < 2; ++ai)
#pragma unroll
            for (int m = 0; m < 4; ++m) { float v[8];
#pragma unroll
                for (int n = 0; n < 2; ++n)
#pragma unroll
                    for (int i = 0; i < 4; ++i) { const float gt = acc[ai][0][m][n][i], up = acc[ai][1][m][n][i]; v[4 * n + i] = gt * fast_rcp(1.0f + fast_exp2(-1.4426950408889634f * gt)) * up; }
                *(u32x4*)(hid + (size_t)(row0 + ai * HALF + m * 16) * DEXP + col0) = (u32x4){cvt_pk_bf16(v[0], v[1]), cvt_pk_bf16(v[2], v[3]), cvt_pk_bf16(v[4], v[5]), cvt_pk_bf16(v[6], v[7])}; }
    }
};

struct EpiDown {
    static constexpr bool PERM = false, AFTER_DRAIN = false;
    bf16_t* y;
    __device__ __forceinline__ void operator()(const f32x4 (&acc)[2][2][4][2], const Unit& u, int wr, int wc, int fr, int fq) const {
        const int row0 = u.pm * BM + wr * 64 + fr, col0 = (u.pn & 3) * BM + wc * 32 + fq * 8;
#pragma unroll
        for (int ai = 0; ai < 2; ++ai)
#pragma unroll
            for (int m = 0; m < 4; ++m)
#pragma unroll
                for (int bj = 0; bj < 2; ++bj) { const f32x4 a = acc[ai][bj][m][0], b = acc[ai][bj][m][1];
                    *(u32x4*)(y + (size_t)(row0 + ai * HALF + m * 16) * 1024 + col0 + bj * HALF) = (u32x4){cvt_pk_bf16(a[0], a[1]), cvt_pk_bf16(a[2], a[3]), cvt_pk_bf16(b[0], b[1]), cvt_pk_bf16(b[2], b[3])}; }
    }
};

struct MoeOrder {
    int nunits, G, c; const PG8_LAS int* blk2e;
    __device__ __forceinline__ bool next(int i, Unit& u) const { const int L = i * G + c; if (L >= nunits) return false; const int rb = L >> 2; u.pm = rb; u.pn = blk2e[rb] * 4 + (L & 3); return true; }
    __device__ __forceinline__ void a_ready(const Unit&) const {}
    __device__ __forceinline__ void done(const Unit&) const {}
};

template <class Epi, class Sched, bool ALIGN_EPI = false, bool SP2 = false>
__device__ __forceinline__ void gemm_phase(PG8_LAS unsigned char* lds, const Gemm g, const Sched& S, const Epi& E) {
    int tid_l = (int)threadIdx.x; asm volatile("" : "+v"(tid_l));
    const int tid = tid_l, wid = __builtin_amdgcn_readfirstlane(tid >> 6), lane = tid & 63, wr = wid >> 2, wc = wid & 3, fr = lane & 15, fq = lane >> 4;
    const int K = g.K, nt = K / BK;
    unsigned voffA[2], voffB[2];
#pragma unroll
    for (int i = 0; i < 2; ++i) { int R, C; stage_rc(tid * 16 + i * 8192, R, C); const int Rb = Epi::PERM ? ((R & ~31) + perm32(R & 31)) : R;
        voffA[i] = (unsigned)(R * K + C) * 2u; voffB[i] = (unsigned)(Rb * K + C) * 2u; }
    const size_t kstep = (size_t)(BK * 2);
    const size_t hstep = (size_t)HALF * K * 2;
    const size_t tstep = 2 * hstep;
    const unsigned ldsw = (unsigned)wid * 1024u;
    const int aoff = lds_byte(wr * 64 + fr, fq * 8), boff = lds_byte(wc * 32 + fr, fq * 8);
#define PG8_SA(b, h) (((b) * 2 + (h)) * HTB)
#define PG8_SB(b, h) ((4 + (b) * 2 + (h)) * HTB)
#define PG8_STAGE(bufoff, gbase, voff) do { _Pragma("unroll") for (int _i = 0; _i < 2; ++_i) \
        __builtin_amdgcn_global_load_lds((const unsigned*)((const char*)(gbase) + (voff)[_i]), (PG8_LAS unsigned*)(lds + (bufoff) + ldsw + _i * 8192), 16, 0, 0); } while (0)
#define PG8_LDA(dst, b, h) do { _Pragma("unroll") for (int m = 0; m < 4; ++m) _Pragma("unroll") for (int k = 0; k < 2; ++k) dst[m][k] = *(const PG8_LAS bf16x8*)(lds + PG8_SA(b, h) + aoff + m * 2048 + k * 1024); } while (0)
#define PG8_LDB(dst, b, h) do { _Pragma("unroll") for (int n = 0; n < 2; ++n) _Pragma("unroll") for (int k = 0; k < 2; ++k) dst[n][k] = *(const PG8_LAS bf16x8*)(lds + PG8_SB(b, h) + boff + n * 2048 + k * 1024); } while (0)
#define PG8_MMA(ai, bj, At, Bt) do { __builtin_amdgcn_s_setprio(1); _Pragma("unroll") for (int m = 0; m < 4; ++m) _Pragma("unroll") for (int n = 0; n < 2; ++n) _Pragma("unroll") for (int k = 0; k < 2; ++k) \
        acc[ai][bj][m][n] = __builtin_amdgcn_mfma_f32_16x16x32_bf16(Bt[n][k], At[m][k], acc[ai][bj][m][n], 0, 0, 0); __builtin_amdgcn_s_setprio(0); } while (0)
#define PG8_WAIT_V(n) asm volatile("s_waitcnt vmcnt(" #n ")" ::: "memory")
#define PG8_WAIT_L(n) asm volatile("s_waitcnt lgkmcnt(" #n ")" ::: "memory")
#define PG8_BAR __builtin_amdgcn_s_barrier()
#define PG8_SCHED __builtin_amdgcn_sched_barrier(0)
    Unit cur, nxt; int ui = 0;
    if (!S.next(0, cur)) return;
    f32x4 acc[2][2][4][2];
#pragma unroll
    for (int a = 0; a < 2; ++a)
#pragma unroll
        for (int b = 0; b < 2; ++b)
#pragma unroll
            for (int m = 0; m < 4; ++m)
#pragma unroll
                for (int n = 0; n < 2; ++n) acc[a][b][m][n] = (f32x4){0.f, 0.f, 0.f, 0.f};
    bf16x8 At[4][2], B0[2][2], B1[2][2];
    const char* cA = (const char*)g.A + (size_t)cur.pm * tstep; const char* cB = (const char*)g.Bt + (size_t)cur.pn * tstep;
    S.a_ready(cur);
    if constexpr (SP2) {
        PG8_STAGE(PG8_SB(0, 0), cB, voffB); PG8_STAGE(PG8_SB(0, 1), cB + hstep, voffB); PG8_STAGE(PG8_SA(0, 0), cA, voffA); PG8_STAGE(PG8_SA(0, 1), cA + hstep, voffA);
        if (wr == 1) PG8_BAR;
        PG8_WAIT_V(2); PG8_BAR;
        PG8_STAGE(PG8_SB(1, 0), cB + kstep, voffB); PG8_STAGE(PG8_SA(1, 0), cA + kstep, voffA); PG8_STAGE(PG8_SB(1, 1), cB + hstep + kstep, voffB);
        PG8_WAIT_V(6); PG8_BAR;
    } else {
        PG8_STAGE(PG8_SB(0, 0), cB, voffB); PG8_STAGE(PG8_SA(0, 0), cA, voffA); PG8_STAGE(PG8_SB(0, 1), cB + hstep, voffB); PG8_STAGE(PG8_SA(0, 1), cA + hstep, voffA);
        if (wr == 1) PG8_BAR;
        PG8_WAIT_V(4); PG8_BAR;
        PG8_STAGE(PG8_SB(1, 0), cB + kstep, voffB); PG8_STAGE(PG8_SA(1, 0), cA + kstep, voffA); PG8_STAGE(PG8_SB(1, 1), cB + hstep + kstep, voffB);
        PG8_WAIT_V(6); PG8_BAR;
    }
    for (;;) {
        const bool has_next = S.next(ui + 1, nxt);
        const char* nA = has_next ? (const char*)g.A + (size_t)nxt.pm * tstep : cA; const char* nB = has_next ? (const char*)g.Bt + (size_t)nxt.pn * tstep : cB;
#pragma unroll 1
        for (int t = 0; t < nt; t += 2) {
            const bool last = (t == nt - 2);
            const char* a1 = cA + (size_t)(t + 1) * kstep;
            const char* a2 = last ? nA : cA + (size_t)(t + 2) * kstep; const char* b2 = last ? nB : cB + (size_t)(t + 2) * kstep;
            const char* a3 = a2 + kstep; const char* b3 = b2 + kstep;
            if (last && has_next) S.a_ready(nxt);
            if constexpr (SP2) {
            PG8_LDB(B0, 0, 0); PG8_LDB(B1, 0, 1); PG8_SCHED; PG8_LDA(At, 0, 0); PG8_STAGE(PG8_SA(1, 1), a1 + hstep, voffA);
            PG8_WAIT_V(8); PG8_WAIT_L(0); PG8_BAR; PG8_MMA(0, 0, At, B0); PG8_MMA(0, 1, At, B1); PG8_BAR; PG8_SCHED;
            PG8_LDA(At, 0, 1); PG8_STAGE(PG8_SB(0, 0), b2, voffB); PG8_STAGE(PG8_SB(0, 1), b2 + hstep, voffB); PG8_STAGE(PG8_SA(0, 0), a2, voffA);
            PG8_WAIT_V(8); PG8_WAIT_L(0); PG8_BAR; PG8_MMA(1, 0, At, B0); PG8_MMA(1, 1, At, B1); PG8_BAR; PG8_SCHED;
            PG8_LDB(B0, 1, 0); PG8_LDB(B1, 1, 1); PG8_SCHED; PG8_LDA(At, 1, 0); PG8_STAGE(PG8_SA(0, 1), a2 + hstep, voffA);
            PG8_WAIT_V(8); PG8_WAIT_L(0); PG8_BAR; PG8_MMA(0, 0, At, B0); PG8_MMA(0, 1, At, B1); PG8_BAR; PG8_SCHED;
            PG8_LDA(At, 1, 1); PG8_STAGE(PG8_SB(1, 0), b3, voffB); PG8_STAGE(PG8_SB(1, 1), b3 + hstep, voffB); PG8_STAGE(PG8_SA(1, 0), a3, voffA);
            PG8_WAIT_V(8); PG8_WAIT_L(0); PG8_BAR; PG8_MMA(1, 0, At, B0); PG8_MMA(1, 1, At, B1); PG8_BAR; PG8_SCHED;
            } else {
            PG8_LDB(B0, 0, 0); PG8_SCHED; PG8_LDA(At, 0, 0); PG8_STAGE(PG8_SA(1, 1), a1 + hstep, voffA);
            PG8_WAIT_L(8); PG8_BAR; PG8_WAIT_L(0); PG8_MMA(0, 0, At, B0); PG8_BAR; PG8_SCHED;
            PG8_LDB(B1, 0, 1); PG8_STAGE(PG8_SB(0, 0), b2, voffB);
            PG8_BAR; PG8_WAIT_L(0); PG8_MMA(0, 1, At, B1); PG8_BAR;
            PG8_LDA(At, 0, 1); PG8_STAGE(PG8_SA(0, 0), a2, voffA);
            PG8_BAR; PG8_WAIT_L(0); PG8_MMA(1, 0, At, B0); PG8_BAR; PG8_SCHED;
            PG8_STAGE(PG8_SB(0, 1), b2 + hstep, voffB);
            PG8_WAIT_V(6); PG8_BAR; PG8_MMA(1, 1, At, B1); PG8_BAR;
            PG8_LDB(B0, 1, 0); PG8_SCHED; PG8_LDA(At, 1, 0); PG8_STAGE(PG8_SA(0, 1), a2 + hstep, voffA);
            PG8_WAIT_L(8); PG8_BAR; PG8_WAIT_L(0); PG8_MMA(0, 0, At, B0); PG8_BAR; PG8_SCHED;
            PG8_LDB(B1, 1, 1); PG8_STAGE(PG8_SB(1, 0), b3, voffB);
            PG8_BAR; PG8_WAIT_L(0); PG8_MMA(0, 1, At, B1); PG8_BAR;
            PG8_LDA(At, 1, 1); PG8_STAGE(PG8_SA(1, 0), a3, voffA);
            PG8_BAR; PG8_WAIT_L(0); PG8_MMA(1, 0, At, B0); PG8_BAR; PG8_SCHED;
            PG8_STAGE(PG8_SB(1, 1), b3 + hstep, voffB);
            PG8_WAIT_V(6); PG8_BAR; PG8_MMA(1, 1, At, B1); PG8_BAR;
            }
        }
        if constexpr (ALIGN_EPI) { if (wr == 0) PG8_BAR; }
        if constexpr (!Epi::AFTER_DRAIN) { E(acc, cur, wr, wc, fr, fq); S.done(cur); }
        if (!has_next) break;
#pragma unroll
        for (int a = 0; a < 2; ++a)
#pragma unroll
            for (int b = 0; b < 2; ++b)
#pragma unroll
                for (int m = 0; m < 4; ++m)
#pragma unroll
                    for (int n = 0; n < 2; ++n) acc[a][b][m][n] = (f32x4){0.f, 0.f, 0.f, 0.f};
        cur = nxt; cA = nA; cB = nB; ++ui;
        if constexpr (ALIGN_EPI) { if (wr == 1) PG8_BAR; }
    }
    PG8_WAIT_V(0);
    if constexpr (!ALIGN_EPI) { if (wr == 0) PG8_BAR; }
    PG8_BAR;
    if constexpr (Epi::AFTER_DRAIN) { E.fused(acc, cur, wr, wc, fr, fq, lds, wid, lane); S.done(cur); }
#undef PG8_SA
#undef PG8_SB
#undef PG8_STAGE
#undef PG8_LDA
#undef PG8_LDB
#undef PG8_MMA
#undef PG8_WAIT_V
#undef PG8_WAIT_L
#undef PG8_BAR
#undef PG8_SCHED
}
}
#define XB_TMO      128
#define XB_XCNT(j)  (256  + 64 * (j))
#define XB_XSUB(j)  (1280 + 64 * (j))
#define XB_XGEN(j)  (2304 + 64 * (j))
#define XB_TOP      3328
#define XB_TOPGEN   3392
#define XCD_BAR_WORDS 3456
#define XB_SPIN_CAP (1u << 21)

__device__ __forceinline__ unsigned xb_ld(unsigned* p)              { return __hip_atomic_load(p, __ATOMIC_RELAXED, __HIP_MEMORY_SCOPE_AGENT); }
__device__ __forceinline__ unsigned xb_add(unsigned* p, unsigned v) { return __hip_atomic_fetch_add(p, v, __ATOMIC_RELAXED, __HIP_MEMORY_SCOPE_AGENT); }
__device__ __forceinline__ unsigned xb_xcc_id() { return (unsigned)__builtin_amdgcn_s_getreg((3 << 11) | 20) & 0xFu; }
#define XB_SPIN(cond, bar) do { unsigned _sp = 0; while (cond) { __builtin_amdgcn_s_sleep(1); \
    if ((++_sp & 255u) == 0u) { if (xb_ld(&(bar)[XB_TMO])) break; if (_sp > XB_SPIN_CAP) { atomicAdd(&(bar)[XB_TMO], 1u); break; } } } } while (0)

struct XcdBarrier {
    unsigned* bar; unsigned x;
    volatile LAS unsigned* st;
};

__device__ __forceinline__ XcdBarrier xcd_barrier_post(unsigned* bar, volatile LAS unsigned* st) {
    XcdBarrier b; b.bar = bar; b.x = xb_xcc_id(); b.st = st;
    if (threadIdx.x == 0) (void)xb_add(&bar[XB_XCNT(b.x)], 1u);
    return b;
}
__device__ __forceinline__ void xcd_barrier_complete(unsigned* bar, unsigned x, unsigned& nloc, unsigned& nx) {
    const unsigned G = gridDim.x * gridDim.y * gridDim.z;
    unsigned sum, cnt, mine, sp = 0u;
    for (;;) {
        sum = 0u; cnt = 0u; mine = 0u;
#pragma unroll
        for (unsigned j = 0; j < 16; ++j) { const unsigned c = xb_ld(&bar[XB_XCNT(j)]); sum += c; cnt += (c > 0u) ? 1u : 0u; mine = (j == x) ? c : mine; }
        if (sum == G) break;
        __builtin_amdgcn_s_sleep(1);
        if ((++sp & 255u) == 0u) { if (xb_ld(&bar[XB_TMO])) break; if (sp > XB_SPIN_CAP) { atomicAdd(&bar[XB_TMO], 1u); break; } }
    }
    nloc = mine > 0u ? mine : 1u; nx = cnt > 0u ? cnt : 1u;
}

__device__ __forceinline__ void xcd_barrier(const XcdBarrier& b) {
    asm volatile("s_waitcnt vmcnt(0)" ::: "memory");
    __syncthreads();
    int tid_l = (int)threadIdx.x; asm volatile("" : "+v"(tid_l));
    if (tid_l == 0) {
        unsigned* bar = b.bar;
        __builtin_amdgcn_s_waitcnt(0);
        unsigned nloc = b.st[0], nx = b.st[1];
        if (nloc == 0u) { xcd_barrier_complete(bar, b.x, nloc, nx); b.st[0] = nloc; b.st[1] = nx; }
        const unsigned old = xb_add(&bar[XB_XSUB(b.x)], 1u);
        const unsigned gen = old / nloc;
        if (old + 1u == (gen + 1u) * nloc) {
            __builtin_amdgcn_fence(__ATOMIC_RELEASE, "agent");
            asm volatile("s_waitcnt vmcnt(0)" ::: "memory");
            const unsigned og = xb_add(&bar[XB_TOP], 1u);
            const unsigned tg = og / nx;
            if (og + 1u == (tg + 1u) * nx) xb_add(&bar[XB_TOPGEN], 1u);
            else XB_SPIN(xb_ld(&bar[XB_TOPGEN]) == tg, bar);
            __builtin_amdgcn_fence(__ATOMIC_ACQUIRE, "agent");
            xb_add(&bar[XB_XGEN(b.x)], 1u);
            asm volatile("s_waitcnt vmcnt(0)" ::: "memory");
        } else {
            XB_SPIN(xb_ld(&bar[XB_XGEN(b.x)]) == gen, bar);
            __builtin_amdgcn_fence(__ATOMIC_ACQUIRE, "agent");
            asm volatile("s_waitcnt vmcnt(0)" ::: "memory");
        }
    }
    __syncthreads();
}

enum { I_X = 0, I_NORM_ATTN, I_W_IN, I_QK_GAIN, I_IDX_K_GAIN, I_DIFF_LAMBDA, I_DIFF_SUBLN, I_W_PROJ_A, I_W_PROJ_B, I_W_PROJ_C, I_W_OUT, I_NORM_FFN, I_W_GROUP, I_B_GROUP, I_W_ROUTER, I_B_ROUTER,
       I_W_E_GATE, I_W_E_UP, I_W_E_DOWN, N_INPUTS };
struct Args { const float* in[N_INPUTS]; float* out; unsigned char* ws; };

#define LDS_WAIT() asm volatile("s_waitcnt lgkmcnt(0)" ::: "memory")

__device__ __forceinline__ int inproj_src_col(int d) {
    const int pn = d >> 8, s = d & 255;
    if (pn >= 15) return C_G + 256 * (pn - 15) + (s & ~31) + pg8::perm32(s & 31);
    const int u = (s >> 5) & 3, e = 32 * (s >> 7) + pg8::perm32(s & 31);
    if (pn < 8) return 256 * pn + 64 * u + e;
    if (pn == 8) { if (u == 0) return C_KI + e; if (u == 1) return e < 8 ? C_WI + e : -1; return -1; }
    return C_Q1 + 256 * (pn - 9) + 64 * u + e;
}
__device__ __forceinline__ void transpose_item(const float* W, int ldw, int K, bf16_t* WT, int drow0, int k0, int srccol, LAS float* scr, int lane) {
    const float* src = W + (size_t)k0 * ldw + (srccol >= 0 ? srccol : 0);
#pragma unroll 8
    for (int i = 0; i < 32; ++i) { const int kk = 2 * i + (lane >> 5); const float v = src[(size_t)kk * ldw]; scr[kk * 33 + (lane & 31)] = srccol >= 0 ? v : 0.f; }
    LDS_WAIT(); asm volatile("" ::: "memory");
    const int c = lane & 7;
#pragma unroll
    for (int j = 0; j < 4; ++j) { const int n = (lane >> 3) + 8 * j; const LAS float* s = scr + (8 * c) * 33 + n;
        u32x4 o; o.x = cvt_pk_bf16(s[0 * 33], s[1 * 33]); o.y = cvt_pk_bf16(s[2 * 33], s[3 * 33]); o.z = cvt_pk_bf16(s[4 * 33], s[5 * 33]); o.w = cvt_pk_bf16(s[6 * 33], s[7 * 33]);
        *(u32x4*)(WT + (size_t)(drow0 + n) * K + k0 + 8 * c) = o; }
    LDS_WAIT(); asm volatile("" ::: "memory");
}

template <bool COMBINE, bool WRITE_HN>
__device__ __forceinline__ void token_row(const float* src, float* dst, const bf16_t* y, const unsigned* rt0, const unsigned* rt1, const f32x2* rtw, const LAS int* pstart,
                                          const float* gain, bf16_t* hn, int m, int lane) {
    f32x4 v[4];
#pragma unroll
    for (int j = 0; j < 4; ++j) v[j] = ((const f32x4*)(src + (size_t)m * DM))[lane + 64 * j];
    if (COMBINE) {
        const unsigned a = rt0[m], b = rt1[m]; const f32x2 w = rtw[m];
        const size_t s0 = (size_t)(pstart[a >> 24] + (int)(a & 0xffffffu)), s1 = (size_t)(pstart[b >> 24] + (int)(b & 0xffffffu));
#pragma unroll
        for (int j = 0; j < 4; ++j) { const u32x2 p = ((const u32x2*)(y + s0 * DM))[lane + 64 * j], q = ((const u32x2*)(y + s1 * DM))[lane + 64 * j];
            v[j][0] += w[0] * bf_lo(p[0]) + w[1] * bf_lo(q[0]); v[j][1] += w[0] * bf_hi(p[0]) + w[1] * bf_hi(q[0]);
            v[j][2] += w[0] * bf_lo(p[1]) + w[1] * bf_lo(q[1]); v[j][3] += w[0] * bf_hi(p[1]) + w[1] * bf_hi(q[1]);
            ((f32x4*)(dst + (size_t)m * DM))[lane + 64 * j] = v[j]; }
    }
    if (WRITE_HN) {
        float ss = 0.f;
#pragma unroll
        for (int j = 0; j < 4; ++j) ss += (v[j][0] * v[j][0] + v[j][1] * v[j][1]) + (v[j][2] * v[j][2] + v[j][3] * v[j][3]);
        const float rstd = 1.0f / sqrtf(wave_sum(ss) * (1.0f / DM) + EPS);
#pragma unroll
        for (int j = 0; j < 4; ++j) { const f32x4 g = ((const f32x4*)gain)[lane + 64 * j]; const f32x4 o = v[j] * rstd * g;
            ((u32x2*)(hn + (size_t)m * DM))[lane + 64 * j] = (u32x2){cvt_pk_bf16(o[0], o[1]), cvt_pk_bf16(o[2], o[3])}; }
    }
}

template <bool EXPERTS> __device__ __forceinline__ void convert_weights(const Args& a, unsigned char* ws, int l, LAS unsigned char* lds, int lane, int wave, int vcu, int G);
__device__ __forceinline__ void p0_phase(const Args& a, unsigned char* ws, int l, LAS unsigned char* lds, int tid, int lane, int wave, int vcu, int G) {
    convert_weights<false>(a, ws, l, lds, lane, wave, vcu, G);
    const int gw = vcu * 8 + wave, NGW = G * 8, gt = vcu * 512 + tid, NGT = G * 512;
    if (l == 0) {
        float* cosT = (float*)(ws + WS_COS); float* sinT = (float*)(ws + WS_SIN);
        for (int idx = gt; idx < SEQ * 32; idx += NGT) { const int pos = idx >> 5, j = idx & 31;
            const float inv_freq = 1.0f / powf(10000.0f, (float)(2 * j) * (1.0f / 64.0f));
            const float ang = (float)pos * inv_freq;
            const double rev = (double)ang * 0.15915494309189533577; const float fr = (float)(rev - rint(rev));
            cosT[idx] = __builtin_amdgcn_cosf(fr); sinT[idx] = __builtin_amdgcn_sinf(fr); }
    }
    { float* wrt = (float*)(ws + WS_WRT); const float* wg = a.in[I_W_GROUP] + (size_t)l * DM * 4; const float* wr = a.in[I_W_ROUTER] + (size_t)l * DM * 32;
      const float* g2 = a.in[I_NORM_FFN] + (size_t)l * DM;
      for (int idx = gt; idx < 36 * DM; idx += NGT) { const int c = idx >> 10, k = idx & 1023; wrt[idx] = g2[k] * (c < 4 ? wg[k * 4 + c] : wr[k * 32 + (c - 4)]); } }
    const float* gain = a.in[I_NORM_ATTN] + (size_t)l * DM; bf16_t* hn = (bf16_t*)(ws + WS_HN);
    const LAS int* pstart = (const LAS int*)(lds + LX_PSTART);
    if (l == 0) { for (int m = gw; m < MTOK; m += NGW) token_row<false, true>(a.in[I_X], nullptr, nullptr, nullptr, nullptr, nullptr, pstart, gain, hn, m, lane); }
    else { for (int m = gw; m < MTOK; m += NGW) token_row<true, true>(a.out, a.out, (const bf16_t*)(ws + WS_Y), (const unsigned*)(ws + WS_RT0), (const unsigned*)(ws + WS_RT1), (const f32x2*)(ws + WS_RTW), pstart, gain, hn, m, lane); }
}

template <bool EXPERTS> __device__ __forceinline__ void convert_weights(const Args& a, unsigned char* ws, int l, LAS unsigned char* lds, int lane, int wave, int vcu, int G) {
    LAS float* scr = (LAS float*)(lds + wave * 16384);
    const int gw = vcu * 8 + wave, NGW = G * 8;
    constexpr int I_IN = 216 * 16, I_PA = 32 * 4, I_PC = 32 * 8, I_WO = 32 * 16, I_GU = 32 * 32 * 16, I_DN = 32 * 32 * 8, NIT = I_IN + 2 * I_PA + I_PC + I_WO + I_GU + I_DN;
    constexpr int I_SMALL = I_IN + 2 * I_PA + I_PC + I_WO;
    for (int it = gw + (EXPERTS ? I_SMALL : 0); it < (EXPERTS ? NIT : I_SMALL); it += NGW) {
        int r = it; const int d31 = lane & 31;
        if (r < I_IN) { const int nb = r >> 4, kb = r & 15; transpose_item(a.in[I_W_IN] + (size_t)l * DM * D_IN, D_IN, 1024, (bf16_t*)(ws + WS_WIN), nb * 32, kb * 64, inproj_src_col(nb * 32 + d31), scr, lane); continue; } r -= I_IN;
        const int pcol = pg8::perm32(d31);
        if (r < I_PA) { const int nb = r >> 2, kb = r & 3; transpose_item(a.in[I_W_PROJ_A] + (size_t)l * 256 * DM, DM, 256, (bf16_t*)(ws + WS_WPA), nb * 32, kb * 64, nb * 32 + pcol, scr, lane); continue; } r -= I_PA;
        if (r < I_PA) { const int nb = r >> 2, kb = r & 3; transpose_item(a.in[I_W_PROJ_B] + (size_t)l * 256 * DM, DM, 256, (bf16_t*)(ws + WS_WPB), nb * 32, kb * 64, nb * 32 + pcol, scr, lane); continue; } r -= I_PA;
        if (r < I_PC) { const int nb = r >> 3, kb = r & 7; transpose_item(a.in[I_W_PROJ_C] + (size_t)l * 512 * DM, DM, 512, (bf16_t*)(ws + WS_WPC), nb * 32, kb * 64, nb * 32 + pcol, scr, lane); continue; } r -= I_PC;
        if (r < I_WO) { const int nb = r >> 4, kb = r & 15; transpose_item(a.in[I_W_OUT] + (size_t)l * DM * DM, DM, 1024, (bf16_t*)(ws + WS_WO), nb * 32, kb * 64, nb * 32 + pcol, scr, lane); continue; } r -= I_WO;
        if (r < I_GU) { const int e = r >> 9, rr = r & 511, nb = rr >> 4, kb = rr & 15, dd = nb * 32, pn = dd >> 8, s = dd & 255, half = s >> 7;
            const float* src = (half ? a.in[I_W_E_UP] : a.in[I_W_E_GATE]) + (size_t)(l * NEXP + e) * DM * DEXP;
            transpose_item(src, DEXP, 1024, (bf16_t*)(ws + WS_WGU) + (size_t)e * 1024 * 1024, nb * 32, kb * 64, 128 * pn + (s & 127) + pcol, scr, lane); continue; } r -= I_GU;
        { const int e = r >> 8, rr = r & 255, nb = rr >> 3, kb = rr & 7;
            transpose_item(a.in[I_W_E_DOWN] + (size_t)(l * NEXP + e) * DEXP * DM, DM, 512, (bf16_t*)(ws + WS_WD) + (size_t)e * 1024 * 512, nb * 32, kb * 64, nb * 32 + pcol, scr, lane); }
    }
}

__device__ __forceinline__ f32x16 mfma32(bf16x8 a, bf16x8 b, f32x16 c) { return __builtin_amdgcn_mfma_f32_32x32x16_bf16(a, b, c, 0, 0, 0); }
typedef short v4i16_t __attribute__((ext_vector_type(4)));
__device__ __forceinline__ s16x4 vtr(const LAS unsigned char* p) { return __builtin_bit_cast(s16x4, __builtin_amdgcn_ds_read_tr16_b64_v4i16((LAS v4i16_t*)p)); }
__device__ __forceinline__ int crow(int r, int hi) { return (r & 3) + 8 * (r >> 2) + 4 * hi; }
#define NEG_INF (-__builtin_inff())

__device__ __forceinline__ f32x16 splat16(float v) { f32x16 r;
#pragma unroll
    for (int i = 0; i < 16; ++i) r[i] = v;
    return r; }
struct QReg { const bf16x8 (&q)[4]; __device__ __forceinline__ bf16x8 operator()(int ks) const { return q[ks]; } };
struct QLds { const LAS unsigned char* p; __device__ __forceinline__ bf16x8 operator()(int ks) const { return *(const LAS bf16x8*)(p + ks * 1024); } };
template <int NDB, class QF, class MaskF>
__device__ __forceinline__ void flash_tile(float& m_run, float& l_run, f32x16 (&o)[NDB], const LAS unsigned char* kimg, const LAS unsigned char* vimg, const QF& qf, const MaskF& maskf, int r32, int hi, int vboff) {
    if (NDB == 4) __builtin_amdgcn_sched_barrier(0);
    f32x16 p0 = splat16(0.f), p1 = splat16(0.f);
#pragma unroll
    for (int ks = 0; ks < 4; ++ks) {
        const bf16x8 a0 = *(const LAS bf16x8*)(kimg + (2 * ks + hi) * 1024 + r32 * 16);
        const bf16x8 a1 = *(const LAS bf16x8*)(kimg + (2 * ks + hi) * 1024 + 512 + r32 * 16);
        const bf16x8 qk = qf(ks);
        p0 = mfma32(a0, qk, p0); p1 = mfma32(a1, qk, p1);
        if (NDB == 4 && (ks & 1)) __builtin_amdgcn_sched_barrier(0);
    }
    maskf(p0, p1);
    float mx = fmaxf(p0[0], p1[0]);
#pragma unroll
    for (int r = 1; r < 16; ++r) mx = fmaxf(mx, fmaxf(p0[r], p1[r]));
    mx = max_xor32(mx);
    const float mnew = fmaxf(m_run, mx);
    if (__ballot(mnew > m_run) != 0ull) {
        const float alpha = fast_exp2(m_run - mnew);
        l_run *= alpha;
#pragma unroll
        for (int db = 0; db < NDB; ++db) o[db] = o[db] * alpha;
    }
    m_run = mnew;
    float sum = 0.f;
#pragma unroll
    for (int r = 0; r < 16; ++r) { p0[r] = fast_exp2(p0[r] - mnew); p1[r] = fast_exp2(p1[r] - mnew); sum += p0[r] + p1[r]; }
    l_run += sum;
    bf16x8 pa[4];
    pa[0] = __builtin_bit_cast(bf16x8, (u32x4){cvt_pk_bf16(p0[0], p0[1]), cvt_pk_bf16(p0[2], p0[3]), cvt_pk_bf16(p0[4], p0[5]), cvt_pk_bf16(p0[6], p0[7])});
    pa[1] = __builtin_bit_cast(bf16x8, (u32x4){cvt_pk_bf16(p0[8], p0[9]), cvt_pk_bf16(p0[10], p0[11]), cvt_pk_bf16(p0[12], p0[13]), cvt_pk_bf16(p0[14], p0[15])});
    pa[2] = __builtin_bit_cast(bf16x8, (u32x4){cvt_pk_bf16(p1[0], p1[1]), cvt_pk_bf16(p1[2], p1[3]), cvt_pk_bf16(p1[4], p1[5]), cvt_pk_bf16(p1[6], p1[7])});
    pa[3] = __builtin_bit_cast(bf16x8, (u32x4){cvt_pk_bf16(p1[8], p1[9]), cvt_pk_bf16(p1[10], p1[11]), cvt_pk_bf16(p1[12], p1[13]), cvt_pk_bf16(p1[14], p1[15])});
#pragma unroll
    for (int db = 0; db < NDB; ++db)
#pragma unroll
        for (int s = 0; s < 4; ++s) {
            const s16x4 lo = vtr(vimg + vboff + db * 4096 + s * 1024), h4 = vtr(vimg + vboff + db * 4096 + s * 1024 + 512);
            const bf16x8 vt = (bf16x8){lo[0], lo[1], lo[2], lo[3], h4[0], h4[1], h4[2], h4[3]};
            o[db] = mfma32(vt, pa[s], o[db]);
            if (NDB == 4 && (s & 1)) __builtin_amdgcn_sched_barrier(0);
        }    __builtin_amdgcn_sched_barrier(0);
}
struct MaskNone { __device__ __forceinline__ void operator()(f32x16&, f32x16&) const {} };
struct MaskCausal { int kb0, qloc, hi;
    __device__ __forceinline__ void operator()(f32x16& p0, f32x16& p1) const {
#pragma unroll
        for (int r = 0; r < 16; ++r) { const int kv = kb0 + crow(r, hi); p0[r] = kv > qloc ? NEG_INF : p0[r]; p1[r] = kv + 32 > qloc ? NEG_INF : p1[r]; } } };
struct MaskCausalIf { bool on; int kb0, qloc, hi;
    __device__ __forceinline__ void operator()(f32x16& p0, f32x16& p1) const { if (on) {
#pragma unroll
        for (int r = 0; r < 16; ++r) { const int kv = kb0 + crow(r, hi); p0[r] = kv > qloc ? NEG_INF : p0[r]; p1[r] = kv + 32 > qloc ? NEG_INF : p1[r]; } } } };
struct MaskLane { float ci;
    __device__ __forceinline__ void operator()(f32x16& p0, f32x16& p1) const {
#pragma unroll
        for (int r = 0; r < 16; ++r) { p0[r] += ci; p1[r] += ci; } } };
struct MaskBits { unsigned w0, w1; int hi;
    __device__ __forceinline__ void operator()(f32x16& p0, f32x16& p1) const {
#pragma unroll
        for (int r = 0; r < 16; ++r) { p0[r] = ((w0 >> crow(r, hi)) & 1u) ? p0[r] : NEG_INF; p1[r] = ((w1 >> crow(r, hi)) & 1u) ? p1[r] : NEG_INF; } } };
__device__ __forceinline__ void dma16(const void* g, LAS unsigned char* l) { __builtin_amdgcn_global_load_lds((const unsigned*)g, (LAS unsigned*)l, 16, 0, 0); }
#define DMA_WAIT_SYNC() do { asm volatile("s_waitcnt vmcnt(0)" ::: "memory"); __syncthreads(); } while (0)

__device__ __forceinline__ void glds16(const void* gsrc, unsigned lds_dst) { unsigned keep;
    asm volatile("s_mov_b32 %0, m0\n\ts_mov_b32 m0, %2\n\ts_nop 0\n\tglobal_load_lds_dwordx4 %1, off\n\ts_mov_b32 m0, %0" : "=&s"(keep) : "v"(gsrc), "s"(lds_dst) : "memory"); }
__device__ __forceinline__ void glds4(const void* gsrc, unsigned lds_dst) { unsigned keep;
    asm volatile("s_mov_b32 %0, m0\n\ts_mov_b32 m0, %2\n\ts_nop 0\n\tglobal_load_lds_dword %1, off\n\ts_mov_b32 m0, %0" : "=&s"(keep) : "v"(gsrc), "s"(lds_dst) : "memory"); }
#define WAITV_BAR(N) asm volatile("s_waitcnt vmcnt(" #N ")\n\ts_barrier" ::: "memory")

template <int MODE>
__device__ __forceinline__ void attn_ab_unit(int b, int h, int qt, const bf16_t* qkv, bf16_t* obuf, const float* kmean, const unsigned* maskg, LAS unsigned char* lds, int tid, int lane, int w) {
    constexpr int CQ = MODE == 0 ? C_QA : C_QB, CK = MODE == 0 ? C_KA : C_KB, CV = MODE == 0 ? C_VA : C_VB;
    constexpr int NS = 4, D = 3, SLOT = 16384;
    const int r32 = lane & 31, hi = lane >> 5;
    const size_t rowbase = (size_t)b * SEQ; const int q0 = 256 * qt, qloc = 32 * w + r32; const size_t qrow = rowbase + q0 + qloc;
    const unsigned lds0 = (unsigned)(size_t)lds;
    LAS float* kml = (LAS float*)(lds + 73728); LAS unsigned* mwl = (LAS unsigned*)(lds + 65536);
    bf16x8 qf[4];
#pragma unroll
    for (int ks = 0; ks < 4; ++ks) qf[ks] = *(const bf16x8*)(qkv + qrow * QP + CQ + 64 * h + 16 * ks + 8 * hi);
    const bf16_t* ksrc = qkv + (rowbase + lane) * QP + CK + 64 * h + 8 * w;
    const bf16_t* vsrc = qkv + (rowbase + 16 * (w & 3) + (lane >> 2)) * QP + CV + 64 * h + 32 * (w >> 2) + 8 * (lane & 3);
    const unsigned* msrc = maskg + qrow * 128 + hi;
    const int NT = 4 * qt + 4, wlim = 4 * qt + (w >> 1);
    const unsigned kdst0 = (unsigned)__builtin_amdgcn_readfirstlane(lds0 + w * 1024), mdst0 = (unsigned)__builtin_amdgcn_readfirstlane(lds0 + 65536 + w * 256);
    __syncthreads();
#pragma unroll
    for (int d = 0; d < D; ++d) { const int t = d < NT ? d : NT - 1;
        glds16(ksrc + (size_t)t * 64 * QP, kdst0 + d * SLOT); glds16(vsrc + (size_t)t * 64 * QP, kdst0 + d * SLOT + 8192);
        if (MODE == 1) glds4(msrc + 2 * t, mdst0 + d * 2048); }
    unsigned selbits = 0;
    if (MODE == 0) {
        if (tid < 256) ((LAS f32x4*)kml)[tid] = ((const f32x4*)(kmean + (size_t)((b * 4 + h) * 16) * 64))[tid];
        __syncthreads();
        if (qt > 0) {
            float qv[32];
#pragma unroll
            for (int ks = 0; ks < 4; ++ks) { const u32x4 qq = __builtin_bit_cast(u32x4, qf[ks]);
#pragma unroll
                for (int k = 0; k < 4; ++k) { qv[8 * ks + 2 * k] = bf_lo(qq[k]); qv[8 * ks + 2 * k + 1] = bf_hi(qq[k]); } }
            float v1 = NEG_INF, v2 = NEG_INF, v3 = NEG_INF; int i1 = -1, i2 = -1, i3 = -1;
#pragma unroll 1
            for (int j = 0; j < qt; ++j) {
                float g = 0.f;
#pragma unroll
                for (int ks = 0; ks < 4; ++ks) { const f32x4 k0 = *(const LAS f32x4*)(kml + j * 64 + 16 * ks + 8 * hi), k1 = *(const LAS f32x4*)(kml + j * 64 + 16 * ks + 8 * hi + 4);
                    g += qv[8 * ks + 0] * k0[0] + qv[8 * ks + 1] * k0[1] + qv[8 * ks + 2] * k0[2] + qv[8 * ks + 3] * k0[3] + qv[8 * ks + 4] * k1[0] + qv[8 * ks + 5] * k1[1] + qv[8 * ks + 6] * k1[2] + qv[8 * ks + 7] * k1[3]; }
                g = sum_xor32(g);
                if (g > v1) { v3 = v2; i3 = i2; v2 = v1; i2 = i1; v1 = g; i1 = j; }
                else if (g > v2) { v3 = v2; i3 = i2; v2 = g; i2 = j; }
                else if (g > v3) { v3 = g; i3 = j; }
            }
            if (i1 >= 0) selbits |= 1u << i1; if (i2 >= 0) selbits |= 1u << i2; if (i3 >= 0) selbits |= 1u << i3;
        }
    }
    const int vboff = (4 * hi + ((lane & 15) >> 2)) * 64 + ((lane >> 4) & 1) * 32 + (lane & 3) * 8;
    float m_run = -1e30f, l_run = 0.f; f32x16 o[2]; o[0] = splat16(0.f); o[1] = splat16(0.f);
    int scur = 0, siss = D;
    asm volatile("s_waitcnt vmcnt(0)" ::: "memory");
    asm volatile("" : "+v"(qf[0]), "+v"(qf[1]), "+v"(qf[2]), "+v"(qf[3]));
#pragma unroll 1
    for (int kt = 0; kt < NT; ++kt) {
        if (MODE == 1) WAITV_BAR(6); else WAITV_BAR(4);
        { const int t = kt + D < NT ? kt + D : NT - 1;
          glds16(ksrc + (size_t)t * 64 * QP, kdst0 + siss * SLOT); glds16(vsrc + (size_t)t * 64 * QP, kdst0 + siss * SLOT + 8192);
          if (MODE == 1) glds4(msrc + 2 * t, mdst0 + siss * 2048); }
        const LAS unsigned char* cur = lds + scur * SLOT;
        if (MODE == 0) {
            const int j = kt >> 2;
            if (j < qt) { const bool sel = (selbits >> j) & 1u; if (__ballot(sel) != 0ull) flash_tile<2>(m_run, l_run, o, cur, cur + 8192, QReg{qf}, MaskLane{sel ? 0.f : NEG_INF}, r32, hi, vboff); }
            else { const int kb0 = 64 * (kt & 3); if (kb0 <= 32 * w + 31) flash_tile<2>(m_run, l_run, o, cur, cur + 8192, QReg{qf}, MaskCausal{kb0, qloc, hi}, r32, hi, vboff); }
        } else {
            if (kt <= wlim) { const LAS unsigned* mp = mwl + scur * 512 + w * 64; const unsigned cw0 = mp[r32], cw1 = mp[32 + r32];
                flash_tile<2>(m_run, l_run, o, cur, cur + 8192, QReg{qf}, MaskBits{cw0, cw1, hi}, r32, hi, vboff); }
        }
        scur = scur + 1 == NS ? 0 : scur + 1; siss = siss + 1 == NS ? 0 : siss + 1;
    }
    asm volatile("s_waitcnt vmcnt(0)" ::: "memory");
    const float inv = 1.0f / sum_xor32(l_run);
    bf16_t* orow = obuf + qrow * 256 + 64 * h;
#pragma unroll
    for (int db = 0; db < 2; ++db)
#pragma unroll
        for (int g = 0; g < 4; ++g)
            *(u32x2*)(orow + 32 * db + 8 * g + 4 * hi) = (u32x2){cvt_pk_bf16(o[db][4 * g] * inv, o[db][4 * g + 1] * inv), cvt_pk_bf16(o[db][4 * g + 2] * inv, o[db][4 * g + 3] * inv)};
}

__device__ __forceinline__ void attn_c_unit(int b, int h, int qt, const bf16_t* qkv, bf16_t* oc, float lam, const float* subg, float coef, LAS unsigned char* lds, int tid, int lane, int w) {
    const int r32 = lane & 31, hi = lane >> 5;
    const size_t rowbase = (size_t)b * SEQ; const int q0 = 256 * qt, qloc = 32 * w + r32; const size_t qrow = rowbase + q0 + qloc;
    LAS unsigned char* qimg = lds + 65536 + w * 8192 + lane * 16;
    __syncthreads();
#pragma unroll
    for (int ks = 0; ks < 4; ++ks) { *(LAS bf16x8*)(qimg + ks * 1024) = *(const bf16x8*)(qkv + qrow * QP + C_Q1 + 64 * h + 16 * ks + 8 * hi); *(LAS bf16x8*)(qimg + 4096 + ks * 1024) = *(const bf16x8*)(qkv + qrow * QP + C_Q2 + 64 * h + 16 * ks + 8 * hi); }
    const bf16_t* k1src = qkv + (rowbase + lane) * QP + C_K1 + 64 * h + 8 * w;
    const bf16_t* k2src = k1src + (C_K2 - C_K1);
    const bf16_t* v0src = qkv + (rowbase + 16 * (w & 3) + (lane >> 2)) * QP + C_VC + 128 * h + 32 * (w >> 2) + 8 * (lane & 3);
    const bf16_t* v1src = v0src + 64;
    const int vboff = (4 * hi + ((lane & 15) >> 2)) * 64 + ((lane >> 4) & 1) * 32 + (lane & 3) * 8;
    const int NT = 4 * qt + 4;
    float m1 = -1e30f, l1 = 0.f, m2 = -1e30f, l2 = 0.f; f32x16 o1[4], o2[4];
#pragma unroll
    for (int i = 0; i < 4; ++i) { o1[i] = splat16(0.f); o2[i] = splat16(0.f); }
    dma16(k1src, lds + w * 1024); dma16(k2src, lds + 8192 + w * 1024); dma16(v0src, lds + 16384 + w * 1024); dma16(v1src, lds + 16384 + 8192 + w * 1024);
    DMA_WAIT_SYNC();
#pragma unroll 1
    for (int kt = 0; kt < NT; ++kt) {
        LAS unsigned char* cur = lds + (kt & 1) * 32768; LAS unsigned char* nxt = lds + ((kt + 1) & 1) * 32768;
        if (kt + 1 < NT) { const size_t adv = (size_t)(kt + 1) * 64 * QP;
            dma16(k1src + adv, nxt + w * 1024); dma16(k2src + adv, nxt + 8192 + w * 1024); dma16(v0src + adv, nxt + 16384 + w * 1024); dma16(v1src + adv, nxt + 16384 + 8192 + w * 1024); }
        const bool band = kt >= 4 * qt; const int kb0 = 64 * (kt & 3);
        if (!band || kb0 <= 32 * w + 31) { const MaskCausalIf mk{band, kb0, qloc, hi};
            flash_tile<4>(m1, l1, o1, cur, cur + 16384, QLds{qimg}, mk, r32, hi, vboff); flash_tile<4>(m2, l2, o2, cur + 8192, cur + 16384, QLds{qimg + 4096}, mk, r32, hi, vboff); }
        DMA_WAIT_SYNC();
    }
    const float i1 = 1.0f / sum_xor32(l1), i2 = lam / sum_xor32(l2);
    float ss = 0.f;
#pragma unroll
    for (int db = 0; db < 4; ++db) { o1[db] = o1[db] * i1 - o2[db] * i2;
#pragma unroll
        for (int r = 0; r < 16; ++r) ss += o1[db][r] * o1[db][r]; }
    ss = sum_xor32(ss);
    const float rn = coef / sqrtf(ss * (1.0f / 128.0f) + EPS);
    bf16_t* orow = oc + qrow * 512 + 128 * h;
#pragma unroll
    for (int db = 0; db < 4; ++db)
#pragma unroll
        for (int g = 0; g < 4; ++g) { const int d = 32 * db + 8 * g + 4 * hi; const f32x4 gg = *(const f32x4*)(subg + d);
            *(u32x2*)(orow + d) = (u32x2){cvt_pk_bf16(o1[db][4 * g] * rn * gg[0], o1[db][4 * g + 1] * rn * gg[1]), cvt_pk_bf16(o1[db][4 * g + 2] * rn * gg[2], o1[db][4 * g + 3] * rn * gg[3])}; }
}

__device__ __forceinline__ void index_unit(int b, int i64, const bf16_t* qkv, unsigned* maskg, unsigned char* scr, LAS unsigned char* lds, int tid, int lane, int w) {
    constexpr int NS = 5, D = 4, HS = 257, RING = 84224, TOFF = 65792, TROW = 144;
    const int r32 = lane & 31, hi = lane >> 5;
    const unsigned lds0 = (unsigned)(size_t)lds;
    LAS unsigned* hist = (LAS unsigned*)lds; LAS unsigned char* ring = lds + RING; LAS unsigned char* mb8 = lds;
    LAS int* thrB1 = (LAS int*)(lds + 125184); LAS int* thrRem = thrB1 + 64; LAS int* thrT = thrB1 + 128; LAS int* thrNeed = thrB1 + 192;
    const size_t rowbase = (size_t)b * SEQ; const int q0 = 64 * i64, NT = i64 + 1;
    __syncthreads();
    {
        const int hh = 4 * ((r32 >> 3) & 1) + (r32 & 3), qp = 2 * (r32 >> 4) + ((r32 >> 2) & 1);
        bf16x8 aq[2][4]; float wv[2][2][8];
#pragma unroll
        for (int rb = 0; rb < 2; ++rb) {
            const size_t row = rowbase + q0 + 8 * w + 4 * rb + qp;
#pragma unroll
            for (int ks = 0; ks < 4; ++ks) aq[rb][ks] = *(const bf16x8*)(qkv + row * QP + C_QI + 64 * hh + 16 * ks + 8 * hi);
#pragma unroll
            for (int hf = 0; hf < 2; ++hf) { const u32x4 ww = *(const u32x4*)(qkv + (rowbase + q0 + 8 * w + 4 * rb + 2 * hf + hi) * QP + C_WI);
#pragma unroll
                for (int k = 0; k < 4; ++k) { wv[rb][hf][2 * k] = bf_lo(ww[k]); wv[rb][hf][2 * k + 1] = bf_hi(ww[k]); } }
        }
#pragma unroll
        for (int rb = 0; rb < 2; ++rb) { asm volatile("" : "+v"(aq[rb][0]), "+v"(aq[rb][1]), "+v"(aq[rb][2]), "+v"(aq[rb][3]));
#pragma unroll
            for (int hf = 0; hf < 2; ++hf) asm volatile("" : "+v"(wv[rb][hf][0]), "+v"(wv[rb][hf][1]), "+v"(wv[rb][hf][2]), "+v"(wv[rb][hf][3]), "+v"(wv[rb][hf][4]), "+v"(wv[rb][hf][5]), "+v"(wv[rb][hf][6]), "+v"(wv[rb][hf][7])); }
        const bf16_t* ksrc = qkv + (rowbase + lane) * QP + C_KI + 8 * w;
        const unsigned kdst0 = (unsigned)__builtin_amdgcn_readfirstlane(lds0 + RING + w * 1024);
#pragma unroll
        for (int d = 0; d < D; ++d) { const int t = d < NT ? d : NT - 1; glds16(ksrc + (size_t)t * 64 * QP, kdst0 + d * 8192); }
        for (int i = tid; i < 4112; i += 512) ((LAS u32x4*)hist)[i] = (u32x4){0u, 0u, 0u, 0u};
        asm volatile("s_waitcnt lgkmcnt(0)" ::: "memory");
        unsigned char* srow = scr + (size_t)lane * 8192 + w * 16;
        int scur = 0, siss = D;
#pragma unroll 1
        for (int kt = 0; kt <= NT; ++kt) {
            if (kt < NT) WAITV_BAR(3); else { asm volatile("s_waitcnt vmcnt(0)" ::: "memory"); __syncthreads(); }
            if (kt > 0) {
                const u32x4 kk = *(const LAS u32x4*)(lds + TOFF + ((kt - 1) & 1) * 9216 + lane * TROW + w * 16);
                if (kt < NT) asm volatile("global_store_dwordx4 %0, %1, off" :: "v"(srow + (size_t)(kt - 1) * 128), "v"(kk) : "memory");
                else *(u32x4*)(srow + (size_t)(kt - 1) * 128) = kk;
#pragma unroll
                for (int k = 0; k < 4; ++k) { const unsigned a = kk[k] & 0xffffu, c = kk[k] >> 16;
                    if (a) __hip_atomic_fetch_add(&hist[lane * HS + (a >> 8)], 1u, __ATOMIC_RELAXED, __HIP_MEMORY_SCOPE_WORKGROUP);
                    if (c) __hip_atomic_fetch_add(&hist[lane * HS + (c >> 8)], 1u, __ATOMIC_RELAXED, __HIP_MEMORY_SCOPE_WORKGROUP); }
            }
            if (kt == NT) break;
            { const int t = kt + D < NT ? kt + D : NT - 1; glds16(ksrc + (size_t)t * 64 * QP, kdst0 + siss * 8192); }
            const LAS unsigned char* kimg = ring + scur * 8192;
            const bool diag = kt == NT - 1;
#pragma unroll
            for (int rb = 0; rb < 2; ++rb)
#pragma unroll
                for (int kb = 0; kb < 2; ++kb) {
                    f32x16 d = splat16(0.f);
#pragma unroll
                    for (int ks = 0; ks < 4; ++ks) d = mfma32(aq[rb][ks], *(const LAS bf16x8*)(kimg + (2 * ks + hi) * 1024 + (32 * kb + r32) * 16), d);
#pragma unroll
                    for (int hf = 0; hf < 2; ++hf) {
                        float sc = 0.f;
#pragma unroll
                        for (int t = 0; t < 8; ++t) sc += wv[rb][hf][t] * fmaxf(d[8 * hf + t], 0.f);
                        const int ql = 8 * w + 4 * rb + 2 * hf + hi;
                        const unsigned u = (unsigned)__builtin_bit_cast(unsigned short, (_Float16)sc);
                        unsigned key = u ^ ((u & 0x8000u) ? 0xffffu : 0x8000u);
                        if (diag && 32 * kb + r32 > ql) key = 0u;
                        *(LAS unsigned short*)(lds + TOFF + (kt & 1) * 9216 + ql * TROW + (32 * kb + r32) * 2) = (unsigned short)key;
                    }
                }
            scur = scur + 1 == NS ? 0 : scur + 1; siss = siss + 1 == NS ? 0 : siss + 1;
        }
        asm volatile("s_waitcnt vmcnt(0)" ::: "memory");
        __syncthreads();
    }
#define IDX_SEARCH(STAGE) do { _Pragma("unroll 1") for (int qq = 0; qq < 8; ++qq) { const int q = 8 * w + qq; int target; \
        if (STAGE == 0) { if (q0 + q + 1 <= 256) { if (lane == 0) { thrB1[q] = 0x10000; thrRem[q] = 0; } continue; } target = 256; } \
        else { if (thrB1[q] == 0x10000) { if (lane == 0) { thrT[q] = 0; thrNeed[q] = 0; } continue; } target = thrRem[q]; } \
        const LAS unsigned* hp = hist + q * HS + 4 * lane; const int h0 = (int)hp[0], h1 = (int)hp[1], h2 = (int)hp[2], h3 = (int)hp[3]; \
        int P = h0 + h1 + h2 + h3; const int s_ = P; \
        _Pragma("unroll") for (int o = 1; o < 64; o <<= 1) { const int t_ = lane_val(P, (lane - o) & 63); if (lane >= o) P += t_; } \
        const int above = __builtin_amdgcn_readlane(P, 63) - P; (void)s_; \
        const int c3 = above + h3, c2 = c3 + h2, c1 = c2 + h1, c0 = c1 + h0; int bin = -1, ab = 0; \
        if (above < target && c3 >= target) { bin = 4 * lane + 3; ab = above; } else if (c3 < target && c2 >= target) { bin = 4 * lane + 2; ab = c3; } \
        else if (c2 < target && c1 >= target) { bin = 4 * lane + 1; ab = c2; } else if (c1 < target && c0 >= target) { bin = 4 * lane; ab = c1; } \
        if (bin >= 0) { if (STAGE == 0) { thrB1[q] = bin; thrRem[q] = target - ab; } else { thrT[q] = (thrB1[q] << 8) | bin; thrNeed[q] = target - ab; } } } \
        __syncthreads(); } while (0)
    IDX_SEARCH(0);
    const int qs = 8 * w + (lane >> 3), pc = lane & 7;
    const unsigned char* rrow = scr + (size_t)qs * 8192 + pc * 16;
    {
        const int b1 = thrB1[qs];
        for (int i = tid; i < 4112; i += 512) ((LAS u32x4*)hist)[i] = (u32x4){0u, 0u, 0u, 0u};
        __syncthreads();
#pragma unroll 4
        for (int it = 0; it < NT; ++it) { const u32x4 kk = *(const u32x4*)(rrow + (size_t)it * 128);
#pragma unroll
            for (int k = 0; k < 4; ++k) { const unsigned a = kk[k] & 0xffffu, c = kk[k] >> 16;
                if ((int)(a >> 8) == b1) __hip_atomic_fetch_add(&hist[qs * HS + (a & 255u)], 1u, __ATOMIC_RELAXED, __HIP_MEMORY_SCOPE_WORKGROUP);
                if ((int)(c >> 8) == b1) __hip_atomic_fetch_add(&hist[qs * HS + (c & 255u)], 1u, __ATOMIC_RELAXED, __HIP_MEMORY_SCOPE_WORKGROUP); } }
        __syncthreads();
    }
    IDX_SEARCH(1);
    {
        const unsigned T = (unsigned)thrT[qs]; const int need = thrNeed[qs]; int tc = 0;
        __syncthreads();
#pragma unroll 2
        for (int it = 0; it < NT; ++it) { const u32x4 kk = *(const u32x4*)(rrow + (size_t)it * 128);
            unsigned sel = 0, eq = 0;
#pragma unroll
            for (int k = 0; k < 4; ++k) { const unsigned a = kk[k] & 0xffffu, c = kk[k] >> 16;
                sel |= (a > T ? 1u : 0u) << (2 * k); sel |= (c > T ? 1u : 0u) << (2 * k + 1); eq |= (a == T ? 1u : 0u) << (2 * k); eq |= (c == T ? 1u : 0u) << (2 * k + 1); }
            if (T == 0u) eq = 0u;
            if (__ballot(eq != 0u) != 0ull) {
                const int n = __popc(eq); int P = n;
#pragma unroll
                for (int o = 1; o < 8; o <<= 1) { const int t_ = lane_val(P, (lane - o) & 63); if ((lane & 7) >= o) P += t_; }
                int allow = need - tc - (P - n);
#pragma unroll
                for (int k = 0; k < 8; ++k) if (((eq >> k) & 1u) && allow > 0) { sel |= 1u << k; --allow; }
                tc += lane_val(P, (lane & ~7) + 7);
            }
            mb8[qs * 512 + it * 8 + pc] = (unsigned char)sel;
        }
        __syncthreads();
    }
#undef IDX_SEARCH
    for (int idx = tid; idx < 64 * 2 * NT; idx += 512) { const int q = idx / (2 * NT), wd = idx - q * 2 * NT; maskg[(rowbase + q0 + q) * 128 + wd] = ((const LAS unsigned*)mb8)[q * 128 + wd]; }
}

__device__ __forceinline__ int next_unit(unsigned* ctr, LAS unsigned char* lds, int tid) {
    volatile LAS int* bc = (volatile LAS int*)(lds + LX_BC);
    __syncthreads();
    if (tid == 0) *bc = (int)__hip_atomic_fetch_add(ctr, 1u, __ATOMIC_RELAXED, __HIP_MEMORY_SCOPE_AGENT);
    __syncthreads();
    return *bc;
}

__device__ __forceinline__ void m1_phase(const Args& a, unsigned char* ws, int lc, LAS unsigned char* lds, int lane, int wave, int vcu, int G) {
    const int l = lc & 1;
    const float* wrt = (const float*)(ws + WS_WRT);
    const float* bg = a.in[I_B_GROUP] + l * 4; const float* br = a.in[I_B_ROUTER] + l * 32;
    unsigned* cnt = (unsigned*)(ws + WS_CTL) + CW_CNT + 2048 * lc;
    unsigned* rt0 = (unsigned*)(ws + WS_RT0); unsigned* rt1 = (unsigned*)(ws + WS_RT1); f32x2* rtw = (f32x2*)(ws + WS_RTW);
    const int r32 = lane & 31, kh = lane >> 5, wq = wave & 3, kpart = wave >> 2;
    LAS float* tl = (LAS float*)(lds + wq * 8192);
    LAS float* tss = tl + 32 * 40;
#pragma unroll 1
    for (int t = wq * G + vcu; t < MTOK / 32; t += 4 * G) {
        const float* xrow = a.out + (size_t)(32 * t + r32) * DM + 512 * kpart + 4 * kh;
        const float* wp0 = wrt + (size_t)r32 * DM + 512 * kpart + 4 * kh; const float* wp1 = wrt + (size_t)(32 + (r32 & 3)) * DM + 512 * kpart + 4 * kh;
        f32x16 d0 = splat16(0.f), d1 = splat16(0.f); float ss = 0.f;
#pragma unroll 8
        for (int m = 0; m < 64; ++m) {
            const f32x4 xa = *(const f32x4*)(xrow + 8 * m), b0 = *(const f32x4*)(wp0 + 8 * m), b1 = *(const f32x4*)(wp1 + 8 * m);
            ss += (xa[0] * xa[0] + xa[1] * xa[1]) + (xa[2] * xa[2] + xa[3] * xa[3]);
#pragma unroll
            for (int i = 0; i < 4; ++i) { d0 = __builtin_amdgcn_mfma_f32_32x32x2f32(xa[i], b0[i], d0, 0, 0, 0); d1 = __builtin_amdgcn_mfma_f32_32x32x2f32(xa[i], b1[i], d1, 0, 0, 0); }
        }
        ss = sum_xor32(ss);
        if (kpart == 1) {
#pragma unroll
            for (int r = 0; r < 16; ++r) { tl[crow(r, kh) * 40 + r32] = d0[r]; if (r32 < 4) tl[crow(r, kh) * 40 + 32 + r32] = d1[r]; }
            if (kh == 0) tss[r32] = ss;
        }
        __syncthreads();
        if (kpart == 0) {
#pragma unroll
            for (int r = 0; r < 16; ++r) { tl[crow(r, kh) * 40 + r32] += d0[r]; if (r32 < 4) tl[crow(r, kh) * 40 + 32 + r32] += d1[r]; }
            ss += tss[r32];
            LDS_WAIT(); asm volatile("" ::: "memory");
            const float rstd = 1.0f / sqrtf(ss * (1.0f / DM) + EPS);
            const LAS float* my = tl + r32 * 40;
            float gl[4];
#pragma unroll
            for (int c = 0; c < 4; ++c) gl[c] = my[c] * rstd + bg[c];
            int g = 0; float gm = gl[0];
#pragma unroll
            for (int c = 1; c < 4; ++c) if (gl[c] > gm) { gm = gl[c]; g = c; }
            float den = 0.f;
#pragma unroll
            for (int c = 0; c < 4; ++c) den += __expf(gl[c] - gm);
            const float gwt = 1.0f / den;
            float le[8];
#pragma unroll
            for (int e = 0; e < 8; ++e) le[e] = my[4 + 8 * g + e] * rstd + br[8 * g + e];
            int i1 = 0; float v1 = le[0];
#pragma unroll
            for (int e = 1; e < 8; ++e) if (le[e] > v1) { v1 = le[e]; i1 = e; }
            int i2 = -1; float v2 = NEG_INF;
#pragma unroll
            for (int e = 0; e < 8; ++e) if (e != i1 && le[e] > v2) { v2 = le[e]; i2 = e; }
            const float ex = __expf(v2 - v1), w1 = 1.0f / (1.0f + ex), w2 = ex * w1;
            if (kh == 0) { const int e0 = g * 8 + i1, e1 = g * 8 + i2, m = 32 * t + r32;
                const unsigned r0 = atomicAdd(cnt + 64 * e0, 1u), r1 = atomicAdd(cnt + 64 * e1, 1u);
                rt0[m] = ((unsigned)e0 << 24) | r0; rt1[m] = ((unsigned)e1 << 24) | r1; rtw[m] = (f32x2){gwt * w1, gwt * w2}; }
        }
        __syncthreads();
    }
}
__device__ __forceinline__ void build_tables(const unsigned* cnt, LAS unsigned char* lds, int tid) {
    LAS int* pstart = (LAS int*)(lds + LX_PSTART); LAS int* blk2e = (LAS int*)(lds + LX_BLK2E);
    if (tid < 64) {
        const int c = tid < NEXP ? (int)cnt[64 * tid] : 0, nb = (c + 255) >> 8;
        int P = nb;
#pragma unroll
        for (int o = 1; o < 64; o <<= 1) { const int t = lane_val(P, (tid - o) & 63); if (tid >= o) P += t; }
        const int pb = P - nb;
        if (tid <= NEXP) pstart[tid] = pb * 256;
        if (tid == NEXP) *(LAS int*)(lds + LX_NBLK) = pb < MAXBLK ? pb : MAXBLK;
#pragma unroll 1
        for (int k = 0; k < nb; ++k) if (pb + k < MAXBLK) blk2e[pb + k] = tid;
    }
    __syncthreads();
}
__device__ __forceinline__ void m2_phase(const Args& a, unsigned char* ws, int l, LAS unsigned char* lds, int lane, int wave, int vcu, int G) {
    const int gw = vcu * 8 + wave, NGW = G * 8;
    const float* gain = a.in[I_NORM_FFN] + (size_t)l * DM; const LAS int* pstart = (const LAS int*)(lds + LX_PSTART);
    const unsigned* rt0 = (const unsigned*)(ws + WS_RT0); const unsigned* rt1 = (const unsigned*)(ws + WS_RT1); bf16_t* xb = (bf16_t*)(ws + WS_XB);
    for (int m = gw; m < MTOK; m += NGW) {
        f32x4 v[4]; float ss = 0.f;
#pragma unroll
        for (int j = 0; j < 4; ++j) { v[j] = ((const f32x4*)(a.out + (size_t)m * DM))[lane + 64 * j]; ss += (v[j][0] * v[j][0] + v[j][1] * v[j][1]) + (v[j][2] * v[j][2] + v[j][3] * v[j][3]); }
        const float rstd = 1.0f / sqrtf(wave_sum(ss) * (1.0f / DM) + EPS);
        const unsigned ua = rt0[m], ub = rt1[m];
        const size_t s0 = (size_t)(pstart[ua >> 24] + (int)(ua & 0xffffffu)), s1 = (size_t)(pstart[ub >> 24] + (int)(ub & 0xffffffu));
#pragma unroll
        for (int j = 0; j < 4; ++j) { const f32x4 o = v[j] * rstd * ((const f32x4*)gain)[lane + 64 * j]; const u32x2 pk = (u32x2){cvt_pk_bf16(o[0], o[1]), cvt_pk_bf16(o[2], o[3])};
            ((u32x2*)(xb + s0 * DM))[lane + 64 * j] = pk; ((u32x2*)(xb + s1 * DM))[lane + 64 * j] = pk; }
    }
}

#ifndef PHASES
#define PHASES 0xFFFF
#endif
#define PH(n) if constexpr (((PHASES) >> (n)) & 1)
#ifndef REPEAT_MASK
#define REPEAT_MASK 0
#endif
#define REP(k) for (int rep_ = 0; rep_ < 1 + (((REPEAT_MASK) >> (k)) & 1); ++rep_)
#ifndef GEMM_ALIGN
#define GEMM_ALIGN true
#endif
#ifndef GEMM_SP2
#define GEMM_SP2 true
#endif
#define PHASE_ENV() unsigned long long wsi_ = (unsigned long long)args.ws; int G = (int)gridDim.x, bx = (int)blockIdx.x; asm volatile("" : "+s"(wsi_), "+s"(G), "+s"(bx)); \
    unsigned char* const ws = (unsigned char*)(GAS unsigned char*)wsi_; const int vcu = (G % 8 == 0) ? (bx % 8) * (G / 8) + bx / 8 : bx;   \
    int tid = (int)threadIdx.x; asm volatile("" : "+v"(tid)); const int lane = tid & 63, wave = __builtin_amdgcn_readfirstlane(tid >> 6); \
    unsigned* const ctl = (unsigned*)(ws + WS_CTL); bf16_t* const QKV = (bf16_t*)(ws + WS_QKV); unsigned char* const SG = ws + WS_SG; unsigned* const MASK = (unsigned*)(ws + WS_MASK); float* const KMEAN = (float*)(ws + WS_KMEAN); \
    (void)lane; (void)wave; (void)ctl; (void)QKV; (void)SG; (void)MASK; (void)KMEAN; (void)vcu
#define GRID_BAR() do { unsigned long long wb_ = (unsigned long long)args.ws; asm volatile("" : "+s"(wb_)); XcdBarrier b_ = bar0; b_.bar = (unsigned*)((GAS unsigned char*)wb_ + WS_CTL) + CW_BAR; asm volatile("" : "+s"(b_.x)); xcd_barrier(b_); if (((REPEAT_MASK) >> 12) & 1) xcd_barrier(b_); } while (0)


template <int L> __device__ __forceinline__ void layer_body(const Args& args, LAS unsigned char* lds, const XcdBarrier& bar0) {
    constexpr int l = L;

        PH(0) for (int rep_ = 0; rep_ < 1 + ((((REPEAT_MASK) >> 0) & 1) && l == 0); ++rep_) { PHASE_ENV(); p0_phase(args, ws, l, lds, tid, lane, wave, vcu, G); }
        GRID_BAR();
        PH(1) REP(1) { PHASE_ENV();
            pg8::Gemm g{(const bf16_t*)(ws + WS_HN), (const bf16_t*)(ws + WS_WIN), MTOK, NT_IN * 256, DM}; pg8::StaticOrder S; S.init(MTOK, NT_IN * 256, G, bx);
            pg8::EpiInProj E{QKV, SG, (const float*)(ws + WS_COS), (const float*)(ws + WS_SIN), args.in[I_QK_GAIN] + l * 6 * 64, args.in[I_IDX_K_GAIN] + l * 64};
            pg8::gemm_phase<pg8::EpiInProj, pg8::StaticOrder, GEMM_ALIGN, GEMM_SP2>(lds, g, S, E);
        }
        GRID_BAR();
        { PHASE_ENV();
            LAS float* red = (LAS float*)lds;
            for (int it = bx; it < NBATCH * 4 * 16; it += G) { const int b = it >> 6, h = (it >> 4) & 3, blk = it & 15, d = tid & 63, rg = tid >> 6;
                const bf16_t* kp = QKV + ((size_t)b * SEQ + blk * 256 + rg * 32) * QP + C_KA + 64 * h + d; float s = 0.f;
#pragma unroll 8
                for (int r = 0; r < 32; ++r) s += __builtin_bit_cast(float, (unsigned)kp[(size_t)r * QP] << 16);
                __syncthreads(); red[tid] = s; __syncthreads();
                if (tid < 64) { float t = 0.f;
#pragma unroll
                    for (int k = 0; k < 8; ++k) t += red[k * 64 + tid];
                    KMEAN[(size_t)it * 64 + tid] = t * (1.0f / 256.0f); } }
            __syncthreads();
        }
        PH(2) REP(2) { PHASE_ENV();
            const float* dl = args.in[I_DIFF_LAMBDA] + l * 256;
            const float lam_init = 0.8f - 0.6f * __expf(-0.3f * (float)l);
            const float lam = __expf(wave_sum(dl[lane] * dl[64 + lane])) - __expf(wave_sum(dl[128 + lane] * dl[192 + lane])) + lam_init;
            const float* subg = args.in[I_DIFF_SUBLN] + l * 128;
            unsigned* qc = ctl + CW_QUEUE + 64 * (l * 4 + 0 + 8 * rep_);
            for (;;) { const int u = next_unit(qc, lds, tid); if (u >= 512) break; const int r = u & 31; attn_c_unit(r >> 2, r & 3, 15 - (u >> 5), QKV, (bf16_t*)(ws + WS_OC), lam, subg, 1.0f - lam_init, lds, tid, lane, wave); }
        }
        PH(3) REP(3) { PHASE_ENV();
            unsigned* qi = ctl + CW_QUEUE + 64 * (l * 4 + 1 + 8 * rep_);
            for (;;) { const int u = next_unit(qi, lds, tid); if (u >= 512) break; index_unit(u & 7, 63 - (u >> 3), QKV, MASK, ws + WS_WGU + (size_t)bx * 524288, lds, tid, lane, wave); }
        }
        GRID_BAR();
        PH(4) REP(4) { PHASE_ENV();
            unsigned* qa = ctl + CW_QUEUE + 64 * (l * 4 + 2 + 8 * rep_);
            for (;;) { const int u = next_unit(qa, lds, tid); if (u >= 512) break; const int r = u & 31; attn_ab_unit<0>(r >> 2, r & 3, 15 - (u >> 5), QKV, (bf16_t*)(ws + WS_OA), KMEAN, MASK, lds, tid, lane, wave); }
        }
        PH(5) REP(5) { PHASE_ENV();
            unsigned* qb = ctl + CW_QUEUE + 64 * (l * 4 + 3 + 8 * rep_);
            for (;;) { const int u = next_unit(qb, lds, tid); if (u >= 512) break; const int r = u & 31; attn_ab_unit<1>(r >> 2, r & 3, 15 - (u >> 5), QKV, (bf16_t*)(ws + WS_OB), KMEAN, MASK, lds, tid, lane, wave); }
        }
        GRID_BAR();
        PH(6) REP(6) {
            { PHASE_ENV(); pg8::StaticOrder S; S.init(MTOK, DM, G, bx); pg8::Gemm g{(const bf16_t*)(ws + WS_OA), (const bf16_t*)(ws + WS_WPA), MTOK, DM, 256}; pg8::EpiMerge<0> E{(bf16_t*)(ws + WS_MERGED), SG}; pg8::gemm_phase<pg8::EpiMerge<0>, pg8::StaticOrder, GEMM_ALIGN, GEMM_SP2>(lds, g, S, E); }
            { PHASE_ENV(); pg8::StaticOrder S; S.init(MTOK, DM, G, bx); pg8::Gemm g{(const bf16_t*)(ws + WS_OB), (const bf16_t*)(ws + WS_WPB), MTOK, DM, 256}; pg8::EpiMerge<1> E{(bf16_t*)(ws + WS_MERGED), SG}; pg8::gemm_phase<pg8::EpiMerge<1>, pg8::StaticOrder, GEMM_ALIGN, GEMM_SP2>(lds, g, S, E); }
            { PHASE_ENV(); pg8::StaticOrder S; S.init(MTOK, DM, G, bx); pg8::Gemm g{(const bf16_t*)(ws + WS_OC), (const bf16_t*)(ws + WS_WPC), MTOK, DM, 512}; pg8::EpiMerge<2> E{(bf16_t*)(ws + WS_MERGED), SG}; pg8::gemm_phase<pg8::EpiMerge<2>, pg8::StaticOrder, GEMM_ALIGN, GEMM_SP2>(lds, g, S, E); }
        }
        GRID_BAR();
        PH(7) for (int rep_ = 0; rep_ < 1 + ((((REPEAT_MASK) >> 7) & 1) && l == 0); ++rep_) { PHASE_ENV();
            pg8::Gemm g{(const bf16_t*)(ws + WS_MERGED), (const bf16_t*)(ws + WS_WO), MTOK, DM, DM}; pg8::StaticOrder S; S.init(MTOK, DM, G, bx);
            pg8::EpiResid E{l == 0 ? args.in[I_X] : args.out, args.out};
            pg8::gemm_phase<pg8::EpiResid, pg8::StaticOrder, GEMM_ALIGN, GEMM_SP2>(lds, g, S, E);
        }
        GRID_BAR();
        PH(8) REP(8) { PHASE_ENV(); m1_phase(args, ws, l + 2 * rep_, lds, lane, wave, vcu, G); if (rep_ == 0) convert_weights<true>(args, ws, l, lds, lane, wave, vcu, G); }
        GRID_BAR();
        { PHASE_ENV(); build_tables(ctl + CW_CNT + 2048 * (l + 2 * (((REPEAT_MASK) >> 8) & 1)), lds, tid);
          PH(9) REP(9) m2_phase(args, ws, l, lds, lane, wave, vcu, G); }
        GRID_BAR();
        PH(10) REP(10) { PHASE_ENV();
            const int nblk = *(const LAS int*)(lds + LX_NBLK);
            pg8::Gemm g{(const bf16_t*)(ws + WS_XB), (const bf16_t*)(ws + WS_WGU), MAXBLK * 256, NEXP * 1024, DM};
            pg8::MoeOrder S{nblk * 4, G, vcu, (const LAS int*)(lds + LX_BLK2E)};
            pg8::EpiGateUp E{(bf16_t*)(ws + WS_HID)};
            pg8::gemm_phase<pg8::EpiGateUp, pg8::MoeOrder, GEMM_ALIGN, GEMM_SP2>(lds, g, S, E);
        }
        GRID_BAR();
        PH(11) REP(11) { PHASE_ENV();
            const int nblk = *(const LAS int*)(lds + LX_NBLK);
            pg8::Gemm g{(const bf16_t*)(ws + WS_HID), (const bf16_t*)(ws + WS_WD), MAXBLK * 256, NEXP * 1024, DEXP};
            pg8::MoeOrder S{nblk * 4, G, vcu, (const LAS int*)(lds + LX_BLK2E)};
            pg8::EpiDown E{(bf16_t*)(ws + WS_Y)};
            pg8::gemm_phase<pg8::EpiDown, pg8::MoeOrder, GEMM_ALIGN, GEMM_SP2>(lds, g, S, E);
        }
        GRID_BAR();
    }

__global__ void __launch_bounds__(512, 2) fwd_kernel(Args args) {
    extern __shared__ __attribute__((aligned(16))) unsigned char lds_raw[];
    LAS unsigned char* lds = (LAS unsigned char*)lds_raw;
    for (int u = threadIdx.x; u < (LDS_BYTES - LDSX) / 4; u += 512) ((LAS unsigned*)(lds + LDSX))[u] = 0u;
    __syncthreads();
    const XcdBarrier bar0 = xcd_barrier_post((unsigned*)(args.ws + WS_CTL) + CW_BAR, (volatile LAS unsigned*)(lds + LX_BAR));
    layer_body<0>(args, lds, bar0);
    layer_body<1>(args, lds, bar0);
    { PHASE_ENV();
        const int gw = vcu * 8 + wave, NGW = G * 8; const LAS int* pstart = (const LAS int*)(lds + LX_PSTART);
        for (int m = gw; m < MTOK; m += NGW) token_row<true, false>(args.out, args.out, (const bf16_t*)(ws + WS_Y), (const unsigned*)(ws + WS_RT0), (const unsigned*)(ws + WS_RT1), (const f32x2*)(ws + WS_RTW), pstart, nullptr, nullptr, m, lane);
    }
}

extern "C" void kernel_launch(void* const* d_in, const int* in_sizes, int n_in, void* d_out, int out_size, void* d_ws, size_t ws_size, hipStream_t stream) {
    static int grid = 0;
    if (grid == 0) {
        if (n_in != N_INPUTS || in_sizes[0] != MTOK * DM || out_size != MTOK * DM || ws_size < WS_END) {
            fprintf(stderr, "kernel_launch: built for %d inputs, x/out of %d floats, >= %zu bytes of workspace; got n_in %d, in0 %d, out %d, ws %zu; nothing launched\n", (int)N_INPUTS, MTOK * DM, (size_t)WS_END, n_in, n_in > 0 ? in_sizes[0] : -1, out_size, ws_size);
            grid = -1; return; }
        int dev = 0, cus = 0;
        if (hipGetDevice(&dev) != hipSuccess || hipDeviceGetAttribute(&cus, hipDeviceAttributeMultiprocessorCount, dev) != hipSuccess) { fprintf(stderr, "kernel_launch: device query failed\n"); grid = -1; return; }
        if (hipFuncSetAttribute((const void*)fwd_kernel, hipFuncAttributeMaxDynamicSharedMemorySize, LDS_BYTES) != hipSuccess) { fprintf(stderr, "kernel_launch: hipFuncSetAttribute failed\n"); grid = -1; return; }
        int per_cu = 0;
        if (hipOccupancyMaxActiveBlocksPerMultiprocessor(&per_cu, (const void*)fwd_kernel, 512, LDS_BYTES) != hipSuccess || per_cu < 1) fprintf(stderr, "kernel_launch: note: occupancy query reports %d workgroups per CU\n", per_cu);
        (void)hipGetLastError();
        grid = cus;
    }
    if (grid < 0) return;
    if (hipMemsetAsync((char*)d_ws + WS_CTL, 0, CTL_BYTES, stream) != hipSuccess) { fprintf(stderr, "kernel_launch: memset failed\n"); return; }
    Args a{};
    for (int i = 0; i < N_INPUTS; ++i) a.in[i] = (const float*)d_in[i];
    a.out = (float*)d_out; a.ws = (unsigned char*)d_ws;
    hipLaunchKernelGGL(fwd_kernel, dim3(grid), dim3(512), LDS_BYTES, stream, a);
    const hipError_t le = hipPeekAtLastError();
    if (le != hipSuccess) fprintf(stderr, "kernel_launch: launch failed: %s\n", hipGetErrorName(le));
}
```

```cpp
#include <hip/hip_runtime.h>
#include <cstdio>
#include <cstdint>

#define LAS __attribute__((address_space(3)))
#define GAS __attribute__((address_space(1)))
typedef unsigned short bf16_t;
typedef short bf16x8 __attribute__((ext_vector_type(8)));
typedef short s16x4 __attribute__((ext_vector_type(4)));
typedef float f32x4 __attribute__((ext_vector_type(4)));
typedef float f32x2 __attribute__((ext_vector_type(2)));
typedef float f32x16 __attribute__((ext_vector_type(16)));
typedef unsigned u32x4 __attribute__((ext_vector_type(4)));
typedef unsigned u32x2 __attribute__((ext_vector_type(2)));

constexpr int NBATCH = 8, SEQ = 4096, MTOK = NBATCH * SEQ, DM = 1024, NLAYER = 2;
constexpr int QP = 3656;
constexpr int C_QA = 0, C_KA = 256, C_VA = 512, C_QB = 768, C_KB = 1024, C_VB = 1280, C_QI = 1536, C_KI = 2048, C_WI = 2112,
              C_Q1 = 2120, C_Q2 = 2376, C_K1 = 2632, C_K2 = 2888, C_VC = 3144, C_G = 3656, D_IN = 6728;
constexpr int NT_IN = 27;
constexpr int NEXP = 32, DEXP = 512, MAXBLK = 288;
constexpr float C2 = 0.125f * 1.4426950408889634f;
constexpr float EPS = 1e-6f;
#ifndef REF0_ENABLE
#define REF0_ENABLE 1
#endif

constexpr size_t MiB = 1u << 20;
constexpr size_t WS_CTL = 0, CTL_BYTES = 1 * MiB;
constexpr size_t WS_COS = 1 * MiB, WS_SIN = WS_COS + 512 * 1024;
constexpr size_t WS_SMALL = 2 * MiB;
constexpr size_t WS_KMEAN = WS_SMALL, WS_RT0 = WS_SMALL + 256 * 1024, WS_RT1 = WS_SMALL + 384 * 1024, WS_RTW = WS_SMALL + 512 * 1024, WS_WRT = WS_SMALL + 768 * 1024;
constexpr size_t WS_WIN = 3 * MiB;
constexpr size_t WS_WPA = 17 * MiB, WS_WPB = WS_WPA + 512 * 1024, WS_WPC = 18 * MiB;
constexpr size_t WS_WO = 19 * MiB;
constexpr size_t WS_WGU = 21 * MiB;
constexpr size_t WS_WD = 85 * MiB;
constexpr size_t WS_HN = 117 * MiB;
constexpr size_t WS_OA = WS_HN, WS_OB = WS_HN + 16 * MiB, WS_OC = WS_HN + 32 * MiB;
constexpr size_t WS_QKV = 181 * MiB;
constexpr size_t WS_MERGED = WS_QKV, WS_XB = WS_QKV, WS_Y = WS_QKV, WS_HID = WS_QKV + 144 * MiB;
constexpr size_t WS_SG = 410 * MiB;
constexpr size_t WS_MASK = 506 * MiB;
constexpr size_t WS_END = 522 * MiB;
static_assert((size_t)MTOK * QP * 2 <= 229 * MiB && (size_t)MAXBLK * 256 * 1024 * 2 <= 144 * MiB && (size_t)MAXBLK * 256 * 512 * 2 <= 72 * MiB, "ws map");
constexpr int CW_BAR = 4096;
constexpr int CW_QUEUE = 8192;
constexpr int CW_CNT = 16384;

constexpr int LDSX = 131072;
constexpr int LX_BAR = LDSX, LX_BC = LDSX + 16, LX_NBLK = LDSX + 32, LX_PSTART = LDSX + 64, LX_BLK2E = LDSX + 256;
constexpr int LDS_BYTES = 147456;

typedef __bf16 bf16x2_t __attribute__((ext_vector_type(2)));
__device__ __forceinline__ unsigned cvt_pk_bf16(float lo, float hi) { const f32x2 v = {lo, hi}; const bf16x2_t b = __builtin_convertvector(v, bf16x2_t); return __builtin_bit_cast(unsigned, b); }
__device__ __forceinline__ float bf_lo(unsigned w) { return __builtin_bit_cast(float, w << 16); }
__device__ __forceinline__ float bf_hi(unsigned w) { return __builtin_bit_cast(float, w & 0xffff0000u); }
template <int M> __device__ __forceinline__ float xor_lane(float v) {
    return __builtin_bit_cast(float, __builtin_amdgcn_ds_swizzle(__builtin_bit_cast(int, v), (M << 10) | 0x1f)); }
__device__ __forceinline__ float sum_xor32(float v) {
    const unsigned u = __builtin_bit_cast(unsigned, v); const auto rr = __builtin_amdgcn_permlane32_swap(u, u, false, false);
    return __builtin_bit_cast(float, (unsigned)rr[0]) + __builtin_bit_cast(float, (unsigned)rr[1]); }
__device__ __forceinline__ float max_xor32(float v) {
    const unsigned u = __builtin_bit_cast(unsigned, v); const auto rr = __builtin_amdgcn_permlane32_swap(u, u, false, false);
    return fmaxf(__builtin_bit_cast(float, (unsigned)rr[0]), __builtin_bit_cast(float, (unsigned)rr[1])); }
__device__ __forceinline__ int lane_val(int v, int src_lane) { return __builtin_amdgcn_ds_bpermute(src_lane << 2, v); }
__device__ __forceinline__ float wave_sum(float v) {
    v += xor_lane<1>(v); v += xor_lane<2>(v); v += xor_lane<4>(v); v += xor_lane<8>(v); v += xor_lane<16>(v);
    return sum_xor32(v);
}
__device__ __forceinline__ float fast_exp2(float x) { return __builtin_amdgcn_exp2f(x); }
__device__ __forceinline__ float fast_rcp(float x) { return __builtin_amdgcn_rcpf(x); }

namespace pg8 {
#define PG8_LAS __attribute__((address_space(3)))
typedef unsigned short bf16_t;
typedef short bf16x8 __attribute__((ext_vector_type(8)));
typedef float f32x4 __attribute__((ext_vector_type(4)));
typedef unsigned u32x4 __attribute__((ext_vector_type(4)));
constexpr int BM = 256, BK = 64, HALF = 128, HTB = HALF * BK * 2  , STAGE_BYTES = 8 * HTB, NXCD = 8, WGM = 8;

__host__ __device__ __forceinline__ int lds_byte(int r, int c) { const int st = (r >> 4) * 2 + (c >> 5), rr = r & 15, cc = c & 31, ob = rr * 64 + cc * 2; return st * 1024 + (ob ^ (((ob >> 9) & 1) << 5)); }
__host__ __device__ __forceinline__ void stage_rc(int b, int& R, int& C) { const int st = b / 1024, sb = b % 1024, swz = sb ^ (((sb >> 9) & 1) << 5); R = (st >> 1) * 16 + swz / 64; C = (st & 1) * 32 + (swz % 64) / 2; }
__host__ __device__ __forceinline__ int perm32(int rho) { const int n = rho >> 4, i = rho & 15; return 8 * (i >> 2) + 4 * n + (i & 3); }
struct Unit { int pm, pn; };
struct Gemm { const bf16_t* A; const bf16_t* Bt; int M, N, K; };

struct StaticOrder {
    int nM, nN, nwg, G, c;
    __host__ __device__ void init(int M, int N, int G_, int c_) { nM = M / BM; nN = N / BM; nwg = nM * nN; G = G_; c = c_; }
    __host__ __device__ bool next(int i, Unit& u) const {
        const long L = (long)i * G + c; if (L >= nwg) return false;
        int wgid = (int)L; { const int q = nwg / NXCD, r = nwg % NXCD, xcd = wgid % NXCD, off = wgid / NXCD; wgid = (xcd < r ? xcd * (q + 1) : r * (q + 1) + (xcd - r) * q) + off; }
        const int nig = WGM * nN, gid = wgid / nig, fm = gid * WGM, gsz = (nM - fm) < WGM ? (nM - fm) : WGM;
        u.pm = fm + ((wgid % nig) % gsz); u.pn = (wgid % nig) / gsz; return true;
    }
    __device__ __forceinline__ void a_ready(const Unit&) const {}
    __device__ __forceinline__ void done(const Unit&) const {}
};


struct EpiInProj {
    static constexpr bool PERM = false, AFTER_DRAIN = false;
    bf16_t* qkv; unsigned char* sg; const float* cosT; const float* sinT; const float* qkg; const float* ikg;
    __device__ __forceinline__ void operator()(const f32x4 (&acc)[2][2][4][2], const Unit& u, int wr, int wc, int fr, int fq) const {
        const int pn = u.pn, row0 = u.pm * BM + wr * 64 + fr;
        if (pn >= 15) {
            unsigned char* base = sg + (size_t)row0 * 3072 + (pn - 15) * 256 + wc * 32 + fq * 8;
#pragma unroll
            for (int ai = 0; ai < 2; ++ai)
#pragma unroll
                for (int m = 0; m < 4; ++m)
#pragma unroll
                    for (int bj = 0; bj < 2; ++bj) {
                        unsigned w[2];
#pragma unroll
                        for (int n = 0; n < 2; ++n) { unsigned pk = 0;
#pragma unroll
                            for (int i = 0; i < 4; ++i) { const float x = acc[ai][bj][m][n][i]; const float s = fast_rcp(1.0f + fast_exp2(-1.4426950408889634f * x));
                                unsigned q = (unsigned)(s * 255.0f + 0.5f); q = q > 255u ? 255u : q; pk |= q << (8 * i); }
                            w[n] = pk; }
                        *(u32x2*)(base + (size_t)(ai * HALF + m * 16) * 3072 + bj * HALF) = (u32x2){w[0], w[1]};
                    }
            return;
        }
        int type = 0, gi = 0; bool qscale = false;
        int ocol = (pn < 8 ? 256 * pn : C_Q1 + 256 * (pn - 9)) + 64 * wc;
        switch (pn) {
            case 0: type = 2; gi = 0; qscale = true; break;
            case 1: type = 2; gi = 1; break;
            case 3: type = 2; gi = 2; qscale = true; break;
            case 4: type = 2; gi = 3; break;
            case 6: case 7: type = 1; break;
            case 8: if (wc == 0) { type = 2; ocol = C_KI; } else if (wc == 1) { type = 3; ocol = C_WI; } else type = 4; break;
            case 9: case 10: type = 2; gi = 4; qscale = true; break;
            case 11: case 12: type = 2; gi = 5; break;
            default: type = 0; break;
        }
        if (type == 4) return;
        if (type == 3) {
            if (fq == 0) {
#pragma unroll
                for (int ai = 0; ai < 2; ++ai)
#pragma unroll
                    for (int m = 0; m < 4; ++m) { const f32x4 a = acc[ai][0][m][0] * 0.35355339059327373f, b = acc[ai][0][m][1] * 0.35355339059327373f;
                        *(u32x4*)(qkv + (size_t)(row0 + ai * HALF + m * 16) * QP + C_WI) = (u32x4){cvt_pk_bf16(a[0], a[1]), cvt_pk_bf16(a[2], a[3]), cvt_pk_bf16(b[0], b[1]), cvt_pk_bf16(b[2], b[3])}; }
            }
            return;
        }
        const float* gp = (pn == 8) ? ikg : qkg + 64 * gi;
        if (type == 2) { if (qscale) body<2, true>(acc, row0, ocol, gp, fq); else body<2, false>(acc, row0, ocol, gp, fq); }
        else if (type == 1) body<1, false>(acc, row0, ocol, gp, fq);
        else body<0, false>(acc, row0, ocol, gp, fq);
    }
    template <int TYPE, bool QS>
    __device__ __forceinline__ void body(const f32x4 (&acc)[2][2][4][2], int row0, int ocol, const float* gp, int fq) const {
#pragma unroll
        for (int ai = 0; ai < 2; ++ai)
#pragma unroll
            for (int m = 0; m < 4; ++m) {
                const int row = row0 + ai * HALF + m * 16;
                f32x4 x[2][2];
#pragma unroll
                for (int bj = 0; bj < 2; ++bj)
#pragma unroll
                    for (int n = 0; n < 2; ++n) x[bj][n] = acc[ai][bj][m][n];
                if (TYPE == 2) {
                    float ss = 0.f;
#pragma unroll
                    for (int bj = 0; bj < 2; ++bj)
#pragma unroll
                        for (int n = 0; n < 2; ++n) ss += (x[bj][n][0] * x[bj][n][0] + x[bj][n][1] * x[bj][n][1]) + (x[bj][n][2] * x[bj][n][2] + x[bj][n][3] * x[bj][n][3]);
                    ss += xor_lane<16>(ss); ss = sum_xor32(ss);
                    const float inv = (QS ? C2 : 1.0f) / sqrtf(ss * (1.0f / 64.0f) + EPS);
#pragma unroll
                    for (int bj = 0; bj < 2; ++bj)
#pragma unroll
                        for (int n = 0; n < 2; ++n) x[bj][n] = x[bj][n] * inv * *(const f32x4*)(gp + 32 * bj + 8 * fq + 4 * n);
                }
                if (TYPE >= 1) {
                    const int pos = row & (SEQ - 1);
#pragma unroll
                    for (int n = 0; n < 2; ++n) {
                        const f32x4 c = *(const f32x4*)(cosT + pos * 32 + 8 * fq + 4 * n), s = *(const f32x4*)(sinT + pos * 32 + 8 * fq + 4 * n);
                        const f32x4 a = x[0][n], b = x[1][n];
                        x[0][n] = a * c - b * s; x[1][n] = b * c + a * s;
                    }
                }
#pragma unroll
                for (int bj = 0; bj < 2; ++bj)
                    *(u32x4*)(qkv + (size_t)row * QP + ocol + 32 * bj + 8 * fq) = (u32x4){cvt_pk_bf16(x[bj][0][0], x[bj][0][1]), cvt_pk_bf16(x[bj][0][2], x[bj][0][3]), cvt_pk_bf16(x[bj][1][0], x[bj][1][1]), cvt_pk_bf16(x[bj][1][2], x[bj][1][3])};
                asm volatile("" ::: "memory");
            }
    }
};

template <int BR> struct EpiMerge {
    static constexpr bool PERM = false, AFTER_DRAIN = false;
    bf16_t* merged; const unsigned char* sg;
    __device__ __forceinline__ void operator()(const f32x4 (&acc)[2][2][4][2], const Unit& u, int wr, int wc, int fr, int fq) const {
        const int row0 = u.pm * BM + wr * 64 + fr, col0 = u.pn * BM + wc * 32 + fq * 8;
#pragma unroll
        for (int ai = 0; ai < 2; ++ai)
#pragma unroll
            for (int m = 0; m < 4; ++m) { const size_t row = (size_t)(row0 + ai * HALF + m * 16);
#pragma unroll
                for (int bj = 0; bj < 2; ++bj) {
                    const u32x2 gq = *(const u32x2*)(sg + row * 3072 + BR * 1024 + col0 + bj * HALF);
                    bf16_t* mp = merged + row * 1024 + col0 + bj * HALF;
                    float v[8];
#pragma unroll
                    for (int n = 0; n < 2; ++n)
#pragma unroll
                        for (int i = 0; i < 4; ++i) v[4 * n + i] = acc[ai][bj][m][n][i] * ((float)((gq[n] >> (8 * i)) & 255u) * (1.0f / 255.0f));
                    if (BR > 0) { const u32x4 o = *(const u32x4*)mp;
#pragma unroll
                        for (int k = 0; k < 4; ++k) { v[2 * k] += bf_lo(o[k]); v[2 * k + 1] += bf_hi(o[k]); } }
                    *(u32x4*)mp = (u32x4){cvt_pk_bf16(v[0], v[1]), cvt_pk_bf16(v[2], v[3]), cvt_pk_bf16(v[4], v[5]), cvt_pk_bf16(v[6], v[7])};
                }
                asm volatile("" ::: "memory"); }
    }
};

struct EpiResid {
    static constexpr bool PERM = false, AFTER_DRAIN = false;
    const float* res; float* out;
    __device__ __forceinline__ void operator()(const f32x4 (&acc)[2][2][4][2], const Unit& u, int wr, int wc, int fr, int fq) const {
        const int row0 = u.pm * BM + wr * 64 + fr, col0 = u.pn * BM + wc * 32 + fq * 8;
#pragma unroll
        for (int ai = 0; ai < 2; ++ai)
#pragma unroll
            for (int m = 0; m < 4; ++m) { const size_t off = (size_t)(row0 + ai * HALF + m * 16) * 1024 + col0;
#pragma unroll
                for (int bj = 0; bj < 2; ++bj)
#pragma unroll
                    for (int n = 0; n < 2; ++n) { const f32x4 r = *(const f32x4*)(res + off + bj * HALF + 4 * n); *(f32x4*)(out + off + bj * HALF + 4 * n) = r + acc[ai][bj][m][n]; }
                if (m & 1) asm volatile("" ::: "memory"); }
    }
};

struct EpiGateUp {
    static constexpr bool PERM = false, AFTER_DRAIN = false;
    bf16_t* hid;
    __device__ __forceinline__ void operator()(const f32x4 (&acc)[2][2][4][2], const Unit& u, int wr, int wc, int fr, int fq) const {
        const int row0 = u.pm * BM + wr * 64 + fr, col0 = (u.pn & 3) * HALF + wc * 32 + fq * 8;
#pragma unroll
        for (int ai = 0; ai < 2; ++ai)
#pragma unroll
            for (int m = 0; m < 4; ++m) { float v[8];
#pragma unroll
                for (int n = 0; n < 2; ++n)
#pragma unroll
                    for (int i = 0; i < 4; ++i) { const float gt = acc[ai][0][m][n][i], up = acc[ai][1][m][n][i]; v[4 * n + i] = gt * fast_rcp(1.0f + fast_exp2(-1.4426950408889634f * gt)) * up; }
                *(u32x4*)(hid + (size_t)(row0 + ai * HALF + m * 16) * DEXP + col0) = (u32x4){cvt_pk_bf16(v[0], v[1]), cvt_pk_bf16(v[2], v[3]), cvt_pk_bf16(v[4], v[5]), cvt_pk_bf16(v[6], v[7])}; }
    }
};

struct EpiDown {
    static constexpr bool PERM = false, AFTER_DRAIN = false;
    bf16_t* y;
    __device__ __forceinline__ void operator()(const f32x4 (&acc)[2][2][4][2], const Unit& u, int wr, int wc, int fr, int fq) const {
        const int row0 = u.pm * BM + wr * 64 + fr, col0 = (u.pn & 3) * BM + wc * 32 + fq * 8;
#pragma unroll
        for (int ai = 0; ai < 2; ++ai)
#pragma unroll
            for (int m = 0; m < 4; ++m)
#pragma unroll
                for (int bj = 0; bj < 2; ++bj) { const f32x4 a = acc[ai][bj][m][0], b = acc[ai][bj][m][1];
                    *(u32x4*)(y + (size_t)(row0 + ai * HALF + m * 16) * 1024 + col0 + bj * HALF) = (u32x4){cvt_pk_bf16(a[0], a[1]), cvt_pk_bf16(a[2], a[3]), cvt_pk_bf16(b[0], b[1]), cvt_pk_bf16(b[2], b[3])}; }
    }
};

struct MoeOrder {
    int nunits, G, c; const PG8_LAS int* blk2e;
    __device__ __forceinline__ bool next(int i, Unit& u) const { const int L = i * G + c; if (L >= nunits) return false; const int rb = L >> 2; u.pm = rb; u.pn = blk2e[rb] * 4 + (L & 3); return true; }
    __device__ __forceinline__ void a_ready(const Unit&) const {}
    __device__ __forceinline__ void done(const Unit&) const {}
};

template <class Epi, class Sched, bool ALIGN_EPI = false, bool SP2 = false>
__device__ __forceinline__ void gemm_phase(PG8_LAS unsigned char* lds, const Gemm g, const Sched& S, const Epi& E) {
    int tid_l = (int)threadIdx.x; asm volatile("" : "+v"(tid_l));
    const int tid = tid_l, wid = __builtin_amdgcn_readfirstlane(tid >> 6), lane = tid & 63, wr = wid >> 2, wc = wid & 3, fr = lane & 15, fq = lane >> 4;
    const int K = g.K, nt = K / BK;
    unsigned voffA[2], voffB[2];
#pragma unroll
    for (int i = 0; i < 2; ++i) { int R, C; stage_rc(tid * 16 + i * 8192, R, C); const int Rb = Epi::PERM ? ((R & ~31) + perm32(R & 31)) : R;
        voffA[i] = (unsigned)(R * K + C) * 2u; voffB[i] = (unsigned)(Rb * K + C) * 2u; }
    const size_t kstep = (size_t)(BK * 2);
    const size_t hstep = (size_t)HALF * K * 2;
    const size_t tstep = 2 * hstep;
    const unsigned ldsw = (unsigned)wid * 1024u;
    const int aoff = lds_byte(wr * 64 + fr, fq * 8), boff = lds_byte(wc * 32 + fr, fq * 8);
#define PG8_SA(b, h) (((b) * 2 + (h)) * HTB)
#define PG8_SB(b, h) ((4 + (b) * 2 + (h)) * HTB)
#define PG8_STAGE(bufoff, gbase, voff) do { _Pragma("unroll") for (int _i = 0; _i < 2; ++_i) \
        __builtin_amdgcn_global_load_lds((const unsigned*)((const char*)(gbase) + (voff)[_i]), (PG8_LAS unsigned*)(lds + (bufoff) + ldsw + _i * 8192), 16, 0, 0); } while (0)
#define PG8_LDA(dst, b, h) do { _Pragma("unroll") for (int m = 0; m < 4; ++m) _Pragma("unroll") for (int k = 0; k < 2; ++k) dst[m][k] = *(const PG8_LAS bf16x8*)(lds + PG8_SA(b, h) + aoff + m * 2048 + k * 1024); } while (0)
#define PG8_LDB(dst, b, h) do { _Pragma("unroll") for (int n = 0; n < 2; ++n) _Pragma("unroll") for (int k = 0; k < 2; ++k) dst[n][k] = *(const PG8_LAS bf16x8*)(lds + PG8_SB(b, h) + boff + n * 2048 + k * 1024); } while (0)
#define PG8_MMA(ai, bj, At, Bt) do { __builtin_amdgcn_s_setprio(1); _Pragma("unroll") for (int m = 0; m < 4; ++m) _Pragma("unroll") for (int n = 0; n < 2; ++n) _Pragma("unroll") for (int k = 0; k < 2; ++k) \
        acc[ai][bj][m][n] = __builtin_amdgcn_mfma_f32_16x16x32_bf16(Bt[n][k], At[m][k], acc[ai][bj][m][n], 0, 0, 0); __builtin_amdgcn_s_setprio(0); } while (0)
#define PG8_WAIT_V(n) asm volatile("s_waitcnt vmcnt(" #n ")" ::: "memory")
#define PG8_WAIT_L(n) asm volatile("s_waitcnt lgkmcnt(" #n ")" ::: "memory")
#define PG8_BAR __builtin_amdgcn_s_barrier()
#define PG8_SCHED __builtin_amdgcn_sched_barrier(0)
    Unit cur, nxt; int ui = 0;
    if (!S.next(0, cur)) return;
    f32x4 acc[2][2][4][2];
#pragma unroll
    for (int a = 0; a < 2; ++a)
#pragma unroll
        for (int b = 0; b < 2; ++b)
#pragma unroll
            for (int m = 0; m < 4; ++m)
#pragma unroll
                for (int n = 0; n < 2; ++n) acc[a][b][m][n] = (f32x4){0.f, 0.f, 0.f, 0.f};
    bf16x8 At[4][2], B0[2][2], B1[2][2];
    const char* cA = (const char*)g.A + (size_t)cur.pm * tstep; const char* cB = (const char*)g.Bt + (size_t)cur.pn * tstep;
    S.a_ready(cur);
    if constexpr (SP2) {
        PG8_STAGE(PG8_SB(0, 0), cB, voffB); PG8_STAGE(PG8_SB(0, 1), cB + hstep, voffB); PG8_STAGE(PG8_SA(0, 0), cA, voffA); PG8_STAGE(PG8_SA(0, 1), cA + hstep, voffA);
        if (wr == 1) PG8_BAR;
        PG8_WAIT_V(2); PG8_BAR;
        PG8_STAGE(PG8_SB(1, 0), cB + kstep, voffB); PG8_STAGE(PG8_SA(1, 0), cA + kstep, voffA); PG8_STAGE(PG8_SB(1, 1), cB + hstep + kstep, voffB);
        PG8_WAIT_V(6); PG8_BAR;
    } else {
        PG8_STAGE(PG8_SB(0, 0), cB, voffB); PG8_STAGE(PG8_SA(0, 0), cA, voffA); PG8_STAGE(PG8_SB(0, 1), cB + hstep, voffB); PG8_STAGE(PG8_SA(0, 1), cA + hstep, voffA);
        if (wr == 1) PG8_BAR;
        PG8_WAIT_V(4); PG8_BAR;
        PG8_STAGE(PG8_SB(1, 0), cB + kstep, voffB); PG8_STAGE(PG8_SA(1, 0), cA + kstep, voffA); PG8_STAGE(PG8_SB(1, 1), cB + hstep + kstep, voffB);
        PG8_WAIT_V(6); PG8_BAR;
    }
    for (;;) {
        const bool has_next = S.next(ui + 1, nxt);
        const char* nA = has_next ? (const char*)g.A + (size_t)nxt.pm * tstep : cA; const char* nB = has_next ? (const char*)g.Bt + (size_t)nxt.pn * tstep : cB;
#pragma unroll 1
        for (int t = 0; t < nt; t += 2) {
            const bool last = (t == nt - 2);
            const char* a1 = cA + (size_t)(t + 1) * kstep;
            const char* a2 = last ? nA : cA + (size_t)(t + 2) * kstep; const char* b2 = last ? nB : cB + (size_t)(t + 2) * kstep;
            const char* a3 = a2 + kstep; const char* b3 = b2 + kstep;
            if (last && has_next) S.a_ready(nxt);
            if constexpr (SP2) {
            PG8_LDB(B0, 0, 0); PG8_LDB(B1, 0, 1); PG8_SCHED; PG8_LDA(At, 0, 0); PG8_STAGE(PG8_SA(1, 1), a1 + hstep, voffA);
            PG8_WAIT_V(8); PG8_WAIT_L(0); PG8_BAR; PG8_MMA(0, 0, At, B0); PG8_MMA(0, 1, At, B1); PG8_BAR; PG8_SCHED;
            PG8_LDA(At, 0, 1); PG8_STAGE(PG8_SB(0, 0), b2, voffB); PG8_STAGE(PG8_SB(0, 1), b2 + hstep, voffB); PG8_STAGE(PG8_SA(0, 0), a2, voffA);
            PG8_WAIT_V(8); PG8_WAIT_L(0); PG8_BAR; PG8_MMA(1, 0, At, B0); PG8_MMA(1, 1, At, B1); PG8_BAR; PG8_SCHED;
            PG8_LDB(B0, 1, 0); PG8_LDB(B1, 1, 1); PG8_SCHED; PG8_LDA(At, 1, 0); PG8_STAGE(PG8_SA(0, 1), a2 + hstep, voffA);
            PG8_WAIT_V(8); PG8_WAIT_L(0); PG8_BAR; PG8_MMA(0, 0, At, B0); PG8_MMA(0, 1, At, B1); PG8_BAR; PG8_SCHED;
            PG8_LDA(At, 1, 1); PG8_STAGE(PG8_SB(1, 0), b3, voffB); PG8_STAGE(PG8_SB(1, 1), b3 + hstep, voffB); PG8_STAGE(PG8_SA(1, 0), a3, voffA);
            PG8_WAIT_V(8); PG8_WAIT_L(0); PG8_BAR; PG8_MMA(1, 0, At, B0); PG8_MMA(1, 1, At, B1); PG8_BAR; PG8_SCHED;
            } else {
            PG8_LDB(B0, 0, 0); PG8_SCHED; PG8_LDA(At, 0, 0); PG8_STAGE(PG8_SA(1, 1), a1 + hstep, voffA);
            PG8_WAIT_L(8); PG8_BAR; PG8_WAIT_L(0); PG8_MMA(0, 0, At, B0); PG8_BAR; PG8_SCHED;
            PG8_LDB(B1, 0, 1); PG8_STAGE(PG8_SB(0, 0), b2, voffB);
            PG8_BAR; PG8_WAIT_L(0); PG8_MMA(0, 1, At, B1); PG8_BAR;
            PG8_LDA(At, 0, 1); PG8_STAGE(PG8_SA(0, 0), a2, voffA);
            PG8_BAR; PG8_WAIT_L(0); PG8_MMA(1, 0, At, B0); PG8_BAR; PG8_SCHED;
            PG8_STAGE(PG8_SB(0, 1), b2 + hstep, voffB);
            PG8_WAIT_V(6); PG8_BAR; PG8_MMA(1, 1, At, B1); PG8_BAR;
            PG8_LDB(B0, 1, 0); PG8_SCHED; PG8_LDA(At, 1, 0); PG8_STAGE(PG8_SA(0, 1), a2 + hstep, voffA);
            PG8_WAIT_L(8); PG8_BAR; PG8_WAIT_L(0); PG8_MMA(0, 0, At, B0); PG8_BAR; PG8_SCHED;
            PG8_LDB(B1, 1, 1); PG8_STAGE(PG8_SB(1, 0), b3, voffB);
            PG8_BAR; PG8_WAIT_L(0); PG8_MMA(0, 1, At, B1); PG8_BAR;
            PG8_LDA(At, 1, 1); PG8_STAGE(PG8_SA(1, 0), a3, voffA);
            PG8_BAR; PG8_WAIT_L(0); PG8_MMA(1, 0, At, B0); PG8_BAR; PG8_SCHED;
            PG8_STAGE(PG8_SB(1, 1), b3 + hstep, voffB);
            PG8_WAIT_V(6); PG8_BAR; PG8_MMA(1, 1, At, B1); PG8_BAR;
            }
        }
        if constexpr (ALIGN_EPI) { if (wr == 0) PG8_BAR; }
        if constexpr (!Epi::AFTER_DRAIN) { E(acc, cur, wr, wc, fr, fq); S.done(cur); }
        if (!has_next) break;
#pragma unroll
        for (int a = 0; a < 2; ++a)
#pragma unroll
            for (int b = 0; b < 2; ++b)
#pragma unroll
                for (int m = 0; m < 4; ++m)
#pragma unroll
                    for (int n = 0; n < 2; ++n) acc[a][b][m][n] = (f32x4){0.f, 0.f, 0.f, 0.f};
        cur = nxt; cA = nA; cB = nB; ++ui;
        if constexpr (ALIGN_EPI) { if (wr == 1) PG8_BAR; }
    }
    PG8_WAIT_V(0);
    if constexpr (!ALIGN_EPI) { if (wr == 0) PG8_BAR; }
    PG8_BAR;
    if constexpr (Epi::AFTER_DRAIN) { E.fused(acc, cur, wr, wc, fr, fq, lds, wid, lane); S.done(cur); }
#undef PG8_SA
#undef PG8_SB
#undef PG8_STAGE
#undef PG8_LDA
#undef PG8_LDB
#undef PG8_MMA
#undef PG8_WAIT_V
#undef PG8_WAIT_L
#undef PG8_BAR
#undef PG8_SCHED
}
}
#define XB_TMO      128
#define XB_XCNT(j)  (256  + 64 * (j))
#define XB_XSUB(j)  (1280 + 64 * (j))
#define XB_XGEN(j)  (2304 + 64 * (j))
#define XB_TOP      3328
#define XB_TOPGEN   3392
#define XCD_BAR_WORDS 3456
#define XB_SPIN_CAP (1u << 21)

__device__ __forceinline__ unsigned xb_ld(unsigned* p)              { return __hip_atomic_load(p, __ATOMIC_RELAXED, __HIP_MEMORY_SCOPE_AGENT); }
__device__ __forceinline__ unsigned xb_add(unsigned* p, unsigned v) { return __hip_atomic_fetch_add(p, v, __ATOMIC_RELAXED, __HIP_MEMORY_SCOPE_AGENT); }
__device__ __forceinline__ unsigned xb_xcc_id() { return (unsigned)__builtin_amdgcn_s_getreg((3 << 11) | 20) & 0xFu; }
#define XB_SPIN(cond, bar) do { unsigned _sp = 0; while (cond) { __builtin_amdgcn_s_sleep(1); \
    if ((++_sp & 255u) == 0u) { if (xb_ld(&(bar)[XB_TMO])) break; if (_sp > XB_SPIN_CAP) { atomicAdd(&(bar)[XB_TMO], 1u); break; } } } } while (0)

struct XcdBarrier {
    unsigned* bar; unsigned x;
    volatile LAS unsigned* st;
};

__device__ __forceinline__ XcdBarrier xcd_barrier_post(unsigned* bar, volatile LAS unsigned* st) {
    XcdBarrier b; b.bar = bar; b.x = xb_xcc_id(); b.st = st;
    if (threadIdx.x == 0) (void)xb_add(&bar[XB_XCNT(b.x)], 1u);
    return b;
}
__device__ __forceinline__ void xcd_barrier_complete(unsigned* bar, unsigned x, unsigned& nloc, unsigned& nx) {
    const unsigned G = gridDim.x * gridDim.y * gridDim.z;
    unsigned sum, cnt, mine, sp = 0u;
    for (;;) {
        sum = 0u; cnt = 0u; mine = 0u;
#pragma unroll
        for (unsigned j = 0; j < 16; ++j) { const unsigned c = xb_ld(&bar[XB_XCNT(j)]); sum += c; cnt += (c > 0u) ? 1u : 0u; mine = (j == x) ? c : mine; }
        if (sum == G) break;
        __builtin_amdgcn_s_sleep(1);
        if ((++sp & 255u) == 0u) { if (xb_ld(&bar[XB_TMO])) break; if (sp > XB_SPIN_CAP) { atomicAdd(&bar[XB_TMO], 1u); break; } }
    }
    nloc = mine > 0u ? mine : 1u; nx = cnt > 0u ? cnt : 1u;
}

__device__ __forceinline__ void xcd_barrier(const XcdBarrier& b) {
    asm volatile("s_waitcnt vmcnt(0)" ::: "memory");
    __syncthreads();
    int tid_l = (int)threadIdx.x; asm volatile("" : "+v"(tid_l));
    if (tid_l == 0) {
        unsigned* bar = b.bar;
        __builtin_amdgcn_s_waitcnt(0);
        unsigned nloc = b.st[0], nx = b.st[1];
        if (nloc == 0u) { xcd_barrier_complete(bar, b.x, nloc, nx); b.st[0] = nloc; b.st[1] = nx; }
        const unsigned old = xb_add(&bar[XB_XSUB(b.x)], 1u);
        const unsigned gen = old / nloc;
        if (old + 1u == (gen + 1u) * nloc) {
            __builtin_amdgcn_fence(__ATOMIC_RELEASE, "agent");
            asm volatile("s_waitcnt vmcnt(0)" ::: "memory");
            const unsigned og = xb_add(&bar[XB_TOP], 1u);
            const unsigned tg = og / nx;
            if (og + 1u == (tg + 1u) * nx) xb_add(&bar[XB_TOPGEN], 1u);
            else XB_SPIN(xb_ld(&bar[XB_TOPGEN]) == tg, bar);
            __builtin_amdgcn_fence(__ATOMIC_ACQUIRE, "agent");
            xb_add(&bar[XB_XGEN(b.x)], 1u);
            asm volatile("s_waitcnt vmcnt(0)" ::: "memory");
        } else {
            XB_SPIN(xb_ld(&bar[XB_XGEN(b.x)]) == gen, bar);
            __builtin_amdgcn_fence(__ATOMIC_ACQUIRE, "agent");
            asm volatile("s_waitcnt vmcnt(0)" ::: "memory");
        }
    }
    __syncthreads();
}

enum { I_X = 0, I_NORM_ATTN, I_W_IN, I_QK_GAIN, I_IDX_K_GAIN, I_DIFF_LAMBDA, I_DIFF_SUBLN, I_W_PROJ_A, I_W_PROJ_B, I_W_PROJ_C, I_W_OUT, I_NORM_FFN, I_W_GROUP, I_B_GROUP, I_W_ROUTER, I_B_ROUTER,
       I_W_E_GATE, I_W_E_UP, I_W_E_DOWN, N_INPUTS };
struct Args { const float* in[N_INPUTS]; float* out; unsigned char* ws; };

#define LDS_WAIT() asm volatile("s_waitcnt lgkmcnt(0)" ::: "memory")

__device__ __forceinline__ int inproj_src_col(int d) {
    const int pn = d >> 8, s = d & 255;
    if (pn >= 15) return C_G + 256 * (pn - 15) + (s & ~31) + pg8::perm32(s & 31);
    const int u = (s >> 5) & 3, e = 32 * (s >> 7) + pg8::perm32(s & 31);
    if (pn < 8) return 256 * pn + 64 * u + e;
    if (pn == 8) { if (u == 0) return C_KI + e; if (u == 1) return e < 8 ? C_WI + e : -1; return -1; }
    return C_Q1 + 256 * (pn - 9) + 64 * u + e;
}
__device__ __forceinline__ void transpose_item(const float* W, int ldw, int K, bf16_t* WT, int drow0, int k0, int srccol, LAS float* scr, int lane) {
    const float* src = W + (size_t)k0 * ldw + (srccol >= 0 ? srccol : 0);
#pragma unroll 8
    for (int i = 0; i < 32; ++i) { const int kk = 2 * i + (lane >> 5); const float v = src[(size_t)kk * ldw]; scr[kk * 33 + (lane & 31)] = srccol >= 0 ? v : 0.f; }
    LDS_WAIT(); asm volatile("" ::: "memory");
    const int c = lane & 7;
#pragma unroll
    for (int j = 0; j < 4; ++j) { const int n = (lane >> 3) + 8 * j; const LAS float* s = scr + (8 * c) * 33 + n;
        u32x4 o; o.x = cvt_pk_bf16(s[0 * 33], s[1 * 33]); o.y = cvt_pk_bf16(s[2 * 33], s[3 * 33]); o.z = cvt_pk_bf16(s[4 * 33], s[5 * 33]); o.w = cvt_pk_bf16(s[6 * 33], s[7 * 33]);
        *(u32x4*)(WT + (size_t)(drow0 + n) * K + k0 + 8 * c) = o; }
    LDS_WAIT(); asm volatile("" ::: "memory");
}

template <bool COMBINE, bool WRITE_HN>
__device__ __forceinline__ void token_row(const float* src, float* dst, const bf16_t* y, const unsigned* rt0, const unsigned* rt1, const f32x2* rtw, const LAS int* pstart,
                                          const float* gain, bf16_t* hn, int m, int lane) {
    f32x4 v[4];
#pragma unroll
    for (int j = 0; j < 4; ++j) v[j] = ((const f32x4*)(src + (size_t)m * DM))[lane + 64 * j];
    if (COMBINE) {
        const unsigned a = rt0[m], b = rt1[m]; const f32x2 w = rtw[m];
        const size_t s0 = (size_t)(pstart[a >> 24] + (int)(a & 0xffffffu)), s1 = (size_t)(pstart[b >> 24] + (int)(b & 0xffffffu));
#pragma unroll
        for (int j = 0; j < 4; ++j) { const u32x2 p = ((const u32x2*)(y + s0 * DM))[lane + 64 * j], q = ((const u32x2*)(y + s1 * DM))[lane + 64 * j];
            v[j][0] += w[0] * bf_lo(p[0]) + w[1] * bf_lo(q[0]); v[j][1] += w[0] * bf_hi(p[0]) + w[1] * bf_hi(q[0]);
            v[j][2] += w[0] * bf_lo(p[1]) + w[1] * bf_lo(q[1]); v[j][3] += w[0] * bf_hi(p[1]) + w[1] * bf_hi(q[1]);
            ((f32x4*)(dst + (size_t)m * DM))[lane + 64 * j] = v[j]; }
    }
    if (WRITE_HN) {
        float ss = 0.f;
#pragma unroll
        for (int j = 0; j < 4; ++j) ss += (v[j][0] * v[j][0] + v[j][1] * v[j][1]) + (v[j][2] * v[j][2] + v[j][3] * v[j][3]);
        const float rstd = 1.0f / sqrtf(wave_sum(ss) * (1.0f / DM) + EPS);
#pragma unroll
        for (int j = 0; j < 4; ++j) { const f32x4 g = ((const f32x4*)gain)[lane + 64 * j]; const f32x4 o = v[j] * rstd * g;
            ((u32x2*)(hn + (size_t)m * DM))[lane + 64 * j] = (u32x2){cvt_pk_bf16(o[0], o[1]), cvt_pk_bf16(o[2], o[3])}; }
    }
}

template <bool EXPERTS> __device__ __forceinline__ void convert_weights(const Args& a, unsigned char* ws, int l, LAS unsigned char* lds, int lane, int wave, int vcu, int G);
__device__ __forceinline__ void p0_phase(const Args& a, unsigned char* ws, int l, LAS unsigned char* lds, int tid, int lane, int wave, int vcu, int G) {
    convert_weights<false>(a, ws, l, lds, lane, wave, vcu, G);
    const int gw = vcu * 8 + wave, NGW = G * 8, gt = vcu * 512 + tid, NGT = G * 512;
    if (l == 0) {
        float* cosT = (float*)(ws + WS_COS); float* sinT = (float*)(ws + WS_SIN);
        for (int idx = gt; idx < SEQ * 32; idx += NGT) { const int pos = idx >> 5, j = idx & 31;
            const float inv_freq = 1.0f / powf(10000.0f, (float)(2 * j) * (1.0f / 64.0f));
            const float ang = (float)pos * inv_freq;
            const double rev = (double)ang * 0.15915494309189533577; const float fr = (float)(rev - rint(rev));
            cosT[idx] = __builtin_amdgcn_cosf(fr); sinT[idx] = __builtin_amdgcn_sinf(fr); }
    }
    { float* wrt = (float*)(ws + WS_WRT); const float* wg = a.in[I_W_GROUP] + (size_t)l * DM * 4; const float* wr = a.in[I_W_ROUTER] + (size_t)l * DM * 32;
      const float* g2 = a.in[I_NORM_FFN] + (size_t)l * DM;
      for (int idx = gt; idx < 36 * DM; idx += NGT) { const int c = idx >> 10, k = idx & 1023; wrt[idx] = g2[k] * (c < 4 ? wg[k * 4 + c] : wr[k * 32 + (c - 4)]); } }
    const float* gain = a.in[I_NORM_ATTN] + (size_t)l * DM; bf16_t* hn = (bf16_t*)(ws + WS_HN);
    const LAS int* pstart = (const LAS int*)(lds + LX_PSTART);
    if (l == 0) { for (int m = gw; m < MTOK; m += NGW) token_row<false, true>(a.in[I_X], nullptr, nullptr, nullptr, nullptr, nullptr, pstart, gain, hn, m, lane); }
    else { for (int m = gw; m < MTOK; m += NGW) token_row<true, true>(a.out, a.out, (const bf16_t*)(ws + WS_Y), (const unsigned*)(ws + WS_RT0), (const unsigned*)(ws + WS_RT1), (const f32x2*)(ws + WS_RTW), pstart, gain, hn, m, lane); }
}

template <bool EXPERTS> __device__ __forceinline__ void convert_weights(const Args& a, unsigned char* ws, int l, LAS unsigned char* lds, int lane, int wave, int vcu, int G) {
    LAS float* scr = (LAS float*)(lds + wave * 16384);
    const int gw = vcu * 8 + wave, NGW = G * 8;
    constexpr int I_IN = 216 * 16, I_PA = 32 * 4, I_PC = 32 * 8, I_WO = 32 * 16, I_GU = 32 * 32 * 16, I_DN = 32 * 32 * 8, NIT = I_IN + 2 * I_PA + I_PC + I_WO + I_GU + I_DN;
    constexpr int I_SMALL = I_IN + 2 * I_PA + I_PC + I_WO;
    for (int it = gw + (EXPERTS ? I_SMALL : 0); it < (EXPERTS ? NIT : I_SMALL); it += NGW) {
        int r = it; const int d31 = lane & 31;
        if (r < I_IN) { const int nb = r >> 4, kb = r & 15; transpose_item(a.in[I_W_IN] + (size_t)l * DM * D_IN, D_IN, 1024, (bf16_t*)(ws + WS_WIN), nb * 32, kb * 64, inproj_src_col(nb * 32 + d31), scr, lane); continue; } r -= I_IN;
        const int pcol = pg8::perm32(d31);
        if (r < I_PA) { const int nb = r >> 2, kb = r & 3; transpose_item(a.in[I_W_PROJ_A] + (size_t)l * 256 * DM, DM, 256, (bf16_t*)(ws + WS_WPA), nb * 32, kb * 64, nb * 32 + pcol, scr, lane); continue; } r -= I_PA;
        if (r < I_PA) { const int nb = r >> 2, kb = r & 3; transpose_item(a.in[I_W_PROJ_B] + (size_t)l * 256 * DM, DM, 256, (bf16_t*)(ws + WS_WPB), nb * 32, kb * 64, nb * 32 + pcol, scr, lane); continue; } r -= I_PA;
        if (r < I_PC) { const int nb = r >> 3, kb = r & 7; transpose_item(a.in[I_W_PROJ_C] + (size_t)l * 512 * DM, DM, 512, (bf16_t*)(ws + WS_WPC), nb * 32, kb * 64, nb * 32 + pcol, scr, lane); continue; } r -= I_PC;
        if (r < I_WO) { const int nb = r >> 4, kb = r & 15; transpose_item(a.in[I_W_OUT] + (size_t)l * DM * DM, DM, 1024, (bf16_t*)(ws + WS_WO), nb * 32, kb * 64, nb * 32 + pcol, scr, lane); continue; } r -= I_WO;
        if (r < I_GU) { const int e = r >> 9, rr = r & 511, nb = rr >> 4, kb = rr & 15, dd = nb * 32, pn = dd >> 8, s = dd & 255, half = s >> 7;
            const float* src = (half ? a.in[I_W_E_UP] : a.in[I_W_E_GATE]) + (size_t)(l * NEXP + e) * DM * DEXP;
            transpose_item(src, DEXP, 1024, (bf16_t*)(ws + WS_WGU) + (size_t)e * 1024 * 1024, nb * 32, kb * 64, 128 * pn + (s & 127) + pcol, scr, lane); continue; } r -= I_GU;
        { const int e = r >> 8, rr = r & 255, nb = rr >> 3, kb = rr & 7;
            transpose_item(a.in[I_W_E_DOWN] + (size_t)(l * NEXP + e) * DEXP * DM, DM, 512, (bf16_t*)(ws + WS_WD) + (size_t)e * 1024 * 512, nb * 32, kb * 64, nb * 32 + pcol, scr, lane); }
    }
}

__device__ __forceinline__ f32x16 mfma32(bf16x8 a, bf16x8 b, f32x16 c) { return __builtin_amdgcn_mfma_f32_32x32x16_bf16(a, b, c, 0, 0, 0); }
typedef short v4i16_t __attribute__((ext_vector_type(4)));
__device__ __forceinline__ s16x4 vtr(const LAS unsigned char* p) { return __builtin_bit_cast(s16x4, __builtin_amdgcn_ds_read_tr16_b64_v4i16((LAS v4i16_t*)p)); }
__device__ __forceinline__ int crow(int r, int hi) { return (r & 3) + 8 * (r >> 2) + 4 * hi; }
#define NEG_INF (-__builtin_inff())

__device__ __forceinline__ f32x16 splat16(float v) { f32x16 r;
#pragma unroll
    for (int i = 0; i < 16; ++i) r[i] = v;
    return r; }
struct QReg { const bf16x8 (&q)[4]; __device__ __forceinline__ bf16x8 operator()(int ks) const { return q[ks]; } };
struct QLds { const LAS unsigned char* p; __device__ __forceinline__ bf16x8 operator()(int ks) const { return *(const LAS bf16x8*)(p + ks * 1024); } };
template <int NDB, class QF, class MaskF>
__device__ __forceinline__ void flash_tile(float& m_run, float& l_run, f32x16 (&o)[NDB], const LAS unsigned char* kimg, const LAS unsigned char* vimg, const QF& qf, const MaskF& maskf, int r32, int hi, int vboff) {
    if (NDB == 4) __builtin_amdgcn_sched_barrier(0);
    f32x16 p0, p1; maskf.init(p0, p1);
#pragma unroll
    for (int ks = 0; ks < 4; ++ks) {
        const bf16x8 a0 = *(const LAS bf16x8*)(kimg + (2 * ks + hi) * 1024 + r32 * 16);
        const bf16x8 a1 = *(const LAS bf16x8*)(kimg + (2 * ks + hi) * 1024 + 512 + r32 * 16);
        const bf16x8 qk = qf(ks);
        p0 = mfma32(a0, qk, p0); p1 = mfma32(a1, qk, p1);
        if (NDB == 4 && (ks & 1)) __builtin_amdgcn_sched_barrier(0);
    }
    maskf(p0, p1);
    float mx = fmaxf(p0[0], p1[0]);
#pragma unroll
    for (int r = 1; r < 16; ++r) mx = fmaxf(mx, fmaxf(p0[r], p1[r]));
    mx = max_xor32(mx);
    const float mnew = fmaxf(m_run, mx);
    if (__ballot(mnew > m_run) != 0ull) {
        const float alpha = fast_exp2(m_run - mnew);
        l_run *= alpha;
#pragma unroll
        for (int db = 0; db < NDB; ++db) o[db] = o[db] * alpha;
    }
    m_run = mnew;
    float sum = 0.f;
#pragma unroll
    for (int r = 0; r < 16; ++r) { p0[r] = fast_exp2(p0[r] - mnew); p1[r] = fast_exp2(p1[r] - mnew); sum += p0[r] + p1[r]; }
    l_run += sum;
    bf16x8 pa[4];
    pa[0] = __builtin_bit_cast(bf16x8, (u32x4){cvt_pk_bf16(p0[0], p0[1]), cvt_pk_bf16(p0[2], p0[3]), cvt_pk_bf16(p0[4], p0[5]), cvt_pk_bf16(p0[6], p0[7])});
    pa[1] = __builtin_bit_cast(bf16x8, (u32x4){cvt_pk_bf16(p0[8], p0[9]), cvt_pk_bf16(p0[10], p0[11]), cvt_pk_bf16(p0[12], p0[13]), cvt_pk_bf16(p0[14], p0[15])});
    pa[2] = __builtin_bit_cast(bf16x8, (u32x4){cvt_pk_bf16(p1[0], p1[1]), cvt_pk_bf16(p1[2], p1[3]), cvt_pk_bf16(p1[4], p1[5]), cvt_pk_bf16(p1[6], p1[7])});
    pa[3] = __builtin_bit_cast(bf16x8, (u32x4){cvt_pk_bf16(p1[8], p1[9]), cvt_pk_bf16(p1[10], p1[11]), cvt_pk_bf16(p1[12], p1[13]), cvt_pk_bf16(p1[14], p1[15])});
#pragma unroll
    for (int db = 0; db < NDB; ++db)
#pragma unroll
        for (int s = 0; s < 4; ++s) {
            const s16x4 lo = vtr(vimg + vboff + db * 4096 + s * 1024), h4 = vtr(vimg + vboff + db * 4096 + s * 1024 + 512);
            const bf16x8 vt = (bf16x8){lo[0], lo[1], lo[2], lo[3], h4[0], h4[1], h4[2], h4[3]};
            o[db] = mfma32(vt, pa[s], o[db]);
            if (NDB == 4 && (s & 1)) __builtin_amdgcn_sched_barrier(0);
        }    __builtin_amdgcn_sched_barrier(0);
}
template <int NDB, class QF, class MaskF>
__device__ __forceinline__ void flash_tile_ref0(float& l_run, f32x16 (&o)[NDB], const LAS unsigned char* kimg, const LAS unsigned char* vimg, const QF& qf, const MaskF& maskf, int r32, int hi, int vboff) {
    if (NDB == 4) __builtin_amdgcn_sched_barrier(0);
    f32x16 p0, p1; maskf.init(p0, p1);
#pragma unroll
    for (int ks = 0; ks < 4; ++ks) {
        const bf16x8 a0 = *(const LAS bf16x8*)(kimg + (2 * ks + hi) * 1024 + r32 * 16);
        const bf16x8 a1 = *(const LAS bf16x8*)(kimg + (2 * ks + hi) * 1024 + 512 + r32 * 16);
        const bf16x8 qk = qf(ks);
        p0 = mfma32(a0, qk, p0); p1 = mfma32(a1, qk, p1);
        if (NDB == 4 && (ks & 1)) __builtin_amdgcn_sched_barrier(0);
    }
    maskf(p0, p1);
    float sum = 0.f;
#pragma unroll
    for (int r = 0; r < 16; ++r) { p0[r] = fast_exp2(p0[r]); p1[r] = fast_exp2(p1[r]); sum += p0[r] + p1[r]; }
    l_run += sum;
    bf16x8 pa[4];
    pa[0] = __builtin_bit_cast(bf16x8, (u32x4){cvt_pk_bf16(p0[0], p0[1]), cvt_pk_bf16(p0[2], p0[3]), cvt_pk_bf16(p0[4], p0[5]), cvt_pk_bf16(p0[6], p0[7])});
    pa[1] = __builtin_bit_cast(bf16x8, (u32x4){cvt_pk_bf16(p0[8], p0[9]), cvt_pk_bf16(p0[10], p0[11]), cvt_pk_bf16(p0[12], p0[13]), cvt_pk_bf16(p0[14], p0[15])});
    pa[2] = __builtin_bit_cast(bf16x8, (u32x4){cvt_pk_bf16(p1[0], p1[1]), cvt_pk_bf16(p1[2], p1[3]), cvt_pk_bf16(p1[4], p1[5]), cvt_pk_bf16(p1[6], p1[7])});
    pa[3] = __builtin_bit_cast(bf16x8, (u32x4){cvt_pk_bf16(p1[8], p1[9]), cvt_pk_bf16(p1[10], p1[11]), cvt_pk_bf16(p1[12], p1[13]), cvt_pk_bf16(p1[14], p1[15])});
#pragma unroll
    for (int db = 0; db < NDB; ++db)
#pragma unroll
        for (int s = 0; s < 4; ++s) {
            const s16x4 lo = vtr(vimg + vboff + db * 4096 + s * 1024), h4 = vtr(vimg + vboff + db * 4096 + s * 1024 + 512);
            const bf16x8 vt = (bf16x8){lo[0], lo[1], lo[2], lo[3], h4[0], h4[1], h4[2], h4[3]};
            o[db] = mfma32(vt, pa[s], o[db]);
            if (NDB == 4 && (s & 1)) __builtin_amdgcn_sched_barrier(0);
        }
    if (NDB == 4) __builtin_amdgcn_sched_barrier(0);
}
template <bool FAST, int NDB, class QF, class MaskF>
__device__ __forceinline__ void flash_step(float& m_run, float& l_run, f32x16 (&o)[NDB], const LAS unsigned char* kimg, const LAS unsigned char* vimg, const QF& qf, const MaskF& maskf, int r32, int hi, int vboff) {
    if (FAST) flash_tile_ref0<NDB>(l_run, o, kimg, vimg, qf, maskf, r32, hi, vboff); else flash_tile<NDB>(m_run, l_run, o, kimg, vimg, qf, maskf, r32, hi, vboff);
}
__device__ __forceinline__ bool softmax_ref0_ok(const float* gq, const float* gk, int lane) {
    float a = fabsf(gq[lane]), b = fabsf(gk[lane]);
    a = fmaxf(a, xor_lane<1>(a)); a = fmaxf(a, xor_lane<2>(a)); a = fmaxf(a, xor_lane<4>(a)); a = fmaxf(a, xor_lane<8>(a)); a = fmaxf(a, xor_lane<16>(a)); a = max_xor32(a);
    b = fmaxf(b, xor_lane<1>(b)); b = fmaxf(b, xor_lane<2>(b)); b = fmaxf(b, xor_lane<4>(b)); b = fmaxf(b, xor_lane<8>(b)); b = fmaxf(b, xor_lane<16>(b)); b = max_xor32(b);
    return __builtin_amdgcn_readfirstlane(__builtin_bit_cast(int, a * b * (C2 * 64.0f * 1.02f))) < __builtin_bit_cast(int, 48.0f) && REF0_ENABLE;
}
#define MASK_INIT_ZERO __device__ __forceinline__ void init(f32x16& p0, f32x16& p1) const { p0 = splat16(0.f); p1 = splat16(0.f); }
struct MaskNone { MASK_INIT_ZERO __device__ __forceinline__ void operator()(f32x16&, f32x16&) const {} };
struct MaskCausal { int kb0, qloc, hi;
    MASK_INIT_ZERO
    __device__ __forceinline__ void operator()(f32x16& p0, f32x16& p1) const {
#pragma unroll
        for (int r = 0; r < 16; ++r) { const int kv = kb0 + crow(r, hi); p0[r] = kv > qloc ? NEG_INF : p0[r]; p1[r] = kv + 32 > qloc ? NEG_INF : p1[r]; } } };
struct MaskCausalIf { bool on; int kb0, qloc, hi;
    MASK_INIT_ZERO
    __device__ __forceinline__ void operator()(f32x16& p0, f32x16& p1) const { if (on) {
#pragma unroll
        for (int r = 0; r < 16; ++r) { const int kv = kb0 + crow(r, hi); p0[r] = kv > qloc ? NEG_INF : p0[r]; p1[r] = kv + 32 > qloc ? NEG_INF : p1[r]; } } } };
struct MaskLane { float ci;
    MASK_INIT_ZERO
    __device__ __forceinline__ void operator()(f32x16& p0, f32x16& p1) const {
#pragma unroll
        for (int r = 0; r < 16; ++r) { p0[r] += ci; p1[r] += ci; } } };
struct MaskBits { unsigned n0, n1;
    __device__ __forceinline__ void init(f32x16& p0, f32x16& p1) const {
#pragma unroll
        for (int r = 0; r < 16; ++r) { const int pos = (r & 3) + 8 * (r >> 2);
            p0[r] = __builtin_bit_cast(float, (unsigned)__builtin_amdgcn_sbfe((int)n0, pos, 1) & 0xff800000u); p1[r] = __builtin_bit_cast(float, (unsigned)__builtin_amdgcn_sbfe((int)n1, pos, 1) & 0xff800000u); } }
    __device__ __forceinline__ void operator()(f32x16&, f32x16&) const {} };
__device__ __forceinline__ void dma16(const void* g, LAS unsigned char* l) { __builtin_amdgcn_global_load_lds((const unsigned*)g, (LAS unsigned*)l, 16, 0, 0); }
#define DMA_WAIT_SYNC() do { asm volatile("s_waitcnt vmcnt(0)" ::: "memory"); __syncthreads(); } while (0)

__device__ __forceinline__ void glds16(const void* gsrc, unsigned lds_dst) { unsigned keep;
    asm volatile("s_mov_b32 %0, m0\n\ts_mov_b32 m0, %2\n\ts_nop 0\n\tglobal_load_lds_dwordx4 %1, off\n\ts_mov_b32 m0, %0" : "=&s"(keep) : "v"(gsrc), "s"(lds_dst) : "memory"); }
__device__ __forceinline__ void glds4(const void* gsrc, unsigned lds_dst) { unsigned keep;
    asm volatile("s_mov_b32 %0, m0\n\ts_mov_b32 m0, %2\n\ts_nop 0\n\tglobal_load_lds_dword %1, off\n\ts_mov_b32 m0, %0" : "=&s"(keep) : "v"(gsrc), "s"(lds_dst) : "memory"); }
#define WAITV_BAR(N) asm volatile("s_waitcnt vmcnt(" #N ") lgkmcnt(0)\n\ts_barrier" ::: "memory")

template <int MODE, bool FAST>
__device__ __forceinline__ void attn_ab_unit(int b, int h, int qt, const bf16_t* qkv, bf16_t* obuf, const float* kmean, const unsigned* maskg, LAS unsigned char* lds, int tid, int lane, int w) {
    constexpr int CQ = MODE == 0 ? C_QA : C_QB, CK = MODE == 0 ? C_KA : C_KB, CV = MODE == 0 ? C_VA : C_VB;
    constexpr int NS = 4, D = 3, SLOT = 16384;
    const int r32 = lane & 31, hi = lane >> 5;
    const size_t rowbase = (size_t)b * SEQ; const int q0 = 256 * qt, qloc = 32 * w + r32; const size_t qrow = rowbase + q0 + qloc;
    const unsigned lds0 = (unsigned)(size_t)lds;
    LAS float* kml = (LAS float*)(lds + 73728); LAS unsigned* mwl = (LAS unsigned*)(lds + 65536);
    bf16x8 qf[4];
#pragma unroll
    for (int ks = 0; ks < 4; ++ks) qf[ks] = *(const bf16x8*)(qkv + qrow * QP + CQ + 64 * h + 16 * ks + 8 * hi);
    const bf16_t* ksrc = qkv + (rowbase + lane) * QP + CK + 64 * h + 8 * w;
    const bf16_t* vsrc = qkv + (rowbase + 16 * (w & 3) + (lane >> 2)) * QP + CV + 64 * h + 32 * (w >> 2) + 8 * (lane & 3);
    const unsigned* msrc = maskg + qrow * 128 + hi;
    const int NT = 4 * qt + 4, wlim = 4 * qt + (w >> 1);
    const unsigned kdst0 = (unsigned)__builtin_amdgcn_readfirstlane(lds0 + w * 1024), mdst0 = (unsigned)__builtin_amdgcn_readfirstlane(lds0 + 65536 + w * 256);
    __syncthreads();
#pragma unroll
    for (int d = 0; d < D; ++d) { const int t = d < NT ? d : NT - 1;
        glds16(ksrc + (size_t)t * 64 * QP, kdst0 + d * SLOT); glds16(vsrc + (size_t)t * 64 * QP, kdst0 + d * SLOT + 8192);
        if (MODE == 1) glds4(msrc + 2 * t, mdst0 + d * 2048); }
    unsigned selbits = 0;
    if (MODE == 0) {
        if (tid < 256) ((LAS f32x4*)kml)[tid] = ((const f32x4*)(kmean + (size_t)((b * 4 + h) * 16) * 64))[tid];
        __syncthreads();
        if (qt > 0) {
            float qv[32];
#pragma unroll
            for (int ks = 0; ks < 4; ++ks) { const u32x4 qq = __builtin_bit_cast(u32x4, qf[ks]);
#pragma unroll
                for (int k = 0; k < 4; ++k) { qv[8 * ks + 2 * k] = bf_lo(qq[k]); qv[8 * ks + 2 * k + 1] = bf_hi(qq[k]); } }
            float v1 = NEG_INF, v2 = NEG_INF, v3 = NEG_INF; int i1 = -1, i2 = -1, i3 = -1;
#pragma unroll 1
            for (int j = 0; j < qt; ++j) {
                float g = 0.f;
#pragma unroll
                for (int ks = 0; ks < 4; ++ks) { const f32x4 k0 = *(const LAS f32x4*)(kml + j * 64 + 16 * ks + 8 * hi), k1 = *(const LAS f32x4*)(kml + j * 64 + 16 * ks + 8 * hi + 4);
                    g += qv[8 * ks + 0] * k0[0] + qv[8 * ks + 1] * k0[1] + qv[8 * ks + 2] * k0[2] + qv[8 * ks + 3] * k0[3] + qv[8 * ks + 4] * k1[0] + qv[8 * ks + 5] * k1[1] + qv[8 * ks + 6] * k1[2] + qv[8 * ks + 7] * k1[3]; }
                g = sum_xor32(g);
                if (g > v1) { v3 = v2; i3 = i2; v2 = v1; i2 = i1; v1 = g; i1 = j; }
                else if (g > v2) { v3 = v2; i3 = i2; v2 = g; i2 = j; }
                else if (g > v3) { v3 = g; i3 = j; }
            }
            if (i1 >= 0) selbits |= 1u << i1; if (i2 >= 0) selbits |= 1u << i2; if (i3 >= 0) selbits |= 1u << i3;
        }
    }
    const int vboff = (4 * hi + ((lane & 15) >> 2)) * 64 + ((lane >> 4) & 1) * 32 + (lane & 3) * 8;
    float m_run = -1e30f, l_run = 0.f; f32x16 o[2]; o[0] = splat16(0.f); o[1] = splat16(0.f);
    int scur = 0, siss = D;
    asm volatile("s_waitcnt vmcnt(0)" ::: "memory");
    asm volatile("" : "+v"(qf[0]), "+v"(qf[1]), "+v"(qf[2]), "+v"(qf[3]));
#pragma unroll 1
    for (int kt = 0; kt < NT; ++kt) {
        if (MODE == 1) WAITV_BAR(6); else WAITV_BAR(4);
        { const int t = kt + D < NT ? kt + D : NT - 1;
          glds16(ksrc + (size_t)t * 64 * QP, kdst0 + siss * SLOT); glds16(vsrc + (size_t)t * 64 * QP, kdst0 + siss * SLOT + 8192);
          if (MODE == 1) glds4(msrc + 2 * t, mdst0 + siss * 2048); }
        const LAS unsigned char* cur = lds + scur * SLOT;
        if (MODE == 0) {
            const int j = kt >> 2;
            if (j < qt) { const bool sel = (selbits >> j) & 1u; if (__ballot(sel) != 0ull) flash_step<FAST, 2>(m_run, l_run, o, cur, cur + 8192, QReg{qf}, MaskLane{sel ? 0.f : NEG_INF}, r32, hi, vboff); }
            else { const int kb0 = 64 * (kt & 3); if (kb0 <= 32 * w + 31) flash_step<FAST, 2>(m_run, l_run, o, cur, cur + 8192, QReg{qf}, MaskCausal{kb0, qloc, hi}, r32, hi, vboff); }
        } else {
            if (kt <= wlim) { const LAS unsigned* mp = mwl + scur * 512 + w * 64; const unsigned cw0 = mp[r32], cw1 = mp[32 + r32];
                flash_step<FAST, 2>(m_run, l_run, o, cur, cur + 8192, QReg{qf}, MaskBits{~cw0 >> (4 * hi), ~cw1 >> (4 * hi)}, r32, hi, vboff); }
        }
        scur = scur + 1 == NS ? 0 : scur + 1; siss = siss + 1 == NS ? 0 : siss + 1;
    }
    asm volatile("s_waitcnt vmcnt(0)" ::: "memory");
    const float inv = 1.0f / sum_xor32(l_run);
    bf16_t* orow = obuf + qrow * 256 + 64 * h;
#pragma unroll
    for (int db = 0; db < 2; ++db)
#pragma unroll
        for (int g = 0; g < 4; ++g)
            *(u32x2*)(orow + 32 * db + 8 * g + 4 * hi) = (u32x2){cvt_pk_bf16(o[db][4 * g] * inv, o[db][4 * g + 1] * inv), cvt_pk_bf16(o[db][4 * g + 2] * inv, o[db][4 * g + 3] * inv)};
}

template <bool FAST>
__device__ __forceinline__ void attn_c_unit(int b, int h, int qt, const bf16_t* qkv, bf16_t* oc, float lam, const float* subg, float coef, LAS unsigned char* lds, int tid, int lane, int w) {
    const int r32 = lane & 31, hi = lane >> 5;
    const size_t rowbase = (size_t)b * SEQ; const int q0 = 256 * qt, qloc = 32 * w + r32; const size_t qrow = rowbase + q0 + qloc;
    LAS unsigned char* qimg = lds + 65536 + w * 8192 + lane * 16;
    __syncthreads();
#pragma unroll
    for (int ks = 0; ks < 4; ++ks) { *(LAS bf16x8*)(qimg + ks * 1024) = *(const bf16x8*)(qkv + qrow * QP + C_Q1 + 64 * h + 16 * ks + 8 * hi); *(LAS bf16x8*)(qimg + 4096 + ks * 1024) = *(const bf16x8*)(qkv + qrow * QP + C_Q2 + 64 * h + 16 * ks + 8 * hi); }
    const bf16_t* k1src = qkv + (rowbase + lane) * QP + C_K1 + 64 * h + 8 * w;
    const bf16_t* k2src = k1src + (C_K2 - C_K1);
    const bf16_t* v0src = qkv + (rowbase + 16 * (w & 3) + (lane >> 2)) * QP + C_VC + 128 * h + 32 * (w >> 2) + 8 * (lane & 3);
    const bf16_t* v1src = v0src + 64;
    const int vboff = (4 * hi + ((lane & 15) >> 2)) * 64 + ((lane >> 4) & 1) * 32 + (lane & 3) * 8;
    const int NT = 4 * qt + 4;
    float m1 = -1e30f, l1 = 0.f, m2 = -1e30f, l2 = 0.f; f32x16 o1[4], o2[4];
#pragma unroll
    for (int i = 0; i < 4; ++i) { o1[i] = splat16(0.f); o2[i] = splat16(0.f); }
    dma16(k1src, lds + w * 1024); dma16(k2src, lds + 8192 + w * 1024); dma16(v0src, lds + 16384 + w * 1024); dma16(v1src, lds + 16384 + 8192 + w * 1024);
    DMA_WAIT_SYNC();
#pragma unroll 1
    for (int kt = 0; kt < NT; ++kt) {
        LAS unsigned char* cur = lds + (kt & 1) * 32768; LAS unsigned char* nxt = lds + ((kt + 1) & 1) * 32768;
        if (kt + 1 < NT) { const size_t adv = (size_t)(kt + 1) * 64 * QP;
            dma16(k1src + adv, nxt + w * 1024); dma16(k2src + adv, nxt + 8192 + w * 1024); dma16(v0src + adv, nxt + 16384 + w * 1024); dma16(v1src + adv, nxt + 16384 + 8192 + w * 1024); }
        const bool band = kt >= 4 * qt; const int kb0 = 64 * (kt & 3);
        if (!band || kb0 <= 32 * w + 31) { const MaskCausalIf mk{band, kb0, qloc, hi};
            flash_step<FAST, 4>(m1, l1, o1, cur, cur + 16384, QLds{qimg}, mk, r32, hi, vboff); flash_step<FAST, 4>(m2, l2, o2, cur + 8192, cur + 16384, QLds{qimg + 4096}, mk, r32, hi, vboff); }
        DMA_WAIT_SYNC();
    }
    const float i1 = 1.0f / sum_xor32(l1), i2 = lam / sum_xor32(l2);
    float ss = 0.f;
#pragma unroll
    for (int db = 0; db < 4; ++db) { o1[db] = o1[db] * i1 - o2[db] * i2;
#pragma unroll
        for (int r = 0; r < 16; ++r) ss += o1[db][r] * o1[db][r]; }
    ss = sum_xor32(ss);
    const float rn = coef / sqrtf(ss * (1.0f / 128.0f) + EPS);
    bf16_t* orow = oc + qrow * 512 + 128 * h;
#pragma unroll
    for (int db = 0; db < 4; ++db)
#pragma unroll
        for (int g = 0; g < 4; ++g) { const int d = 32 * db + 8 * g + 4 * hi; const f32x4 gg = *(const f32x4*)(subg + d);
            *(u32x2*)(orow + d) = (u32x2){cvt_pk_bf16(o1[db][4 * g] * rn * gg[0], o1[db][4 * g + 1] * rn * gg[1]), cvt_pk_bf16(o1[db][4 * g + 2] * rn * gg[2], o1[db][4 * g + 3] * rn * gg[3])}; }
}

__device__ __forceinline__ void index_unit(int b, int i64, const bf16_t* qkv, unsigned* maskg, unsigned char* scr, LAS unsigned char* lds, int tid, int lane, int w) {
    constexpr int NS = 5, D = 4, HS = 257, RING = 84224, TOFF = 65792, TROW = 144;
    const int r32 = lane & 31, hi = lane >> 5;
    const unsigned lds0 = (unsigned)(size_t)lds;
    LAS unsigned* hist = (LAS unsigned*)lds; LAS unsigned char* ring = lds + RING; LAS unsigned char* mb8 = lds;
    LAS int* thrB1 = (LAS int*)(lds + 125184); LAS int* thrRem = thrB1 + 64; LAS int* thrT = thrB1 + 128; LAS int* thrNeed = thrB1 + 192;
    const size_t rowbase = (size_t)b * SEQ; const int q0 = 64 * i64, NT = i64 + 1;
    __syncthreads();
    {
        const int hh = 4 * ((r32 >> 3) & 1) + (r32 & 3), qp = 2 * (r32 >> 4) + ((r32 >> 2) & 1);
        bf16x8 aq[2][4]; float wv[2][2][8];
#pragma unroll
        for (int rb = 0; rb < 2; ++rb) {
            const size_t row = rowbase + q0 + 8 * w + 4 * rb + qp;
#pragma unroll
            for (int ks = 0; ks < 4; ++ks) aq[rb][ks] = *(const bf16x8*)(qkv + row * QP + C_QI + 64 * hh + 16 * ks + 8 * hi);
#pragma unroll
            for (int hf = 0; hf < 2; ++hf) { const u32x4 ww = *(const u32x4*)(qkv + (rowbase + q0 + 8 * w + 4 * rb + 2 * hf + hi) * QP + C_WI);
#pragma unroll
                for (int k = 0; k < 4; ++k) { wv[rb][hf][2 * k] = bf_lo(ww[k]); wv[rb][hf][2 * k + 1] = bf_hi(ww[k]); } }
        }
#pragma unroll
        for (int rb = 0; rb < 2; ++rb) { asm volatile("" : "+v"(aq[rb][0]), "+v"(aq[rb][1]), "+v"(aq[rb][2]), "+v"(aq[rb][3]));
#pragma unroll
            for (int hf = 0; hf < 2; ++hf) asm volatile("" : "+v"(wv[rb][hf][0]), "+v"(wv[rb][hf][1]), "+v"(wv[rb][hf][2]), "+v"(wv[rb][hf][3]), "+v"(wv[rb][hf][4]), "+v"(wv[rb][hf][5]), "+v"(wv[rb][hf][6]), "+v"(wv[rb][hf][7])); }
        const bf16_t* ksrc = qkv + (rowbase + lane) * QP + C_KI + 8 * w;
        const unsigned kdst0 = (unsigned)__builtin_amdgcn_readfirstlane(lds0 + RING + w * 1024);
#pragma unroll
        for (int d = 0; d < D; ++d) { const int t = d < NT ? d : NT - 1; glds16(ksrc + (size_t)t * 64 * QP, kdst0 + d * 8192); }
        for (int i = tid; i < 4112; i += 512) ((LAS u32x4*)hist)[i] = (u32x4){0u, 0u, 0u, 0u};
        asm volatile("s_waitcnt lgkmcnt(0)" ::: "memory");
        unsigned char* srow = scr + (size_t)lane * 8192 + w * 16;
        int scur = 0, siss = D;
#pragma unroll 1
        for (int kt = 0; kt <= NT; ++kt) {
            if (kt < NT) WAITV_BAR(3); else { asm volatile("s_waitcnt vmcnt(0)" ::: "memory"); __syncthreads(); }
            if (kt > 0) {
                const u32x4 kk = *(const LAS u32x4*)(lds + TOFF + ((kt - 1) & 1) * 9216 + lane * TROW + w * 16);
                if (kt < NT) asm volatile("global_store_dwordx4 %0, %1, off" :: "v"(srow + (size_t)(kt - 1) * 128), "v"(kk) : "memory");
                else *(u32x4*)(srow + (size_t)(kt - 1) * 128) = kk;
#pragma unroll
                for (int k = 0; k < 4; ++k) { const unsigned a = kk[k] & 0xffffu, c = kk[k] >> 16;
                    if (a) __hip_atomic_fetch_add(&hist[lane * HS + (a >> 8)], 1u, __ATOMIC_RELAXED, __HIP_MEMORY_SCOPE_WORKGROUP);
                    if (c) __hip_atomic_fetch_add(&hist[lane * HS + (c >> 8)], 1u, __ATOMIC_RELAXED, __HIP_MEMORY_SCOPE_WORKGROUP); }
            }
            if (kt == NT) break;
            { const int t = kt + D < NT ? kt + D : NT - 1; glds16(ksrc + (size_t)t * 64 * QP, kdst0 + siss * 8192); }
            const LAS unsigned char* kimg = ring + scur * 8192;
            const bool diag = kt == NT - 1;
#pragma unroll
            for (int rb = 0; rb < 2; ++rb)
#pragma unroll
                for (int kb = 0; kb < 2; ++kb) {
                    f32x16 d = splat16(0.f);
#pragma unroll
                    for (int ks = 0; ks < 4; ++ks) d = mfma32(aq[rb][ks], *(const LAS bf16x8*)(kimg + (2 * ks + hi) * 1024 + (32 * kb + r32) * 16), d);
#pragma unroll
                    for (int hf = 0; hf < 2; ++hf) {
                        float sc = 0.f;
#pragma unroll
                        for (int t = 0; t < 8; ++t) sc += wv[rb][hf][t] * fmaxf(d[8 * hf + t], 0.f);
                        const int ql = 8 * w + 4 * rb + 2 * hf + hi;
                        const unsigned u = (unsigned)__builtin_bit_cast(unsigned short, (_Float16)sc);
                        unsigned key = u ^ ((u & 0x8000u) ? 0xffffu : 0x8000u);
                        if (diag && 32 * kb + r32 > ql) key = 0u;
                        *(LAS unsigned short*)(lds + TOFF + (kt & 1) * 9216 + ql * TROW + (32 * kb + r32) * 2) = (unsigned short)key;
                    }
                }
            scur = scur + 1 == NS ? 0 : scur + 1; siss = siss + 1 == NS ? 0 : siss + 1;
        }
        asm volatile("s_waitcnt vmcnt(0)" ::: "memory");
        __syncthreads();
    }
#define IDX_SEARCH(STAGE) do { _Pragma("unroll 1") for (int qq = 0; qq < 8; ++qq) { const int q = 8 * w + qq; int target; \
        if (STAGE == 0) { if (q0 + q + 1 <= 256) { if (lane == 0) { thrB1[q] = 0x10000; thrRem[q] = 0; } continue; } target = 256; } \
        else { if (thrB1[q] == 0x10000) { if (lane == 0) { thrT[q] = 0; thrNeed[q] = 0; } continue; } target = thrRem[q]; } \
        const LAS unsigned* hp = hist + q * HS + 4 * lane; const int h0 = (int)hp[0], h1 = (int)hp[1], h2 = (int)hp[2], h3 = (int)hp[3]; \
        int P = h0 + h1 + h2 + h3; const int s_ = P; \
        _Pragma("unroll") for (int o = 1; o < 64; o <<= 1) { const int t_ = lane_val(P, (lane - o) & 63); if (lane >= o) P += t_; } \
        const int above = __builtin_amdgcn_readlane(P, 63) - P; (void)s_; \
        const int c3 = above + h3, c2 = c3 + h2, c1 = c2 + h1, c0 = c1 + h0; int bin = -1, ab = 0; \
        if (above < target && c3 >= target) { bin = 4 * lane + 3; ab = above; } else if (c3 < target && c2 >= target) { bin = 4 * lane + 2; ab = c3; } \
        else if (c2 < target && c1 >= target) { bin = 4 * lane + 1; ab = c2; } else if (c1 < target && c0 >= target) { bin = 4 * lane; ab = c1; } \
        if (bin >= 0) { if (STAGE == 0) { thrB1[q] = bin; thrRem[q] = target - ab; } else { thrT[q] = (thrB1[q] << 8) | bin; thrNeed[q] = target - ab; } } } \
        __syncthreads(); } while (0)
    IDX_SEARCH(0);
    const int qs = 8 * w + (lane >> 3), pc = lane & 7;
    const unsigned char* rrow = scr + (size_t)qs * 8192 + pc * 16;
    {
        __builtin_amdgcn_fence(__ATOMIC_ACQUIRE, "agent");
        asm volatile("s_waitcnt vmcnt(0)" ::: "memory");
        const int b1 = thrB1[qs];
        for (int i = tid; i < 4112; i += 512) ((LAS u32x4*)hist)[i] = (u32x4){0u, 0u, 0u, 0u};
        __syncthreads();
#pragma unroll 4
        for (int it = 0; it < NT; ++it) { const u32x4 kk = *(const u32x4*)(rrow + (size_t)it * 128);
#pragma unroll
            for (int k = 0; k < 4; ++k) { const unsigned a = kk[k] & 0xffffu, c = kk[k] >> 16;
                if ((int)(a >> 8) == b1) __hip_atomic_fetch_add(&hist[qs * HS + (a & 255u)], 1u, __ATOMIC_RELAXED, __HIP_MEMORY_SCOPE_WORKGROUP);
                if ((int)(c >> 8) == b1) __hip_atomic_fetch_add(&hist[qs * HS + (c & 255u)], 1u, __ATOMIC_RELAXED, __HIP_MEMORY_SCOPE_WORKGROUP); } }
        __syncthreads();
    }
    IDX_SEARCH(1);
    {
        const unsigned T = (unsigned)thrT[qs]; const int need = thrNeed[qs]; int tc = 0;
        __syncthreads();
#pragma unroll 2
        for (int it = 0; it < NT; ++it) { const u32x4 kk = *(const u32x4*)(rrow + (size_t)it * 128);
            unsigned sel = 0, eq = 0;
#pragma unroll
            for (int k = 0; k < 4; ++k) { const unsigned a = kk[k] & 0xffffu, c = kk[k] >> 16;
                sel |= (a > T ? 1u : 0u) << (2 * k); sel |= (c > T ? 1u : 0u) << (2 * k + 1); eq |= (a == T ? 1u : 0u) << (2 * k); eq |= (c == T ? 1u : 0u) << (2 * k + 1); }
            if (T == 0u) eq = 0u;
            if (__ballot(eq != 0u) != 0ull) {
                const int n = __popc(eq); int P = n;
#pragma unroll
                for (int o = 1; o < 8; o <<= 1) { const int t_ = lane_val(P, (lane - o) & 63); if ((lane & 7) >= o) P += t_; }
                int allow = need - tc - (P - n);
#pragma unroll
                for (int k = 0; k < 8; ++k) if (((eq >> k) & 1u) && allow > 0) { sel |= 1u << k; --allow; }
                tc += lane_val(P, (lane & ~7) + 7);
            }
            mb8[qs * 512 + it * 8 + pc] = (unsigned char)sel;
        }
        __syncthreads();
    }
#undef IDX_SEARCH
    for (int idx = tid; idx < 64 * 2 * NT; idx += 512) { const int q = idx / (2 * NT), wd = idx - q * 2 * NT; maskg[(rowbase + q0 + q) * 128 + wd] = ((const LAS unsigned*)mb8)[q * 128 + wd]; }
}

__device__ __forceinline__ int next_unit(unsigned* ctr, LAS unsigned char* lds, int tid) {
    volatile LAS int* bc = (volatile LAS int*)(lds + LX_BC);
    __syncthreads();
    if (tid == 0) *bc = (int)__hip_atomic_fetch_add(ctr, 1u, __ATOMIC_RELAXED, __HIP_MEMORY_SCOPE_AGENT);
    __syncthreads();
    return *bc;
}

__device__ __forceinline__ void m1_phase(const Args& a, unsigned char* ws, int lc, LAS unsigned char* lds, int lane, int wave, int vcu, int G) {
    const int l = lc & 1;
    const float* wrt = (const float*)(ws + WS_WRT);
    const float* bg = a.in[I_B_GROUP] + l * 4; const float* br = a.in[I_B_ROUTER] + l * 32;
    unsigned* cnt = (unsigned*)(ws + WS_CTL) + CW_CNT + 2048 * lc;
    unsigned* rt0 = (unsigned*)(ws + WS_RT0); unsigned* rt1 = (unsigned*)(ws + WS_RT1); f32x2* rtw = (f32x2*)(ws + WS_RTW);
    const int r32 = lane & 31, kh = lane >> 5, wq = wave & 3, kpart = wave >> 2;
    LAS float* tl = (LAS float*)(lds + wq * 8192);
    LAS float* tss = tl + 32 * 40;
#pragma unroll 1
    for (int t = wq * G + vcu; t < MTOK / 32; t += 4 * G) {
        const float* xrow = a.out + (size_t)(32 * t + r32) * DM + 512 * kpart + 4 * kh;
        const float* wp0 = wrt + (size_t)r32 * DM + 512 * kpart + 4 * kh; const float* wp1 = wrt + (size_t)(32 + (r32 & 3)) * DM + 512 * kpart + 4 * kh;
        f32x16 d0 = splat16(0.f), d1 = splat16(0.f); float ss = 0.f;
#pragma unroll 8
        for (int m = 0; m < 64; ++m) {
            const f32x4 xa = *(const f32x4*)(xrow + 8 * m), b0 = *(const f32x4*)(wp0 + 8 * m), b1 = *(const f32x4*)(wp1 + 8 * m);
            ss += (xa[0] * xa[0] + xa[1] * xa[1]) + (xa[2] * xa[2] + xa[3] * xa[3]);
#pragma unroll
            for (int i = 0; i < 4; ++i) { d0 = __builtin_amdgcn_mfma_f32_32x32x2f32(xa[i], b0[i], d0, 0, 0, 0); d1 = __builtin_amdgcn_mfma_f32_32x32x2f32(xa[i], b1[i], d1, 0, 0, 0); }
        }
        ss = sum_xor32(ss);
        if (kpart == 1) {
#pragma unroll
            for (int r = 0; r < 16; ++r) { tl[crow(r, kh) * 40 + r32] = d0[r]; if (r32 < 4) tl[crow(r, kh) * 40 + 32 + r32] = d1[r]; }
            if (kh == 0) tss[r32] = ss;
        }
        __syncthreads();
        if (kpart == 0) {
#pragma unroll
            for (int r = 0; r < 16; ++r) { tl[crow(r, kh) * 40 + r32] += d0[r]; if (r32 < 4) tl[crow(r, kh) * 40 + 32 + r32] += d1[r]; }
            ss += tss[r32];
            LDS_WAIT(); asm volatile("" ::: "memory");
            const float rstd = 1.0f / sqrtf(ss * (1.0f / DM) + EPS);
            const LAS float* my = tl + r32 * 40;
            float gl[4];
#pragma unroll
            for (int c = 0; c < 4; ++c) gl[c] = my[c] * rstd + bg[c];
            int g = 0; float gm = gl[0];
#pragma unroll
            for (int c = 1; c < 4; ++c) if (gl[c] > gm) { gm = gl[c]; g = c; }
            float den = 0.f;
#pragma unroll
            for (int c = 0; c < 4; ++c) den += __expf(gl[c] - gm);
            const float gwt = 1.0f / den;
            float le[8];
#pragma unroll
            for (int e = 0; e < 8; ++e) le[e] = my[4 + 8 * g + e] * rstd + br[8 * g + e];
            int i1 = 0; float v1 = le[0];
#pragma unroll
            for (int e = 1; e < 8; ++e) if (le[e] > v1) { v1 = le[e]; i1 = e; }
            int i2 = -1; float v2 = NEG_INF;
#pragma unroll
            for (int e = 0; e < 8; ++e) if (e != i1 && le[e] > v2) { v2 = le[e]; i2 = e; }
            const float ex = __expf(v2 - v1), w1 = 1.0f / (1.0f + ex), w2 = ex * w1;
            if (kh == 0) { const int e0 = g * 8 + i1, e1 = g * 8 + i2, m = 32 * t + r32;
                const unsigned r0 = atomicAdd(cnt + 64 * e0, 1u), r1 = atomicAdd(cnt + 64 * e1, 1u);
                rt0[m] = ((unsigned)e0 << 24) | r0; rt1[m] = ((unsigned)e1 << 24) | r1; rtw[m] = (f32x2){gwt * w1, gwt * w2}; }
        }
        __syncthreads();
    }
}
__device__ __forceinline__ void build_tables(const unsigned* cnt, LAS unsigned char* lds, int tid) {
    LAS int* pstart = (LAS int*)(lds + LX_PSTART); LAS int* blk2e = (LAS int*)(lds + LX_BLK2E);
    if (tid < 64) {
        const int c = tid < NEXP ? (int)cnt[64 * tid] : 0, nb = (c + 255) >> 8;
        int P = nb;
#pragma unroll
        for (int o = 1; o < 64; o <<= 1) { const int t = lane_val(P, (tid - o) & 63); if (tid >= o) P += t; }
        const int pb = P - nb;
        if (tid <= NEXP) pstart[tid] = pb * 256;
        if (tid == NEXP) *(LAS int*)(lds + LX_NBLK) = pb < MAXBLK ? pb : MAXBLK;
#pragma unroll 1
        for (int k = 0; k < nb; ++k) if (pb + k < MAXBLK) blk2e[pb + k] = tid;
    }
    __syncthreads();
}
__device__ __forceinline__ void m2_phase(const Args& a, unsigned char* ws, int l, LAS unsigned char* lds, int lane, int wave, int vcu, int G) {
    const int gw = vcu * 8 + wave, NGW = G * 8;
    const float* gain = a.in[I_NORM_FFN] + (size_t)l * DM; const LAS int* pstart = (const LAS int*)(lds + LX_PSTART);
    const unsigned* rt0 = (const unsigned*)(ws + WS_RT0); const unsigned* rt1 = (const unsigned*)(ws + WS_RT1); bf16_t* xb = (bf16_t*)(ws + WS_XB);
    for (int m = gw; m < MTOK; m += NGW) {
        f32x4 v[4]; float ss = 0.f;
#pragma unroll
        for (int j = 0; j < 4; ++j) { v[j] = ((const f32x4*)(a.out + (size_t)m * DM))[lane + 64 * j]; ss += (v[j][0] * v[j][0] + v[j][1] * v[j][1]) + (v[j][2] * v[j][2] + v[j][3] * v[j][3]); }
        const float rstd = 1.0f / sqrtf(wave_sum(ss) * (1.0f / DM) + EPS);
        const unsigned ua = rt0[m], ub = rt1[m];
        const size_t s0 = (size_t)(pstart[ua >> 24] + (int)(ua & 0xffffffu)), s1 = (size_t)(pstart[ub >> 24] + (int)(ub & 0xffffffu));
#pragma unroll
        for (int j = 0; j < 4; ++j) { const f32x4 o = v[j] * rstd * ((const f32x4*)gain)[lane + 64 * j]; const u32x2 pk = (u32x2){cvt_pk_bf16(o[0], o[1]), cvt_pk_bf16(o[2], o[3])};
            ((u32x2*)(xb + s0 * DM))[lane + 64 * j] = pk; ((u32x2*)(xb + s1 * DM))[lane + 64 * j] = pk; }
    }
}

#ifndef PHASES
#define PHASES 0xFFFF
#endif
#define PH(n) if constexpr (((PHASES) >> (n)) & 1)
#ifndef REPEAT_MASK
#define REPEAT_MASK 0
#endif
#define REP(k) for (int rep_ = 0; rep_ < 1 + (((REPEAT_MASK) >> (k)) & 1); ++rep_)
#ifndef GEMM_ALIGN
#define GEMM_ALIGN true
#endif
#ifndef GEMM_SP2
#define GEMM_SP2 true
#endif
#define PHASE_ENV() unsigned long long wsi_ = (unsigned long long)args.ws; int G = (int)gridDim.x, bx = (int)blockIdx.x; asm volatile("" : "+s"(wsi_), "+s"(G), "+s"(bx)); \
    unsigned char* const ws = (unsigned char*)(GAS unsigned char*)wsi_; const int vcu = (G % 8 == 0) ? (bx % 8) * (G / 8) + bx / 8 : bx;   \
    int tid = (int)threadIdx.x; asm volatile("" : "+v"(tid)); const int lane = tid & 63, wave = __builtin_amdgcn_readfirstlane(tid >> 6); \
    unsigned* const ctl = (unsigned*)(ws + WS_CTL); bf16_t* const QKV = (bf16_t*)(ws + WS_QKV); unsigned char* const SG = ws + WS_SG; unsigned* const MASK = (unsigned*)(ws + WS_MASK); float* const KMEAN = (float*)(ws + WS_KMEAN); \
    (void)lane; (void)wave; (void)ctl; (void)QKV; (void)SG; (void)MASK; (void)KMEAN; (void)vcu
#define GRID_BAR() do { unsigned long long wb_ = (unsigned long long)args.ws; asm volatile("" : "+s"(wb_)); XcdBarrier b_ = bar0; b_.bar = (unsigned*)((GAS unsigned char*)wb_ + WS_CTL) + CW_BAR; asm volatile("" : "+s"(b_.x)); xcd_barrier(b_); if (((REPEAT_MASK) >> 12) & 1) xcd_barrier(b_); } while (0)


template <int L> __device__ __forceinline__ void layer_body(const Args& args, LAS unsigned char* lds, const XcdBarrier& bar0) {
    constexpr int l = L;

        PH(0) for (int rep_ = 0; rep_ < 1 + ((((REPEAT_MASK) >> 0) & 1) && l == 0); ++rep_) { PHASE_ENV(); p0_phase(args, ws, l, lds, tid, lane, wave, vcu, G); }
        GRID_BAR();
        PH(1) REP(1) { PHASE_ENV();
            pg8::Gemm g{(const bf16_t*)(ws + WS_HN), (const bf16_t*)(ws + WS_WIN), MTOK, NT_IN * 256, DM}; pg8::StaticOrder S; S.init(MTOK, NT_IN * 256, G, bx);
            pg8::EpiInProj E{QKV, SG, (const float*)(ws + WS_COS), (const float*)(ws + WS_SIN), args.in[I_QK_GAIN] + l * 6 * 64, args.in[I_IDX_K_GAIN] + l * 64};
            pg8::gemm_phase<pg8::EpiInProj, pg8::StaticOrder, GEMM_ALIGN, GEMM_SP2>(lds, g, S, E);
        }
        GRID_BAR();
        { PHASE_ENV();
            LAS float* red = (LAS float*)lds;
            for (int it = bx; it < NBATCH * 4 * 16; it += G) { const int b = it >> 6, h = (it >> 4) & 3, blk = it & 15, d = tid & 63, rg = tid >> 6;
                const bf16_t* kp = QKV + ((size_t)b * SEQ + blk * 256 + rg * 32) * QP + C_KA + 64 * h + d; float s = 0.f;
#pragma unroll 8
                for (int r = 0; r < 32; ++r) s += __builtin_bit_cast(float, (unsigned)kp[(size_t)r * QP] << 16);
                __syncthreads(); red[tid] = s; __syncthreads();
                if (tid < 64) { float t = 0.f;
#pragma unroll
                    for (int k = 0; k < 8; ++k) t += red[k * 64 + tid];
                    KMEAN[(size_t)it * 64 + tid] = t * (1.0f / 256.0f); } }
            __syncthreads();
        }
        PH(2) REP(2) { PHASE_ENV();
            const float* dl = args.in[I_DIFF_LAMBDA] + l * 256;
            const float lam_init = 0.8f - 0.6f * __expf(-0.3f * (float)l);
            const float lam = __expf(wave_sum(dl[lane] * dl[64 + lane])) - __expf(wave_sum(dl[128 + lane] * dl[192 + lane])) + lam_init;
            const float* subg = args.in[I_DIFF_SUBLN] + l * 128;
            unsigned* qc = ctl + CW_QUEUE + 64 * (l * 4 + 0 + 8 * rep_);
            const float* qkg = args.in[I_QK_GAIN] + l * 6 * 64;
            if (softmax_ref0_ok(qkg + 4 * 64, qkg + 5 * 64, lane)) { for (;;) { const int u = next_unit(qc, lds, tid); if (u >= 512) break; const int r = u & 31; attn_c_unit<true>(r >> 2, r & 3, 15 - (u >> 5), QKV, (bf16_t*)(ws + WS_OC), lam, subg, 1.0f - lam_init, lds, tid, lane, wave); } }
            else { for (;;) { const int u = next_unit(qc, lds, tid); if (u >= 512) break; const int r = u & 31; attn_c_unit<false>(r >> 2, r & 3, 15 - (u >> 5), QKV, (bf16_t*)(ws + WS_OC), lam, subg, 1.0f - lam_init, lds, tid, lane, wave); } }
        }
        PH(3) REP(3) { PHASE_ENV();
            unsigned* qi = ctl + CW_QUEUE + 64 * (l * 4 + 1 + 8 * rep_);
            for (;;) { const int u = next_unit(qi, lds, tid); if (u >= 512) break; index_unit(u & 7, 63 - (u >> 3), QKV, MASK, ws + WS_WGU + (size_t)bx * 524288, lds, tid, lane, wave); }
        }
        GRID_BAR();
        PH(4) REP(4) { PHASE_ENV();
            unsigned* qa = ctl + CW_QUEUE + 64 * (l * 4 + 2 + 8 * rep_);
            const float* qkg = args.in[I_QK_GAIN] + l * 6 * 64;
            if (softmax_ref0_ok(qkg, qkg + 64, lane)) { for (;;) { const int u = next_unit(qa, lds, tid); if (u >= 512) break; const int r = u & 31; attn_ab_unit<0, true>(r >> 2, r & 3, 15 - (u >> 5), QKV, (bf16_t*)(ws + WS_OA), KMEAN, MASK, lds, tid, lane, wave); } }
            else { for (;;) { const int u = next_unit(qa, lds, tid); if (u >= 512) break; const int r = u & 31; attn_ab_unit<0, false>(r >> 2, r & 3, 15 - (u >> 5), QKV, (bf16_t*)(ws + WS_OA), KMEAN, MASK, lds, tid, lane, wave); } }
        }
        PH(5) REP(5) { PHASE_ENV();
            unsigned* qb = ctl + CW_QUEUE + 64 * (l * 4 + 3 + 8 * rep_);
            const float* qkg = args.in[I_QK_GAIN] + l * 6 * 64;
            if (softmax_ref0_ok(qkg + 2 * 64, qkg + 3 * 64, lane)) { for (;;) { const int u = next_unit(qb, lds, tid); if (u >= 512) break; const int r = u & 31; attn_ab_unit<1, true>(r >> 2, r & 3, 15 - (u >> 5), QKV, (bf16_t*)(ws + WS_OB), KMEAN, MASK, lds, tid, lane, wave); } }
            else { for (;;) { const int u = next_unit(qb, lds, tid); if (u >= 512) break; const int r = u & 31; attn_ab_unit<1, false>(r >> 2, r & 3, 15 - (u >> 5), QKV, (bf16_t*)(ws + WS_OB), KMEAN, MASK, lds, tid, lane, wave); } }
        }
        GRID_BAR();
        PH(6) REP(6) {
            { PHASE_ENV(); pg8::StaticOrder S; S.init(MTOK, DM, G, bx); pg8::Gemm g{(const bf16_t*)(ws + WS_OA), (const bf16_t*)(ws + WS_WPA), MTOK, DM, 256}; pg8::EpiMerge<0> E{(bf16_t*)(ws + WS_MERGED), SG}; pg8::gemm_phase<pg8::EpiMerge<0>, pg8::StaticOrder, GEMM_ALIGN, GEMM_SP2>(lds, g, S, E); }
            { PHASE_ENV(); pg8::StaticOrder S; S.init(MTOK, DM, G, bx); pg8::Gemm g{(const bf16_t*)(ws + WS_OB), (const bf16_t*)(ws + WS_WPB), MTOK, DM, 256}; pg8::EpiMerge<1> E{(bf16_t*)(ws + WS_MERGED), SG}; pg8::gemm_phase<pg8::EpiMerge<1>, pg8::StaticOrder, GEMM_ALIGN, GEMM_SP2>(lds, g, S, E); }
            { PHASE_ENV(); pg8::StaticOrder S; S.init(MTOK, DM, G, bx); pg8::Gemm g{(const bf16_t*)(ws + WS_OC), (const bf16_t*)(ws + WS_WPC), MTOK, DM, 512}; pg8::EpiMerge<2> E{(bf16_t*)(ws + WS_MERGED), SG}; pg8::gemm_phase<pg8::EpiMerge<2>, pg8::StaticOrder, GEMM_ALIGN, GEMM_SP2>(lds, g, S, E); }
        }
        GRID_BAR();
        PH(7) for (int rep_ = 0; rep_ < 1 + ((((REPEAT_MASK) >> 7) & 1) && l == 0); ++rep_) { PHASE_ENV();
            pg8::Gemm g{(const bf16_t*)(ws + WS_MERGED), (const bf16_t*)(ws + WS_WO), MTOK, DM, DM}; pg8::StaticOrder S; S.init(MTOK, DM, G, bx);
            pg8::EpiResid E{l == 0 ? args.in[I_X] : args.out, args.out};
            pg8::gemm_phase<pg8::EpiResid, pg8::StaticOrder, GEMM_ALIGN, GEMM_SP2>(lds, g, S, E);
        }
        GRID_BAR();
        PH(8) REP(8) { PHASE_ENV(); m1_phase(args, ws, l + 2 * rep_, lds, lane, wave, vcu, G); if (rep_ == 0) convert_weights<true>(args, ws, l, lds, lane, wave, vcu, G); }
        GRID_BAR();
        { PHASE_ENV(); build_tables(ctl + CW_CNT + 2048 * (l + 2 * (((REPEAT_MASK) >> 8) & 1)), lds, tid);
          PH(9) REP(9) m2_phase(args, ws, l, lds, lane, wave, vcu, G); }
        GRID_BAR();
        PH(10) REP(10) { PHASE_ENV();
            const int nblk = *(const LAS int*)(lds + LX_NBLK);
            pg8::Gemm g{(const bf16_t*)(ws + WS_XB), (const bf16_t*)(ws + WS_WGU), MAXBLK * 256, NEXP * 1024, DM};
            pg8::MoeOrder S{nblk * 4, G, vcu, (const LAS int*)(lds + LX_BLK2E)};
            pg8::EpiGateUp E{(bf16_t*)(ws + WS_HID)};
            pg8::gemm_phase<pg8::EpiGateUp, pg8::MoeOrder, GEMM_ALIGN, GEMM_SP2>(lds, g, S, E);
        }
        GRID_BAR();
        PH(11) REP(11) { PHASE_ENV();
            const int nblk = *(const LAS int*)(lds + LX_NBLK);
            pg8::Gemm g{(const bf16_t*)(ws + WS_HID), (const bf16_t*)(ws + WS_WD), MAXBLK * 256, NEXP * 1024, DEXP};
            pg8::MoeOrder S{nblk * 4, G, vcu, (const LAS int*)(lds + LX_BLK2E)};
            pg8::EpiDown E{(bf16_t*)(ws + WS_Y)};
            pg8::gemm_phase<pg8::EpiDown, pg8::MoeOrder, GEMM_ALIGN, GEMM_SP2>(lds, g, S, E);
        }
        GRID_BAR();
    }

__global__ void __launch_bounds__(512, 2) fwd_kernel(Args args) {
    extern __shared__ __attribute__((aligned(16))) unsigned char lds_raw[];
    LAS unsigned char* lds = (LAS unsigned char*)lds_raw;
    for (int u = threadIdx.x; u < (LDS_BYTES - LDSX) / 4; u += 512) ((LAS unsigned*)(lds + LDSX))[u] = 0u;
    __syncthreads();
    const XcdBarrier bar0 = xcd_barrier_post((unsigned*)(args.ws + WS_CTL) + CW_BAR, (volatile LAS unsigned*)(lds + LX_BAR));
    layer_body<0>(args, lds, bar0);
    layer_body<1>(args, lds, bar0);
    { PHASE_ENV();
        const int gw = vcu * 8 + wave, NGW = G * 8; const LAS int* pstart = (const LAS int*)(lds + LX_PSTART);
        for (int m = gw; m < MTOK; m += NGW) token_row<true, false>(args.out, args.out, (const bf16_t*)(ws + WS_Y), (const unsigned*)(ws + WS_RT0), (const unsigned*)(ws + WS_RT1), (const f32x2*)(ws + WS_RTW), pstart, nullptr, nullptr, m, lane);
    }
}

extern "C" void kernel_launch(void* const* d_in, const int* in_sizes, int n_in, void* d_out, int out_size, void* d_ws, size_t ws_size, hipStream_t stream) {
    static int grid = 0;
    if (grid == 0) {
        if (n_in != N_INPUTS || in_sizes[0] != MTOK * DM || out_size != MTOK * DM || ws_size < WS_END) {
            fprintf(stderr, "kernel_launch: built for %d inputs, x/out of %d floats, >= %zu bytes of workspace; got n_in %d, in0 %d, out %d, ws %zu; nothing launched\n", (int)N_INPUTS, MTOK * DM, (size_t)WS_END, n_in, n_in > 0 ? in_sizes[0] : -1, out_size, ws_size);
            grid = -1; return; }
        int dev = 0, cus = 0;
        if (hipGetDevice(&dev) != hipSuccess || hipDeviceGetAttribute(&cus, hipDeviceAttributeMultiprocessorCount, dev) != hipSuccess) { fprintf(stderr, "kernel_launch: device query failed\n"); grid = -1; return; }
        if (hipFuncSetAttribute((const void*)fwd_kernel, hipFuncAttributeMaxDynamicSharedMemorySize, LDS_BYTES) != hipSuccess) { fprintf(stderr, "kernel_launch: hipFuncSetAttribute failed\n"); grid = -1; return; }
        int per_cu = 0;
        if (hipOccupancyMaxActiveBlocksPerMultiprocessor(&per_cu, (const void*)fwd_kernel, 512, LDS_BYTES) != hipSuccess || per_cu < 1) fprintf(stderr, "kernel_launch: note: occupancy query reports %d workgroups per CU\n", per_cu);
        (void)hipGetLastError();
        grid = cus;
    }
    if (grid < 0) return;
    if (hipMemsetAsync((char*)d_ws + WS_CTL, 0, CTL_BYTES, stream) != hipSuccess) { fprintf(stderr, "kernel_launch: memset failed\n"); return; }
    Args a{};
    for (int i = 0; i < N_INPUTS; ++i) a.in[i] = (const float*)d_in[i];
    a.out = (float*)d_out; a.ws = (unsigned char*)d_ws;
    hipLaunchKernelGGL(fwd_kernel, dim3(grid), dim3(512), LDS_BYTES, stream, a);
    const hipError_t le = hipPeekAtLastError();
    if (le != hipSuccess) fprintf(stderr, "kernel_launch: launch failed: %s\n", hipGetErrorName(le));
}
```

```cpp
#include <hip/hip_runtime.h>
#include <cstdio>
#include <cstdint>

#define LAS __attribute__((address_space(3)))
#define GAS __attribute__((address_space(1)))
typedef unsigned short bf16_t;
typedef short bf16x8 __attribute__((ext_vector_type(8)));
typedef short s16x4 __attribute__((ext_vector_type(4)));
typedef float f32x4 __attribute__((ext_vector_type(4)));
typedef float f32x2 __attribute__((ext_vector_type(2)));
typedef float f32x16 __attribute__((ext_vector_type(16)));
typedef unsigned u32x4 __attribute__((ext_vector_type(4)));
typedef unsigned u32x2 __attribute__((ext_vector_type(2)));

constexpr int NBATCH = 8, SEQ = 4096, MTOK = NBATCH * SEQ, DM = 1024, NLAYER = 2;
constexpr int QP = 3656;
constexpr int C_QA = 0, C_KA = 256, C_VA = 512, C_QB = 768, C_KB = 1024, C_VB = 1280, C_QI = 1536, C_KI = 2048, C_WI = 2112,
              C_Q1 = 2120, C_Q2 = 2376, C_K1 = 2632, C_K2 = 2888, C_VC = 3144, C_G = 3656, D_IN = 6728;
constexpr int NT_IN = 27;
constexpr int NEXP = 32, DEXP = 512, MAXBLK = 288;
constexpr float C2 = 0.125f * 1.4426950408889634f;
constexpr float EPS = 1e-6f;
#ifndef REF0_ENABLE
#define REF0_ENABLE 1
#endif

constexpr size_t MiB = 1u << 20;
constexpr size_t WS_CTL = 0, CTL_BYTES = 1 * MiB;
constexpr size_t WS_COS = 1 * MiB, WS_SIN = WS_COS + 512 * 1024;
constexpr size_t WS_SMALL = 2 * MiB;
constexpr size_t WS_KMEAN = WS_SMALL, WS_RT0 = WS_SMALL + 256 * 1024, WS_RT1 = WS_SMALL + 384 * 1024, WS_RTW = WS_SMALL + 512 * 1024, WS_WRT = WS_SMALL + 768 * 1024;
constexpr size_t WS_WIN = 3 * MiB;
constexpr size_t WS_WPA = 17 * MiB, WS_WPB = WS_WPA + 512 * 1024, WS_WPC = 18 * MiB;
constexpr size_t WS_WO = 19 * MiB;
constexpr size_t WS_WGU = 21 * MiB;
constexpr size_t WS_WD = 85 * MiB;
constexpr size_t WS_HN = 117 * MiB;
constexpr size_t WS_OA = WS_HN, WS_OB = WS_HN + 16 * MiB, WS_OC = WS_HN + 32 * MiB;
constexpr size_t WS_QKV = 181 * MiB;
constexpr size_t WS_MERGED = WS_QKV, WS_Y = WS_QKV, WS_HID = WS_QKV + 144 * MiB;
constexpr size_t WS_XG = WS_QKV, WS_TOKL = WS_QKV + 64 * MiB, WS_RSTD = WS_QKV + 68 * MiB;
constexpr size_t WS_SG = 410 * MiB;
constexpr size_t WS_MASK = 506 * MiB;
constexpr size_t WS_END = 522 * MiB;
static_assert((size_t)MTOK * QP * 2 <= 229 * MiB && (size_t)MAXBLK * 256 * 1024 * 2 <= 144 * MiB && (size_t)MAXBLK * 256 * 512 * 2 <= 72 * MiB, "ws map");
constexpr int CW_BAR = 4096;
constexpr int CW_QUEUE = 8192;
constexpr int CW_CNT = 16384;

constexpr int LDSX = 131072;
constexpr int LX_BAR = LDSX, LX_BC = LDSX + 16, LX_NBLK = LDSX + 32, LX_PSTART = LDSX + 64, LX_BLK2E = LDSX + 256, LX_CNT = LDSX + 1536, LX_TOK = LDSX + 2048, LX_RST = LDSX + 2048 + 6144;
constexpr int LDS_BYTES = 147456;

typedef __bf16 bf16x2_t __attribute__((ext_vector_type(2)));
__device__ __forceinline__ unsigned cvt_pk_bf16(float lo, float hi) { const f32x2 v = {lo, hi}; const bf16x2_t b = __builtin_convertvector(v, bf16x2_t); return __builtin_bit_cast(unsigned, b); }
__device__ __forceinline__ float bf_lo(unsigned w) { return __builtin_bit_cast(float, w << 16); }
__device__ __forceinline__ float bf_hi(unsigned w) { return __builtin_bit_cast(float, w & 0xffff0000u); }
template <int M> __device__ __forceinline__ float xor_lane(float v) {
    return __builtin_bit_cast(float, __builtin_amdgcn_ds_swizzle(__builtin_bit_cast(int, v), (M << 10) | 0x1f)); }
__device__ __forceinline__ float sum_xor32(float v) {
    const unsigned u = __builtin_bit_cast(unsigned, v); const auto rr = __builtin_amdgcn_permlane32_swap(u, u, false, false);
    return __builtin_bit_cast(float, (unsigned)rr[0]) + __builtin_bit_cast(float, (unsigned)rr[1]); }
__device__ __forceinline__ float max_xor32(float v) {
    const unsigned u = __builtin_bit_cast(unsigned, v); const auto rr = __builtin_amdgcn_permlane32_swap(u, u, false, false);
    return fmaxf(__builtin_bit_cast(float, (unsigned)rr[0]), __builtin_bit_cast(float, (unsigned)rr[1])); }
__device__ __forceinline__ int lane_val(int v, int src_lane) { return __builtin_amdgcn_ds_bpermute(src_lane << 2, v); }
__device__ __forceinline__ float wave_sum(float v) {
    v += xor_lane<1>(v); v += xor_lane<2>(v); v += xor_lane<4>(v); v += xor_lane<8>(v); v += xor_lane<16>(v);
    return sum_xor32(v);
}
__device__ __forceinline__ float fast_exp2(float x) { return __builtin_amdgcn_exp2f(x); }
__device__ __forceinline__ float fast_rcp(float x) { return __builtin_amdgcn_rcpf(x); }

namespace pg8 {
#define PG8_LAS __attribute__((address_space(3)))
typedef unsigned short bf16_t;
typedef short bf16x8 __attribute__((ext_vector_type(8)));
typedef float f32x4 __attribute__((ext_vector_type(4)));
typedef unsigned u32x4 __attribute__((ext_vector_type(4)));
constexpr int BM = 256, BK = 64, HALF = 128, HTB = HALF * BK * 2  , STAGE_BYTES = 8 * HTB, NXCD = 8, WGM = 8;

__host__ __device__ __forceinline__ int lds_byte(int r, int c) { const int st = (r >> 4) * 2 + (c >> 5), rr = r & 15, cc = c & 31, ob = rr * 64 + cc * 2; return st * 1024 + (ob ^ (((ob >> 9) & 1) << 5)); }
__host__ __device__ __forceinline__ void stage_rc(int b, int& R, int& C) { const int st = b / 1024, sb = b % 1024, swz = sb ^ (((sb >> 9) & 1) << 5); R = (st >> 1) * 16 + swz / 64; C = (st & 1) * 32 + (swz % 64) / 2; }
__host__ __device__ __forceinline__ int perm32(int rho) { const int n = rho >> 4, i = rho & 15; return 8 * (i >> 2) + 4 * n + (i & 3); }
struct Unit { int pm, pn; };
struct Gemm { const bf16_t* A; const bf16_t* Bt; int M, N, K; };

struct StaticOrder {
    int nM, nN, nwg, G, c;
    __host__ __device__ void init(int M, int N, int G_, int c_) { nM = M / BM; nN = N / BM; nwg = nM * nN; G = G_; c = c_; }
    __host__ __device__ bool next(int i, Unit& u) const {
        const long L = (long)i * G + c; if (L >= nwg) return false;
        int wgid = (int)L; { const int q = nwg / NXCD, r = nwg % NXCD, xcd = wgid % NXCD, off = wgid / NXCD; wgid = (xcd < r ? xcd * (q + 1) : r * (q + 1) + (xcd - r) * q) + off; }
        const int nig = WGM * nN, gid = wgid / nig, fm = gid * WGM, gsz = (nM - fm) < WGM ? (nM - fm) : WGM;
        u.pm = fm + ((wgid % nig) % gsz); u.pn = (wgid % nig) / gsz; return true;
    }
    __device__ __forceinline__ void a_ready(const Unit&) const {}
    __device__ __forceinline__ void done(const Unit&) const {}
};


struct EpiInProj {
    static constexpr bool PERM = false, AFTER_DRAIN = false;
    bf16_t* qkv; unsigned char* sg; const float* cosT; const float* sinT; const float* qkg; const float* ikg;
    __device__ __forceinline__ void operator()(const f32x4 (&acc)[2][2][4][2], const Unit& u, int wr, int wc, int fr, int fq) const {
        const int pn = u.pn, row0 = u.pm * BM + wr * 64 + fr;
        if (pn >= 15) {
            unsigned char* base = sg + (size_t)row0 * 3072 + (pn - 15) * 256 + wc * 32 + fq * 8;
#pragma unroll
            for (int ai = 0; ai < 2; ++ai)
#pragma unroll
                for (int m = 0; m < 4; ++m)
#pragma unroll
                    for (int bj = 0; bj < 2; ++bj) {
                        unsigned w[2];
#pragma unroll
                        for (int n = 0; n < 2; ++n) { unsigned pk = 0;
#pragma unroll
                            for (int i = 0; i < 4; ++i) { const float x = acc[ai][bj][m][n][i]; const float s = fast_rcp(1.0f + fast_exp2(-1.4426950408889634f * x));
                                unsigned q = (unsigned)(s * 255.0f + 0.5f); q = q > 255u ? 255u : q; pk |= q << (8 * i); }
                            w[n] = pk; }
                        *(u32x2*)(base + (size_t)(ai * HALF + m * 16) * 3072 + bj * HALF) = (u32x2){w[0], w[1]};
                    }
            return;
        }
        int type = 0, gi = 0; bool qscale = false;
        int ocol = (pn < 8 ? 256 * pn : C_Q1 + 256 * (pn - 9)) + 64 * wc;
        switch (pn) {
            case 0: type = 2; gi = 0; qscale = true; break;
            case 1: type = 2; gi = 1; break;
            case 3: type = 2; gi = 2; qscale = true; break;
            case 4: type = 2; gi = 3; break;
            case 6: case 7: type = 1; break;
            case 8: if (wc == 0) { type = 2; ocol = C_KI; } else if (wc == 1) { type = 3; ocol = C_WI; } else type = 4; break;
            case 9: case 10: type = 2; gi = 4; qscale = true; break;
            case 11: case 12: type = 2; gi = 5; break;
            default: type = 0; break;
        }
        if (type == 4) return;
        if (type == 3) {
            if (fq == 0) {
#pragma unroll
                for (int ai = 0; ai < 2; ++ai)
#pragma unroll
                    for (int m = 0; m < 4; ++m) { const f32x4 a = acc[ai][0][m][0] * 0.35355339059327373f, b = acc[ai][0][m][1] * 0.35355339059327373f;
                        *(u32x4*)(qkv + (size_t)(row0 + ai * HALF + m * 16) * QP + C_WI) = (u32x4){cvt_pk_bf16(a[0], a[1]), cvt_pk_bf16(a[2], a[3]), cvt_pk_bf16(b[0], b[1]), cvt_pk_bf16(b[2], b[3])}; }
            }
            return;
        }
        const float* gp = (pn == 8) ? ikg : qkg + 64 * gi;
        if (type == 2) { if (qscale) body<2, true>(acc, row0, ocol, gp, fq); else body<2, false>(acc, row0, ocol, gp, fq); }
        else if (type == 1) body<1, false>(acc, row0, ocol, gp, fq);
        else body<0, false>(acc, row0, ocol, gp, fq);
    }
    template <int TYPE, bool QS>
    __device__ __forceinline__ void body(const f32x4 (&acc)[2][2][4][2], int row0, int ocol, const float* gp, int fq) const {
#pragma unroll
        for (int ai = 0; ai < 2; ++ai)
#pragma unroll
            for (int m = 0; m < 4; ++m) {
                const int row = row0 + ai * HALF + m * 16;
                f32x4 x[2][2];
#pragma unroll
                for (int bj = 0; bj < 2; ++bj)
#pragma unroll
                    for (int n = 0; n < 2; ++n) x[bj][n] = acc[ai][bj][m][n];
                if (TYPE == 2) {
                    float ss = 0.f;
#pragma unroll
                    for (int bj = 0; bj < 2; ++bj)
#pragma unroll
                        for (int n = 0; n < 2; ++n) ss += (x[bj][n][0] * x[bj][n][0] + x[bj][n][1] * x[bj][n][1]) + (x[bj][n][2] * x[bj][n][2] + x[bj][n][3] * x[bj][n][3]);
                    ss += xor_lane<16>(ss); ss = sum_xor32(ss);
                    const float inv = (QS ? C2 : 1.0f) / sqrtf(ss * (1.0f / 64.0f) + EPS);
#pragma unroll
                    for (int bj = 0; bj < 2; ++bj)
#pragma unroll
                        for (int n = 0; n < 2; ++n) x[bj][n] = x[bj][n] * inv * *(const f32x4*)(gp + 32 * bj + 8 * fq + 4 * n);
                }
                if (TYPE >= 1) {
                    const int pos = row & (SEQ - 1);
#pragma unroll
                    for (int n = 0; n < 2; ++n) {
                        const f32x4 c = *(const f32x4*)(cosT + pos * 32 + 8 * fq + 4 * n), s = *(const f32x4*)(sinT + pos * 32 + 8 * fq + 4 * n);
                        const f32x4 a = x[0][n], b = x[1][n];
                        x[0][n] = a * c - b * s; x[1][n] = b * c + a * s;
                    }
                }
#pragma unroll
                for (int bj = 0; bj < 2; ++bj)
                    *(u32x4*)(qkv + (size_t)row * QP + ocol + 32 * bj + 8 * fq) = (u32x4){cvt_pk_bf16(x[bj][0][0], x[bj][0][1]), cvt_pk_bf16(x[bj][0][2], x[bj][0][3]), cvt_pk_bf16(x[bj][1][0], x[bj][1][1]), cvt_pk_bf16(x[bj][1][2], x[bj][1][3])};
                asm volatile("" ::: "memory");
            }
    }
};

template <int BR> struct EpiMerge {
    static constexpr bool PERM = false, AFTER_DRAIN = false;
    bf16_t* merged; const unsigned char* sg;
    __device__ __forceinline__ void operator()(const f32x4 (&acc)[2][2][4][2], const Unit& u, int wr, int wc, int fr, int fq) const {
        const int row0 = u.pm * BM + wr * 64 + fr, col0 = u.pn * BM + wc * 32 + fq * 8;
#pragma unroll
        for (int ai = 0; ai < 2; ++ai)
#pragma unroll
            for (int m = 0; m < 4; ++m) { const size_t row = (size_t)(row0 + ai * HALF + m * 16);
#pragma unroll
                for (int bj = 0; bj < 2; ++bj) {
                    const u32x2 gq = *(const u32x2*)(sg + row * 3072 + BR * 1024 + col0 + bj * HALF);
                    bf16_t* mp = merged + row * 1024 + col0 + bj * HALF;
                    float v[8];
#pragma unroll
                    for (int n = 0; n < 2; ++n)
#pragma unroll
                        for (int i = 0; i < 4; ++i) v[4 * n + i] = acc[ai][bj][m][n][i] * ((float)((gq[n] >> (8 * i)) & 255u) * (1.0f / 255.0f));
                    if (BR > 0) { const u32x4 o = *(const u32x4*)mp;
#pragma unroll
                        for (int k = 0; k < 4; ++k) { v[2 * k] += bf_lo(o[k]); v[2 * k + 1] += bf_hi(o[k]); } }
                    *(u32x4*)mp = (u32x4){cvt_pk_bf16(v[0], v[1]), cvt_pk_bf16(v[2], v[3]), cvt_pk_bf16(v[4], v[5]), cvt_pk_bf16(v[6], v[7])};
                }
                asm volatile("" ::: "memory"); }
    }
};

struct EpiResid {
    static constexpr bool PERM = false, AFTER_DRAIN = false;
    const float* res; float* out;
    __device__ __forceinline__ void operator()(const f32x4 (&acc)[2][2][4][2], const Unit& u, int wr, int wc, int fr, int fq) const {
        const int row0 = u.pm * BM + wr * 64 + fr, col0 = u.pn * BM + wc * 32 + fq * 8;
#pragma unroll
        for (int ai = 0; ai < 2; ++ai)
#pragma unroll
            for (int m = 0; m < 4; ++m) { const size_t off = (size_t)(row0 + ai * HALF + m * 16) * 1024 + col0;
#pragma unroll
                for (int bj = 0; bj < 2; ++bj)
#pragma unroll
                    for (int n = 0; n < 2; ++n) { const f32x4 r = *(const f32x4*)(res + off + bj * HALF + 4 * n); *(f32x4*)(out + off + bj * HALF + 4 * n) = r + acc[ai][bj][m][n]; }
                if (m & 1) asm volatile("" ::: "memory"); }
    }
};

struct EpiGateUp {
    static constexpr bool PERM = false, AFTER_DRAIN = false;
    bf16_t* hid; const PG8_LAS float* rst; int rbs;
    __device__ __forceinline__ void operator()(const f32x4 (&acc)[2][2][4][2], const Unit& u, int wr, int wc, int fr, int fq) const {
        const int row0 = u.pm * BM + wr * 64 + fr, col0 = (u.pn & 3) * HALF + wc * 32 + fq * 8;
        const PG8_LAS float* rs = rst + (u.pm / rbs) * 256 + wr * 64 + fr;
#pragma unroll
        for (int ai = 0; ai < 2; ++ai)
#pragma unroll
            for (int m = 0; m < 4; ++m) { float v[8]; const float r = rs[ai * HALF + m * 16];
#pragma unroll
                for (int n = 0; n < 2; ++n)
#pragma unroll
                    for (int i = 0; i < 4; ++i) { const float gt = acc[ai][0][m][n][i] * r, up = acc[ai][1][m][n][i] * r; v[4 * n + i] = gt * fast_rcp(1.0f + fast_exp2(-1.4426950408889634f * gt)) * up; }
                *(u32x4*)(hid + (size_t)(row0 + ai * HALF + m * 16) * DEXP + col0) = (u32x4){cvt_pk_bf16(v[0], v[1]), cvt_pk_bf16(v[2], v[3]), cvt_pk_bf16(v[4], v[5]), cvt_pk_bf16(v[6], v[7])}; }
    }
};

struct EpiDown {
    static constexpr bool PERM = false, AFTER_DRAIN = false;
    bf16_t* y;
    __device__ __forceinline__ void operator()(const f32x4 (&acc)[2][2][4][2], const Unit& u, int wr, int wc, int fr, int fq) const {
        const int row0 = u.pm * BM + wr * 64 + fr, col0 = (u.pn & 3) * BM + wc * 32 + fq * 8;
#pragma unroll
        for (int ai = 0; ai < 2; ++ai)
#pragma unroll
            for (int m = 0; m < 4; ++m)
#pragma unroll
                for (int bj = 0; bj < 2; ++bj) { const f32x4 a = acc[ai][bj][m][0], b = acc[ai][bj][m][1];
                    *(u32x4*)(y + (size_t)(row0 + ai * HALF + m * 16) * 1024 + col0 + bj * HALF) = (u32x4){cvt_pk_bf16(a[0], a[1]), cvt_pk_bf16(a[2], a[3]), cvt_pk_bf16(b[0], b[1]), cvt_pk_bf16(b[2], b[3])}; }
    }
};

struct AMapMoe { static constexpr bool GATHER = true; const PG8_LAS int* tok; int rbs;
    __device__ __forceinline__ unsigned row(const Unit& u, int R) const { return (unsigned)tok[(u.pm / rbs) * 256 + R]; } };
struct MoeOrder {
    int nunits, G, c; const PG8_LAS int* blk2e;
    __device__ __forceinline__ bool next(int i, Unit& u) const { const int L = i * G + c; if (L >= nunits) return false; const int rb = L >> 2; u.pm = rb; u.pn = blk2e[rb] * 4 + (L & 3); return true; }
    __device__ __forceinline__ void a_ready(const Unit&) const {}
    __device__ __forceinline__ void done(const Unit&) const {}
};

struct NoAMap { static constexpr bool GATHER = false; __device__ __forceinline__ unsigned row(const Unit&, int) const { return 0u; } };
template <class Epi, class Sched, bool ALIGN_EPI = false, bool SP2 = false, class AMap = NoAMap>
__device__ __forceinline__ void gemm_phase(PG8_LAS unsigned char* lds, const Gemm g, const Sched& S, const Epi& E, const AMap& AM = AMap()) {
    static_assert(!AMap::GATHER || SP2, "the row gather is wired into the SP2 loop only");
    int tid_l = (int)threadIdx.x; asm volatile("" : "+v"(tid_l));
    const int tid = tid_l, wid = __builtin_amdgcn_readfirstlane(tid >> 6), lane = tid & 63, wr = wid >> 2, wc = wid & 3, fr = lane & 15, fq = lane >> 4;
    const int K = g.K, nt = K / BK;
    unsigned voffA[2], voffB[2];
#pragma unroll
    for (int i = 0; i < 2; ++i) { int R, C; stage_rc(tid * 16 + i * 8192, R, C); const int Rb = Epi::PERM ? ((R & ~31) + perm32(R & 31)) : R;
        voffA[i] = (unsigned)(R * K + C) * 2u; voffB[i] = (unsigned)(Rb * K + C) * 2u; }
    int RA[2], CA[2];
#pragma unroll
    for (int i = 0; i < 2; ++i) stage_rc(tid * 16 + i * 8192, RA[i], CA[i]);
    unsigned vC0[2] = {0u, 0u}, vC1[2] = {0u, 0u}, vN0[2] = {0u, 0u}, vN1[2] = {0u, 0u};
#define PG8_AOFFS(v0, v1, unit) do { if constexpr (AMap::GATHER) { _Pragma("unroll") for (int _i = 0; _i < 2; ++_i) { \
        v0[_i] = (AM.row(unit, RA[_i]) * (unsigned)K + (unsigned)CA[_i]) * 2u; v1[_i] = (AM.row(unit, HALF + RA[_i]) * (unsigned)K + (unsigned)CA[_i]) * 2u; } } } while (0)
#define PG8_STAGE_A(bufoff, base, half, usenext) do { if constexpr (AMap::GATHER) { unsigned vv_[2]; _Pragma("unroll") for (int _j = 0; _j < 2; ++_j) vv_[_j] = (usenext) ? ((half) ? vN1[_j] : vN0[_j]) : ((half) ? vC1[_j] : vC0[_j]); \
        PG8_STAGE(bufoff, base, vv_); } else { PG8_STAGE(bufoff, (base) + (half) * hstep, voffA); } } while (0)
    const size_t kstep = (size_t)(BK * 2);
    const size_t hstep = (size_t)HALF * K * 2;
    const size_t tstep = 2 * hstep;
    const unsigned ldsw = (unsigned)wid * 1024u;
    const int aoff = lds_byte(wr * 64 + fr, fq * 8), boff = lds_byte(wc * 32 + fr, fq * 8);
#define PG8_SA(b, h) (((b) * 2 + (h)) * HTB)
#define PG8_SB(b, h) ((4 + (b) * 2 + (h)) * HTB)
#define PG8_STAGE(bufoff, gbase, voff) do { _Pragma("unroll") for (int _i = 0; _i < 2; ++_i) \
        __builtin_amdgcn_global_load_lds((const unsigned*)((const char*)(gbase) + (voff)[_i]), (PG8_LAS unsigned*)(lds + (bufoff) + ldsw + _i * 8192), 16, 0, 0); } while (0)
#define PG8_LDA(dst, b, h) do { _Pragma("unroll") for (int m = 0; m < 4; ++m) _Pragma("unroll") for (int k = 0; k < 2; ++k) dst[m][k] = *(const PG8_LAS bf16x8*)(lds + PG8_SA(b, h) + aoff + m * 2048 + k * 1024); } while (0)
#define PG8_LDB(dst, b, h) do { _Pragma("unroll") for (int n = 0; n < 2; ++n) _Pragma("unroll") for (int k = 0; k < 2; ++k) dst[n][k] = *(const PG8_LAS bf16x8*)(lds + PG8_SB(b, h) + boff + n * 2048 + k * 1024); } while (0)
#define PG8_MMA(ai, bj, At, Bt) do { __builtin_amdgcn_s_setprio(1); _Pragma("unroll") for (int m = 0; m < 4; ++m) _Pragma("unroll") for (int n = 0; n < 2; ++n) _Pragma("unroll") for (int k = 0; k < 2; ++k) \
        acc[ai][bj][m][n] = __builtin_amdgcn_mfma_f32_16x16x32_bf16(Bt[n][k], At[m][k], acc[ai][bj][m][n], 0, 0, 0); __builtin_amdgcn_s_setprio(0); } while (0)
#define PG8_WAIT_V(n) asm volatile("s_waitcnt vmcnt(" #n ")" ::: "memory")
#define PG8_WAIT_L(n) asm volatile("s_waitcnt lgkmcnt(" #n ")" ::: "memory")
#define PG8_BAR __builtin_amdgcn_s_barrier()
#define PG8_SCHED __builtin_amdgcn_sched_barrier(0)
    Unit cur, nxt; int ui = 0;
    if (!S.next(0, cur)) return;
    f32x4 acc[2][2][4][2];
#pragma unroll
    for (int a = 0; a < 2; ++a)
#pragma unroll
        for (int b = 0; b < 2; ++b)
#pragma unroll
            for (int m = 0; m < 4; ++m)
#pragma unroll
                for (int n = 0; n < 2; ++n) acc[a][b][m][n] = (f32x4){0.f, 0.f, 0.f, 0.f};
    bf16x8 At[4][2], B0[2][2], B1[2][2];
    const char* cA = (const char*)g.A + (AMap::GATHER ? (size_t)0 : (size_t)cur.pm * tstep); const char* cB = (const char*)g.Bt + (size_t)cur.pn * tstep;
    PG8_AOFFS(vC0, vC1, cur);
    S.a_ready(cur);
    if constexpr (SP2) {
        PG8_STAGE(PG8_SB(0, 0), cB, voffB); PG8_STAGE(PG8_SB(0, 1), cB + hstep, voffB); PG8_STAGE_A(PG8_SA(0, 0), cA, 0, false); PG8_STAGE_A(PG8_SA(0, 1), cA, 1, false);
        if (wr == 1) PG8_BAR;
        PG8_WAIT_V(2); PG8_BAR;
        PG8_STAGE(PG8_SB(1, 0), cB + kstep, voffB); PG8_STAGE_A(PG8_SA(1, 0), cA + kstep, 0, false); PG8_STAGE(PG8_SB(1, 1), cB + hstep + kstep, voffB);
        PG8_WAIT_V(6); PG8_BAR;
    } else {
        PG8_STAGE(PG8_SB(0, 0), cB, voffB); PG8_STAGE(PG8_SA(0, 0), cA, voffA); PG8_STAGE(PG8_SB(0, 1), cB + hstep, voffB); PG8_STAGE(PG8_SA(0, 1), cA + hstep, voffA);
        if (wr == 1) PG8_BAR;
        PG8_WAIT_V(4); PG8_BAR;
        PG8_STAGE(PG8_SB(1, 0), cB + kstep, voffB); PG8_STAGE(PG8_SA(1, 0), cA + kstep, voffA); PG8_STAGE(PG8_SB(1, 1), cB + hstep + kstep, voffB);
        PG8_WAIT_V(6); PG8_BAR;
    }
    for (;;) {
        const bool has_next = S.next(ui + 1, nxt);
        const char* nA = (has_next && !AMap::GATHER) ? (const char*)g.A + (size_t)nxt.pm * tstep : cA; const char* nB = has_next ? (const char*)g.Bt + (size_t)nxt.pn * tstep : cB;
        if constexpr (AMap::GATHER) { if (has_next) PG8_AOFFS(vN0, vN1, nxt); else { vN0[0] = vC0[0]; vN0[1] = vC0[1]; vN1[0] = vC1[0]; vN1[1] = vC1[1]; } }
#pragma unroll 1
        for (int t = 0; t < nt; t += 2) {
            const bool last = (t == nt - 2);
            const char* a1 = cA + (size_t)(t + 1) * kstep;
            const char* a2 = last ? nA : cA + (size_t)(t + 2) * kstep; const char* b2 = last ? nB : cB + (size_t)(t + 2) * kstep;
            const char* a3 = a2 + kstep; const char* b3 = b2 + kstep;
            if (last && has_next) S.a_ready(nxt);
            if constexpr (SP2) {
            PG8_LDB(B0, 0, 0); PG8_LDB(B1, 0, 1); PG8_SCHED; PG8_LDA(At, 0, 0); PG8_STAGE_A(PG8_SA(1, 1), a1, 1, false);
            PG8_WAIT_V(8); PG8_WAIT_L(0); PG8_BAR; PG8_MMA(0, 0, At, B0); PG8_MMA(0, 1, At, B1); PG8_BAR; PG8_SCHED;
            PG8_LDA(At, 0, 1); PG8_STAGE(PG8_SB(0, 0), b2, voffB); PG8_STAGE(PG8_SB(0, 1), b2 + hstep, voffB); PG8_STAGE_A(PG8_SA(0, 0), a2, 0, last);
            PG8_WAIT_V(8); PG8_WAIT_L(0); PG8_BAR; PG8_MMA(1, 0, At, B0); PG8_MMA(1, 1, At, B1); PG8_BAR; PG8_SCHED;
            PG8_LDB(B0, 1, 0); PG8_LDB(B1, 1, 1); PG8_SCHED; PG8_LDA(At, 1, 0); PG8_STAGE_A(PG8_SA(0, 1), a2, 1, last);
            PG8_WAIT_V(8); PG8_WAIT_L(0); PG8_BAR; PG8_MMA(0, 0, At, B0); PG8_MMA(0, 1, At, B1); PG8_BAR; PG8_SCHED;
            PG8_LDA(At, 1, 1); PG8_STAGE(PG8_SB(1, 0), b3, voffB); PG8_STAGE(PG8_SB(1, 1), b3 + hstep, voffB); PG8_STAGE_A(PG8_SA(1, 0), a3, 0, last);
            PG8_WAIT_V(8); PG8_WAIT_L(0); PG8_BAR; PG8_MMA(1, 0, At, B0); PG8_MMA(1, 1, At, B1); PG8_BAR; PG8_SCHED;
            } else {
            PG8_LDB(B0, 0, 0); PG8_SCHED; PG8_LDA(At, 0, 0); PG8_STAGE(PG8_SA(1, 1), a1 + hstep, voffA);
            PG8_WAIT_L(8); PG8_BAR; PG8_WAIT_L(0); PG8_MMA(0, 0, At, B0); PG8_BAR; PG8_SCHED;
            PG8_LDB(B1, 0, 1); PG8_STAGE(PG8_SB(0, 0), b2, voffB);
            PG8_BAR; PG8_WAIT_L(0); PG8_MMA(0, 1, At, B1); PG8_BAR;
            PG8_LDA(At, 0, 1); PG8_STAGE(PG8_SA(0, 0), a2, voffA);
            PG8_BAR; PG8_WAIT_L(0); PG8_MMA(1, 0, At, B0); PG8_BAR; PG8_SCHED;
            PG8_STAGE(PG8_SB(0, 1), b2 + hstep, voffB);
            PG8_WAIT_V(6); PG8_BAR; PG8_MMA(1, 1, At, B1); PG8_BAR;
            PG8_LDB(B0, 1, 0); PG8_SCHED; PG8_LDA(At, 1, 0); PG8_STAGE(PG8_SA(0, 1), a2 + hstep, voffA);
            PG8_WAIT_L(8); PG8_BAR; PG8_WAIT_L(0); PG8_MMA(0, 0, At, B0); PG8_BAR; PG8_SCHED;
            PG8_LDB(B1, 1, 1); PG8_STAGE(PG8_SB(1, 0), b3, voffB);
            PG8_BAR; PG8_WAIT_L(0); PG8_MMA(0, 1, At, B1); PG8_BAR;
            PG8_LDA(At, 1, 1); PG8_STAGE(PG8_SA(1, 0), a3, voffA);
            PG8_BAR; PG8_WAIT_L(0); PG8_MMA(1, 0, At, B0); PG8_BAR; PG8_SCHED;
            PG8_STAGE(PG8_SB(1, 1), b3 + hstep, voffB);
            PG8_WAIT_V(6); PG8_BAR; PG8_MMA(1, 1, At, B1); PG8_BAR;
            }
        }
        if constexpr (ALIGN_EPI) { if (wr == 0) PG8_BAR; }
        if constexpr (!Epi::AFTER_DRAIN) { E(acc, cur, wr, wc, fr, fq); S.done(cur); }
        if (!has_next) break;
#pragma unroll
        for (int a = 0; a < 2; ++a)
#pragma unroll
            for (int b = 0; b < 2; ++b)
#pragma unroll
                for (int m = 0; m < 4; ++m)
#pragma unroll
                    for (int n = 0; n < 2; ++n) acc[a][b][m][n] = (f32x4){0.f, 0.f, 0.f, 0.f};
        cur = nxt; cA = nA; cB = nB; ++ui;
        if constexpr (AMap::GATHER) { vC0[0] = vN0[0]; vC0[1] = vN0[1]; vC1[0] = vN1[0]; vC1[1] = vN1[1]; }
        if constexpr (ALIGN_EPI) { if (wr == 1) PG8_BAR; }
    }
    PG8_WAIT_V(0);
    if constexpr (!ALIGN_EPI) { if (wr == 0) PG8_BAR; }
    PG8_BAR;
    if constexpr (Epi::AFTER_DRAIN) { E.fused(acc, cur, wr, wc, fr, fq, lds, wid, lane); S.done(cur); }
#undef PG8_SA
#undef PG8_AOFFS
#undef PG8_STAGE_A
#undef PG8_SB
#undef PG8_STAGE
#undef PG8_LDA
#undef PG8_LDB
#undef PG8_MMA
#undef PG8_WAIT_V
#undef PG8_WAIT_L
#undef PG8_BAR
#undef PG8_SCHED
}
}
#define XB_TMO      128
#define XB_XCNT(j)  (256  + 64 * (j))
#define XB_XSUB(j)  (1280 + 64 * (j))
#define XB_XGEN(j)  (2304 + 64 * (j))
#define XB_TOP      3328
#define XB_TOPGEN   3392
#define XCD_BAR_WORDS 3456
#define XB_SPIN_CAP (1u << 21)

__device__ __forceinline__ unsigned xb_ld(unsigned* p)              { return __hip_atomic_load(p, __ATOMIC_RELAXED, __HIP_MEMORY_SCOPE_AGENT); }
__device__ __forceinline__ unsigned xb_add(unsigned* p, unsigned v) { return __hip_atomic_fetch_add(p, v, __ATOMIC_RELAXED, __HIP_MEMORY_SCOPE_AGENT); }
__device__ __forceinline__ unsigned xb_xcc_id() { return (unsigned)__builtin_amdgcn_s_getreg((3 << 11) | 20) & 0xFu; }
#define XB_SPIN(cond, bar) do { unsigned _sp = 0; while (cond) { __builtin_amdgcn_s_sleep(1); \
    if ((++_sp & 255u) == 0u) { if (xb_ld(&(bar)[XB_TMO])) break; if (_sp > XB_SPIN_CAP) { atomicAdd(&(bar)[XB_TMO], 1u); break; } } } } while (0)

struct XcdBarrier {
    unsigned* bar; unsigned x;
    volatile LAS unsigned* st;
};

__device__ __forceinline__ XcdBarrier xcd_barrier_post(unsigned* bar, volatile LAS unsigned* st) {
    XcdBarrier b; b.bar = bar; b.x = xb_xcc_id(); b.st = st;
    if (threadIdx.x == 0) (void)xb_add(&bar[XB_XCNT(b.x)], 1u);
    return b;
}
__device__ __forceinline__ void xcd_barrier_complete(unsigned* bar, unsigned x, unsigned& nloc, unsigned& nx) {
    const unsigned G = gridDim.x * gridDim.y * gridDim.z;
    unsigned sum, cnt, mine, sp = 0u;
    for (;;) {
        sum = 0u; cnt = 0u; mine = 0u;
#pragma unroll
        for (unsigned j = 0; j < 16; ++j) { const unsigned c = xb_ld(&bar[XB_XCNT(j)]); sum += c; cnt += (c > 0u) ? 1u : 0u; mine = (j == x) ? c : mine; }
        if (sum == G) break;
        __builtin_amdgcn_s_sleep(1);
        if ((++sp & 255u) == 0u) { if (xb_ld(&bar[XB_TMO])) break; if (sp > XB_SPIN_CAP) { atomicAdd(&bar[XB_TMO], 1u); break; } }
    }
    nloc = mine > 0u ? mine : 1u; nx = cnt > 0u ? cnt : 1u;
}

__device__ __forceinline__ void xcd_barrier(const XcdBarrier& b) {
    asm volatile("s_waitcnt vmcnt(0)" ::: "memory");
    __syncthreads();
    int tid_l = (int)threadIdx.x; asm volatile("" : "+v"(tid_l));
    if (tid_l == 0) {
        unsigned* bar = b.bar;
        __builtin_amdgcn_s_waitcnt(0);
        unsigned nloc = b.st[0], nx = b.st[1];
        if (nloc == 0u) { xcd_barrier_complete(bar, b.x, nloc, nx); b.st[0] = nloc; b.st[1] = nx; }
        const unsigned old = xb_add(&bar[XB_XSUB(b.x)], 1u);
        const unsigned gen = old / nloc;
        if (old + 1u == (gen + 1u) * nloc) {
            __builtin_amdgcn_fence(__ATOMIC_RELEASE, "agent");
            asm volatile("s_waitcnt vmcnt(0)" ::: "memory");
            const unsigned og = xb_add(&bar[XB_TOP], 1u);
            const unsigned tg = og / nx;
            if (og + 1u == (tg + 1u) * nx) xb_add(&bar[XB_TOPGEN], 1u);
            else XB_SPIN(xb_ld(&bar[XB_TOPGEN]) == tg, bar);
            __builtin_amdgcn_fence(__ATOMIC_ACQUIRE, "agent");
            xb_add(&bar[XB_XGEN(b.x)], 1u);
            asm volatile("s_waitcnt vmcnt(0)" ::: "memory");
        } else {
            XB_SPIN(xb_ld(&bar[XB_XGEN(b.x)]) == gen, bar);
            __builtin_amdgcn_fence(__ATOMIC_ACQUIRE, "agent");
            asm volatile("s_waitcnt vmcnt(0)" ::: "memory");
        }
    }
    __syncthreads();
}

enum { I_X = 0, I_NORM_ATTN, I_W_IN, I_QK_GAIN, I_IDX_K_GAIN, I_DIFF_LAMBDA, I_DIFF_SUBLN, I_W_PROJ_A, I_W_PROJ_B, I_W_PROJ_C, I_W_OUT, I_NORM_FFN, I_W_GROUP, I_B_GROUP, I_W_ROUTER, I_B_ROUTER,
       I_W_E_GATE, I_W_E_UP, I_W_E_DOWN, N_INPUTS };
struct Args { const float* in[N_INPUTS]; float* out; unsigned char* ws; };

#define LDS_WAIT() asm volatile("s_waitcnt lgkmcnt(0)" ::: "memory")

__device__ __forceinline__ int inproj_src_col(int d) {
    const int pn = d >> 8, s = d & 255;
    if (pn >= 15) return C_G + 256 * (pn - 15) + (s & ~31) + pg8::perm32(s & 31);
    const int u = (s >> 5) & 3, e = 32 * (s >> 7) + pg8::perm32(s & 31);
    if (pn < 8) return 256 * pn + 64 * u + e;
    if (pn == 8) { if (u == 0) return C_KI + e; if (u == 1) return e < 8 ? C_WI + e : -1; return -1; }
    return C_Q1 + 256 * (pn - 9) + 64 * u + e;
}
__device__ __forceinline__ void transpose_item(const float* W, int ldw, int K, bf16_t* WT, int drow0, int k0, int srccol, LAS float* scr, int lane) {
    const float* src = W + (size_t)k0 * ldw + (srccol >= 0 ? srccol : 0);
#pragma unroll 8
    for (int i = 0; i < 32; ++i) { const int kk = 2 * i + (lane >> 5); const float v = src[(size_t)kk * ldw]; scr[kk * 33 + (lane & 31)] = srccol >= 0 ? v : 0.f; }
    LDS_WAIT(); asm volatile("" ::: "memory");
    const int c = lane & 7;
#pragma unroll
    for (int j = 0; j < 4; ++j) { const int n = (lane >> 3) + 8 * j; const LAS float* s = scr + (8 * c) * 33 + n;
        u32x4 o; o.x = cvt_pk_bf16(s[0 * 33], s[1 * 33]); o.y = cvt_pk_bf16(s[2 * 33], s[3 * 33]); o.z = cvt_pk_bf16(s[4 * 33], s[5 * 33]); o.w = cvt_pk_bf16(s[6 * 33], s[7 * 33]);
        *(u32x4*)(WT + (size_t)(drow0 + n) * K + k0 + 8 * c) = o; }
    LDS_WAIT(); asm volatile("" ::: "memory");
}

template <bool COMBINE, bool WRITE_HN>
__device__ __forceinline__ void token_row(const float* src, float* dst, const bf16_t* y, const unsigned* rt0, const unsigned* rt1, const f32x2* rtw, const LAS int* pstart,
                                          const float* gain, bf16_t* hn, int m, int lane) {
    f32x4 v[4];
#pragma unroll
    for (int j = 0; j < 4; ++j) v[j] = ((const f32x4*)(src + (size_t)m * DM))[lane + 64 * j];
    if (COMBINE) {
        const unsigned a = rt0[m], b = rt1[m]; const f32x2 w = rtw[m];
        const size_t s0 = (size_t)(pstart[a >> 24] + (int)(a & 0xffffffu)), s1 = (size_t)(pstart[b >> 24] + (int)(b & 0xffffffu));
#pragma unroll
        for (int j = 0; j < 4; ++j) { const u32x2 p = ((const u32x2*)(y + s0 * DM))[lane + 64 * j], q = ((const u32x2*)(y + s1 * DM))[lane + 64 * j];
            v[j][0] += w[0] * bf_lo(p[0]) + w[1] * bf_lo(q[0]); v[j][1] += w[0] * bf_hi(p[0]) + w[1] * bf_hi(q[0]);
            v[j][2] += w[0] * bf_lo(p[1]) + w[1] * bf_lo(q[1]); v[j][3] += w[0] * bf_hi(p[1]) + w[1] * bf_hi(q[1]);
            ((f32x4*)(dst + (size_t)m * DM))[lane + 64 * j] = v[j]; }
    }
    if (WRITE_HN) {
        float ss = 0.f;
#pragma unroll
        for (int j = 0; j < 4; ++j) ss += (v[j][0] * v[j][0] + v[j][1] * v[j][1]) + (v[j][2] * v[j][2] + v[j][3] * v[j][3]);
        const float rstd = 1.0f / sqrtf(wave_sum(ss) * (1.0f / DM) + EPS);
#pragma unroll
        for (int j = 0; j < 4; ++j) { const f32x4 g = ((const f32x4*)gain)[lane + 64 * j]; const f32x4 o = v[j] * rstd * g;
            ((u32x2*)(hn + (size_t)m * DM))[lane + 64 * j] = (u32x2){cvt_pk_bf16(o[0], o[1]), cvt_pk_bf16(o[2], o[3])}; }
    }
}

template <bool EXPERTS> __device__ __forceinline__ void convert_weights(const Args& a, unsigned char* ws, int l, LAS unsigned char* lds, int lane, int wave, int vcu, int G, int chunk = -1);
__device__ __forceinline__ void p0_phase(const Args& a, unsigned char* ws, int l, LAS unsigned char* lds, int tid, int lane, int wave, int vcu, int G) {
    convert_weights<false>(a, ws, l, lds, lane, wave, vcu, G);
    const int gw = vcu * 8 + wave, NGW = G * 8, gt = vcu * 512 + tid, NGT = G * 512;
    if (l == 0) {
        float* cosT = (float*)(ws + WS_COS); float* sinT = (float*)(ws + WS_SIN);
        for (int idx = gt; idx < SEQ * 32; idx += NGT) { const int pos = idx >> 5, j = idx & 31;
            const float inv_freq = 1.0f / powf(10000.0f, (float)(2 * j) * (1.0f / 64.0f));
            const float ang = (float)pos * inv_freq;
            const double rev = (double)ang * 0.15915494309189533577; const float fr = (float)(rev - rint(rev));
            cosT[idx] = __builtin_amdgcn_cosf(fr); sinT[idx] = __builtin_amdgcn_sinf(fr); }
    }
    { float* wrt = (float*)(ws + WS_WRT); const float* wg = a.in[I_W_GROUP] + (size_t)l * DM * 4; const float* wr = a.in[I_W_ROUTER] + (size_t)l * DM * 32;
      const float* g2 = a.in[I_NORM_FFN] + (size_t)l * DM;
      for (int idx = gt; idx < 36 * DM; idx += NGT) { const int c = idx >> 10, k = idx & 1023; wrt[idx] = g2[k] * (c < 4 ? wg[k * 4 + c] : wr[k * 32 + (c - 4)]); } }
    const float* gain = a.in[I_NORM_ATTN] + (size_t)l * DM; bf16_t* hn = (bf16_t*)(ws + WS_HN);
    const LAS int* pstart = (const LAS int*)(lds + LX_PSTART);
    if (l == 0) { for (int m = gw; m < MTOK; m += NGW) token_row<false, true>(a.in[I_X], nullptr, nullptr, nullptr, nullptr, nullptr, pstart, gain, hn, m, lane); }
    else { for (int m = gw; m < MTOK; m += NGW) token_row<true, true>(a.out, a.out, (const bf16_t*)(ws + WS_Y), (const unsigned*)(ws + WS_RT0), (const unsigned*)(ws + WS_RT1), (const f32x2*)(ws + WS_RTW), pstart, gain, hn, m, lane); }
}

template <bool EXPERTS> __device__ __forceinline__ void convert_weights(const Args& a, unsigned char* ws, int l, LAS unsigned char* lds, int lane, int wave, int vcu, int G, int chunk) {
    LAS float* scr = (LAS float*)(lds + wave * 16384);
    int gw = vcu * 8 + wave, NGW = G * 8;
    constexpr int I_IN = 216 * 16, I_PA = 32 * 4, I_PC = 32 * 8, I_WO = 32 * 16, I_GU = 32 * 32 * 16, I_DN = 32 * 32 * 8, NIT = I_IN + 2 * I_PA + I_PC + I_WO + I_GU + I_DN;
    constexpr int I_SMALL = I_IN + 2 * I_PA + I_PC + I_WO;
    int it_end = EXPERTS ? NIT : I_SMALL;
    if (chunk >= 0) { gw = chunk * 128 + wave * 16; NGW = 1; it_end = I_SMALL + gw + 16 < NIT ? I_SMALL + gw + 16 : NIT; }
    for (int it = gw + (EXPERTS ? I_SMALL : 0); it < it_end; it += NGW) {
        int r = it; const int d31 = lane & 31;
        if (r < I_IN) { const int nb = r >> 4, kb = r & 15; transpose_item(a.in[I_W_IN] + (size_t)l * DM * D_IN, D_IN, 1024, (bf16_t*)(ws + WS_WIN), nb * 32, kb * 64, inproj_src_col(nb * 32 + d31), scr, lane); continue; } r -= I_IN;
        const int pcol = pg8::perm32(d31);
        if (r < I_PA) { const int nb = r >> 2, kb = r & 3; transpose_item(a.in[I_W_PROJ_A] + (size_t)l * 256 * DM, DM, 256, (bf16_t*)(ws + WS_WPA), nb * 32, kb * 64, nb * 32 + pcol, scr, lane); continue; } r -= I_PA;
        if (r < I_PA) { const int nb = r >> 2, kb = r & 3; transpose_item(a.in[I_W_PROJ_B] + (size_t)l * 256 * DM, DM, 256, (bf16_t*)(ws + WS_WPB), nb * 32, kb * 64, nb * 32 + pcol, scr, lane); continue; } r -= I_PA;
        if (r < I_PC) { const int nb = r >> 3, kb = r & 7; transpose_item(a.in[I_W_PROJ_C] + (size_t)l * 512 * DM, DM, 512, (bf16_t*)(ws + WS_WPC), nb * 32, kb * 64, nb * 32 + pcol, scr, lane); continue; } r -= I_PC;
        if (r < I_WO) { const int nb = r >> 4, kb = r & 15; transpose_item(a.in[I_W_OUT] + (size_t)l * DM * DM, DM, 1024, (bf16_t*)(ws + WS_WO), nb * 32, kb * 64, nb * 32 + pcol, scr, lane); continue; } r -= I_WO;
        if (r < I_GU) { const int e = r >> 9, rr = r & 511, nb = rr >> 4, kb = rr & 15, dd = nb * 32, pn = dd >> 8, s = dd & 255, half = s >> 7;
            const float* src = (half ? a.in[I_W_E_UP] : a.in[I_W_E_GATE]) + (size_t)(l * NEXP + e) * DM * DEXP;
            transpose_item(src, DEXP, 1024, (bf16_t*)(ws + WS_WGU) + (size_t)e * 1024 * 1024, nb * 32, kb * 64, 128 * pn + (s & 127) + pcol, scr, lane); continue; } r -= I_GU;
        { const int e = r >> 8, rr = r & 255, nb = rr >> 3, kb = rr & 7;
            transpose_item(a.in[I_W_E_DOWN] + (size_t)(l * NEXP + e) * DEXP * DM, DM, 512, (bf16_t*)(ws + WS_WD) + (size_t)e * 1024 * 512, nb * 32, kb * 64, nb * 32 + pcol, scr, lane); }
    }
}

__device__ __forceinline__ f32x16 mfma32(bf16x8 a, bf16x8 b, f32x16 c) { return __builtin_amdgcn_mfma_f32_32x32x16_bf16(a, b, c, 0, 0, 0); }
typedef short v4i16_t __attribute__((ext_vector_type(4)));
__device__ __forceinline__ s16x4 vtr(const LAS unsigned char* p) { return __builtin_bit_cast(s16x4, __builtin_amdgcn_ds_read_tr16_b64_v4i16((LAS v4i16_t*)p)); }
__device__ __forceinline__ int crow(int r, int hi) { return (r & 3) + 8 * (r >> 2) + 4 * hi; }
#define NEG_INF (-__builtin_inff())

__device__ __forceinline__ f32x16 splat16(float v) { f32x16 r;
#pragma unroll
    for (int i = 0; i < 16; ++i) r[i] = v;
    return r; }
struct QReg { const bf16x8 (&q)[4]; __device__ __forceinline__ bf16x8 operator()(int ks) const { return q[ks]; } };
struct QLds { const LAS unsigned char* p; __device__ __forceinline__ bf16x8 operator()(int ks) const { return *(const LAS bf16x8*)(p + ks * 1024); } };
template <int NDB, class QF, class MaskF>
__device__ __forceinline__ void flash_tile(float& m_run, float& l_run, f32x16 (&o)[NDB], const LAS unsigned char* kimg, const LAS unsigned char* vimg, const QF& qf, const MaskF& maskf, int r32, int hi, int vboff) {
    if (NDB == 4) __builtin_amdgcn_sched_barrier(0);
    f32x16 p0, p1; maskf.init(p0, p1);
#pragma unroll
    for (int ks = 0; ks < 4; ++ks) {
        const bf16x8 a0 = *(const LAS bf16x8*)(kimg + (2 * ks + hi) * 1024 + r32 * 16);
        const bf16x8 a1 = *(const LAS bf16x8*)(kimg + (2 * ks + hi) * 1024 + 512 + r32 * 16);
        const bf16x8 qk = qf(ks);
        p0 = mfma32(a0, qk, p0); p1 = mfma32(a1, qk, p1);
        if (NDB == 4 && (ks & 1)) __builtin_amdgcn_sched_barrier(0);
    }
    maskf(p0, p1);
    float mx = fmaxf(p0[0], p1[0]);
#pragma unroll
    for (int r = 1; r < 16; ++r) mx = fmaxf(mx, fmaxf(p0[r], p1[r]));
    mx = max_xor32(mx);
    const float mnew = fmaxf(m_run, mx);
    if (__ballot(mnew > m_run) != 0ull) {
        const float alpha = fast_exp2(m_run - mnew);
        l_run *= alpha;
#pragma unroll
        for (int db = 0; db < NDB; ++db) o[db] = o[db] * alpha;
    }
    m_run = mnew;
    float sum = 0.f;
#pragma unroll
    for (int r = 0; r < 16; ++r) { p0[r] = fast_exp2(p0[r] - mnew); p1[r] = fast_exp2(p1[r] - mnew); sum += p0[r] + p1[r]; }
    l_run += sum;
    bf16x8 pa[4];
    pa[0] = __builtin_bit_cast(bf16x8, (u32x4){cvt_pk_bf16(p0[0], p0[1]), cvt_pk_bf16(p0[2], p0[3]), cvt_pk_bf16(p0[4], p0[5]), cvt_pk_bf16(p0[6], p0[7])});
    pa[1] = __builtin_bit_cast(bf16x8, (u32x4){cvt_pk_bf16(p0[8], p0[9]), cvt_pk_bf16(p0[10], p0[11]), cvt_pk_bf16(p0[12], p0[13]), cvt_pk_bf16(p0[14], p0[15])});
    pa[2] = __builtin_bit_cast(bf16x8, (u32x4){cvt_pk_bf16(p1[0], p1[1]), cvt_pk_bf16(p1[2], p1[3]), cvt_pk_bf16(p1[4], p1[5]), cvt_pk_bf16(p1[6], p1[7])});
    pa[3] = __builtin_bit_cast(bf16x8, (u32x4){cvt_pk_bf16(p1[8], p1[9]), cvt_pk_bf16(p1[10], p1[11]), cvt_pk_bf16(p1[12], p1[13]), cvt_pk_bf16(p1[14], p1[15])});
#pragma unroll
    for (int db = 0; db < NDB; ++db)
#pragma unroll
        for (int s = 0; s < 4; ++s) {
            const s16x4 lo = vtr(vimg + vboff + db * 4096 + s * 1024), h4 = vtr(vimg + vboff + db * 4096 + s * 1024 + 512);
            const bf16x8 vt = (bf16x8){lo[0], lo[1], lo[2], lo[3], h4[0], h4[1], h4[2], h4[3]};
            o[db] = mfma32(vt, pa[s], o[db]);
            if (NDB == 4 && (s & 1)) __builtin_amdgcn_sched_barrier(0);
        }    __builtin_amdgcn_sched_barrier(0);
}
template <int NDB, class QF, class MaskF>
__device__ __forceinline__ void flash_tile_ref0(float& l_run, f32x16 (&o)[NDB], const LAS unsigned char* kimg, const LAS unsigned char* vimg, const QF& qf, const MaskF& maskf, int r32, int hi, int vboff) {
    f32x16 p0, p1; maskf.init(p0, p1);
    bf16x8 kf[8];
#pragma unroll
    for (int ks = 0; ks < 4; ++ks) { kf[2 * ks] = *(const LAS bf16x8*)(kimg + (2 * ks + hi) * 1024 + r32 * 16); kf[2 * ks + 1] = *(const LAS bf16x8*)(kimg + (2 * ks + hi) * 1024 + 512 + r32 * 16); }
    __builtin_amdgcn_sched_barrier(0);
#pragma unroll
    for (int ks = 0; ks < 4; ++ks) { const bf16x8 qk = qf(ks); p0 = mfma32(kf[2 * ks], qk, p0); p1 = mfma32(kf[2 * ks + 1], qk, p1); }
    maskf(p0, p1);
    __builtin_amdgcn_sched_barrier(0);
    float sum = 0.f;
#pragma unroll
    for (int r = 0; r < 16; ++r) { p0[r] = fast_exp2(p0[r]); sum += p0[r]; }
    bf16x8 pa[4];
    pa[0] = __builtin_bit_cast(bf16x8, (u32x4){cvt_pk_bf16(p0[0], p0[1]), cvt_pk_bf16(p0[2], p0[3]), cvt_pk_bf16(p0[4], p0[5]), cvt_pk_bf16(p0[6], p0[7])});
    pa[1] = __builtin_bit_cast(bf16x8, (u32x4){cvt_pk_bf16(p0[8], p0[9]), cvt_pk_bf16(p0[10], p0[11]), cvt_pk_bf16(p0[12], p0[13]), cvt_pk_bf16(p0[14], p0[15])});
    __builtin_amdgcn_sched_barrier(0);
#pragma unroll
    for (int db = 0; db < NDB; ++db)
#pragma unroll
        for (int s = 0; s < 2; ++s) {
            const s16x4 lo = vtr(vimg + vboff + db * 4096 + s * 1024), h4 = vtr(vimg + vboff + db * 4096 + s * 1024 + 512);
            o[db] = mfma32((bf16x8){lo[0], lo[1], lo[2], lo[3], h4[0], h4[1], h4[2], h4[3]}, pa[s], o[db]);
        }
#pragma unroll
    for (int r = 0; r < 16; ++r) { p1[r] = fast_exp2(p1[r]); sum += p1[r]; }
    l_run += sum;
    pa[2] = __builtin_bit_cast(bf16x8, (u32x4){cvt_pk_bf16(p1[0], p1[1]), cvt_pk_bf16(p1[2], p1[3]), cvt_pk_bf16(p1[4], p1[5]), cvt_pk_bf16(p1[6], p1[7])});
    pa[3] = __builtin_bit_cast(bf16x8, (u32x4){cvt_pk_bf16(p1[8], p1[9]), cvt_pk_bf16(p1[10], p1[11]), cvt_pk_bf16(p1[12], p1[13]), cvt_pk_bf16(p1[14], p1[15])});
    __builtin_amdgcn_sched_barrier(0);
#pragma unroll
    for (int db = 0; db < NDB; ++db)
#pragma unroll
        for (int s = 2; s < 4; ++s) {
            const s16x4 lo = vtr(vimg + vboff + db * 4096 + s * 1024), h4 = vtr(vimg + vboff + db * 4096 + s * 1024 + 512);
            o[db] = mfma32((bf16x8){lo[0], lo[1], lo[2], lo[3], h4[0], h4[1], h4[2], h4[3]}, pa[s], o[db]);
        }
    __builtin_amdgcn_sched_barrier(0);
}
template <bool FAST, int NDB, class QF, class MaskF>
__device__ __forceinline__ void flash_step(float& m_run, float& l_run, f32x16 (&o)[NDB], const LAS unsigned char* kimg, const LAS unsigned char* vimg, const QF& qf, const MaskF& maskf, int r32, int hi, int vboff) {
    if (FAST) flash_tile_ref0<NDB>(l_run, o, kimg, vimg, qf, maskf, r32, hi, vboff); else flash_tile<NDB>(m_run, l_run, o, kimg, vimg, qf, maskf, r32, hi, vboff);
}
__device__ __forceinline__ bool softmax_ref0_ok(const float* gq, const float* gk, int lane) {
    float a = fabsf(gq[lane]), b = fabsf(gk[lane]);
    a = fmaxf(a, xor_lane<1>(a)); a = fmaxf(a, xor_lane<2>(a)); a = fmaxf(a, xor_lane<4>(a)); a = fmaxf(a, xor_lane<8>(a)); a = fmaxf(a, xor_lane<16>(a)); a = max_xor32(a);
    b = fmaxf(b, xor_lane<1>(b)); b = fmaxf(b, xor_lane<2>(b)); b = fmaxf(b, xor_lane<4>(b)); b = fmaxf(b, xor_lane<8>(b)); b = fmaxf(b, xor_lane<16>(b)); b = max_xor32(b);
    return __builtin_amdgcn_readfirstlane(__builtin_bit_cast(int, a * b * (C2 * 64.0f * 1.02f))) < __builtin_bit_cast(int, 48.0f) && REF0_ENABLE;
}
#define MASK_INIT_ZERO __device__ __forceinline__ void init(f32x16& p0, f32x16& p1) const { p0 = splat16(0.f); p1 = splat16(0.f); }
struct MaskNone { MASK_INIT_ZERO __device__ __forceinline__ void operator()(f32x16&, f32x16&) const {} };
struct MaskCausal { int kb0, qloc, hi;
    MASK_INIT_ZERO
    __device__ __forceinline__ void operator()(f32x16& p0, f32x16& p1) const {
#pragma unroll
        for (int r = 0; r < 16; ++r) { const int kv = kb0 + crow(r, hi); p0[r] = kv > qloc ? NEG_INF : p0[r]; p1[r] = kv + 32 > qloc ? NEG_INF : p1[r]; } } };
struct MaskCausalIf { bool on; int kb0, qloc, hi;
    MASK_INIT_ZERO
    __device__ __forceinline__ void operator()(f32x16& p0, f32x16& p1) const { if (on) {
#pragma unroll
        for (int r = 0; r < 16; ++r) { const int kv = kb0 + crow(r, hi); p0[r] = kv > qloc ? NEG_INF : p0[r]; p1[r] = kv + 32 > qloc ? NEG_INF : p1[r]; } } } };
struct MaskLane { float ci;
    MASK_INIT_ZERO
    __device__ __forceinline__ void operator()(f32x16& p0, f32x16& p1) const {
#pragma unroll
        for (int r = 0; r < 16; ++r) { p0[r] += ci; p1[r] += ci; } } };
struct MaskBits { unsigned n0, n1;
    __device__ __forceinline__ void init(f32x16& p0, f32x16& p1) const {
#pragma unroll
        for (int r = 0; r < 16; ++r) { const int pos = (r & 3) + 8 * (r >> 2);
            p0[r] = __builtin_bit_cast(float, (unsigned)__builtin_amdgcn_sbfe((int)n0, pos, 1) & 0xff800000u); p1[r] = __builtin_bit_cast(float, (unsigned)__builtin_amdgcn_sbfe((int)n1, pos, 1) & 0xff800000u); } }
    __device__ __forceinline__ void operator()(f32x16&, f32x16&) const {} };
__device__ __forceinline__ void dma16(const void* g, LAS unsigned char* l) { __builtin_amdgcn_global_load_lds((const unsigned*)g, (LAS unsigned*)l, 16, 0, 0); }
#define DMA_WAIT_SYNC() do { asm volatile("s_waitcnt vmcnt(0)" ::: "memory"); __syncthreads(); } while (0)

__device__ __forceinline__ void glds16(const void* gsrc, unsigned lds_dst) { unsigned keep;
    asm volatile("s_mov_b32 %0, m0\n\ts_mov_b32 m0, %2\n\ts_nop 0\n\tglobal_load_lds_dwordx4 %1, off\n\ts_mov_b32 m0, %0" : "=&s"(keep) : "v"(gsrc), "s"(lds_dst) : "memory"); }
__device__ __forceinline__ void glds4(const void* gsrc, unsigned lds_dst) { unsigned keep;
    asm volatile("s_mov_b32 %0, m0\n\ts_mov_b32 m0, %2\n\ts_nop 0\n\tglobal_load_lds_dword %1, off\n\ts_mov_b32 m0, %0" : "=&s"(keep) : "v"(gsrc), "s"(lds_dst) : "memory"); }
#define WAITV_BAR(N) asm volatile("s_waitcnt vmcnt(" #N ") lgkmcnt(0)\n\ts_barrier" ::: "memory")

template <int MODE, bool FAST>
__device__ __forceinline__ void attn_ab_unit(int b, int h, int qt, const bf16_t* qkv, bf16_t* obuf, const float* kmean, const unsigned* maskg, LAS unsigned char* lds, int tid, int lane, int w) {
    constexpr int CQ = MODE == 0 ? C_QA : C_QB, CK = MODE == 0 ? C_KA : C_KB, CV = MODE == 0 ? C_VA : C_VB;
    constexpr int NS = 4, D = 3, SLOT = 16384;
    const int r32 = lane & 31, hi = lane >> 5;
    const size_t rowbase = (size_t)b * SEQ; const int q0 = 256 * qt, qloc = 32 * w + r32; const size_t qrow = rowbase + q0 + qloc;
    const unsigned lds0 = (unsigned)(size_t)lds;
    LAS float* kml = (LAS float*)(lds + 73728); LAS unsigned* mwl = (LAS unsigned*)(lds + 65536);
    bf16x8 qf[4];
#pragma unroll
    for (int ks = 0; ks < 4; ++ks) qf[ks] = *(const bf16x8*)(qkv + qrow * QP + CQ + 64 * h + 16 * ks + 8 * hi);
    const bf16_t* ksrc = qkv + (rowbase + lane) * QP + CK + 64 * h + 8 * w;
    const bf16_t* vsrc = qkv + (rowbase + 16 * (w & 3) + (lane >> 2)) * QP + CV + 64 * h + 32 * (w >> 2) + 8 * (lane & 3);
    const unsigned* msrc = maskg + qrow * 128 + hi;
    const int NT = 4 * qt + 4, wlim = 4 * qt + (w >> 1);
    const unsigned kdst0 = (unsigned)__builtin_amdgcn_readfirstlane(lds0 + w * 1024), mdst0 = (unsigned)__builtin_amdgcn_readfirstlane(lds0 + 65536 + w * 256);
    __syncthreads();
#pragma unroll
    for (int d = 0; d < D; ++d) { const int t = d < NT ? d : NT - 1;
        glds16(ksrc + (size_t)t * 64 * QP, kdst0 + d * SLOT); glds16(vsrc + (size_t)t * 64 * QP, kdst0 + d * SLOT + 8192);
        if (MODE == 1) glds4(msrc + 2 * t, mdst0 + d * 2048); }
    unsigned selbits = 0;
    if (MODE == 0) {
        if (tid < 256) ((LAS f32x4*)kml)[tid] = ((const f32x4*)(kmean + (size_t)((b * 4 + h) * 16) * 64))[tid];
        __syncthreads();
        if (qt > 0) {
            float qv[32];
#pragma unroll
            for (int ks = 0; ks < 4; ++ks) { const u32x4 qq = __builtin_bit_cast(u32x4, qf[ks]);
#pragma unroll
                for (int k = 0; k < 4; ++k) { qv[8 * ks + 2 * k] = bf_lo(qq[k]); qv[8 * ks + 2 * k + 1] = bf_hi(qq[k]); } }
            float v1 = NEG_INF, v2 = NEG_INF, v3 = NEG_INF; int i1 = -1, i2 = -1, i3 = -1;
#pragma unroll 1
            for (int j = 0; j < qt; ++j) {
                float g = 0.f;
#pragma unroll
                for (int ks = 0; ks < 4; ++ks) { const f32x4 k0 = *(const LAS f32x4*)(kml + j * 64 + 16 * ks + 8 * hi), k1 = *(const LAS f32x4*)(kml + j * 64 + 16 * ks + 8 * hi + 4);
                    g += qv[8 * ks + 0] * k0[0] + qv[8 * ks + 1] * k0[1] + qv[8 * ks + 2] * k0[2] + qv[8 * ks + 3] * k0[3] + qv[8 * ks + 4] * k1[0] + qv[8 * ks + 5] * k1[1] + qv[8 * ks + 6] * k1[2] + qv[8 * ks + 7] * k1[3]; }
                g = sum_xor32(g);
                if (g > v1) { v3 = v2; i3 = i2; v2 = v1; i2 = i1; v1 = g; i1 = j; }
                else if (g > v2) { v3 = v2; i3 = i2; v2 = g; i2 = j; }
                else if (g > v3) { v3 = g; i3 = j; }
            }
            if (i1 >= 0) selbits |= 1u << i1; if (i2 >= 0) selbits |= 1u << i2; if (i3 >= 0) selbits |= 1u << i3;
        }
    }
    const int vboff = (4 * hi + ((lane & 15) >> 2)) * 64 + ((lane >> 4) & 1) * 32 + (lane & 3) * 8;
    float m_run = -1e30f, l_run = 0.f; f32x16 o[2]; o[0] = splat16(0.f); o[1] = splat16(0.f);
    int scur = 0, siss = D;
    asm volatile("s_waitcnt vmcnt(0)" ::: "memory");
    asm volatile("" : "+v"(qf[0]), "+v"(qf[1]), "+v"(qf[2]), "+v"(qf[3]));
#pragma unroll 1
    for (int kt = 0; kt < NT; ++kt) {
        if (MODE == 1) WAITV_BAR(6); else WAITV_BAR(4);
        { const int t = kt + D < NT ? kt + D : NT - 1;
          glds16(ksrc + (size_t)t * 64 * QP, kdst0 + siss * SLOT); glds16(vsrc + (size_t)t * 64 * QP, kdst0 + siss * SLOT + 8192);
          if (MODE == 1) glds4(msrc + 2 * t, mdst0 + siss * 2048); }
        const LAS unsigned char* cur = lds + scur * SLOT;
        if (MODE == 0) {
            const int j = kt >> 2;
            if (j < qt) { const bool sel = (selbits >> j) & 1u; if (__ballot(sel) != 0ull) flash_step<FAST, 2>(m_run, l_run, o, cur, cur + 8192, QReg{qf}, MaskLane{sel ? 0.f : NEG_INF}, r32, hi, vboff); }
            else { const int kb0 = 64 * (kt & 3); if (kb0 <= 32 * w + 31) flash_step<FAST, 2>(m_run, l_run, o, cur, cur + 8192, QReg{qf}, MaskCausal{kb0, qloc, hi}, r32, hi, vboff); }
        } else {
            if (kt <= wlim) { const LAS unsigned* mp = mwl + scur * 512 + w * 64; const unsigned cw0 = mp[r32], cw1 = mp[32 + r32];
                flash_step<FAST, 2>(m_run, l_run, o, cur, cur + 8192, QReg{qf}, MaskBits{~cw0 >> (4 * hi), ~cw1 >> (4 * hi)}, r32, hi, vboff); }
        }
        scur = scur + 1 == NS ? 0 : scur + 1; siss = siss + 1 == NS ? 0 : siss + 1;
    }
    asm volatile("s_waitcnt vmcnt(0)" ::: "memory");
    const float inv = 1.0f / sum_xor32(l_run);
    bf16_t* orow = obuf + qrow * 256 + 64 * h;
#pragma unroll
    for (int db = 0; db < 2; ++db)
#pragma unroll
        for (int g = 0; g < 4; ++g)
            *(u32x2*)(orow + 32 * db + 8 * g + 4 * hi) = (u32x2){cvt_pk_bf16(o[db][4 * g] * inv, o[db][4 * g + 1] * inv), cvt_pk_bf16(o[db][4 * g + 2] * inv, o[db][4 * g + 3] * inv)};
}

template <bool FAST>
__device__ __forceinline__ void attn_c_unit(int b, int h, int qt, const bf16_t* qkv, bf16_t* oc, float lam, const float* subg, float coef, LAS unsigned char* lds, int tid, int lane, int w) {
    const int r32 = lane & 31, hi = lane >> 5;
    const size_t rowbase = (size_t)b * SEQ; const int q0 = 256 * qt, qloc = 32 * w + r32; const size_t qrow = rowbase + q0 + qloc;
    LAS unsigned char* qimg = lds + 65536 + w * 8192 + lane * 16;
    __syncthreads();
#pragma unroll
    for (int ks = 0; ks < 4; ++ks) { *(LAS bf16x8*)(qimg + ks * 1024) = *(const bf16x8*)(qkv + qrow * QP + C_Q1 + 64 * h + 16 * ks + 8 * hi); *(LAS bf16x8*)(qimg + 4096 + ks * 1024) = *(const bf16x8*)(qkv + qrow * QP + C_Q2 + 64 * h + 16 * ks + 8 * hi); }
    const bf16_t* k1src = qkv + (rowbase + lane) * QP + C_K1 + 64 * h + 8 * w;
    const bf16_t* k2src = k1src + (C_K2 - C_K1);
    const bf16_t* v0src = qkv + (rowbase + 16 * (w & 3) + (lane >> 2)) * QP + C_VC + 128 * h + 32 * (w >> 2) + 8 * (lane & 3);
    const bf16_t* v1src = v0src + 64;
    const int vboff = (4 * hi + ((lane & 15) >> 2)) * 64 + ((lane >> 4) & 1) * 32 + (lane & 3) * 8;
    const int NT = 4 * qt + 4;
    float m1 = -1e30f, l1 = 0.f, m2 = -1e30f, l2 = 0.f; f32x16 o1[4], o2[4];
#pragma unroll
    for (int i = 0; i < 4; ++i) { o1[i] = splat16(0.f); o2[i] = splat16(0.f); }
    dma16(k1src, lds + w * 1024); dma16(k2src, lds + 8192 + w * 1024); dma16(v0src, lds + 16384 + w * 1024); dma16(v1src, lds + 16384 + 8192 + w * 1024);
    DMA_WAIT_SYNC();
#pragma unroll 1
    for (int kt = 0; kt < NT; ++kt) {
        LAS unsigned char* cur = lds + (kt & 1) * 32768; LAS unsigned char* nxt = lds + ((kt + 1) & 1) * 32768;
        if (kt + 1 < NT) { const size_t adv = (size_t)(kt + 1) * 64 * QP;
            dma16(k1src + adv, nxt + w * 1024); dma16(k2src + adv, nxt + 8192 + w * 1024); dma16(v0src + adv, nxt + 16384 + w * 1024); dma16(v1src + adv, nxt + 16384 + 8192 + w * 1024); }
        const bool band = kt >= 4 * qt; const int kb0 = 64 * (kt & 3);
        if (!band || kb0 <= 32 * w + 31) { const MaskCausalIf mk{band, kb0, qloc, hi};
            flash_step<FAST, 4>(m1, l1, o1, cur, cur + 16384, QLds{qimg}, mk, r32, hi, vboff); flash_step<FAST, 4>(m2, l2, o2, cur + 8192, cur + 16384, QLds{qimg + 4096}, mk, r32, hi, vboff); }
        DMA_WAIT_SYNC();
    }
    const float i1 = 1.0f / sum_xor32(l1), i2 = lam / sum_xor32(l2);
    float ss = 0.f;
#pragma unroll
    for (int db = 0; db < 4; ++db) { o1[db] = o1[db] * i1 - o2[db] * i2;
#pragma unroll
        for (int r = 0; r < 16; ++r) ss += o1[db][r] * o1[db][r]; }
    ss = sum_xor32(ss);
    const float rn = coef / sqrtf(ss * (1.0f / 128.0f) + EPS);
    bf16_t* orow = oc + qrow * 512 + 128 * h;
#pragma unroll
    for (int db = 0; db < 4; ++db)
#pragma unroll
        for (int g = 0; g < 4; ++g) { const int d = 32 * db + 8 * g + 4 * hi; const f32x4 gg = *(const f32x4*)(subg + d);
            *(u32x2*)(orow + d) = (u32x2){cvt_pk_bf16(o1[db][4 * g] * rn * gg[0], o1[db][4 * g + 1] * rn * gg[1]), cvt_pk_bf16(o1[db][4 * g + 2] * rn * gg[2], o1[db][4 * g + 3] * rn * gg[3])}; }
}

__device__ __forceinline__ void index_unit(int b, int i64, const bf16_t* qkv, unsigned* maskg, unsigned char* scr, LAS unsigned char* lds, int tid, int lane, int w) {
    constexpr int NS = 5, D = 4, HS = 257, RING = 84224, TOFF = 65792, TROW = 144;
    const int r32 = lane & 31, hi = lane >> 5;
    const unsigned lds0 = (unsigned)(size_t)lds;
    LAS unsigned* hist = (LAS unsigned*)lds; LAS unsigned char* ring = lds + RING; LAS unsigned char* mb8 = lds;
    LAS int* thrB1 = (LAS int*)(lds + 125184); LAS int* thrRem = thrB1 + 64; LAS int* thrT = thrB1 + 128; LAS int* thrNeed = thrB1 + 192;
    const size_t rowbase = (size_t)b * SEQ; const int q0 = 64 * i64, NT = i64 + 1;
    __syncthreads();
    {
        const int hh = 4 * ((r32 >> 3) & 1) + (r32 & 3), qp = 2 * (r32 >> 4) + ((r32 >> 2) & 1);
        bf16x8 aq[2][4]; float wv[2][2][8];
#pragma unroll
        for (int rb = 0; rb < 2; ++rb) {
            const size_t row = rowbase + q0 + 8 * w + 4 * rb + qp;
#pragma unroll
            for (int ks = 0; ks < 4; ++ks) aq[rb][ks] = *(const bf16x8*)(qkv + row * QP + C_QI + 64 * hh + 16 * ks + 8 * hi);
#pragma unroll
            for (int hf = 0; hf < 2; ++hf) { const u32x4 ww = *(const u32x4*)(qkv + (rowbase + q0 + 8 * w + 4 * rb + 2 * hf + hi) * QP + C_WI);
#pragma unroll
                for (int k = 0; k < 4; ++k) { wv[rb][hf][2 * k] = bf_lo(ww[k]); wv[rb][hf][2 * k + 1] = bf_hi(ww[k]); } }
        }
#pragma unroll
        for (int rb = 0; rb < 2; ++rb) { asm volatile("" : "+v"(aq[rb][0]), "+v"(aq[rb][1]), "+v"(aq[rb][2]), "+v"(aq[rb][3]));
#pragma unroll
            for (int hf = 0; hf < 2; ++hf) asm volatile("" : "+v"(wv[rb][hf][0]), "+v"(wv[rb][hf][1]), "+v"(wv[rb][hf][2]), "+v"(wv[rb][hf][3]), "+v"(wv[rb][hf][4]), "+v"(wv[rb][hf][5]), "+v"(wv[rb][hf][6]), "+v"(wv[rb][hf][7])); }
        const bf16_t* ksrc = qkv + (rowbase + lane) * QP + C_KI + 8 * w;
        const unsigned kdst0 = (unsigned)__builtin_amdgcn_readfirstlane(lds0 + RING + w * 1024);
#pragma unroll
        for (int d = 0; d < D; ++d) { const int t = d < NT ? d : NT - 1; glds16(ksrc + (size_t)t * 64 * QP, kdst0 + d * 8192); }
        for (int i = tid; i < 4112; i += 512) ((LAS u32x4*)hist)[i] = (u32x4){0u, 0u, 0u, 0u};
        asm volatile("s_waitcnt lgkmcnt(0)" ::: "memory");
        unsigned char* srow = scr + (size_t)lane * 8192 + w * 16;
        int scur = 0, siss = D;
#pragma unroll 1
        for (int kt = 0; kt <= NT; ++kt) {
            if (kt < NT) WAITV_BAR(3); else { asm volatile("s_waitcnt vmcnt(0)" ::: "memory"); __syncthreads(); }
            if (kt > 0) {
                const u32x4 kk = *(const LAS u32x4*)(lds + TOFF + ((kt - 1) & 1) * 9216 + lane * TROW + w * 16);
                if (kt < NT) asm volatile("global_store_dwordx4 %0, %1, off" :: "v"(srow + (size_t)(kt - 1) * 128), "v"(kk) : "memory");
                else *(u32x4*)(srow + (size_t)(kt - 1) * 128) = kk;
#pragma unroll
                for (int k = 0; k < 4; ++k) { const unsigned a = kk[k] & 0xffffu, c = kk[k] >> 16;
                    if (a) __hip_atomic_fetch_add(&hist[lane * HS + (a >> 8)], 1u, __ATOMIC_RELAXED, __HIP_MEMORY_SCOPE_WORKGROUP);
                    if (c) __hip_atomic_fetch_add(&hist[lane * HS + (c >> 8)], 1u, __ATOMIC_RELAXED, __HIP_MEMORY_SCOPE_WORKGROUP); }
            }
            if (kt == NT) break;
            { const int t = kt + D < NT ? kt + D : NT - 1; glds16(ksrc + (size_t)t * 64 * QP, kdst0 + siss * 8192); }
            const LAS unsigned char* kimg = ring + scur * 8192;
            const bool diag = kt == NT - 1;
#pragma unroll
            for (int rb = 0; rb < 2; ++rb)
#pragma unroll
                for (int kb = 0; kb < 2; ++kb) {
                    f32x16 d = splat16(0.f);
#pragma unroll
                    for (int ks = 0; ks < 4; ++ks) d = mfma32(aq[rb][ks], *(const LAS bf16x8*)(kimg + (2 * ks + hi) * 1024 + (32 * kb + r32) * 16), d);
#pragma unroll
                    for (int hf = 0; hf < 2; ++hf) {
                        float sc = 0.f;
#pragma unroll
                        for (int t = 0; t < 8; ++t) sc += wv[rb][hf][t] * fmaxf(d[8 * hf + t], 0.f);
                        const int ql = 8 * w + 4 * rb + 2 * hf + hi;
                        const unsigned u = (unsigned)__builtin_bit_cast(unsigned short, (_Float16)sc);
                        unsigned key = u ^ ((u & 0x8000u) ? 0xffffu : 0x8000u);
                        if (diag && 32 * kb + r32 > ql) key = 0u;
                        *(LAS unsigned short*)(lds + TOFF + (kt & 1) * 9216 + ql * TROW + (32 * kb + r32) * 2) = (unsigned short)key;
                    }
                }
            scur = scur + 1 == NS ? 0 : scur + 1; siss = siss + 1 == NS ? 0 : siss + 1;
        }
        asm volatile("s_waitcnt vmcnt(0)" ::: "memory");
        __syncthreads();
    }
#define IDX_SEARCH(STAGE) do { _Pragma("unroll 1") for (int qq = 0; qq < 8; ++qq) { const int q = 8 * w + qq; int target; \
        if (STAGE == 0) { if (q0 + q + 1 <= 256) { if (lane == 0) { thrB1[q] = 0x10000; thrRem[q] = 0; } continue; } target = 256; } \
        else { if (thrB1[q] == 0x10000) { if (lane == 0) { thrT[q] = 0; thrNeed[q] = 0; } continue; } target = thrRem[q]; } \
        const LAS unsigned* hp = hist + q * HS + 4 * lane; const int h0 = (int)hp[0], h1 = (int)hp[1], h2 = (int)hp[2], h3 = (int)hp[3]; \
        int P = h0 + h1 + h2 + h3; const int s_ = P; \
        _Pragma("unroll") for (int o = 1; o < 64; o <<= 1) { const int t_ = lane_val(P, (lane - o) & 63); if (lane >= o) P += t_; } \
        const int above = __builtin_amdgcn_readlane(P, 63) - P; (void)s_; \
        const int c3 = above + h3, c2 = c3 + h2, c1 = c2 + h1, c0 = c1 + h0; int bin = -1, ab = 0; \
        if (above < target && c3 >= target) { bin = 4 * lane + 3; ab = above; } else if (c3 < target && c2 >= target) { bin = 4 * lane + 2; ab = c3; } \
        else if (c2 < target && c1 >= target) { bin = 4 * lane + 1; ab = c2; } else if (c1 < target && c0 >= target) { bin = 4 * lane; ab = c1; } \
        if (bin >= 0) { if (STAGE == 0) { thrB1[q] = bin; thrRem[q] = target - ab; } else { thrT[q] = (thrB1[q] << 8) | bin; thrNeed[q] = target - ab; } } } \
        __syncthreads(); } while (0)
    IDX_SEARCH(0);
    const int qs = 8 * w + (lane >> 3), pc = lane & 7;
    const unsigned char* rrow = scr + (size_t)qs * 8192 + pc * 16;
    {
        __builtin_amdgcn_fence(__ATOMIC_ACQUIRE, "agent");
        asm volatile("s_waitcnt vmcnt(0)" ::: "memory");
        const int b1 = thrB1[qs];
        for (int i = tid; i < 4112; i += 512) ((LAS u32x4*)hist)[i] = (u32x4){0u, 0u, 0u, 0u};
        __syncthreads();
#pragma unroll 4
        for (int it = 0; it < NT; ++it) { const u32x4 kk = *(const u32x4*)(rrow + (size_t)it * 128);
#pragma unroll
            for (int k = 0; k < 4; ++k) { const unsigned a = kk[k] & 0xffffu, c = kk[k] >> 16;
                if ((int)(a >> 8) == b1) __hip_atomic_fetch_add(&hist[qs * HS + (a & 255u)], 1u, __ATOMIC_RELAXED, __HIP_MEMORY_SCOPE_WORKGROUP);
                if ((int)(c >> 8) == b1) __hip_atomic_fetch_add(&hist[qs * HS + (c & 255u)], 1u, __ATOMIC_RELAXED, __HIP_MEMORY_SCOPE_WORKGROUP); } }
        __syncthreads();
    }
    IDX_SEARCH(1);
    {
        const unsigned T = (unsigned)thrT[qs]; const int need = thrNeed[qs]; int tc = 0;
        __syncthreads();
#pragma unroll 2
        for (int it = 0; it < NT; ++it) { const u32x4 kk = *(const u32x4*)(rrow + (size_t)it * 128);
            unsigned sel = 0, eq = 0;
#pragma unroll
            for (int k = 0; k < 4; ++k) { const unsigned a = kk[k] & 0xffffu, c = kk[k] >> 16;
                sel |= (a > T ? 1u : 0u) << (2 * k); sel |= (c > T ? 1u : 0u) << (2 * k + 1); eq |= (a == T ? 1u : 0u) << (2 * k); eq |= (c == T ? 1u : 0u) << (2 * k + 1); }
            if (T == 0u) eq = 0u;
            if (__ballot(eq != 0u) != 0ull) {
                const int n = __popc(eq); int P = n;
#pragma unroll
                for (int o = 1; o < 8; o <<= 1) { const int t_ = lane_val(P, (lane - o) & 63); if ((lane & 7) >= o) P += t_; }
                int allow = need - tc - (P - n);
#pragma unroll
                for (int k = 0; k < 8; ++k) if (((eq >> k) & 1u) && allow > 0) { sel |= 1u << k; --allow; }
                tc += lane_val(P, (lane & ~7) + 7);
            }
            mb8[qs * 512 + it * 8 + pc] = (unsigned char)sel;
        }
        __syncthreads();
    }
#undef IDX_SEARCH
    for (int idx = tid; idx < 64 * 2 * NT; idx += 512) { const int q = idx / (2 * NT), wd = idx - q * 2 * NT; maskg[(rowbase + q0 + q) * 128 + wd] = ((const LAS unsigned*)mb8)[q * 128 + wd]; }
}

__device__ __forceinline__ int next_unit(unsigned* ctr, LAS unsigned char* lds, int tid) {
    volatile LAS int* bc = (volatile LAS int*)(lds + LX_BC);
    __syncthreads();
    if (tid == 0) *bc = (int)__hip_atomic_fetch_add(ctr, 1u, __ATOMIC_RELAXED, __HIP_MEMORY_SCOPE_AGENT);
    __syncthreads();
    return __builtin_amdgcn_readfirstlane(*bc);
}

__device__ __forceinline__ void m1_phase(const Args& a, unsigned char* ws, int lc, LAS unsigned char* lds, int lane, int wave, int vcu, int G) {
    const int l = lc & 1;
    const float* wrt = (const float*)(ws + WS_WRT);
    const float* bg = a.in[I_B_GROUP] + l * 4; const float* br = a.in[I_B_ROUTER] + l * 32;
    unsigned* cnt = (unsigned*)(ws + WS_CTL) + CW_CNT + 2048 * lc;
    unsigned* rt0 = (unsigned*)(ws + WS_RT0); unsigned* rt1 = (unsigned*)(ws + WS_RT1); f32x2* rtw = (f32x2*)(ws + WS_RTW);
    int* tokl = (int*)(ws + WS_TOKL); bf16_t* xg = (bf16_t*)(ws + WS_XG); float* rstdg = (float*)(ws + WS_RSTD); const float* gain = a.in[I_NORM_FFN] + (size_t)l * DM;
    const int r32 = lane & 31, kh = lane >> 5, wq = wave & 3, kpart = wave >> 2;
    LAS float* tl = (LAS float*)(lds + wq * 8192);
    LAS float* tss = tl + 32 * 40;
#pragma unroll 1
    for (int t = wq * G + vcu; t < MTOK / 32; t += 4 * G) {
        const float* xrow = a.out + (size_t)(32 * t + r32) * DM + 512 * kpart + 4 * kh;
        const float* wp0 = wrt + (size_t)r32 * DM + 512 * kpart + 4 * kh; const float* wp1 = wrt + (size_t)(32 + (r32 & 3)) * DM + 512 * kpart + 4 * kh;
        bf16_t* xo = xg + (size_t)(32 * t + r32) * DM + 512 * kpart + 4 * kh; const float* gp = gain + 512 * kpart + 4 * kh;
        f32x16 d0 = splat16(0.f), d1 = splat16(0.f); float ss = 0.f;
#pragma unroll 8
        for (int m = 0; m < 64; ++m) {
            const f32x4 xa = *(const f32x4*)(xrow + 8 * m), b0 = *(const f32x4*)(wp0 + 8 * m), b1 = *(const f32x4*)(wp1 + 8 * m);
            ss += (xa[0] * xa[0] + xa[1] * xa[1]) + (xa[2] * xa[2] + xa[3] * xa[3]);
            { const f32x4 o = xa * *(const f32x4*)(gp + 8 * m); *(u32x2*)(xo + 8 * m) = (u32x2){cvt_pk_bf16(o[0], o[1]), cvt_pk_bf16(o[2], o[3])}; }
#pragma unroll
            for (int i = 0; i < 4; ++i) { d0 = __builtin_amdgcn_mfma_f32_32x32x2f32(xa[i], b0[i], d0, 0, 0, 0); d1 = __builtin_amdgcn_mfma_f32_32x32x2f32(xa[i], b1[i], d1, 0, 0, 0); }
        }
        ss = sum_xor32(ss);
        if (kpart == 1) {
#pragma unroll
            for (int r = 0; r < 16; ++r) { tl[crow(r, kh) * 40 + r32] = d0[r]; if (r32 < 4) tl[crow(r, kh) * 40 + 32 + r32] = d1[r]; }
            if (kh == 0) tss[r32] = ss;
        }
        __syncthreads();
        if (kpart == 0) {
#pragma unroll
            for (int r = 0; r < 16; ++r) { tl[crow(r, kh) * 40 + r32] += d0[r]; if (r32 < 4) tl[crow(r, kh) * 40 + 32 + r32] += d1[r]; }
            ss += tss[r32];
            LDS_WAIT(); asm volatile("" ::: "memory");
            const float rstd = 1.0f / sqrtf(ss * (1.0f / DM) + EPS);
            const LAS float* my = tl + r32 * 40;
            float gl[4];
#pragma unroll
            for (int c = 0; c < 4; ++c) gl[c] = my[c] * rstd + bg[c];
            int g = 0; float gm = gl[0];
#pragma unroll
            for (int c = 1; c < 4; ++c) if (gl[c] > gm) { gm = gl[c]; g = c; }
            float den = 0.f;
#pragma unroll
            for (int c = 0; c < 4; ++c) den += __expf(gl[c] - gm);
            const float gwt = 1.0f / den;
            float le[8];
#pragma unroll
            for (int e = 0; e < 8; ++e) le[e] = my[4 + 8 * g + e] * rstd + br[8 * g + e];
            int i1 = 0; float v1 = le[0];
#pragma unroll
            for (int e = 1; e < 8; ++e) if (le[e] > v1) { v1 = le[e]; i1 = e; }
            int i2 = -1; float v2 = NEG_INF;
#pragma unroll
            for (int e = 0; e < 8; ++e) if (e != i1 && le[e] > v2) { v2 = le[e]; i2 = e; }
            const float ex = __expf(v2 - v1), w1 = 1.0f / (1.0f + ex), w2 = ex * w1;
            if (kh == 0) { const int e0 = g * 8 + i1, e1 = g * 8 + i2, m = 32 * t + r32;
                const unsigned r0 = atomicAdd(cnt + 64 * e0, 1u), r1 = atomicAdd(cnt + 64 * e1, 1u);
                rt0[m] = ((unsigned)e0 << 24) | r0; rt1[m] = ((unsigned)e1 << 24) | r1; rtw[m] = (f32x2){gwt * w1, gwt * w2};
                tokl[e0 * 32768 + (int)r0] = m; tokl[e1 * 32768 + (int)r1] = m; }
            if (kh == 0) rstdg[32 * t + r32] = rstd;
        }
        __syncthreads();
    }
}
__device__ __forceinline__ void moe_tables(const unsigned* cnt, const int* tokl, const float* rstdg, LAS unsigned char* lds, int tid, int c, int G) {
    LAS int* pstart = (LAS int*)(lds + LX_PSTART); LAS int* blk2e = (LAS int*)(lds + LX_BLK2E); LAS int* cntl = (LAS int*)(lds + LX_CNT); LAS int* tok = (LAS int*)(lds + LX_TOK);
    if (tid < 64) {
        const int cn = tid < NEXP ? (int)cnt[64 * tid] : 0, nb = (cn + 255) >> 8;
        int P = nb;
#pragma unroll
        for (int o = 1; o < 64; o <<= 1) { const int t = lane_val(P, (tid - o) & 63); if (tid >= o) P += t; }
        const int pb = P - nb;
        if (tid <= NEXP) pstart[tid] = pb * 256;
        if (tid < NEXP) cntl[tid] = cn;
        if (tid == NEXP) *(LAS int*)(lds + LX_NBLK) = pb < MAXBLK ? pb : MAXBLK;
#pragma unroll 1
        for (int k = 0; k < nb; ++k) if (pb + k < MAXBLK) blk2e[pb + k] = tid;
    }
    __syncthreads();
    const int nblk = *(const LAS int*)(lds + LX_NBLK), rbs = G / 4;
    LAS float* rst = (LAS float*)(lds + LX_RST);
    for (int k = 0; k < 6; ++k) { const int rb = c / 4 + k * rbs; if (rb >= nblk) break;
        const int e = blk2e[rb], r = rb * 256 - pstart[e] + (tid & 255);
        if (tid < 256) { const int tk = r < cntl[e] ? tokl[e * 32768 + r] : 0; tok[k * 256 + tid] = tk; rst[k * 256 + tid] = rstdg[tk]; } }
    __syncthreads();
}

#ifndef PHASES
#define PHASES 0xFFFF
#endif
#define PH(n) if constexpr (((PHASES) >> (n)) & 1)
#ifndef REPEAT_MASK
#define REPEAT_MASK 0
#endif
#define REP(k) for (int rep_ = 0; rep_ < 1 + (((REPEAT_MASK) >> (k)) & 1); ++rep_)
#ifndef GEMM_ALIGN
#define GEMM_ALIGN true
#endif
#ifndef GEMM_SP2
#define GEMM_SP2 true
#endif
#define PHASE_ENV() unsigned long long wsi_ = (unsigned long long)args.ws; int G = (int)gridDim.x, bx = (int)blockIdx.x; asm volatile("" : "+s"(wsi_), "+s"(G), "+s"(bx)); \
    unsigned char* const ws = (unsigned char*)(GAS unsigned char*)wsi_; const int vcu = (G % 8 == 0) ? (bx % 8) * (G / 8) + bx / 8 : bx;   \
    int tid = (int)threadIdx.x; asm volatile("" : "+v"(tid)); const int lane = tid & 63, wave = __builtin_amdgcn_readfirstlane(tid >> 6); \
    unsigned* const ctl = (unsigned*)(ws + WS_CTL); bf16_t* const QKV = (bf16_t*)(ws + WS_QKV); unsigned char* const SG = ws + WS_SG; unsigned* const MASK = (unsigned*)(ws + WS_MASK); float* const KMEAN = (float*)(ws + WS_KMEAN); \
    (void)lane; (void)wave; (void)ctl; (void)QKV; (void)SG; (void)MASK; (void)KMEAN; (void)vcu
#define GRID_BAR() do { unsigned long long wb_ = (unsigned long long)args.ws; asm volatile("" : "+s"(wb_)); XcdBarrier b_ = bar0; b_.bar = (unsigned*)((GAS unsigned char*)wb_ + WS_CTL) + CW_BAR; asm volatile("" : "+s"(b_.x)); xcd_barrier(b_); if (((REPEAT_MASK) >> 12) & 1) xcd_barrier(b_); } while (0)


template <int L> __device__ __forceinline__ void layer_body(const Args& args, LAS unsigned char* lds, const XcdBarrier& bar0) {
    constexpr int l = L;

        PH(0) for (int rep_ = 0; rep_ < 1 + ((((REPEAT_MASK) >> 0) & 1) && l == 0); ++rep_) { PHASE_ENV(); p0_phase(args, ws, l, lds, tid, lane, wave, vcu, G); }
        GRID_BAR();
        PH(1) REP(1) { PHASE_ENV();
            pg8::Gemm g{(const bf16_t*)(ws + WS_HN), (const bf16_t*)(ws + WS_WIN), MTOK, NT_IN * 256, DM}; pg8::StaticOrder S; S.init(MTOK, NT_IN * 256, G, bx);
            pg8::EpiInProj E{QKV, SG, (const float*)(ws + WS_COS), (const float*)(ws + WS_SIN), args.in[I_QK_GAIN] + l * 6 * 64, args.in[I_IDX_K_GAIN] + l * 64};
            pg8::gemm_phase<pg8::EpiInProj, pg8::StaticOrder, GEMM_ALIGN, GEMM_SP2>(lds, g, S, E);
        }
        GRID_BAR();
        { PHASE_ENV();
            LAS float* red = (LAS float*)lds;
            for (int it = bx; it < NBATCH * 4 * 16; it += G) { const int b = it >> 6, h = (it >> 4) & 3, blk = it & 15, d = tid & 63, rg = tid >> 6;
                const bf16_t* kp = QKV + ((size_t)b * SEQ + blk * 256 + rg * 32) * QP + C_KA + 64 * h + d; float s = 0.f;
#pragma unroll 8
                for (int r = 0; r < 32; ++r) s += __builtin_bit_cast(float, (unsigned)kp[(size_t)r * QP] << 16);
                __syncthreads(); red[tid] = s; __syncthreads();
                if (tid < 64) { float t = 0.f;
#pragma unroll
                    for (int k = 0; k < 8; ++k) t += red[k * 64 + tid];
                    KMEAN[(size_t)it * 64 + tid] = t * (1.0f / 256.0f); } }
            __syncthreads();
        }
        PH(2) REP(2) { PHASE_ENV();
            const float* dl = args.in[I_DIFF_LAMBDA] + l * 256;
            const float lam_init = 0.8f - 0.6f * __expf(-0.3f * (float)l);
            const float lam = __expf(wave_sum(dl[lane] * dl[64 + lane])) - __expf(wave_sum(dl[128 + lane] * dl[192 + lane])) + lam_init;
            const float* subg = args.in[I_DIFF_SUBLN] + l * 128;
            unsigned* qc = ctl + CW_QUEUE + 64 * (l * 4 + 0 + 8 * rep_);
            const float* qkg = args.in[I_QK_GAIN] + l * 6 * 64;
            if (softmax_ref0_ok(qkg + 4 * 64, qkg + 5 * 64, lane)) { for (;;) { const int u = next_unit(qc, lds, tid); if (u >= 512) break; const int r = u & 31; attn_c_unit<true>(r >> 2, r & 3, 15 - (u >> 5), QKV, (bf16_t*)(ws + WS_OC), lam, subg, 1.0f - lam_init, lds, tid, lane, wave); } }
            else { for (;;) { const int u = next_unit(qc, lds, tid); if (u >= 512) break; const int r = u & 31; attn_c_unit<false>(r >> 2, r & 3, 15 - (u >> 5), QKV, (bf16_t*)(ws + WS_OC), lam, subg, 1.0f - lam_init, lds, tid, lane, wave); } }
        }
        PH(3) REP(3) { PHASE_ENV();
            unsigned* qi = ctl + CW_QUEUE + 64 * (l * 4 + 1 + 8 * rep_);
            for (;;) { const int u = next_unit(qi, lds, tid); if (u >= 512) break; index_unit(u & 7, 63 - (u >> 3), QKV, MASK, ws + WS_WGU + (size_t)bx * 524288, lds, tid, lane, wave); }
        }
        GRID_BAR();
        PH(4) REP(4) { PHASE_ENV();
            unsigned* qa = ctl + CW_QUEUE + 64 * (l * 4 + 2 + 8 * rep_);
            const float* qkg = args.in[I_QK_GAIN] + l * 6 * 64;
            if (softmax_ref0_ok(qkg, qkg + 64, lane)) { for (;;) { const int u = next_unit(qa, lds, tid); if (u >= 512) break; const int r = u & 31; attn_ab_unit<0, true>(r >> 2, r & 3, 15 - (u >> 5), QKV, (bf16_t*)(ws + WS_OA), KMEAN, MASK, lds, tid, lane, wave); } }
            else { for (;;) { const int u = next_unit(qa, lds, tid); if (u >= 512) break; const int r = u & 31; attn_ab_unit<0, false>(r >> 2, r & 3, 15 - (u >> 5), QKV, (bf16_t*)(ws + WS_OA), KMEAN, MASK, lds, tid, lane, wave); } }
        }
        PH(5) REP(5) { PHASE_ENV();
            unsigned* qb = ctl + CW_QUEUE + 64 * (l * 4 + 3 + 8 * rep_);
            const float* qkg = args.in[I_QK_GAIN] + l * 6 * 64;
            if (softmax_ref0_ok(qkg + 2 * 64, qkg + 3 * 64, lane)) { for (;;) { const int u = next_unit(qb, lds, tid); if (u >= 512) break; const int r = u & 31; attn_ab_unit<1, true>(r >> 2, r & 3, 15 - (u >> 5), QKV, (bf16_t*)(ws + WS_OB), KMEAN, MASK, lds, tid, lane, wave); } }
            else { for (;;) { const int u = next_unit(qb, lds, tid); if (u >= 512) break; const int r = u & 31; attn_ab_unit<1, false>(r >> 2, r & 3, 15 - (u >> 5), QKV, (bf16_t*)(ws + WS_OB), KMEAN, MASK, lds, tid, lane, wave); } }
        }
        { PHASE_ENV();
            unsigned* qw = ctl + CW_QUEUE + 64 * (16 + l);
            for (;;) { const int c = next_unit(qw, lds, tid); if (c >= (32 * 32 * 16 + 32 * 32 * 8) / 128) break; convert_weights<true>(args, ws, l, lds, lane, wave, vcu, G, c); }
        }
        GRID_BAR();
        PH(6) REP(6) {
            { PHASE_ENV(); pg8::StaticOrder S; S.init(MTOK, DM, G, bx); pg8::Gemm g{(const bf16_t*)(ws + WS_OA), (const bf16_t*)(ws + WS_WPA), MTOK, DM, 256}; pg8::EpiMerge<0> E{(bf16_t*)(ws + WS_MERGED), SG}; pg8::gemm_phase<pg8::EpiMerge<0>, pg8::StaticOrder, GEMM_ALIGN, GEMM_SP2>(lds, g, S, E); }
            { PHASE_ENV(); pg8::StaticOrder S; S.init(MTOK, DM, G, bx); pg8::Gemm g{(const bf16_t*)(ws + WS_OB), (const bf16_t*)(ws + WS_WPB), MTOK, DM, 256}; pg8::EpiMerge<1> E{(bf16_t*)(ws + WS_MERGED), SG}; pg8::gemm_phase<pg8::EpiMerge<1>, pg8::StaticOrder, GEMM_ALIGN, GEMM_SP2>(lds, g, S, E); }
            { PHASE_ENV(); pg8::StaticOrder S; S.init(MTOK, DM, G, bx); pg8::Gemm g{(const bf16_t*)(ws + WS_OC), (const bf16_t*)(ws + WS_WPC), MTOK, DM, 512}; pg8::EpiMerge<2> E{(bf16_t*)(ws + WS_MERGED), SG}; pg8::gemm_phase<pg8::EpiMerge<2>, pg8::StaticOrder, GEMM_ALIGN, GEMM_SP2>(lds, g, S, E); }
        }
        GRID_BAR();
        PH(7) for (int rep_ = 0; rep_ < 1 + ((((REPEAT_MASK) >> 7) & 1) && l == 0); ++rep_) { PHASE_ENV();
            pg8::Gemm g{(const bf16_t*)(ws + WS_MERGED), (const bf16_t*)(ws + WS_WO), MTOK, DM, DM}; pg8::StaticOrder S; S.init(MTOK, DM, G, bx);
            pg8::EpiResid E{l == 0 ? args.in[I_X] : args.out, args.out};
            pg8::gemm_phase<pg8::EpiResid, pg8::StaticOrder, GEMM_ALIGN, GEMM_SP2>(lds, g, S, E);
        }
        GRID_BAR();
        PH(8) REP(8) { PHASE_ENV(); m1_phase(args, ws, l + 2 * rep_, lds, lane, wave, vcu, G); }
        GRID_BAR();
        { PHASE_ENV(); moe_tables(ctl + CW_CNT + 2048 * (l + 2 * (((REPEAT_MASK) >> 8) & 1)), (const int*)(ws + WS_TOKL), (const float*)(ws + WS_RSTD), lds, tid, vcu, G); }
        PH(10) REP(10) { PHASE_ENV();
            const int nblk = *(const LAS int*)(lds + LX_NBLK);
            pg8::Gemm g{(const bf16_t*)(ws + WS_XG), (const bf16_t*)(ws + WS_WGU), MTOK, NEXP * 1024, DM};
            pg8::MoeOrder S{nblk * 4, G, vcu, (const LAS int*)(lds + LX_BLK2E)};
            pg8::EpiGateUp E{(bf16_t*)(ws + WS_HID), (const LAS float*)(lds + LX_RST), G / 4}; pg8::AMapMoe AM{(const LAS int*)(lds + LX_TOK), G / 4};
            pg8::gemm_phase<pg8::EpiGateUp, pg8::MoeOrder, GEMM_ALIGN, GEMM_SP2, pg8::AMapMoe>(lds, g, S, E, AM);
        }
        GRID_BAR();
        PH(11) REP(11) { PHASE_ENV();
            const int nblk = *(const LAS int*)(lds + LX_NBLK);
            pg8::Gemm g{(const bf16_t*)(ws + WS_HID), (const bf16_t*)(ws + WS_WD), MAXBLK * 256, NEXP * 1024, DEXP};
            pg8::MoeOrder S{nblk * 4, G, vcu, (const LAS int*)(lds + LX_BLK2E)};
            pg8::EpiDown E{(bf16_t*)(ws + WS_Y)};
            pg8::gemm_phase<pg8::EpiDown, pg8::MoeOrder, GEMM_ALIGN, GEMM_SP2>(lds, g, S, E);
        }
        GRID_BAR();
    }

__global__ void __launch_bounds__(512, 2) fwd_kernel(Args args) {
    extern __shared__ __attribute__((aligned(16))) unsigned char lds_raw[];
    LAS unsigned char* lds = (LAS unsigned char*)lds_raw;
    for (int u = threadIdx.x; u < (LDS_BYTES - LDSX) / 4; u += 512) ((LAS unsigned*)(lds + LDSX))[u] = 0u;
    __syncthreads();
    const XcdBarrier bar0 = xcd_barrier_post((unsigned*)(args.ws + WS_CTL) + CW_BAR, (volatile LAS unsigned*)(lds + LX_BAR));
    layer_body<0>(args, lds, bar0);
    layer_body<1>(args, lds, bar0);
    { PHASE_ENV();
        const int gw = vcu * 8 + wave, NGW = G * 8; const LAS int* pstart = (const LAS int*)(lds + LX_PSTART);
        for (int m = gw; m < MTOK; m += NGW) token_row<true, false>(args.out, args.out, (const bf16_t*)(ws + WS_Y), (const unsigned*)(ws + WS_RT0), (const unsigned*)(ws + WS_RT1), (const f32x2*)(ws + WS_RTW), pstart, nullptr, nullptr, m, lane);
    }
}

extern "C" void kernel_launch(void* const* d_in, const int* in_sizes, int n_in, void* d_out, int out_size, void* d_ws, size_t ws_size, hipStream_t stream) {
    static int grid = 0;
    if (grid == 0) {
        if (n_in != N_INPUTS || in_sizes[0] != MTOK * DM || out_size != MTOK * DM || ws_size < WS_END) {
            fprintf(stderr, "kernel_launch: built for %d inputs, x/out of %d floats, >= %zu bytes of workspace; got n_in %d, in0 %d, out %d, ws %zu; nothing launched\n", (int)N_INPUTS, MTOK * DM, (size_t)WS_END, n_in, n_in > 0 ? in_sizes[0] : -1, out_size, ws_size);
            grid = -1; return; }
        int dev = 0, cus = 0;
        if (hipGetDevice(&dev) != hipSuccess || hipDeviceGetAttribute(&cus, hipDeviceAttributeMultiprocessorCount, dev) != hipSuccess) { fprintf(stderr, "kernel_launch: device query failed\n"); grid = -1; return; }
        if (hipFuncSetAttribute((const void*)fwd_kernel, hipFuncAttributeMaxDynamicSharedMemorySize, LDS_BYTES) != hipSuccess) { fprintf(stderr, "kernel_launch: hipFuncSetAttribute failed\n"); grid = -1; return; }
        int per_cu = 0;
        if (hipOccupancyMaxActiveBlocksPerMultiprocessor(&per_cu, (const void*)fwd_kernel, 512, LDS_BYTES) != hipSuccess || per_cu < 1) fprintf(stderr, "kernel_launch: note: occupancy query reports %d workgroups per CU\n", per_cu);
        (void)hipGetLastError();
        grid = cus;
    }
    if (grid < 0) return;
    if (hipMemsetAsync((char*)d_ws + WS_CTL, 0, CTL_BYTES, stream) != hipSuccess) { fprintf(stderr, "kernel_launch: memset failed\n"); return; }
    Args a{};
    for (int i = 0; i < N_INPUTS; ++i) a.in[i] = (const float*)d_in[i];
    a.out = (float*)d_out; a.ws = (unsigned char*)d_ws;
    hipLaunchKernelGGL(fwd_kernel, dim3(grid), dim3(512), LDS_BYTES, stream, a);
    const hipError_t le = hipPeekAtLastError();
    if (le != hipSuccess) fprintf(stderr, "kernel_launch: launch failed: %s\n", hipGetErrorName(le));
}
```

```cpp
#include <hip/hip_runtime.h>
#include <cstdio>
#include <cstdint>

#define LAS __attribute__((address_space(3)))
#define GAS __attribute__((address_space(1)))
typedef unsigned short bf16_t;
typedef short bf16x8 __attribute__((ext_vector_type(8)));
typedef short s16x4 __attribute__((ext_vector_type(4)));
typedef float f32x4 __attribute__((ext_vector_type(4)));
typedef float f32x2 __attribute__((ext_vector_type(2)));
typedef float f32x16 __attribute__((ext_vector_type(16)));
typedef unsigned u32x4 __attribute__((ext_vector_type(4)));
typedef unsigned u32x2 __attribute__((ext_vector_type(2)));

constexpr int NBATCH = 8, SEQ = 4096, MTOK = NBATCH * SEQ, DM = 1024, NLAYER = 2;
constexpr int QP = 3656;
constexpr int C_QA = 0, C_KA = 256, C_VA = 512, C_QB = 768, C_KB = 1024, C_VB = 1280, C_QI = 1536, C_KI = 2048, C_WI = 2112,
              C_Q1 = 2120, C_Q2 = 2376, C_K1 = 2632, C_K2 = 2888, C_VC = 3144, C_G = 3656, D_IN = 6728;
constexpr int NT_IN = 27;
constexpr int NEXP = 32, DEXP = 512, MAXBLK = 288;
constexpr float C2 = 0.125f * 1.4426950408889634f;
constexpr float EPS = 1e-6f;
#ifndef REF0_ENABLE
#define REF0_ENABLE 1
#endif

constexpr size_t MiB = 1u << 20;
constexpr size_t WS_CTL = 0, CTL_BYTES = 1 * MiB;
constexpr size_t WS_COS = 1 * MiB, WS_SIN = WS_COS + 512 * 1024;
constexpr size_t WS_SMALL = 2 * MiB;
constexpr size_t WS_KMEAN = WS_SMALL, WS_RT0 = WS_SMALL + 256 * 1024, WS_RT1 = WS_SMALL + 384 * 1024, WS_RTW = WS_SMALL + 512 * 1024, WS_WRT = WS_SMALL + 768 * 1024;
constexpr size_t WS_WIN = 3 * MiB;
constexpr size_t WS_WPA = 17 * MiB, WS_WPB = WS_WPA + 512 * 1024, WS_WPC = 18 * MiB;
constexpr size_t WS_WO = 19 * MiB;
constexpr size_t WS_WGU = 21 * MiB;
constexpr size_t WS_WD = 85 * MiB;
constexpr size_t WS_HN = 117 * MiB;
constexpr size_t WS_OA = WS_HN, WS_OB = WS_HN + 16 * MiB, WS_OC = WS_HN + 32 * MiB;
constexpr size_t WS_QKV = 181 * MiB;
constexpr size_t WS_MERGED = WS_QKV, WS_Y = WS_QKV, WS_HID = WS_QKV + 144 * MiB;
constexpr size_t WS_XG = WS_QKV, WS_TOKL = WS_QKV + 64 * MiB, WS_RSTD = WS_QKV + 68 * MiB;
constexpr size_t WS_SG = 410 * MiB;
constexpr size_t WS_MASK = 506 * MiB;
constexpr size_t WS_END = 522 * MiB;
static_assert((size_t)MTOK * QP * 2 <= 229 * MiB && (size_t)MAXBLK * 256 * 1024 * 2 <= 144 * MiB && (size_t)MAXBLK * 256 * 512 * 2 <= 72 * MiB, "ws map");
constexpr int CW_BAR = 4096;
constexpr int CW_QUEUE = 8192;
constexpr int CW_CNT = 16384;

constexpr int LDSX = 131072;
constexpr int LX_BAR = LDSX, LX_BC = LDSX + 16, LX_NBLK = LDSX + 32, LX_PSTART = LDSX + 64, LX_BLK2E = LDSX + 256, LX_CNT = LDSX + 1536, LX_TOK = LDSX + 2048, LX_RST = LDSX + 2048 + 6144;
constexpr int LDS_BYTES = 147456;

typedef __bf16 bf16x2_t __attribute__((ext_vector_type(2)));
__device__ __forceinline__ unsigned cvt_pk_bf16(float lo, float hi) { const f32x2 v = {lo, hi}; const bf16x2_t b = __builtin_convertvector(v, bf16x2_t); return __builtin_bit_cast(unsigned, b); }
__device__ __forceinline__ float bf_lo(unsigned w) { return __builtin_bit_cast(float, w << 16); }
__device__ __forceinline__ float bf_hi(unsigned w) { return __builtin_bit_cast(float, w & 0xffff0000u); }
template <int M> __device__ __forceinline__ float xor_lane(float v) {
    return __builtin_bit_cast(float, __builtin_amdgcn_ds_swizzle(__builtin_bit_cast(int, v), (M << 10) | 0x1f)); }
__device__ __forceinline__ float sum_xor32(float v) {
    const unsigned u = __builtin_bit_cast(unsigned, v); const auto rr = __builtin_amdgcn_permlane32_swap(u, u, false, false);
    return __builtin_bit_cast(float, (unsigned)rr[0]) + __builtin_bit_cast(float, (unsigned)rr[1]); }
__device__ __forceinline__ float max_xor32(float v) {
    const unsigned u = __builtin_bit_cast(unsigned, v); const auto rr = __builtin_amdgcn_permlane32_swap(u, u, false, false);
    return fmaxf(__builtin_bit_cast(float, (unsigned)rr[0]), __builtin_bit_cast(float, (unsigned)rr[1])); }
__device__ __forceinline__ int lane_val(int v, int src_lane) { return __builtin_amdgcn_ds_bpermute(src_lane << 2, v); }
__device__ __forceinline__ float wave_sum(float v) {
    v += xor_lane<1>(v); v += xor_lane<2>(v); v += xor_lane<4>(v); v += xor_lane<8>(v); v += xor_lane<16>(v);
    return sum_xor32(v);
}
__device__ __forceinline__ float fast_exp2(float x) { return __builtin_amdgcn_exp2f(x); }
__device__ __forceinline__ float fast_rcp(float x) { return __builtin_amdgcn_rcpf(x); }

namespace pg8 {
#define PG8_LAS __attribute__((address_space(3)))
typedef unsigned short bf16_t;
typedef short bf16x8 __attribute__((ext_vector_type(8)));
typedef float f32x4 __attribute__((ext_vector_type(4)));
typedef unsigned u32x4 __attribute__((ext_vector_type(4)));
constexpr int BM = 256, BK = 64, HALF = 128, HTB = HALF * BK * 2  , STAGE_BYTES = 8 * HTB, NXCD = 8, WGM = 8;

__host__ __device__ __forceinline__ int lds_byte(int r, int c) { const int st = (r >> 4) * 2 + (c >> 5), rr = r & 15, cc = c & 31, ob = rr * 64 + cc * 2; return st * 1024 + (ob ^ (((ob >> 9) & 1) << 5)); }
__host__ __device__ __forceinline__ void stage_rc(int b, int& R, int& C) { const int st = b / 1024, sb = b % 1024, swz = sb ^ (((sb >> 9) & 1) << 5); R = (st >> 1) * 16 + swz / 64; C = (st & 1) * 32 + (swz % 64) / 2; }
__host__ __device__ __forceinline__ int perm32(int rho) { const int n = rho >> 4, i = rho & 15; return 8 * (i >> 2) + 4 * n + (i & 3); }
struct Unit { int pm, pn; };
struct Gemm { const bf16_t* A; const bf16_t* Bt; int M, N, K; };

struct StaticOrder {
    int nM, nN, nwg, G, c;
    __host__ __device__ void init(int M, int N, int G_, int c_) { nM = M / BM; nN = N / BM; nwg = nM * nN; G = G_; c = c_; }
    __host__ __device__ bool next(int i, Unit& u) const {
        const long L = (long)i * G + c; if (L >= nwg) return false;
        int wgid = (int)L; { const int q = nwg / NXCD, r = nwg % NXCD, xcd = wgid % NXCD, off = wgid / NXCD; wgid = (xcd < r ? xcd * (q + 1) : r * (q + 1) + (xcd - r) * q) + off; }
        const int nig = WGM * nN, gid = wgid / nig, fm = gid * WGM, gsz = (nM - fm) < WGM ? (nM - fm) : WGM;
        u.pm = fm + ((wgid % nig) % gsz); u.pn = (wgid % nig) / gsz; return true;
    }
    __device__ __forceinline__ void a_ready(const Unit&) const {}
    __device__ __forceinline__ void done(const Unit&) const {}
};


struct EpiInProj {
    static constexpr bool PERM = false, AFTER_DRAIN = false;
    bf16_t* qkv; unsigned char* sg; const float* cosT; const float* sinT; const float* qkg; const float* ikg;
    __device__ __forceinline__ void operator()(const f32x4 (&acc)[2][2][4][2], const Unit& u, int wr, int wc, int fr, int fq) const {
        const int pn = u.pn, row0 = u.pm * BM + wr * 64 + fr;
        if (pn >= 15) {
            unsigned char* base = sg + (size_t)row0 * 3072 + (pn - 15) * 256 + wc * 32 + fq * 8;
#pragma unroll
            for (int ai = 0; ai < 2; ++ai)
#pragma unroll
                for (int m = 0; m < 4; ++m)
#pragma unroll
                    for (int bj = 0; bj < 2; ++bj) {
                        unsigned w[2];
#pragma unroll
                        for (int n = 0; n < 2; ++n) { unsigned pk = 0;
#pragma unroll
                            for (int i = 0; i < 4; i += 2) { const float x0 = fminf(fmaxf(acc[ai][bj][m][n][i], -30.f), 30.f), x1 = fminf(fmaxf(acc[ai][bj][m][n][i + 1], -30.f), 30.f);
                                const float a = 1.0f + fast_exp2(-1.4426950408889634f * x0), b = 1.0f + fast_exp2(-1.4426950408889634f * x1), r = 255.0f * fast_rcp(a * b);
                                pk = __builtin_amdgcn_cvt_pk_u8_f32(floorf(b * r + 0.5f), i, pk); pk = __builtin_amdgcn_cvt_pk_u8_f32(floorf(a * r + 0.5f), i + 1, pk); }
                            w[n] = pk; }
                        *(u32x2*)(base + (size_t)(ai * HALF + m * 16) * 3072 + bj * HALF) = (u32x2){w[0], w[1]};
                    }
            return;
        }
        int type = 0, gi = 0; bool qscale = false;
        int ocol = (pn < 8 ? 256 * pn : C_Q1 + 256 * (pn - 9)) + 64 * wc;
        switch (pn) {
            case 0: type = 2; gi = 0; qscale = true; break;
            case 1: type = 2; gi = 1; break;
            case 3: type = 2; gi = 2; qscale = true; break;
            case 4: type = 2; gi = 3; break;
            case 6: case 7: type = 1; break;
            case 8: if (wc == 0) { type = 2; ocol = C_KI; } else if (wc == 1) { type = 3; ocol = C_WI; } else type = 4; break;
            case 9: case 10: type = 2; gi = 4; qscale = true; break;
            case 11: case 12: type = 2; gi = 5; break;
            default: type = 0; break;
        }
        if (type == 4) return;
        if (type == 3) {
            if (fq == 0) {
#pragma unroll
                for (int ai = 0; ai < 2; ++ai)
#pragma unroll
                    for (int m = 0; m < 4; ++m) { const f32x4 a = acc[ai][0][m][0] * 0.35355339059327373f, b = acc[ai][0][m][1] * 0.35355339059327373f;
                        *(u32x4*)(qkv + (size_t)(row0 + ai * HALF + m * 16) * QP + C_WI) = (u32x4){cvt_pk_bf16(a[0], a[1]), cvt_pk_bf16(a[2], a[3]), cvt_pk_bf16(b[0], b[1]), cvt_pk_bf16(b[2], b[3])}; }
            }
            return;
        }
        const float* gp = (pn == 8) ? ikg : qkg + 64 * gi;
        if (type == 2) { if (qscale) body<2, true>(acc, row0, ocol, gp, fq); else body<2, false>(acc, row0, ocol, gp, fq); }
        else if (type == 1) body<1, false>(acc, row0, ocol, gp, fq);
        else body<0, false>(acc, row0, ocol, gp, fq);
    }
    template <int TYPE, bool QS>
    __device__ __forceinline__ void body(const f32x4 (&acc)[2][2][4][2], int row0, int ocol, const float* gp, int fq) const {
#pragma unroll
        for (int ai = 0; ai < 2; ++ai)
#pragma unroll
            for (int m = 0; m < 4; ++m) {
                const int row = row0 + ai * HALF + m * 16;
                f32x4 x[2][2];
#pragma unroll
                for (int bj = 0; bj < 2; ++bj)
#pragma unroll
                    for (int n = 0; n < 2; ++n) x[bj][n] = acc[ai][bj][m][n];
                if (TYPE == 2) {
                    float ss = 0.f;
#pragma unroll
                    for (int bj = 0; bj < 2; ++bj)
#pragma unroll
                        for (int n = 0; n < 2; ++n) ss += (x[bj][n][0] * x[bj][n][0] + x[bj][n][1] * x[bj][n][1]) + (x[bj][n][2] * x[bj][n][2] + x[bj][n][3] * x[bj][n][3]);
                    ss += xor_lane<16>(ss); ss = sum_xor32(ss);
                    const float inv = (QS ? C2 : 1.0f) / sqrtf(ss * (1.0f / 64.0f) + EPS);
#pragma unroll
                    for (int bj = 0; bj < 2; ++bj)
#pragma unroll
                        for (int n = 0; n < 2; ++n) x[bj][n] = x[bj][n] * inv * *(const f32x4*)(gp + 32 * bj + 8 * fq + 4 * n);
                }
                if (TYPE >= 1) {
                    const int pos = row & (SEQ - 1);
#pragma unroll
                    for (int n = 0; n < 2; ++n) {
                        const f32x4 c = *(const f32x4*)(cosT + pos * 32 + 8 * fq + 4 * n), s = *(const f32x4*)(sinT + pos * 32 + 8 * fq + 4 * n);
                        const f32x4 a = x[0][n], b = x[1][n];
                        x[0][n] = a * c - b * s; x[1][n] = b * c + a * s;
                    }
                }
#pragma unroll
                for (int bj = 0; bj < 2; ++bj)
                    *(u32x4*)(qkv + (size_t)row * QP + ocol + 32 * bj + 8 * fq) = (u32x4){cvt_pk_bf16(x[bj][0][0], x[bj][0][1]), cvt_pk_bf16(x[bj][0][2], x[bj][0][3]), cvt_pk_bf16(x[bj][1][0], x[bj][1][1]), cvt_pk_bf16(x[bj][1][2], x[bj][1][3])};
                asm volatile("" ::: "memory");
            }
    }
};

template <int BR> struct EpiMerge {
    static constexpr bool PERM = false, AFTER_DRAIN = false;
    bf16_t* merged; const unsigned char* sg;
    __device__ __forceinline__ void operator()(const f32x4 (&acc)[2][2][4][2], const Unit& u, int wr, int wc, int fr, int fq) const {
        const int row0 = u.pm * BM + wr * 64 + fr, col0 = u.pn * BM + wc * 32 + fq * 8;
#pragma unroll
        for (int ai = 0; ai < 2; ++ai)
#pragma unroll
            for (int m = 0; m < 4; ++m) { const size_t row = (size_t)(row0 + ai * HALF + m * 16);
#pragma unroll
                for (int bj = 0; bj < 2; ++bj) {
                    const u32x2 gq = *(const u32x2*)(sg + row * 3072 + BR * 1024 + col0 + bj * HALF);
                    bf16_t* mp = merged + row * 1024 + col0 + bj * HALF;
                    float v[8];
#pragma unroll
                    for (int n = 0; n < 2; ++n)
#pragma unroll
                        for (int i = 0; i < 4; ++i) v[4 * n + i] = acc[ai][bj][m][n][i] * ((float)((gq[n] >> (8 * i)) & 255u) * (1.0f / 255.0f));
                    if (BR > 0) { const u32x4 o = *(const u32x4*)mp;
#pragma unroll
                        for (int k = 0; k < 4; ++k) { v[2 * k] += bf_lo(o[k]); v[2 * k + 1] += bf_hi(o[k]); } }
                    *(u32x4*)mp = (u32x4){cvt_pk_bf16(v[0], v[1]), cvt_pk_bf16(v[2], v[3]), cvt_pk_bf16(v[4], v[5]), cvt_pk_bf16(v[6], v[7])};
                }
                asm volatile("" ::: "memory"); }
    }
};

struct EpiResid {
    static constexpr bool PERM = false, AFTER_DRAIN = false;
    const float* res; float* out;
    __device__ __forceinline__ void operator()(const f32x4 (&acc)[2][2][4][2], const Unit& u, int wr, int wc, int fr, int fq) const {
        const int row0 = u.pm * BM + wr * 64 + fr, col0 = u.pn * BM + wc * 32 + fq * 8;
#pragma unroll
        for (int ai = 0; ai < 2; ++ai)
#pragma unroll
            for (int m = 0; m < 4; ++m) { const size_t off = (size_t)(row0 + ai * HALF + m * 16) * 1024 + col0;
#pragma unroll
                for (int bj = 0; bj < 2; ++bj)
#pragma unroll
                    for (int n = 0; n < 2; ++n) { const f32x4 r = *(const f32x4*)(res + off + bj * HALF + 4 * n); *(f32x4*)(out + off + bj * HALF + 4 * n) = r + acc[ai][bj][m][n]; }
                if (m & 1) asm volatile("" ::: "memory"); }
    }
};

struct EpiGateUp {
    static constexpr bool PERM = false, AFTER_DRAIN = false;
    bf16_t* hid; const PG8_LAS float* rst; int rbs;
    __device__ __forceinline__ void operator()(const f32x4 (&acc)[2][2][4][2], const Unit& u, int wr, int wc, int fr, int fq) const {
        const int row0 = u.pm * BM + wr * 64 + fr, col0 = (u.pn & 3) * HALF + wc * 32 + fq * 8;
        const PG8_LAS float* rs = rst + (u.pm / rbs) * 256 + wr * 64 + fr;
#pragma unroll
        for (int ai = 0; ai < 2; ++ai)
#pragma unroll
            for (int m = 0; m < 4; ++m) { float v[8]; const float r = rs[ai * HALF + m * 16];
#pragma unroll
                for (int n = 0; n < 2; ++n)
#pragma unroll
                    for (int i = 0; i < 4; ++i) { const float gt = acc[ai][0][m][n][i] * r, up = acc[ai][1][m][n][i] * r; v[4 * n + i] = gt * fast_rcp(1.0f + fast_exp2(-1.4426950408889634f * gt)) * up; }
                *(u32x4*)(hid + (size_t)(row0 + ai * HALF + m * 16) * DEXP + col0) = (u32x4){cvt_pk_bf16(v[0], v[1]), cvt_pk_bf16(v[2], v[3]), cvt_pk_bf16(v[4], v[5]), cvt_pk_bf16(v[6], v[7])}; }
    }
};

struct EpiDown {
    static constexpr bool PERM = false, AFTER_DRAIN = false;
    bf16_t* y;
    __device__ __forceinline__ void operator()(const f32x4 (&acc)[2][2][4][2], const Unit& u, int wr, int wc, int fr, int fq) const {
        const int row0 = u.pm * BM + wr * 64 + fr, col0 = (u.pn & 3) * BM + wc * 32 + fq * 8;
#pragma unroll
        for (int ai = 0; ai < 2; ++ai)
#pragma unroll
            for (int m = 0; m < 4; ++m)
#pragma unroll
                for (int bj = 0; bj < 2; ++bj) { const f32x4 a = acc[ai][bj][m][0], b = acc[ai][bj][m][1];
                    *(u32x4*)(y + (size_t)(row0 + ai * HALF + m * 16) * 1024 + col0 + bj * HALF) = (u32x4){cvt_pk_bf16(a[0], a[1]), cvt_pk_bf16(a[2], a[3]), cvt_pk_bf16(b[0], b[1]), cvt_pk_bf16(b[2], b[3])}; }
    }
};

struct AMapMoe { static constexpr bool GATHER = true; const PG8_LAS int* tok; int rbs;
    __device__ __forceinline__ unsigned row(const Unit& u, int R) const { return (unsigned)tok[(u.pm / rbs) * 256 + R]; } };
struct MoeOrder {
    int nunits, G, c; const PG8_LAS int* blk2e;
    __device__ __forceinline__ bool next(int i, Unit& u) const { const int L = i * G + c; if (L >= nunits) return false; const int rb = L >> 2; u.pm = rb; u.pn = blk2e[rb] * 4 + (L & 3); return true; }
    __device__ __forceinline__ void a_ready(const Unit&) const {}
    __device__ __forceinline__ void done(const Unit&) const {}
};

struct NoAMap { static constexpr bool GATHER = false; __device__ __forceinline__ unsigned row(const Unit&, int) const { return 0u; } };
template <class Epi, class Sched, bool ALIGN_EPI = false, bool SP2 = false, class AMap = NoAMap>
__device__ __forceinline__ void gemm_phase(PG8_LAS unsigned char* lds, const Gemm g, const Sched& S, const Epi& E, const AMap& AM = AMap()) {
    static_assert(!AMap::GATHER || SP2, "the row gather is wired into the SP2 loop only");
    int tid_l = (int)threadIdx.x; asm volatile("" : "+v"(tid_l));
    const int tid = tid_l, wid = __builtin_amdgcn_readfirstlane(tid >> 6), lane = tid & 63, wr = wid >> 2, wc = wid & 3, fr = lane & 15, fq = lane >> 4;
    const int K = g.K, nt = K / BK;
    unsigned voffA[2], voffB[2];
#pragma unroll
    for (int i = 0; i < 2; ++i) { int R, C; stage_rc(tid * 16 + i * 8192, R, C); const int Rb = Epi::PERM ? ((R & ~31) + perm32(R & 31)) : R;
        voffA[i] = (unsigned)(R * K + C) * 2u; voffB[i] = (unsigned)(Rb * K + C) * 2u; }
    int RA[2], CA[2];
#pragma unroll
    for (int i = 0; i < 2; ++i) stage_rc(tid * 16 + i * 8192, RA[i], CA[i]);
    unsigned vC0[2] = {0u, 0u}, vC1[2] = {0u, 0u}, vN0[2] = {0u, 0u}, vN1[2] = {0u, 0u};
#define PG8_AOFFS(v0, v1, unit) do { if constexpr (AMap::GATHER) { _Pragma("unroll") for (int _i = 0; _i < 2; ++_i) { \
        v0[_i] = (AM.row(unit, RA[_i]) * (unsigned)K + (unsigned)CA[_i]) * 2u; v1[_i] = (AM.row(unit, HALF + RA[_i]) * (unsigned)K + (unsigned)CA[_i]) * 2u; } } } while (0)
#define PG8_STAGE_A(bufoff, base, half, usenext) do { if constexpr (AMap::GATHER) { unsigned vv_[2]; _Pragma("unroll") for (int _j = 0; _j < 2; ++_j) vv_[_j] = (usenext) ? ((half) ? vN1[_j] : vN0[_j]) : ((half) ? vC1[_j] : vC0[_j]); \
        PG8_STAGE(bufoff, base, vv_); } else { PG8_STAGE(bufoff, (base) + (half) * hstep, voffA); } } while (0)
    const size_t kstep = (size_t)(BK * 2);
    const size_t hstep = (size_t)HALF * K * 2;
    const size_t tstep = 2 * hstep;
    const unsigned ldsw = (unsigned)wid * 1024u;
    const int aoff = lds_byte(wr * 64 + fr, fq * 8), boff = lds_byte(wc * 32 + fr, fq * 8);
#define PG8_SA(b, h) (((b) * 2 + (h)) * HTB)
#define PG8_SB(b, h) ((4 + (b) * 2 + (h)) * HTB)
#define PG8_STAGE(bufoff, gbase, voff) do { _Pragma("unroll") for (int _i = 0; _i < 2; ++_i) \
        __builtin_amdgcn_global_load_lds((const unsigned*)((const char*)(gbase) + (voff)[_i]), (PG8_LAS unsigned*)(lds + (bufoff) + ldsw + _i * 8192), 16, 0, 0); } while (0)
#define PG8_LDA(dst, b, h) do { _Pragma("unroll") for (int m = 0; m < 4; ++m) _Pragma("unroll") for (int k = 0; k < 2; ++k) dst[m][k] = *(const PG8_LAS bf16x8*)(lds + PG8_SA(b, h) + aoff + m * 2048 + k * 1024); } while (0)
#define PG8_LDB(dst, b, h) do { _Pragma("unroll") for (int n = 0; n < 2; ++n) _Pragma("unroll") for (int k = 0; k < 2; ++k) dst[n][k] = *(const PG8_LAS bf16x8*)(lds + PG8_SB(b, h) + boff + n * 2048 + k * 1024); } while (0)
#define PG8_MMA(ai, bj, At, Bt) do { __builtin_amdgcn_s_setprio(1); _Pragma("unroll") for (int m = 0; m < 4; ++m) _Pragma("unroll") for (int n = 0; n < 2; ++n) _Pragma("unroll") for (int k = 0; k < 2; ++k) \
        acc[ai][bj][m][n] = __builtin_amdgcn_mfma_f32_16x16x32_bf16(Bt[n][k], At[m][k], acc[ai][bj][m][n], 0, 0, 0); __builtin_amdgcn_s_setprio(0); } while (0)
#define PG8_WAIT_V(n) asm volatile("s_waitcnt vmcnt(" #n ")" ::: "memory")
#define PG8_WAIT_L(n) asm volatile("s_waitcnt lgkmcnt(" #n ")" ::: "memory")
#define PG8_BAR __builtin_amdgcn_s_barrier()
#define PG8_SCHED __builtin_amdgcn_sched_barrier(0)
    Unit cur, nxt; int ui = 0;
    if (!S.next(0, cur)) return;
    f32x4 acc[2][2][4][2];
#pragma unroll
    for (int a = 0; a < 2; ++a)
#pragma unroll
        for (int b = 0; b < 2; ++b)
#pragma unroll
            for (int m = 0; m < 4; ++m)
#pragma unroll
                for (int n = 0; n < 2; ++n) acc[a][b][m][n] = (f32x4){0.f, 0.f, 0.f, 0.f};
    bf16x8 At[4][2], B0[2][2], B1[2][2];
    const char* cA = (const char*)g.A + (AMap::GATHER ? (size_t)0 : (size_t)cur.pm * tstep); const char* cB = (const char*)g.Bt + (size_t)cur.pn * tstep;
    PG8_AOFFS(vC0, vC1, cur);
    S.a_ready(cur);
    if constexpr (SP2) {
        PG8_STAGE(PG8_SB(0, 0), cB, voffB); PG8_STAGE(PG8_SB(0, 1), cB + hstep, voffB); PG8_STAGE_A(PG8_SA(0, 0), cA, 0, false); PG8_STAGE_A(PG8_SA(0, 1), cA, 1, false);
        if (wr == 1) PG8_BAR;
        PG8_WAIT_V(2); PG8_BAR;
        PG8_STAGE(PG8_SB(1, 0), cB + kstep, voffB); PG8_STAGE_A(PG8_SA(1, 0), cA + kstep, 0, false); PG8_STAGE(PG8_SB(1, 1), cB + hstep + kstep, voffB);
        PG8_WAIT_V(6); PG8_BAR;
    } else {
        PG8_STAGE(PG8_SB(0, 0), cB, voffB); PG8_STAGE(PG8_SA(0, 0), cA, voffA); PG8_STAGE(PG8_SB(0, 1), cB + hstep, voffB); PG8_STAGE(PG8_SA(0, 1), cA + hstep, voffA);
        if (wr == 1) PG8_BAR;
        PG8_WAIT_V(4); PG8_BAR;
        PG8_STAGE(PG8_SB(1, 0), cB + kstep, voffB); PG8_STAGE(PG8_SA(1, 0), cA + kstep, voffA); PG8_STAGE(PG8_SB(1, 1), cB + hstep + kstep, voffB);
        PG8_WAIT_V(6); PG8_BAR;
    }
    for (;;) {
        const bool has_next = S.next(ui + 1, nxt);
        const char* nA = (has_next && !AMap::GATHER) ? (const char*)g.A + (size_t)nxt.pm * tstep : cA; const char* nB = has_next ? (const char*)g.Bt + (size_t)nxt.pn * tstep : cB;
        if constexpr (AMap::GATHER) { if (has_next) PG8_AOFFS(vN0, vN1, nxt); else { vN0[0] = vC0[0]; vN0[1] = vC0[1]; vN1[0] = vC1[0]; vN1[1] = vC1[1]; } }
#pragma unroll 1
        for (int t = 0; t < nt; t += 2) {
            const bool last = (t == nt - 2);
            const char* a1 = cA + (size_t)(t + 1) * kstep;
            const char* a2 = last ? nA : cA + (size_t)(t + 2) * kstep; const char* b2 = last ? nB : cB + (size_t)(t + 2) * kstep;
            const char* a3 = a2 + kstep; const char* b3 = b2 + kstep;
            if (last && has_next) S.a_ready(nxt);
            if constexpr (SP2) {
            PG8_LDB(B0, 0, 0); PG8_LDB(B1, 0, 1); PG8_SCHED; PG8_LDA(At, 0, 0); PG8_STAGE_A(PG8_SA(1, 1), a1, 1, false);
            PG8_WAIT_V(8); PG8_WAIT_L(0); PG8_BAR; PG8_MMA(0, 0, At, B0); PG8_MMA(0, 1, At, B1); PG8_BAR; PG8_SCHED;
            PG8_LDA(At, 0, 1); PG8_STAGE(PG8_SB(0, 0), b2, voffB); PG8_STAGE(PG8_SB(0, 1), b2 + hstep, voffB); PG8_STAGE_A(PG8_SA(0, 0), a2, 0, last);
            PG8_WAIT_V(8); PG8_WAIT_L(0); PG8_BAR; PG8_MMA(1, 0, At, B0); PG8_MMA(1, 1, At, B1); PG8_BAR; PG8_SCHED;
            PG8_LDB(B0, 1, 0); PG8_LDB(B1, 1, 1); PG8_SCHED; PG8_LDA(At, 1, 0); PG8_STAGE_A(PG8_SA(0, 1), a2, 1, last);
            PG8_WAIT_V(8); PG8_WAIT_L(0); PG8_BAR; PG8_MMA(0, 0, At, B0); PG8_MMA(0, 1, At, B1); PG8_BAR; PG8_SCHED;
            PG8_LDA(At, 1, 1); PG8_STAGE(PG8_SB(1, 0), b3, voffB); PG8_STAGE(PG8_SB(1, 1), b3 + hstep, voffB); PG8_STAGE_A(PG8_SA(1, 0), a3, 0, last);
            PG8_WAIT_V(8); PG8_WAIT_L(0); PG8_BAR; PG8_MMA(1, 0, At, B0); PG8_MMA(1, 1, At, B1); PG8_BAR; PG8_SCHED;
            } else {
            PG8_LDB(B0, 0, 0); PG8_SCHED; PG8_LDA(At, 0, 0); PG8_STAGE(PG8_SA(1, 1), a1 + hstep, voffA);
            PG8_WAIT_L(8); PG8_BAR; PG8_WAIT_L(0); PG8_MMA(0, 0, At, B0); PG8_BAR; PG8_SCHED;
            PG8_LDB(B1, 0, 1); PG8_STAGE(PG8_SB(0, 0), b2, voffB);
            PG8_BAR; PG8_WAIT_L(0); PG8_MMA(0, 1, At, B1); PG8_BAR;
            PG8_LDA(At, 0, 1); PG8_STAGE(PG8_SA(0, 0), a2, voffA);
            PG8_BAR; PG8_WAIT_L(0); PG8_MMA(1, 0, At, B0); PG8_BAR; PG8_SCHED;
            PG8_STAGE(PG8_SB(0, 1), b2 + hstep, voffB);
            PG8_WAIT_V(6); PG8_BAR; PG8_MMA(1, 1, At, B1); PG8_BAR;
            PG8_LDB(B0, 1, 0); PG8_SCHED; PG8_LDA(At, 1, 0); PG8_STAGE(PG8_SA(0, 1), a2 + hstep, voffA);
            PG8_WAIT_L(8); PG8_BAR; PG8_WAIT_L(0); PG8_MMA(0, 0, At, B0); PG8_BAR; PG8_SCHED;
            PG8_LDB(B1, 1, 1); PG8_STAGE(PG8_SB(1, 0), b3, voffB);
            PG8_BAR; PG8_WAIT_L(0); PG8_MMA(0, 1, At, B1); PG8_BAR;
            PG8_LDA(At, 1, 1); PG8_STAGE(PG8_SA(1, 0), a3, voffA);
            PG8_BAR; PG8_WAIT_L(0); PG8_MMA(1, 0, At, B0); PG8_BAR; PG8_SCHED;
            PG8_STAGE(PG8_SB(1, 1), b3 + hstep, voffB);
            PG8_WAIT_V(6); PG8_BAR; PG8_MMA(1, 1, At, B1); PG8_BAR;
            }
        }
        if constexpr (ALIGN_EPI) { if (wr == 0) PG8_BAR; }
        if constexpr (!Epi::AFTER_DRAIN) { E(acc, cur, wr, wc, fr, fq); S.done(cur); }
        if (!has_next) break;
#pragma unroll
        for (int a = 0; a < 2; ++a)
#pragma unroll
            for (int b = 0; b < 2; ++b)
#pragma unroll
                for (int m = 0; m < 4; ++m)
#pragma unroll
                    for (int n = 0; n < 2; ++n) acc[a][b][m][n] = (f32x4){0.f, 0.f, 0.f, 0.f};
        cur = nxt; cA = nA; cB = nB; ++ui;
        if constexpr (AMap::GATHER) { vC0[0] = vN0[0]; vC0[1] = vN0[1]; vC1[0] = vN1[0]; vC1[1] = vN1[1]; }
        if constexpr (ALIGN_EPI) { if (wr == 1) PG8_BAR; }
    }
    PG8_WAIT_V(0);
    if constexpr (!ALIGN_EPI) { if (wr == 0) PG8_BAR; }
    PG8_BAR;
    if constexpr (Epi::AFTER_DRAIN) { E.fused(acc, cur, wr, wc, fr, fq, lds, wid, lane); S.done(cur); }
#undef PG8_SA
#undef PG8_AOFFS
#undef PG8_STAGE_A
#undef PG8_SB
#undef PG8_STAGE
#undef PG8_LDA
#undef PG8_LDB
#undef PG8_MMA
#undef PG8_WAIT_V
#undef PG8_WAIT_L
#undef PG8_BAR
#undef PG8_SCHED
}
}
#define XB_TMO      128
#define XB_XCNT(j)  (256  + 64 * (j))
#define XB_XSUB(j)  (1280 + 64 * (j))
#define XB_XGEN(j)  (2304 + 64 * (j))
#define XB_TOP      3328
#define XB_TOPGEN   3392
#define XCD_BAR_WORDS 3456
#define XB_SPIN_CAP (1u << 21)

__device__ __forceinline__ unsigned xb_ld(unsigned* p)              { return __hip_atomic_load(p, __ATOMIC_RELAXED, __HIP_MEMORY_SCOPE_AGENT); }
__device__ __forceinline__ unsigned xb_add(unsigned* p, unsigned v) { return __hip_atomic_fetch_add(p, v, __ATOMIC_RELAXED, __HIP_MEMORY_SCOPE_AGENT); }
__device__ __forceinline__ unsigned xb_xcc_id() { return (unsigned)__builtin_amdgcn_s_getreg((3 << 11) | 20) & 0xFu; }
#define XB_SPIN(cond, bar) do { unsigned _sp = 0; while (cond) { __builtin_amdgcn_s_sleep(1); \
    if ((++_sp & 255u) == 0u) { if (xb_ld(&(bar)[XB_TMO])) break; if (_sp > XB_SPIN_CAP) { atomicAdd(&(bar)[XB_TMO], 1u); break; } } } } while (0)

struct XcdBarrier {
    unsigned* bar; unsigned x;
    volatile LAS unsigned* st;
};

__device__ __forceinline__ XcdBarrier xcd_barrier_post(unsigned* bar, volatile LAS unsigned* st) {
    XcdBarrier b; b.bar = bar; b.x = xb_xcc_id(); b.st = st;
    if (threadIdx.x == 0) (void)xb_add(&bar[XB_XCNT(b.x)], 1u);
    return b;
}
__device__ __forceinline__ void xcd_barrier_complete(unsigned* bar, unsigned x, unsigned& nloc, unsigned& nx) {
    const unsigned G = gridDim.x * gridDim.y * gridDim.z;
    unsigned sum, cnt, mine, sp = 0u;
    for (;;) {
        sum = 0u; cnt = 0u; mine = 0u;
#pragma unroll
        for (unsigned j = 0; j < 16; ++j) { const unsigned c = xb_ld(&bar[XB_XCNT(j)]); sum += c; cnt += (c > 0u) ? 1u : 0u; mine = (j == x) ? c : mine; }
        if (sum == G) break;
        __builtin_amdgcn_s_sleep(1);
        if ((++sp & 255u) == 0u) { if (xb_ld(&bar[XB_TMO])) break; if (sp > XB_SPIN_CAP) { atomicAdd(&bar[XB_TMO], 1u); break; } }
    }
    nloc = mine > 0u ? mine : 1u; nx = cnt > 0u ? cnt : 1u;
}

__device__ __forceinline__ void xcd_barrier(const XcdBarrier& b) {
    asm volatile("s_waitcnt vmcnt(0)" ::: "memory");
    __syncthreads();
    int tid_l = (int)threadIdx.x; asm volatile("" : "+v"(tid_l));
    if (tid_l == 0) {
        unsigned* bar = b.bar;
        __builtin_amdgcn_s_waitcnt(0);
        unsigned nloc = b.st[0], nx = b.st[1];
        if (nloc == 0u) { xcd_barrier_complete(bar, b.x, nloc, nx); b.st[0] = nloc; b.st[1] = nx; }
        const unsigned old = xb_add(&bar[XB_XSUB(b.x)], 1u);
        const unsigned gen = old / nloc;
        if (old + 1u == (gen + 1u) * nloc) {
            __builtin_amdgcn_fence(__ATOMIC_RELEASE, "agent");
            asm volatile("s_waitcnt vmcnt(0)" ::: "memory");
            const unsigned og = xb_add(&bar[XB_TOP], 1u);
            const unsigned tg = og / nx;
            if (og + 1u == (tg + 1u) * nx) xb_add(&bar[XB_TOPGEN], 1u);
            else XB_SPIN(xb_ld(&bar[XB_TOPGEN]) == tg, bar);
            __builtin_amdgcn_fence(__ATOMIC_ACQUIRE, "agent");
            xb_add(&bar[XB_XGEN(b.x)], 1u);
            asm volatile("s_waitcnt vmcnt(0)" ::: "memory");
        } else {
            XB_SPIN(xb_ld(&bar[XB_XGEN(b.x)]) == gen, bar);
            __builtin_amdgcn_fence(__ATOMIC_ACQUIRE, "agent");
            asm volatile("s_waitcnt vmcnt(0)" ::: "memory");
        }
    }
    __syncthreads();
}

enum { I_X = 0, I_NORM_ATTN, I_W_IN, I_QK_GAIN, I_IDX_K_GAIN, I_DIFF_LAMBDA, I_DIFF_SUBLN, I_W_PROJ_A, I_W_PROJ_B, I_W_PROJ_C, I_W_OUT, I_NORM_FFN, I_W_GROUP, I_B_GROUP, I_W_ROUTER, I_B_ROUTER,
       I_W_E_GATE, I_W_E_UP, I_W_E_DOWN, N_INPUTS };
struct Args { const float* in[N_INPUTS]; float* out; unsigned char* ws; };

#define LDS_WAIT() asm volatile("s_waitcnt lgkmcnt(0)" ::: "memory")

__device__ __forceinline__ int inproj_src_col(int d) {
    const int pn = d >> 8, s = d & 255;
    if (pn >= 15) return C_G + 256 * (pn - 15) + (s & ~31) + pg8::perm32(s & 31);
    const int u = (s >> 5) & 3, e = 32 * (s >> 7) + pg8::perm32(s & 31);
    if (pn < 8) return 256 * pn + 64 * u + e;
    if (pn == 8) { if (u == 0) return C_KI + e; if (u == 1) return e < 8 ? C_WI + e : -1; return -1; }
    return C_Q1 + 256 * (pn - 9) + 64 * u + e;
}
__device__ __forceinline__ void transpose_item(const float* W, int ldw, int K, bf16_t* WT, int drow0, int k0, int srccol, LAS float* scr, int lane) {
    const float* src = W + (size_t)k0 * ldw + (srccol >= 0 ? srccol : 0);
#pragma unroll 8
    for (int i = 0; i < 32; ++i) { const int kk = 2 * i + (lane >> 5); const float v = src[(size_t)kk * ldw]; scr[kk * 33 + (lane & 31)] = srccol >= 0 ? v : 0.f; }
    LDS_WAIT(); asm volatile("" ::: "memory");
    const int c = lane & 7;
#pragma unroll
    for (int j = 0; j < 4; ++j) { const int n = (lane >> 3) + 8 * j; const LAS float* s = scr + (8 * c) * 33 + n;
        u32x4 o; o.x = cvt_pk_bf16(s[0 * 33], s[1 * 33]); o.y = cvt_pk_bf16(s[2 * 33], s[3 * 33]); o.z = cvt_pk_bf16(s[4 * 33], s[5 * 33]); o.w = cvt_pk_bf16(s[6 * 33], s[7 * 33]);
        *(u32x4*)(WT + (size_t)(drow0 + n) * K + k0 + 8 * c) = o; }
    LDS_WAIT(); asm volatile("" ::: "memory");
}

template <bool COMBINE, bool WRITE_HN>
__device__ __forceinline__ void token_row(const float* src, float* dst, const bf16_t* y, const unsigned* rt0, const unsigned* rt1, const f32x2* rtw, const LAS int* pstart,
                                          const float* gain, bf16_t* hn, int m, int lane) {
    f32x4 v[4];
#pragma unroll
    for (int j = 0; j < 4; ++j) v[j] = ((const f32x4*)(src + (size_t)m * DM))[lane + 64 * j];
    if (COMBINE) {
        const unsigned a = rt0[m], b = rt1[m]; const f32x2 w = rtw[m];
        const size_t s0 = (size_t)(pstart[a >> 24] + (int)(a & 0xffffffu)), s1 = (size_t)(pstart[b >> 24] + (int)(b & 0xffffffu));
#pragma unroll
        for (int j = 0; j < 4; ++j) { const u32x2 p = ((const u32x2*)(y + s0 * DM))[lane + 64 * j], q = ((const u32x2*)(y + s1 * DM))[lane + 64 * j];
            v[j][0] += w[0] * bf_lo(p[0]) + w[1] * bf_lo(q[0]); v[j][1] += w[0] * bf_hi(p[0]) + w[1] * bf_hi(q[0]);
            v[j][2] += w[0] * bf_lo(p[1]) + w[1] * bf_lo(q[1]); v[j][3] += w[0] * bf_hi(p[1]) + w[1] * bf_hi(q[1]);
            ((f32x4*)(dst + (size_t)m * DM))[lane + 64 * j] = v[j]; }
    }
    if (WRITE_HN) {
        float ss = 0.f;
#pragma unroll
        for (int j = 0; j < 4; ++j) ss += (v[j][0] * v[j][0] + v[j][1] * v[j][1]) + (v[j][2] * v[j][2] + v[j][3] * v[j][3]);
        const float rstd = 1.0f / sqrtf(wave_sum(ss) * (1.0f / DM) + EPS);
#pragma unroll
        for (int j = 0; j < 4; ++j) { const f32x4 g = ((const f32x4*)gain)[lane + 64 * j]; const f32x4 o = v[j] * rstd * g;
            ((u32x2*)(hn + (size_t)m * DM))[lane + 64 * j] = (u32x2){cvt_pk_bf16(o[0], o[1]), cvt_pk_bf16(o[2], o[3])}; }
    }
}

template <bool EXPERTS> __device__ __forceinline__ void convert_weights(const Args& a, unsigned char* ws, int l, LAS unsigned char* lds, int lane, int wave, int vcu, int G, int chunk = -1);
__device__ __forceinline__ void p0_phase(const Args& a, unsigned char* ws, int l, LAS unsigned char* lds, int tid, int lane, int wave, int vcu, int G) {
    convert_weights<false>(a, ws, l, lds, lane, wave, vcu, G);
    const int gw = vcu * 8 + wave, NGW = G * 8, gt = vcu * 512 + tid, NGT = G * 512;
    if (l == 0) {
        float* cosT = (float*)(ws + WS_COS); float* sinT = (float*)(ws + WS_SIN);
        for (int idx = gt; idx < SEQ * 32; idx += NGT) { const int pos = idx >> 5, j = idx & 31;
            const float inv_freq = 1.0f / powf(10000.0f, (float)(2 * j) * (1.0f / 64.0f));
            const float ang = (float)pos * inv_freq;
            const double rev = (double)ang * 0.15915494309189533577; const float fr = (float)(rev - rint(rev));
            cosT[idx] = __builtin_amdgcn_cosf(fr); sinT[idx] = __builtin_amdgcn_sinf(fr); }
    }
    { float* wrt = (float*)(ws + WS_WRT); const float* wg = a.in[I_W_GROUP] + (size_t)l * DM * 4; const float* wr = a.in[I_W_ROUTER] + (size_t)l * DM * 32;
      const float* g2 = a.in[I_NORM_FFN] + (size_t)l * DM;
      for (int idx = gt; idx < 36 * DM; idx += NGT) { const int c = idx >> 10, k = idx & 1023; wrt[idx] = g2[k] * (c < 4 ? wg[k * 4 + c] : wr[k * 32 + (c - 4)]); } }
    const float* gain = a.in[I_NORM_ATTN] + (size_t)l * DM; bf16_t* hn = (bf16_t*)(ws + WS_HN);
    const LAS int* pstart = (const LAS int*)(lds + LX_PSTART);
    if (l == 0) { for (int m = gw; m < MTOK; m += NGW) token_row<false, true>(a.in[I_X], nullptr, nullptr, nullptr, nullptr, nullptr, pstart, gain, hn, m, lane); }
    else { for (int m = gw; m < MTOK; m += NGW) token_row<true, true>(a.out, a.out, (const bf16_t*)(ws + WS_Y), (const unsigned*)(ws + WS_RT0), (const unsigned*)(ws + WS_RT1), (const f32x2*)(ws + WS_RTW), pstart, gain, hn, m, lane); }
}

template <bool EXPERTS> __device__ __forceinline__ void convert_weights(const Args& a, unsigned char* ws, int l, LAS unsigned char* lds, int lane, int wave, int vcu, int G, int chunk) {
    LAS float* scr = (LAS float*)(lds + wave * 16384);
    int gw = vcu * 8 + wave, NGW = G * 8;
    constexpr int I_IN = 216 * 16, I_PA = 32 * 4, I_PC = 32 * 8, I_WO = 32 * 16, I_GU = 32 * 32 * 16, I_DN = 32 * 32 * 8, NIT = I_IN + 2 * I_PA + I_PC + I_WO + I_GU + I_DN;
    constexpr int I_SMALL = I_IN + 2 * I_PA + I_PC + I_WO;
    int it_end = EXPERTS ? NIT : I_SMALL;
    if (chunk >= 0) { gw = chunk * 128 + wave * 16; NGW = 1; it_end = I_SMALL + gw + 16 < NIT ? I_SMALL + gw + 16 : NIT; }
    for (int it = gw + (EXPERTS ? I_SMALL : 0); it < it_end; it += NGW) {
        int r = it; const int d31 = lane & 31;
        if (r < I_IN) { const int nb = r >> 4, kb = r & 15; transpose_item(a.in[I_W_IN] + (size_t)l * DM * D_IN, D_IN, 1024, (bf16_t*)(ws + WS_WIN), nb * 32, kb * 64, inproj_src_col(nb * 32 + d31), scr, lane); continue; } r -= I_IN;
        const int pcol = pg8::perm32(d31);
        if (r < I_PA) { const int nb = r >> 2, kb = r & 3; transpose_item(a.in[I_W_PROJ_A] + (size_t)l * 256 * DM, DM, 256, (bf16_t*)(ws + WS_WPA), nb * 32, kb * 64, nb * 32 + pcol, scr, lane); continue; } r -= I_PA;
        if (r < I_PA) { const int nb = r >> 2, kb = r & 3; transpose_item(a.in[I_W_PROJ_B] + (size_t)l * 256 * DM, DM, 256, (bf16_t*)(ws + WS_WPB), nb * 32, kb * 64, nb * 32 + pcol, scr, lane); continue; } r -= I_PA;
        if (r < I_PC) { const int nb = r >> 3, kb = r & 7; transpose_item(a.in[I_W_PROJ_C] + (size_t)l * 512 * DM, DM, 512, (bf16_t*)(ws + WS_WPC), nb * 32, kb * 64, nb * 32 + pcol, scr, lane); continue; } r -= I_PC;
        if (r < I_WO) { const int nb = r >> 4, kb = r & 15; transpose_item(a.in[I_W_OUT] + (size_t)l * DM * DM, DM, 1024, (bf16_t*)(ws + WS_WO), nb * 32, kb * 64, nb * 32 + pcol, scr, lane); continue; } r -= I_WO;
        if (r < I_GU) { const int e = r >> 9, rr = r & 511, nb = rr >> 4, kb = rr & 15, dd = nb * 32, pn = dd >> 8, s = dd & 255, half = s >> 7;
            const float* src = (half ? a.in[I_W_E_UP] : a.in[I_W_E_GATE]) + (size_t)(l * NEXP + e) * DM * DEXP;
            transpose_item(src, DEXP, 1024, (bf16_t*)(ws + WS_WGU) + (size_t)e * 1024 * 1024, nb * 32, kb * 64, 128 * pn + (s & 127) + pcol, scr, lane); continue; } r -= I_GU;
        { const int e = r >> 8, rr = r & 255, nb = rr >> 3, kb = rr & 7;
            transpose_item(a.in[I_W_E_DOWN] + (size_t)(l * NEXP + e) * DEXP * DM, DM, 512, (bf16_t*)(ws + WS_WD) + (size_t)e * 1024 * 512, nb * 32, kb * 64, nb * 32 + pcol, scr, lane); }
    }
}

__device__ __forceinline__ f32x16 mfma32(bf16x8 a, bf16x8 b, f32x16 c) { return __builtin_amdgcn_mfma_f32_32x32x16_bf16(a, b, c, 0, 0, 0); }
typedef short v4i16_t __attribute__((ext_vector_type(4)));
__device__ __forceinline__ s16x4 vtr(const LAS unsigned char* p) { return __builtin_bit_cast(s16x4, __builtin_amdgcn_ds_read_tr16_b64_v4i16((LAS v4i16_t*)p)); }
__device__ __forceinline__ int crow(int r, int hi) { return (r & 3) + 8 * (r >> 2) + 4 * hi; }
#define NEG_INF (-__builtin_inff())

__device__ __forceinline__ f32x16 splat16(float v) { f32x16 r;
#pragma unroll
    for (int i = 0; i < 16; ++i) r[i] = v;
    return r; }
__device__ __forceinline__ int kimg_off(int key, int ch) { return key * 128 + ((ch ^ ((key >> 1) & 7)) << 4); }
__device__ __forceinline__ int kdma_row(int w, int lane) { return 8 * w + (lane >> 3); }
__device__ __forceinline__ int kdma_chunk(int w, int lane) { return (lane & 7) ^ (((8 * w + (lane >> 3)) >> 1) & 7); }
struct QReg { const bf16x8 (&q)[4]; __device__ __forceinline__ bf16x8 operator()(int ks) const { return q[ks]; } };
struct QLds { const LAS unsigned char* p; __device__ __forceinline__ bf16x8 operator()(int ks) const { return *(const LAS bf16x8*)(p + ks * 1024); } };
template <int NDB, class QF, class MaskF>
__device__ __forceinline__ void flash_tile(float& m_run, float& l_run, f32x16 (&o)[NDB], const LAS unsigned char* kimg, const LAS unsigned char* vimg, const QF& qf, const MaskF& maskf, int r32, int hi, int vboff) {
    if (NDB == 4) __builtin_amdgcn_sched_barrier(0);
    f32x16 p0, p1; maskf.init(p0, p1);
#pragma unroll
    for (int ks = 0; ks < 4; ++ks) {
        const bf16x8 a0 = *(const LAS bf16x8*)(kimg + (NDB == 4 ? (2 * ks + hi) * 1024 + r32 * 16 : kimg_off(r32, 2 * ks + hi)));
        const bf16x8 a1 = *(const LAS bf16x8*)(kimg + (NDB == 4 ? (2 * ks + hi) * 1024 + 512 + r32 * 16 : kimg_off(r32, 2 * ks + hi) + 4096));
        const bf16x8 qk = qf(ks);
        p0 = mfma32(a0, qk, p0); p1 = mfma32(a1, qk, p1);
        if (NDB == 4 && (ks & 1)) __builtin_amdgcn_sched_barrier(0);
    }
    maskf(p0, p1);
    float mx = fmaxf(p0[0], p1[0]);
#pragma unroll
    for (int r = 1; r < 16; ++r) mx = fmaxf(mx, fmaxf(p0[r], p1[r]));
    mx = max_xor32(mx);
    const float mnew = fmaxf(m_run, mx);
    if (__ballot(mnew > m_run) != 0ull) {
        const float alpha = fast_exp2(m_run - mnew);
        l_run *= alpha;
#pragma unroll
        for (int db = 0; db < NDB; ++db) o[db] = o[db] * alpha;
    }
    m_run = mnew;
    float sum = 0.f;
#pragma unroll
    for (int r = 0; r < 16; ++r) { p0[r] = fast_exp2(p0[r] - mnew); p1[r] = fast_exp2(p1[r] - mnew); sum += p0[r] + p1[r]; }
    l_run += sum;
    bf16x8 pa[4];
    pa[0] = __builtin_bit_cast(bf16x8, (u32x4){cvt_pk_bf16(p0[0], p0[1]), cvt_pk_bf16(p0[2], p0[3]), cvt_pk_bf16(p0[4], p0[5]), cvt_pk_bf16(p0[6], p0[7])});
    pa[1] = __builtin_bit_cast(bf16x8, (u32x4){cvt_pk_bf16(p0[8], p0[9]), cvt_pk_bf16(p0[10], p0[11]), cvt_pk_bf16(p0[12], p0[13]), cvt_pk_bf16(p0[14], p0[15])});
    pa[2] = __builtin_bit_cast(bf16x8, (u32x4){cvt_pk_bf16(p1[0], p1[1]), cvt_pk_bf16(p1[2], p1[3]), cvt_pk_bf16(p1[4], p1[5]), cvt_pk_bf16(p1[6], p1[7])});
    pa[3] = __builtin_bit_cast(bf16x8, (u32x4){cvt_pk_bf16(p1[8], p1[9]), cvt_pk_bf16(p1[10], p1[11]), cvt_pk_bf16(p1[12], p1[13]), cvt_pk_bf16(p1[14], p1[15])});
#pragma unroll
    for (int db = 0; db < NDB; ++db)
#pragma unroll
        for (int s = 0; s < 4; ++s) {
            const s16x4 lo = vtr(vimg + vboff + db * 4096 + s * 1024), h4 = vtr(vimg + vboff + db * 4096 + s * 1024 + 512);
            const bf16x8 vt = (bf16x8){lo[0], lo[1], lo[2], lo[3], h4[0], h4[1], h4[2], h4[3]};
            o[db] = mfma32(vt, pa[s], o[db]);
            if (NDB == 4 && (s & 1)) __builtin_amdgcn_sched_barrier(0);
        }    __builtin_amdgcn_sched_barrier(0);
}
template <int NDB, class QF, class MaskF>
__device__ __forceinline__ void flash_tile_ref0(float& l_run, f32x16 (&o)[NDB], const LAS unsigned char* kimg, const LAS unsigned char* vimg, const QF& qf, const MaskF& maskf, int r32, int hi, int vboff) {
    f32x16 p0, p1; maskf.init(p0, p1);
    bf16x8 kf[8];
#pragma unroll
    for (int ks = 0; ks < 4; ++ks) { kf[2 * ks] = *(const LAS bf16x8*)(kimg + (NDB == 4 ? (2 * ks + hi) * 1024 + r32 * 16 : kimg_off(r32, 2 * ks + hi))); kf[2 * ks + 1] = *(const LAS bf16x8*)(kimg + (NDB == 4 ? (2 * ks + hi) * 1024 + 512 + r32 * 16 : kimg_off(r32, 2 * ks + hi) + 4096)); }
    __builtin_amdgcn_sched_barrier(0);
#pragma unroll
    for (int ks = 0; ks < 4; ++ks) { const bf16x8 qk = qf(ks); p0 = mfma32(kf[2 * ks], qk, p0); p1 = mfma32(kf[2 * ks + 1], qk, p1); }
    maskf(p0, p1);
    __builtin_amdgcn_sched_barrier(0);
    float sum = 0.f;
#pragma unroll
    for (int r = 0; r < 16; ++r) { p0[r] = fast_exp2(p0[r]); sum += p0[r]; }
    bf16x8 pa[4];
    pa[0] = __builtin_bit_cast(bf16x8, (u32x4){cvt_pk_bf16(p0[0], p0[1]), cvt_pk_bf16(p0[2], p0[3]), cvt_pk_bf16(p0[4], p0[5]), cvt_pk_bf16(p0[6], p0[7])});
    pa[1] = __builtin_bit_cast(bf16x8, (u32x4){cvt_pk_bf16(p0[8], p0[9]), cvt_pk_bf16(p0[10], p0[11]), cvt_pk_bf16(p0[12], p0[13]), cvt_pk_bf16(p0[14], p0[15])});
    __builtin_amdgcn_sched_barrier(0);
#pragma unroll
    for (int db = 0; db < NDB; ++db)
#pragma unroll
        for (int s = 0; s < 2; ++s) {
            const s16x4 lo = vtr(vimg + vboff + db * 4096 + s * 1024), h4 = vtr(vimg + vboff + db * 4096 + s * 1024 + 512);
            o[db] = mfma32((bf16x8){lo[0], lo[1], lo[2], lo[3], h4[0], h4[1], h4[2], h4[3]}, pa[s], o[db]);
        }
#pragma unroll
    for (int r = 0; r < 16; ++r) { p1[r] = fast_exp2(p1[r]); sum += p1[r]; }
    l_run += sum;
    pa[2] = __builtin_bit_cast(bf16x8, (u32x4){cvt_pk_bf16(p1[0], p1[1]), cvt_pk_bf16(p1[2], p1[3]), cvt_pk_bf16(p1[4], p1[5]), cvt_pk_bf16(p1[6], p1[7])});
    pa[3] = __builtin_bit_cast(bf16x8, (u32x4){cvt_pk_bf16(p1[8], p1[9]), cvt_pk_bf16(p1[10], p1[11]), cvt_pk_bf16(p1[12], p1[13]), cvt_pk_bf16(p1[14], p1[15])});
    __builtin_amdgcn_sched_barrier(0);
#pragma unroll
    for (int db = 0; db < NDB; ++db)
#pragma unroll
        for (int s = 2; s < 4; ++s) {
            const s16x4 lo = vtr(vimg + vboff + db * 4096 + s * 1024), h4 = vtr(vimg + vboff + db * 4096 + s * 1024 + 512);
            o[db] = mfma32((bf16x8){lo[0], lo[1], lo[2], lo[3], h4[0], h4[1], h4[2], h4[3]}, pa[s], o[db]);
        }
    __builtin_amdgcn_sched_barrier(0);
}
template <bool FAST, int NDB, class QF, class MaskF>
__device__ __forceinline__ void flash_step(float& m_run, float& l_run, f32x16 (&o)[NDB], const LAS unsigned char* kimg, const LAS unsigned char* vimg, const QF& qf, const MaskF& maskf, int r32, int hi, int vboff) {
    if (FAST) flash_tile_ref0<NDB>(l_run, o, kimg, vimg, qf, maskf, r32, hi, vboff); else flash_tile<NDB>(m_run, l_run, o, kimg, vimg, qf, maskf, r32, hi, vboff);
}
__device__ __forceinline__ bool softmax_ref0_ok(const float* gq, const float* gk, int lane) {
    float a = fabsf(gq[lane]), b = fabsf(gk[lane]);
    a = fmaxf(a, xor_lane<1>(a)); a = fmaxf(a, xor_lane<2>(a)); a = fmaxf(a, xor_lane<4>(a)); a = fmaxf(a, xor_lane<8>(a)); a = fmaxf(a, xor_lane<16>(a)); a = max_xor32(a);
    b = fmaxf(b, xor_lane<1>(b)); b = fmaxf(b, xor_lane<2>(b)); b = fmaxf(b, xor_lane<4>(b)); b = fmaxf(b, xor_lane<8>(b)); b = fmaxf(b, xor_lane<16>(b)); b = max_xor32(b);
    return __builtin_amdgcn_readfirstlane(__builtin_bit_cast(int, a * b * (C2 * 64.0f * 1.02f))) < __builtin_bit_cast(int, 48.0f) && REF0_ENABLE;
}
#define MASK_INIT_ZERO __device__ __forceinline__ void init(f32x16& p0, f32x16& p1) const { p0 = splat16(0.f); p1 = splat16(0.f); }
struct MaskNone { MASK_INIT_ZERO __device__ __forceinline__ void operator()(f32x16&, f32x16&) const {} };
struct MaskCausal { int kb0, qloc, hi;
    MASK_INIT_ZERO
    __device__ __forceinline__ void operator()(f32x16& p0, f32x16& p1) const {
#pragma unroll
        for (int r = 0; r < 16; ++r) { const int kv = kb0 + crow(r, hi); p0[r] = kv > qloc ? NEG_INF : p0[r]; p1[r] = kv + 32 > qloc ? NEG_INF : p1[r]; } } };
struct MaskCausalIf { bool on; int kb0, qloc, hi;
    MASK_INIT_ZERO
    __device__ __forceinline__ void operator()(f32x16& p0, f32x16& p1) const { if (on) {
#pragma unroll
        for (int r = 0; r < 16; ++r) { const int kv = kb0 + crow(r, hi); p0[r] = kv > qloc ? NEG_INF : p0[r]; p1[r] = kv + 32 > qloc ? NEG_INF : p1[r]; } } } };
struct MaskLane { float ci;
    MASK_INIT_ZERO
    __device__ __forceinline__ void operator()(f32x16& p0, f32x16& p1) const {
#pragma unroll
        for (int r = 0; r < 16; ++r) { p0[r] += ci; p1[r] += ci; } } };
template <int POS> __device__ __forceinline__ float neginf_if_bit(unsigned n) { float r; asm("v_bfe_i32 %0, %1, %2, 1\n\tv_and_b32 %0, 0xff800000, %0" : "=v"(r) : "v"(n), "n"(POS)); return r; }
struct MaskBits { unsigned n0, n1;
    __device__ __forceinline__ void init(f32x16& p0, f32x16& p1) const {
#define MB_(r) p0[r] = neginf_if_bit<((r) & 3) + 8 * ((r) >> 2)>(n0); p1[r] = neginf_if_bit<((r) & 3) + 8 * ((r) >> 2)>(n1);
        MB_(0) MB_(1) MB_(2) MB_(3) MB_(4) MB_(5) MB_(6) MB_(7) MB_(8) MB_(9) MB_(10) MB_(11) MB_(12) MB_(13) MB_(14) MB_(15)
#undef MB_
        asm volatile("s_nop 1" ::: "memory"); }
    __device__ __forceinline__ void operator()(f32x16&, f32x16&) const {} };
__device__ __forceinline__ void dma16(const void* g, LAS unsigned char* l) { __builtin_amdgcn_global_load_lds((const unsigned*)g, (LAS unsigned*)l, 16, 0, 0); }
#define DMA_WAIT_SYNC() do { asm volatile("s_waitcnt vmcnt(0)" ::: "memory"); __syncthreads(); } while (0)

__device__ __forceinline__ void glds16(const void* gsrc, unsigned lds_dst) { unsigned keep;
    asm volatile("s_mov_b32 %0, m0\n\ts_mov_b32 m0, %2\n\ts_nop 0\n\tglobal_load_lds_dwordx4 %1, off\n\ts_mov_b32 m0, %0" : "=&s"(keep) : "v"(gsrc), "s"(lds_dst) : "memory"); }
__device__ __forceinline__ void glds4(const void* gsrc, unsigned lds_dst) { unsigned keep;
    asm volatile("s_mov_b32 %0, m0\n\ts_mov_b32 m0, %2\n\ts_nop 0\n\tglobal_load_lds_dword %1, off\n\ts_mov_b32 m0, %0" : "=&s"(keep) : "v"(gsrc), "s"(lds_dst) : "memory"); }
#define WAITV_BAR(N) asm volatile("s_waitcnt vmcnt(" #N ") lgkmcnt(0)\n\ts_barrier" ::: "memory")

template <int MODE, bool FAST>
__device__ __forceinline__ void attn_ab_unit(int b, int h, int qt, const bf16_t* qkv, bf16_t* obuf, const float* kmean, const unsigned* maskg, LAS unsigned char* lds, int tid, int lane, int w) {
    constexpr int CQ = MODE == 0 ? C_QA : C_QB, CK = MODE == 0 ? C_KA : C_KB, CV = MODE == 0 ? C_VA : C_VB;
    constexpr int NS = 4, D = 3, SLOT = 16384;
    const int r32 = lane & 31, hi = lane >> 5;
    const size_t rowbase = (size_t)b * SEQ; const int q0 = 256 * qt, qloc = 32 * w + r32; const size_t qrow = rowbase + q0 + qloc;
    const unsigned lds0 = (unsigned)(size_t)lds;
    LAS float* kml = (LAS float*)(lds + 73728); LAS unsigned* mwl = (LAS unsigned*)(lds + 65536);
    bf16x8 qf[4];
#pragma unroll
    for (int ks = 0; ks < 4; ++ks) qf[ks] = *(const bf16x8*)(qkv + qrow * QP + CQ + 64 * h + 16 * ks + 8 * hi);
    const bf16_t* ksrc = qkv + (rowbase + kdma_row(w, lane)) * QP + CK + 64 * h + 8 * kdma_chunk(w, lane);
    const bf16_t* vsrc = qkv + (rowbase + 16 * (w & 3) + (lane >> 2)) * QP + CV + 64 * h + 32 * (w >> 2) + 8 * (lane & 3);
    const unsigned* msrc = maskg + qrow * 128 + hi;
    const int NT = 4 * qt + 4, wlim = 4 * qt + (w >> 1);
    const unsigned kdst0 = (unsigned)__builtin_amdgcn_readfirstlane(lds0 + w * 1024), mdst0 = (unsigned)__builtin_amdgcn_readfirstlane(lds0 + 65536 + w * 256);
    __syncthreads();
#pragma unroll
    for (int d = 0; d < D; ++d) { const int t = d < NT ? d : NT - 1;
        glds16(ksrc + (size_t)t * 64 * QP, kdst0 + d * SLOT); glds16(vsrc + (size_t)t * 64 * QP, kdst0 + d * SLOT + 8192);
        if (MODE == 1) glds4(msrc + 2 * t, mdst0 + d * 2048); }
    unsigned selbits = 0;
    if (MODE == 0) {
        if (tid < 256) ((LAS f32x4*)kml)[tid] = ((const f32x4*)(kmean + (size_t)((b * 4 + h) * 16) * 64))[tid];
        __syncthreads();
        if (qt > 0) {
            float qv[32];
#pragma unroll
            for (int ks = 0; ks < 4; ++ks) { const u32x4 qq = __builtin_bit_cast(u32x4, qf[ks]);
#pragma unroll
                for (int k = 0; k < 4; ++k) { qv[8 * ks + 2 * k] = bf_lo(qq[k]); qv[8 * ks + 2 * k + 1] = bf_hi(qq[k]); } }
            float v1 = NEG_INF, v2 = NEG_INF, v3 = NEG_INF; int i1 = -1, i2 = -1, i3 = -1;
#pragma unroll 1
            for (int j = 0; j < qt; ++j) {
                float g = 0.f;
#pragma unroll
                for (int ks = 0; ks < 4; ++ks) { const f32x4 k0 = *(const LAS f32x4*)(kml + j * 64 + 16 * ks + 8 * hi), k1 = *(const LAS f32x4*)(kml + j * 64 + 16 * ks + 8 * hi + 4);
                    g += qv[8 * ks + 0] * k0[0] + qv[8 * ks + 1] * k0[1] + qv[8 * ks + 2] * k0[2] + qv[8 * ks + 3] * k0[3] + qv[8 * ks + 4] * k1[0] + qv[8 * ks + 5] * k1[1] + qv[8 * ks + 6] * k1[2] + qv[8 * ks + 7] * k1[3]; }
                g = sum_xor32(g);
                if (g > v1) { v3 = v2; i3 = i2; v2 = v1; i2 = i1; v1 = g; i1 = j; }
                else if (g > v2) { v3 = v2; i3 = i2; v2 = g; i2 = j; }
                else if (g > v3) { v3 = g; i3 = j; }
            }
            if (i1 >= 0) selbits |= 1u << i1; if (i2 >= 0) selbits |= 1u << i2; if (i3 >= 0) selbits |= 1u << i3;
        }
    }
    const int vboff = (4 * hi + ((lane & 15) >> 2)) * 64 + ((lane >> 4) & 1) * 32 + (lane & 3) * 8;
    float m_run = -1e30f, l_run = 0.f; f32x16 o[2]; o[0] = splat16(0.f); o[1] = splat16(0.f);
    int scur = 0, siss = D;
    asm volatile("s_waitcnt vmcnt(0)" ::: "memory");
    asm volatile("" : "+v"(qf[0]), "+v"(qf[1]), "+v"(qf[2]), "+v"(qf[3]));
#pragma unroll 1
    for (int kt = 0; kt < NT; ++kt) {
        if (MODE == 1) WAITV_BAR(6); else WAITV_BAR(4);
        { const int t = kt + D < NT ? kt + D : NT - 1;
          glds16(ksrc + (size_t)t * 64 * QP, kdst0 + siss * SLOT); glds16(vsrc + (size_t)t * 64 * QP, kdst0 + siss * SLOT + 8192);
          if (MODE == 1) glds4(msrc + 2 * t, mdst0 + siss * 2048); }
        const LAS unsigned char* cur = lds + scur * SLOT;
        if (MODE == 0) {
            const int j = kt >> 2;
            if (j < qt) { const bool sel = (selbits >> j) & 1u; if (__ballot(sel) != 0ull) flash_step<FAST, 2>(m_run, l_run, o, cur, cur + 8192, QReg{qf}, MaskLane{sel ? 0.f : NEG_INF}, r32, hi, vboff); }
            else { const int kb0 = 64 * (kt & 3); if (kb0 <= 32 * w + 31) flash_step<FAST, 2>(m_run, l_run, o, cur, cur + 8192, QReg{qf}, MaskCausal{kb0, qloc, hi}, r32, hi, vboff); }
        } else {
            if (kt <= wlim) { const LAS unsigned* mp = mwl + scur * 512 + w * 64; const unsigned cw0 = mp[r32], cw1 = mp[32 + r32];
                flash_step<FAST, 2>(m_run, l_run, o, cur, cur + 8192, QReg{qf}, MaskBits{~cw0 >> (4 * hi), ~cw1 >> (4 * hi)}, r32, hi, vboff); }
        }
        scur = scur + 1 == NS ? 0 : scur + 1; siss = siss + 1 == NS ? 0 : siss + 1;
    }
    asm volatile("s_waitcnt vmcnt(0)" ::: "memory");
    const float inv = 1.0f / sum_xor32(l_run);
    bf16_t* orow = obuf + qrow * 256 + 64 * h;
#pragma unroll
    for (int db = 0; db < 2; ++db)
#pragma unroll
        for (int g = 0; g < 4; ++g)
            *(u32x2*)(orow + 32 * db + 8 * g + 4 * hi) = (u32x2){cvt_pk_bf16(o[db][4 * g] * inv, o[db][4 * g + 1] * inv), cvt_pk_bf16(o[db][4 * g + 2] * inv, o[db][4 * g + 3] * inv)};
}

template <bool FAST>
__device__ __forceinline__ void attn_c_unit(int b, int h, int qt, const bf16_t* qkv, bf16_t* oc, float lam, const float* subg, float coef, LAS unsigned char* lds, int tid, int lane, int w) {
    const int r32 = lane & 31, hi = lane >> 5;
    const size_t rowbase = (size_t)b * SEQ; const int q0 = 256 * qt, qloc = 32 * w + r32; const size_t qrow = rowbase + q0 + qloc;
    LAS unsigned char* qimg = lds + 65536 + w * 8192 + lane * 16;
    __syncthreads();
#pragma unroll
    for (int ks = 0; ks < 4; ++ks) { *(LAS bf16x8*)(qimg + ks * 1024) = *(const bf16x8*)(qkv + qrow * QP + C_Q1 + 64 * h + 16 * ks + 8 * hi); *(LAS bf16x8*)(qimg + 4096 + ks * 1024) = *(const bf16x8*)(qkv + qrow * QP + C_Q2 + 64 * h + 16 * ks + 8 * hi); }
    const bf16_t* k1src = qkv + (rowbase + lane) * QP + C_K1 + 64 * h + 8 * w;
    const bf16_t* k2src = k1src + (C_K2 - C_K1);
    const bf16_t* v0src = qkv + (rowbase + 16 * (w & 3) + (lane >> 2)) * QP + C_VC + 128 * h + 32 * (w >> 2) + 8 * (lane & 3);
    const bf16_t* v1src = v0src + 64;
    const int vboff = (4 * hi + ((lane & 15) >> 2)) * 64 + ((lane >> 4) & 1) * 32 + (lane & 3) * 8;
    const int NT = 4 * qt + 4;
    float m1 = -1e30f, l1 = 0.f, m2 = -1e30f, l2 = 0.f; f32x16 o1[4], o2[4];
#pragma unroll
    for (int i = 0; i < 4; ++i) { o1[i] = splat16(0.f); o2[i] = splat16(0.f); }
    dma16(k1src, lds + w * 1024); dma16(k2src, lds + 8192 + w * 1024); dma16(v0src, lds + 16384 + w * 1024); dma16(v1src, lds + 16384 + 8192 + w * 1024);
    DMA_WAIT_SYNC();
#pragma unroll 1
    for (int kt = 0; kt < NT; ++kt) {
        LAS unsigned char* cur = lds + (kt & 1) * 32768; LAS unsigned char* nxt = lds + ((kt + 1) & 1) * 32768;
        if (kt + 1 < NT) { const size_t adv = (size_t)(kt + 1) * 64 * QP;
            dma16(k1src + adv, nxt + w * 1024); dma16(k2src + adv, nxt + 8192 + w * 1024); dma16(v0src + adv, nxt + 16384 + w * 1024); dma16(v1src + adv, nxt + 16384 + 8192 + w * 1024); }
        const bool band = kt >= 4 * qt; const int kb0 = 64 * (kt & 3);
        if (!band || kb0 <= 32 * w + 31) { const MaskCausalIf mk{band, kb0, qloc, hi};
            flash_step<FAST, 4>(m1, l1, o1, cur, cur + 16384, QLds{qimg}, mk, r32, hi, vboff); flash_step<FAST, 4>(m2, l2, o2, cur + 8192, cur + 16384, QLds{qimg + 4096}, mk, r32, hi, vboff); }
        DMA_WAIT_SYNC();
    }
    const float i1 = 1.0f / sum_xor32(l1), i2 = lam / sum_xor32(l2);
    float ss = 0.f;
#pragma unroll
    for (int db = 0; db < 4; ++db) { o1[db] = o1[db] * i1 - o2[db] * i2;
#pragma unroll
        for (int r = 0; r < 16; ++r) ss += o1[db][r] * o1[db][r]; }
    ss = sum_xor32(ss);
    const float rn = coef / sqrtf(ss * (1.0f / 128.0f) + EPS);
    bf16_t* orow = oc + qrow * 512 + 128 * h;
#pragma unroll
    for (int db = 0; db < 4; ++db)
#pragma unroll
        for (int g = 0; g < 4; ++g) { const int d = 32 * db + 8 * g + 4 * hi; const f32x4 gg = *(const f32x4*)(subg + d);
            *(u32x2*)(orow + d) = (u32x2){cvt_pk_bf16(o1[db][4 * g] * rn * gg[0], o1[db][4 * g + 1] * rn * gg[1]), cvt_pk_bf16(o1[db][4 * g + 2] * rn * gg[2], o1[db][4 * g + 3] * rn * gg[3])}; }
}

__device__ __forceinline__ void index_unit(int b, int i64, const bf16_t* qkv, unsigned* maskg, unsigned char* scr, LAS unsigned char* lds, int tid, int lane, int w) {
    constexpr int NS = 5, D = 4, HS = 257, RING = 84224, TOFF = 65792, TROW = 144;
    const int r32 = lane & 31, hi = lane >> 5;
    const unsigned lds0 = (unsigned)(size_t)lds;
    LAS unsigned* hist = (LAS unsigned*)lds; LAS unsigned char* ring = lds + RING; LAS unsigned char* mb8 = lds;
    LAS int* thrB1 = (LAS int*)(lds + 125184); LAS int* thrRem = thrB1 + 64; LAS int* thrT = thrB1 + 128; LAS int* thrNeed = thrB1 + 192;
    const size_t rowbase = (size_t)b * SEQ; const int q0 = 64 * i64, NT = i64 + 1;
    __syncthreads();
    {
        const int hh = 4 * ((r32 >> 3) & 1) + (r32 & 3), qp = 2 * (r32 >> 4) + ((r32 >> 2) & 1);
        bf16x8 aq[2][4]; float wv[2][2][8];
#pragma unroll
        for (int rb = 0; rb < 2; ++rb) {
            const size_t row = rowbase + q0 + 8 * w + 4 * rb + qp;
#pragma unroll
            for (int ks = 0; ks < 4; ++ks) aq[rb][ks] = *(const bf16x8*)(qkv + row * QP + C_QI + 64 * hh + 16 * ks + 8 * hi);
#pragma unroll
            for (int hf = 0; hf < 2; ++hf) { const u32x4 ww = *(const u32x4*)(qkv + (rowbase + q0 + 8 * w + 4 * rb + 2 * hf + hi) * QP + C_WI);
#pragma unroll
                for (int k = 0; k < 4; ++k) { wv[rb][hf][2 * k] = bf_lo(ww[k]); wv[rb][hf][2 * k + 1] = bf_hi(ww[k]); } }
        }
#pragma unroll
        for (int rb = 0; rb < 2; ++rb) { asm volatile("" : "+v"(aq[rb][0]), "+v"(aq[rb][1]), "+v"(aq[rb][2]), "+v"(aq[rb][3]));
#pragma unroll
            for (int hf = 0; hf < 2; ++hf) asm volatile("" : "+v"(wv[rb][hf][0]), "+v"(wv[rb][hf][1]), "+v"(wv[rb][hf][2]), "+v"(wv[rb][hf][3]), "+v"(wv[rb][hf][4]), "+v"(wv[rb][hf][5]), "+v"(wv[rb][hf][6]), "+v"(wv[rb][hf][7])); }
        const bf16_t* ksrc = qkv + (rowbase + kdma_row(w, lane)) * QP + C_KI + 8 * kdma_chunk(w, lane);
        const unsigned kdst0 = (unsigned)__builtin_amdgcn_readfirstlane(lds0 + RING + w * 1024);
#pragma unroll
        for (int d = 0; d < D; ++d) { const int t = d < NT ? d : NT - 1; glds16(ksrc + (size_t)t * 64 * QP, kdst0 + d * 8192); }
        for (int i = tid; i < 4112; i += 512) ((LAS u32x4*)hist)[i] = (u32x4){0u, 0u, 0u, 0u};
        asm volatile("s_waitcnt lgkmcnt(0)" ::: "memory");
        unsigned char* srow = scr + (size_t)lane * 8192 + w * 16;
        int scur = 0, siss = D;
#pragma unroll 1
        for (int kt = 0; kt <= NT; ++kt) {
            if (kt < NT) WAITV_BAR(3); else { asm volatile("s_waitcnt vmcnt(0)" ::: "memory"); __syncthreads(); }
            if (kt > 0) {
                const u32x4 kk = *(const LAS u32x4*)(lds + TOFF + ((kt - 1) & 1) * 9216 + lane * TROW + w * 16);
                if (kt < NT) asm volatile("global_store_dwordx4 %0, %1, off" :: "v"(srow + (size_t)(kt - 1) * 128), "v"(kk) : "memory");
                else *(u32x4*)(srow + (size_t)(kt - 1) * 128) = kk;
#pragma unroll
                for (int k = 0; k < 4; ++k) { const unsigned a = kk[k] & 0xffffu, c = kk[k] >> 16;
                    if (a) __hip_atomic_fetch_add(&hist[lane * HS + (a >> 8)], 1u, __ATOMIC_RELAXED, __HIP_MEMORY_SCOPE_WORKGROUP);
                    if (c) __hip_atomic_fetch_add(&hist[lane * HS + (c >> 8)], 1u, __ATOMIC_RELAXED, __HIP_MEMORY_SCOPE_WORKGROUP); }
            }
            if (kt == NT) break;
            { const int t = kt + D < NT ? kt + D : NT - 1; glds16(ksrc + (size_t)t * 64 * QP, kdst0 + siss * 8192); }
            const LAS unsigned char* kimg = ring + scur * 8192;
            const bool diag = kt == NT - 1;
#pragma unroll
            for (int rb = 0; rb < 2; ++rb)
#pragma unroll
                for (int kb = 0; kb < 2; ++kb) {
                    f32x16 d = splat16(0.f);
#pragma unroll
                    for (int ks = 0; ks < 4; ++ks) d = mfma32(aq[rb][ks], *(const LAS bf16x8*)(kimg + kimg_off(32 * kb + r32, 2 * ks + hi)), d);
#pragma unroll
                    for (int hf = 0; hf < 2; ++hf) {
                        float sc = 0.f;
#pragma unroll
                        for (int t = 0; t < 8; ++t) sc += wv[rb][hf][t] * fmaxf(d[8 * hf + t], 0.f);
                        const int ql = 8 * w + 4 * rb + 2 * hf + hi;
                        const unsigned u = (unsigned)__builtin_bit_cast(unsigned short, (_Float16)sc);
                        unsigned key = u ^ ((u & 0x8000u) ? 0xffffu : 0x8000u);
                        if (diag && 32 * kb + r32 > ql) key = 0u;
                        *(LAS unsigned short*)(lds + TOFF + (kt & 1) * 9216 + ql * TROW + (32 * kb + r32) * 2) = (unsigned short)key;
                    }
                }
            scur = scur + 1 == NS ? 0 : scur + 1; siss = siss + 1 == NS ? 0 : siss + 1;
        }
        asm volatile("s_waitcnt vmcnt(0)" ::: "memory");
        __syncthreads();
    }
#define IDX_SEARCH(STAGE) do { _Pragma("unroll 1") for (int qq = 0; qq < 8; ++qq) { const int q = 8 * w + qq; int target; \
        if (STAGE == 0) { if (q0 + q + 1 <= 256) { if (lane == 0) { thrB1[q] = 0x10000; thrRem[q] = 0; } continue; } target = 256; } \
        else { if (thrB1[q] == 0x10000) { if (lane == 0) { thrT[q] = 0; thrNeed[q] = 0; } continue; } target = thrRem[q]; } \
        const LAS unsigned* hp = hist + q * HS + 4 * lane; const int h0 = (int)hp[0], h1 = (int)hp[1], h2 = (int)hp[2], h3 = (int)hp[3]; \
        int P = h0 + h1 + h2 + h3; const int s_ = P; \
        _Pragma("unroll") for (int o = 1; o < 64; o <<= 1) { const int t_ = lane_val(P, (lane - o) & 63); if (lane >= o) P += t_; } \
        const int above = __builtin_amdgcn_readlane(P, 63) - P; (void)s_; \
        const int c3 = above + h3, c2 = c3 + h2, c1 = c2 + h1, c0 = c1 + h0; int bin = -1, ab = 0; \
        if (above < target && c3 >= target) { bin = 4 * lane + 3; ab = above; } else if (c3 < target && c2 >= target) { bin = 4 * lane + 2; ab = c3; } \
        else if (c2 < target && c1 >= target) { bin = 4 * lane + 1; ab = c2; } else if (c1 < target && c0 >= target) { bin = 4 * lane; ab = c1; } \
        if (bin >= 0) { if (STAGE == 0) { thrB1[q] = bin; thrRem[q] = target - ab; } else { thrT[q] = (thrB1[q] << 8) | bin; thrNeed[q] = target - ab; } } } \
        __syncthreads(); } while (0)
    IDX_SEARCH(0);
    const int qs = 8 * w + (lane >> 3), pc = lane & 7;
    const unsigned char* rrow = scr + (size_t)qs * 8192 + pc * 16;
    {
        __builtin_amdgcn_fence(__ATOMIC_ACQUIRE, "agent");
        asm volatile("s_waitcnt vmcnt(0)" ::: "memory");
        const int b1 = thrB1[qs];
        for (int i = tid; i < 4112; i += 512) ((LAS u32x4*)hist)[i] = (u32x4){0u, 0u, 0u, 0u};
        __syncthreads();
#pragma unroll 4
        for (int it = 0; it < NT; ++it) { const u32x4 kk = *(const u32x4*)(rrow + (size_t)it * 128);
#pragma unroll
            for (int k = 0; k < 4; ++k) { const unsigned a = kk[k] & 0xffffu, c = kk[k] >> 16;
                if ((int)(a >> 8) == b1) __hip_atomic_fetch_add(&hist[qs * HS + (a & 255u)], 1u, __ATOMIC_RELAXED, __HIP_MEMORY_SCOPE_WORKGROUP);
                if ((int)(c >> 8) == b1) __hip_atomic_fetch_add(&hist[qs * HS + (c & 255u)], 1u, __ATOMIC_RELAXED, __HIP_MEMORY_SCOPE_WORKGROUP); } }
        __syncthreads();
    }
    IDX_SEARCH(1);
    {
        const unsigned T = (unsigned)thrT[qs]; const int need = thrNeed[qs]; int tc = 0;
        __syncthreads();
#pragma unroll 2
        for (int it = 0; it < NT; ++it) { const u32x4 kk = *(const u32x4*)(rrow + (size_t)it * 128);
            unsigned sel = 0, eq = 0;
#pragma unroll
            for (int k = 0; k < 4; ++k) { const unsigned a = kk[k] & 0xffffu, c = kk[k] >> 16;
                sel |= (a > T ? 1u : 0u) << (2 * k); sel |= (c > T ? 1u : 0u) << (2 * k + 1); eq |= (a == T ? 1u : 0u) << (2 * k); eq |= (c == T ? 1u : 0u) << (2 * k + 1); }
            if (T == 0u) eq = 0u;
            if (__ballot(eq != 0u) != 0ull) {
                const int n = __popc(eq); int P = n;
#pragma unroll
                for (int o = 1; o < 8; o <<= 1) { const int t_ = lane_val(P, (lane - o) & 63); if ((lane & 7) >= o) P += t_; }
                int allow = need - tc - (P - n);
#pragma unroll
                for (int k = 0; k < 8; ++k) if (((eq >> k) & 1u) && allow > 0) { sel |= 1u << k; --allow; }
                tc += lane_val(P, (lane & ~7) + 7);
            }
            mb8[qs * 512 + it * 8 + pc] = (unsigned char)sel;
        }
        __syncthreads();
    }
#undef IDX_SEARCH
    for (int idx = tid; idx < 64 * 2 * NT; idx += 512) { const int q = idx / (2 * NT), wd = idx - q * 2 * NT; maskg[(rowbase + q0 + q) * 128 + wd] = ((const LAS unsigned*)mb8)[q * 128 + wd]; }
}

__device__ __forceinline__ int next_unit(unsigned* ctr, LAS unsigned char* lds, int tid) {
    volatile LAS int* bc = (volatile LAS int*)(lds + LX_BC);
    __syncthreads();
    if (tid == 0) *bc = (int)__hip_atomic_fetch_add(ctr, 1u, __ATOMIC_RELAXED, __HIP_MEMORY_SCOPE_AGENT);
    __syncthreads();
    return __builtin_amdgcn_readfirstlane(*bc);
}

__device__ __forceinline__ void m1_phase(const Args& a, unsigned char* ws, int lc, LAS unsigned char* lds, int lane, int wave, int vcu, int G) {
    const int l = lc & 1;
    const float* wrt = (const float*)(ws + WS_WRT);
    const float* bg = a.in[I_B_GROUP] + l * 4; const float* br = a.in[I_B_ROUTER] + l * 32;
    unsigned* cnt = (unsigned*)(ws + WS_CTL) + CW_CNT + 2048 * lc;
    unsigned* rt0 = (unsigned*)(ws + WS_RT0); unsigned* rt1 = (unsigned*)(ws + WS_RT1); f32x2* rtw = (f32x2*)(ws + WS_RTW);
    int* tokl = (int*)(ws + WS_TOKL); bf16_t* xg = (bf16_t*)(ws + WS_XG); float* rstdg = (float*)(ws + WS_RSTD); const float* gain = a.in[I_NORM_FFN] + (size_t)l * DM;
    const int r32 = lane & 31, kh = lane >> 5, wq = wave & 3, kpart = wave >> 2;
    LAS float* tl = (LAS float*)(lds + wq * 8192);
    LAS float* tss = tl + 32 * 40;
#pragma unroll 1
    for (int t = wq * G + vcu; t < MTOK / 32; t += 4 * G) {
        const float* xrow = a.out + (size_t)(32 * t + r32) * DM + 512 * kpart + 4 * kh;
        const float* wp0 = wrt + (size_t)r32 * DM + 512 * kpart + 4 * kh; const float* wp1 = wrt + (size_t)(32 + (r32 & 3)) * DM + 512 * kpart + 4 * kh;
        bf16_t* xo = xg + (size_t)(32 * t + r32) * DM + 512 * kpart + 4 * kh; const float* gp = gain + 512 * kpart + 4 * kh;
        f32x16 d0 = splat16(0.f), d1 = splat16(0.f); float ss = 0.f;
#pragma unroll 8
        for (int m = 0; m < 64; ++m) {
            const f32x4 xa = *(const f32x4*)(xrow + 8 * m), b0 = *(const f32x4*)(wp0 + 8 * m), b1 = *(const f32x4*)(wp1 + 8 * m);
            ss += (xa[0] * xa[0] + xa[1] * xa[1]) + (xa[2] * xa[2] + xa[3] * xa[3]);
            { const f32x4 o = xa * *(const f32x4*)(gp + 8 * m); *(u32x2*)(xo + 8 * m) = (u32x2){cvt_pk_bf16(o[0], o[1]), cvt_pk_bf16(o[2], o[3])}; }
#pragma unroll
            for (int i = 0; i < 4; ++i) { d0 = __builtin_amdgcn_mfma_f32_32x32x2f32(xa[i], b0[i], d0, 0, 0, 0); d1 = __builtin_amdgcn_mfma_f32_32x32x2f32(xa[i], b1[i], d1, 0, 0, 0); }
        }
        ss = sum_xor32(ss);
        if (kpart == 1) {
#pragma unroll
            for (int r = 0; r < 16; ++r) { tl[crow(r, kh) * 40 + r32] = d0[r]; if (r32 < 4) tl[crow(r, kh) * 40 + 32 + r32] = d1[r]; }
            if (kh == 0) tss[r32] = ss;
        }
        __syncthreads();
        if (kpart == 0) {
#pragma unroll
            for (int r = 0; r < 16; ++r) { tl[crow(r, kh) * 40 + r32] += d0[r]; if (r32 < 4) tl[crow(r, kh) * 40 + 32 + r32] += d1[r]; }
            ss += tss[r32];
            LDS_WAIT(); asm volatile("" ::: "memory");
            const float rstd = 1.0f / sqrtf(ss * (1.0f / DM) + EPS);
            const LAS float* my = tl + r32 * 40;
            float gl[4];
#pragma unroll
            for (int c = 0; c < 4; ++c) gl[c] = my[c] * rstd + bg[c];
            int g = 0; float gm = gl[0];
#pragma unroll
            for (int c = 1; c < 4; ++c) if (gl[c] > gm) { gm = gl[c]; g = c; }
            float den = 0.f;
#pragma unroll
            for (int c = 0; c < 4; ++c) den += __expf(gl[c] - gm);
            const float gwt = 1.0f / den;
            float le[8];
#pragma unroll
            for (int e = 0; e < 8; ++e) le[e] = my[4 + 8 * g + e] * rstd + br[8 * g + e];
            int i1 = 0; float v1 = le[0];
#pragma unroll
            for (int e = 1; e < 8; ++e) if (le[e] > v1) { v1 = le[e]; i1 = e; }
            int i2 = -1; float v2 = NEG_INF;
#pragma unroll
            for (int e = 0; e < 8; ++e) if (e != i1 && le[e] > v2) { v2 = le[e]; i2 = e; }
            const float ex = __expf(v2 - v1), w1 = 1.0f / (1.0f + ex), w2 = ex * w1;
            if (kh == 0) { const int e0 = g * 8 + i1, e1 = g * 8 + i2, m = 32 * t + r32;
                const unsigned r0 = atomicAdd(cnt + 64 * e0, 1u), r1 = atomicAdd(cnt + 64 * e1, 1u);
                rt0[m] = ((unsigned)e0 << 24) | r0; rt1[m] = ((unsigned)e1 << 24) | r1; rtw[m] = (f32x2){gwt * w1, gwt * w2};
                tokl[e0 * 32768 + (int)r0] = m; tokl[e1 * 32768 + (int)r1] = m; }
            if (kh == 0) rstdg[32 * t + r32] = rstd;
        }
        __syncthreads();
    }
}
__device__ __forceinline__ void moe_tables(const unsigned* cnt, const int* tokl, const float* rstdg, LAS unsigned char* lds, int tid, int c, int G) {
    LAS int* pstart = (LAS int*)(lds + LX_PSTART); LAS int* blk2e = (LAS int*)(lds + LX_BLK2E); LAS int* cntl = (LAS int*)(lds + LX_CNT); LAS int* tok = (LAS int*)(lds + LX_TOK);
    if (tid < 64) {
        const int cn = tid < NEXP ? (int)cnt[64 * tid] : 0, nb = (cn + 255) >> 8;
        int P = nb;
#pragma unroll
        for (int o = 1; o < 64; o <<= 1) { const int t = lane_val(P, (tid - o) & 63); if (tid >= o) P += t; }
        const int pb = P - nb;
        if (tid <= NEXP) pstart[tid] = pb * 256;
        if (tid < NEXP) cntl[tid] = cn;
        if (tid == NEXP) *(LAS int*)(lds + LX_NBLK) = pb < MAXBLK ? pb : MAXBLK;
#pragma unroll 1
        for (int k = 0; k < nb; ++k) if (pb + k < MAXBLK) blk2e[pb + k] = tid;
    }
    __syncthreads();
    const int nblk = *(const LAS int*)(lds + LX_NBLK), rbs = G / 4;
    LAS float* rst = (LAS float*)(lds + LX_RST);
    for (int k = 0; k < 6; ++k) { const int rb = c / 4 + k * rbs; if (rb >= nblk) break;
        const int e = blk2e[rb], r = rb * 256 - pstart[e] + (tid & 255);
        if (tid < 256) { const int tk = r < cntl[e] ? tokl[e * 32768 + r] : 0; tok[k * 256 + tid] = tk; rst[k * 256 + tid] = rstdg[tk]; } }
    __syncthreads();
}

#ifndef PHASES
#define PHASES 0xFFFF
#endif
#define PH(n) if constexpr (((PHASES) >> (n)) & 1)
#ifndef REPEAT_MASK
#define REPEAT_MASK 0
#endif
#define REP(k) for (int rep_ = 0; rep_ < 1 + (((REPEAT_MASK) >> (k)) & 1); ++rep_)
#ifndef GEMM_ALIGN
#define GEMM_ALIGN true
#endif
#ifndef GEMM_SP2
#define GEMM_SP2 true
#endif
#define PHASE_ENV() unsigned long long wsi_ = (unsigned long long)args.ws; int G = (int)gridDim.x, bx = (int)blockIdx.x; asm volatile("" : "+s"(wsi_), "+s"(G), "+s"(bx)); \
    unsigned char* const ws = (unsigned char*)(GAS unsigned char*)wsi_; const int vcu = (G % 8 == 0) ? (bx % 8) * (G / 8) + bx / 8 : bx;   \
    int tid = (int)threadIdx.x; asm volatile("" : "+v"(tid)); const int lane = tid & 63, wave = __builtin_amdgcn_readfirstlane(tid >> 6); \
    unsigned* const ctl = (unsigned*)(ws + WS_CTL); bf16_t* const QKV = (bf16_t*)(ws + WS_QKV); unsigned char* const SG = ws + WS_SG; unsigned* const MASK = (unsigned*)(ws + WS_MASK); float* const KMEAN = (float*)(ws + WS_KMEAN); \
    (void)lane; (void)wave; (void)ctl; (void)QKV; (void)SG; (void)MASK; (void)KMEAN; (void)vcu
#define GRID_BAR() do { unsigned long long wb_ = (unsigned long long)args.ws; asm volatile("" : "+s"(wb_)); XcdBarrier b_ = bar0; b_.bar = (unsigned*)((GAS unsigned char*)wb_ + WS_CTL) + CW_BAR; asm volatile("" : "+s"(b_.x)); xcd_barrier(b_); if (((REPEAT_MASK) >> 12) & 1) xcd_barrier(b_); } while (0)


template <int L> __device__ __forceinline__ void layer_body(const Args& args, LAS unsigned char* lds, const XcdBarrier& bar0) {
    constexpr int l = L;

        PH(0) for (int rep_ = 0; rep_ < 1 + ((((REPEAT_MASK) >> 0) & 1) && l == 0); ++rep_) { PHASE_ENV(); p0_phase(args, ws, l, lds, tid, lane, wave, vcu, G); }
        GRID_BAR();
        PH(1) REP(1) { PHASE_ENV();
            pg8::Gemm g{(const bf16_t*)(ws + WS_HN), (const bf16_t*)(ws + WS_WIN), MTOK, NT_IN * 256, DM}; pg8::StaticOrder S; S.init(MTOK, NT_IN * 256, G, bx);
            pg8::EpiInProj E{QKV, SG, (const float*)(ws + WS_COS), (const float*)(ws + WS_SIN), args.in[I_QK_GAIN] + l * 6 * 64, args.in[I_IDX_K_GAIN] + l * 64};
            pg8::gemm_phase<pg8::EpiInProj, pg8::StaticOrder, GEMM_ALIGN, GEMM_SP2>(lds, g, S, E);
        }
        GRID_BAR();
        { PHASE_ENV();
            LAS float* red = (LAS float*)lds;
            for (int it = bx; it < NBATCH * 4 * 16; it += G) { const int b = it >> 6, h = (it >> 4) & 3, blk = it & 15, d = tid & 63, rg = tid >> 6;
                const bf16_t* kp = QKV + ((size_t)b * SEQ + blk * 256 + rg * 32) * QP + C_KA + 64 * h + d; float s = 0.f;
#pragma unroll 8
                for (int r = 0; r < 32; ++r) s += __builtin_bit_cast(float, (unsigned)kp[(size_t)r * QP] << 16);
                __syncthreads(); red[tid] = s; __syncthreads();
                if (tid < 64) { float t = 0.f;
#pragma unroll
                    for (int k = 0; k < 8; ++k) t += red[k * 64 + tid];
                    KMEAN[(size_t)it * 64 + tid] = t * (1.0f / 256.0f); } }
            __syncthreads();
        }
        PH(2) REP(2) { PHASE_ENV();
            const float* dl = args.in[I_DIFF_LAMBDA] + l * 256;
            const float lam_init = 0.8f - 0.6f * __expf(-0.3f * (float)l);
            const float lam = __expf(wave_sum(dl[lane] * dl[64 + lane])) - __expf(wave_sum(dl[128 + lane] * dl[192 + lane])) + lam_init;
            const float* subg = args.in[I_DIFF_SUBLN] + l * 128;
            unsigned* qc = ctl + CW_QUEUE + 64 * (l * 4 + 0 + 8 * rep_);
            const float* qkg = args.in[I_QK_GAIN] + l * 6 * 64;
            if (softmax_ref0_ok(qkg + 4 * 64, qkg + 5 * 64, lane)) { for (;;) { const int u = next_unit(qc, lds, tid); if (u >= 512) break; const int r = u & 31; attn_c_unit<true>(r >> 2, r & 3, 15 - (u >> 5), QKV, (bf16_t*)(ws + WS_OC), lam, subg, 1.0f - lam_init, lds, tid, lane, wave); } }
            else { for (;;) { const int u = next_unit(qc, lds, tid); if (u >= 512) break; const int r = u & 31; attn_c_unit<false>(r >> 2, r & 3, 15 - (u >> 5), QKV, (bf16_t*)(ws + WS_OC), lam, subg, 1.0f - lam_init, lds, tid, lane, wave); } }
        }
        PH(3) REP(3) { PHASE_ENV();
            unsigned* qi = ctl + CW_QUEUE + 64 * (l * 4 + 1 + 8 * rep_);
            for (;;) { const int u = next_unit(qi, lds, tid); if (u >= 512) break; index_unit(u & 7, 63 - (u >> 3), QKV, MASK, ws + WS_WGU + (size_t)bx * 524288, lds, tid, lane, wave); }
        }
        GRID_BAR();
        PH(4) REP(4) { PHASE_ENV();
            unsigned* qa = ctl + CW_QUEUE + 64 * (l * 4 + 2 + 8 * rep_);
            const float* qkg = args.in[I_QK_GAIN] + l * 6 * 64;
            if (softmax_ref0_ok(qkg, qkg + 64, lane)) { for (;;) { const int u = next_unit(qa, lds, tid); if (u >= 512) break; const int r = u & 31; attn_ab_unit<0, true>(r >> 2, r & 3, 15 - (u >> 5), QKV, (bf16_t*)(ws + WS_OA), KMEAN, MASK, lds, tid, lane, wave); } }
            else { for (;;) { const int u = next_unit(qa, lds, tid); if (u >= 512) break; const int r = u & 31; attn_ab_unit<0, false>(r >> 2, r & 3, 15 - (u >> 5), QKV, (bf16_t*)(ws + WS_OA), KMEAN, MASK, lds, tid, lane, wave); } }
        }
        PH(5) REP(5) { PHASE_ENV();
            unsigned* qb = ctl + CW_QUEUE + 64 * (l * 4 + 3 + 8 * rep_);
            const float* qkg = args.in[I_QK_GAIN] + l * 6 * 64;
            if (softmax_ref0_ok(qkg + 2 * 64, qkg + 3 * 64, lane)) { for (;;) { const int u = next_unit(qb, lds, tid); if (u >= 512) break; const int r = u & 31; attn_ab_unit<1, true>(r >> 2, r & 3, 15 - (u >> 5), QKV, (bf16_t*)(ws + WS_OB), KMEAN, MASK, lds, tid, lane, wave); } }
            else { for (;;) { const int u = next_unit(qb, lds, tid); if (u >= 512) break; const int r = u & 31; attn_ab_unit<1, false>(r >> 2, r & 3, 15 - (u >> 5), QKV, (bf16_t*)(ws + WS_OB), KMEAN, MASK, lds, tid, lane, wave); } }
        }
        { PHASE_ENV();
            unsigned* qw = ctl + CW_QUEUE + 64 * (16 + l);
            for (;;) { const int c = next_unit(qw, lds, tid); if (c >= (32 * 32 * 16 + 32 * 32 * 8) / 128) break; convert_weights<true>(args, ws, l, lds, lane, wave, vcu, G, c); }
        }
        GRID_BAR();
        PH(6) REP(6) {
            { PHASE_ENV(); pg8::StaticOrder S; S.init(MTOK, DM, G, bx); pg8::Gemm g{(const bf16_t*)(ws + WS_OA), (const bf16_t*)(ws + WS_WPA), MTOK, DM, 256}; pg8::EpiMerge<0> E{(bf16_t*)(ws + WS_MERGED), SG}; pg8::gemm_phase<pg8::EpiMerge<0>, pg8::StaticOrder, GEMM_ALIGN, GEMM_SP2>(lds, g, S, E); }
            { PHASE_ENV(); pg8::StaticOrder S; S.init(MTOK, DM, G, bx); pg8::Gemm g{(const bf16_t*)(ws + WS_OB), (const bf16_t*)(ws + WS_WPB), MTOK, DM, 256}; pg8::EpiMerge<1> E{(bf16_t*)(ws + WS_MERGED), SG}; pg8::gemm_phase<pg8::EpiMerge<1>, pg8::StaticOrder, GEMM_ALIGN, GEMM_SP2>(lds, g, S, E); }
            { PHASE_ENV(); pg8::StaticOrder S; S.init(MTOK, DM, G, bx); pg8::Gemm g{(const bf16_t*)(ws + WS_OC), (const bf16_t*)(ws + WS_WPC), MTOK, DM, 512}; pg8::EpiMerge<2> E{(bf16_t*)(ws + WS_MERGED), SG}; pg8::gemm_phase<pg8::EpiMerge<2>, pg8::StaticOrder, GEMM_ALIGN, GEMM_SP2>(lds, g, S, E); }
        }
        GRID_BAR();
        PH(7) for (int rep_ = 0; rep_ < 1 + ((((REPEAT_MASK) >> 7) & 1) && l == 0); ++rep_) { PHASE_ENV();
            pg8::Gemm g{(const bf16_t*)(ws + WS_MERGED), (const bf16_t*)(ws + WS_WO), MTOK, DM, DM}; pg8::StaticOrder S; S.init(MTOK, DM, G, bx);
            pg8::EpiResid E{l == 0 ? args.in[I_X] : args.out, args.out};
            pg8::gemm_phase<pg8::EpiResid, pg8::StaticOrder, GEMM_ALIGN, GEMM_SP2>(lds, g, S, E);
        }
        GRID_BAR();
        PH(8) REP(8) { PHASE_ENV(); m1_phase(args, ws, l + 2 * rep_, lds, lane, wave, vcu, G); }
        GRID_BAR();
        { PHASE_ENV(); moe_tables(ctl + CW_CNT + 2048 * (l + 2 * (((REPEAT_MASK) >> 8) & 1)), (const int*)(ws + WS_TOKL), (const float*)(ws + WS_RSTD), lds, tid, vcu, G); }
        PH(10) REP(10) { PHASE_ENV();
            const int nblk = *(const LAS int*)(lds + LX_NBLK);
            pg8::Gemm g{(const bf16_t*)(ws + WS_XG), (const bf16_t*)(ws + WS_WGU), MTOK, NEXP * 1024, DM};
            pg8::MoeOrder S{nblk * 4, G, vcu, (const LAS int*)(lds + LX_BLK2E)};
            pg8::EpiGateUp E{(bf16_t*)(ws + WS_HID), (const LAS float*)(lds + LX_RST), G / 4}; pg8::AMapMoe AM{(const LAS int*)(lds + LX_TOK), G / 4};
            pg8::gemm_phase<pg8::EpiGateUp, pg8::MoeOrder, GEMM_ALIGN, GEMM_SP2, pg8::AMapMoe>(lds, g, S, E, AM);
        }
        GRID_BAR();
        PH(11) REP(11) { PHASE_ENV();
            const int nblk = *(const LAS int*)(lds + LX_NBLK);
            pg8::Gemm g{(const bf16_t*)(ws + WS_HID), (const bf16_t*)(ws + WS_WD), MAXBLK * 256, NEXP * 1024, DEXP};
            pg8::MoeOrder S{nblk * 4, G, vcu, (const LAS int*)(lds + LX_BLK2E)};
            pg8::EpiDown E{(bf16_t*)(ws + WS_Y)};
            pg8::gemm_phase<pg8::EpiDown, pg8::MoeOrder, GEMM_ALIGN, GEMM_SP2>(lds, g, S, E);
        }
        GRID_BAR();
    }

__global__ void __launch_bounds__(512, 2) fwd_kernel(Args args) {
    extern __shared__ __attribute__((aligned(16))) unsigned char lds_raw[];
    LAS unsigned char* lds = (LAS unsigned char*)lds_raw;
    for (int u = threadIdx.x; u < (LDS_BYTES - LDSX) / 4; u += 512) ((LAS unsigned*)(lds + LDSX))[u] = 0u;
    __syncthreads();
    const XcdBarrier bar0 = xcd_barrier_post((unsigned*)(args.ws + WS_CTL) + CW_BAR, (volatile LAS unsigned*)(lds + LX_BAR));
    layer_body<0>(args, lds, bar0);
    layer_body<1>(args, lds, bar0);
    { PHASE_ENV();
        const int gw = vcu * 8 + wave, NGW = G * 8; const LAS int* pstart = (const LAS int*)(lds + LX_PSTART);
        for (int m = gw; m < MTOK; m += NGW) token_row<true, false>(args.out, args.out, (const bf16_t*)(ws + WS_Y), (const unsigned*)(ws + WS_RT0), (const unsigned*)(ws + WS_RT1), (const f32x2*)(ws + WS_RTW), pstart, nullptr, nullptr, m, lane);
    }
}

extern "C" void kernel_launch(void* const* d_in, const int* in_sizes, int n_in, void* d_out, int out_size, void* d_ws, size_t ws_size, hipStream_t stream) {
    static int grid = 0;
    if (grid == 0) {
        if (n_in != N_INPUTS || in_sizes[0] != MTOK * DM || out_size != MTOK * DM || ws_size < WS_END) {
            fprintf(stderr, "kernel_launch: built for %d inputs, x/out of %d floats, >= %zu bytes of workspace; got n_in %d, in0 %d, out %d, ws %zu; nothing launched\n", (int)N_INPUTS, MTOK * DM, (size_t)WS_END, n_in, n_in > 0 ? in_sizes[0] : -1, out_size, ws_size);
            grid = -1; return; }
        int dev = 0, cus = 0;
        if (hipGetDevice(&dev) != hipSuccess || hipDeviceGetAttribute(&cus, hipDeviceAttributeMultiprocessorCount, dev) != hipSuccess) { fprintf(stderr, "kernel_launch: device query failed\n"); grid = -1; return; }
        if (hipFuncSetAttribute((const void*)fwd_kernel, hipFuncAttributeMaxDynamicSharedMemorySize, LDS_BYTES) != hipSuccess) { fprintf(stderr, "kernel_launch: hipFuncSetAttribute failed\n"); grid = -1; return; }
        int per_cu = 0;
        if (hipOccupancyMaxActiveBlocksPerMultiprocessor(&per_cu, (const void*)fwd_kernel, 512, LDS_BYTES) != hipSuccess || per_cu < 1) fprintf(stderr, "kernel_launch: note: occupancy query reports %d workgroups per CU\n", per_cu);
        (void)hipGetLastError();
        grid = cus;
    }
    if (grid < 0) return;
    if (hipMemsetAsync((char*)d_ws + WS_CTL, 0, CTL_BYTES, stream) != hipSuccess) { fprintf(stderr, "kernel_launch: memset failed\n"); return; }
    Args a{};
    for (int i = 0; i < N_INPUTS; ++i) a.in[i] = (const float*)d_in[i];
    a.out = (float*)d_out; a.ws = (unsigned char*)d_ws;
    hipLaunchKernelGGL(fwd_kernel, dim3(grid), dim3(512), LDS_BYTES, stream, a);
    const hipError_t le = hipPeekAtLastError();
    if (le != hipSuccess) fprintf(stderr, "kernel_launch: launch failed: %s\n", hipGetErrorName(le));
}
```

```cpp
#include <hip/hip_runtime.h>
#include <cstdio>
#include <cstdint>

#define LAS __attribute__((address_space(3)))
#define GAS __attribute__((address_space(1)))
typedef unsigned short bf16_t;
typedef short bf16x8 __attribute__((ext_vector_type(8)));
typedef short s16x4 __attribute__((ext_vector_type(4)));
typedef float f32x4 __attribute__((ext_vector_type(4)));
typedef float f32x2 __attribute__((ext_vector_type(2)));
typedef float f32x16 __attribute__((ext_vector_type(16)));
typedef unsigned u32x4 __attribute__((ext_vector_type(4)));
typedef unsigned u32x2 __attribute__((ext_vector_type(2)));

constexpr int NBATCH = 8, SEQ = 4096, MTOK = NBATCH * SEQ, DM = 1024, NLAYER = 2;
constexpr int QP = 3656;
constexpr int C_QA = 0, C_KA = 256, C_VA = 512, C_QB = 768, C_KB = 1024, C_VB = 1280, C_QI = 1536, C_KI = 2048, C_WI = 2112,
              C_Q1 = 2120, C_Q2 = 2376, C_K1 = 2632, C_K2 = 2888, C_VC = 3144, C_G = 3656, D_IN = 6728;
constexpr int NT_IN = 27;
constexpr int NEXP = 32, DEXP = 512, MAXBLK = 288;
constexpr float C2 = 0.125f * 1.4426950408889634f;
constexpr float EPS = 1e-6f;
#ifndef REF0_ENABLE
#define REF0_ENABLE 1
#endif

constexpr size_t MiB = 1u << 20;
constexpr size_t WS_CTL = 0, CTL_BYTES = 1 * MiB;
constexpr size_t WS_COS = 1 * MiB, WS_SIN = WS_COS + 512 * 1024;
constexpr size_t WS_SMALL = 2 * MiB;
constexpr size_t WS_KMEAN = WS_SMALL, WS_RT0 = WS_SMALL + 256 * 1024, WS_RT1 = WS_SMALL + 384 * 1024, WS_RTW = WS_SMALL + 512 * 1024, WS_WRT = WS_SMALL + 768 * 1024;
constexpr size_t WS_WIN = 3 * MiB;
constexpr size_t WS_WPA = 17 * MiB, WS_WPB = WS_WPA + 512 * 1024, WS_WPC = 18 * MiB;
constexpr size_t WS_WO = 19 * MiB;
constexpr size_t WS_WGU = 21 * MiB;
constexpr size_t WS_WD = 85 * MiB;
constexpr size_t WS_HN = 117 * MiB;
constexpr size_t WS_OA = WS_HN, WS_OB = WS_HN + 16 * MiB, WS_OC = WS_HN + 32 * MiB;
constexpr size_t WS_QKV = 181 * MiB;
constexpr size_t WS_MERGED = WS_QKV, WS_Y = WS_QKV, WS_HID = WS_QKV + 144 * MiB;
constexpr size_t WS_XG = WS_QKV, WS_TOKL = WS_QKV + 64 * MiB, WS_RSTD = WS_QKV + 68 * MiB;
constexpr size_t WS_SG = 410 * MiB;
constexpr size_t WS_MASK = 506 * MiB;
constexpr size_t WS_END = 522 * MiB;
static_assert((size_t)MTOK * QP * 2 <= 229 * MiB && (size_t)MAXBLK * 256 * 1024 * 2 <= 144 * MiB && (size_t)MAXBLK * 256 * 512 * 2 <= 72 * MiB, "ws map");
constexpr int CW_BAR = 4096;
constexpr int CW_QUEUE = 8192;
constexpr int CW_CNT = 16384;

constexpr int LDSX = 131072;
constexpr int LX_BAR = LDSX, LX_BC = LDSX + 16, LX_NBLK = LDSX + 32, LX_PSTART = LDSX + 64, LX_BLK2E = LDSX + 256, LX_CNT = LDSX + 1536, LX_TOK = LDSX + 2048, LX_RST = LDSX + 2048 + 6144;
constexpr int LDS_BYTES = 147456;

typedef __bf16 bf16x2_t __attribute__((ext_vector_type(2)));
__device__ __forceinline__ unsigned cvt_pk_bf16(float lo, float hi) { const f32x2 v = {lo, hi}; const bf16x2_t b = __builtin_convertvector(v, bf16x2_t); return __builtin_bit_cast(unsigned, b); }
__device__ __forceinline__ float bf_lo(unsigned w) { return __builtin_bit_cast(float, w << 16); }
__device__ __forceinline__ float bf_hi(unsigned w) { return __builtin_bit_cast(float, w & 0xffff0000u); }
template <int M> __device__ __forceinline__ float xor_lane(float v) {
    return __builtin_bit_cast(float, __builtin_amdgcn_ds_swizzle(__builtin_bit_cast(int, v), (M << 10) | 0x1f)); }
__device__ __forceinline__ float sum_xor32(float v) {
    const unsigned u = __builtin_bit_cast(unsigned, v); const auto rr = __builtin_amdgcn_permlane32_swap(u, u, false, false);
    return __builtin_bit_cast(float, (unsigned)rr[0]) + __builtin_bit_cast(float, (unsigned)rr[1]); }
__device__ __forceinline__ float max_xor32(float v) {
    const unsigned u = __builtin_bit_cast(unsigned, v); const auto rr = __builtin_amdgcn_permlane32_swap(u, u, false, false);
    return fmaxf(__builtin_bit_cast(float, (unsigned)rr[0]), __builtin_bit_cast(float, (unsigned)rr[1])); }
__device__ __forceinline__ int lane_val(int v, int src_lane) { return __builtin_amdgcn_ds_bpermute(src_lane << 2, v); }
__device__ __forceinline__ float wave_sum(float v) {
    v += xor_lane<1>(v); v += xor_lane<2>(v); v += xor_lane<4>(v); v += xor_lane<8>(v); v += xor_lane<16>(v);
    return sum_xor32(v);
}
__device__ __forceinline__ float fast_exp2(float x) { return __builtin_amdgcn_exp2f(x); }
__device__ __forceinline__ float fast_rcp(float x) { return __builtin_amdgcn_rcpf(x); }

namespace pg8 {
#define PG8_LAS __attribute__((address_space(3)))
typedef unsigned short bf16_t;
typedef short bf16x8 __attribute__((ext_vector_type(8)));
typedef float f32x4 __attribute__((ext_vector_type(4)));
typedef unsigned u32x4 __attribute__((ext_vector_type(4)));
constexpr int BM = 256, BK = 64, HALF = 128, HTB = HALF * BK * 2  , STAGE_BYTES = 8 * HTB, NXCD = 8, WGM = 8;

__host__ __device__ __forceinline__ int lds_byte(int r, int c) { const int st = (r >> 4) * 2 + (c >> 5), rr = r & 15, cc = c & 31, ob = rr * 64 + cc * 2; return st * 1024 + (ob ^ (((ob >> 9) & 1) << 5)); }
__host__ __device__ __forceinline__ void stage_rc(int b, int& R, int& C) { const int st = b / 1024, sb = b % 1024, swz = sb ^ (((sb >> 9) & 1) << 5); R = (st >> 1) * 16 + swz / 64; C = (st & 1) * 32 + (swz % 64) / 2; }
__host__ __device__ __forceinline__ int perm32(int rho) { const int n = rho >> 4, i = rho & 15; return 8 * (i >> 2) + 4 * n + (i & 3); }
struct Unit { int pm, pn; };
struct Gemm { const bf16_t* A; const bf16_t* Bt; int M, N, K; };

struct StaticOrder {
    int nM, nN, nwg, G, c;
    __host__ __device__ void init(int M, int N, int G_, int c_) { nM = M / BM; nN = N / BM; nwg = nM * nN; G = G_; c = c_; }
    __host__ __device__ bool next(int i, Unit& u) const {
        const long L = (long)i * G + c; if (L >= nwg) return false;
        int wgid = (int)L; { const int q = nwg / NXCD, r = nwg % NXCD, xcd = wgid % NXCD, off = wgid / NXCD; wgid = (xcd < r ? xcd * (q + 1) : r * (q + 1) + (xcd - r) * q) + off; }
        const int nig = WGM * nN, gid = wgid / nig, fm = gid * WGM, gsz = (nM - fm) < WGM ? (nM - fm) : WGM;
        u.pm = fm + ((wgid % nig) % gsz); u.pn = (wgid % nig) / gsz; return true;
    }
    __device__ __forceinline__ void a_ready(const Unit&) const {}
    __device__ __forceinline__ void done(const Unit&) const {}
};


struct EpiInProj {
    static constexpr bool PERM = false, AFTER_DRAIN = false;
    bf16_t* qkv; unsigned char* sg; const float* cosT; const float* sinT; const float* qkg; const float* ikg;
    __device__ __forceinline__ void operator()(const f32x4 (&acc)[2][2][4][2], const Unit& u, int wr, int wc, int fr, int fq) const {
        const int pn = u.pn, row0 = u.pm * BM + wr * 64 + fr;
        if (pn >= 15) {
            unsigned char* base = sg + (size_t)row0 * 3072 + (pn - 15) * 256 + wc * 64 + fq * 16;
#pragma unroll
            for (int ai = 0; ai < 2; ++ai)
#pragma unroll
                for (int m = 0; m < 4; ++m) {
                    unsigned w[2][2];
#pragma unroll
                    for (int bj = 0; bj < 2; ++bj)
#pragma unroll
                        for (int n = 0; n < 2; ++n) { unsigned pk = 0;
#pragma unroll
                            for (int i = 0; i < 4; i += 2) { const float x0 = fminf(fmaxf(acc[ai][bj][m][n][i], -30.f), 30.f), x1 = fminf(fmaxf(acc[ai][bj][m][n][i + 1], -30.f), 30.f);
                                const float a = 1.0f + fast_exp2(-1.4426950408889634f * x0), b = 1.0f + fast_exp2(-1.4426950408889634f * x1), r = 255.0f * fast_rcp(a * b);
                                pk = __builtin_amdgcn_cvt_pk_u8_f32(floorf(b * r + 0.5f), i, pk); pk = __builtin_amdgcn_cvt_pk_u8_f32(floorf(a * r + 0.5f), i + 1, pk); }
                            w[bj][n] = pk; }
                    *(u32x4*)(base + (size_t)(ai * HALF + m * 16) * 3072) = (u32x4){w[0][0], w[0][1], w[1][0], w[1][1]};
                }
            return;
        }
        int type = 0, gi = 0; bool qscale = false;
        int ocol = (pn < 8 ? 256 * pn : C_Q1 + 256 * (pn - 9)) + 64 * wc;
        switch (pn) {
            case 0: type = 2; gi = 0; qscale = true; break;
            case 1: type = 2; gi = 1; break;
            case 3: type = 2; gi = 2; qscale = true; break;
            case 4: type = 2; gi = 3; break;
            case 6: case 7: type = 1; break;
            case 8: if (wc == 0) { type = 2; ocol = C_KI; } else if (wc == 1) { type = 3; ocol = C_WI; } else type = 4; break;
            case 9: case 10: type = 2; gi = 4; qscale = true; break;
            case 11: case 12: type = 2; gi = 5; break;
            default: type = 0; break;
        }
        if (type == 4) return;
        if (type == 3) {
            if (fq == 0) {
#pragma unroll
                for (int ai = 0; ai < 2; ++ai)
#pragma unroll
                    for (int m = 0; m < 4; ++m) { const f32x4 a = acc[ai][0][m][0] * 0.35355339059327373f, b = acc[ai][0][m][1] * 0.35355339059327373f;
                        *(u32x4*)(qkv + (size_t)(row0 + ai * HALF + m * 16) * QP + C_WI) = (u32x4){cvt_pk_bf16(a[0], a[1]), cvt_pk_bf16(a[2], a[3]), cvt_pk_bf16(b[0], b[1]), cvt_pk_bf16(b[2], b[3])}; }
            }
            return;
        }
        const float* gp = (pn == 8) ? ikg : qkg + 64 * gi;
        if (type == 2) { if (qscale) body<2, true>(acc, row0, ocol, gp, fq); else body<2, false>(acc, row0, ocol, gp, fq); }
        else if (type == 1) body<1, false>(acc, row0, ocol, gp, fq);
        else body<0, false>(acc, row0, ocol, gp, fq);
    }
    template <int TYPE, bool QS>
    __device__ __forceinline__ void body(const f32x4 (&acc)[2][2][4][2], int row0, int ocol, const float* gp, int fq) const {
#pragma unroll
        for (int ai = 0; ai < 2; ++ai)
#pragma unroll
            for (int m = 0; m < 4; ++m) {
                const int row = row0 + ai * HALF + m * 16;
                f32x4 x[2][2];
#pragma unroll
                for (int bj = 0; bj < 2; ++bj)
#pragma unroll
                    for (int n = 0; n < 2; ++n) x[bj][n] = acc[ai][bj][m][n];
                if (TYPE == 2) {
                    float ss = 0.f;
#pragma unroll
                    for (int bj = 0; bj < 2; ++bj)
#pragma unroll
                        for (int n = 0; n < 2; ++n) ss += (x[bj][n][0] * x[bj][n][0] + x[bj][n][1] * x[bj][n][1]) + (x[bj][n][2] * x[bj][n][2] + x[bj][n][3] * x[bj][n][3]);
                    ss += xor_lane<16>(ss); ss = sum_xor32(ss);
                    const float inv = (QS ? C2 : 1.0f) / sqrtf(ss * (1.0f / 64.0f) + EPS);
#pragma unroll
                    for (int bj = 0; bj < 2; ++bj)
#pragma unroll
                        for (int n = 0; n < 2; ++n) x[bj][n] = x[bj][n] * inv * *(const f32x4*)(gp + 32 * bj + 8 * fq + 4 * n);
                }
                if (TYPE >= 1) {
                    const int pos = row & (SEQ - 1);
#pragma unroll
                    for (int n = 0; n < 2; ++n) {
                        const f32x4 c = *(const f32x4*)(cosT + pos * 32 + 8 * fq + 4 * n), s = *(const f32x4*)(sinT + pos * 32 + 8 * fq + 4 * n);
                        const f32x4 a = x[0][n], b = x[1][n];
                        x[0][n] = a * c - b * s; x[1][n] = b * c + a * s;
                    }
                }
#pragma unroll
                for (int bj = 0; bj < 2; ++bj)
                    *(u32x4*)(qkv + (size_t)row * QP + ocol + 32 * bj + 8 * fq) = (u32x4){cvt_pk_bf16(x[bj][0][0], x[bj][0][1]), cvt_pk_bf16(x[bj][0][2], x[bj][0][3]), cvt_pk_bf16(x[bj][1][0], x[bj][1][1]), cvt_pk_bf16(x[bj][1][2], x[bj][1][3])};
                asm volatile("" ::: "memory");
            }
    }
};

template <int BR> struct EpiMerge {
    static constexpr bool PERM = false, AFTER_DRAIN = false;
    bf16_t* merged; const unsigned char* sg;
    __device__ __forceinline__ void operator()(const f32x4 (&acc)[2][2][4][2], const Unit& u, int wr, int wc, int fr, int fq) const {
        const int row0 = u.pm * BM + wr * 64 + fr, col0 = u.pn * BM + wc * 64 + fq * 16;
#pragma unroll
        for (int ai = 0; ai < 2; ++ai)
#pragma unroll
            for (int m = 0; m < 4; ++m) { const size_t row = (size_t)(row0 + ai * HALF + m * 16);
                const u32x4 gq = *(const u32x4*)(sg + row * 3072 + BR * 1024 + col0);
                bf16_t* mp = merged + row * 1024 + col0;
                float v[16];
#pragma unroll
                for (int bj = 0; bj < 2; ++bj)
#pragma unroll
                    for (int n = 0; n < 2; ++n)
#pragma unroll
                        for (int i = 0; i < 4; ++i) v[8 * bj + 4 * n + i] = acc[ai][bj][m][n][i] * ((float)((gq[2 * bj + n] >> (8 * i)) & 255u) * (1.0f / 255.0f));
                if (BR > 0) { const u32x4 o0 = *(const u32x4*)mp, o1 = *(const u32x4*)(mp + 8);
#pragma unroll
                    for (int k = 0; k < 4; ++k) { v[2 * k] += bf_lo(o0[k]); v[2 * k + 1] += bf_hi(o0[k]); v[8 + 2 * k] += bf_lo(o1[k]); v[8 + 2 * k + 1] += bf_hi(o1[k]); } }
                *(u32x4*)mp = (u32x4){cvt_pk_bf16(v[0], v[1]), cvt_pk_bf16(v[2], v[3]), cvt_pk_bf16(v[4], v[5]), cvt_pk_bf16(v[6], v[7])};
                *(u32x4*)(mp + 8) = (u32x4){cvt_pk_bf16(v[8], v[9]), cvt_pk_bf16(v[10], v[11]), cvt_pk_bf16(v[12], v[13]), cvt_pk_bf16(v[14], v[15])};
                asm volatile("" ::: "memory"); }
    }
};

struct EpiResid {
    static constexpr bool PERM = false, AFTER_DRAIN = false;
    const float* res; float* out;
    __device__ __forceinline__ void operator()(const f32x4 (&acc)[2][2][4][2], const Unit& u, int wr, int wc, int fr, int fq) const {
        const int row0 = u.pm * BM + wr * 64 + fr, col0 = u.pn * BM + wc * 32 + fq * 8;
#pragma unroll
        for (int ai = 0; ai < 2; ++ai)
#pragma unroll
            for (int m = 0; m < 4; ++m) { const size_t off = (size_t)(row0 + ai * HALF + m * 16) * 1024 + col0;
#pragma unroll
                for (int bj = 0; bj < 2; ++bj)
#pragma unroll
                    for (int n = 0; n < 2; ++n) { const f32x4 r = *(const f32x4*)(res + off + bj * HALF + 4 * n); *(f32x4*)(out + off + bj * HALF + 4 * n) = r + acc[ai][bj][m][n]; }
                if (m & 1) asm volatile("" ::: "memory"); }
    }
};

struct EpiGateUp {
    static constexpr bool PERM = false, AFTER_DRAIN = false;
    bf16_t* hid; const PG8_LAS float* rst; int rbs;
    __device__ __forceinline__ void operator()(const f32x4 (&acc)[2][2][4][2], const Unit& u, int wr, int wc, int fr, int fq) const {
        const int row0 = u.pm * BM + wr * 64 + fr, col0 = (u.pn & 3) * HALF + wc * 32 + fq * 8;
        const PG8_LAS float* rs = rst + (u.pm / rbs) * 256 + wr * 64 + fr;
#pragma unroll
        for (int ai = 0; ai < 2; ++ai)
#pragma unroll
            for (int m = 0; m < 4; ++m) { float v[8]; const float r = rs[ai * HALF + m * 16];
#pragma unroll
                for (int n = 0; n < 2; ++n)
#pragma unroll
                    for (int i = 0; i < 4; ++i) { const float gt = acc[ai][0][m][n][i] * r, up = acc[ai][1][m][n][i] * r; v[4 * n + i] = gt * fast_rcp(1.0f + fast_exp2(-1.4426950408889634f * gt)) * up; }
                *(u32x4*)(hid + (size_t)(row0 + ai * HALF + m * 16) * DEXP + col0) = (u32x4){cvt_pk_bf16(v[0], v[1]), cvt_pk_bf16(v[2], v[3]), cvt_pk_bf16(v[4], v[5]), cvt_pk_bf16(v[6], v[7])}; }
    }
};

struct EpiDown {
    static constexpr bool PERM = false, AFTER_DRAIN = false;
    bf16_t* y;
    __device__ __forceinline__ void operator()(const f32x4 (&acc)[2][2][4][2], const Unit& u, int wr, int wc, int fr, int fq) const {
        const int row0 = u.pm * BM + wr * 64 + fr, col0 = (u.pn & 3) * BM + wc * 64 + fq * 16;
#pragma unroll
        for (int ai = 0; ai < 2; ++ai)
#pragma unroll
            for (int m = 0; m < 4; ++m) { bf16_t* yp = y + (size_t)(row0 + ai * HALF + m * 16) * 1024 + col0;
#pragma unroll
                for (int bj = 0; bj < 2; ++bj) { const f32x4 a = acc[ai][bj][m][0], b = acc[ai][bj][m][1];
                    *(u32x4*)(yp + 8 * bj) = (u32x4){cvt_pk_bf16(a[0], a[1]), cvt_pk_bf16(a[2], a[3]), cvt_pk_bf16(b[0], b[1]), cvt_pk_bf16(b[2], b[3])}; } }
    }
};

struct AMapMoe { static constexpr bool GATHER = true; const PG8_LAS int* tok; int rbs;
    __device__ __forceinline__ unsigned row(const Unit& u, int R) const { return (unsigned)tok[(u.pm / rbs) * 256 + R]; } };
struct MoeOrder {
    int nunits, G, c; const PG8_LAS int* blk2e;
    __device__ __forceinline__ bool next(int i, Unit& u) const { const int L = i * G + c; if (L >= nunits) return false; const int rb = L >> 2; u.pm = rb; u.pn = blk2e[rb] * 4 + (L & 3); return true; }
    __device__ __forceinline__ void a_ready(const Unit&) const {}
    __device__ __forceinline__ void done(const Unit&) const {}
};

struct NoAMap { static constexpr bool GATHER = false; __device__ __forceinline__ unsigned row(const Unit&, int) const { return 0u; } };
template <class Epi, class Sched, bool ALIGN_EPI = false, bool SP2 = false, class AMap = NoAMap>
__device__ __forceinline__ void gemm_phase(PG8_LAS unsigned char* lds, const Gemm g, const Sched& S, const Epi& E, const AMap& AM = AMap()) {
    static_assert(!AMap::GATHER || SP2, "the row gather is wired into the SP2 loop only");
    int tid_l = (int)threadIdx.x; asm volatile("" : "+v"(tid_l));
    const int tid = tid_l, wid = __builtin_amdgcn_readfirstlane(tid >> 6), lane = tid & 63, wr = wid >> 2, wc = wid & 3, fr = lane & 15, fq = lane >> 4;
    const int K = g.K, nt = K / BK;
    unsigned voffA[2], voffB[2];
#pragma unroll
    for (int i = 0; i < 2; ++i) { int R, C; stage_rc(tid * 16 + i * 8192, R, C); const int Rb = Epi::PERM ? ((R & ~31) + perm32(R & 31)) : R;
        voffA[i] = (unsigned)(R * K + C) * 2u; voffB[i] = (unsigned)(Rb * K + C) * 2u; }
    int RA[2], CA[2];
#pragma unroll
    for (int i = 0; i < 2; ++i) stage_rc(tid * 16 + i * 8192, RA[i], CA[i]);
    unsigned vC0[2] = {0u, 0u}, vC1[2] = {0u, 0u}, vN0[2] = {0u, 0u}, vN1[2] = {0u, 0u};
#define PG8_AOFFS(v0, v1, unit) do { if constexpr (AMap::GATHER) { _Pragma("unroll") for (int _i = 0; _i < 2; ++_i) { \
        v0[_i] = (AM.row(unit, RA[_i]) * (unsigned)K + (unsigned)CA[_i]) * 2u; v1[_i] = (AM.row(unit, HALF + RA[_i]) * (unsigned)K + (unsigned)CA[_i]) * 2u; } } } while (0)
#define PG8_STAGE_A(bufoff, base, half, usenext) do { if constexpr (AMap::GATHER) { unsigned vv_[2]; _Pragma("unroll") for (int _j = 0; _j < 2; ++_j) vv_[_j] = (usenext) ? ((half) ? vN1[_j] : vN0[_j]) : ((half) ? vC1[_j] : vC0[_j]); \
        PG8_STAGE(bufoff, base, vv_); } else { PG8_STAGE(bufoff, (base) + (half) * hstep, voffA); } } while (0)
    const size_t kstep = (size_t)(BK * 2);
    const size_t hstep = (size_t)HALF * K * 2;
    const size_t tstep = 2 * hstep;
    const unsigned ldsw = (unsigned)wid * 1024u;
    const int aoff = lds_byte(wr * 64 + fr, fq * 8), boff = lds_byte(wc * 32 + fr, fq * 8);
#define PG8_SA(b, h) (((b) * 2 + (h)) * HTB)
#define PG8_SB(b, h) ((4 + (b) * 2 + (h)) * HTB)
#define PG8_STAGE(bufoff, gbase, voff) do { _Pragma("unroll") for (int _i = 0; _i < 2; ++_i) \
        __builtin_amdgcn_global_load_lds((const unsigned*)((const char*)(gbase) + (voff)[_i]), (PG8_LAS unsigned*)(lds + (bufoff) + ldsw + _i * 8192), 16, 0, 0); } while (0)
#define PG8_LDA(dst, b, h) do { _Pragma("unroll") for (int m = 0; m < 4; ++m) _Pragma("unroll") for (int k = 0; k < 2; ++k) dst[m][k] = *(const PG8_LAS bf16x8*)(lds + PG8_SA(b, h) + aoff + m * 2048 + k * 1024); } while (0)
#define PG8_LDB(dst, b, h) do { _Pragma("unroll") for (int n = 0; n < 2; ++n) _Pragma("unroll") for (int k = 0; k < 2; ++k) dst[n][k] = *(const PG8_LAS bf16x8*)(lds + PG8_SB(b, h) + boff + n * 2048 + k * 1024); } while (0)
#define PG8_MMA(ai, bj, At, Bt) do { __builtin_amdgcn_s_setprio(1); _Pragma("unroll") for (int m = 0; m < 4; ++m) _Pragma("unroll") for (int n = 0; n < 2; ++n) _Pragma("unroll") for (int k = 0; k < 2; ++k) \
        acc[ai][bj][m][n] = __builtin_amdgcn_mfma_f32_16x16x32_bf16(Bt[n][k], At[m][k], acc[ai][bj][m][n], 0, 0, 0); __builtin_amdgcn_s_setprio(0); } while (0)
#define PG8_WAIT_V(n) asm volatile("s_waitcnt vmcnt(" #n ")" ::: "memory")
#define PG8_WAIT_L(n) asm volatile("s_waitcnt lgkmcnt(" #n ")" ::: "memory")
#define PG8_BAR __builtin_amdgcn_s_barrier()
#define PG8_SCHED __builtin_amdgcn_sched_barrier(0)
    Unit cur, nxt; int ui = 0;
    if (!S.next(0, cur)) return;
    f32x4 acc[2][2][4][2];
#pragma unroll
    for (int a = 0; a < 2; ++a)
#pragma unroll
        for (int b = 0; b < 2; ++b)
#pragma unroll
            for (int m = 0; m < 4; ++m)
#pragma unroll
                for (int n = 0; n < 2; ++n) acc[a][b][m][n] = (f32x4){0.f, 0.f, 0.f, 0.f};
    bf16x8 At[4][2], B0[2][2], B1[2][2];
    const char* cA = (const char*)g.A + (AMap::GATHER ? (size_t)0 : (size_t)cur.pm * tstep); const char* cB = (const char*)g.Bt + (size_t)cur.pn * tstep;
    PG8_AOFFS(vC0, vC1, cur);
    S.a_ready(cur);
    if constexpr (SP2) {
        PG8_STAGE(PG8_SB(0, 0), cB, voffB); PG8_STAGE(PG8_SB(0, 1), cB + hstep, voffB); PG8_STAGE_A(PG8_SA(0, 0), cA, 0, false); PG8_STAGE_A(PG8_SA(0, 1), cA, 1, false);
        if (wr == 1) PG8_BAR;
        PG8_WAIT_V(2); PG8_BAR;
        PG8_STAGE(PG8_SB(1, 0), cB + kstep, voffB); PG8_STAGE_A(PG8_SA(1, 0), cA + kstep, 0, false); PG8_STAGE(PG8_SB(1, 1), cB + hstep + kstep, voffB);
        PG8_WAIT_V(6); PG8_BAR;
    } else {
        PG8_STAGE(PG8_SB(0, 0), cB, voffB); PG8_STAGE(PG8_SA(0, 0), cA, voffA); PG8_STAGE(PG8_SB(0, 1), cB + hstep, voffB); PG8_STAGE(PG8_SA(0, 1), cA + hstep, voffA);
        if (wr == 1) PG8_BAR;
        PG8_WAIT_V(4); PG8_BAR;
        PG8_STAGE(PG8_SB(1, 0), cB + kstep, voffB); PG8_STAGE(PG8_SA(1, 0), cA + kstep, voffA); PG8_STAGE(PG8_SB(1, 1), cB + hstep + kstep, voffB);
        PG8_WAIT_V(6); PG8_BAR;
    }
    for (;;) {
        const bool has_next = S.next(ui + 1, nxt);
        const char* nA = (has_next && !AMap::GATHER) ? (const char*)g.A + (size_t)nxt.pm * tstep : cA; const char* nB = has_next ? (const char*)g.Bt + (size_t)nxt.pn * tstep : cB;
        if constexpr (AMap::GATHER) { if (has_next) PG8_AOFFS(vN0, vN1, nxt); else { vN0[0] = vC0[0]; vN0[1] = vC0[1]; vN1[0] = vC1[0]; vN1[1] = vC1[1]; } }
#pragma unroll 1
        for (int t = 0; t < nt; t += 2) {
            const bool last = (t == nt - 2);
            const char* a1 = cA + (size_t)(t + 1) * kstep;
            const char* a2 = last ? nA : cA + (size_t)(t + 2) * kstep; const char* b2 = last ? nB : cB + (size_t)(t + 2) * kstep;
            const char* a3 = a2 + kstep; const char* b3 = b2 + kstep;
            if (last && has_next) S.a_ready(nxt);
            if constexpr (SP2) {
            PG8_LDB(B0, 0, 0); PG8_LDB(B1, 0, 1); PG8_SCHED; PG8_LDA(At, 0, 0); PG8_STAGE_A(PG8_SA(1, 1), a1, 1, false);
            PG8_WAIT_V(8); PG8_WAIT_L(0); PG8_BAR; PG8_MMA(0, 0, At, B0); PG8_MMA(0, 1, At, B1); PG8_BAR; PG8_SCHED;
            PG8_LDA(At, 0, 1); PG8_STAGE(PG8_SB(0, 0), b2, voffB); PG8_STAGE(PG8_SB(0, 1), b2 + hstep, voffB); PG8_STAGE_A(PG8_SA(0, 0), a2, 0, last);
            PG8_WAIT_V(8); PG8_WAIT_L(0); PG8_BAR; PG8_MMA(1, 0, At, B0); PG8_MMA(1, 1, At, B1); PG8_BAR; PG8_SCHED;
            PG8_LDB(B0, 1, 0); PG8_LDB(B1, 1, 1); PG8_SCHED; PG8_LDA(At, 1, 0); PG8_STAGE_A(PG8_SA(0, 1), a2, 1, last);
            PG8_WAIT_V(8); PG8_WAIT_L(0); PG8_BAR; PG8_MMA(0, 0, At, B0); PG8_MMA(0, 1, At, B1); PG8_BAR; PG8_SCHED;
            PG8_LDA(At, 1, 1); PG8_STAGE(PG8_SB(1, 0), b3, voffB); PG8_STAGE(PG8_SB(1, 1), b3 + hstep, voffB); PG8_STAGE_A(PG8_SA(1, 0), a3, 0, last);
            PG8_WAIT_V(8); PG8_WAIT_L(0); PG8_BAR; PG8_MMA(1, 0, At, B0); PG8_MMA(1, 1, At, B1); PG8_BAR; PG8_SCHED;
            } else {
            PG8_LDB(B0, 0, 0); PG8_SCHED; PG8_LDA(At, 0, 0); PG8_STAGE(PG8_SA(1, 1), a1 + hstep, voffA);
            PG8_WAIT_L(8); PG8_BAR; PG8_WAIT_L(0); PG8_MMA(0, 0, At, B0); PG8_BAR; PG8_SCHED;
            PG8_LDB(B1, 0, 1); PG8_STAGE(PG8_SB(0, 0), b2, voffB);
            PG8_BAR; PG8_WAIT_L(0); PG8_MMA(0, 1, At, B1); PG8_BAR;
            PG8_LDA(At, 0, 1); PG8_STAGE(PG8_SA(0, 0), a2, voffA);
            PG8_BAR; PG8_WAIT_L(0); PG8_MMA(1, 0, At, B0); PG8_BAR; PG8_SCHED;
            PG8_STAGE(PG8_SB(0, 1), b2 + hstep, voffB);
            PG8_WAIT_V(6); PG8_BAR; PG8_MMA(1, 1, At, B1); PG8_BAR;
            PG8_LDB(B0, 1, 0); PG8_SCHED; PG8_LDA(At, 1, 0); PG8_STAGE(PG8_SA(0, 1), a2 + hstep, voffA);
            PG8_WAIT_L(8); PG8_BAR; PG8_WAIT_L(0); PG8_MMA(0, 0, At, B0); PG8_BAR; PG8_SCHED;
            PG8_LDB(B1, 1, 1); PG8_STAGE(PG8_SB(1, 0), b3, voffB);
            PG8_BAR; PG8_WAIT_L(0); PG8_MMA(0, 1, At, B1); PG8_BAR;
            PG8_LDA(At, 1, 1); PG8_STAGE(PG8_SA(1, 0), a3, voffA);
            PG8_BAR; PG8_WAIT_L(0); PG8_MMA(1, 0, At, B0); PG8_BAR; PG8_SCHED;
            PG8_STAGE(PG8_SB(1, 1), b3 + hstep, voffB);
            PG8_WAIT_V(6); PG8_BAR; PG8_MMA(1, 1, At, B1); PG8_BAR;
            }
        }
        if constexpr (ALIGN_EPI) { if (wr == 0) PG8_BAR; }
        if constexpr (!Epi::AFTER_DRAIN) { E(acc, cur, wr, wc, fr, fq); S.done(cur); }
        if (!has_next) break;
#pragma unroll
        for (int a = 0; a < 2; ++a)
#pragma unroll
            for (int b = 0; b < 2; ++b)
#pragma unroll
                for (int m = 0; m < 4; ++m)
#pragma unroll
                    for (int n = 0; n < 2; ++n) acc[a][b][m][n] = (f32x4){0.f, 0.f, 0.f, 0.f};
        cur = nxt; cA = nA; cB = nB; ++ui;
        if constexpr (AMap::GATHER) { vC0[0] = vN0[0]; vC0[1] = vN0[1]; vC1[0] = vN1[0]; vC1[1] = vN1[1]; }
        if constexpr (ALIGN_EPI) { if (wr == 1) PG8_BAR; }
    }
    PG8_WAIT_V(0);
    if constexpr (!ALIGN_EPI) { if (wr == 0) PG8_BAR; }
    PG8_BAR;
    if constexpr (Epi::AFTER_DRAIN) { E.fused(acc, cur, wr, wc, fr, fq, lds, wid, lane); S.done(cur); }
#undef PG8_SA
#undef PG8_AOFFS
#undef PG8_STAGE_A
#undef PG8_SB
#undef PG8_STAGE
#undef PG8_LDA
#undef PG8_LDB
#undef PG8_MMA
#undef PG8_WAIT_V
#undef PG8_WAIT_L
#undef PG8_BAR
#undef PG8_SCHED
}
}
#define XB_TMO      128
#define XB_XCNT(j)  (256  + 64 * (j))
#define XB_XSUB(j)  (1280 + 64 * (j))
#define XB_XGEN(j)  (2304 + 64 * (j))
#define XB_TOP      3328
#define XB_TOPGEN   3392
#define XCD_BAR_WORDS 3456
#define XB_SPIN_CAP (1u << 21)

__device__ __forceinline__ unsigned xb_ld(unsigned* p)              { return __hip_atomic_load(p, __ATOMIC_RELAXED, __HIP_MEMORY_SCOPE_AGENT); }
__device__ __forceinline__ unsigned xb_add(unsigned* p, unsigned v) { return __hip_atomic_fetch_add(p, v, __ATOMIC_RELAXED, __HIP_MEMORY_SCOPE_AGENT); }
__device__ __forceinline__ unsigned xb_xcc_id() { return (unsigned)__builtin_amdgcn_s_getreg((3 << 11) | 20) & 0xFu; }
#define XB_SPIN(cond, bar) do { unsigned _sp = 0; while (cond) { __builtin_amdgcn_s_sleep(1); \
    if ((++_sp & 255u) == 0u) { if (xb_ld(&(bar)[XB_TMO])) break; if (_sp > XB_SPIN_CAP) { atomicAdd(&(bar)[XB_TMO], 1u); break; } } } } while (0)

struct XcdBarrier {
    unsigned* bar; unsigned x;
    volatile LAS unsigned* st;
};

__device__ __forceinline__ XcdBarrier xcd_barrier_post(unsigned* bar, volatile LAS unsigned* st) {
    XcdBarrier b; b.bar = bar; b.x = xb_xcc_id(); b.st = st;
    if (threadIdx.x == 0) (void)xb_add(&bar[XB_XCNT(b.x)], 1u);
    return b;
}
__device__ __forceinline__ void xcd_barrier_complete(unsigned* bar, unsigned x, unsigned& nloc, unsigned& nx) {
    const unsigned G = gridDim.x * gridDim.y * gridDim.z;
    unsigned sum, cnt, mine, sp = 0u;
    for (;;) {
        sum = 0u; cnt = 0u; mine = 0u;
#pragma unroll
        for (unsigned j = 0; j < 16; ++j) { const unsigned c = xb_ld(&bar[XB_XCNT(j)]); sum += c; cnt += (c > 0u) ? 1u : 0u; mine = (j == x) ? c : mine; }
        if (sum == G) break;
        __builtin_amdgcn_s_sleep(1);
        if ((++sp & 255u) == 0u) { if (xb_ld(&bar[XB_TMO])) break; if (sp > XB_SPIN_CAP) { atomicAdd(&bar[XB_TMO], 1u); break; } }
    }
    nloc = mine > 0u ? mine : 1u; nx = cnt > 0u ? cnt : 1u;
}

__device__ __forceinline__ void xcd_barrier(const XcdBarrier& b) {
    asm volatile("s_waitcnt vmcnt(0)" ::: "memory");
    __syncthreads();
    int tid_l = (int)threadIdx.x; asm volatile("" : "+v"(tid_l));
    if (tid_l == 0) {
        unsigned* bar = b.bar;
        __builtin_amdgcn_s_waitcnt(0);
        unsigned nloc = b.st[0], nx = b.st[1];
        if (nloc == 0u) { xcd_barrier_complete(bar, b.x, nloc, nx); b.st[0] = nloc; b.st[1] = nx; }
        const unsigned old = xb_add(&bar[XB_XSUB(b.x)], 1u);
        const unsigned gen = old / nloc;
        if (old + 1u == (gen + 1u) * nloc) {
            __builtin_amdgcn_fence(__ATOMIC_RELEASE, "agent");
            asm volatile("s_waitcnt vmcnt(0)" ::: "memory");
            const unsigned og = xb_add(&bar[XB_TOP], 1u);
            const unsigned tg = og / nx;
            if (og + 1u == (tg + 1u) * nx) xb_add(&bar[XB_TOPGEN], 1u);
            else XB_SPIN(xb_ld(&bar[XB_TOPGEN]) == tg, bar);
            __builtin_amdgcn_fence(__ATOMIC_ACQUIRE, "agent");
            xb_add(&bar[XB_XGEN(b.x)], 1u);
            asm volatile("s_waitcnt vmcnt(0)" ::: "memory");
        } else {
            XB_SPIN(xb_ld(&bar[XB_XGEN(b.x)]) == gen, bar);
            __builtin_amdgcn_fence(__ATOMIC_ACQUIRE, "agent");
            asm volatile("s_waitcnt vmcnt(0)" ::: "memory");
        }
    }
    __syncthreads();
}

enum { I_X = 0, I_NORM_ATTN, I_W_IN, I_QK_GAIN, I_IDX_K_GAIN, I_DIFF_LAMBDA, I_DIFF_SUBLN, I_W_PROJ_A, I_W_PROJ_B, I_W_PROJ_C, I_W_OUT, I_NORM_FFN, I_W_GROUP, I_B_GROUP, I_W_ROUTER, I_B_ROUTER,
       I_W_E_GATE, I_W_E_UP, I_W_E_DOWN, N_INPUTS };
struct Args { const float* in[N_INPUTS]; float* out; unsigned char* ws; };

#define LDS_WAIT() asm volatile("s_waitcnt lgkmcnt(0)" ::: "memory")

__device__ __forceinline__ int perm16col(int s) { return 64 * ((s >> 5) & 3) + 16 * ((s >> 2) & 3) + 8 * (s >> 7) + 4 * ((s >> 4) & 1) + (s & 3); }
__device__ __forceinline__ int inproj_src_col(int d) {
    const int pn = d >> 8, s = d & 255;
    if (pn >= 15) return C_G + 256 * (pn - 15) + perm16col(s);
    const int u = (s >> 5) & 3, e = 32 * (s >> 7) + pg8::perm32(s & 31);
    if (pn < 8) return 256 * pn + 64 * u + e;
    if (pn == 8) { if (u == 0) return C_KI + e; if (u == 1) return e < 8 ? C_WI + e : -1; return -1; }
    return C_Q1 + 256 * (pn - 9) + 64 * u + e;
}
__device__ __forceinline__ void transpose_item(const float* W, int ldw, int K, bf16_t* WT, int drow0, int k0, int srccol, LAS float* scr, int lane) {
    const float* src = W + (size_t)k0 * ldw + (srccol >= 0 ? srccol : 0);
#pragma unroll 8
    for (int i = 0; i < 32; ++i) { const int kk = 2 * i + (lane >> 5); const float v = src[(size_t)kk * ldw]; scr[kk * 33 + (lane & 31)] = srccol >= 0 ? v : 0.f; }
    LDS_WAIT(); asm volatile("" ::: "memory");
    const int c = lane & 7;
#pragma unroll
    for (int j = 0; j < 4; ++j) { const int n = (lane >> 3) + 8 * j; const LAS float* s = scr + (8 * c) * 33 + n;
        u32x4 o; o.x = cvt_pk_bf16(s[0 * 33], s[1 * 33]); o.y = cvt_pk_bf16(s[2 * 33], s[3 * 33]); o.z = cvt_pk_bf16(s[4 * 33], s[5 * 33]); o.w = cvt_pk_bf16(s[6 * 33], s[7 * 33]);
        *(u32x4*)(WT + (size_t)(drow0 + n) * K + k0 + 8 * c) = o; }
    LDS_WAIT(); asm volatile("" ::: "memory");
}

template <bool COMBINE, bool WRITE_HN>
__device__ __forceinline__ void token_row(const float* src, float* dst, const bf16_t* y, const unsigned* rt0, const unsigned* rt1, const f32x2* rtw, const LAS int* pstart,
                                          const float* gain, bf16_t* hn, int m, int lane) {
    f32x4 v[4];
#pragma unroll
    for (int j = 0; j < 4; ++j) v[j] = ((const f32x4*)(src + (size_t)m * DM))[lane + 64 * j];
    if (COMBINE) {
        const unsigned a = rt0[m], b = rt1[m]; const f32x2 w = rtw[m];
        const size_t s0 = (size_t)(pstart[a >> 24] + (int)(a & 0xffffffu)), s1 = (size_t)(pstart[b >> 24] + (int)(b & 0xffffffu));
#pragma unroll
        for (int j = 0; j < 4; ++j) { const u32x2 p = ((const u32x2*)(y + s0 * DM))[lane + 64 * j], q = ((const u32x2*)(y + s1 * DM))[lane + 64 * j];
            v[j][0] += w[0] * bf_lo(p[0]) + w[1] * bf_lo(q[0]); v[j][1] += w[0] * bf_hi(p[0]) + w[1] * bf_hi(q[0]);
            v[j][2] += w[0] * bf_lo(p[1]) + w[1] * bf_lo(q[1]); v[j][3] += w[0] * bf_hi(p[1]) + w[1] * bf_hi(q[1]);
            ((f32x4*)(dst + (size_t)m * DM))[lane + 64 * j] = v[j]; }
    }
    if (WRITE_HN) {
        float ss = 0.f;
#pragma unroll
        for (int j = 0; j < 4; ++j) ss += (v[j][0] * v[j][0] + v[j][1] * v[j][1]) + (v[j][2] * v[j][2] + v[j][3] * v[j][3]);
        const float rstd = 1.0f / sqrtf(wave_sum(ss) * (1.0f / DM) + EPS);
#pragma unroll
        for (int j = 0; j < 4; ++j) { const f32x4 g = ((const f32x4*)gain)[lane + 64 * j]; const f32x4 o = v[j] * rstd * g;
            ((u32x2*)(hn + (size_t)m * DM))[lane + 64 * j] = (u32x2){cvt_pk_bf16(o[0], o[1]), cvt_pk_bf16(o[2], o[3])}; }
    }
}

template <bool EXPERTS> __device__ __forceinline__ void convert_weights(const Args& a, unsigned char* ws, int l, LAS unsigned char* lds, int lane, int wave, int vcu, int G, int chunk = -1);
__device__ __forceinline__ void p0_phase(const Args& a, unsigned char* ws, int l, LAS unsigned char* lds, int tid, int lane, int wave, int vcu, int G) {
    convert_weights<false>(a, ws, l, lds, lane, wave, vcu, G);
    const int gw = vcu * 8 + wave, NGW = G * 8, gt = vcu * 512 + tid, NGT = G * 512;
    if (l == 0) {
        float* cosT = (float*)(ws + WS_COS); float* sinT = (float*)(ws + WS_SIN);
        for (int idx = gt; idx < SEQ * 32; idx += NGT) { const int pos = idx >> 5, j = idx & 31;
            const float inv_freq = 1.0f / powf(10000.0f, (float)(2 * j) * (1.0f / 64.0f));
            const float ang = (float)pos * inv_freq;
            const double rev = (double)ang * 0.15915494309189533577; const float fr = (float)(rev - rint(rev));
            cosT[idx] = __builtin_amdgcn_cosf(fr); sinT[idx] = __builtin_amdgcn_sinf(fr); }
    }
    { float* wrt = (float*)(ws + WS_WRT); const float* wg = a.in[I_W_GROUP] + (size_t)l * DM * 4; const float* wr = a.in[I_W_ROUTER] + (size_t)l * DM * 32;
      const float* g2 = a.in[I_NORM_FFN] + (size_t)l * DM;
      for (int idx = gt; idx < 36 * DM; idx += NGT) { const int c = idx >> 10, k = idx & 1023; wrt[idx] = g2[k] * (c < 4 ? wg[k * 4 + c] : wr[k * 32 + (c - 4)]); } }
    const float* gain = a.in[I_NORM_ATTN] + (size_t)l * DM; bf16_t* hn = (bf16_t*)(ws + WS_HN);
    const LAS int* pstart = (const LAS int*)(lds + LX_PSTART);
    if (l == 0) { for (int m = gw; m < MTOK; m += NGW) token_row<false, true>(a.in[I_X], nullptr, nullptr, nullptr, nullptr, nullptr, pstart, gain, hn, m, lane); }
    else { for (int m = gw; m < MTOK; m += NGW) token_row<true, true>(a.out, a.out, (const bf16_t*)(ws + WS_Y), (const unsigned*)(ws + WS_RT0), (const unsigned*)(ws + WS_RT1), (const f32x2*)(ws + WS_RTW), pstart, gain, hn, m, lane); }
}

template <bool EXPERTS> __device__ __forceinline__ void convert_weights(const Args& a, unsigned char* ws, int l, LAS unsigned char* lds, int lane, int wave, int vcu, int G, int chunk) {
    LAS float* scr = (LAS float*)(lds + wave * 16384);
    int gw = vcu * 8 + wave, NGW = G * 8;
    constexpr int I_IN = 216 * 16, I_PA = 32 * 4, I_PC = 32 * 8, I_WO = 32 * 16, I_GU = 32 * 32 * 16, I_DN = 32 * 32 * 8, NIT = I_IN + 2 * I_PA + I_PC + I_WO + I_GU + I_DN;
    constexpr int I_SMALL = I_IN + 2 * I_PA + I_PC + I_WO;
    int it_end = EXPERTS ? NIT : I_SMALL;
    if (chunk >= 0) { gw = chunk * 128 + wave * 16; NGW = 1; it_end = I_SMALL + gw + 16 < NIT ? I_SMALL + gw + 16 : NIT; }
    for (int it = gw + (EXPERTS ? I_SMALL : 0); it < it_end; it += NGW) {
        int r = it; const int d31 = lane & 31;
        if (r < I_IN) { const int nb = r >> 4, kb = r & 15; transpose_item(a.in[I_W_IN] + (size_t)l * DM * D_IN, D_IN, 1024, (bf16_t*)(ws + WS_WIN), nb * 32, kb * 64, inproj_src_col(nb * 32 + d31), scr, lane); continue; } r -= I_IN;
        const int pcol = pg8::perm32(d31);
        if (r < I_PA) { const int nb = r >> 2, kb = r & 3; transpose_item(a.in[I_W_PROJ_A] + (size_t)l * 256 * DM, DM, 256, (bf16_t*)(ws + WS_WPA), nb * 32, kb * 64, ((nb * 32 + d31) & ~255) + perm16col((nb * 32 + d31) & 255), scr, lane); continue; } r -= I_PA;
        if (r < I_PA) { const int nb = r >> 2, kb = r & 3; transpose_item(a.in[I_W_PROJ_B] + (size_t)l * 256 * DM, DM, 256, (bf16_t*)(ws + WS_WPB), nb * 32, kb * 64, ((nb * 32 + d31) & ~255) + perm16col((nb * 32 + d31) & 255), scr, lane); continue; } r -= I_PA;
        if (r < I_PC) { const int nb = r >> 3, kb = r & 7; transpose_item(a.in[I_W_PROJ_C] + (size_t)l * 512 * DM, DM, 512, (bf16_t*)(ws + WS_WPC), nb * 32, kb * 64, ((nb * 32 + d31) & ~255) + perm16col((nb * 32 + d31) & 255), scr, lane); continue; } r -= I_PC;
        if (r < I_WO) { const int nb = r >> 4, kb = r & 15; transpose_item(a.in[I_W_OUT] + (size_t)l * DM * DM, DM, 1024, (bf16_t*)(ws + WS_WO), nb * 32, kb * 64, nb * 32 + pcol, scr, lane); continue; } r -= I_WO;
        if (r < I_GU) { const int e = r >> 9, rr = r & 511, nb = rr >> 4, kb = rr & 15, dd = nb * 32, pn = dd >> 8, s = dd & 255, half = s >> 7;
            const float* src = (half ? a.in[I_W_E_UP] : a.in[I_W_E_GATE]) + (size_t)(l * NEXP + e) * DM * DEXP;
            transpose_item(src, DEXP, 1024, (bf16_t*)(ws + WS_WGU) + (size_t)e * 1024 * 1024, nb * 32, kb * 64, 128 * pn + (s & 127) + pcol, scr, lane); continue; } r -= I_GU;
        { const int e = r >> 8, rr = r & 255, nb = rr >> 3, kb = rr & 7;
            transpose_item(a.in[I_W_E_DOWN] + (size_t)(l * NEXP + e) * DEXP * DM, DM, 512, (bf16_t*)(ws + WS_WD) + (size_t)e * 1024 * 512, nb * 32, kb * 64, ((nb * 32 + d31) & ~255) + perm16col((nb * 32 + d31) & 255), scr, lane); }
    }
}

__device__ __forceinline__ f32x16 mfma32(bf16x8 a, bf16x8 b, f32x16 c) { return __builtin_amdgcn_mfma_f32_32x32x16_bf16(a, b, c, 0, 0, 0); }
typedef short v4i16_t __attribute__((ext_vector_type(4)));
__device__ __forceinline__ s16x4 vtr(const LAS unsigned char* p) { return __builtin_bit_cast(s16x4, __builtin_amdgcn_ds_read_tr16_b64_v4i16((LAS v4i16_t*)p)); }
__device__ __forceinline__ int crow(int r, int hi) { return (r & 3) + 8 * (r >> 2) + 4 * hi; }
#define NEG_INF (-__builtin_inff())

__device__ __forceinline__ f32x16 splat16(float v) { f32x16 r;
#pragma unroll
    for (int i = 0; i < 16; ++i) r[i] = v;
    return r; }
__device__ __forceinline__ int kimg_off(int key, int ch) { return key * 128 + ((ch ^ ((key >> 1) & 7)) << 4); }
__device__ __forceinline__ int kdma_row(int w, int lane) { return 8 * w + (lane >> 3); }
__device__ __forceinline__ int kdma_chunk(int w, int lane) { return (lane & 7) ^ (((8 * w + (lane >> 3)) >> 1) & 7); }
struct QReg { const bf16x8 (&q)[4]; __device__ __forceinline__ bf16x8 operator()(int ks) const { return q[ks]; } };
struct QLds { const LAS unsigned char* p; __device__ __forceinline__ bf16x8 operator()(int ks) const { return *(const LAS bf16x8*)(p + ks * 1024); } };
template <int NDB, class QF, class MaskF>
__device__ __forceinline__ void flash_tile(float& m_run, float& l_run, f32x16 (&o)[NDB], const LAS unsigned char* kimg, const LAS unsigned char* vimg, const QF& qf, const MaskF& maskf, int r32, int hi, int vboff) {
    if (NDB == 4) __builtin_amdgcn_sched_barrier(0);
    f32x16 p0, p1; maskf.init(p0, p1);
#pragma unroll
    for (int ks = 0; ks < 4; ++ks) {
        const bf16x8 a0 = *(const LAS bf16x8*)(kimg + (NDB == 4 ? (2 * ks + hi) * 1024 + r32 * 16 : kimg_off(r32, 2 * ks + hi)));
        const bf16x8 a1 = *(const LAS bf16x8*)(kimg + (NDB == 4 ? (2 * ks + hi) * 1024 + 512 + r32 * 16 : kimg_off(r32, 2 * ks + hi) + 4096));
        const bf16x8 qk = qf(ks);
        p0 = mfma32(a0, qk, p0); p1 = mfma32(a1, qk, p1);
        if (NDB == 4 && (ks & 1)) __builtin_amdgcn_sched_barrier(0);
    }
    maskf(p0, p1);
    float mx = fmaxf(p0[0], p1[0]);
#pragma unroll
    for (int r = 1; r < 16; ++r) mx = fmaxf(mx, fmaxf(p0[r], p1[r]));
    mx = max_xor32(mx);
    const float mnew = fmaxf(m_run, mx);
    if (__ballot(mnew > m_run) != 0ull) {
        const float alpha = fast_exp2(m_run - mnew);
        l_run *= alpha;
#pragma unroll
        for (int db = 0; db < NDB; ++db) o[db] = o[db] * alpha;
    }
    m_run = mnew;
    float sum = 0.f;
#pragma unroll
    for (int r = 0; r < 16; ++r) { p0[r] = fast_exp2(p0[r] - mnew); p1[r] = fast_exp2(p1[r] - mnew); sum += p0[r] + p1[r]; }
    l_run += sum;
    bf16x8 pa[4];
    pa[0] = __builtin_bit_cast(bf16x8, (u32x4){cvt_pk_bf16(p0[0], p0[1]), cvt_pk_bf16(p0[2], p0[3]), cvt_pk_bf16(p0[4], p0[5]), cvt_pk_bf16(p0[6], p0[7])});
    pa[1] = __builtin_bit_cast(bf16x8, (u32x4){cvt_pk_bf16(p0[8], p0[9]), cvt_pk_bf16(p0[10], p0[11]), cvt_pk_bf16(p0[12], p0[13]), cvt_pk_bf16(p0[14], p0[15])});
    pa[2] = __builtin_bit_cast(bf16x8, (u32x4){cvt_pk_bf16(p1[0], p1[1]), cvt_pk_bf16(p1[2], p1[3]), cvt_pk_bf16(p1[4], p1[5]), cvt_pk_bf16(p1[6], p1[7])});
    pa[3] = __builtin_bit_cast(bf16x8, (u32x4){cvt_pk_bf16(p1[8], p1[9]), cvt_pk_bf16(p1[10], p1[11]), cvt_pk_bf16(p1[12], p1[13]), cvt_pk_bf16(p1[14], p1[15])});
#pragma unroll
    for (int db = 0; db < NDB; ++db)
#pragma unroll
        for (int s = 0; s < 4; ++s) {
            const s16x4 lo = vtr(vimg + vboff + db * 4096 + s * 1024), h4 = vtr(vimg + vboff + db * 4096 + s * 1024 + 512);
            const bf16x8 vt = (bf16x8){lo[0], lo[1], lo[2], lo[3], h4[0], h4[1], h4[2], h4[3]};
            o[db] = mfma32(vt, pa[s], o[db]);
            if (NDB == 4 && (s & 1)) __builtin_amdgcn_sched_barrier(0);
        }    __builtin_amdgcn_sched_barrier(0);
}
template <int NDB, class QF, class MaskF>
__device__ __forceinline__ void flash_tile_ref0(float& l_run, f32x16& lacc, f32x16 (&o)[NDB], const LAS unsigned char* kimg, const LAS unsigned char* vimg, const QF& qf, const MaskF& maskf, int r32, int hi, int vboff) {
    f32x16 p0, p1; maskf.init(p0, p1);
    bf16x8 kf[8];
#pragma unroll
    for (int ks = 0; ks < 4; ++ks) { kf[2 * ks] = *(const LAS bf16x8*)(kimg + kimg_off(r32, 2 * ks + hi)); kf[2 * ks + 1] = *(const LAS bf16x8*)(kimg + kimg_off(r32, 2 * ks + hi) + 4096); }
    __builtin_amdgcn_sched_barrier(0);
#pragma unroll
    for (int ks = 0; ks < 4; ++ks) { const bf16x8 qk = qf(ks); p0 = mfma32(kf[2 * ks], qk, p0); p1 = mfma32(kf[2 * ks + 1], qk, p1); }
    maskf(p0, p1);
    __builtin_amdgcn_sched_barrier(0);
    const bf16x8 ones = (bf16x8){0x3f80, 0x3f80, 0x3f80, 0x3f80, 0x3f80, 0x3f80, 0x3f80, 0x3f80};
#pragma unroll
    for (int r = 0; r < 16; ++r) p0[r] = fast_exp2(p0[r]);
    bf16x8 pa[4];
    pa[0] = __builtin_bit_cast(bf16x8, (u32x4){cvt_pk_bf16(p0[0], p0[1]), cvt_pk_bf16(p0[2], p0[3]), cvt_pk_bf16(p0[4], p0[5]), cvt_pk_bf16(p0[6], p0[7])});
    pa[1] = __builtin_bit_cast(bf16x8, (u32x4){cvt_pk_bf16(p0[8], p0[9]), cvt_pk_bf16(p0[10], p0[11]), cvt_pk_bf16(p0[12], p0[13]), cvt_pk_bf16(p0[14], p0[15])});
    maskf.pack(pa[0]); maskf.pack(pa[1]);
    __builtin_amdgcn_sched_barrier(0);
#pragma unroll
    for (int s = 0; s < 2; ++s) {
        lacc = mfma32(ones, pa[s], lacc);
#pragma unroll
        for (int db = 0; db < NDB; ++db) {
            const s16x4 lo = vtr(vimg + vboff + db * 4096 + s * 1024), h4 = vtr(vimg + vboff + db * 4096 + s * 1024 + 512);
            o[db] = mfma32((bf16x8){lo[0], lo[1], lo[2], lo[3], h4[0], h4[1], h4[2], h4[3]}, pa[s], o[db]);
        }
    }
#pragma unroll
    for (int r = 0; r < 16; ++r) p1[r] = fast_exp2(p1[r]);
    pa[2] = __builtin_bit_cast(bf16x8, (u32x4){cvt_pk_bf16(p1[0], p1[1]), cvt_pk_bf16(p1[2], p1[3]), cvt_pk_bf16(p1[4], p1[5]), cvt_pk_bf16(p1[6], p1[7])});
    pa[3] = __builtin_bit_cast(bf16x8, (u32x4){cvt_pk_bf16(p1[8], p1[9]), cvt_pk_bf16(p1[10], p1[11]), cvt_pk_bf16(p1[12], p1[13]), cvt_pk_bf16(p1[14], p1[15])});
    maskf.pack(pa[2]); maskf.pack(pa[3]);
    __builtin_amdgcn_sched_barrier(0);
#pragma unroll
    for (int s = 2; s < 4; ++s) {
        lacc = mfma32(ones, pa[s], lacc);
#pragma unroll
        for (int db = 0; db < NDB; ++db) {
            const s16x4 lo = vtr(vimg + vboff + db * 4096 + s * 1024), h4 = vtr(vimg + vboff + db * 4096 + s * 1024 + 512);
            o[db] = mfma32((bf16x8){lo[0], lo[1], lo[2], lo[3], h4[0], h4[1], h4[2], h4[3]}, pa[s], o[db]);
        }
    }
    __builtin_amdgcn_sched_barrier(0);
    (void)l_run;
}
template <bool KSWZ, class MaskF>
__device__ __forceinline__ void flash_tile_dual_ref0(float& l1, float& l2, f32x16 (&o1)[4], f32x16 (&o2)[4], const LAS unsigned char* k1img, const LAS unsigned char* k2img, const LAS unsigned char* vimg,
                                                     const LAS unsigned char* q1img, const LAS unsigned char* q2img, const MaskF& maskf, int r32, int hi, int vboff) {
    bf16x8 pa1[4], pa2[4];
#define DUAL_MAP_(kimg, qimg, pa, lsum) do { __builtin_amdgcn_sched_barrier(0); f32x16 p0, p1; maskf.init(p0, p1); \
        _Pragma("unroll") for (int ks = 0; ks < 4; ++ks) { const int ko = KSWZ ? kimg_off(r32, 2 * ks + hi) : (2 * ks + hi) * 1024 + r32 * 16; const bf16x8 qq = *(const LAS bf16x8*)(qimg + ks * 1024); \
            p0 = mfma32(*(const LAS bf16x8*)(kimg + ko), qq, p0); p1 = mfma32(*(const LAS bf16x8*)(kimg + ko + (KSWZ ? 4096 : 512)), qq, p1); if (ks & 1) __builtin_amdgcn_sched_barrier(0); } \
        maskf(p0, p1); float sm = 0.f; \
        _Pragma("unroll") for (int r = 0; r < 16; ++r) { p0[r] = fast_exp2(p0[r]); p1[r] = fast_exp2(p1[r]); sm += p0[r] + p1[r]; } \
        lsum += sm; \
        pa[0] = __builtin_bit_cast(bf16x8, (u32x4){cvt_pk_bf16(p0[0], p0[1]), cvt_pk_bf16(p0[2], p0[3]), cvt_pk_bf16(p0[4], p0[5]), cvt_pk_bf16(p0[6], p0[7])}); \
        pa[1] = __builtin_bit_cast(bf16x8, (u32x4){cvt_pk_bf16(p0[8], p0[9]), cvt_pk_bf16(p0[10], p0[11]), cvt_pk_bf16(p0[12], p0[13]), cvt_pk_bf16(p0[14], p0[15])}); \
        pa[2] = __builtin_bit_cast(bf16x8, (u32x4){cvt_pk_bf16(p1[0], p1[1]), cvt_pk_bf16(p1[2], p1[3]), cvt_pk_bf16(p1[4], p1[5]), cvt_pk_bf16(p1[6], p1[7])}); \
        pa[3] = __builtin_bit_cast(bf16x8, (u32x4){cvt_pk_bf16(p1[8], p1[9]), cvt_pk_bf16(p1[10], p1[11]), cvt_pk_bf16(p1[12], p1[13]), cvt_pk_bf16(p1[14], p1[15])}); } while (0)
    DUAL_MAP_(k1img, q1img, pa1, l1);
    DUAL_MAP_(k2img, q2img, pa2, l2);
#undef DUAL_MAP_
    __builtin_amdgcn_sched_barrier(0);
#pragma unroll
    for (int s = 0; s < 4; ++s) {
#pragma unroll
        for (int db = 0; db < 4; ++db) {
            const s16x4 lo = vtr(vimg + vboff + db * 4096 + s * 1024), h4 = vtr(vimg + vboff + db * 4096 + s * 1024 + 512);
            const bf16x8 vt = (bf16x8){lo[0], lo[1], lo[2], lo[3], h4[0], h4[1], h4[2], h4[3]};
            o1[db] = mfma32(vt, pa1[s], o1[db]); o2[db] = mfma32(vt, pa2[s], o2[db]);
            if (db & 1) __builtin_amdgcn_sched_barrier(0);
        }
    }
}
template <bool FAST, int NDB, class QF, class MaskF>
__device__ __forceinline__ void flash_step(float& m_run, float& l_run, f32x16& lacc, f32x16 (&o)[NDB], const LAS unsigned char* kimg, const LAS unsigned char* vimg, const QF& qf, const MaskF& maskf, int r32, int hi, int vboff) {
    if constexpr (FAST) flash_tile_ref0<NDB>(l_run, lacc, o, kimg, vimg, qf, maskf, r32, hi, vboff); else flash_tile<NDB>(m_run, l_run, o, kimg, vimg, qf, maskf, r32, hi, vboff);
}
__device__ __forceinline__ bool softmax_ref0_ok(const float* gq, const float* gk, int lane) {
    float a = fabsf(gq[lane]), b = fabsf(gk[lane]);
    a = fmaxf(a, xor_lane<1>(a)); a = fmaxf(a, xor_lane<2>(a)); a = fmaxf(a, xor_lane<4>(a)); a = fmaxf(a, xor_lane<8>(a)); a = fmaxf(a, xor_lane<16>(a)); a = max_xor32(a);
    b = fmaxf(b, xor_lane<1>(b)); b = fmaxf(b, xor_lane<2>(b)); b = fmaxf(b, xor_lane<4>(b)); b = fmaxf(b, xor_lane<8>(b)); b = fmaxf(b, xor_lane<16>(b)); b = max_xor32(b);
    return __builtin_amdgcn_readfirstlane(__builtin_bit_cast(int, a * b * (C2 * 64.0f * 1.02f))) < __builtin_bit_cast(int, 48.0f) && REF0_ENABLE;
}
#define MASK_INIT_ZERO __device__ __forceinline__ void init(f32x16& p0, f32x16& p1) const { p0 = splat16(0.f); p1 = splat16(0.f); }
#define MASK_PACK_NONE __device__ __forceinline__ void pack(bf16x8&) const {}
struct MaskNone { MASK_INIT_ZERO MASK_PACK_NONE __device__ __forceinline__ void operator()(f32x16&, f32x16&) const {} };
struct MaskCausal { int kb0, qloc, hi;
    MASK_INIT_ZERO MASK_PACK_NONE
    __device__ __forceinline__ void operator()(f32x16& p0, f32x16& p1) const {
#pragma unroll
        for (int r = 0; r < 16; ++r) { const int kv = kb0 + crow(r, hi); p0[r] = kv > qloc ? NEG_INF : p0[r]; p1[r] = kv + 32 > qloc ? NEG_INF : p1[r]; } } };
struct MaskCausalIf { bool on; int kb0, qloc, hi;
    MASK_INIT_ZERO MASK_PACK_NONE
    __device__ __forceinline__ void operator()(f32x16& p0, f32x16& p1) const { if (on) {
#pragma unroll
        for (int r = 0; r < 16; ++r) { const int kv = kb0 + crow(r, hi); p0[r] = kv > qloc ? NEG_INF : p0[r]; p1[r] = kv + 32 > qloc ? NEG_INF : p1[r]; } } } };
struct MaskLaneP { unsigned keep;
    MASK_INIT_ZERO
    __device__ __forceinline__ void operator()(f32x16&, f32x16&) const {}
    __device__ __forceinline__ void pack(bf16x8& pa) const { u32x4 v = __builtin_bit_cast(u32x4, pa); v = v & keep; pa = __builtin_bit_cast(bf16x8, v); } };
struct MaskLane { float ci;
    MASK_INIT_ZERO MASK_PACK_NONE
    __device__ __forceinline__ void operator()(f32x16& p0, f32x16& p1) const {
#pragma unroll
        for (int r = 0; r < 16; ++r) { p0[r] += ci; p1[r] += ci; } } };
template <int POS> __device__ __forceinline__ float neginf_if_bit(unsigned n) { float r; asm("v_bfe_i32 %0, %1, %2, 1\n\tv_and_b32 %0, 0xff800000, %0" : "=v"(r) : "v"(n), "n"(POS)); return r; }
struct MaskBits { unsigned n0, n1;
    __device__ __forceinline__ void init(f32x16& p0, f32x16& p1) const {
#define MB_(r) p0[r] = neginf_if_bit<((r) & 3) + 8 * ((r) >> 2)>(n0); p1[r] = neginf_if_bit<((r) & 3) + 8 * ((r) >> 2)>(n1);
        MB_(0) MB_(1) MB_(2) MB_(3) MB_(4) MB_(5) MB_(6) MB_(7) MB_(8) MB_(9) MB_(10) MB_(11) MB_(12) MB_(13) MB_(14) MB_(15)
#undef MB_
        asm volatile("s_nop 1" ::: "memory"); }
    MASK_PACK_NONE
    __device__ __forceinline__ void operator()(f32x16&, f32x16&) const {} };
__device__ __forceinline__ void dma16(const void* g, LAS unsigned char* l) { __builtin_amdgcn_global_load_lds((const unsigned*)g, (LAS unsigned*)l, 16, 0, 0); }
#define DMA_WAIT_SYNC() do { asm volatile("s_waitcnt vmcnt(0)" ::: "memory"); __syncthreads(); } while (0)

__device__ __forceinline__ void glds16(const void* gsrc, unsigned lds_dst) { unsigned keep;
    asm volatile("s_mov_b32 %0, m0\n\ts_mov_b32 m0, %2\n\ts_nop 0\n\tglobal_load_lds_dwordx4 %1, off\n\ts_mov_b32 m0, %0" : "=&s"(keep) : "v"(gsrc), "s"(lds_dst) : "memory"); }
__device__ __forceinline__ void glds4(const void* gsrc, unsigned lds_dst) { unsigned keep;
    asm volatile("s_mov_b32 %0, m0\n\ts_mov_b32 m0, %2\n\ts_nop 0\n\tglobal_load_lds_dword %1, off\n\ts_mov_b32 m0, %0" : "=&s"(keep) : "v"(gsrc), "s"(lds_dst) : "memory"); }
#define WAITV_BAR(N) asm volatile("s_waitcnt vmcnt(" #N ") lgkmcnt(0)\n\ts_barrier" ::: "memory")

template <int MODE, bool FAST>
__device__ __forceinline__ void attn_ab_unit(int b, int h, int qt, const bf16_t* qkv, bf16_t* obuf, const float* kmean, const unsigned* maskg, LAS unsigned char* lds, int tid, int lane, int w) {
    constexpr int CQ = MODE == 0 ? C_QA : C_QB, CK = MODE == 0 ? C_KA : C_KB, CV = MODE == 0 ? C_VA : C_VB;
    constexpr int NS = 4, D = 3, SLOT = 16384;
    const int r32 = lane & 31, hi = lane >> 5;
    const size_t rowbase = (size_t)b * SEQ; const int q0 = 256 * qt, qloc = 32 * w + r32; const size_t qrow = rowbase + q0 + qloc;
    const unsigned lds0 = (unsigned)(size_t)lds;
    LAS float* kml = (LAS float*)(lds + 73728); LAS unsigned* mwl = (LAS unsigned*)(lds + 65536);
    bf16x8 qf[4];
#pragma unroll
    for (int ks = 0; ks < 4; ++ks) qf[ks] = *(const bf16x8*)(qkv + qrow * QP + CQ + 64 * h + 16 * ks + 8 * hi);
    const bf16_t* ksrc = qkv + (rowbase + kdma_row(w, lane)) * QP + CK + 64 * h + 8 * kdma_chunk(w, lane);
    const bf16_t* vsrc = qkv + (rowbase + 16 * (w & 3) + (lane >> 2)) * QP + CV + 64 * h + 32 * (w >> 2) + 8 * (lane & 3);
    const unsigned* msrc = maskg + qrow * 128 + hi;
    const int NT = 4 * qt + 4, wlim = 4 * qt + (w >> 1);
    const unsigned kdst0 = (unsigned)__builtin_amdgcn_readfirstlane(lds0 + w * 1024), mdst0 = (unsigned)__builtin_amdgcn_readfirstlane(lds0 + 65536 + w * 256);
    __syncthreads();
#pragma unroll
    for (int d = 0; d < D; ++d) { const int t = d < NT ? d : NT - 1;
        glds16(ksrc + (size_t)t * 64 * QP, kdst0 + d * SLOT); glds16(vsrc + (size_t)t * 64 * QP, kdst0 + d * SLOT + 8192);
        if (MODE == 1) glds4(msrc + 2 * t, mdst0 + d * 2048); }
    unsigned selbits = 0;
    if (MODE == 0) {
        if (tid < 256) ((LAS f32x4*)kml)[tid] = ((const f32x4*)(kmean + (size_t)((b * 4 + h) * 16) * 64))[tid];
        __syncthreads();
        if (qt > 0) {
            float qv[32];
#pragma unroll
            for (int ks = 0; ks < 4; ++ks) { const u32x4 qq = __builtin_bit_cast(u32x4, qf[ks]);
#pragma unroll
                for (int k = 0; k < 4; ++k) { qv[8 * ks + 2 * k] = bf_lo(qq[k]); qv[8 * ks + 2 * k + 1] = bf_hi(qq[k]); } }
            float v1 = NEG_INF, v2 = NEG_INF, v3 = NEG_INF; int i1 = -1, i2 = -1, i3 = -1;
#pragma unroll 1
            for (int j = 0; j < qt; ++j) {
                float g = 0.f;
#pragma unroll
                for (int ks = 0; ks < 4; ++ks) { const f32x4 k0 = *(const LAS f32x4*)(kml + j * 64 + 16 * ks + 8 * hi), k1 = *(const LAS f32x4*)(kml + j * 64 + 16 * ks + 8 * hi + 4);
                    g += qv[8 * ks + 0] * k0[0] + qv[8 * ks + 1] * k0[1] + qv[8 * ks + 2] * k0[2] + qv[8 * ks + 3] * k0[3] + qv[8 * ks + 4] * k1[0] + qv[8 * ks + 5] * k1[1] + qv[8 * ks + 6] * k1[2] + qv[8 * ks + 7] * k1[3]; }
                g = sum_xor32(g);
                if (g > v1) { v3 = v2; i3 = i2; v2 = v1; i2 = i1; v1 = g; i1 = j; }
                else if (g > v2) { v3 = v2; i3 = i2; v2 = g; i2 = j; }
                else if (g > v3) { v3 = g; i3 = j; }
            }
            if (i1 >= 0) selbits |= 1u << i1; if (i2 >= 0) selbits |= 1u << i2; if (i3 >= 0) selbits |= 1u << i3;
        }
    }
    const int vboff = (4 * hi + ((lane & 15) >> 2)) * 64 + ((lane >> 4) & 1) * 32 + (lane & 3) * 8;
    float m_run = -1e30f, l_run = 0.f; f32x16 o[2], lacc = splat16(0.f); o[0] = splat16(0.f); o[1] = splat16(0.f);
    int scur = 0, siss = D;
    asm volatile("s_waitcnt vmcnt(0)" ::: "memory");
    asm volatile("" : "+v"(qf[0]), "+v"(qf[1]), "+v"(qf[2]), "+v"(qf[3]));
#pragma unroll 1
    for (int kt = 0; kt < NT; ++kt) {
        if (MODE == 1) WAITV_BAR(6); else WAITV_BAR(4);
        { const int t = kt + D < NT ? kt + D : NT - 1;
          glds16(ksrc + (size_t)t * 64 * QP, kdst0 + siss * SLOT); glds16(vsrc + (size_t)t * 64 * QP, kdst0 + siss * SLOT + 8192);
          if (MODE == 1) glds4(msrc + 2 * t, mdst0 + siss * 2048); }
        const LAS unsigned char* cur = lds + scur * SLOT;
        if (MODE == 0) {
            const int j = kt >> 2;
            if (j < qt) { const bool sel = (selbits >> j) & 1u; if (__ballot(sel) != 0ull) { if (FAST) flash_step<FAST, 2>(m_run, l_run, lacc, o, cur, cur + 8192, QReg{qf}, MaskLaneP{sel ? 0xffffffffu : 0u}, r32, hi, vboff); else flash_step<FAST, 2>(m_run, l_run, lacc, o, cur, cur + 8192, QReg{qf}, MaskLane{sel ? 0.f : NEG_INF}, r32, hi, vboff); } }
            else { const int kb0 = 64 * (kt & 3); if (kb0 <= 32 * w + 31) flash_step<FAST, 2>(m_run, l_run, lacc, o, cur, cur + 8192, QReg{qf}, MaskCausal{kb0, qloc, hi}, r32, hi, vboff); }
        } else {
            if (kt <= wlim) { const LAS unsigned* mp = mwl + scur * 512 + w * 64; const unsigned cw0 = mp[r32], cw1 = mp[32 + r32];
                flash_step<FAST, 2>(m_run, l_run, lacc, o, cur, cur + 8192, QReg{qf}, MaskBits{~cw0 >> (4 * hi), ~cw1 >> (4 * hi)}, r32, hi, vboff); }
        }
        scur = scur + 1 == NS ? 0 : scur + 1; siss = siss + 1 == NS ? 0 : siss + 1;
    }
    asm volatile("s_waitcnt vmcnt(0)" ::: "memory");
    const float inv = 1.0f / (FAST ? lacc[0] : sum_xor32(l_run));
    bf16_t* orow = obuf + qrow * 256 + 64 * h;
#pragma unroll
    for (int db = 0; db < 2; ++db)
#pragma unroll
        for (int g = 0; g < 4; ++g)
            *(u32x2*)(orow + 32 * db + 8 * g + 4 * hi) = (u32x2){cvt_pk_bf16(o[db][4 * g] * inv, o[db][4 * g + 1] * inv), cvt_pk_bf16(o[db][4 * g + 2] * inv, o[db][4 * g + 3] * inv)};
}

template <bool FAST>
__device__ __forceinline__ void attn_c_unit(int b, int h, int qt, const bf16_t* qkv, bf16_t* oc, float lam, const float* subg, float coef, LAS unsigned char* lds, int tid, int lane, int w) {
    const int r32 = lane & 31, hi = lane >> 5;
    const size_t rowbase = (size_t)b * SEQ; const int q0 = 256 * qt, qloc = 32 * w + r32; const size_t qrow = rowbase + q0 + qloc;
    LAS unsigned char* qimg = lds + 65536 + w * 8192 + lane * 16;
    __syncthreads();
#pragma unroll
    for (int ks = 0; ks < 4; ++ks) { *(LAS bf16x8*)(qimg + ks * 1024) = *(const bf16x8*)(qkv + qrow * QP + C_Q1 + 64 * h + 16 * ks + 8 * hi); *(LAS bf16x8*)(qimg + 4096 + ks * 1024) = *(const bf16x8*)(qkv + qrow * QP + C_Q2 + 64 * h + 16 * ks + 8 * hi); }
    const bf16_t* k1src = FAST ? qkv + (rowbase + kdma_row(w, lane)) * QP + C_K1 + 64 * h + 8 * kdma_chunk(w, lane)
                               : qkv + (rowbase + lane) * QP + C_K1 + 64 * h + 8 * w;
    const bf16_t* k2src = k1src + (C_K2 - C_K1);
    const bf16_t* v0src = qkv + (rowbase + 16 * (w & 3) + (lane >> 2)) * QP + C_VC + 128 * h + 32 * (w >> 2) + 8 * (lane & 3);
    const bf16_t* v1src = v0src + 64;
    const int vboff = (4 * hi + ((lane & 15) >> 2)) * 64 + ((lane >> 4) & 1) * 32 + (lane & 3) * 8;
    const int NT = 4 * qt + 4;
    float m1 = -1e30f, l1 = 0.f, m2 = -1e30f, l2 = 0.f; f32x16 o1[4], o2[4];
#pragma unroll
    for (int i = 0; i < 4; ++i) { o1[i] = splat16(0.f); o2[i] = splat16(0.f); }
    dma16(k1src, lds + w * 1024); dma16(k2src, lds + 8192 + w * 1024); dma16(v0src, lds + 16384 + w * 1024); dma16(v1src, lds + 16384 + 8192 + w * 1024);
    DMA_WAIT_SYNC();
#pragma unroll 1
    for (int kt = 0; kt < NT; ++kt) {
        LAS unsigned char* cur = lds + (kt & 1) * 32768; LAS unsigned char* nxt = lds + ((kt + 1) & 1) * 32768;
        if (kt + 1 < NT) { const size_t adv = (size_t)(kt + 1) * 64 * QP;
            dma16(k1src + adv, nxt + w * 1024); dma16(k2src + adv, nxt + 8192 + w * 1024); dma16(v0src + adv, nxt + 16384 + w * 1024); dma16(v1src + adv, nxt + 16384 + 8192 + w * 1024); }
        const bool band = kt >= 4 * qt; const int kb0 = 64 * (kt & 3);
        if (!band || kb0 <= 32 * w + 31) { const MaskCausalIf mk{band, kb0, qloc, hi};
            if (FAST) flash_tile_dual_ref0<true>(l1, l2, o1, o2, cur, cur + 8192, cur + 16384, qimg, qimg + 4096, mk, r32, hi, vboff);
            else { flash_step<false, 4>(m1, l1, o1[0], o1, cur, cur + 16384, QLds{qimg}, mk, r32, hi, vboff); flash_step<false, 4>(m2, l2, o2[0], o2, cur + 8192, cur + 16384, QLds{qimg + 4096}, mk, r32, hi, vboff); } }
        DMA_WAIT_SYNC();
    }
    const float i1 = 1.0f / sum_xor32(l1), i2 = lam / sum_xor32(l2);
    float ss = 0.f;
#pragma unroll
    for (int db = 0; db < 4; ++db) { o1[db] = o1[db] * i1 - o2[db] * i2;
#pragma unroll
        for (int r = 0; r < 16; ++r) ss += o1[db][r] * o1[db][r]; }
    ss = sum_xor32(ss);
    const float rn = coef / sqrtf(ss * (1.0f / 128.0f) + EPS);
    bf16_t* orow = oc + qrow * 512 + 128 * h;
#pragma unroll
    for (int db = 0; db < 4; ++db)
#pragma unroll
        for (int g = 0; g < 4; ++g) { const int d = 32 * db + 8 * g + 4 * hi; const f32x4 gg = *(const f32x4*)(subg + d);
            *(u32x2*)(orow + d) = (u32x2){cvt_pk_bf16(o1[db][4 * g] * rn * gg[0], o1[db][4 * g + 1] * rn * gg[1]), cvt_pk_bf16(o1[db][4 * g + 2] * rn * gg[2], o1[db][4 * g + 3] * rn * gg[3])}; }
}

__device__ __forceinline__ void index_unit(int b, int i64, const bf16_t* qkv, unsigned* maskg, unsigned char* scr, LAS unsigned char* lds, int tid, int lane, int w) {
    constexpr int NS = 5, D = 4, HS = 257, RING = 84224, TOFF = 65792, TROW = 144;
    const int r32 = lane & 31, hi = lane >> 5;
    const unsigned lds0 = (unsigned)(size_t)lds;
    LAS unsigned* hist = (LAS unsigned*)lds; LAS unsigned char* ring = lds + RING; LAS unsigned char* mb8 = lds;
    LAS int* thrB1 = (LAS int*)(lds + 125184); LAS int* thrRem = thrB1 + 64; LAS int* thrT = thrB1 + 128; LAS int* thrNeed = thrB1 + 192;
    const size_t rowbase = (size_t)b * SEQ; const int q0 = 64 * i64, NT = i64 + 1;
    __syncthreads();
    {
        const int hh = 4 * ((r32 >> 3) & 1) + (r32 & 3), qp = 2 * (r32 >> 4) + ((r32 >> 2) & 1);
        bf16x8 aq[2][4]; float wv[2][2][8];
#pragma unroll
        for (int rb = 0; rb < 2; ++rb) {
            const size_t row = rowbase + q0 + 8 * w + 4 * rb + qp;
#pragma unroll
            for (int ks = 0; ks < 4; ++ks) aq[rb][ks] = *(const bf16x8*)(qkv + row * QP + C_QI + 64 * hh + 16 * ks + 8 * hi);
#pragma unroll
            for (int hf = 0; hf < 2; ++hf) { const u32x4 ww = *(const u32x4*)(qkv + (rowbase + q0 + 8 * w + 4 * rb + 2 * hf + hi) * QP + C_WI);
#pragma unroll
                for (int k = 0; k < 4; ++k) { wv[rb][hf][2 * k] = bf_lo(ww[k]); wv[rb][hf][2 * k + 1] = bf_hi(ww[k]); } }
        }
#pragma unroll
        for (int rb = 0; rb < 2; ++rb) { asm volatile("" : "+v"(aq[rb][0]), "+v"(aq[rb][1]), "+v"(aq[rb][2]), "+v"(aq[rb][3]));
#pragma unroll
            for (int hf = 0; hf < 2; ++hf) asm volatile("" : "+v"(wv[rb][hf][0]), "+v"(wv[rb][hf][1]), "+v"(wv[rb][hf][2]), "+v"(wv[rb][hf][3]), "+v"(wv[rb][hf][4]), "+v"(wv[rb][hf][5]), "+v"(wv[rb][hf][6]), "+v"(wv[rb][hf][7])); }
        const bf16_t* ksrc = qkv + (rowbase + kdma_row(w, lane)) * QP + C_KI + 8 * kdma_chunk(w, lane);
        const unsigned kdst0 = (unsigned)__builtin_amdgcn_readfirstlane(lds0 + RING + w * 1024);
#pragma unroll
        for (int d = 0; d < D; ++d) { const int t = d < NT ? d : NT - 1; glds16(ksrc + (size_t)t * 64 * QP, kdst0 + d * 8192); }
        for (int i = tid; i < 4112; i += 512) ((LAS u32x4*)hist)[i] = (u32x4){0u, 0u, 0u, 0u};
        asm volatile("s_waitcnt lgkmcnt(0)" ::: "memory");
        int scur = 0, siss = D;
#pragma unroll 1
        for (int kt = 0; kt <= NT; ++kt) {
            if (kt < NT) WAITV_BAR(3); else { asm volatile("s_waitcnt vmcnt(0)" ::: "memory"); __syncthreads(); }
            if (kt > 0) {
                const u32x4 kk = *(const LAS u32x4*)(lds + TOFF + ((kt - 1) & 1) * 9216 + lane * TROW + w * 16);
                {
                    const u32x4 ks = *(const LAS u32x4*)(lds + TOFF + ((kt - 1) & 1) * 9216 + (8 * w + (lane >> 3)) * TROW + (lane & 7) * 16);
                    unsigned char* sp = scr + (size_t)(8 * w + (lane >> 3)) * 8192 + (size_t)(kt - 1) * 128 + (lane & 7) * 16;
                    if (kt < NT) asm volatile("global_store_dwordx4 %0, %1, off" :: "v"(sp), "v"(ks) : "memory");
                    else *(u32x4*)sp = ks; }
#pragma unroll
                for (int k = 0; k < 4; ++k) { const unsigned a = kk[k] & 0xffffu, c = kk[k] >> 16;
                    if (a) __hip_atomic_fetch_add(&hist[lane * HS + (a >> 8)], 1u, __ATOMIC_RELAXED, __HIP_MEMORY_SCOPE_WORKGROUP);
                    if (c) __hip_atomic_fetch_add(&hist[lane * HS + (c >> 8)], 1u, __ATOMIC_RELAXED, __HIP_MEMORY_SCOPE_WORKGROUP); }
            }
            if (kt == NT) break;
            { const int t = kt + D < NT ? kt + D : NT - 1; glds16(ksrc + (size_t)t * 64 * QP, kdst0 + siss * 8192); }
            const LAS unsigned char* kimg = ring + scur * 8192;
            const bool diag = kt == NT - 1;
#pragma unroll
            for (int rb = 0; rb < 2; ++rb)
#pragma unroll
                for (int kb = 0; kb < 2; ++kb) {
                    f32x16 d = splat16(0.f);
#pragma unroll
                    for (int ks = 0; ks < 4; ++ks) d = mfma32(aq[rb][ks], *(const LAS bf16x8*)(kimg + kimg_off(32 * kb + r32, 2 * ks + hi)), d);
#pragma unroll
                    for (int hf = 0; hf < 2; ++hf) {
                        float sc = 0.f;
#pragma unroll
                        for (int t = 0; t < 8; ++t) sc += wv[rb][hf][t] * fmaxf(d[8 * hf + t], 0.f);
                        const int ql = 8 * w + 4 * rb + 2 * hf + hi;
                        const unsigned u = (unsigned)__builtin_bit_cast(unsigned short, (_Float16)sc);
                        unsigned key = u ^ ((u & 0x8000u) ? 0xffffu : 0x8000u);
                        if (diag && 32 * kb + r32 > ql) key = 0u;
                        *(LAS unsigned short*)(lds + TOFF + (kt & 1) * 9216 + ql * TROW + (32 * kb + r32) * 2) = (unsigned short)key;
                    }
                }
            scur = scur + 1 == NS ? 0 : scur + 1; siss = siss + 1 == NS ? 0 : siss + 1;
        }
        asm volatile("s_waitcnt vmcnt(0)" ::: "memory");
        __syncthreads();
    }
#define IDX_SEARCH(STAGE) do { _Pragma("unroll 1") for (int qq = 0; qq < 8; ++qq) { const int q = 8 * w + qq; int target; \
        if (STAGE == 0) { if (q0 + q + 1 <= 256) { if (lane == 0) { thrB1[q] = 0x10000; thrRem[q] = 0; } continue; } target = 256; } \
        else { if (thrB1[q] == 0x10000) { if (lane == 0) { thrT[q] = 0; thrNeed[q] = 0; } continue; } target = thrRem[q]; } \
        const LAS unsigned* hp = hist + q * HS + 4 * lane; const int h0 = (int)hp[0], h1 = (int)hp[1], h2 = (int)hp[2], h3 = (int)hp[3]; \
        int P = h0 + h1 + h2 + h3; const int s_ = P; \
        _Pragma("unroll") for (int o = 1; o < 64; o <<= 1) { const int t_ = lane_val(P, (lane - o) & 63); if (lane >= o) P += t_; } \
        const int above = __builtin_amdgcn_readlane(P, 63) - P; (void)s_; \
        const int c3 = above + h3, c2 = c3 + h2, c1 = c2 + h1, c0 = c1 + h0; int bin = -1, ab = 0; \
        if (above < target && c3 >= target) { bin = 4 * lane + 3; ab = above; } else if (c3 < target && c2 >= target) { bin = 4 * lane + 2; ab = c3; } \
        else if (c2 < target && c1 >= target) { bin = 4 * lane + 1; ab = c2; } else if (c1 < target && c0 >= target) { bin = 4 * lane; ab = c1; } \
        if (bin >= 0) { if (STAGE == 0) { thrB1[q] = bin; thrRem[q] = target - ab; } else { thrT[q] = (thrB1[q] << 8) | bin; thrNeed[q] = target - ab; } } } \
        __syncthreads(); } while (0)
    IDX_SEARCH(0);
    const int qs = 8 * w + (lane >> 3), pc = lane & 7;
    const unsigned char* rrow = scr + (size_t)qs * 8192 + pc * 16;
    {
        __builtin_amdgcn_fence(__ATOMIC_ACQUIRE, "agent");
        asm volatile("s_waitcnt vmcnt(0)" ::: "memory");
        const int b1 = thrB1[qs];
        for (int i = tid; i < 4112; i += 512) ((LAS u32x4*)hist)[i] = (u32x4){0u, 0u, 0u, 0u};
        __syncthreads();
#pragma unroll 4
        for (int it = 0; it < NT; ++it) { const u32x4 kk = *(const u32x4*)(rrow + (size_t)it * 128);
#pragma unroll
            for (int k = 0; k < 4; ++k) { const unsigned a = kk[k] & 0xffffu, c = kk[k] >> 16;
                if ((int)(a >> 8) == b1) __hip_atomic_fetch_add(&hist[qs * HS + (a & 255u)], 1u, __ATOMIC_RELAXED, __HIP_MEMORY_SCOPE_WORKGROUP);
                if ((int)(c >> 8) == b1) __hip_atomic_fetch_add(&hist[qs * HS + (c & 255u)], 1u, __ATOMIC_RELAXED, __HIP_MEMORY_SCOPE_WORKGROUP); } }
        __syncthreads();
    }
    IDX_SEARCH(1);
    {
        const unsigned T = (unsigned)thrT[qs]; const int need = thrNeed[qs]; int tc = 0;
        __syncthreads();
#pragma unroll 2
        for (int it = 0; it < NT; ++it) { const u32x4 kk = *(const u32x4*)(rrow + (size_t)it * 128);
            unsigned sel = 0, eq = 0;
#pragma unroll
            for (int k = 0; k < 4; ++k) { const unsigned a = kk[k] & 0xffffu, c = kk[k] >> 16;
                sel |= (a > T ? 1u : 0u) << (2 * k); sel |= (c > T ? 1u : 0u) << (2 * k + 1); eq |= (a == T ? 1u : 0u) << (2 * k); eq |= (c == T ? 1u : 0u) << (2 * k + 1); }
            if (T == 0u) eq = 0u;
            if (__ballot(eq != 0u) != 0ull) {
                const int n = __popc(eq); int P = n;
#pragma unroll
                for (int o = 1; o < 8; o <<= 1) { const int t_ = lane_val(P, (lane - o) & 63); if ((lane & 7) >= o) P += t_; }
                int allow = need - tc - (P - n);
#pragma unroll
                for (int k = 0; k < 8; ++k) if (((eq >> k) & 1u) && allow > 0) { sel |= 1u << k; --allow; }
                tc += lane_val(P, (lane & ~7) + 7);
            }
            mb8[qs * 512 + it * 8 + pc] = (unsigned char)sel;
        }
        __syncthreads();
    }
#undef IDX_SEARCH
    for (int idx = tid; idx < 64 * 2 * NT; idx += 512) { const int q = idx / (2 * NT), wd = idx - q * 2 * NT; maskg[(rowbase + q0 + q) * 128 + wd] = ((const LAS unsigned*)mb8)[q * 128 + wd]; }
}

__device__ __forceinline__ int next_unit(unsigned* ctr, LAS unsigned char* lds, int tid) {
    volatile LAS int* bc = (volatile LAS int*)(lds + LX_BC);
    __syncthreads();
    if (tid == 0) *bc = (int)__hip_atomic_fetch_add(ctr, 1u, __ATOMIC_RELAXED, __HIP_MEMORY_SCOPE_AGENT);
    __syncthreads();
    return __builtin_amdgcn_readfirstlane(*bc);
}

__device__ __forceinline__ void m1_phase(const Args& a, unsigned char* ws, int lc, LAS unsigned char* lds, int lane, int wave, int vcu, int G) {
    const int l = lc & 1;
    const float* wrt = (const float*)(ws + WS_WRT);
    const float* bg = a.in[I_B_GROUP] + l * 4; const float* br = a.in[I_B_ROUTER] + l * 32;
    unsigned* cnt = (unsigned*)(ws + WS_CTL) + CW_CNT + 2048 * lc;
    unsigned* rt0 = (unsigned*)(ws + WS_RT0); unsigned* rt1 = (unsigned*)(ws + WS_RT1); f32x2* rtw = (f32x2*)(ws + WS_RTW);
    int* tokl = (int*)(ws + WS_TOKL); bf16_t* xg = (bf16_t*)(ws + WS_XG); float* rstdg = (float*)(ws + WS_RSTD); const float* gain = a.in[I_NORM_FFN] + (size_t)l * DM;
    const int r32 = lane & 31, kh = lane >> 5, wq = wave & 3, kpart = wave >> 2;
    LAS float* tl = (LAS float*)(lds + wq * 8192);
    LAS float* tss = tl + 32 * 40;
    LAS float* xs = (LAS float*)(lds + 32768 + wave * 8704);
#pragma unroll 1
    for (int t = wq * G + vcu; t < MTOK / 32; t += 4 * G) {
        const float* xbase = a.out + (size_t)(32 * t + (lane >> 4)) * DM + 512 * kpart + 4 * (lane & 15);
        bf16_t* xobase = xg + (size_t)(32 * t + (lane >> 4)) * DM + 512 * kpart + 4 * (lane & 15); const float* gbase = gain + 512 * kpart + 4 * (lane & 15);
        const float* wp0 = wrt + (size_t)r32 * DM + 512 * kpart + 4 * kh; const float* wp1 = wrt + (size_t)(32 + (r32 & 3)) * DM + 512 * kpart + 4 * kh;
        f32x16 d0 = splat16(0.f), d1 = splat16(0.f); float ss = 0.f;
        f32x4 xr[8];
#pragma unroll
        for (int j = 0; j < 8; ++j) xr[j] = *(const f32x4*)(xbase + (size_t)(4 * j) * DM);
#pragma unroll 1
        for (int c = 0; c < 8; ++c) {
            const f32x4 g4 = *(const f32x4*)(gbase + 64 * c);
#pragma unroll
            for (int j = 0; j < 8; ++j) { *(LAS f32x4*)(xs + (4 * j + (lane >> 4)) * 68 + 4 * (lane & 15)) = xr[j];
                const f32x4 o = xr[j] * g4; *(u32x2*)(xobase + (size_t)(4 * j) * DM + 64 * c) = (u32x2){cvt_pk_bf16(o[0], o[1]), cvt_pk_bf16(o[2], o[3])}; }
            if (c < 7) {
#pragma unroll
                for (int j = 0; j < 8; ++j) xr[j] = *(const f32x4*)(xbase + (size_t)(4 * j) * DM + 64 * (c + 1)); }
            LDS_WAIT(); asm volatile("" ::: "memory");
#pragma unroll
            for (int mm = 0; mm < 8; ++mm) {
                const f32x4 xa = *(const LAS f32x4*)(xs + r32 * 68 + 8 * mm + 4 * kh), b0 = *(const f32x4*)(wp0 + 64 * c + 8 * mm), b1 = *(const f32x4*)(wp1 + 64 * c + 8 * mm);
                ss += (xa[0] * xa[0] + xa[1] * xa[1]) + (xa[2] * xa[2] + xa[3] * xa[3]);
#pragma unroll
                for (int i = 0; i < 4; ++i) { d0 = __builtin_amdgcn_mfma_f32_32x32x2f32(xa[i], b0[i], d0, 0, 0, 0); d1 = __builtin_amdgcn_mfma_f32_32x32x2f32(xa[i], b1[i], d1, 0, 0, 0); }
            }
            LDS_WAIT(); asm volatile("" ::: "memory");
        }
        ss = sum_xor32(ss);
        if (kpart == 1) {
#pragma unroll
            for (int r = 0; r < 16; ++r) { tl[crow(r, kh) * 40 + r32] = d0[r]; if (r32 < 4) tl[crow(r, kh) * 40 + 32 + r32] = d1[r]; }
            if (kh == 0) tss[r32] = ss;
        }
        __syncthreads();
        if (kpart == 0) {
#pragma unroll
            for (int r = 0; r < 16; ++r) { tl[crow(r, kh) * 40 + r32] += d0[r]; if (r32 < 4) tl[crow(r, kh) * 40 + 32 + r32] += d1[r]; }
            ss += tss[r32];
            LDS_WAIT(); asm volatile("" ::: "memory");
            const float rstd = 1.0f / sqrtf(ss * (1.0f / DM) + EPS);
            const LAS float* my = tl + r32 * 40;
            float gl[4];
#pragma unroll
            for (int c = 0; c < 4; ++c) gl[c] = my[c] * rstd + bg[c];
            int g = 0; float gm = gl[0];
#pragma unroll
            for (int c = 1; c < 4; ++c) if (gl[c] > gm) { gm = gl[c]; g = c; }
            float den = 0.f;
#pragma unroll
            for (int c = 0; c < 4; ++c) den += __expf(gl[c] - gm);
            const float gwt = 1.0f / den;
            float le[8];
#pragma unroll
            for (int e = 0; e < 8; ++e) le[e] = my[4 + 8 * g + e] * rstd + br[8 * g + e];
            int i1 = 0; float v1 = le[0];
#pragma unroll
            for (int e = 1; e < 8; ++e) if (le[e] > v1) { v1 = le[e]; i1 = e; }
            int i2 = -1; float v2 = NEG_INF;
#pragma unroll
            for (int e = 0; e < 8; ++e) if (e != i1 && le[e] > v2) { v2 = le[e]; i2 = e; }
            const float ex = __expf(v2 - v1), w1 = 1.0f / (1.0f + ex), w2 = ex * w1;
            if (kh == 0) { const int e0 = g * 8 + i1, e1 = g * 8 + i2, m = 32 * t + r32;
                const unsigned r0 = atomicAdd(cnt + 64 * e0, 1u), r1 = atomicAdd(cnt + 64 * e1, 1u);
                rt0[m] = ((unsigned)e0 << 24) | r0; rt1[m] = ((unsigned)e1 << 24) | r1; rtw[m] = (f32x2){gwt * w1, gwt * w2};
                tokl[e0 * 32768 + (int)r0] = m; tokl[e1 * 32768 + (int)r1] = m; }
            if (kh == 0) rstdg[32 * t + r32] = rstd;
        }
        __syncthreads();
    }
}
__device__ __forceinline__ void moe_tables(const unsigned* cnt, const int* tokl, const float* rstdg, LAS unsigned char* lds, int tid, int c, int G) {
    LAS int* pstart = (LAS int*)(lds + LX_PSTART); LAS int* blk2e = (LAS int*)(lds + LX_BLK2E); LAS int* cntl = (LAS int*)(lds + LX_CNT); LAS int* tok = (LAS int*)(lds + LX_TOK);
    if (tid < 64) {
        const int cn = tid < NEXP ? (int)cnt[64 * tid] : 0, nb = (cn + 255) >> 8;
        int P = nb;
#pragma unroll
        for (int o = 1; o < 64; o <<= 1) { const int t = lane_val(P, (tid - o) & 63); if (tid >= o) P += t; }
        const int pb = P - nb;
        if (tid <= NEXP) pstart[tid] = pb * 256;
        if (tid < NEXP) cntl[tid] = cn;
        if (tid == NEXP) *(LAS int*)(lds + LX_NBLK) = pb < MAXBLK ? pb : MAXBLK;
#pragma unroll 1
        for (int k = 0; k < nb; ++k) if (pb + k < MAXBLK) blk2e[pb + k] = tid;
    }
    __syncthreads();
    const int nblk = *(const LAS int*)(lds + LX_NBLK), rbs = G / 4;
    LAS float* rst = (LAS float*)(lds + LX_RST);
    for (int k = 0; k < 6; ++k) { const int rb = c / 4 + k * rbs; if (rb >= nblk) break;
        const int e = blk2e[rb], r = rb * 256 - pstart[e] + (tid & 255);
        if (tid < 256) { const int tk = r < cntl[e] ? tokl[e * 32768 + r] : 0; tok[k * 256 + tid] = tk; rst[k * 256 + tid] = rstdg[tk]; } }
    __syncthreads();
}

#ifndef PHASES
#define PHASES 0xFFFF
#endif
#define PH(n) if constexpr (((PHASES) >> (n)) & 1)
#ifndef REPEAT_MASK
#define REPEAT_MASK 0
#endif
#define REP(k) for (int rep_ = 0; rep_ < 1 + (((REPEAT_MASK) >> (k)) & 1); ++rep_)
#ifndef GEMM_ALIGN
#define GEMM_ALIGN true
#endif
#ifndef GEMM_SP2
#define GEMM_SP2 true
#endif
#define PHASE_ENV() unsigned long long wsi_ = (unsigned long long)args.ws; int G = (int)gridDim.x, bx = (int)blockIdx.x; asm volatile("" : "+s"(wsi_), "+s"(G), "+s"(bx)); \
    unsigned char* const ws = (unsigned char*)(GAS unsigned char*)wsi_; const int vcu = (G % 8 == 0) ? (bx % 8) * (G / 8) + bx / 8 : bx;   \
    int tid = (int)threadIdx.x; asm volatile("" : "+v"(tid)); const int lane = tid & 63, wave = __builtin_amdgcn_readfirstlane(tid >> 6); \
    unsigned* const ctl = (unsigned*)(ws + WS_CTL); bf16_t* const QKV = (bf16_t*)(ws + WS_QKV); unsigned char* const SG = ws + WS_SG; unsigned* const MASK = (unsigned*)(ws + WS_MASK); float* const KMEAN = (float*)(ws + WS_KMEAN); \
    (void)lane; (void)wave; (void)ctl; (void)QKV; (void)SG; (void)MASK; (void)KMEAN; (void)vcu
#define GRID_BAR() do { unsigned long long wb_ = (unsigned long long)args.ws; asm volatile("" : "+s"(wb_)); XcdBarrier b_ = bar0; b_.bar = (unsigned*)((GAS unsigned char*)wb_ + WS_CTL) + CW_BAR; asm volatile("" : "+s"(b_.x)); xcd_barrier(b_); if (((REPEAT_MASK) >> 12) & 1) xcd_barrier(b_); } while (0)


template <int L> __device__ __forceinline__ void layer_body(const Args& args, LAS unsigned char* lds, const XcdBarrier& bar0) {
    constexpr int l = L;

        PH(0) for (int rep_ = 0; rep_ < 1 + ((((REPEAT_MASK) >> 0) & 1) && l == 0); ++rep_) { PHASE_ENV(); p0_phase(args, ws, l, lds, tid, lane, wave, vcu, G); }
        GRID_BAR();
        PH(1) REP(1) { PHASE_ENV();
            pg8::Gemm g{(const bf16_t*)(ws + WS_HN), (const bf16_t*)(ws + WS_WIN), MTOK, NT_IN * 256, DM}; pg8::StaticOrder S; S.init(MTOK, NT_IN * 256, G, bx);
            pg8::EpiInProj E{QKV, SG, (const float*)(ws + WS_COS), (const float*)(ws + WS_SIN), args.in[I_QK_GAIN] + l * 6 * 64, args.in[I_IDX_K_GAIN] + l * 64};
            pg8::gemm_phase<pg8::EpiInProj, pg8::StaticOrder, GEMM_ALIGN, GEMM_SP2>(lds, g, S, E);
        }
        GRID_BAR();
        { PHASE_ENV();
            LAS float* red = (LAS float*)lds;
            for (int it = bx; it < NBATCH * 4 * 16; it += G) { const int b = it >> 6, h = (it >> 4) & 3, blk = it & 15, d = tid & 63, rg = tid >> 6;
                const bf16_t* kp = QKV + ((size_t)b * SEQ + blk * 256 + rg * 32) * QP + C_KA + 64 * h + d; float s = 0.f;
#pragma unroll 8
                for (int r = 0; r < 32; ++r) s += __builtin_bit_cast(float, (unsigned)kp[(size_t)r * QP] << 16);
                __syncthreads(); red[tid] = s; __syncthreads();
                if (tid < 64) { float t = 0.f;
#pragma unroll
                    for (int k = 0; k < 8; ++k) t += red[k * 64 + tid];
                    KMEAN[(size_t)it * 64 + tid] = t * (1.0f / 256.0f); } }
            __syncthreads();
        }
        PH(2) REP(2) { PHASE_ENV();
            const float* dl = args.in[I_DIFF_LAMBDA] + l * 256;
            const float lam_init = 0.8f - 0.6f * __expf(-0.3f * (float)l);
            const float lam = __expf(wave_sum(dl[lane] * dl[64 + lane])) - __expf(wave_sum(dl[128 + lane] * dl[192 + lane])) + lam_init;
            const float* subg = args.in[I_DIFF_SUBLN] + l * 128;
            unsigned* qc = ctl + CW_QUEUE + 64 * (l * 4 + 0 + 8 * rep_);
            const float* qkg = args.in[I_QK_GAIN] + l * 6 * 64;
            if (softmax_ref0_ok(qkg + 4 * 64, qkg + 5 * 64, lane)) { for (;;) { const int u = next_unit(qc, lds, tid); if (u >= 512) break; const int r = u & 31; attn_c_unit<true>(r >> 2, r & 3, 15 - (u >> 5), QKV, (bf16_t*)(ws + WS_OC), lam, subg, 1.0f - lam_init, lds, tid, lane, wave); } }
            else { for (;;) { const int u = next_unit(qc, lds, tid); if (u >= 512) break; const int r = u & 31; attn_c_unit<false>(r >> 2, r & 3, 15 - (u >> 5), QKV, (bf16_t*)(ws + WS_OC), lam, subg, 1.0f - lam_init, lds, tid, lane, wave); } }
        }
        PH(3) REP(3) { PHASE_ENV();
            unsigned* qi = ctl + CW_QUEUE + 64 * (l * 4 + 1 + 8 * rep_);
            for (;;) { const int u = next_unit(qi, lds, tid); if (u >= 512) break; index_unit(u & 7, 63 - (u >> 3), QKV, MASK, ws + WS_WGU + (size_t)bx * 524288, lds, tid, lane, wave); }
        }
        GRID_BAR();
        PH(4) REP(4) { PHASE_ENV();
            unsigned* qa = ctl + CW_QUEUE + 64 * (l * 4 + 2 + 8 * rep_);
            const float* qkg = args.in[I_QK_GAIN] + l * 6 * 64;
            if (softmax_ref0_ok(qkg, qkg + 64, lane)) { for (;;) { const int u = next_unit(qa, lds, tid); if (u >= 512) break; const int r = u & 31; attn_ab_unit<0, true>(r >> 2, r & 3, 15 - (u >> 5), QKV, (bf16_t*)(ws + WS_OA), KMEAN, MASK, lds, tid, lane, wave); } }
            else { for (;;) { const int u = next_unit(qa, lds, tid); if (u >= 512) break; const int r = u & 31; attn_ab_unit<0, false>(r >> 2, r & 3, 15 - (u >> 5), QKV, (bf16_t*)(ws + WS_OA), KMEAN, MASK, lds, tid, lane, wave); } }
        }
        PH(5) REP(5) { PHASE_ENV();
            unsigned* qb = ctl + CW_QUEUE + 64 * (l * 4 + 3 + 8 * rep_);
            const float* qkg = args.in[I_QK_GAIN] + l * 6 * 64;
            if (softmax_ref0_ok(qkg + 2 * 64, qkg + 3 * 64, lane)) { for (;;) { const int u = next_unit(qb, lds, tid); if (u >= 512) break; const int r = u & 31; attn_ab_unit<1, true>(r >> 2, r & 3, 15 - (u >> 5), QKV, (bf16_t*)(ws + WS_OB), KMEAN, MASK, lds, tid, lane, wave); } }
            else { for (;;) { const int u = next_unit(qb, lds, tid); if (u >= 512) break; const int r = u & 31; attn_ab_unit<1, false>(r >> 2, r & 3, 15 - (u >> 5), QKV, (bf16_t*)(ws + WS_OB), KMEAN, MASK, lds, tid, lane, wave); } }
        }
        { PHASE_ENV();
            unsigned* qw = ctl + CW_QUEUE + 64 * (16 + l);
            for (;;) { const int c = next_unit(qw, lds, tid); if (c >= (32 * 32 * 16 + 32 * 32 * 8) / 128) break; convert_weights<true>(args, ws, l, lds, lane, wave, vcu, G, c); }
        }
        GRID_BAR();
        PH(6) REP(6) {
            { PHASE_ENV(); pg8::StaticOrder S; S.init(MTOK, DM, G, bx); pg8::Gemm g{(const bf16_t*)(ws + WS_OA), (const bf16_t*)(ws + WS_WPA), MTOK, DM, 256}; pg8::EpiMerge<0> E{(bf16_t*)(ws + WS_MERGED), SG}; pg8::gemm_phase<pg8::EpiMerge<0>, pg8::StaticOrder, GEMM_ALIGN, GEMM_SP2>(lds, g, S, E); }
            { PHASE_ENV(); pg8::StaticOrder S; S.init(MTOK, DM, G, bx); pg8::Gemm g{(const bf16_t*)(ws + WS_OB), (const bf16_t*)(ws + WS_WPB), MTOK, DM, 256}; pg8::EpiMerge<1> E{(bf16_t*)(ws + WS_MERGED), SG}; pg8::gemm_phase<pg8::EpiMerge<1>, pg8::StaticOrder, GEMM_ALIGN, GEMM_SP2>(lds, g, S, E); }
            { PHASE_ENV(); pg8::StaticOrder S; S.init(MTOK, DM, G, bx); pg8::Gemm g{(const bf16_t*)(ws + WS_OC), (const bf16_t*)(ws + WS_WPC), MTOK, DM, 512}; pg8::EpiMerge<2> E{(bf16_t*)(ws + WS_MERGED), SG}; pg8::gemm_phase<pg8::EpiMerge<2>, pg8::StaticOrder, GEMM_ALIGN, GEMM_SP2>(lds, g, S, E); }
        }
        GRID_BAR();
        PH(7) for (int rep_ = 0; rep_ < 1 + ((((REPEAT_MASK) >> 7) & 1) && l == 0); ++rep_) { PHASE_ENV();
            pg8::Gemm g{(const bf16_t*)(ws + WS_MERGED), (const bf16_t*)(ws + WS_WO), MTOK, DM, DM}; pg8::StaticOrder S; S.init(MTOK, DM, G, bx);
            pg8::EpiResid E{l == 0 ? args.in[I_X] : args.out, args.out};
            pg8::gemm_phase<pg8::EpiResid, pg8::StaticOrder, GEMM_ALIGN, GEMM_SP2>(lds, g, S, E);
        }
        GRID_BAR();
        PH(8) REP(8) { PHASE_ENV(); m1_phase(args, ws, l + 2 * rep_, lds, lane, wave, vcu, G); }
        GRID_BAR();
        { PHASE_ENV(); moe_tables(ctl + CW_CNT + 2048 * (l + 2 * (((REPEAT_MASK) >> 8) & 1)), (const int*)(ws + WS_TOKL), (const float*)(ws + WS_RSTD), lds, tid, vcu, G); }
        PH(10) REP(10) { PHASE_ENV();
            const int nblk = *(const LAS int*)(lds + LX_NBLK);
            pg8::Gemm g{(const bf16_t*)(ws + WS_XG), (const bf16_t*)(ws + WS_WGU), MTOK, NEXP * 1024, DM};
            pg8::MoeOrder S{nblk * 4, G, vcu, (const LAS int*)(lds + LX_BLK2E)};
            pg8::EpiGateUp E{(bf16_t*)(ws + WS_HID), (const LAS float*)(lds + LX_RST), G / 4}; pg8::AMapMoe AM{(const LAS int*)(lds + LX_TOK), G / 4};
            pg8::gemm_phase<pg8::EpiGateUp, pg8::MoeOrder, GEMM_ALIGN, GEMM_SP2, pg8::AMapMoe>(lds, g, S, E, AM);
        }
        GRID_BAR();
        PH(11) REP(11) { PHASE_ENV();
            const int nblk = *(const LAS int*)(lds + LX_NBLK);
            pg8::Gemm g{(const bf16_t*)(ws + WS_HID), (const bf16_t*)(ws + WS_WD), MAXBLK * 256, NEXP * 1024, DEXP};
            pg8::MoeOrder S{nblk * 4, G, vcu, (const LAS int*)(lds + LX_BLK2E)};
            pg8::EpiDown E{(bf16_t*)(ws + WS_Y)};
            pg8::gemm_phase<pg8::EpiDown, pg8::MoeOrder, GEMM_ALIGN, GEMM_SP2>(lds, g, S, E);
        }
        GRID_BAR();
    }

__global__ void __launch_bounds__(512, 2) fwd_kernel(Args args) {
    extern __shared__ __attribute__((aligned(16))) unsigned char lds_raw[];
    LAS unsigned char* lds = (LAS unsigned char*)lds_raw;
    for (int u = threadIdx.x; u < (LDS_BYTES - LDSX) / 4; u += 512) ((LAS unsigned*)(lds + LDSX))[u] = 0u;
    __syncthreads();
    const XcdBarrier bar0 = xcd_barrier_post((unsigned*)(args.ws + WS_CTL) + CW_BAR, (volatile LAS unsigned*)(lds + LX_BAR));
    layer_body<0>(args, lds, bar0);
    layer_body<1>(args, lds, bar0);
    { PHASE_ENV();
        const int gw = vcu * 8 + wave, NGW = G * 8; const LAS int* pstart = (const LAS int*)(lds + LX_PSTART);
        for (int m = gw; m < MTOK; m += NGW) token_row<true, false>(args.out, args.out, (const bf16_t*)(ws + WS_Y), (const unsigned*)(ws + WS_RT0), (const unsigned*)(ws + WS_RT1), (const f32x2*)(ws + WS_RTW), pstart, nullptr, nullptr, m, lane);
    }
}

extern "C" void kernel_launch(void* const* d_in, const int* in_sizes, int n_in, void* d_out, int out_size, void* d_ws, size_t ws_size, hipStream_t stream) {
    static int grid = 0;
    if (grid == 0) {
        if (n_in != N_INPUTS || in_sizes[0] != MTOK * DM || out_size != MTOK * DM || ws_size < WS_END) {
            fprintf(stderr, "kernel_launch: built for %d inputs, x/out of %d floats, >= %zu bytes of workspace; got n_in %d, in0 %d, out %d, ws %zu; nothing launched\n", (int)N_INPUTS, MTOK * DM, (size_t)WS_END, n_in, n_in > 0 ? in_sizes[0] : -1, out_size, ws_size);
            grid = -1; return; }
        int dev = 0, cus = 0;
        if (hipGetDevice(&dev) != hipSuccess || hipDeviceGetAttribute(&cus, hipDeviceAttributeMultiprocessorCount, dev) != hipSuccess) { fprintf(stderr, "kernel_launch: device query failed\n"); grid = -1; return; }
        if (hipFuncSetAttribute((const void*)fwd_kernel, hipFuncAttributeMaxDynamicSharedMemorySize, LDS_BYTES) != hipSuccess) { fprintf(stderr, "kernel_launch: hipFuncSetAttribute failed\n"); grid = -1; return; }
        int per_cu = 0;
        if (hipOccupancyMaxActiveBlocksPerMultiprocessor(&per_cu, (const void*)fwd_kernel, 512, LDS_BYTES) != hipSuccess || per_cu < 1) fprintf(stderr, "kernel_launch: note: occupancy query reports %d workgroups per CU\n", per_cu);
        (void)hipGetLastError();
        grid = cus;
    }
    if (grid < 0) return;
    if (hipMemsetAsync((char*)d_ws + WS_CTL, 0, CTL_BYTES, stream) != hipSuccess) { fprintf(stderr, "kernel_launch: memset failed\n"); return; }
    Args a{};
    for (int i = 0; i < N_INPUTS; ++i) a.in[i] = (const float*)d_in[i];
    a.out = (float*)d_out; a.ws = (unsigned char*)d_ws;
    hipLaunchKernelGGL(fwd_kernel, dim3(grid), dim3(512), LDS_BYTES, stream, a);
    const hipError_t le = hipPeekAtLastError();
    if (le != hipSuccess) fprintf(stderr, "kernel_launch: launch failed: %s\n", hipGetErrorName(le));
}
```

```cpp
#include <hip/hip_runtime.h>
#include <cstdio>
#include <cstdint>

#define LAS __attribute__((address_space(3)))
#define GAS __attribute__((address_space(1)))
typedef unsigned short bf16_t;
typedef short bf16x8 __attribute__((ext_vector_type(8)));
typedef short s16x4 __attribute__((ext_vector_type(4)));
typedef float f32x4 __attribute__((ext_vector_type(4)));
typedef float f32x2 __attribute__((ext_vector_type(2)));
typedef float f32x16 __attribute__((ext_vector_type(16)));
typedef unsigned u32x4 __attribute__((ext_vector_type(4)));
typedef unsigned u32x2 __attribute__((ext_vector_type(2)));

constexpr int NBATCH = 8, SEQ = 4096, MTOK = NBATCH * SEQ, DM = 1024, NLAYER = 2;
constexpr int QP = 3656;
constexpr int C_QA = 0, C_KA = 256, C_VA = 512, C_QB = 768, C_KB = 1024, C_VB = 1280, C_QI = 1536, C_KI = 2048, C_WI = 2112,
              C_Q1 = 2120, C_Q2 = 2376, C_K1 = 2632, C_K2 = 2888, C_VC = 3144, C_G = 3656, D_IN = 6728;
constexpr int NT_IN = 27;
constexpr int NEXP = 32, DEXP = 512, MAXBLK = 288;
constexpr float C2 = 0.125f * 1.4426950408889634f;
constexpr float EPS = 1e-6f;
#ifndef REF0_ENABLE
#define REF0_ENABLE 1
#endif

constexpr size_t MiB = 1u << 20;
constexpr size_t WS_CTL = 0, CTL_BYTES = 1 * MiB;
constexpr size_t WS_COS = 1 * MiB, WS_SIN = WS_COS + 512 * 1024;
constexpr size_t WS_SMALL = 2 * MiB;
constexpr size_t WS_KMEAN = WS_SMALL, WS_RT0 = WS_SMALL + 256 * 1024, WS_RT1 = WS_SMALL + 384 * 1024, WS_RTW = WS_SMALL + 512 * 1024, WS_WRT = WS_SMALL + 768 * 1024;
constexpr size_t WS_WIN = 3 * MiB;
constexpr size_t WS_WPA = 17 * MiB, WS_WPB = WS_WPA + 512 * 1024, WS_WPC = 18 * MiB;
constexpr size_t WS_WO = 19 * MiB;
constexpr size_t WS_WGU = 21 * MiB;
constexpr size_t WS_WD = 85 * MiB;
constexpr size_t WS_HN = 117 * MiB;
constexpr size_t WS_OA = WS_HN, WS_OB = WS_HN + 16 * MiB, WS_OC = WS_HN + 32 * MiB;
constexpr size_t WS_QKV = 181 * MiB;
constexpr size_t WS_MERGED = WS_QKV, WS_Y = WS_QKV, WS_HID = WS_QKV + 144 * MiB;
constexpr size_t WS_XG = WS_QKV, WS_TOKL = WS_QKV + 64 * MiB, WS_RSTD = WS_QKV + 68 * MiB;
constexpr size_t WS_SG = 410 * MiB;
constexpr size_t WS_MASK = 506 * MiB;
constexpr size_t WS_END = 522 * MiB;
static_assert((size_t)MTOK * QP * 2 <= 229 * MiB && (size_t)MAXBLK * 256 * 1024 * 2 <= 144 * MiB && (size_t)MAXBLK * 256 * 512 * 2 <= 72 * MiB, "ws map");
constexpr int CW_BAR = 4096;
constexpr int CW_QUEUE = 8192;
constexpr int CW_CNT = 16384;

constexpr int LDSX = 131072;
constexpr int LX_BAR = LDSX, LX_BC = LDSX + 16, LX_NBLK = LDSX + 32, LX_PSTART = LDSX + 64, LX_BLK2E = LDSX + 256, LX_CNT = LDSX + 1536, LX_TOK = LDSX + 2048, LX_RST = LDSX + 2048 + 6144;
constexpr int LDS_BYTES = 147456;

typedef __bf16 bf16x2_t __attribute__((ext_vector_type(2)));
__device__ __forceinline__ unsigned cvt_pk_bf16(float lo, float hi) { const f32x2 v = {lo, hi}; const bf16x2_t b = __builtin_convertvector(v, bf16x2_t); return __builtin_bit_cast(unsigned, b); }
__device__ __forceinline__ float bf_lo(unsigned w) { return __builtin_bit_cast(float, w << 16); }
__device__ __forceinline__ float bf_hi(unsigned w) { return __builtin_bit_cast(float, w & 0xffff0000u); }
template <int M> __device__ __forceinline__ float xor_lane(float v) {
    return __builtin_bit_cast(float, __builtin_amdgcn_ds_swizzle(__builtin_bit_cast(int, v), (M << 10) | 0x1f)); }
__device__ __forceinline__ float sum_xor32(float v) {
    const unsigned u = __builtin_bit_cast(unsigned, v); const auto rr = __builtin_amdgcn_permlane32_swap(u, u, false, false);
    return __builtin_bit_cast(float, (unsigned)rr[0]) + __builtin_bit_cast(float, (unsigned)rr[1]); }
__device__ __forceinline__ float max_xor32(float v) {
    const unsigned u = __builtin_bit_cast(unsigned, v); const auto rr = __builtin_amdgcn_permlane32_swap(u, u, false, false);
    return fmaxf(__builtin_bit_cast(float, (unsigned)rr[0]), __builtin_bit_cast(float, (unsigned)rr[1])); }
__device__ __forceinline__ int lane_val(int v, int src_lane) { return __builtin_amdgcn_ds_bpermute(src_lane << 2, v); }
__device__ __forceinline__ float wave_sum(float v) {
    v += xor_lane<1>(v); v += xor_lane<2>(v); v += xor_lane<4>(v); v += xor_lane<8>(v); v += xor_lane<16>(v);
    return sum_xor32(v);
}
__device__ __forceinline__ float fast_exp2(float x) { return __builtin_amdgcn_exp2f(x); }
__device__ __forceinline__ float fast_rcp(float x) { return __builtin_amdgcn_rcpf(x); }

namespace pg8 {
#define PG8_LAS __attribute__((address_space(3)))
typedef unsigned short bf16_t;
typedef short bf16x8 __attribute__((ext_vector_type(8)));
typedef float f32x4 __attribute__((ext_vector_type(4)));
typedef unsigned u32x4 __attribute__((ext_vector_type(4)));
constexpr int BM = 256, BK = 64, HALF = 128, HTB = HALF * BK * 2  , STAGE_BYTES = 8 * HTB, NXCD = 8, WGM = 8;

__host__ __device__ __forceinline__ int lds_byte(int r, int c) { const int st = (r >> 4) * 2 + (c >> 5), rr = r & 15, cc = c & 31, ob = rr * 64 + cc * 2; return st * 1024 + (ob ^ (((ob >> 9) & 1) << 5)); }
__host__ __device__ __forceinline__ void stage_rc(int b, int& R, int& C) { const int st = b / 1024, sb = b % 1024, swz = sb ^ (((sb >> 9) & 1) << 5); R = (st >> 1) * 16 + swz / 64; C = (st & 1) * 32 + (swz % 64) / 2; }
__host__ __device__ __forceinline__ int perm32(int rho) { const int n = rho >> 4, i = rho & 15; return 8 * (i >> 2) + 4 * n + (i & 3); }
struct Unit { int pm, pn; };
struct Gemm { const bf16_t* A; const bf16_t* Bt; int M, N, K; };

struct StaticOrder {
    int nM, nN, nwg, G, c;
    __host__ __device__ void init(int M, int N, int G_, int c_) { nM = M / BM; nN = N / BM; nwg = nM * nN; G = G_; c = c_; }
    __host__ __device__ bool next(int i, Unit& u) const {
        const long L = (long)i * G + c; if (L >= nwg) return false;
        int wgid = (int)L; { const int q = nwg / NXCD, r = nwg % NXCD, xcd = wgid % NXCD, off = wgid / NXCD; wgid = (xcd < r ? xcd * (q + 1) : r * (q + 1) + (xcd - r) * q) + off; }
        const int nig = WGM * nN, gid = wgid / nig, fm = gid * WGM, gsz = (nM - fm) < WGM ? (nM - fm) : WGM;
        u.pm = fm + ((wgid % nig) % gsz); u.pn = (wgid % nig) / gsz; return true;
    }
    __device__ __forceinline__ void a_ready(const Unit&) const {}
    __device__ __forceinline__ void done(const Unit&) const {}
};


struct EpiInProj {
    static constexpr bool PERM = false, AFTER_DRAIN = false;
    bf16_t* qkv; unsigned char* sg; const float* cosT; const float* sinT; const float* qkg; const float* ikg;
    __device__ __forceinline__ void operator()(const f32x4 (&acc)[2][2][4][2], const Unit& u, int wr, int wc, int fr, int fq) const {
        const int pn = u.pn, row0 = u.pm * BM + wr * 64 + fr;
        if (pn >= 15) {
            unsigned char* base = sg + (size_t)row0 * 3072 + (pn - 15) * 256 + wc * 64 + fq * 16;
#pragma unroll
            for (int ai = 0; ai < 2; ++ai)
#pragma unroll
                for (int m = 0; m < 4; ++m) {
                    unsigned w[2][2];
#pragma unroll
                    for (int bj = 0; bj < 2; ++bj)
#pragma unroll
                        for (int n = 0; n < 2; ++n) { unsigned pk = 0;
#pragma unroll
                            for (int i = 0; i < 4; i += 2) { const float x0 = fminf(fmaxf(acc[ai][bj][m][n][i], -30.f), 30.f), x1 = fminf(fmaxf(acc[ai][bj][m][n][i + 1], -30.f), 30.f);
                                const float a = 1.0f + fast_exp2(-1.4426950408889634f * x0), b = 1.0f + fast_exp2(-1.4426950408889634f * x1), r = 255.0f * fast_rcp(a * b);
                                pk = __builtin_amdgcn_cvt_pk_u8_f32(floorf(b * r + 0.5f), i, pk); pk = __builtin_amdgcn_cvt_pk_u8_f32(floorf(a * r + 0.5f), i + 1, pk); }
                            w[bj][n] = pk; }
                    *(u32x4*)(base + (size_t)(ai * HALF + m * 16) * 3072) = (u32x4){w[0][0], w[0][1], w[1][0], w[1][1]};
                }
            return;
        }
        int type = 0, gi = 0; bool qscale = false;
        int ocol = (pn < 8 ? 256 * pn : C_Q1 + 256 * (pn - 9)) + 64 * wc;
        switch (pn) {
            case 0: type = 2; gi = 0; qscale = true; break;
            case 1: type = 2; gi = 1; break;
            case 3: type = 2; gi = 2; qscale = true; break;
            case 4: type = 2; gi = 3; break;
            case 6: case 7: type = 1; break;
            case 8: if (wc == 0) { type = 2; ocol = C_KI; } else if (wc == 1) { type = 3; ocol = C_WI; } else type = 4; break;
            case 9: case 10: type = 2; gi = 4; qscale = true; break;
            case 11: case 12: type = 2; gi = 5; break;
            default: type = 0; break;
        }
        if (type == 4) return;
        if (type == 3) {
            if (fq == 0) {
#pragma unroll
                for (int ai = 0; ai < 2; ++ai)
#pragma unroll
                    for (int m = 0; m < 4; ++m) { const f32x4 a = acc[ai][0][m][0] * 0.35355339059327373f, b = acc[ai][0][m][1] * 0.35355339059327373f;
                        *(u32x4*)(qkv + (size_t)(row0 + ai * HALF + m * 16) * QP + C_WI) = (u32x4){cvt_pk_bf16(a[0], a[1]), cvt_pk_bf16(a[2], a[3]), cvt_pk_bf16(b[0], b[1]), cvt_pk_bf16(b[2], b[3])}; }
            }
            return;
        }
        const float* gp = (pn == 8) ? ikg : qkg + 64 * gi;
        if (type == 2) { if (qscale) body<2, true>(acc, row0, ocol, gp, fq); else body<2, false>(acc, row0, ocol, gp, fq); }
        else if (type == 1) body<1, false>(acc, row0, ocol, gp, fq);
        else body<0, false>(acc, row0, ocol, gp, fq);
    }
    template <int TYPE, bool QS>
    __device__ __forceinline__ void body(const f32x4 (&acc)[2][2][4][2], int row0, int ocol, const float* gp, int fq) const {
#pragma unroll
        for (int ai = 0; ai < 2; ++ai)
#pragma unroll
            for (int m = 0; m < 4; ++m) {
                const int row = row0 + ai * HALF + m * 16;
                f32x4 x[2][2];
#pragma unroll
                for (int bj = 0; bj < 2; ++bj)
#pragma unroll
                    for (int n = 0; n < 2; ++n) x[bj][n] = acc[ai][bj][m][n];
                if (TYPE == 2) {
                    float ss = 0.f;
#pragma unroll
                    for (int bj = 0; bj < 2; ++bj)
#pragma unroll
                        for (int n = 0; n < 2; ++n) ss += (x[bj][n][0] * x[bj][n][0] + x[bj][n][1] * x[bj][n][1]) + (x[bj][n][2] * x[bj][n][2] + x[bj][n][3] * x[bj][n][3]);
                    ss += xor_lane<16>(ss); ss = sum_xor32(ss);
                    const float inv = (QS ? C2 : 1.0f) / sqrtf(ss * (1.0f / 64.0f) + EPS);
#pragma unroll
                    for (int bj = 0; bj < 2; ++bj)
#pragma unroll
                        for (int n = 0; n < 2; ++n) x[bj][n] = x[bj][n] * inv * *(const f32x4*)(gp + 32 * bj + 8 * fq + 4 * n);
                }
                if (TYPE >= 1) {
                    const int pos = row & (SEQ - 1);
#pragma unroll
                    for (int n = 0; n < 2; ++n) {
                        const f32x4 c = *(const f32x4*)(cosT + pos * 32 + 8 * fq + 4 * n), s = *(const f32x4*)(sinT + pos * 32 + 8 * fq + 4 * n);
                        const f32x4 a = x[0][n], b = x[1][n];
                        x[0][n] = a * c - b * s; x[1][n] = b * c + a * s;
                    }
                }
#pragma unroll
                for (int bj = 0; bj < 2; ++bj)
                    *(u32x4*)(qkv + (size_t)row * QP + ocol + 32 * bj + 8 * fq) = (u32x4){cvt_pk_bf16(x[bj][0][0], x[bj][0][1]), cvt_pk_bf16(x[bj][0][2], x[bj][0][3]), cvt_pk_bf16(x[bj][1][0], x[bj][1][1]), cvt_pk_bf16(x[bj][1][2], x[bj][1][3])};
                asm volatile("" ::: "memory");
            }
    }
};

template <int BR> struct EpiMerge {
    static constexpr bool PERM = false, AFTER_DRAIN = false;
    bf16_t* merged; const unsigned char* sg;
    __device__ __forceinline__ void operator()(const f32x4 (&acc)[2][2][4][2], const Unit& u, int wr, int wc, int fr, int fq) const {
        const int row0 = u.pm * BM + wr * 64 + fr, col0 = u.pn * BM + wc * 64 + fq * 16;
#pragma unroll
        for (int ai = 0; ai < 2; ++ai)
#pragma unroll
            for (int m = 0; m < 4; ++m) { const size_t row = (size_t)(row0 + ai * HALF + m * 16);
                const u32x4 gq = *(const u32x4*)(sg + row * 3072 + BR * 1024 + col0);
                bf16_t* mp = merged + row * 1024 + col0;
                float v[16];
#pragma unroll
                for (int bj = 0; bj < 2; ++bj)
#pragma unroll
                    for (int n = 0; n < 2; ++n)
#pragma unroll
                        for (int i = 0; i < 4; ++i) v[8 * bj + 4 * n + i] = acc[ai][bj][m][n][i] * ((float)((gq[2 * bj + n] >> (8 * i)) & 255u) * (1.0f / 255.0f));
                if (BR > 0) { const u32x4 o0 = *(const u32x4*)mp, o1 = *(const u32x4*)(mp + 8);
#pragma unroll
                    for (int k = 0; k < 4; ++k) { v[2 * k] += bf_lo(o0[k]); v[2 * k + 1] += bf_hi(o0[k]); v[8 + 2 * k] += bf_lo(o1[k]); v[8 + 2 * k + 1] += bf_hi(o1[k]); } }
                *(u32x4*)mp = (u32x4){cvt_pk_bf16(v[0], v[1]), cvt_pk_bf16(v[2], v[3]), cvt_pk_bf16(v[4], v[5]), cvt_pk_bf16(v[6], v[7])};
                *(u32x4*)(mp + 8) = (u32x4){cvt_pk_bf16(v[8], v[9]), cvt_pk_bf16(v[10], v[11]), cvt_pk_bf16(v[12], v[13]), cvt_pk_bf16(v[14], v[15])};
                asm volatile("" ::: "memory"); }
    }
};

struct EpiResid {
    static constexpr bool PERM = false, AFTER_DRAIN = false;
    const float* res; float* out;
    __device__ __forceinline__ void operator()(const f32x4 (&acc)[2][2][4][2], const Unit& u, int wr, int wc, int fr, int fq) const {
        const int row0 = u.pm * BM + wr * 64 + fr, col0 = u.pn * BM + wc * 32 + fq * 8;
#pragma unroll
        for (int ai = 0; ai < 2; ++ai)
#pragma unroll
            for (int m = 0; m < 4; ++m) { const size_t off = (size_t)(row0 + ai * HALF + m * 16) * 1024 + col0;
#pragma unroll
                for (int bj = 0; bj < 2; ++bj)
#pragma unroll
                    for (int n = 0; n < 2; ++n) { const f32x4 r = *(const f32x4*)(res + off + bj * HALF + 4 * n); *(f32x4*)(out + off + bj * HALF + 4 * n) = r + acc[ai][bj][m][n]; }
                if (m & 1) asm volatile("" ::: "memory"); }
    }
};

struct EpiGateUp {
    static constexpr bool PERM = false, AFTER_DRAIN = false;
    bf16_t* hid; const PG8_LAS float* rst; int rbs;
    __device__ __forceinline__ void operator()(const f32x4 (&acc)[2][2][4][2], const Unit& u, int wr, int wc, int fr, int fq) const {
        const int row0 = u.pm * BM + wr * 64 + fr, col0 = (u.pn & 3) * HALF + wc * 32 + fq * 8;
        const PG8_LAS float* rs = rst + (u.pm / rbs) * 256 + wr * 64 + fr;
#pragma unroll
        for (int ai = 0; ai < 2; ++ai)
#pragma unroll
            for (int m = 0; m < 4; ++m) { float v[8]; const float r = rs[ai * HALF + m * 16];
#pragma unroll
                for (int n = 0; n < 2; ++n)
#pragma unroll
                    for (int i = 0; i < 4; ++i) { const float gt = acc[ai][0][m][n][i] * r, up = acc[ai][1][m][n][i] * r; v[4 * n + i] = gt * fast_rcp(1.0f + fast_exp2(-1.4426950408889634f * gt)) * up; }
                *(u32x4*)(hid + (size_t)(row0 + ai * HALF + m * 16) * DEXP + col0) = (u32x4){cvt_pk_bf16(v[0], v[1]), cvt_pk_bf16(v[2], v[3]), cvt_pk_bf16(v[4], v[5]), cvt_pk_bf16(v[6], v[7])}; }
    }
};

struct EpiDown {
    static constexpr bool PERM = false, AFTER_DRAIN = false;
    bf16_t* y;
    __device__ __forceinline__ void operator()(const f32x4 (&acc)[2][2][4][2], const Unit& u, int wr, int wc, int fr, int fq) const {
        const int row0 = u.pm * BM + wr * 64 + fr, col0 = (u.pn & 3) * BM + wc * 64 + fq * 16;
#pragma unroll
        for (int ai = 0; ai < 2; ++ai)
#pragma unroll
            for (int m = 0; m < 4; ++m) { bf16_t* yp = y + (size_t)(row0 + ai * HALF + m * 16) * 1024 + col0;
#pragma unroll
                for (int bj = 0; bj < 2; ++bj) { const f32x4 a = acc[ai][bj][m][0], b = acc[ai][bj][m][1];
                    *(u32x4*)(yp + 8 * bj) = (u32x4){cvt_pk_bf16(a[0], a[1]), cvt_pk_bf16(a[2], a[3]), cvt_pk_bf16(b[0], b[1]), cvt_pk_bf16(b[2], b[3])}; } }
    }
};

struct AMapMoe { static constexpr bool GATHER = true; const PG8_LAS int* tok; int rbs;
    __device__ __forceinline__ unsigned row(const Unit& u, int R) const { return (unsigned)tok[(u.pm / rbs) * 256 + R]; } };
struct MoeOrder {
    int nunits, G, c; const PG8_LAS int* blk2e;
    __device__ __forceinline__ bool next(int i, Unit& u) const { const int L = i * G + c; if (L >= nunits) return false; const int rb = L >> 2; u.pm = rb; u.pn = blk2e[rb] * 4 + (L & 3); return true; }
    __device__ __forceinline__ void a_ready(const Unit&) const {}
    __device__ __forceinline__ void done(const Unit&) const {}
};

struct NoAMap { static constexpr bool GATHER = false; __device__ __forceinline__ unsigned row(const Unit&, int) const { return 0u; } };
template <class Epi, class Sched, bool ALIGN_EPI = false, bool SP2 = false, class AMap = NoAMap>
__device__ __forceinline__ void gemm_phase(PG8_LAS unsigned char* lds, const Gemm g, const Sched& S, const Epi& E, const AMap& AM = AMap()) {
    static_assert(!AMap::GATHER || SP2, "the row gather is wired into the SP2 loop only");
    int tid_l = (int)threadIdx.x; asm volatile("" : "+v"(tid_l));
    const int tid = tid_l, wid = __builtin_amdgcn_readfirstlane(tid >> 6), lane = tid & 63, wr = wid >> 2, wc = wid & 3, fr = lane & 15, fq = lane >> 4;
    const int K = g.K, nt = K / BK;
    unsigned voffA[2], voffB[2];
#pragma unroll
    for (int i = 0; i < 2; ++i) { int R, C; stage_rc(tid * 16 + i * 8192, R, C); const int Rb = Epi::PERM ? ((R & ~31) + perm32(R & 31)) : R;
        voffA[i] = (unsigned)(R * K + C) * 2u; voffB[i] = (unsigned)(Rb * K + C) * 2u; }
    int RA[2], CA[2];
#pragma unroll
    for (int i = 0; i < 2; ++i) stage_rc(tid * 16 + i * 8192, RA[i], CA[i]);
    unsigned vC0[2] = {0u, 0u}, vC1[2] = {0u, 0u}, vN0[2] = {0u, 0u}, vN1[2] = {0u, 0u};
#define PG8_AOFFS(v0, v1, unit) do { if constexpr (AMap::GATHER) { _Pragma("unroll") for (int _i = 0; _i < 2; ++_i) { \
        v0[_i] = (AM.row(unit, RA[_i]) * (unsigned)K + (unsigned)CA[_i]) * 2u; v1[_i] = (AM.row(unit, HALF + RA[_i]) * (unsigned)K + (unsigned)CA[_i]) * 2u; } } } while (0)
#define PG8_STAGE_A(bufoff, base, half, usenext) do { if constexpr (AMap::GATHER) { unsigned vv_[2]; _Pragma("unroll") for (int _j = 0; _j < 2; ++_j) vv_[_j] = (usenext) ? ((half) ? vN1[_j] : vN0[_j]) : ((half) ? vC1[_j] : vC0[_j]); \
        PG8_STAGE(bufoff, base, vv_); } else { PG8_STAGE(bufoff, (base) + (half) * hstep, voffA); } } while (0)
    const size_t kstep = (size_t)(BK * 2);
    const size_t hstep = (size_t)HALF * K * 2;
    const size_t tstep = 2 * hstep;
    const unsigned ldsw = (unsigned)wid * 1024u;
    const int aoff = lds_byte(wr * 64 + fr, fq * 8), boff = lds_byte(wc * 32 + fr, fq * 8);
#define PG8_SA(b, h) (((b) * 2 + (h)) * HTB)
#define PG8_SB(b, h) ((4 + (b) * 2 + (h)) * HTB)
#define PG8_STAGE(bufoff, gbase, voff) do { _Pragma("unroll") for (int _i = 0; _i < 2; ++_i) \
        __builtin_amdgcn_global_load_lds((const unsigned*)((const char*)(gbase) + (voff)[_i]), (PG8_LAS unsigned*)(lds + (bufoff) + ldsw + _i * 8192), 16, 0, 0); } while (0)
#define PG8_LDA(dst, b, h) do { _Pragma("unroll") for (int m = 0; m < 4; ++m) _Pragma("unroll") for (int k = 0; k < 2; ++k) dst[m][k] = *(const PG8_LAS bf16x8*)(lds + PG8_SA(b, h) + aoff + m * 2048 + k * 1024); } while (0)
#define PG8_LDB(dst, b, h) do { _Pragma("unroll") for (int n = 0; n < 2; ++n) _Pragma("unroll") for (int k = 0; k < 2; ++k) dst[n][k] = *(const PG8_LAS bf16x8*)(lds + PG8_SB(b, h) + boff + n * 2048 + k * 1024); } while (0)
#define PG8_MMA(ai, bj, At, Bt) do { __builtin_amdgcn_s_setprio(1); _Pragma("unroll") for (int m = 0; m < 4; ++m) _Pragma("unroll") for (int n = 0; n < 2; ++n) _Pragma("unroll") for (int k = 0; k < 2; ++k) \
        acc[ai][bj][m][n] = __builtin_amdgcn_mfma_f32_16x16x32_bf16(Bt[n][k], At[m][k], acc[ai][bj][m][n], 0, 0, 0); __builtin_amdgcn_s_setprio(0); } while (0)
#define PG8_WAIT_V(n) asm volatile("s_waitcnt vmcnt(" #n ")" ::: "memory")
#define PG8_WAIT_L(n) asm volatile("s_waitcnt lgkmcnt(" #n ")" ::: "memory")
#define PG8_BAR __builtin_amdgcn_s_barrier()
#define PG8_SCHED __builtin_amdgcn_sched_barrier(0)
    Unit cur, nxt; int ui = 0;
    if (!S.next(0, cur)) return;
    f32x4 acc[2][2][4][2];
#pragma unroll
    for (int a = 0; a < 2; ++a)
#pragma unroll
        for (int b = 0; b < 2; ++b)
#pragma unroll
            for (int m = 0; m < 4; ++m)
#pragma unroll
                for (int n = 0; n < 2; ++n) acc[a][b][m][n] = (f32x4){0.f, 0.f, 0.f, 0.f};
    bf16x8 At[4][2], B0[2][2], B1[2][2];
    const char* cA = (const char*)g.A + (AMap::GATHER ? (size_t)0 : (size_t)cur.pm * tstep); const char* cB = (const char*)g.Bt + (size_t)cur.pn * tstep;
    PG8_AOFFS(vC0, vC1, cur);
    S.a_ready(cur);
    if constexpr (SP2) {
        PG8_STAGE(PG8_SB(0, 0), cB, voffB); PG8_STAGE(PG8_SB(0, 1), cB + hstep, voffB); PG8_STAGE_A(PG8_SA(0, 0), cA, 0, false); PG8_STAGE_A(PG8_SA(0, 1), cA, 1, false);
        if (wr == 1) PG8_BAR;
        PG8_WAIT_V(2); PG8_BAR;
        PG8_STAGE(PG8_SB(1, 0), cB + kstep, voffB); PG8_STAGE_A(PG8_SA(1, 0), cA + kstep, 0, false); PG8_STAGE(PG8_SB(1, 1), cB + hstep + kstep, voffB);
        PG8_WAIT_V(6); PG8_BAR;
    } else {
        PG8_STAGE(PG8_SB(0, 0), cB, voffB); PG8_STAGE(PG8_SA(0, 0), cA, voffA); PG8_STAGE(PG8_SB(0, 1), cB + hstep, voffB); PG8_STAGE(PG8_SA(0, 1), cA + hstep, voffA);
        if (wr == 1) PG8_BAR;
        PG8_WAIT_V(4); PG8_BAR;
        PG8_STAGE(PG8_SB(1, 0), cB + kstep, voffB); PG8_STAGE(PG8_SA(1, 0), cA + kstep, voffA); PG8_STAGE(PG8_SB(1, 1), cB + hstep + kstep, voffB);
        PG8_WAIT_V(6); PG8_BAR;
    }
    for (;;) {
        const bool has_next = S.next(ui + 1, nxt);
        const char* nA = (has_next && !AMap::GATHER) ? (const char*)g.A + (size_t)nxt.pm * tstep : cA; const char* nB = has_next ? (const char*)g.Bt + (size_t)nxt.pn * tstep : cB;
        if constexpr (AMap::GATHER) { if (has_next) PG8_AOFFS(vN0, vN1, nxt); else { vN0[0] = vC0[0]; vN0[1] = vC0[1]; vN1[0] = vC1[0]; vN1[1] = vC1[1]; } }
#pragma unroll 1
        for (int t = 0; t < nt; t += 2) {
            const bool last = (t == nt - 2);
            const char* a1 = cA + (size_t)(t + 1) * kstep;
            const char* a2 = last ? nA : cA + (size_t)(t + 2) * kstep; const char* b2 = last ? nB : cB + (size_t)(t + 2) * kstep;
            const char* a3 = a2 + kstep; const char* b3 = b2 + kstep;
            if (last && has_next) S.a_ready(nxt);
            if constexpr (SP2) {
            PG8_LDB(B0, 0, 0); PG8_LDB(B1, 0, 1); PG8_SCHED; PG8_LDA(At, 0, 0); PG8_STAGE_A(PG8_SA(1, 1), a1, 1, false);
            PG8_WAIT_V(8); PG8_WAIT_L(0); PG8_BAR; PG8_MMA(0, 0, At, B0); PG8_MMA(0, 1, At, B1); PG8_BAR; PG8_SCHED;
            PG8_LDA(At, 0, 1); PG8_STAGE(PG8_SB(0, 0), b2, voffB); PG8_STAGE(PG8_SB(0, 1), b2 + hstep, voffB); PG8_STAGE_A(PG8_SA(0, 0), a2, 0, last);
            PG8_WAIT_V(8); PG8_WAIT_L(0); PG8_BAR; PG8_MMA(1, 0, At, B0); PG8_MMA(1, 1, At, B1); PG8_BAR; PG8_SCHED;
            PG8_LDB(B0, 1, 0); PG8_LDB(B1, 1, 1); PG8_SCHED; PG8_LDA(At, 1, 0); PG8_STAGE_A(PG8_SA(0, 1), a2, 1, last);
            PG8_WAIT_V(8); PG8_WAIT_L(0); PG8_BAR; PG8_MMA(0, 0, At, B0); PG8_MMA(0, 1, At, B1); PG8_BAR; PG8_SCHED;
            PG8_LDA(At, 1, 1); PG8_STAGE(PG8_SB(1, 0), b3, voffB); PG8_STAGE(PG8_SB(1, 1), b3 + hstep, voffB); PG8_STAGE_A(PG8_SA(1, 0), a3, 0, last);
            PG8_WAIT_V(8); PG8_WAIT_L(0); PG8_BAR; PG8_MMA(1, 0, At, B0); PG8_MMA(1, 1, At, B1); PG8_BAR; PG8_SCHED;
            } else {
            PG8_LDB(B0, 0, 0); PG8_SCHED; PG8_LDA(At, 0, 0); PG8_STAGE(PG8_SA(1, 1), a1 + hstep, voffA);
            PG8_WAIT_L(8); PG8_BAR; PG8_WAIT_L(0); PG8_MMA(0, 0, At, B0); PG8_BAR; PG8_SCHED;
            PG8_LDB(B1, 0, 1); PG8_STAGE(PG8_SB(0, 0), b2, voffB);
            PG8_BAR; PG8_WAIT_L(0); PG8_MMA(0, 1, At, B1); PG8_BAR;
            PG8_LDA(At, 0, 1); PG8_STAGE(PG8_SA(0, 0), a2, voffA);
            PG8_BAR; PG8_WAIT_L(0); PG8_MMA(1, 0, At, B0); PG8_BAR; PG8_SCHED;
            PG8_STAGE(PG8_SB(0, 1), b2 + hstep, voffB);
            PG8_WAIT_V(6); PG8_BAR; PG8_MMA(1, 1, At, B1); PG8_BAR;
            PG8_LDB(B0, 1, 0); PG8_SCHED; PG8_LDA(At, 1, 0); PG8_STAGE(PG8_SA(0, 1), a2 + hstep, voffA);
            PG8_WAIT_L(8); PG8_BAR; PG8_WAIT_L(0); PG8_MMA(0, 0, At, B0); PG8_BAR; PG8_SCHED;
            PG8_LDB(B1, 1, 1); PG8_STAGE(PG8_SB(1, 0), b3, voffB);
            PG8_BAR; PG8_WAIT_L(0); PG8_MMA(0, 1, At, B1); PG8_BAR;
            PG8_LDA(At, 1, 1); PG8_STAGE(PG8_SA(1, 0), a3, voffA);
            PG8_BAR; PG8_WAIT_L(0); PG8_MMA(1, 0, At, B0); PG8_BAR; PG8_SCHED;
            PG8_STAGE(PG8_SB(1, 1), b3 + hstep, voffB);
            PG8_WAIT_V(6); PG8_BAR; PG8_MMA(1, 1, At, B1); PG8_BAR;
            }
        }
        if constexpr (ALIGN_EPI) { if (wr == 0) PG8_BAR; }
        if constexpr (!Epi::AFTER_DRAIN) { E(acc, cur, wr, wc, fr, fq); S.done(cur); }
        if (!has_next) break;
#pragma unroll
        for (int a = 0; a < 2; ++a)
#pragma unroll
            for (int b = 0; b < 2; ++b)
#pragma unroll
                for (int m = 0; m < 4; ++m)
#pragma unroll
                    for (int n = 0; n < 2; ++n) acc[a][b][m][n] = (f32x4){0.f, 0.f, 0.f, 0.f};
        cur = nxt; cA = nA; cB = nB; ++ui;
        if constexpr (AMap::GATHER) { vC0[0] = vN0[0]; vC0[1] = vN0[1]; vC1[0] = vN1[0]; vC1[1] = vN1[1]; }
        if constexpr (ALIGN_EPI) { if (wr == 1) PG8_BAR; }
    }
    PG8_WAIT_V(0);
    if constexpr (!ALIGN_EPI) { if (wr == 0) PG8_BAR; }
    PG8_BAR;
    if constexpr (Epi::AFTER_DRAIN) { E.fused(acc, cur, wr, wc, fr, fq, lds, wid, lane); S.done(cur); }
#undef PG8_SA
#undef PG8_AOFFS
#undef PG8_STAGE_A
#undef PG8_SB
#undef PG8_STAGE
#undef PG8_LDA
#undef PG8_LDB
#undef PG8_MMA
#undef PG8_WAIT_V
#undef PG8_WAIT_L
#undef PG8_BAR
#undef PG8_SCHED
}
}
#define XB_TMO      128
#define XB_XCNT(j)  (256  + 64 * (j))
#define XB_XSUB(j)  (1280 + 64 * (j))
#define XB_XGEN(j)  (2304 + 64 * (j))
#define XB_TOP      3328
#define XB_TOPGEN   3392
#define XCD_BAR_WORDS 3456
#define XB_SPIN_CAP (1u << 21)

__device__ __forceinline__ unsigned xb_ld(unsigned* p)              { return __hip_atomic_load(p, __ATOMIC_RELAXED, __HIP_MEMORY_SCOPE_AGENT); }
__device__ __forceinline__ unsigned xb_add(unsigned* p, unsigned v) { return __hip_atomic_fetch_add(p, v, __ATOMIC_RELAXED, __HIP_MEMORY_SCOPE_AGENT); }
__device__ __forceinline__ unsigned xb_xcc_id() { return (unsigned)__builtin_amdgcn_s_getreg((3 << 11) | 20) & 0xFu; }
#define XB_SPIN(cond, bar) do { unsigned _sp = 0; while (cond) { __builtin_amdgcn_s_sleep(1); \
    if ((++_sp & 255u) == 0u) { if (xb_ld(&(bar)[XB_TMO])) break; if (_sp > XB_SPIN_CAP) { atomicAdd(&(bar)[XB_TMO], 1u); break; } } } } while (0)

struct XcdBarrier {
    unsigned* bar; unsigned x;
    volatile LAS unsigned* st;
};

__device__ __forceinline__ XcdBarrier xcd_barrier_post(unsigned* bar, volatile LAS unsigned* st) {
    XcdBarrier b; b.bar = bar; b.x = xb_xcc_id(); b.st = st;
    if (threadIdx.x == 0) (void)xb_add(&bar[XB_XCNT(b.x)], 1u);
    return b;
}
__device__ __forceinline__ void xcd_barrier_complete(unsigned* bar, unsigned x, unsigned& nloc, unsigned& nx) {
    const unsigned G = gridDim.x * gridDim.y * gridDim.z;
    unsigned sum, cnt, mine, sp = 0u;
    for (;;) {
        sum = 0u; cnt = 0u; mine = 0u;
#pragma unroll
        for (unsigned j = 0; j < 16; ++j) { const unsigned c = xb_ld(&bar[XB_XCNT(j)]); sum += c; cnt += (c > 0u) ? 1u : 0u; mine = (j == x) ? c : mine; }
        if (sum == G) break;
        __builtin_amdgcn_s_sleep(1);
        if ((++sp & 255u) == 0u) { if (xb_ld(&bar[XB_TMO])) break; if (sp > XB_SPIN_CAP) { atomicAdd(&bar[XB_TMO], 1u); break; } }
    }
    nloc = mine > 0u ? mine : 1u; nx = cnt > 0u ? cnt : 1u;
}

__device__ __forceinline__ void xcd_barrier(const XcdBarrier& b) {
    asm volatile("s_waitcnt vmcnt(0)" ::: "memory");
    __syncthreads();
    int tid_l = (int)threadIdx.x; asm volatile("" : "+v"(tid_l));
    if (tid_l == 0) {
        unsigned* bar = b.bar;
        __builtin_amdgcn_s_waitcnt(0);
        unsigned nloc = b.st[0], nx = b.st[1];
        if (nloc == 0u) { xcd_barrier_complete(bar, b.x, nloc, nx); b.st[0] = nloc; b.st[1] = nx; }
        const unsigned old = xb_add(&bar[XB_XSUB(b.x)], 1u);
        const unsigned gen = old / nloc;
        if (old + 1u == (gen + 1u) * nloc) {
            __builtin_amdgcn_fence(__ATOMIC_RELEASE, "agent");
            asm volatile("s_waitcnt vmcnt(0)" ::: "memory");
            const unsigned og = xb_add(&bar[XB_TOP], 1u);
            const unsigned tg = og / nx;
            if (og + 1u == (tg + 1u) * nx) xb_add(&bar[XB_TOPGEN], 1u);
            else XB_SPIN(xb_ld(&bar[XB_TOPGEN]) == tg, bar);
            __builtin_amdgcn_fence(__ATOMIC_ACQUIRE, "agent");
            xb_add(&bar[XB_XGEN(b.x)], 1u);
            asm volatile("s_waitcnt vmcnt(0)" ::: "memory");
        } else {
            XB_SPIN(xb_ld(&bar[XB_XGEN(b.x)]) == gen, bar);
            __builtin_amdgcn_fence(__ATOMIC_ACQUIRE, "agent");
            asm volatile("s_waitcnt vmcnt(0)" ::: "memory");
        }
    }
    __syncthreads();
}

enum { I_X = 0, I_NORM_ATTN, I_W_IN, I_QK_GAIN, I_IDX_K_GAIN, I_DIFF_LAMBDA, I_DIFF_SUBLN, I_W_PROJ_A, I_W_PROJ_B, I_W_PROJ_C, I_W_OUT, I_NORM_FFN, I_W_GROUP, I_B_GROUP, I_W_ROUTER, I_B_ROUTER,
       I_W_E_GATE, I_W_E_UP, I_W_E_DOWN, N_INPUTS };
struct Args { const float* in[N_INPUTS]; float* out; unsigned char* ws; };

#define LDS_WAIT() asm volatile("s_waitcnt lgkmcnt(0)" ::: "memory")

__device__ __forceinline__ int perm16col(int s) { return 64 * ((s >> 5) & 3) + 16 * ((s >> 2) & 3) + 8 * (s >> 7) + 4 * ((s >> 4) & 1) + (s & 3); }
__device__ __forceinline__ int inproj_src_col(int d) {
    const int pn = d >> 8, s = d & 255;
    if (pn >= 15) return C_G + 256 * (pn - 15) + perm16col(s);
    const int u = (s >> 5) & 3, e = 32 * (s >> 7) + pg8::perm32(s & 31);
    if (pn < 8) return 256 * pn + 64 * u + e;
    if (pn == 8) { if (u == 0) return C_KI + e; if (u == 1) return e < 8 ? C_WI + e : -1; return -1; }
    return C_Q1 + 256 * (pn - 9) + 64 * u + e;
}
__device__ __forceinline__ void transpose_item(const float* W, int ldw, int K, bf16_t* WT, int drow0, int k0, int srccol, LAS float* scr, int lane) {
    const float* src = W + (size_t)k0 * ldw + (srccol >= 0 ? srccol : 0);
#pragma unroll 8
    for (int i = 0; i < 32; ++i) { const int kk = 2 * i + (lane >> 5); const float v = src[(size_t)kk * ldw]; scr[kk * 33 + (lane & 31)] = srccol >= 0 ? v : 0.f; }
    LDS_WAIT(); asm volatile("" ::: "memory");
    const int c = lane & 7;
#pragma unroll
    for (int j = 0; j < 4; ++j) { const int n = (lane >> 3) + 8 * j; const LAS float* s = scr + (8 * c) * 33 + n;
        u32x4 o; o.x = cvt_pk_bf16(s[0 * 33], s[1 * 33]); o.y = cvt_pk_bf16(s[2 * 33], s[3 * 33]); o.z = cvt_pk_bf16(s[4 * 33], s[5 * 33]); o.w = cvt_pk_bf16(s[6 * 33], s[7 * 33]);
        *(u32x4*)(WT + (size_t)(drow0 + n) * K + k0 + 8 * c) = o; }
    LDS_WAIT(); asm volatile("" ::: "memory");
}

template <bool COMBINE, bool WRITE_HN>
__device__ __forceinline__ void token_row(const float* src, float* dst, const bf16_t* y, const unsigned* rt0, const unsigned* rt1, const f32x2* rtw, const LAS int* pstart,
                                          const float* gain, bf16_t* hn, int m, int lane) {
    f32x4 v[4];
#pragma unroll
    for (int j = 0; j < 4; ++j) v[j] = ((const f32x4*)(src + (size_t)m * DM))[lane + 64 * j];
    if (COMBINE) {
        const unsigned a = rt0[m], b = rt1[m]; const f32x2 w = rtw[m];
        const size_t s0 = (size_t)(pstart[a >> 24] + (int)(a & 0xffffffu)), s1 = (size_t)(pstart[b >> 24] + (int)(b & 0xffffffu));
#pragma unroll
        for (int j = 0; j < 4; ++j) { const u32x2 p = ((const u32x2*)(y + s0 * DM))[lane + 64 * j], q = ((const u32x2*)(y + s1 * DM))[lane + 64 * j];
            v[j][0] += w[0] * bf_lo(p[0]) + w[1] * bf_lo(q[0]); v[j][1] += w[0] * bf_hi(p[0]) + w[1] * bf_hi(q[0]);
            v[j][2] += w[0] * bf_lo(p[1]) + w[1] * bf_lo(q[1]); v[j][3] += w[0] * bf_hi(p[1]) + w[1] * bf_hi(q[1]);
            ((f32x4*)(dst + (size_t)m * DM))[lane + 64 * j] = v[j]; }
    }
    if (WRITE_HN) {
        float ss = 0.f;
#pragma unroll
        for (int j = 0; j < 4; ++j) ss += (v[j][0] * v[j][0] + v[j][1] * v[j][1]) + (v[j][2] * v[j][2] + v[j][3] * v[j][3]);
        const float rstd = 1.0f / sqrtf(wave_sum(ss) * (1.0f / DM) + EPS);
#pragma unroll
        for (int j = 0; j < 4; ++j) { const f32x4 g = ((const f32x4*)gain)[lane + 64 * j]; const f32x4 o = v[j] * rstd * g;
            ((u32x2*)(hn + (size_t)m * DM))[lane + 64 * j] = (u32x2){cvt_pk_bf16(o[0], o[1]), cvt_pk_bf16(o[2], o[3])}; }
    }
}

template <bool EXPERTS> __device__ __forceinline__ void convert_weights(const Args& a, unsigned char* ws, int l, LAS unsigned char* lds, int lane, int wave, int vcu, int G, int chunk = -1);
__device__ __forceinline__ void p0_phase(const Args& a, unsigned char* ws, int l, LAS unsigned char* lds, int tid, int lane, int wave, int vcu, int G) {
    convert_weights<false>(a, ws, l, lds, lane, wave, vcu, G);
    const int gw = vcu * 8 + wave, NGW = G * 8, gt = vcu * 512 + tid, NGT = G * 512;
    if (l == 0) {
        float* cosT = (float*)(ws + WS_COS); float* sinT = (float*)(ws + WS_SIN);
        for (int idx = gt; idx < SEQ * 32; idx += NGT) { const int pos = idx >> 5, j = idx & 31;
            const float inv_freq = 1.0f / powf(10000.0f, (float)(2 * j) * (1.0f / 64.0f));
            const float ang = (float)pos * inv_freq;
            const double rev = (double)ang * 0.15915494309189533577; const float fr = (float)(rev - rint(rev));
            cosT[idx] = __builtin_amdgcn_cosf(fr); sinT[idx] = __builtin_amdgcn_sinf(fr); }
    }
    { float* wrt = (float*)(ws + WS_WRT); const float* wg = a.in[I_W_GROUP] + (size_t)l * DM * 4; const float* wr = a.in[I_W_ROUTER] + (size_t)l * DM * 32;
      const float* g2 = a.in[I_NORM_FFN] + (size_t)l * DM;
      for (int idx = gt; idx < 36 * DM; idx += NGT) { const int c = idx >> 10, k = idx & 1023; wrt[idx] = g2[k] * (c < 4 ? wg[k * 4 + c] : wr[k * 32 + (c - 4)]); } }
    const float* gain = a.in[I_NORM_ATTN] + (size_t)l * DM; bf16_t* hn = (bf16_t*)(ws + WS_HN);
    const LAS int* pstart = (const LAS int*)(lds + LX_PSTART);
    if (l == 0) { for (int m = gw; m < MTOK; m += NGW) token_row<false, true>(a.in[I_X], nullptr, nullptr, nullptr, nullptr, nullptr, pstart, gain, hn, m, lane); }
    else { for (int m = gw; m < MTOK; m += NGW) token_row<true, true>(a.out, a.out, (const bf16_t*)(ws + WS_Y), (const unsigned*)(ws + WS_RT0), (const unsigned*)(ws + WS_RT1), (const f32x2*)(ws + WS_RTW), pstart, gain, hn, m, lane); }
}

template <bool EXPERTS> __device__ __forceinline__ void convert_weights(const Args& a, unsigned char* ws, int l, LAS unsigned char* lds, int lane, int wave, int vcu, int G, int chunk) {
    LAS float* scr = (LAS float*)(lds + wave * 16384);
    int gw = vcu * 8 + wave, NGW = G * 8;
    constexpr int I_IN = 216 * 16, I_PA = 32 * 4, I_PC = 32 * 8, I_WO = 32 * 16, I_GU = 32 * 32 * 16, I_DN = 32 * 32 * 8, NIT = I_IN + 2 * I_PA + I_PC + I_WO + I_GU + I_DN;
    constexpr int I_SMALL = I_IN + 2 * I_PA + I_PC + I_WO;
    int it_end = EXPERTS ? NIT : I_SMALL;
    if (chunk >= 0) { gw = chunk * 128 + wave * 16; NGW = 1; it_end = I_SMALL + gw + 16 < NIT ? I_SMALL + gw + 16 : NIT; }
    for (int it = gw + (EXPERTS ? I_SMALL : 0); it < it_end; it += NGW) {
        int r = it; const int d31 = lane & 31;
        if (r < I_IN) { const int nb = r >> 4, kb = r & 15; transpose_item(a.in[I_W_IN] + (size_t)l * DM * D_IN, D_IN, 1024, (bf16_t*)(ws + WS_WIN), nb * 32, kb * 64, inproj_src_col(nb * 32 + d31), scr, lane); continue; } r -= I_IN;
        const int pcol = pg8::perm32(d31);
        if (r < I_PA) { const int nb = r >> 2, kb = r & 3; transpose_item(a.in[I_W_PROJ_A] + (size_t)l * 256 * DM, DM, 256, (bf16_t*)(ws + WS_WPA), nb * 32, kb * 64, ((nb * 32 + d31) & ~255) + perm16col((nb * 32 + d31) & 255), scr, lane); continue; } r -= I_PA;
        if (r < I_PA) { const int nb = r >> 2, kb = r & 3; transpose_item(a.in[I_W_PROJ_B] + (size_t)l * 256 * DM, DM, 256, (bf16_t*)(ws + WS_WPB), nb * 32, kb * 64, ((nb * 32 + d31) & ~255) + perm16col((nb * 32 + d31) & 255), scr, lane); continue; } r -= I_PA;
        if (r < I_PC) { const int nb = r >> 3, kb = r & 7; transpose_item(a.in[I_W_PROJ_C] + (size_t)l * 512 * DM, DM, 512, (bf16_t*)(ws + WS_WPC), nb * 32, kb * 64, ((nb * 32 + d31) & ~255) + perm16col((nb * 32 + d31) & 255), scr, lane); continue; } r -= I_PC;
        if (r < I_WO) { const int nb = r >> 4, kb = r & 15; transpose_item(a.in[I_W_OUT] + (size_t)l * DM * DM, DM, 1024, (bf16_t*)(ws + WS_WO), nb * 32, kb * 64, nb * 32 + pcol, scr, lane); continue; } r -= I_WO;
        if (r < I_GU) { const int e = r >> 9, rr = r & 511, nb = rr >> 4, kb = rr & 15, dd = nb * 32, pn = dd >> 8, s = dd & 255, half = s >> 7;
            const float* src = (half ? a.in[I_W_E_UP] : a.in[I_W_E_GATE]) + (size_t)(l * NEXP + e) * DM * DEXP;
            transpose_item(src, DEXP, 1024, (bf16_t*)(ws + WS_WGU) + (size_t)e * 1024 * 1024, nb * 32, kb * 64, 128 * pn + (s & 127) + pcol, scr, lane); continue; } r -= I_GU;
        { const int e = r >> 8, rr = r & 255, nb = rr >> 3, kb = rr & 7;
            transpose_item(a.in[I_W_E_DOWN] + (size_t)(l * NEXP + e) * DEXP * DM, DM, 512, (bf16_t*)(ws + WS_WD) + (size_t)e * 1024 * 512, nb * 32, kb * 64, ((nb * 32 + d31) & ~255) + perm16col((nb * 32 + d31) & 255), scr, lane); }
    }
}

__device__ __forceinline__ f32x16 mfma32(bf16x8 a, bf16x8 b, f32x16 c) { return __builtin_amdgcn_mfma_f32_32x32x16_bf16(a, b, c, 0, 0, 0); }
typedef short v4i16_t __attribute__((ext_vector_type(4)));
__device__ __forceinline__ s16x4 vtr(const LAS unsigned char* p) { return __builtin_bit_cast(s16x4, __builtin_amdgcn_ds_read_tr16_b64_v4i16((LAS v4i16_t*)p)); }
__device__ __forceinline__ int crow(int r, int hi) { return (r & 3) + 8 * (r >> 2) + 4 * hi; }
#define NEG_INF (-__builtin_inff())

__device__ __forceinline__ f32x16 splat16(float v) { f32x16 r;
#pragma unroll
    for (int i = 0; i < 16; ++i) r[i] = v;
    return r; }
__device__ __forceinline__ int kimg_off(int key, int ch) { return key * 128 + ((ch ^ ((key >> 1) & 7)) << 4); }
__device__ __forceinline__ int kdma_row(int w, int lane) { return 8 * w + (lane >> 3); }
__device__ __forceinline__ int kdma_chunk(int w, int lane) { return (lane & 7) ^ (((8 * w + (lane >> 3)) >> 1) & 7); }
struct QReg { const bf16x8 (&q)[4]; __device__ __forceinline__ bf16x8 operator()(int ks) const { return q[ks]; } };
struct QLds { const LAS unsigned char* p; __device__ __forceinline__ bf16x8 operator()(int ks) const { return *(const LAS bf16x8*)(p + ks * 1024); } };
template <int NDB, class QF, class MaskF>
__device__ __forceinline__ void flash_tile(float& m_run, float& l_run, f32x16 (&o)[NDB], const LAS unsigned char* kimg, const LAS unsigned char* vimg, const QF& qf, const MaskF& maskf, int r32, int hi, int vboff) {
    if (NDB == 4) __builtin_amdgcn_sched_barrier(0);
    f32x16 p0, p1; maskf.init(p0, p1);
#pragma unroll
    for (int ks = 0; ks < 4; ++ks) {
        const bf16x8 a0 = *(const LAS bf16x8*)(kimg + (NDB == 4 ? (2 * ks + hi) * 1024 + r32 * 16 : kimg_off(r32, 2 * ks + hi)));
        const bf16x8 a1 = *(const LAS bf16x8*)(kimg + (NDB == 4 ? (2 * ks + hi) * 1024 + 512 + r32 * 16 : kimg_off(r32, 2 * ks + hi) + 4096));
        const bf16x8 qk = qf(ks);
        p0 = mfma32(a0, qk, p0); p1 = mfma32(a1, qk, p1);
        if (NDB == 4 && (ks & 1)) __builtin_amdgcn_sched_barrier(0);
    }
    maskf(p0, p1);
    float mx = fmaxf(p0[0], p1[0]);
#pragma unroll
    for (int r = 1; r < 16; ++r) mx = fmaxf(mx, fmaxf(p0[r], p1[r]));
    mx = max_xor32(mx);
    const float mnew = fmaxf(m_run, mx);
    if (__ballot(mnew > m_run) != 0ull) {
        const float alpha = fast_exp2(m_run - mnew);
        l_run *= alpha;
#pragma unroll
        for (int db = 0; db < NDB; ++db) o[db] = o[db] * alpha;
    }
    m_run = mnew;
    float sum = 0.f;
#pragma unroll
    for (int r = 0; r < 16; ++r) { p0[r] = fast_exp2(p0[r] - mnew); p1[r] = fast_exp2(p1[r] - mnew); sum += p0[r] + p1[r]; }
    l_run += sum;
    bf16x8 pa[4];
    pa[0] = __builtin_bit_cast(bf16x8, (u32x4){cvt_pk_bf16(p0[0], p0[1]), cvt_pk_bf16(p0[2], p0[3]), cvt_pk_bf16(p0[4], p0[5]), cvt_pk_bf16(p0[6], p0[7])});
    pa[1] = __builtin_bit_cast(bf16x8, (u32x4){cvt_pk_bf16(p0[8], p0[9]), cvt_pk_bf16(p0[10], p0[11]), cvt_pk_bf16(p0[12], p0[13]), cvt_pk_bf16(p0[14], p0[15])});
    pa[2] = __builtin_bit_cast(bf16x8, (u32x4){cvt_pk_bf16(p1[0], p1[1]), cvt_pk_bf16(p1[2], p1[3]), cvt_pk_bf16(p1[4], p1[5]), cvt_pk_bf16(p1[6], p1[7])});
    pa[3] = __builtin_bit_cast(bf16x8, (u32x4){cvt_pk_bf16(p1[8], p1[9]), cvt_pk_bf16(p1[10], p1[11]), cvt_pk_bf16(p1[12], p1[13]), cvt_pk_bf16(p1[14], p1[15])});
#pragma unroll
    for (int db = 0; db < NDB; ++db)
#pragma unroll
        for (int s = 0; s < 4; ++s) {
            const s16x4 lo = vtr(vimg + vboff + db * 4096 + s * 1024), h4 = vtr(vimg + vboff + db * 4096 + s * 1024 + 512);
            const bf16x8 vt = (bf16x8){lo[0], lo[1], lo[2], lo[3], h4[0], h4[1], h4[2], h4[3]};
            o[db] = mfma32(vt, pa[s], o[db]);
            if (NDB == 4 && (s & 1)) __builtin_amdgcn_sched_barrier(0);
        }    __builtin_amdgcn_sched_barrier(0);
}
template <int NDB, class QF, class MaskF>
__device__ __forceinline__ void flash_tile_ref0(float& l_run, f32x16& lacc, f32x16 (&o)[NDB], const LAS unsigned char* kimg, const LAS unsigned char* vimg, const QF& qf, const MaskF& maskf, int r32, int hi, int vboff) {
    f32x16 p0, p1; maskf.init(p0, p1);
    bf16x8 kf[8];
#pragma unroll
    for (int ks = 0; ks < 4; ++ks) { kf[2 * ks] = *(const LAS bf16x8*)(kimg + kimg_off(r32, 2 * ks + hi)); kf[2 * ks + 1] = *(const LAS bf16x8*)(kimg + kimg_off(r32, 2 * ks + hi) + 4096); }
    __builtin_amdgcn_sched_barrier(0);
#pragma unroll
    for (int ks = 0; ks < 4; ++ks) { const bf16x8 qk = qf(ks); p0 = mfma32(kf[2 * ks], qk, p0); p1 = mfma32(kf[2 * ks + 1], qk, p1); }
    maskf(p0, p1);
    __builtin_amdgcn_sched_barrier(0);
    const bf16x8 ones = (bf16x8){0x3f80, 0x3f80, 0x3f80, 0x3f80, 0x3f80, 0x3f80, 0x3f80, 0x3f80};
#pragma unroll
    for (int r = 0; r < 16; ++r) p0[r] = fast_exp2(p0[r]);
    bf16x8 pa[4];
    pa[0] = __builtin_bit_cast(bf16x8, (u32x4){cvt_pk_bf16(p0[0], p0[1]), cvt_pk_bf16(p0[2], p0[3]), cvt_pk_bf16(p0[4], p0[5]), cvt_pk_bf16(p0[6], p0[7])});
    pa[1] = __builtin_bit_cast(bf16x8, (u32x4){cvt_pk_bf16(p0[8], p0[9]), cvt_pk_bf16(p0[10], p0[11]), cvt_pk_bf16(p0[12], p0[13]), cvt_pk_bf16(p0[14], p0[15])});
    maskf.pack(pa[0]); maskf.pack(pa[1]);
    __builtin_amdgcn_sched_barrier(0);
#pragma unroll
    for (int s = 0; s < 2; ++s) {
        lacc = mfma32(ones, pa[s], lacc);
#pragma unroll
        for (int db = 0; db < NDB; ++db) {
            const s16x4 lo = vtr(vimg + vboff + db * 4096 + s * 1024), h4 = vtr(vimg + vboff + db * 4096 + s * 1024 + 512);
            o[db] = mfma32((bf16x8){lo[0], lo[1], lo[2], lo[3], h4[0], h4[1], h4[2], h4[3]}, pa[s], o[db]);
        }
    }
#pragma unroll
    for (int r = 0; r < 16; ++r) p1[r] = fast_exp2(p1[r]);
    pa[2] = __builtin_bit_cast(bf16x8, (u32x4){cvt_pk_bf16(p1[0], p1[1]), cvt_pk_bf16(p1[2], p1[3]), cvt_pk_bf16(p1[4], p1[5]), cvt_pk_bf16(p1[6], p1[7])});
    pa[3] = __builtin_bit_cast(bf16x8, (u32x4){cvt_pk_bf16(p1[8], p1[9]), cvt_pk_bf16(p1[10], p1[11]), cvt_pk_bf16(p1[12], p1[13]), cvt_pk_bf16(p1[14], p1[15])});
    maskf.pack(pa[2]); maskf.pack(pa[3]);
    __builtin_amdgcn_sched_barrier(0);
#pragma unroll
    for (int s = 2; s < 4; ++s) {
        lacc = mfma32(ones, pa[s], lacc);
#pragma unroll
        for (int db = 0; db < NDB; ++db) {
            const s16x4 lo = vtr(vimg + vboff + db * 4096 + s * 1024), h4 = vtr(vimg + vboff + db * 4096 + s * 1024 + 512);
            o[db] = mfma32((bf16x8){lo[0], lo[1], lo[2], lo[3], h4[0], h4[1], h4[2], h4[3]}, pa[s], o[db]);
        }
    }
    __builtin_amdgcn_sched_barrier(0);
    (void)l_run;
}
template <bool KSWZ, class MaskF>
__device__ __forceinline__ void flash_tile_dual_ref0(float& l1, float& l2, f32x16 (&o1)[4], f32x16 (&o2)[4], const LAS unsigned char* k1img, const LAS unsigned char* k2img, const LAS unsigned char* vimg,
                                                     const LAS unsigned char* q1img, const LAS unsigned char* q2img, const MaskF& maskf, int r32, int hi, int vboff) {
    bf16x8 pa1[4], pa2[4];
#define DUAL_MAP_(kimg, qimg, pa, lsum) do { __builtin_amdgcn_sched_barrier(0); f32x16 p0, p1; maskf.init(p0, p1); \
        _Pragma("unroll") for (int ks = 0; ks < 4; ++ks) { const int ko = KSWZ ? kimg_off(r32, 2 * ks + hi) : (2 * ks + hi) * 1024 + r32 * 16; const bf16x8 qq = *(const LAS bf16x8*)(qimg + ks * 1024); \
            p0 = mfma32(*(const LAS bf16x8*)(kimg + ko), qq, p0); p1 = mfma32(*(const LAS bf16x8*)(kimg + ko + (KSWZ ? 4096 : 512)), qq, p1); if (ks & 1) __builtin_amdgcn_sched_barrier(0); } \
        maskf(p0, p1); float sm = 0.f; \
        _Pragma("unroll") for (int r = 0; r < 16; ++r) { p0[r] = fast_exp2(p0[r]); p1[r] = fast_exp2(p1[r]); sm += p0[r] + p1[r]; } \
        lsum += sm; \
        pa[0] = __builtin_bit_cast(bf16x8, (u32x4){cvt_pk_bf16(p0[0], p0[1]), cvt_pk_bf16(p0[2], p0[3]), cvt_pk_bf16(p0[4], p0[5]), cvt_pk_bf16(p0[6], p0[7])}); \
        pa[1] = __builtin_bit_cast(bf16x8, (u32x4){cvt_pk_bf16(p0[8], p0[9]), cvt_pk_bf16(p0[10], p0[11]), cvt_pk_bf16(p0[12], p0[13]), cvt_pk_bf16(p0[14], p0[15])}); \
        pa[2] = __builtin_bit_cast(bf16x8, (u32x4){cvt_pk_bf16(p1[0], p1[1]), cvt_pk_bf16(p1[2], p1[3]), cvt_pk_bf16(p1[4], p1[5]), cvt_pk_bf16(p1[6], p1[7])}); \
        pa[3] = __builtin_bit_cast(bf16x8, (u32x4){cvt_pk_bf16(p1[8], p1[9]), cvt_pk_bf16(p1[10], p1[11]), cvt_pk_bf16(p1[12], p1[13]), cvt_pk_bf16(p1[14], p1[15])}); } while (0)
    DUAL_MAP_(k1img, q1img, pa1, l1);
    DUAL_MAP_(k2img, q2img, pa2, l2);
#undef DUAL_MAP_
    __builtin_amdgcn_sched_barrier(0);
#pragma unroll
    for (int s = 0; s < 4; ++s) {
#pragma unroll
        for (int db = 0; db < 4; ++db) {
            const s16x4 lo = vtr(vimg + vboff + db * 4096 + s * 1024), h4 = vtr(vimg + vboff + db * 4096 + s * 1024 + 512);
            const bf16x8 vt = (bf16x8){lo[0], lo[1], lo[2], lo[3], h4[0], h4[1], h4[2], h4[3]};
            o1[db] = mfma32(vt, pa1[s], o1[db]); o2[db] = mfma32(vt, pa2[s], o2[db]);
            if (db & 1) __builtin_amdgcn_sched_barrier(0);
        }
    }
}
template <bool FAST, int NDB, class QF, class MaskF>
__device__ __forceinline__ void flash_step(float& m_run, float& l_run, f32x16& lacc, f32x16 (&o)[NDB], const LAS unsigned char* kimg, const LAS unsigned char* vimg, const QF& qf, const MaskF& maskf, int r32, int hi, int vboff) {
    if constexpr (FAST) flash_tile_ref0<NDB>(l_run, lacc, o, kimg, vimg, qf, maskf, r32, hi, vboff); else flash_tile<NDB>(m_run, l_run, o, kimg, vimg, qf, maskf, r32, hi, vboff);
}
__device__ __forceinline__ bool softmax_ref0_ok(const float* gq, const float* gk, int lane) {
    float a = fabsf(gq[lane]), b = fabsf(gk[lane]);
    a = fmaxf(a, xor_lane<1>(a)); a = fmaxf(a, xor_lane<2>(a)); a = fmaxf(a, xor_lane<4>(a)); a = fmaxf(a, xor_lane<8>(a)); a = fmaxf(a, xor_lane<16>(a)); a = max_xor32(a);
    b = fmaxf(b, xor_lane<1>(b)); b = fmaxf(b, xor_lane<2>(b)); b = fmaxf(b, xor_lane<4>(b)); b = fmaxf(b, xor_lane<8>(b)); b = fmaxf(b, xor_lane<16>(b)); b = max_xor32(b);
    return __builtin_amdgcn_readfirstlane(__builtin_bit_cast(int, a * b * (C2 * 64.0f * 1.02f))) < __builtin_bit_cast(int, 48.0f) && REF0_ENABLE;
}
#define MASK_INIT_ZERO __device__ __forceinline__ void init(f32x16& p0, f32x16& p1) const { p0 = splat16(0.f); p1 = splat16(0.f); }
#define MASK_PACK_NONE __device__ __forceinline__ void pack(bf16x8&) const {}
struct MaskNone { MASK_INIT_ZERO MASK_PACK_NONE __device__ __forceinline__ void operator()(f32x16&, f32x16&) const {} };
struct MaskCausal { int kb0, qloc, hi;
    MASK_INIT_ZERO MASK_PACK_NONE
    __device__ __forceinline__ void operator()(f32x16& p0, f32x16& p1) const {
#pragma unroll
        for (int r = 0; r < 16; ++r) { const int kv = kb0 + crow(r, hi); p0[r] = kv > qloc ? NEG_INF : p0[r]; p1[r] = kv + 32 > qloc ? NEG_INF : p1[r]; } } };
struct MaskCausalIf { bool on; int kb0, qloc, hi;
    MASK_INIT_ZERO MASK_PACK_NONE
    __device__ __forceinline__ void operator()(f32x16& p0, f32x16& p1) const { if (on) {
#pragma unroll
        for (int r = 0; r < 16; ++r) { const int kv = kb0 + crow(r, hi); p0[r] = kv > qloc ? NEG_INF : p0[r]; p1[r] = kv + 32 > qloc ? NEG_INF : p1[r]; } } } };
struct MaskLaneP { unsigned keep;
    MASK_INIT_ZERO
    __device__ __forceinline__ void operator()(f32x16&, f32x16&) const {}
    __device__ __forceinline__ void pack(bf16x8& pa) const { u32x4 v = __builtin_bit_cast(u32x4, pa); v = v & keep; pa = __builtin_bit_cast(bf16x8, v); } };
struct MaskLane { float ci;
    MASK_INIT_ZERO MASK_PACK_NONE
    __device__ __forceinline__ void operator()(f32x16& p0, f32x16& p1) const {
#pragma unroll
        for (int r = 0; r < 16; ++r) { p0[r] += ci; p1[r] += ci; } } };
template <int POS> __device__ __forceinline__ float neginf_if_bit(unsigned n) { float r; asm("v_bfe_i32 %0, %1, %2, 1\n\tv_and_b32 %0, 0xff800000, %0" : "=v"(r) : "v"(n), "n"(POS)); return r; }
struct MaskBits { unsigned n0, n1;
    __device__ __forceinline__ void init(f32x16& p0, f32x16& p1) const {
#define MB_(r) p0[r] = neginf_if_bit<((r) & 3) + 8 * ((r) >> 2)>(n0); p1[r] = neginf_if_bit<((r) & 3) + 8 * ((r) >> 2)>(n1);
        MB_(0) MB_(1) MB_(2) MB_(3) MB_(4) MB_(5) MB_(6) MB_(7) MB_(8) MB_(9) MB_(10) MB_(11) MB_(12) MB_(13) MB_(14) MB_(15)
#undef MB_
        asm volatile("s_nop 1" ::: "memory"); }
    MASK_PACK_NONE
    __device__ __forceinline__ void operator()(f32x16&, f32x16&) const {} };
__device__ __forceinline__ void dma16(const void* g, LAS unsigned char* l) { __builtin_amdgcn_global_load_lds((const unsigned*)g, (LAS unsigned*)l, 16, 0, 0); }
#define DMA_WAIT_SYNC() do { asm volatile("s_waitcnt vmcnt(0)" ::: "memory"); __syncthreads(); } while (0)

__device__ __forceinline__ void glds16(const void* gsrc, unsigned lds_dst) { unsigned keep;
    asm volatile("s_mov_b32 %0, m0\n\ts_mov_b32 m0, %2\n\ts_nop 0\n\tglobal_load_lds_dwordx4 %1, off\n\ts_mov_b32 m0, %0" : "=&s"(keep) : "v"(gsrc), "s"(lds_dst) : "memory"); }
__device__ __forceinline__ void glds4(const void* gsrc, unsigned lds_dst) { unsigned keep;
    asm volatile("s_mov_b32 %0, m0\n\ts_mov_b32 m0, %2\n\ts_nop 0\n\tglobal_load_lds_dword %1, off\n\ts_mov_b32 m0, %0" : "=&s"(keep) : "v"(gsrc), "s"(lds_dst) : "memory"); }
#define WAITV_BAR(N) asm volatile("s_waitcnt vmcnt(" #N ") lgkmcnt(0)\n\ts_barrier" ::: "memory")

template <int MODE, bool FAST>
__device__ __forceinline__ void attn_ab_unit(int b, int h, int qt, const bf16_t* qkv, bf16_t* obuf, const float* kmean, const unsigned* maskg, LAS unsigned char* lds, int tid, int lane, int w) {
    constexpr int CQ = MODE == 0 ? C_QA : C_QB, CK = MODE == 0 ? C_KA : C_KB, CV = MODE == 0 ? C_VA : C_VB;
    constexpr int NS = 4, D = 3, SLOT = 16384;
    const int r32 = lane & 31, hi = lane >> 5;
    const size_t rowbase = (size_t)b * SEQ; const int q0 = 256 * qt, qloc = 32 * w + r32; const size_t qrow = rowbase + q0 + qloc;
    const unsigned lds0 = (unsigned)(size_t)lds;
    LAS float* kml = (LAS float*)(lds + 73728); LAS unsigned* mwl = (LAS unsigned*)(lds + 65536);
    bf16x8 qf[4];
#pragma unroll
    for (int ks = 0; ks < 4; ++ks) qf[ks] = *(const bf16x8*)(qkv + qrow * QP + CQ + 64 * h + 16 * ks + 8 * hi);
    const bf16_t* ksrc = qkv + (rowbase + kdma_row(w, lane)) * QP + CK + 64 * h + 8 * kdma_chunk(w, lane);
    const bf16_t* vsrc = qkv + (rowbase + 16 * (w & 3) + (lane >> 2)) * QP + CV + 64 * h + 32 * (w >> 2) + 8 * (lane & 3);
    const unsigned* msrc = maskg + qrow * 128 + hi;
    const int NT = 4 * qt + 4, wlim = 4 * qt + (w >> 1);
    const unsigned kdst0 = (unsigned)__builtin_amdgcn_readfirstlane(lds0 + w * 1024), mdst0 = (unsigned)__builtin_amdgcn_readfirstlane(lds0 + 65536 + w * 256);
    __syncthreads();
#pragma unroll
    for (int d = 0; d < D; ++d) { const int t = d < NT ? d : NT - 1;
        glds16(ksrc + (size_t)t * 64 * QP, kdst0 + d * SLOT); glds16(vsrc + (size_t)t * 64 * QP, kdst0 + d * SLOT + 8192);
        if (MODE == 1) glds4(msrc + 2 * t, mdst0 + d * 2048); }
    unsigned selbits = 0;
    if (MODE == 0) {
        if (tid < 256) ((LAS f32x4*)kml)[tid] = ((const f32x4*)(kmean + (size_t)((b * 4 + h) * 16) * 64))[tid];
        __syncthreads();
        if (qt > 0) {
            float qv[32];
#pragma unroll
            for (int ks = 0; ks < 4; ++ks) { const u32x4 qq = __builtin_bit_cast(u32x4, qf[ks]);
#pragma unroll
                for (int k = 0; k < 4; ++k) { qv[8 * ks + 2 * k] = bf_lo(qq[k]); qv[8 * ks + 2 * k + 1] = bf_hi(qq[k]); } }
            float v1 = NEG_INF, v2 = NEG_INF, v3 = NEG_INF; int i1 = -1, i2 = -1, i3 = -1;
#pragma unroll 1
            for (int j = 0; j < qt; ++j) {
                float g = 0.f;
#pragma unroll
                for (int ks = 0; ks < 4; ++ks) { const f32x4 k0 = *(const LAS f32x4*)(kml + j * 64 + 16 * ks + 8 * hi), k1 = *(const LAS f32x4*)(kml + j * 64 + 16 * ks + 8 * hi + 4);
                    g += qv[8 * ks + 0] * k0[0] + qv[8 * ks + 1] * k0[1] + qv[8 * ks + 2] * k0[2] + qv[8 * ks + 3] * k0[3] + qv[8 * ks + 4] * k1[0] + qv[8 * ks + 5] * k1[1] + qv[8 * ks + 6] * k1[2] + qv[8 * ks + 7] * k1[3]; }
                g = sum_xor32(g);
                if (g > v1) { v3 = v2; i3 = i2; v2 = v1; i2 = i1; v1 = g; i1 = j; }
                else if (g > v2) { v3 = v2; i3 = i2; v2 = g; i2 = j; }
                else if (g > v3) { v3 = g; i3 = j; }
            }
            if (i1 >= 0) selbits |= 1u << i1; if (i2 >= 0) selbits |= 1u << i2; if (i3 >= 0) selbits |= 1u << i3;
        }
    }
    const int vboff = (4 * hi + ((lane & 15) >> 2)) * 64 + ((lane >> 4) & 1) * 32 + (lane & 3) * 8;
    float m_run = -1e30f, l_run = 0.f; f32x16 o[2], lacc = splat16(0.f); o[0] = splat16(0.f); o[1] = splat16(0.f);
    int scur = 0, siss = D;
    asm volatile("s_waitcnt vmcnt(0)" ::: "memory");
    asm volatile("" : "+v"(qf[0]), "+v"(qf[1]), "+v"(qf[2]), "+v"(qf[3]));
#pragma unroll 1
    for (int kt = 0; kt < NT; ++kt) {
        if (MODE == 1) WAITV_BAR(6); else WAITV_BAR(4);
        { const int t = kt + D < NT ? kt + D : NT - 1;
          glds16(ksrc + (size_t)t * 64 * QP, kdst0 + siss * SLOT); glds16(vsrc + (size_t)t * 64 * QP, kdst0 + siss * SLOT + 8192);
          if (MODE == 1) glds4(msrc + 2 * t, mdst0 + siss * 2048); }
        const LAS unsigned char* cur = lds + scur * SLOT;
        if (MODE == 0) {
            const int j = kt >> 2;
            if (j < qt) { const bool sel = (selbits >> j) & 1u; if (__ballot(sel) != 0ull) { if (FAST) flash_step<FAST, 2>(m_run, l_run, lacc, o, cur, cur + 8192, QReg{qf}, MaskLaneP{sel ? 0xffffffffu : 0u}, r32, hi, vboff); else flash_step<FAST, 2>(m_run, l_run, lacc, o, cur, cur + 8192, QReg{qf}, MaskLane{sel ? 0.f : NEG_INF}, r32, hi, vboff); } }
            else { const int kb0 = 64 * (kt & 3); if (kb0 <= 32 * w + 31) flash_step<FAST, 2>(m_run, l_run, lacc, o, cur, cur + 8192, QReg{qf}, MaskCausal{kb0, qloc, hi}, r32, hi, vboff); }
        } else {
            if (kt <= wlim) { const LAS unsigned* mp = mwl + scur * 512 + w * 64; const unsigned cw0 = mp[r32], cw1 = mp[32 + r32];
                flash_step<FAST, 2>(m_run, l_run, lacc, o, cur, cur + 8192, QReg{qf}, MaskBits{~cw0 >> (4 * hi), ~cw1 >> (4 * hi)}, r32, hi, vboff); }
        }
        scur = scur + 1 == NS ? 0 : scur + 1; siss = siss + 1 == NS ? 0 : siss + 1;
    }
    asm volatile("s_waitcnt vmcnt(0)" ::: "memory");
    const float inv = 1.0f / (FAST ? lacc[0] : sum_xor32(l_run));
    bf16_t* orow = obuf + qrow * 256 + 64 * h;
#pragma unroll
    for (int db = 0; db < 2; ++db)
#pragma unroll
        for (int g = 0; g < 4; ++g)
            *(u32x2*)(orow + 32 * db + 8 * g + 4 * hi) = (u32x2){cvt_pk_bf16(o[db][4 * g] * inv, o[db][4 * g + 1] * inv), cvt_pk_bf16(o[db][4 * g + 2] * inv, o[db][4 * g + 3] * inv)};
}

template <bool FAST>
__device__ __forceinline__ void attn_c_unit(int b, int h, int qt, const bf16_t* qkv, bf16_t* oc, float lam, const float* subg, float coef, LAS unsigned char* lds, int tid, int lane, int w) {
    const int r32 = lane & 31, hi = lane >> 5;
    const size_t rowbase = (size_t)b * SEQ; const int q0 = 256 * qt, qloc = 32 * w + r32; const size_t qrow = rowbase + q0 + qloc;
    LAS unsigned char* qimg = lds + 65536 + w * 8192 + lane * 16;
    __syncthreads();
#pragma unroll
    for (int ks = 0; ks < 4; ++ks) { *(LAS bf16x8*)(qimg + ks * 1024) = *(const bf16x8*)(qkv + qrow * QP + C_Q1 + 64 * h + 16 * ks + 8 * hi); *(LAS bf16x8*)(qimg + 4096 + ks * 1024) = *(const bf16x8*)(qkv + qrow * QP + C_Q2 + 64 * h + 16 * ks + 8 * hi); }
    const bf16_t* k1src = FAST ? qkv + (rowbase + kdma_row(w, lane)) * QP + C_K1 + 64 * h + 8 * kdma_chunk(w, lane)
                               : qkv + (rowbase + lane) * QP + C_K1 + 64 * h + 8 * w;
    const bf16_t* k2src = k1src + (C_K2 - C_K1);
    const bf16_t* v0src = qkv + (rowbase + 16 * (w & 3) + (lane >> 2)) * QP + C_VC + 128 * h + 32 * (w >> 2) + 8 * (lane & 3);
    const bf16_t* v1src = v0src + 64;
    const int vboff = (4 * hi + ((lane & 15) >> 2)) * 64 + ((lane >> 4) & 1) * 32 + (lane & 3) * 8;
    const int NT = 4 * qt + 4;
    float m1 = -1e30f, l1 = 0.f, m2 = -1e30f, l2 = 0.f; f32x16 o1[4], o2[4];
#pragma unroll
    for (int i = 0; i < 4; ++i) { o1[i] = splat16(0.f); o2[i] = splat16(0.f); }
    dma16(k1src, lds + w * 1024); dma16(k2src, lds + 8192 + w * 1024); dma16(v0src, lds + 16384 + w * 1024); dma16(v1src, lds + 16384 + 8192 + w * 1024);
    DMA_WAIT_SYNC();
#pragma unroll 1
    for (int kt = 0; kt < NT; ++kt) {
        LAS unsigned char* cur = lds + (kt & 1) * 32768; LAS unsigned char* nxt = lds + ((kt + 1) & 1) * 32768;
        if (kt + 1 < NT) { const size_t adv = (size_t)(kt + 1) * 64 * QP;
            dma16(k1src + adv, nxt + w * 1024); dma16(k2src + adv, nxt + 8192 + w * 1024); dma16(v0src + adv, nxt + 16384 + w * 1024); dma16(v1src + adv, nxt + 16384 + 8192 + w * 1024); }
        const bool band = kt >= 4 * qt; const int kb0 = 64 * (kt & 3);
        if (!band || kb0 <= 32 * w + 31) { const MaskCausalIf mk{band, kb0, qloc, hi};
            if (FAST) flash_tile_dual_ref0<true>(l1, l2, o1, o2, cur, cur + 8192, cur + 16384, qimg, qimg + 4096, mk, r32, hi, vboff);
            else { flash_step<false, 4>(m1, l1, o1[0], o1, cur, cur + 16384, QLds{qimg}, mk, r32, hi, vboff); flash_step<false, 4>(m2, l2, o2[0], o2, cur + 8192, cur + 16384, QLds{qimg + 4096}, mk, r32, hi, vboff); } }
        DMA_WAIT_SYNC();
    }
    const float i1 = 1.0f / sum_xor32(l1), i2 = lam / sum_xor32(l2);
    float ss = 0.f;
#pragma unroll
    for (int db = 0; db < 4; ++db) { o1[db] = o1[db] * i1 - o2[db] * i2;
#pragma unroll
        for (int r = 0; r < 16; ++r) ss += o1[db][r] * o1[db][r]; }
    ss = sum_xor32(ss);
    const float rn = coef / sqrtf(ss * (1.0f / 128.0f) + EPS);
    bf16_t* orow = oc + qrow * 512 + 128 * h;
#pragma unroll
    for (int db = 0; db < 4; ++db)
#pragma unroll
        for (int g = 0; g < 4; ++g) { const int d = 32 * db + 8 * g + 4 * hi; const f32x4 gg = *(const f32x4*)(subg + d);
            *(u32x2*)(orow + d) = (u32x2){cvt_pk_bf16(o1[db][4 * g] * rn * gg[0], o1[db][4 * g + 1] * rn * gg[1]), cvt_pk_bf16(o1[db][4 * g + 2] * rn * gg[2], o1[db][4 * g + 3] * rn * gg[3])}; }
}

__device__ __forceinline__ void index_unit(int b, int i64, const bf16_t* qkv, unsigned* maskg, unsigned char* scr, LAS unsigned char* lds, int tid, int lane, int w) {
    constexpr int NS = 5, D = 4, HS = 257, RING = 84224, TOFF = 65792, TROW = 144;
    const int r32 = lane & 31, hi = lane >> 5;
    const unsigned lds0 = (unsigned)(size_t)lds;
    LAS unsigned* hist = (LAS unsigned*)lds; LAS unsigned char* ring = lds + RING; LAS unsigned char* mb8 = lds;
    LAS int* thrB1 = (LAS int*)(lds + 125184); LAS int* thrRem = thrB1 + 64; LAS int* thrT = thrB1 + 128; LAS int* thrNeed = thrB1 + 192;
    const size_t rowbase = (size_t)b * SEQ; const int q0 = 64 * i64, NT = i64 + 1;
    __syncthreads();
    {
        const int hh = 4 * ((r32 >> 3) & 1) + (r32 & 3), qp = 2 * (r32 >> 4) + ((r32 >> 2) & 1);
        bf16x8 aq[2][4]; float wv[2][2][8];
#pragma unroll
        for (int rb = 0; rb < 2; ++rb) {
            const size_t row = rowbase + q0 + 8 * w + 4 * rb + qp;
#pragma unroll
            for (int ks = 0; ks < 4; ++ks) aq[rb][ks] = *(const bf16x8*)(qkv + row * QP + C_QI + 64 * hh + 16 * ks + 8 * hi);
#pragma unroll
            for (int hf = 0; hf < 2; ++hf) { const u32x4 ww = *(const u32x4*)(qkv + (rowbase + q0 + 8 * w + 4 * rb + 2 * hf + hi) * QP + C_WI);
#pragma unroll
                for (int k = 0; k < 4; ++k) { wv[rb][hf][2 * k] = bf_lo(ww[k]); wv[rb][hf][2 * k + 1] = bf_hi(ww[k]); } }
        }
#pragma unroll
        for (int rb = 0; rb < 2; ++rb) { asm volatile("" : "+v"(aq[rb][0]), "+v"(aq[rb][1]), "+v"(aq[rb][2]), "+v"(aq[rb][3]));
#pragma unroll
            for (int hf = 0; hf < 2; ++hf) asm volatile("" : "+v"(wv[rb][hf][0]), "+v"(wv[rb][hf][1]), "+v"(wv[rb][hf][2]), "+v"(wv[rb][hf][3]), "+v"(wv[rb][hf][4]), "+v"(wv[rb][hf][5]), "+v"(wv[rb][hf][6]), "+v"(wv[rb][hf][7])); }
        const bf16_t* ksrc = qkv + (rowbase + kdma_row(w, lane)) * QP + C_KI + 8 * kdma_chunk(w, lane);
        const unsigned kdst0 = (unsigned)__builtin_amdgcn_readfirstlane(lds0 + RING + w * 1024);
#pragma unroll
        for (int d = 0; d < D; ++d) { const int t = d < NT ? d : NT - 1; glds16(ksrc + (size_t)t * 64 * QP, kdst0 + d * 8192); }
        for (int i = tid; i < 4112; i += 512) ((LAS u32x4*)hist)[i] = (u32x4){0u, 0u, 0u, 0u};
        asm volatile("s_waitcnt lgkmcnt(0)" ::: "memory");
        int scur = 0, siss = D;
#pragma unroll 1
        for (int kt = 0; kt <= NT; ++kt) {
            if (kt < NT) WAITV_BAR(3); else { asm volatile("s_waitcnt vmcnt(0)" ::: "memory"); __syncthreads(); }
            if (kt > 0) {
                const u32x4 kk = *(const LAS u32x4*)(lds + TOFF + ((kt - 1) & 1) * 9216 + lane * TROW + w * 16);
                {
                    const u32x4 ks = *(const LAS u32x4*)(lds + TOFF + ((kt - 1) & 1) * 9216 + (8 * w + (lane >> 3)) * TROW + (lane & 7) * 16);
                    unsigned char* sp = scr + (size_t)(8 * w + (lane >> 3)) * 8192 + (size_t)(kt - 1) * 128 + (lane & 7) * 16;
                    if (kt < NT) asm volatile("global_store_dwordx4 %0, %1, off" :: "v"(sp), "v"(ks) : "memory");
                    else *(u32x4*)sp = ks; }
#pragma unroll
                for (int k = 0; k < 4; ++k) { const unsigned a = kk[k] & 0xffffu, c = kk[k] >> 16;
                    if (a) __hip_atomic_fetch_add(&hist[lane * HS + (a >> 8)], 1u, __ATOMIC_RELAXED, __HIP_MEMORY_SCOPE_WORKGROUP);
                    if (c) __hip_atomic_fetch_add(&hist[lane * HS + (c >> 8)], 1u, __ATOMIC_RELAXED, __HIP_MEMORY_SCOPE_WORKGROUP); }
            }
            if (kt == NT) break;
            { const int t = kt + D < NT ? kt + D : NT - 1; glds16(ksrc + (size_t)t * 64 * QP, kdst0 + siss * 8192); }
            const LAS unsigned char* kimg = ring + scur * 8192;
            const bool diag = kt == NT - 1;
#pragma unroll
            for (int rb = 0; rb < 2; ++rb)
#pragma unroll
                for (int kb = 0; kb < 2; ++kb) {
                    f32x16 d = splat16(0.f);
#pragma unroll
                    for (int ks = 0; ks < 4; ++ks) d = mfma32(aq[rb][ks], *(const LAS bf16x8*)(kimg + kimg_off(32 * kb + r32, 2 * ks + hi)), d);
#pragma unroll
                    for (int hf = 0; hf < 2; ++hf) {
                        float sc = 0.f;
#pragma unroll
                        for (int t = 0; t < 8; ++t) { const float mx_ = fmaxf(d[8 * hf + t], 0.f); asm("v_fma_f32 %0, %1, %2, %0" : "+v"(sc) : "v"(wv[rb][hf][t]), "v"(mx_)); }
                        const int ql = 8 * w + 4 * rb + 2 * hf + hi;
                        const unsigned u = (unsigned)__builtin_bit_cast(unsigned short, (_Float16)sc);
                        unsigned key = u ^ ((u & 0x8000u) ? 0xffffu : 0x8000u);
                        if (diag && 32 * kb + r32 > ql) key = 0u;
                        *(LAS unsigned short*)(lds + TOFF + (kt & 1) * 9216 + ql * TROW + (32 * kb + r32) * 2) = (unsigned short)key;
                    }
                }
            scur = scur + 1 == NS ? 0 : scur + 1; siss = siss + 1 == NS ? 0 : siss + 1;
        }
        asm volatile("s_waitcnt vmcnt(0)" ::: "memory");
        __syncthreads();
    }
#define IDX_SEARCH(STAGE) do { _Pragma("unroll 1") for (int qq = 0; qq < 8; ++qq) { const int q = 8 * w + qq; int target; \
        if (STAGE == 0) { if (q0 + q + 1 <= 256) { if (lane == 0) { thrB1[q] = 0x10000; thrRem[q] = 0; } continue; } target = 256; } \
        else { if (thrB1[q] == 0x10000) { if (lane == 0) { thrT[q] = 0; thrNeed[q] = 0; } continue; } target = thrRem[q]; } \
        const LAS unsigned* hp = hist + q * HS + 4 * lane; const int h0 = (int)hp[0], h1 = (int)hp[1], h2 = (int)hp[2], h3 = (int)hp[3]; \
        int P = h0 + h1 + h2 + h3; const int s_ = P; \
        _Pragma("unroll") for (int o = 1; o < 64; o <<= 1) { const int t_ = lane_val(P, (lane - o) & 63); if (lane >= o) P += t_; } \
        const int above = __builtin_amdgcn_readlane(P, 63) - P; (void)s_; \
        const int c3 = above + h3, c2 = c3 + h2, c1 = c2 + h1, c0 = c1 + h0; int bin = -1, ab = 0; \
        if (above < target && c3 >= target) { bin = 4 * lane + 3; ab = above; } else if (c3 < target && c2 >= target) { bin = 4 * lane + 2; ab = c3; } \
        else if (c2 < target && c1 >= target) { bin = 4 * lane + 1; ab = c2; } else if (c1 < target && c0 >= target) { bin = 4 * lane; ab = c1; } \
        if (bin >= 0) { if (STAGE == 0) { thrB1[q] = bin; thrRem[q] = target - ab; } else { thrT[q] = (thrB1[q] << 8) | bin; thrNeed[q] = target - ab; } } } \
        __syncthreads(); } while (0)
    IDX_SEARCH(0);
    const int qs = 8 * w + (lane >> 3), pc = lane & 7;
    const unsigned char* rrow = scr + (size_t)qs * 8192 + pc * 16;
    {
        __builtin_amdgcn_fence(__ATOMIC_ACQUIRE, "agent");
        asm volatile("s_waitcnt vmcnt(0)" ::: "memory");
        const int b1 = thrB1[qs];
        for (int i = tid; i < 4112; i += 512) ((LAS u32x4*)hist)[i] = (u32x4){0u, 0u, 0u, 0u};
        __syncthreads();
#pragma unroll 4
        for (int it = 0; it < NT; ++it) { const u32x4 kk = *(const u32x4*)(rrow + (size_t)it * 128);
#pragma unroll
            for (int k = 0; k < 4; ++k) { const unsigned a = kk[k] & 0xffffu, c = kk[k] >> 16;
                if ((int)(a >> 8) == b1) __hip_atomic_fetch_add(&hist[qs * HS + (a & 255u)], 1u, __ATOMIC_RELAXED, __HIP_MEMORY_SCOPE_WORKGROUP);
                if ((int)(c >> 8) == b1) __hip_atomic_fetch_add(&hist[qs * HS + (c & 255u)], 1u, __ATOMIC_RELAXED, __HIP_MEMORY_SCOPE_WORKGROUP); } }
        __syncthreads();
    }
    IDX_SEARCH(1);
    {
        const unsigned T = (unsigned)thrT[qs]; const int need = thrNeed[qs]; int tc = 0;
        __syncthreads();
#pragma unroll 2
        for (int it = 0; it < NT; ++it) { const u32x4 kk = *(const u32x4*)(rrow + (size_t)it * 128);
            unsigned sel = 0, eq = 0;
#pragma unroll
            for (int k = 0; k < 4; ++k) { const unsigned a = kk[k] & 0xffffu, c = kk[k] >> 16;
                sel |= (a > T ? 1u : 0u) << (2 * k); sel |= (c > T ? 1u : 0u) << (2 * k + 1); eq |= (a == T ? 1u : 0u) << (2 * k); eq |= (c == T ? 1u : 0u) << (2 * k + 1); }
            if (T == 0u) eq = 0u;
            if (__ballot(eq != 0u) != 0ull) {
                const int n = __popc(eq); int P = n;
#pragma unroll
                for (int o = 1; o < 8; o <<= 1) { const int t_ = lane_val(P, (lane - o) & 63); if ((lane & 7) >= o) P += t_; }
                int allow = need - tc - (P - n);
#pragma unroll
                for (int k = 0; k < 8; ++k) if (((eq >> k) & 1u) && allow > 0) { sel |= 1u << k; --allow; }
                tc += lane_val(P, (lane & ~7) + 7);
            }
            mb8[qs * 512 + it * 8 + pc] = (unsigned char)sel;
        }
        __syncthreads();
    }
#undef IDX_SEARCH
    for (int idx = tid; idx < 64 * 2 * NT; idx += 512) { const int q = idx / (2 * NT), wd = idx - q * 2 * NT; maskg[(rowbase + q0 + q) * 128 + wd] = ((const LAS unsigned*)mb8)[q * 128 + wd]; }
}

__device__ __forceinline__ int next_unit(unsigned* ctr, LAS unsigned char* lds, int tid) {
    volatile LAS int* bc = (volatile LAS int*)(lds + LX_BC);
    __syncthreads();
    if (tid == 0) *bc = (int)__hip_atomic_fetch_add(ctr, 1u, __ATOMIC_RELAXED, __HIP_MEMORY_SCOPE_AGENT);
    __syncthreads();
    return __builtin_amdgcn_readfirstlane(*bc);
}

__device__ __forceinline__ void m1_phase(const Args& a, unsigned char* ws, int lc, LAS unsigned char* lds, int lane, int wave, int vcu, int G) {
    const int l = lc & 1;
    const float* wrt = (const float*)(ws + WS_WRT);
    const float* bg = a.in[I_B_GROUP] + l * 4; const float* br = a.in[I_B_ROUTER] + l * 32;
    unsigned* cnt = (unsigned*)(ws + WS_CTL) + CW_CNT + 2048 * lc;
    unsigned* rt0 = (unsigned*)(ws + WS_RT0); unsigned* rt1 = (unsigned*)(ws + WS_RT1); f32x2* rtw = (f32x2*)(ws + WS_RTW);
    int* tokl = (int*)(ws + WS_TOKL); bf16_t* xg = (bf16_t*)(ws + WS_XG); float* rstdg = (float*)(ws + WS_RSTD); const float* gain = a.in[I_NORM_FFN] + (size_t)l * DM;
    const int r32 = lane & 31, kh = lane >> 5, wq = wave & 3, kpart = wave >> 2;
    LAS float* tl = (LAS float*)(lds + wq * 8192);
    LAS float* tss = tl + 32 * 40;
    LAS float* xs = (LAS float*)(lds + 32768 + wave * 8704);
#pragma unroll 1
    for (int t = wq * G + vcu; t < MTOK / 32; t += 4 * G) {
        const float* xbase = a.out + (size_t)(32 * t + (lane >> 4)) * DM + 512 * kpart + 4 * (lane & 15);
        bf16_t* xobase = xg + (size_t)(32 * t + (lane >> 4)) * DM + 512 * kpart + 4 * (lane & 15); const float* gbase = gain + 512 * kpart + 4 * (lane & 15);
        const float* wp0 = wrt + (size_t)r32 * DM + 512 * kpart + 4 * kh; const float* wp1 = wrt + (size_t)(32 + (r32 & 3)) * DM + 512 * kpart + 4 * kh;
        f32x16 d0 = splat16(0.f), d1 = splat16(0.f); float ss = 0.f;
        f32x4 xr[8];
#pragma unroll
        for (int j = 0; j < 8; ++j) xr[j] = *(const f32x4*)(xbase + (size_t)(4 * j) * DM);
#pragma unroll 1
        for (int c = 0; c < 8; ++c) {
            const f32x4 g4 = *(const f32x4*)(gbase + 64 * c);
#pragma unroll
            for (int j = 0; j < 8; ++j) { *(LAS f32x4*)(xs + (4 * j + (lane >> 4)) * 68 + 4 * (lane & 15)) = xr[j];
                const f32x4 o = xr[j] * g4; *(u32x2*)(xobase + (size_t)(4 * j) * DM + 64 * c) = (u32x2){cvt_pk_bf16(o[0], o[1]), cvt_pk_bf16(o[2], o[3])}; }
            if (c < 7) {
#pragma unroll
                for (int j = 0; j < 8; ++j) xr[j] = *(const f32x4*)(xbase + (size_t)(4 * j) * DM + 64 * (c + 1)); }
            LDS_WAIT(); asm volatile("" ::: "memory");
#pragma unroll
            for (int mm = 0; mm < 8; ++mm) {
                const f32x4 xa = *(const LAS f32x4*)(xs + r32 * 68 + 8 * mm + 4 * kh), b0 = *(const f32x4*)(wp0 + 64 * c + 8 * mm), b1 = *(const f32x4*)(wp1 + 64 * c + 8 * mm);
                ss += (xa[0] * xa[0] + xa[1] * xa[1]) + (xa[2] * xa[2] + xa[3] * xa[3]);
#pragma unroll
                for (int i = 0; i < 4; ++i) { d0 = __builtin_amdgcn_mfma_f32_32x32x2f32(xa[i], b0[i], d0, 0, 0, 0); d1 = __builtin_amdgcn_mfma_f32_32x32x2f32(xa[i], b1[i], d1, 0, 0, 0); }
            }
            LDS_WAIT(); asm volatile("" ::: "memory");
        }
        ss = sum_xor32(ss);
        if (kpart == 1) {
#pragma unroll
            for (int r = 0; r < 16; ++r) { tl[crow(r, kh) * 40 + r32] = d0[r]; if (r32 < 4) tl[crow(r, kh) * 40 + 32 + r32] = d1[r]; }
            if (kh == 0) tss[r32] = ss;
        }
        __syncthreads();
        if (kpart == 0) {
#pragma unroll
            for (int r = 0; r < 16; ++r) { tl[crow(r, kh) * 40 + r32] += d0[r]; if (r32 < 4) tl[crow(r, kh) * 40 + 32 + r32] += d1[r]; }
            ss += tss[r32];
            LDS_WAIT(); asm volatile("" ::: "memory");
            const float rstd = 1.0f / sqrtf(ss * (1.0f / DM) + EPS);
            const LAS float* my = tl + r32 * 40;
            float gl[4];
#pragma unroll
            for (int c = 0; c < 4; ++c) gl[c] = my[c] * rstd + bg[c];
            int g = 0; float gm = gl[0];
#pragma unroll
            for (int c = 1; c < 4; ++c) if (gl[c] > gm) { gm = gl[c]; g = c; }
            float den = 0.f;
#pragma unroll
            for (int c = 0; c < 4; ++c) den += __expf(gl[c] - gm);
            const float gwt = 1.0f / den;
            float le[8];
#pragma unroll
            for (int e = 0; e < 8; ++e) le[e] = my[4 + 8 * g + e] * rstd + br[8 * g + e];
            int i1 = 0; float v1 = le[0];
#pragma unroll
            for (int e = 1; e < 8; ++e) if (le[e] > v1) { v1 = le[e]; i1 = e; }
            int i2 = -1; float v2 = NEG_INF;
#pragma unroll
            for (int e = 0; e < 8; ++e) if (e != i1 && le[e] > v2) { v2 = le[e]; i2 = e; }
            const float ex = __expf(v2 - v1), w1 = 1.0f / (1.0f + ex), w2 = ex * w1;
            if (kh == 0) { const int e0 = g * 8 + i1, e1 = g * 8 + i2, m = 32 * t + r32;
                const unsigned r0 = atomicAdd(cnt + 64 * e0, 1u), r1 = atomicAdd(cnt + 64 * e1, 1u);
                rt0[m] = ((unsigned)e0 << 24) | r0; rt1[m] = ((unsigned)e1 << 24) | r1; rtw[m] = (f32x2){gwt * w1, gwt * w2};
                tokl[e0 * 32768 + (int)r0] = m; tokl[e1 * 32768 + (int)r1] = m; }
            if (kh == 0) rstdg[32 * t + r32] = rstd;
        }
        __syncthreads();
    }
}
__device__ __forceinline__ void moe_tables(const unsigned* cnt, const int* tokl, const float* rstdg, LAS unsigned char* lds, int tid, int c, int G) {
    LAS int* pstart = (LAS int*)(lds + LX_PSTART); LAS int* blk2e = (LAS int*)(lds + LX_BLK2E); LAS int* cntl = (LAS int*)(lds + LX_CNT); LAS int* tok = (LAS int*)(lds + LX_TOK);
    if (tid < 64) {
        const int cn = tid < NEXP ? (int)cnt[64 * tid] : 0, nb = (cn + 255) >> 8;
        int P = nb;
#pragma unroll
        for (int o = 1; o < 64; o <<= 1) { const int t = lane_val(P, (tid - o) & 63); if (tid >= o) P += t; }
        const int pb = P - nb;
        if (tid <= NEXP) pstart[tid] = pb * 256;
        if (tid < NEXP) cntl[tid] = cn;
        if (tid == NEXP) *(LAS int*)(lds + LX_NBLK) = pb < MAXBLK ? pb : MAXBLK;
#pragma unroll 1
        for (int k = 0; k < nb; ++k) if (pb + k < MAXBLK) blk2e[pb + k] = tid;
    }
    __syncthreads();
    const int nblk = *(const LAS int*)(lds + LX_NBLK), rbs = G / 4;
    LAS float* rst = (LAS float*)(lds + LX_RST);
    for (int k = 0; k < 6; ++k) { const int rb = c / 4 + k * rbs; if (rb >= nblk) break;
        const int e = blk2e[rb], r = rb * 256 - pstart[e] + (tid & 255);
        if (tid < 256) { const int tk = r < cntl[e] ? tokl[e * 32768 + r] : 0; tok[k * 256 + tid] = tk; rst[k * 256 + tid] = rstdg[tk]; } }
    __syncthreads();
}

#ifndef PHASES
#define PHASES 0xFFFF
#endif
#define PH(n) if constexpr (((PHASES) >> (n)) & 1)
#ifndef REPEAT_MASK
#define REPEAT_MASK 0
#endif
#define REP(k) for (int rep_ = 0; rep_ < 1 + (((REPEAT_MASK) >> (k)) & 1); ++rep_)
#ifndef GEMM_ALIGN
#define GEMM_ALIGN true
#endif
#ifndef GEMM_SP2
#define GEMM_SP2 true
#endif
#define PHASE_ENV() unsigned long long wsi_ = (unsigned long long)args.ws; int G = (int)gridDim.x, bx = (int)blockIdx.x; asm volatile("" : "+s"(wsi_), "+s"(G), "+s"(bx)); \
    unsigned char* const ws = (unsigned char*)(GAS unsigned char*)wsi_; const int vcu = (G % 8 == 0) ? (bx % 8) * (G / 8) + bx / 8 : bx;   \
    int tid = (int)threadIdx.x; asm volatile("" : "+v"(tid)); const int lane = tid & 63, wave = __builtin_amdgcn_readfirstlane(tid >> 6); \
    unsigned* const ctl = (unsigned*)(ws + WS_CTL); bf16_t* const QKV = (bf16_t*)(ws + WS_QKV); unsigned char* const SG = ws + WS_SG; unsigned* const MASK = (unsigned*)(ws + WS_MASK); float* const KMEAN = (float*)(ws + WS_KMEAN); \
    (void)lane; (void)wave; (void)ctl; (void)QKV; (void)SG; (void)MASK; (void)KMEAN; (void)vcu
#define GRID_BAR() do { unsigned long long wb_ = (unsigned long long)args.ws; asm volatile("" : "+s"(wb_)); XcdBarrier b_ = bar0; b_.bar = (unsigned*)((GAS unsigned char*)wb_ + WS_CTL) + CW_BAR; asm volatile("" : "+s"(b_.x)); xcd_barrier(b_); if (((REPEAT_MASK) >> 12) & 1) xcd_barrier(b_); } while (0)


template <int L> __device__ __forceinline__ void layer_body(const Args& args, LAS unsigned char* lds, const XcdBarrier& bar0) {
    constexpr int l = L;

        PH(0) for (int rep_ = 0; rep_ < 1 + ((((REPEAT_MASK) >> 0) & 1) && l == 0); ++rep_) { PHASE_ENV(); p0_phase(args, ws, l, lds, tid, lane, wave, vcu, G); }
        GRID_BAR();
        PH(1) REP(1) { PHASE_ENV();
            pg8::Gemm g{(const bf16_t*)(ws + WS_HN), (const bf16_t*)(ws + WS_WIN), MTOK, NT_IN * 256, DM}; pg8::StaticOrder S; S.init(MTOK, NT_IN * 256, G, bx);
            pg8::EpiInProj E{QKV, SG, (const float*)(ws + WS_COS), (const float*)(ws + WS_SIN), args.in[I_QK_GAIN] + l * 6 * 64, args.in[I_IDX_K_GAIN] + l * 64};
            pg8::gemm_phase<pg8::EpiInProj, pg8::StaticOrder, GEMM_ALIGN, GEMM_SP2>(lds, g, S, E);
        }
        GRID_BAR();
        { PHASE_ENV();
            LAS float* red = (LAS float*)lds;
            for (int it = bx; it < NBATCH * 4 * 16; it += G) { const int b = it >> 6, h = (it >> 4) & 3, blk = it & 15, d = tid & 63, rg = tid >> 6;
                const bf16_t* kp = QKV + ((size_t)b * SEQ + blk * 256 + rg * 32) * QP + C_KA + 64 * h + d; float s = 0.f;
#pragma unroll 8
                for (int r = 0; r < 32; ++r) s += __builtin_bit_cast(float, (unsigned)kp[(size_t)r * QP] << 16);
                __syncthreads(); red[tid] = s; __syncthreads();
                if (tid < 64) { float t = 0.f;
#pragma unroll
                    for (int k = 0; k < 8; ++k) t += red[k * 64 + tid];
                    KMEAN[(size_t)it * 64 + tid] = t * (1.0f / 256.0f); } }
            __syncthreads();
        }
        PH(2) REP(2) { PHASE_ENV();
            const float* dl = args.in[I_DIFF_LAMBDA] + l * 256;
            const float lam_init = 0.8f - 0.6f * __expf(-0.3f * (float)l);
            const float lam = __expf(wave_sum(dl[lane] * dl[64 + lane])) - __expf(wave_sum(dl[128 + lane] * dl[192 + lane])) + lam_init;
            const float* subg = args.in[I_DIFF_SUBLN] + l * 128;
            unsigned* qc = ctl + CW_QUEUE + 64 * (l * 4 + 0 + 8 * rep_);
            const float* qkg = args.in[I_QK_GAIN] + l * 6 * 64;
            if (softmax_ref0_ok(qkg + 4 * 64, qkg + 5 * 64, lane)) { for (;;) { const int u = next_unit(qc, lds, tid); if (u >= 512) break; const int r = u & 31; attn_c_unit<true>(r >> 2, r & 3, 15 - (u >> 5), QKV, (bf16_t*)(ws + WS_OC), lam, subg, 1.0f - lam_init, lds, tid, lane, wave); } }
            else { for (;;) { const int u = next_unit(qc, lds, tid); if (u >= 512) break; const int r = u & 31; attn_c_unit<false>(r >> 2, r & 3, 15 - (u >> 5), QKV, (bf16_t*)(ws + WS_OC), lam, subg, 1.0f - lam_init, lds, tid, lane, wave); } }
        }
        PH(3) REP(3) { PHASE_ENV();
            unsigned* qi = ctl + CW_QUEUE + 64 * (l * 4 + 1 + 8 * rep_);
            for (;;) { const int u = next_unit(qi, lds, tid); if (u >= 512) break; index_unit(u & 7, 63 - (u >> 3), QKV, MASK, ws + WS_WGU + (size_t)bx * 524288, lds, tid, lane, wave); }
        }
        GRID_BAR();
        PH(4) REP(4) { PHASE_ENV();
            unsigned* qa = ctl + CW_QUEUE + 64 * (l * 4 + 2 + 8 * rep_);
            const float* qkg = args.in[I_QK_GAIN] + l * 6 * 64;
            if (softmax_ref0_ok(qkg, qkg + 64, lane)) { for (;;) { const int u = next_unit(qa, lds, tid); if (u >= 512) break; const int r = u & 31; attn_ab_unit<0, true>(r >> 2, r & 3, 15 - (u >> 5), QKV, (bf16_t*)(ws + WS_OA), KMEAN, MASK, lds, tid, lane, wave); } }
            else { for (;;) { const int u = next_unit(qa, lds, tid); if (u >= 512) break; const int r = u & 31; attn_ab_unit<0, false>(r >> 2, r & 3, 15 - (u >> 5), QKV, (bf16_t*)(ws + WS_OA), KMEAN, MASK, lds, tid, lane, wave); } }
        }
        PH(5) REP(5) { PHASE_ENV();
            unsigned* qb = ctl + CW_QUEUE + 64 * (l * 4 + 3 + 8 * rep_);
            const float* qkg = args.in[I_QK_GAIN] + l * 6 * 64;
            if (softmax_ref0_ok(qkg + 2 * 64, qkg + 3 * 64, lane)) { for (;;) { const int u = next_unit(qb, lds, tid); if (u >= 512) break; const int r = u & 31; attn_ab_unit<1, true>(r >> 2, r & 3, 15 - (u >> 5), QKV, (bf16_t*)(ws + WS_OB), KMEAN, MASK, lds, tid, lane, wave); } }
            else { for (;;) { const int u = next_unit(qb, lds, tid); if (u >= 512) break; const int r = u & 31; attn_ab_unit<1, false>(r >> 2, r & 3, 15 - (u >> 5), QKV, (bf16_t*)(ws + WS_OB), KMEAN, MASK, lds, tid, lane, wave); } }
        }
        { PHASE_ENV();
            unsigned* qw = ctl + CW_QUEUE + 64 * (16 + l);
            for (;;) { const int c = next_unit(qw, lds, tid); if (c >= (32 * 32 * 16 + 32 * 32 * 8) / 128) break; convert_weights<true>(args, ws, l, lds, lane, wave, vcu, G, c); }
        }
        GRID_BAR();
        PH(6) REP(6) {
            { PHASE_ENV(); pg8::StaticOrder S; S.init(MTOK, DM, G, bx); pg8::Gemm g{(const bf16_t*)(ws + WS_OA), (const bf16_t*)(ws + WS_WPA), MTOK, DM, 256}; pg8::EpiMerge<0> E{(bf16_t*)(ws + WS_MERGED), SG}; pg8::gemm_phase<pg8::EpiMerge<0>, pg8::StaticOrder, GEMM_ALIGN, GEMM_SP2>(lds, g, S, E); }
            { PHASE_ENV(); pg8::StaticOrder S; S.init(MTOK, DM, G, bx); pg8::Gemm g{(const bf16_t*)(ws + WS_OB), (const bf16_t*)(ws + WS_WPB), MTOK, DM, 256}; pg8::EpiMerge<1> E{(bf16_t*)(ws + WS_MERGED), SG}; pg8::gemm_phase<pg8::EpiMerge<1>, pg8::StaticOrder, GEMM_ALIGN, GEMM_SP2>(lds, g, S, E); }
            { PHASE_ENV(); pg8::StaticOrder S; S.init(MTOK, DM, G, bx); pg8::Gemm g{(const bf16_t*)(ws + WS_OC), (const bf16_t*)(ws + WS_WPC), MTOK, DM, 512}; pg8::EpiMerge<2> E{(bf16_t*)(ws + WS_MERGED), SG}; pg8::gemm_phase<pg8::EpiMerge<2>, pg8::StaticOrder, GEMM_ALIGN, GEMM_SP2>(lds, g, S, E); }
        }
        GRID_BAR();
        PH(7) for (int rep_ = 0; rep_ < 1 + ((((REPEAT_MASK) >> 7) & 1) && l == 0); ++rep_) { PHASE_ENV();
            pg8::Gemm g{(const bf16_t*)(ws + WS_MERGED), (const bf16_t*)(ws + WS_WO), MTOK, DM, DM}; pg8::StaticOrder S; S.init(MTOK, DM, G, bx);
            pg8::EpiResid E{l == 0 ? args.in[I_X] : args.out, args.out};
            pg8::gemm_phase<pg8::EpiResid, pg8::StaticOrder, GEMM_ALIGN, GEMM_SP2>(lds, g, S, E);
        }
        GRID_BAR();
        PH(8) REP(8) { PHASE_ENV(); m1_phase(args, ws, l + 2 * rep_, lds, lane, wave, vcu, G); }
        GRID_BAR();
        { PHASE_ENV(); moe_tables(ctl + CW_CNT + 2048 * (l + 2 * (((REPEAT_MASK) >> 8) & 1)), (const int*)(ws + WS_TOKL), (const float*)(ws + WS_RSTD), lds, tid, vcu, G); }
        PH(10) REP(10) { PHASE_ENV();
            const int nblk = *(const LAS int*)(lds + LX_NBLK);
            pg8::Gemm g{(const bf16_t*)(ws + WS_XG), (const bf16_t*)(ws + WS_WGU), MTOK, NEXP * 1024, DM};
            pg8::MoeOrder S{nblk * 4, G, vcu, (const LAS int*)(lds + LX_BLK2E)};
            pg8::EpiGateUp E{(bf16_t*)(ws + WS_HID), (const LAS float*)(lds + LX_RST), G / 4}; pg8::AMapMoe AM{(const LAS int*)(lds + LX_TOK), G / 4};
            pg8::gemm_phase<pg8::EpiGateUp, pg8::MoeOrder, GEMM_ALIGN, GEMM_SP2, pg8::AMapMoe>(lds, g, S, E, AM);
        }
        GRID_BAR();
        PH(11) REP(11) { PHASE_ENV();
            const int nblk = *(const LAS int*)(lds + LX_NBLK);
            pg8::Gemm g{(const bf16_t*)(ws + WS_HID), (const bf16_t*)(ws + WS_WD), MAXBLK * 256, NEXP * 1024, DEXP};
            pg8::MoeOrder S{nblk * 4, G, vcu, (const LAS int*)(lds + LX_BLK2E)};
            pg8::EpiDown E{(bf16_t*)(ws + WS_Y)};
            pg8::gemm_phase<pg8::EpiDown, pg8::MoeOrder, GEMM_ALIGN, GEMM_SP2>(lds, g, S, E);
        }
        GRID_BAR();
    }

__global__ void __launch_bounds__(512, 2) fwd_kernel(Args args) {
    extern __shared__ __attribute__((aligned(16))) unsigned char lds_raw[];
    LAS unsigned char* lds = (LAS unsigned char*)lds_raw;
    for (int u = threadIdx.x; u < (LDS_BYTES - LDSX) / 4; u += 512) ((LAS unsigned*)(lds + LDSX))[u] = 0u;
    __syncthreads();
    const XcdBarrier bar0 = xcd_barrier_post((unsigned*)(args.ws + WS_CTL) + CW_BAR, (volatile LAS unsigned*)(lds + LX_BAR));
    layer_body<0>(args, lds, bar0);
    layer_body<1>(args, lds, bar0);
    { PHASE_ENV();
        const int gw = vcu * 8 + wave, NGW = G * 8; const LAS int* pstart = (const LAS int*)(lds + LX_PSTART);
        for (int m = gw; m < MTOK; m += NGW) token_row<true, false>(args.out, args.out, (const bf16_t*)(ws + WS_Y), (const unsigned*)(ws + WS_RT0), (const unsigned*)(ws + WS_RT1), (const f32x2*)(ws + WS_RTW), pstart, nullptr, nullptr, m, lane);
    }
}

extern "C" void kernel_launch(void* const* d_in, const int* in_sizes, int n_in, void* d_out, int out_size, void* d_ws, size_t ws_size, hipStream_t stream) {
    static int grid = 0;
    if (grid == 0) {
        if (n_in != N_INPUTS || in_sizes[0] != MTOK * DM || out_size != MTOK * DM || ws_size < WS_END) {
            fprintf(stderr, "kernel_launch: built for %d inputs, x/out of %d floats, >= %zu bytes of workspace; got n_in %d, in0 %d, out %d, ws %zu; nothing launched\n", (int)N_INPUTS, MTOK * DM, (size_t)WS_END, n_in, n_in > 0 ? in_sizes[0] : -1, out_size, ws_size);
            grid = -1; return; }
        int dev = 0, cus = 0;
        if (hipGetDevice(&dev) != hipSuccess || hipDeviceGetAttribute(&cus, hipDeviceAttributeMultiprocessorCount, dev) != hipSuccess) { fprintf(stderr, "kernel_launch: device query failed\n"); grid = -1; return; }
        if (hipFuncSetAttribute((const void*)fwd_kernel, hipFuncAttributeMaxDynamicSharedMemorySize, LDS_BYTES) != hipSuccess) { fprintf(stderr, "kernel_launch: hipFuncSetAttribute failed\n"); grid = -1; return; }
        int per_cu = 0;
        if (hipOccupancyMaxActiveBlocksPerMultiprocessor(&per_cu, (const void*)fwd_kernel, 512, LDS_BYTES) != hipSuccess || per_cu < 1) fprintf(stderr, "kernel_launch: note: occupancy query reports %d workgroups per CU\n", per_cu);
        (void)hipGetLastError();
        grid = cus;
    }
    if (grid < 0) return;
    if (hipMemsetAsync((char*)d_ws + WS_CTL, 0, CTL_BYTES, stream) != hipSuccess) { fprintf(stderr, "kernel_launch: memset failed\n"); return; }
    Args a{};
    for (int i = 0; i < N_INPUTS; ++i) a.in[i] = (const float*)d_in[i];
    a.out = (float*)d_out; a.ws = (unsigned char*)d_ws;
    hipLaunchKernelGGL(fwd_kernel, dim3(grid), dim3(512), LDS_BYTES, stream, a);
    const hipError_t le = hipPeekAtLastError();
    if (le != hipSuccess) fprintf(stderr, "kernel_launch: launch failed: %s\n", hipGetErrorName(le));
}
```

```cpp
#include <hip/hip_runtime.h>
#include <cstdio>
#include <cstdint>

#define LAS __attribute__((address_space(3)))
#define GAS __attribute__((address_space(1)))
typedef unsigned short bf16_t;
typedef short bf16x8 __attribute__((ext_vector_type(8)));
typedef short s16x4 __attribute__((ext_vector_type(4)));
typedef float f32x4 __attribute__((ext_vector_type(4)));
typedef float f32x2 __attribute__((ext_vector_type(2)));
typedef float f32x16 __attribute__((ext_vector_type(16)));
typedef unsigned u32x4 __attribute__((ext_vector_type(4)));
typedef unsigned u32x2 __attribute__((ext_vector_type(2)));

constexpr int NBATCH = 8, SEQ = 4096, MTOK = NBATCH * SEQ, DM = 1024, NLAYER = 2;
constexpr int QP = 3656;
constexpr int C_QA = 0, C_KA = 256, C_VA = 512, C_QB = 768, C_KB = 1024, C_VB = 1280, C_QI = 1536, C_KI = 2048, C_WI = 2112,
              C_Q1 = 2120, C_Q2 = 2376, C_K1 = 2632, C_K2 = 2888, C_VC = 3144, C_G = 3656, D_IN = 6728;
constexpr int NT_IN = 27;
constexpr int NEXP = 32, DEXP = 512, MAXBLK = 288;
constexpr float C2 = 0.125f * 1.4426950408889634f;
constexpr float EPS = 1e-6f;
#ifndef REF0_ENABLE
#define REF0_ENABLE 1
#endif

constexpr size_t MiB = 1u << 20;
constexpr size_t WS_CTL = 0, CTL_BYTES = 1 * MiB;
constexpr size_t WS_COS = 1 * MiB, WS_SIN = WS_COS + 512 * 1024;
constexpr size_t WS_SMALL = 2 * MiB;
constexpr size_t WS_KMEAN = WS_SMALL, WS_RT0 = WS_SMALL + 256 * 1024, WS_RT1 = WS_SMALL + 384 * 1024, WS_RTW = WS_SMALL + 512 * 1024, WS_WRT = WS_SMALL + 768 * 1024;
constexpr size_t WS_WIN = 3 * MiB;
constexpr size_t WS_WPA = 17 * MiB, WS_WPB = WS_WPA + 512 * 1024, WS_WPC = 18 * MiB;
constexpr size_t WS_WO = 19 * MiB;
constexpr size_t WS_WGU = 21 * MiB;
constexpr size_t WS_WD = 85 * MiB;
constexpr size_t WS_HN = 117 * MiB;
constexpr size_t WS_OA = WS_HN, WS_OB = WS_HN + 16 * MiB, WS_OC = WS_HN + 32 * MiB;
constexpr size_t WS_QKV = 181 * MiB;
constexpr size_t WS_MERGED = WS_QKV, WS_Y = WS_QKV, WS_HID = WS_QKV + 144 * MiB;
constexpr size_t WS_XG = WS_QKV, WS_TOKL = WS_QKV + 64 * MiB, WS_RSTD = WS_QKV + 68 * MiB;
constexpr size_t WS_SG = 410 * MiB;
constexpr size_t WS_MASK = 506 * MiB;
constexpr size_t WS_END = 522 * MiB;
static_assert((size_t)MTOK * QP * 2 <= 229 * MiB && (size_t)MAXBLK * 256 * 1024 * 2 <= 144 * MiB && (size_t)MAXBLK * 256 * 512 * 2 <= 72 * MiB, "ws map");
constexpr int CW_BAR = 4096;
constexpr int CW_QUEUE = 8192;
constexpr int CW_CNT = 16384;

constexpr int LDSX = 131072;
constexpr int LX_BAR = LDSX, LX_BC = LDSX + 16, LX_NBLK = LDSX + 32, LX_PSTART = LDSX + 64, LX_BLK2E = LDSX + 256, LX_CNT = LDSX + 1536, LX_TOK = LDSX + 2048, LX_RST = LDSX + 2048 + 6144;
constexpr int LDS_BYTES = 147456;

typedef __bf16 bf16x2_t __attribute__((ext_vector_type(2)));
__device__ __forceinline__ unsigned cvt_pk_bf16(float lo, float hi) { const f32x2 v = {lo, hi}; const bf16x2_t b = __builtin_convertvector(v, bf16x2_t); return __builtin_bit_cast(unsigned, b); }
__device__ __forceinline__ float bf_lo(unsigned w) { return __builtin_bit_cast(float, w << 16); }
__device__ __forceinline__ float bf_hi(unsigned w) { return __builtin_bit_cast(float, w & 0xffff0000u); }
template <int M> __device__ __forceinline__ float xor_lane(float v) {
    return __builtin_bit_cast(float, __builtin_amdgcn_ds_swizzle(__builtin_bit_cast(int, v), (M << 10) | 0x1f)); }
__device__ __forceinline__ float sum_xor32(float v) {
    const unsigned u = __builtin_bit_cast(unsigned, v); const auto rr = __builtin_amdgcn_permlane32_swap(u, u, false, false);
    return __builtin_bit_cast(float, (unsigned)rr[0]) + __builtin_bit_cast(float, (unsigned)rr[1]); }
__device__ __forceinline__ float max_xor32(float v) {
    const unsigned u = __builtin_bit_cast(unsigned, v); const auto rr = __builtin_amdgcn_permlane32_swap(u, u, false, false);
    return fmaxf(__builtin_bit_cast(float, (unsigned)rr[0]), __builtin_bit_cast(float, (unsigned)rr[1])); }
__device__ __forceinline__ int lane_val(int v, int src_lane) { return __builtin_amdgcn_ds_bpermute(src_lane << 2, v); }
__device__ __forceinline__ float wave_sum(float v) {
    v += xor_lane<1>(v); v += xor_lane<2>(v); v += xor_lane<4>(v); v += xor_lane<8>(v); v += xor_lane<16>(v);
    return sum_xor32(v);
}
__device__ __forceinline__ float fast_exp2(float x) { return __builtin_amdgcn_exp2f(x); }
__device__ __forceinline__ float fast_rcp(float x) { return __builtin_amdgcn_rcpf(x); }

namespace pg8 {
#define PG8_LAS __attribute__((address_space(3)))
typedef unsigned short bf16_t;
typedef short bf16x8 __attribute__((ext_vector_type(8)));
typedef float f32x4 __attribute__((ext_vector_type(4)));
typedef unsigned u32x4 __attribute__((ext_vector_type(4)));
constexpr int BM = 256, BK = 64, HALF = 128, HTB = HALF * BK * 2  , STAGE_BYTES = 8 * HTB, NXCD = 8, WGM = 8;

__host__ __device__ __forceinline__ int lds_byte(int r, int c) { const int st = (r >> 4) * 2 + (c >> 5), rr = r & 15, cc = c & 31, ob = rr * 64 + cc * 2; return st * 1024 + (ob ^ (((ob >> 9) & 1) << 5)); }
__host__ __device__ __forceinline__ void stage_rc(int b, int& R, int& C) { const int st = b / 1024, sb = b % 1024, swz = sb ^ (((sb >> 9) & 1) << 5); R = (st >> 1) * 16 + swz / 64; C = (st & 1) * 32 + (swz % 64) / 2; }
__host__ __device__ __forceinline__ int perm32(int rho) { const int n = rho >> 4, i = rho & 15; return 8 * (i >> 2) + 4 * n + (i & 3); }
struct Unit { int pm, pn; };
struct Gemm { const bf16_t* A; const bf16_t* Bt; int M, N, K; };

struct StaticOrder {
    int nM, nN, nwg, G, c;
    __host__ __device__ void init(int M, int N, int G_, int c_) { nM = M / BM; nN = N / BM; nwg = nM * nN; G = G_; c = c_; }
    __host__ __device__ bool next(int i, Unit& u) const {
        const long L = (long)i * G + c; if (L >= nwg) return false;
        int wgid = (int)L; { const int q = nwg / NXCD, r = nwg % NXCD, xcd = wgid % NXCD, off = wgid / NXCD; wgid = (xcd < r ? xcd * (q + 1) : r * (q + 1) + (xcd - r) * q) + off; }
        const int nig = WGM * nN, gid = wgid / nig, fm = gid * WGM, gsz = (nM - fm) < WGM ? (nM - fm) : WGM;
        u.pm = fm + ((wgid % nig) % gsz); u.pn = (wgid % nig) / gsz; return true;
    }
    __device__ __forceinline__ void a_ready(const Unit&) const {}
    __device__ __forceinline__ void done(const Unit&) const {}
};


struct EpiInProj {
    static constexpr bool PERM = false, AFTER_DRAIN = false;
    bf16_t* qkv; unsigned char* sg; const float* cosT; const float* sinT; const float* qkg; const float* ikg;
    __device__ __forceinline__ void operator()(const f32x4 (&acc)[2][2][4][2], const Unit& u, int wr, int wc, int fr, int fq) const {
        const int pn = u.pn, row0 = u.pm * BM + wr * 64 + fr;
        if (pn >= 15) {
            unsigned char* base = sg + (size_t)row0 * 3072 + (pn - 15) * 256 + wc * 64 + fq * 16;
#pragma unroll
            for (int ai = 0; ai < 2; ++ai)
#pragma unroll
                for (int m = 0; m < 4; ++m) {
                    unsigned w[2][2];
#pragma unroll
                    for (int bj = 0; bj < 2; ++bj)
#pragma unroll
                        for (int n = 0; n < 2; ++n) { unsigned pk = 0;
#pragma unroll
                            for (int i = 0; i < 4; i += 2) { const float x0 = fminf(fmaxf(acc[ai][bj][m][n][i], -30.f), 30.f), x1 = fminf(fmaxf(acc[ai][bj][m][n][i + 1], -30.f), 30.f);
                                const float a = 1.0f + fast_exp2(-1.4426950408889634f * x0), b = 1.0f + fast_exp2(-1.4426950408889634f * x1), r = 255.0f * fast_rcp(a * b);
                                pk = __builtin_amdgcn_cvt_pk_u8_f32(floorf(b * r + 0.5f), i, pk); pk = __builtin_amdgcn_cvt_pk_u8_f32(floorf(a * r + 0.5f), i + 1, pk); }
                            w[bj][n] = pk; }
                    *(u32x4*)(base + (size_t)(ai * HALF + m * 16) * 3072) = (u32x4){w[0][0], w[0][1], w[1][0], w[1][1]};
                }
            return;
        }
        int type = 0, gi = 0; bool qscale = false;
        int ocol = (pn < 8 ? 256 * pn : C_Q1 + 256 * (pn - 9)) + 64 * wc;
        switch (pn) {
            case 0: type = 2; gi = 0; qscale = true; break;
            case 1: type = 2; gi = 1; break;
            case 3: type = 2; gi = 2; qscale = true; break;
            case 4: type = 2; gi = 3; break;
            case 6: case 7: type = 1; break;
            case 8: if (wc == 0) { type = 2; ocol = C_KI; } else if (wc == 1) { type = 3; ocol = C_WI; } else type = 4; break;
            case 9: case 10: type = 2; gi = 4; qscale = true; break;
            case 11: case 12: type = 2; gi = 5; break;
            default: type = 0; break;
        }
        if (type == 4) return;
        if (type == 3) {
            if (fq == 0) {
#pragma unroll
                for (int ai = 0; ai < 2; ++ai)
#pragma unroll
                    for (int m = 0; m < 4; ++m) { const f32x4 a = acc[ai][0][m][0] * 0.35355339059327373f, b = acc[ai][0][m][1] * 0.35355339059327373f;
                        *(u32x4*)(qkv + (size_t)(row0 + ai * HALF + m * 16) * QP + C_WI) = (u32x4){cvt_pk_bf16(a[0], a[1]), cvt_pk_bf16(a[2], a[3]), cvt_pk_bf16(b[0], b[1]), cvt_pk_bf16(b[2], b[3])}; }
            }
            return;
        }
        const float* gp = (pn == 8) ? ikg : qkg + 64 * gi;
        if (type == 2) { if (qscale) body<2, true>(acc, row0, ocol, gp, fq); else body<2, false>(acc, row0, ocol, gp, fq); }
        else if (type == 1) body<1, false>(acc, row0, ocol, gp, fq);
        else body<0, false>(acc, row0, ocol, gp, fq);
    }
    template <int TYPE, bool QS>
    __device__ __forceinline__ void body(const f32x4 (&acc)[2][2][4][2], int row0, int ocol, const float* gp, int fq) const {
#pragma unroll
        for (int ai = 0; ai < 2; ++ai)
#pragma unroll
            for (int m = 0; m < 4; ++m) {
                const int row = row0 + ai * HALF + m * 16;
                f32x4 x[2][2];
#pragma unroll
                for (int bj = 0; bj < 2; ++bj)
#pragma unroll
                    for (int n = 0; n < 2; ++n) x[bj][n] = acc[ai][bj][m][n];
                if (TYPE == 2) {
                    float ss = 0.f;
#pragma unroll
                    for (int bj = 0; bj < 2; ++bj)
#pragma unroll
                        for (int n = 0; n < 2; ++n) ss += (x[bj][n][0] * x[bj][n][0] + x[bj][n][1] * x[bj][n][1]) + (x[bj][n][2] * x[bj][n][2] + x[bj][n][3] * x[bj][n][3]);
                    ss += xor_lane<16>(ss); ss = sum_xor32(ss);
                    const float inv = (QS ? C2 : 1.0f) / sqrtf(ss * (1.0f / 64.0f) + EPS);
#pragma unroll
                    for (int bj = 0; bj < 2; ++bj)
#pragma unroll
                        for (int n = 0; n < 2; ++n) x[bj][n] = x[bj][n] * inv * *(const f32x4*)(gp + 32 * bj + 8 * fq + 4 * n);
                }
                if (TYPE >= 1) {
                    const int pos = row & (SEQ - 1);
#pragma unroll
                    for (int n = 0; n < 2; ++n) {
                        const f32x4 c = *(const f32x4*)(cosT + pos * 32 + 8 * fq + 4 * n), s = *(const f32x4*)(sinT + pos * 32 + 8 * fq + 4 * n);
                        const f32x4 a = x[0][n], b = x[1][n];
                        x[0][n] = a * c - b * s; x[1][n] = b * c + a * s;
                    }
                }
#pragma unroll
                for (int bj = 0; bj < 2; ++bj)
                    *(u32x4*)(qkv + (size_t)row * QP + ocol + 32 * bj + 8 * fq) = (u32x4){cvt_pk_bf16(x[bj][0][0], x[bj][0][1]), cvt_pk_bf16(x[bj][0][2], x[bj][0][3]), cvt_pk_bf16(x[bj][1][0], x[bj][1][1]), cvt_pk_bf16(x[bj][1][2], x[bj][1][3])};
                asm volatile("" ::: "memory");
            }
    }
};

template <int BR> struct EpiMerge {
    static constexpr bool PERM = false, AFTER_DRAIN = false;
    bf16_t* merged; const unsigned char* sg;
    __device__ __forceinline__ void operator()(const f32x4 (&acc)[2][2][4][2], const Unit& u, int wr, int wc, int fr, int fq) const {
        const int row0 = u.pm * BM + wr * 64 + fr, col0 = u.pn * BM + wc * 64 + fq * 16;
#pragma unroll
        for (int ai = 0; ai < 2; ++ai)
#pragma unroll
            for (int m = 0; m < 4; ++m) { const size_t row = (size_t)(row0 + ai * HALF + m * 16);
                const u32x4 gq = *(const u32x4*)(sg + row * 3072 + BR * 1024 + col0);
                bf16_t* mp = merged + row * 1024 + col0;
                float v[16];
#pragma unroll
                for (int bj = 0; bj < 2; ++bj)
#pragma unroll
                    for (int n = 0; n < 2; ++n)
#pragma unroll
                        for (int i = 0; i < 4; ++i) v[8 * bj + 4 * n + i] = acc[ai][bj][m][n][i] * ((float)((gq[2 * bj + n] >> (8 * i)) & 255u) * (1.0f / 255.0f));
                if (BR > 0) { const u32x4 o0 = *(const u32x4*)mp, o1 = *(const u32x4*)(mp + 8);
#pragma unroll
                    for (int k = 0; k < 4; ++k) { v[2 * k] += bf_lo(o0[k]); v[2 * k + 1] += bf_hi(o0[k]); v[8 + 2 * k] += bf_lo(o1[k]); v[8 + 2 * k + 1] += bf_hi(o1[k]); } }
                *(u32x4*)mp = (u32x4){cvt_pk_bf16(v[0], v[1]), cvt_pk_bf16(v[2], v[3]), cvt_pk_bf16(v[4], v[5]), cvt_pk_bf16(v[6], v[7])};
                *(u32x4*)(mp + 8) = (u32x4){cvt_pk_bf16(v[8], v[9]), cvt_pk_bf16(v[10], v[11]), cvt_pk_bf16(v[12], v[13]), cvt_pk_bf16(v[14], v[15])};
                asm volatile("" ::: "memory"); }
    }
};

struct EpiResid {
    static constexpr bool PERM = false, AFTER_DRAIN = false;
    const float* res; float* out;
    __device__ __forceinline__ void operator()(const f32x4 (&acc)[2][2][4][2], const Unit& u, int wr, int wc, int fr, int fq) const {
        const int row0 = u.pm * BM + wr * 64 + fr, col0 = u.pn * BM + wc * 32 + fq * 8;
#pragma unroll
        for (int ai = 0; ai < 2; ++ai)
#pragma unroll
            for (int m = 0; m < 4; ++m) { const size_t off = (size_t)(row0 + ai * HALF + m * 16) * 1024 + col0;
#pragma unroll
                for (int bj = 0; bj < 2; ++bj)
#pragma unroll
                    for (int n = 0; n < 2; ++n) { const f32x4 r = *(const f32x4*)(res + off + bj * HALF + 4 * n); *(f32x4*)(out + off + bj * HALF + 4 * n) = r + acc[ai][bj][m][n]; }
                if (m & 1) asm volatile("" ::: "memory"); }
    }
};

struct EpiGateUp {
    static constexpr bool PERM = false, AFTER_DRAIN = false;
    bf16_t* hid; const PG8_LAS float* rst; int rbs;
    __device__ __forceinline__ void operator()(const f32x4 (&acc)[2][2][4][2], const Unit& u, int wr, int wc, int fr, int fq) const {
        const int row0 = u.pm * BM + wr * 64 + fr, col0 = (u.pn & 3) * HALF + wc * 32 + fq * 8;
        const PG8_LAS float* rs = rst + (u.pm / rbs) * 256 + wr * 64 + fr;
#pragma unroll
        for (int ai = 0; ai < 2; ++ai)
#pragma unroll
            for (int m = 0; m < 4; ++m) { float v[8]; const float r = rs[ai * HALF + m * 16];
#pragma unroll
                for (int n = 0; n < 2; ++n)
#pragma unroll
                    for (int i = 0; i < 4; ++i) { const float gt = acc[ai][0][m][n][i] * r, up = acc[ai][1][m][n][i] * r; v[4 * n + i] = gt * fast_rcp(1.0f + fast_exp2(-1.4426950408889634f * gt)) * up; }
                *(u32x4*)(hid + (size_t)(row0 + ai * HALF + m * 16) * DEXP + col0) = (u32x4){cvt_pk_bf16(v[0], v[1]), cvt_pk_bf16(v[2], v[3]), cvt_pk_bf16(v[4], v[5]), cvt_pk_bf16(v[6], v[7])}; }
    }
};

struct EpiDown {
    static constexpr bool PERM = false, AFTER_DRAIN = false;
    bf16_t* y;
    __device__ __forceinline__ void operator()(const f32x4 (&acc)[2][2][4][2], const Unit& u, int wr, int wc, int fr, int fq) const {
        const int row0 = u.pm * BM + wr * 64 + fr, col0 = (u.pn & 3) * BM + wc * 64 + fq * 16;
#pragma unroll
        for (int ai = 0; ai < 2; ++ai)
#pragma unroll
            for (int m = 0; m < 4; ++m) { bf16_t* yp = y + (size_t)(row0 + ai * HALF + m * 16) * 1024 + col0;
#pragma unroll
                for (int bj = 0; bj < 2; ++bj) { const f32x4 a = acc[ai][bj][m][0], b = acc[ai][bj][m][1];
                    *(u32x4*)(yp + 8 * bj) = (u32x4){cvt_pk_bf16(a[0], a[1]), cvt_pk_bf16(a[2], a[3]), cvt_pk_bf16(b[0], b[1]), cvt_pk_bf16(b[2], b[3])}; } }
    }
};

struct AMapMoe { static constexpr bool GATHER = true; const PG8_LAS int* tok; int rbs;
    __device__ __forceinline__ unsigned row(const Unit& u, int R) const { return (unsigned)tok[(u.pm / rbs) * 256 + R]; } };
struct MoeOrder {
    int nunits, G, c; const PG8_LAS int* blk2e;
    __device__ __forceinline__ bool next(int i, Unit& u) const { const int L = i * G + c; if (L >= nunits) return false; const int rb = L >> 2; u.pm = rb; u.pn = blk2e[rb] * 4 + (L & 3); return true; }
    __device__ __forceinline__ void a_ready(const Unit&) const {}
    __device__ __forceinline__ void done(const Unit&) const {}
};

struct NoAMap { static constexpr bool GATHER = false; __device__ __forceinline__ unsigned row(const Unit&, int) const { return 0u; } };
template <class Epi, class Sched, bool ALIGN_EPI = false, bool SP2 = false, class AMap = NoAMap>
__device__ __forceinline__ void gemm_phase(PG8_LAS unsigned char* lds, const Gemm g, const Sched& S, const Epi& E, const AMap& AM = AMap()) {
    static_assert(!AMap::GATHER || SP2, "the row gather is wired into the SP2 loop only");
    int tid_l = (int)threadIdx.x; asm volatile("" : "+v"(tid_l));
    const int tid = tid_l, wid = __builtin_amdgcn_readfirstlane(tid >> 6), lane = tid & 63, wr = wid >> 2, wc = wid & 3, fr = lane & 15, fq = lane >> 4;
    const int K = g.K, nt = K / BK;
    unsigned voffA[2], voffB[2];
#pragma unroll
    for (int i = 0; i < 2; ++i) { int R, C; stage_rc(tid * 16 + i * 8192, R, C); const int Rb = Epi::PERM ? ((R & ~31) + perm32(R & 31)) : R;
        voffA[i] = (unsigned)(R * K + C) * 2u; voffB[i] = (unsigned)(Rb * K + C) * 2u; }
    int RA[2], CA[2];
#pragma unroll
    for (int i = 0; i < 2; ++i) stage_rc(tid * 16 + i * 8192, RA[i], CA[i]);
    unsigned vC0[2] = {0u, 0u}, vC1[2] = {0u, 0u}, vN0[2] = {0u, 0u}, vN1[2] = {0u, 0u};
#define PG8_AOFFS(v0, v1, unit) do { if constexpr (AMap::GATHER) { _Pragma("unroll") for (int _i = 0; _i < 2; ++_i) { \
        v0[_i] = (AM.row(unit, RA[_i]) * (unsigned)K + (unsigned)CA[_i]) * 2u; v1[_i] = (AM.row(unit, HALF + RA[_i]) * (unsigned)K + (unsigned)CA[_i]) * 2u; } } } while (0)
#define PG8_STAGE_A(bufoff, base, half, usenext) do { if constexpr (AMap::GATHER) { unsigned vv_[2]; _Pragma("unroll") for (int _j = 0; _j < 2; ++_j) vv_[_j] = (usenext) ? ((half) ? vN1[_j] : vN0[_j]) : ((half) ? vC1[_j] : vC0[_j]); \
        PG8_STAGE(bufoff, base, vv_); } else { PG8_STAGE(bufoff, (base) + (half) * hstep, voffA); } } while (0)
    const size_t kstep = (size_t)(BK * 2);
    const size_t hstep = (size_t)HALF * K * 2;
    const size_t tstep = 2 * hstep;
    const unsigned ldsw = (unsigned)wid * 1024u;
    const int aoff = lds_byte(wr * 64 + fr, fq * 8), boff = lds_byte(wc * 32 + fr, fq * 8);
#define PG8_SA(b, h) (((b) * 2 + (h)) * HTB)
#define PG8_SB(b, h) ((4 + (b) * 2 + (h)) * HTB)
#define PG8_STAGE(bufoff, gbase, voff) do { _Pragma("unroll") for (int _i = 0; _i < 2; ++_i) \
        __builtin_amdgcn_global_load_lds((const unsigned*)((const char*)(gbase) + (voff)[_i]), (PG8_LAS unsigned*)(lds + (bufoff) + ldsw + _i * 8192), 16, 0, 0); } while (0)
#define PG8_LDA(dst, b, h) do { _Pragma("unroll") for (int m = 0; m < 4; ++m) _Pragma("unroll") for (int k = 0; k < 2; ++k) dst[m][k] = *(const PG8_LAS bf16x8*)(lds + PG8_SA(b, h) + aoff + m * 2048 + k * 1024); } while (0)
#define PG8_LDB(dst, b, h) do { _Pragma("unroll") for (int n = 0; n < 2; ++n) _Pragma("unroll") for (int k = 0; k < 2; ++k) dst[n][k] = *(const PG8_LAS bf16x8*)(lds + PG8_SB(b, h) + boff + n * 2048 + k * 1024); } while (0)
#define PG8_MMA(ai, bj, At, Bt) do { __builtin_amdgcn_s_setprio(1); _Pragma("unroll") for (int m = 0; m < 4; ++m) _Pragma("unroll") for (int n = 0; n < 2; ++n) _Pragma("unroll") for (int k = 0; k < 2; ++k) \
        acc[ai][bj][m][n] = __builtin_amdgcn_mfma_f32_16x16x32_bf16(Bt[n][k], At[m][k], acc[ai][bj][m][n], 0, 0, 0); __builtin_amdgcn_s_setprio(0); } while (0)
#define PG8_WAIT_V(n) asm volatile("s_waitcnt vmcnt(" #n ")" ::: "memory")
#define PG8_WAIT_L(n) asm volatile("s_waitcnt lgkmcnt(" #n ")" ::: "memory")
#define PG8_BAR __builtin_amdgcn_s_barrier()
#define PG8_SCHED __builtin_amdgcn_sched_barrier(0)
    Unit cur, nxt; int ui = 0;
    if (!S.next(0, cur)) return;
    f32x4 acc[2][2][4][2];
#pragma unroll
    for (int a = 0; a < 2; ++a)
#pragma unroll
        for (int b = 0; b < 2; ++b)
#pragma unroll
            for (int m = 0; m < 4; ++m)
#pragma unroll
                for (int n = 0; n < 2; ++n) acc[a][b][m][n] = (f32x4){0.f, 0.f, 0.f, 0.f};
    bf16x8 At[4][2], B0[2][2], B1[2][2];
    const char* cA = (const char*)g.A + (AMap::GATHER ? (size_t)0 : (size_t)cur.pm * tstep); const char* cB = (const char*)g.Bt + (size_t)cur.pn * tstep;
    PG8_AOFFS(vC0, vC1, cur);
    S.a_ready(cur);
    if constexpr (SP2) {
        PG8_STAGE(PG8_SB(0, 0), cB, voffB); PG8_STAGE(PG8_SB(0, 1), cB + hstep, voffB); PG8_STAGE_A(PG8_SA(0, 0), cA, 0, false); PG8_STAGE_A(PG8_SA(0, 1), cA, 1, false);
        if (wr == 1) PG8_BAR;
        PG8_WAIT_V(2); PG8_BAR;
        PG8_STAGE(PG8_SB(1, 0), cB + kstep, voffB); PG8_STAGE_A(PG8_SA(1, 0), cA + kstep, 0, false); PG8_STAGE(PG8_SB(1, 1), cB + hstep + kstep, voffB);
        PG8_WAIT_V(6); PG8_BAR;
    } else {
        PG8_STAGE(PG8_SB(0, 0), cB, voffB); PG8_STAGE(PG8_SA(0, 0), cA, voffA); PG8_STAGE(PG8_SB(0, 1), cB + hstep, voffB); PG8_STAGE(PG8_SA(0, 1), cA + hstep, voffA);
        if (wr == 1) PG8_BAR;
        PG8_WAIT_V(4); PG8_BAR;
        PG8_STAGE(PG8_SB(1, 0), cB + kstep, voffB); PG8_STAGE(PG8_SA(1, 0), cA + kstep, voffA); PG8_STAGE(PG8_SB(1, 1), cB + hstep + kstep, voffB);
        PG8_WAIT_V(6); PG8_BAR;
    }
    for (;;) {
        const bool has_next = S.next(ui + 1, nxt);
        const char* nA = (has_next && !AMap::GATHER) ? (const char*)g.A + (size_t)nxt.pm * tstep : cA; const char* nB = has_next ? (const char*)g.Bt + (size_t)nxt.pn * tstep : cB;
        if constexpr (AMap::GATHER) { if (has_next) PG8_AOFFS(vN0, vN1, nxt); else { vN0[0] = vC0[0]; vN0[1] = vC0[1]; vN1[0] = vC1[0]; vN1[1] = vC1[1]; } }
#pragma unroll 1
        for (int t = 0; t < nt; t += 2) {
            const bool last = (t == nt - 2);
            const char* a1 = cA + (size_t)(t + 1) * kstep;
            const char* a2 = last ? nA : cA + (size_t)(t + 2) * kstep; const char* b2 = last ? nB : cB + (size_t)(t + 2) * kstep;
            const char* a3 = a2 + kstep; const char* b3 = b2 + kstep;
            if (last && has_next) S.a_ready(nxt);
            if constexpr (SP2) {
            PG8_LDB(B0, 0, 0); PG8_LDB(B1, 0, 1); PG8_SCHED; PG8_LDA(At, 0, 0); PG8_STAGE_A(PG8_SA(1, 1), a1, 1, false);
            PG8_WAIT_V(8); PG8_WAIT_L(0); PG8_BAR; PG8_MMA(0, 0, At, B0); PG8_MMA(0, 1, At, B1); PG8_BAR; PG8_SCHED;
            PG8_LDA(At, 0, 1); PG8_STAGE(PG8_SB(0, 0), b2, voffB); PG8_STAGE(PG8_SB(0, 1), b2 + hstep, voffB); PG8_STAGE_A(PG8_SA(0, 0), a2, 0, last);
            PG8_WAIT_V(8); PG8_WAIT_L(0); PG8_BAR; PG8_MMA(1, 0, At, B0); PG8_MMA(1, 1, At, B1); PG8_BAR; PG8_SCHED;
            PG8_LDB(B0, 1, 0); PG8_LDB(B1, 1, 1); PG8_SCHED; PG8_LDA(At, 1, 0); PG8_STAGE_A(PG8_SA(0, 1), a2, 1, last);
            PG8_WAIT_V(8); PG8_WAIT_L(0); PG8_BAR; PG8_MMA(0, 0, At, B0); PG8_MMA(0, 1, At, B1); PG8_BAR; PG8_SCHED;
            PG8_LDA(At, 1, 1); PG8_STAGE(PG8_SB(1, 0), b3, voffB); PG8_STAGE(PG8_SB(1, 1), b3 + hstep, voffB); PG8_STAGE_A(PG8_SA(1, 0), a3, 0, last);
            PG8_WAIT_V(8); PG8_WAIT_L(0); PG8_BAR; PG8_MMA(1, 0, At, B0); PG8_MMA(1, 1, At, B1); PG8_BAR; PG8_SCHED;
            } else {
            PG8_LDB(B0, 0, 0); PG8_SCHED; PG8_LDA(At, 0, 0); PG8_STAGE(PG8_SA(1, 1), a1 + hstep, voffA);
            PG8_WAIT_L(8); PG8_BAR; PG8_WAIT_L(0); PG8_MMA(0, 0, At, B0); PG8_BAR; PG8_SCHED;
            PG8_LDB(B1, 0, 1); PG8_STAGE(PG8_SB(0, 0), b2, voffB);
            PG8_BAR; PG8_WAIT_L(0); PG8_MMA(0, 1, At, B1); PG8_BAR;
            PG8_LDA(At, 0, 1); PG8_STAGE(PG8_SA(0, 0), a2, voffA);
            PG8_BAR; PG8_WAIT_L(0); PG8_MMA(1, 0, At, B0); PG8_BAR; PG8_SCHED;
            PG8_STAGE(PG8_SB(0, 1), b2 + hstep, voffB);
            PG8_WAIT_V(6); PG8_BAR; PG8_MMA(1, 1, At, B1); PG8_BAR;
            PG8_LDB(B0, 1, 0); PG8_SCHED; PG8_LDA(At, 1, 0); PG8_STAGE(PG8_SA(0, 1), a2 + hstep, voffA);
            PG8_WAIT_L(8); PG8_BAR; PG8_WAIT_L(0); PG8_MMA(0, 0, At, B0); PG8_BAR; PG8_SCHED;
            PG8_LDB(B1, 1, 1); PG8_STAGE(PG8_SB(1, 0), b3, voffB);
            PG8_BAR; PG8_WAIT_L(0); PG8_MMA(0, 1, At, B1); PG8_BAR;
            PG8_LDA(At, 1, 1); PG8_STAGE(PG8_SA(1, 0), a3, voffA);
            PG8_BAR; PG8_WAIT_L(0); PG8_MMA(1, 0, At, B0); PG8_BAR; PG8_SCHED;
            PG8_STAGE(PG8_SB(1, 1), b3 + hstep, voffB);
            PG8_WAIT_V(6); PG8_BAR; PG8_MMA(1, 1, At, B1); PG8_BAR;
            }
        }
        if constexpr (ALIGN_EPI) { if (wr == 0) PG8_BAR; }
        if constexpr (!Epi::AFTER_DRAIN) { E(acc, cur, wr, wc, fr, fq); S.done(cur); }
        if (!has_next) break;
#pragma unroll
        for (int a = 0; a < 2; ++a)
#pragma unroll
            for (int b = 0; b < 2; ++b)
#pragma unroll
                for (int m = 0; m < 4; ++m)
#pragma unroll
                    for (int n = 0; n < 2; ++n) acc[a][b][m][n] = (f32x4){0.f, 0.f, 0.f, 0.f};
        cur = nxt; cA = nA; cB = nB; ++ui;
        if constexpr (AMap::GATHER) { vC0[0] = vN0[0]; vC0[1] = vN0[1]; vC1[0] = vN1[0]; vC1[1] = vN1[1]; }
        if constexpr (ALIGN_EPI) { if (wr == 1) PG8_BAR; }
    }
    PG8_WAIT_V(0);
    if constexpr (!ALIGN_EPI) { if (wr == 0) PG8_BAR; }
    PG8_BAR;
    if constexpr (Epi::AFTER_DRAIN) { E.fused(acc, cur, wr, wc, fr, fq, lds, wid, lane); S.done(cur); }
#undef PG8_SA
#undef PG8_AOFFS
#undef PG8_STAGE_A
#undef PG8_SB
#undef PG8_STAGE
#undef PG8_LDA
#undef PG8_LDB
#undef PG8_MMA
#undef PG8_WAIT_V
#undef PG8_WAIT_L
#undef PG8_BAR
#undef PG8_SCHED
}
}
#define XB_TMO      128
#define XB_XCNT(j)  (256  + 64 * (j))
#define XB_XSUB(j)  (1280 + 64 * (j))
#define XB_XGEN(j)  (2304 + 64 * (j))
#define XB_TOP      3328
#define XB_TOPGEN   3392
#define XCD_BAR_WORDS 3456
#define XB_SPIN_CAP (1u << 21)

__device__ __forceinline__ unsigned xb_ld(unsigned* p)              { return __hip_atomic_load(p, __ATOMIC_RELAXED, __HIP_MEMORY_SCOPE_AGENT); }
__device__ __forceinline__ unsigned xb_add(unsigned* p, unsigned v) { return __hip_atomic_fetch_add(p, v, __ATOMIC_RELAXED, __HIP_MEMORY_SCOPE_AGENT); }
__device__ __forceinline__ unsigned xb_xcc_id() { return (unsigned)__builtin_amdgcn_s_getreg((3 << 11) | 20) & 0xFu; }
#define XB_SPIN(cond, bar) do { unsigned _sp = 0; while (cond) { __builtin_amdgcn_s_sleep(1); \
    if ((++_sp & 255u) == 0u) { if (xb_ld(&(bar)[XB_TMO])) break; if (_sp > XB_SPIN_CAP) { atomicAdd(&(bar)[XB_TMO], 1u); break; } } } } while (0)

struct XcdBarrier {
    unsigned* bar; unsigned x;
    volatile LAS unsigned* st;
};

__device__ __forceinline__ XcdBarrier xcd_barrier_post(unsigned* bar, volatile LAS unsigned* st) {
    XcdBarrier b; b.bar = bar; b.x = xb_xcc_id(); b.st = st;
    if (threadIdx.x == 0) (void)xb_add(&bar[XB_XCNT(b.x)], 1u);
    return b;
}
__device__ __forceinline__ void xcd_barrier_complete(unsigned* bar, unsigned x, unsigned& nloc, unsigned& nx) {
    const unsigned G = gridDim.x * gridDim.y * gridDim.z;
    unsigned sum, cnt, mine, sp = 0u;
    for (;;) {
        sum = 0u; cnt = 0u; mine = 0u;
#pragma unroll
        for (unsigned j = 0; j < 16; ++j) { const unsigned c = xb_ld(&bar[XB_XCNT(j)]); sum += c; cnt += (c > 0u) ? 1u : 0u; mine = (j == x) ? c : mine; }
        if (sum == G) break;
        __builtin_amdgcn_s_sleep(1);
        if ((++sp & 255u) == 0u) { if (xb_ld(&bar[XB_TMO])) break; if (sp > XB_SPIN_CAP) { atomicAdd(&bar[XB_TMO], 1u); break; } }
    }
    nloc = mine > 0u ? mine : 1u; nx = cnt > 0u ? cnt : 1u;
}

__device__ __forceinline__ void xcd_barrier(const XcdBarrier& b) {
    asm volatile("s_waitcnt vmcnt(0)" ::: "memory");
    __syncthreads();
    int tid_l = (int)threadIdx.x; asm volatile("" : "+v"(tid_l));
    if (tid_l == 0) {
        unsigned* bar = b.bar;
        __builtin_amdgcn_s_waitcnt(0);
        unsigned nloc = b.st[0], nx = b.st[1];
        if (nloc == 0u) { xcd_barrier_complete(bar, b.x, nloc, nx); b.st[0] = nloc; b.st[1] = nx; }
        const unsigned old = xb_add(&bar[XB_XSUB(b.x)], 1u);
        const unsigned gen = old / nloc;
        if (old + 1u == (gen + 1u) * nloc) {
            __builtin_amdgcn_fence(__ATOMIC_RELEASE, "agent");
            asm volatile("s_waitcnt vmcnt(0)" ::: "memory");
            const unsigned og = xb_add(&bar[XB_TOP], 1u);
            const unsigned tg = og / nx;
            if (og + 1u == (tg + 1u) * nx) xb_add(&bar[XB_TOPGEN], 1u);
            else XB_SPIN(xb_ld(&bar[XB_TOPGEN]) == tg, bar);
            __builtin_amdgcn_fence(__ATOMIC_ACQUIRE, "agent");
            xb_add(&bar[XB_XGEN(b.x)], 1u);
            asm volatile("s_waitcnt vmcnt(0)" ::: "memory");
        } else {
            XB_SPIN(xb_ld(&bar[XB_XGEN(b.x)]) == gen, bar);
            __builtin_amdgcn_fence(__ATOMIC_ACQUIRE, "agent");
            asm volatile("s_waitcnt vmcnt(0)" ::: "memory");
        }
    }
    __syncthreads();
}

enum { I_X = 0, I_NORM_ATTN, I_W_IN, I_QK_GAIN, I_IDX_K_GAIN, I_DIFF_LAMBDA, I_DIFF_SUBLN, I_W_PROJ_A, I_W_PROJ_B, I_W_PROJ_C, I_W_OUT, I_NORM_FFN, I_W_GROUP, I_B_GROUP, I_W_ROUTER, I_B_ROUTER,
       I_W_E_GATE, I_W_E_UP, I_W_E_DOWN, N_INPUTS };
struct Args { const float* in[N_INPUTS]; float* out; unsigned char* ws; };

#define LDS_WAIT() asm volatile("s_waitcnt lgkmcnt(0)" ::: "memory")

__device__ __forceinline__ int perm16col(int s) { return 64 * ((s >> 5) & 3) + 16 * ((s >> 2) & 3) + 8 * (s >> 7) + 4 * ((s >> 4) & 1) + (s & 3); }
__device__ __forceinline__ int inproj_src_col(int d) {
    const int pn = d >> 8, s = d & 255;
    if (pn >= 15) return C_G + 256 * (pn - 15) + perm16col(s);
    const int u = (s >> 5) & 3, e = 32 * (s >> 7) + pg8::perm32(s & 31);
    if (pn < 8) return 256 * pn + 64 * u + e;
    if (pn == 8) { if (u == 0) return C_KI + e; if (u == 1) return e < 8 ? C_WI + e : -1; return -1; }
    return C_Q1 + 256 * (pn - 9) + 64 * u + e;
}
__device__ __forceinline__ void transpose_item(const float* W, int ldw, int K, bf16_t* WT, int drow0, int k0, int srccol, LAS float* scr, int lane) {
    const float* src = W + (size_t)k0 * ldw + (srccol >= 0 ? srccol : 0);
#pragma unroll 8
    for (int i = 0; i < 32; ++i) { const int kk = 2 * i + (lane >> 5); const float v = src[(size_t)kk * ldw]; scr[kk * 33 + (lane & 31)] = srccol >= 0 ? v : 0.f; }
    LDS_WAIT(); asm volatile("" ::: "memory");
    const int c = lane & 7;
#pragma unroll
    for (int j = 0; j < 4; ++j) { const int n = (lane >> 3) + 8 * j; const LAS float* s = scr + (8 * c) * 33 + n;
        u32x4 o; o.x = cvt_pk_bf16(s[0 * 33], s[1 * 33]); o.y = cvt_pk_bf16(s[2 * 33], s[3 * 33]); o.z = cvt_pk_bf16(s[4 * 33], s[5 * 33]); o.w = cvt_pk_bf16(s[6 * 33], s[7 * 33]);
        *(u32x4*)(WT + (size_t)(drow0 + n) * K + k0 + 8 * c) = o; }
    LDS_WAIT(); asm volatile("" ::: "memory");
}

template <bool COMBINE, bool WRITE_HN>
__device__ __forceinline__ void token_row(const float* src, float* dst, const bf16_t* y, const unsigned* rt0, const unsigned* rt1, const f32x2* rtw, const LAS int* pstart,
                                          const float* gain, bf16_t* hn, int m, int lane) {
    f32x4 v[4];
#pragma unroll
    for (int j = 0; j < 4; ++j) v[j] = ((const f32x4*)(src + (size_t)m * DM))[lane + 64 * j];
    if (COMBINE) {
        const unsigned a = rt0[m], b = rt1[m]; const f32x2 w = rtw[m];
        const size_t s0 = (size_t)(pstart[a >> 24] + (int)(a & 0xffffffu)), s1 = (size_t)(pstart[b >> 24] + (int)(b & 0xffffffu));
#pragma unroll
        for (int j = 0; j < 4; ++j) { const u32x2 p = ((const u32x2*)(y + s0 * DM))[lane + 64 * j], q = ((const u32x2*)(y + s1 * DM))[lane + 64 * j];
            v[j][0] += w[0] * bf_lo(p[0]) + w[1] * bf_lo(q[0]); v[j][1] += w[0] * bf_hi(p[0]) + w[1] * bf_hi(q[0]);
            v[j][2] += w[0] * bf_lo(p[1]) + w[1] * bf_lo(q[1]); v[j][3] += w[0] * bf_hi(p[1]) + w[1] * bf_hi(q[1]);
            ((f32x4*)(dst + (size_t)m * DM))[lane + 64 * j] = v[j]; }
    }
    if (WRITE_HN) {
        float ss = 0.f;
#pragma unroll
        for (int j = 0; j < 4; ++j) ss += (v[j][0] * v[j][0] + v[j][1] * v[j][1]) + (v[j][2] * v[j][2] + v[j][3] * v[j][3]);
        const float rstd = 1.0f / sqrtf(wave_sum(ss) * (1.0f / DM) + EPS);
#pragma unroll
        for (int j = 0; j < 4; ++j) { const f32x4 g = ((const f32x4*)gain)[lane + 64 * j]; const f32x4 o = v[j] * rstd * g;
            ((u32x2*)(hn + (size_t)m * DM))[lane + 64 * j] = (u32x2){cvt_pk_bf16(o[0], o[1]), cvt_pk_bf16(o[2], o[3])}; }
    }
}

template <bool EXPERTS> __device__ __forceinline__ void convert_weights(const Args& a, unsigned char* ws, int l, LAS unsigned char* lds, int lane, int wave, int vcu, int G, int chunk = -1);
__device__ __forceinline__ void p0_phase(const Args& a, unsigned char* ws, int l, LAS unsigned char* lds, int tid, int lane, int wave, int vcu, int G) {
    convert_weights<false>(a, ws, l, lds, lane, wave, vcu, G);
    const int gw = vcu * 8 + wave, NGW = G * 8, gt = vcu * 512 + tid, NGT = G * 512;
    if (l == 0) {
        float* cosT = (float*)(ws + WS_COS); float* sinT = (float*)(ws + WS_SIN);
        for (int idx = gt; idx < SEQ * 32; idx += NGT) { const int pos = idx >> 5, j = idx & 31;
            const float inv_freq = 1.0f / powf(10000.0f, (float)(2 * j) * (1.0f / 64.0f));
            const float ang = (float)pos * inv_freq;
            const double rev = (double)ang * 0.15915494309189533577; const float fr = (float)(rev - rint(rev));
            cosT[idx] = __builtin_amdgcn_cosf(fr); sinT[idx] = __builtin_amdgcn_sinf(fr); }
    }
    { float* wrt = (float*)(ws + WS_WRT); const float* wg = a.in[I_W_GROUP] + (size_t)l * DM * 4; const float* wr = a.in[I_W_ROUTER] + (size_t)l * DM * 32;
      const float* g2 = a.in[I_NORM_FFN] + (size_t)l * DM;
      for (int idx = gt; idx < 36 * DM; idx += NGT) { const int c = idx >> 10, k = idx & 1023; wrt[idx] = g2[k] * (c < 4 ? wg[k * 4 + c] : wr[k * 32 + (c - 4)]); } }
    const float* gain = a.in[I_NORM_ATTN] + (size_t)l * DM; bf16_t* hn = (bf16_t*)(ws + WS_HN);
    const LAS int* pstart = (const LAS int*)(lds + LX_PSTART);
    if (l == 0) { for (int m = gw; m < MTOK; m += NGW) token_row<false, true>(a.in[I_X], nullptr, nullptr, nullptr, nullptr, nullptr, pstart, gain, hn, m, lane); }
    else { for (int m = gw; m < MTOK; m += NGW) token_row<true, true>(a.out, a.out, (const bf16_t*)(ws + WS_Y), (const unsigned*)(ws + WS_RT0), (const unsigned*)(ws + WS_RT1), (const f32x2*)(ws + WS_RTW), pstart, gain, hn, m, lane); }
}

template <bool EXPERTS> __device__ __forceinline__ void convert_weights(const Args& a, unsigned char* ws, int l, LAS unsigned char* lds, int lane, int wave, int vcu, int G, int chunk) {
    LAS float* scr = (LAS float*)(lds + wave * 16384);
    int gw = vcu * 8 + wave, NGW = G * 8;
    constexpr int I_IN = 216 * 16, I_PA = 32 * 4, I_PC = 32 * 8, I_WO = 32 * 16, I_GU = 32 * 32 * 16, I_DN = 32 * 32 * 8, NIT = I_IN + 2 * I_PA + I_PC + I_WO + I_GU + I_DN;
    constexpr int I_SMALL = I_IN + 2 * I_PA + I_PC + I_WO;
    int it_end = EXPERTS ? NIT : I_SMALL;
    if (chunk >= 0) { gw = chunk * 128 + wave * 16; NGW = 1; it_end = I_SMALL + gw + 16 < NIT ? I_SMALL + gw + 16 : NIT; }
    for (int it = gw + (EXPERTS ? I_SMALL : 0); it < it_end; it += NGW) {
        int r = it; const int d31 = lane & 31;
        if (r < I_IN) { const int nb = r >> 4, kb = r & 15; transpose_item(a.in[I_W_IN] + (size_t)l * DM * D_IN, D_IN, 1024, (bf16_t*)(ws + WS_WIN), nb * 32, kb * 64, inproj_src_col(nb * 32 + d31), scr, lane); continue; } r -= I_IN;
        const int pcol = pg8::perm32(d31);
        if (r < I_PA) { const int nb = r >> 2, kb = r & 3; transpose_item(a.in[I_W_PROJ_A] + (size_t)l * 256 * DM, DM, 256, (bf16_t*)(ws + WS_WPA), nb * 32, kb * 64, ((nb * 32 + d31) & ~255) + perm16col((nb * 32 + d31) & 255), scr, lane); continue; } r -= I_PA;
        if (r < I_PA) { const int nb = r >> 2, kb = r & 3; transpose_item(a.in[I_W_PROJ_B] + (size_t)l * 256 * DM, DM, 256, (bf16_t*)(ws + WS_WPB), nb * 32, kb * 64, ((nb * 32 + d31) & ~255) + perm16col((nb * 32 + d31) & 255), scr, lane); continue; } r -= I_PA;
        if (r < I_PC) { const int nb = r >> 3, kb = r & 7; transpose_item(a.in[I_W_PROJ_C] + (size_t)l * 512 * DM, DM, 512, (bf16_t*)(ws + WS_WPC), nb * 32, kb * 64, ((nb * 32 + d31) & ~255) + perm16col((nb * 32 + d31) & 255), scr, lane); continue; } r -= I_PC;
        if (r < I_WO) { const int nb = r >> 4, kb = r & 15; transpose_item(a.in[I_W_OUT] + (size_t)l * DM * DM, DM, 1024, (bf16_t*)(ws + WS_WO), nb * 32, kb * 64, nb * 32 + pcol, scr, lane); continue; } r -= I_WO;
        if (r < I_GU) { const int e = r >> 9, rr = r & 511, nb = rr >> 4, kb = rr & 15, dd = nb * 32, pn = dd >> 8, s = dd & 255, half = s >> 7;
            const float* src = (half ? a.in[I_W_E_UP] : a.in[I_W_E_GATE]) + (size_t)(l * NEXP + e) * DM * DEXP;
            transpose_item(src, DEXP, 1024, (bf16_t*)(ws + WS_WGU) + (size_t)e * 1024 * 1024, nb * 32, kb * 64, 128 * pn + (s & 127) + pcol, scr, lane); continue; } r -= I_GU;
        { const int e = r >> 8, rr = r & 255, nb = rr >> 3, kb = rr & 7;
            transpose_item(a.in[I_W_E_DOWN] + (size_t)(l * NEXP + e) * DEXP * DM, DM, 512, (bf16_t*)(ws + WS_WD) + (size_t)e * 1024 * 512, nb * 32, kb * 64, ((nb * 32 + d31) & ~255) + perm16col((nb * 32 + d31) & 255), scr, lane); }
    }
}

__device__ __forceinline__ f32x16 mfma32(bf16x8 a, bf16x8 b, f32x16 c) { return __builtin_amdgcn_mfma_f32_32x32x16_bf16(a, b, c, 0, 0, 0); }
typedef short v4i16_t __attribute__((ext_vector_type(4)));
__device__ __forceinline__ s16x4 vtr(const LAS unsigned char* p) { return __builtin_bit_cast(s16x4, __builtin_amdgcn_ds_read_tr16_b64_v4i16((LAS v4i16_t*)p)); }
__device__ __forceinline__ int crow(int r, int hi) { return (r & 3) + 8 * (r >> 2) + 4 * hi; }
#define NEG_INF (-__builtin_inff())

__device__ __forceinline__ f32x16 splat16(float v) { f32x16 r;
#pragma unroll
    for (int i = 0; i < 16; ++i) r[i] = v;
    return r; }
__device__ __forceinline__ int kimg_off(int key, int ch) { return key * 128 + ((ch ^ ((key >> 1) & 7)) << 4); }
__device__ __forceinline__ int kdma_row(int w, int lane) { return 8 * w + (lane >> 3); }
__device__ __forceinline__ int kdma_chunk(int w, int lane) { return (lane & 7) ^ (((8 * w + (lane >> 3)) >> 1) & 7); }
struct QReg { const bf16x8 (&q)[4]; __device__ __forceinline__ bf16x8 operator()(int ks) const { return q[ks]; } };
struct QLds { const LAS unsigned char* p; __device__ __forceinline__ bf16x8 operator()(int ks) const { return *(const LAS bf16x8*)(p + ks * 1024); } };
template <int NDB, class QF, class MaskF>
__device__ __forceinline__ void flash_tile(float& m_run, float& l_run, f32x16 (&o)[NDB], const LAS unsigned char* kimg, const LAS unsigned char* vimg, const QF& qf, const MaskF& maskf, int r32, int hi, int vboff) {
    if (NDB == 4) __builtin_amdgcn_sched_barrier(0);
    f32x16 p0, p1; maskf.init(p0, p1);
#pragma unroll
    for (int ks = 0; ks < 4; ++ks) {
        const bf16x8 a0 = *(const LAS bf16x8*)(kimg + (NDB == 4 ? (2 * ks + hi) * 1024 + r32 * 16 : kimg_off(r32, 2 * ks + hi)));
        const bf16x8 a1 = *(const LAS bf16x8*)(kimg + (NDB == 4 ? (2 * ks + hi) * 1024 + 512 + r32 * 16 : kimg_off(r32, 2 * ks + hi) + 4096));
        const bf16x8 qk = qf(ks);
        p0 = mfma32(a0, qk, p0); p1 = mfma32(a1, qk, p1);
        if (NDB == 4 && (ks & 1)) __builtin_amdgcn_sched_barrier(0);
    }
    maskf(p0, p1);
    float mx = fmaxf(p0[0], p1[0]);
#pragma unroll
    for (int r = 1; r < 16; ++r) mx = fmaxf(mx, fmaxf(p0[r], p1[r]));
    mx = max_xor32(mx);
    const float mnew = fmaxf(m_run, mx);
    if (__ballot(mnew > m_run) != 0ull) {
        const float alpha = fast_exp2(m_run - mnew);
        l_run *= alpha;
#pragma unroll
        for (int db = 0; db < NDB; ++db) o[db] = o[db] * alpha;
    }
    m_run = mnew;
    float sum = 0.f;
#pragma unroll
    for (int r = 0; r < 16; ++r) { p0[r] = fast_exp2(p0[r] - mnew); p1[r] = fast_exp2(p1[r] - mnew); sum += p0[r] + p1[r]; }
    l_run += sum;
    bf16x8 pa[4];
    pa[0] = __builtin_bit_cast(bf16x8, (u32x4){cvt_pk_bf16(p0[0], p0[1]), cvt_pk_bf16(p0[2], p0[3]), cvt_pk_bf16(p0[4], p0[5]), cvt_pk_bf16(p0[6], p0[7])});
    pa[1] = __builtin_bit_cast(bf16x8, (u32x4){cvt_pk_bf16(p0[8], p0[9]), cvt_pk_bf16(p0[10], p0[11]), cvt_pk_bf16(p0[12], p0[13]), cvt_pk_bf16(p0[14], p0[15])});
    pa[2] = __builtin_bit_cast(bf16x8, (u32x4){cvt_pk_bf16(p1[0], p1[1]), cvt_pk_bf16(p1[2], p1[3]), cvt_pk_bf16(p1[4], p1[5]), cvt_pk_bf16(p1[6], p1[7])});
    pa[3] = __builtin_bit_cast(bf16x8, (u32x4){cvt_pk_bf16(p1[8], p1[9]), cvt_pk_bf16(p1[10], p1[11]), cvt_pk_bf16(p1[12], p1[13]), cvt_pk_bf16(p1[14], p1[15])});
#pragma unroll
    for (int db = 0; db < NDB; ++db)
#pragma unroll
        for (int s = 0; s < 4; ++s) {
            const s16x4 lo = vtr(vimg + vboff + db * 4096 + s * 1024), h4 = vtr(vimg + vboff + db * 4096 + s * 1024 + 512);
            const bf16x8 vt = (bf16x8){lo[0], lo[1], lo[2], lo[3], h4[0], h4[1], h4[2], h4[3]};
            o[db] = mfma32(vt, pa[s], o[db]);
            if (NDB == 4 && (s & 1)) __builtin_amdgcn_sched_barrier(0);
        }    __builtin_amdgcn_sched_barrier(0);
}
template <int NDB, class QF, class MaskF>
__device__ __forceinline__ void flash_tile_ref0(float& l_run, f32x16& lacc, f32x16 (&o)[NDB], const LAS unsigned char* kimg, const LAS unsigned char* vimg, const QF& qf, const MaskF& maskf, int r32, int hi, int vboff) {
    f32x16 p0, p1; maskf.init(p0, p1);
    bf16x8 kf[8];
#pragma unroll
    for (int ks = 0; ks < 4; ++ks) { kf[2 * ks] = *(const LAS bf16x8*)(kimg + kimg_off(r32, 2 * ks + hi)); kf[2 * ks + 1] = *(const LAS bf16x8*)(kimg + kimg_off(r32, 2 * ks + hi) + 4096); }
    __builtin_amdgcn_sched_barrier(0);
    __builtin_amdgcn_s_setprio(1);
#pragma unroll
    for (int ks = 0; ks < 4; ++ks) { const bf16x8 qk = qf(ks); p0 = mfma32(kf[2 * ks], qk, p0); p1 = mfma32(kf[2 * ks + 1], qk, p1); }
    __builtin_amdgcn_s_setprio(0);
    maskf(p0, p1);
    __builtin_amdgcn_sched_barrier(0);
    const bf16x8 ones = (bf16x8){0x3f80, 0x3f80, 0x3f80, 0x3f80, 0x3f80, 0x3f80, 0x3f80, 0x3f80};
#pragma unroll
    for (int r = 0; r < 16; ++r) p0[r] = fast_exp2(p0[r]);
    bf16x8 pa[4];
    pa[0] = __builtin_bit_cast(bf16x8, (u32x4){cvt_pk_bf16(p0[0], p0[1]), cvt_pk_bf16(p0[2], p0[3]), cvt_pk_bf16(p0[4], p0[5]), cvt_pk_bf16(p0[6], p0[7])});
    pa[1] = __builtin_bit_cast(bf16x8, (u32x4){cvt_pk_bf16(p0[8], p0[9]), cvt_pk_bf16(p0[10], p0[11]), cvt_pk_bf16(p0[12], p0[13]), cvt_pk_bf16(p0[14], p0[15])});
    maskf.pack(pa[0]); maskf.pack(pa[1]);
    __builtin_amdgcn_sched_barrier(0);
#pragma unroll
    for (int s = 0; s < 2; ++s) {
        lacc = mfma32(ones, pa[s], lacc);
#pragma unroll
        for (int db = 0; db < NDB; ++db) {
            const s16x4 lo = vtr(vimg + vboff + db * 4096 + s * 1024), h4 = vtr(vimg + vboff + db * 4096 + s * 1024 + 512);
            o[db] = mfma32((bf16x8){lo[0], lo[1], lo[2], lo[3], h4[0], h4[1], h4[2], h4[3]}, pa[s], o[db]);
        }
    }
#pragma unroll
    for (int r = 0; r < 16; ++r) p1[r] = fast_exp2(p1[r]);
    pa[2] = __builtin_bit_cast(bf16x8, (u32x4){cvt_pk_bf16(p1[0], p1[1]), cvt_pk_bf16(p1[2], p1[3]), cvt_pk_bf16(p1[4], p1[5]), cvt_pk_bf16(p1[6], p1[7])});
    pa[3] = __builtin_bit_cast(bf16x8, (u32x4){cvt_pk_bf16(p1[8], p1[9]), cvt_pk_bf16(p1[10], p1[11]), cvt_pk_bf16(p1[12], p1[13]), cvt_pk_bf16(p1[14], p1[15])});
    maskf.pack(pa[2]); maskf.pack(pa[3]);
    __builtin_amdgcn_sched_barrier(0);
#pragma unroll
    for (int s = 2; s < 4; ++s) {
        lacc = mfma32(ones, pa[s], lacc);
#pragma unroll
        for (int db = 0; db < NDB; ++db) {
            const s16x4 lo = vtr(vimg + vboff + db * 4096 + s * 1024), h4 = vtr(vimg + vboff + db * 4096 + s * 1024 + 512);
            o[db] = mfma32((bf16x8){lo[0], lo[1], lo[2], lo[3], h4[0], h4[1], h4[2], h4[3]}, pa[s], o[db]);
        }
    }
    __builtin_amdgcn_sched_barrier(0);
    (void)l_run;
}
template <bool KSWZ, class MaskF>
__device__ __forceinline__ void flash_tile_dual_ref0(float& l1, float& l2, f32x16 (&o1)[4], f32x16 (&o2)[4], const LAS unsigned char* k1img, const LAS unsigned char* k2img, const LAS unsigned char* vimg,
                                                     const LAS unsigned char* q1img, const LAS unsigned char* q2img, const MaskF& maskf, int r32, int hi, int vboff) {
    bf16x8 pa1[4], pa2[4];
#define DUAL_MAP_(kimg, qimg, pa, lsum) do { __builtin_amdgcn_sched_barrier(0); f32x16 p0, p1; maskf.init(p0, p1); \
        _Pragma("unroll") for (int ks = 0; ks < 4; ++ks) { const int ko = KSWZ ? kimg_off(r32, 2 * ks + hi) : (2 * ks + hi) * 1024 + r32 * 16; const bf16x8 qq = *(const LAS bf16x8*)(qimg + ks * 1024); \
            p0 = mfma32(*(const LAS bf16x8*)(kimg + ko), qq, p0); p1 = mfma32(*(const LAS bf16x8*)(kimg + ko + (KSWZ ? 4096 : 512)), qq, p1); if (ks & 1) __builtin_amdgcn_sched_barrier(0); } \
        maskf(p0, p1); float sm = 0.f; \
        _Pragma("unroll") for (int r = 0; r < 16; ++r) { p0[r] = fast_exp2(p0[r]); p1[r] = fast_exp2(p1[r]); sm += p0[r] + p1[r]; } \
        lsum += sm; \
        pa[0] = __builtin_bit_cast(bf16x8, (u32x4){cvt_pk_bf16(p0[0], p0[1]), cvt_pk_bf16(p0[2], p0[3]), cvt_pk_bf16(p0[4], p0[5]), cvt_pk_bf16(p0[6], p0[7])}); \
        pa[1] = __builtin_bit_cast(bf16x8, (u32x4){cvt_pk_bf16(p0[8], p0[9]), cvt_pk_bf16(p0[10], p0[11]), cvt_pk_bf16(p0[12], p0[13]), cvt_pk_bf16(p0[14], p0[15])}); \
        pa[2] = __builtin_bit_cast(bf16x8, (u32x4){cvt_pk_bf16(p1[0], p1[1]), cvt_pk_bf16(p1[2], p1[3]), cvt_pk_bf16(p1[4], p1[5]), cvt_pk_bf16(p1[6], p1[7])}); \
        pa[3] = __builtin_bit_cast(bf16x8, (u32x4){cvt_pk_bf16(p1[8], p1[9]), cvt_pk_bf16(p1[10], p1[11]), cvt_pk_bf16(p1[12], p1[13]), cvt_pk_bf16(p1[14], p1[15])}); } while (0)
    DUAL_MAP_(k1img, q1img, pa1, l1);
    DUAL_MAP_(k2img, q2img, pa2, l2);
#undef DUAL_MAP_
    __builtin_amdgcn_sched_barrier(0);
#pragma unroll
    for (int s = 0; s < 4; ++s) {
#pragma unroll
        for (int db = 0; db < 4; ++db) {
            const s16x4 lo = vtr(vimg + vboff + db * 4096 + s * 1024), h4 = vtr(vimg + vboff + db * 4096 + s * 1024 + 512);
            const bf16x8 vt = (bf16x8){lo[0], lo[1], lo[2], lo[3], h4[0], h4[1], h4[2], h4[3]};
            o1[db] = mfma32(vt, pa1[s], o1[db]); o2[db] = mfma32(vt, pa2[s], o2[db]);
            if (db & 1) __builtin_amdgcn_sched_barrier(0);
        }
    }
}
template <bool FAST, int NDB, class QF, class MaskF>
__device__ __forceinline__ void flash_step(float& m_run, float& l_run, f32x16& lacc, f32x16 (&o)[NDB], const LAS unsigned char* kimg, const LAS unsigned char* vimg, const QF& qf, const MaskF& maskf, int r32, int hi, int vboff) {
    if constexpr (FAST) flash_tile_ref0<NDB>(l_run, lacc, o, kimg, vimg, qf, maskf, r32, hi, vboff); else flash_tile<NDB>(m_run, l_run, o, kimg, vimg, qf, maskf, r32, hi, vboff);
}
__device__ __forceinline__ bool softmax_ref0_ok(const float* gq, const float* gk, int lane) {
    float a = fabsf(gq[lane]), b = fabsf(gk[lane]);
    a = fmaxf(a, xor_lane<1>(a)); a = fmaxf(a, xor_lane<2>(a)); a = fmaxf(a, xor_lane<4>(a)); a = fmaxf(a, xor_lane<8>(a)); a = fmaxf(a, xor_lane<16>(a)); a = max_xor32(a);
    b = fmaxf(b, xor_lane<1>(b)); b = fmaxf(b, xor_lane<2>(b)); b = fmaxf(b, xor_lane<4>(b)); b = fmaxf(b, xor_lane<8>(b)); b = fmaxf(b, xor_lane<16>(b)); b = max_xor32(b);
    return __builtin_amdgcn_readfirstlane(__builtin_bit_cast(int, a * b * (C2 * 64.0f * 1.02f))) < __builtin_bit_cast(int, 48.0f) && REF0_ENABLE;
}
#define MASK_INIT_ZERO __device__ __forceinline__ void init(f32x16& p0, f32x16& p1) const { p0 = splat16(0.f); p1 = splat16(0.f); }
#define MASK_PACK_NONE __device__ __forceinline__ void pack(bf16x8&) const {}
struct MaskNone { MASK_INIT_ZERO MASK_PACK_NONE __device__ __forceinline__ void operator()(f32x16&, f32x16&) const {} };
struct MaskCausal { int kb0, qloc, hi;
    MASK_INIT_ZERO MASK_PACK_NONE
    __device__ __forceinline__ void operator()(f32x16& p0, f32x16& p1) const {
#pragma unroll
        for (int r = 0; r < 16; ++r) { const int kv = kb0 + crow(r, hi); p0[r] = kv > qloc ? NEG_INF : p0[r]; p1[r] = kv + 32 > qloc ? NEG_INF : p1[r]; } } };
struct MaskCausalIf { bool on; int kb0, qloc, hi;
    MASK_INIT_ZERO MASK_PACK_NONE
    __device__ __forceinline__ void operator()(f32x16& p0, f32x16& p1) const { if (on) {
#pragma unroll
        for (int r = 0; r < 16; ++r) { const int kv = kb0 + crow(r, hi); p0[r] = kv > qloc ? NEG_INF : p0[r]; p1[r] = kv + 32 > qloc ? NEG_INF : p1[r]; } } } };
struct MaskLaneP { unsigned keep;
    MASK_INIT_ZERO
    __device__ __forceinline__ void operator()(f32x16&, f32x16&) const {}
    __device__ __forceinline__ void pack(bf16x8& pa) const { u32x4 v = __builtin_bit_cast(u32x4, pa); v = v & keep; pa = __builtin_bit_cast(bf16x8, v); } };
struct MaskLane { float ci;
    MASK_INIT_ZERO MASK_PACK_NONE
    __device__ __forceinline__ void operator()(f32x16& p0, f32x16& p1) const {
#pragma unroll
        for (int r = 0; r < 16; ++r) { p0[r] += ci; p1[r] += ci; } } };
template <int POS> __device__ __forceinline__ float neginf_if_bit(unsigned n) { float r; asm("v_bfe_i32 %0, %1, %2, 1\n\tv_and_b32 %0, 0xff800000, %0" : "=v"(r) : "v"(n), "n"(POS)); return r; }
struct MaskBits { unsigned n0, n1;
    __device__ __forceinline__ void init(f32x16& p0, f32x16& p1) const {
#define MB_(r) p0[r] = neginf_if_bit<((r) & 3) + 8 * ((r) >> 2)>(n0); p1[r] = neginf_if_bit<((r) & 3) + 8 * ((r) >> 2)>(n1);
        MB_(0) MB_(1) MB_(2) MB_(3) MB_(4) MB_(5) MB_(6) MB_(7) MB_(8) MB_(9) MB_(10) MB_(11) MB_(12) MB_(13) MB_(14) MB_(15)
#undef MB_
        asm volatile("s_nop 1" ::: "memory"); }
    MASK_PACK_NONE
    __device__ __forceinline__ void operator()(f32x16&, f32x16&) const {} };
__device__ __forceinline__ void dma16(const void* g, LAS unsigned char* l) { __builtin_amdgcn_global_load_lds((const unsigned*)g, (LAS unsigned*)l, 16, 0, 0); }
#define DMA_WAIT_SYNC() do { asm volatile("s_waitcnt vmcnt(0)" ::: "memory"); __syncthreads(); } while (0)

__device__ __forceinline__ void glds16(const void* gsrc, unsigned lds_dst) { unsigned keep;
    asm volatile("s_mov_b32 %0, m0\n\ts_mov_b32 m0, %2\n\ts_nop 0\n\tglobal_load_lds_dwordx4 %1, off\n\ts_mov_b32 m0, %0" : "=&s"(keep) : "v"(gsrc), "s"(lds_dst) : "memory"); }
__device__ __forceinline__ void glds4(const void* gsrc, unsigned lds_dst) { unsigned keep;
    asm volatile("s_mov_b32 %0, m0\n\ts_mov_b32 m0, %2\n\ts_nop 0\n\tglobal_load_lds_dword %1, off\n\ts_mov_b32 m0, %0" : "=&s"(keep) : "v"(gsrc), "s"(lds_dst) : "memory"); }
#define WAITV_BAR(N) asm volatile("s_waitcnt vmcnt(" #N ") lgkmcnt(0)\n\ts_barrier" ::: "memory")

template <int MODE, bool FAST>
__device__ __forceinline__ void attn_ab_unit(int b, int h, int qt, const bf16_t* qkv, bf16_t* obuf, const float* kmean, const unsigned* maskg, LAS unsigned char* lds, int tid, int lane, int w) {
    constexpr int CQ = MODE == 0 ? C_QA : C_QB, CK = MODE == 0 ? C_KA : C_KB, CV = MODE == 0 ? C_VA : C_VB;
    constexpr int NS = 4, D = 3, SLOT = 16384;
    const int r32 = lane & 31, hi = lane >> 5;
    const size_t rowbase = (size_t)b * SEQ; const int q0 = 256 * qt, qloc = 32 * w + r32; const size_t qrow = rowbase + q0 + qloc;
    const unsigned lds0 = (unsigned)(size_t)lds;
    LAS float* kml = (LAS float*)(lds + 73728); LAS unsigned* mwl = (LAS unsigned*)(lds + 65536);
    bf16x8 qf[4];
#pragma unroll
    for (int ks = 0; ks < 4; ++ks) qf[ks] = *(const bf16x8*)(qkv + qrow * QP + CQ + 64 * h + 16 * ks + 8 * hi);
    const bf16_t* ksrc = qkv + (rowbase + kdma_row(w, lane)) * QP + CK + 64 * h + 8 * kdma_chunk(w, lane);
    const bf16_t* vsrc = qkv + (rowbase + 16 * (w & 3) + (lane >> 2)) * QP + CV + 64 * h + 32 * (w >> 2) + 8 * (lane & 3);
    const unsigned* msrc = maskg + qrow * 128 + hi;
    const int NT = 4 * qt + 4, wlim = 4 * qt + (w >> 1);
    const unsigned kdst0 = (unsigned)__builtin_amdgcn_readfirstlane(lds0 + w * 1024), mdst0 = (unsigned)__builtin_amdgcn_readfirstlane(lds0 + 65536 + w * 256);
    __syncthreads();
#pragma unroll
    for (int d = 0; d < D; ++d) { const int t = d < NT ? d : NT - 1;
        glds16(ksrc + (size_t)t * 64 * QP, kdst0 + d * SLOT); glds16(vsrc + (size_t)t * 64 * QP, kdst0 + d * SLOT + 8192);
        if (MODE == 1) glds4(msrc + 2 * t, mdst0 + d * 2048); }
    unsigned selbits = 0;
    if (MODE == 0) {
        if (tid < 256) ((LAS f32x4*)kml)[tid] = ((const f32x4*)(kmean + (size_t)((b * 4 + h) * 16) * 64))[tid];
        __syncthreads();
        if (qt > 0) {
            float qv[32];
#pragma unroll
            for (int ks = 0; ks < 4; ++ks) { const u32x4 qq = __builtin_bit_cast(u32x4, qf[ks]);
#pragma unroll
                for (int k = 0; k < 4; ++k) { qv[8 * ks + 2 * k] = bf_lo(qq[k]); qv[8 * ks + 2 * k + 1] = bf_hi(qq[k]); } }
            float v1 = NEG_INF, v2 = NEG_INF, v3 = NEG_INF; int i1 = -1, i2 = -1, i3 = -1;
#pragma unroll 1
            for (int j = 0; j < qt; ++j) {
                float g = 0.f;
#pragma unroll
                for (int ks = 0; ks < 4; ++ks) { const f32x4 k0 = *(const LAS f32x4*)(kml + j * 64 + 16 * ks + 8 * hi), k1 = *(const LAS f32x4*)(kml + j * 64 + 16 * ks + 8 * hi + 4);
                    g += qv[8 * ks + 0] * k0[0] + qv[8 * ks + 1] * k0[1] + qv[8 * ks + 2] * k0[2] + qv[8 * ks + 3] * k0[3] + qv[8 * ks + 4] * k1[0] + qv[8 * ks + 5] * k1[1] + qv[8 * ks + 6] * k1[2] + qv[8 * ks + 7] * k1[3]; }
                g = sum_xor32(g);
                if (g > v1) { v3 = v2; i3 = i2; v2 = v1; i2 = i1; v1 = g; i1 = j; }
                else if (g > v2) { v3 = v2; i3 = i2; v2 = g; i2 = j; }
                else if (g > v3) { v3 = g; i3 = j; }
            }
            if (i1 >= 0) selbits |= 1u << i1; if (i2 >= 0) selbits |= 1u << i2; if (i3 >= 0) selbits |= 1u << i3;
        }
    }
    const int vboff = (4 * hi + ((lane & 15) >> 2)) * 64 + ((lane >> 4) & 1) * 32 + (lane & 3) * 8;
    float m_run = -1e30f, l_run = 0.f; f32x16 o[2], lacc = splat16(0.f); o[0] = splat16(0.f); o[1] = splat16(0.f);
    int scur = 0, siss = D;
    asm volatile("s_waitcnt vmcnt(0)" ::: "memory");
    asm volatile("" : "+v"(qf[0]), "+v"(qf[1]), "+v"(qf[2]), "+v"(qf[3]));
#pragma unroll 1
    for (int kt = 0; kt < NT; ++kt) {
        if (MODE == 1) WAITV_BAR(6); else WAITV_BAR(4);
        { const int t = kt + D < NT ? kt + D : NT - 1;
          glds16(ksrc + (size_t)t * 64 * QP, kdst0 + siss * SLOT); glds16(vsrc + (size_t)t * 64 * QP, kdst0 + siss * SLOT + 8192);
          if (MODE == 1) glds4(msrc + 2 * t, mdst0 + siss * 2048); }
        const LAS unsigned char* cur = lds + scur * SLOT;
        if (MODE == 0) {
            const int j = kt >> 2;
            if (j < qt) { const bool sel = (selbits >> j) & 1u; if (__ballot(sel) != 0ull) { if (FAST) flash_step<FAST, 2>(m_run, l_run, lacc, o, cur, cur + 8192, QReg{qf}, MaskLaneP{sel ? 0xffffffffu : 0u}, r32, hi, vboff); else flash_step<FAST, 2>(m_run, l_run, lacc, o, cur, cur + 8192, QReg{qf}, MaskLane{sel ? 0.f : NEG_INF}, r32, hi, vboff); } }
            else { const int kb0 = 64 * (kt & 3); if (kb0 <= 32 * w + 31) flash_step<FAST, 2>(m_run, l_run, lacc, o, cur, cur + 8192, QReg{qf}, MaskCausal{kb0, qloc, hi}, r32, hi, vboff); }
        } else {
            if (kt <= wlim) { const LAS unsigned* mp = mwl + scur * 512 + w * 64; const unsigned cw0 = mp[r32], cw1 = mp[32 + r32];
                flash_step<FAST, 2>(m_run, l_run, lacc, o, cur, cur + 8192, QReg{qf}, MaskBits{~cw0 >> (4 * hi), ~cw1 >> (4 * hi)}, r32, hi, vboff); }
        }
        scur = scur + 1 == NS ? 0 : scur + 1; siss = siss + 1 == NS ? 0 : siss + 1;
    }
    asm volatile("s_waitcnt vmcnt(0)" ::: "memory");
    const float inv = 1.0f / (FAST ? lacc[0] : sum_xor32(l_run));
    bf16_t* orow = obuf + qrow * 256 + 64 * h;
#pragma unroll
    for (int db = 0; db < 2; ++db)
#pragma unroll
        for (int g = 0; g < 4; ++g)
            *(u32x2*)(orow + 32 * db + 8 * g + 4 * hi) = (u32x2){cvt_pk_bf16(o[db][4 * g] * inv, o[db][4 * g + 1] * inv), cvt_pk_bf16(o[db][4 * g + 2] * inv, o[db][4 * g + 3] * inv)};
}

template <bool FAST>
__device__ __forceinline__ void attn_c_unit(int b, int h, int qt, const bf16_t* qkv, bf16_t* oc, float lam, const float* subg, float coef, LAS unsigned char* lds, int tid, int lane, int w) {
    const int r32 = lane & 31, hi = lane >> 5;
    const size_t rowbase = (size_t)b * SEQ; const int q0 = 256 * qt, qloc = 32 * w + r32; const size_t qrow = rowbase + q0 + qloc;
    LAS unsigned char* qimg = lds + 65536 + w * 8192 + lane * 16;
    __syncthreads();
#pragma unroll
    for (int ks = 0; ks < 4; ++ks) { *(LAS bf16x8*)(qimg + ks * 1024) = *(const bf16x8*)(qkv + qrow * QP + C_Q1 + 64 * h + 16 * ks + 8 * hi); *(LAS bf16x8*)(qimg + 4096 + ks * 1024) = *(const bf16x8*)(qkv + qrow * QP + C_Q2 + 64 * h + 16 * ks + 8 * hi); }
    const bf16_t* k1src = FAST ? qkv + (rowbase + kdma_row(w, lane)) * QP + C_K1 + 64 * h + 8 * kdma_chunk(w, lane)
                               : qkv + (rowbase + lane) * QP + C_K1 + 64 * h + 8 * w;
    const bf16_t* k2src = k1src + (C_K2 - C_K1);
    const bf16_t* v0src = qkv + (rowbase + 16 * (w & 3) + (lane >> 2)) * QP + C_VC + 128 * h + 32 * (w >> 2) + 8 * (lane & 3);
    const bf16_t* v1src = v0src + 64;
    const int vboff = (4 * hi + ((lane & 15) >> 2)) * 64 + ((lane >> 4) & 1) * 32 + (lane & 3) * 8;
    const int NT = 4 * qt + 4;
    float m1 = -1e30f, l1 = 0.f, m2 = -1e30f, l2 = 0.f; f32x16 o1[4], o2[4];
#pragma unroll
    for (int i = 0; i < 4; ++i) { o1[i] = splat16(0.f); o2[i] = splat16(0.f); }
    dma16(k1src, lds + w * 1024); dma16(k2src, lds + 8192 + w * 1024); dma16(v0src, lds + 16384 + w * 1024); dma16(v1src, lds + 16384 + 8192 + w * 1024);
    DMA_WAIT_SYNC();
#pragma unroll 1
    for (int kt = 0; kt < NT; ++kt) {
        LAS unsigned char* cur = lds + (kt & 1) * 32768; LAS unsigned char* nxt = lds + ((kt + 1) & 1) * 32768;
        if (kt + 1 < NT) { const size_t adv = (size_t)(kt + 1) * 64 * QP;
            dma16(k1src + adv, nxt + w * 1024); dma16(k2src + adv, nxt + 8192 + w * 1024); dma16(v0src + adv, nxt + 16384 + w * 1024); dma16(v1src + adv, nxt + 16384 + 8192 + w * 1024); }
        const bool band = kt >= 4 * qt; const int kb0 = 64 * (kt & 3);
        if (!band || kb0 <= 32 * w + 31) { const MaskCausalIf mk{band, kb0, qloc, hi};
            if (FAST) flash_tile_dual_ref0<true>(l1, l2, o1, o2, cur, cur + 8192, cur + 16384, qimg, qimg + 4096, mk, r32, hi, vboff);
            else { flash_step<false, 4>(m1, l1, o1[0], o1, cur, cur + 16384, QLds{qimg}, mk, r32, hi, vboff); flash_step<false, 4>(m2, l2, o2[0], o2, cur + 8192, cur + 16384, QLds{qimg + 4096}, mk, r32, hi, vboff); } }
        DMA_WAIT_SYNC();
    }
    const float i1 = 1.0f / sum_xor32(l1), i2 = lam / sum_xor32(l2);
    float ss = 0.f;
#pragma unroll
    for (int db = 0; db < 4; ++db) { o1[db] = o1[db] * i1 - o2[db] * i2;
#pragma unroll
        for (int r = 0; r < 16; ++r) ss += o1[db][r] * o1[db][r]; }
    ss = sum_xor32(ss);
    const float rn = coef / sqrtf(ss * (1.0f / 128.0f) + EPS);
    bf16_t* orow = oc + qrow * 512 + 128 * h;
#pragma unroll
    for (int db = 0; db < 4; ++db)
#pragma unroll
        for (int g = 0; g < 4; ++g) { const int d = 32 * db + 8 * g + 4 * hi; const f32x4 gg = *(const f32x4*)(subg + d);
            *(u32x2*)(orow + d) = (u32x2){cvt_pk_bf16(o1[db][4 * g] * rn * gg[0], o1[db][4 * g + 1] * rn * gg[1]), cvt_pk_bf16(o1[db][4 * g + 2] * rn * gg[2], o1[db][4 * g + 3] * rn * gg[3])}; }
}

__device__ __forceinline__ void index_unit(int b, int i64, const bf16_t* qkv, unsigned* maskg, unsigned char* scr, LAS unsigned char* lds, int tid, int lane, int w) {
    constexpr int NS = 5, D = 4, HS = 257, RING = 84224, TOFF = 65792, TROW = 144;
    const int r32 = lane & 31, hi = lane >> 5;
    const unsigned lds0 = (unsigned)(size_t)lds;
    LAS unsigned* hist = (LAS unsigned*)lds; LAS unsigned char* ring = lds + RING; LAS unsigned char* mb8 = lds;
    LAS int* thrB1 = (LAS int*)(lds + 125184); LAS int* thrRem = thrB1 + 64; LAS int* thrT = thrB1 + 128; LAS int* thrNeed = thrB1 + 192;
    const size_t rowbase = (size_t)b * SEQ; const int q0 = 64 * i64, NT = i64 + 1;
    __syncthreads();
    {
        const int hh = 4 * ((r32 >> 3) & 1) + (r32 & 3), qp = 2 * (r32 >> 4) + ((r32 >> 2) & 1);
        bf16x8 aq[2][4]; float wv[2][2][8];
#pragma unroll
        for (int rb = 0; rb < 2; ++rb) {
            const size_t row = rowbase + q0 + 8 * w + 4 * rb + qp;
#pragma unroll
            for (int ks = 0; ks < 4; ++ks) aq[rb][ks] = *(const bf16x8*)(qkv + row * QP + C_QI + 64 * hh + 16 * ks + 8 * hi);
#pragma unroll
            for (int hf = 0; hf < 2; ++hf) { const u32x4 ww = *(const u32x4*)(qkv + (rowbase + q0 + 8 * w + 4 * rb + 2 * hf + hi) * QP + C_WI);
#pragma unroll
                for (int k = 0; k < 4; ++k) { wv[rb][hf][2 * k] = bf_lo(ww[k]); wv[rb][hf][2 * k + 1] = bf_hi(ww[k]); } }
        }
#pragma unroll
        for (int rb = 0; rb < 2; ++rb) { asm volatile("" : "+v"(aq[rb][0]), "+v"(aq[rb][1]), "+v"(aq[rb][2]), "+v"(aq[rb][3]));
#pragma unroll
            for (int hf = 0; hf < 2; ++hf) asm volatile("" : "+v"(wv[rb][hf][0]), "+v"(wv[rb][hf][1]), "+v"(wv[rb][hf][2]), "+v"(wv[rb][hf][3]), "+v"(wv[rb][hf][4]), "+v"(wv[rb][hf][5]), "+v"(wv[rb][hf][6]), "+v"(wv[rb][hf][7])); }
        const bf16_t* ksrc = qkv + (rowbase + kdma_row(w, lane)) * QP + C_KI + 8 * kdma_chunk(w, lane);
        const unsigned kdst0 = (unsigned)__builtin_amdgcn_readfirstlane(lds0 + RING + w * 1024);
#pragma unroll
        for (int d = 0; d < D; ++d) { const int t = d < NT ? d : NT - 1; glds16(ksrc + (size_t)t * 64 * QP, kdst0 + d * 8192); }
        for (int i = tid; i < 4112; i += 512) ((LAS u32x4*)hist)[i] = (u32x4){0u, 0u, 0u, 0u};
        asm volatile("s_waitcnt lgkmcnt(0)" ::: "memory");
        int scur = 0, siss = D;
#pragma unroll 1
        for (int kt = 0; kt <= NT; ++kt) {
            if (kt < NT) WAITV_BAR(3); else { asm volatile("s_waitcnt vmcnt(0)" ::: "memory"); __syncthreads(); }
            if (kt > 0) {
                const u32x4 kk = *(const LAS u32x4*)(lds + TOFF + ((kt - 1) & 1) * 9216 + lane * TROW + w * 16);
                {
                    const u32x4 ks = *(const LAS u32x4*)(lds + TOFF + ((kt - 1) & 1) * 9216 + (8 * w + (lane >> 3)) * TROW + (lane & 7) * 16);
                    unsigned char* sp = scr + (size_t)(8 * w + (lane >> 3)) * 8192 + (size_t)(kt - 1) * 128 + (lane & 7) * 16;
                    if (kt < NT) asm volatile("global_store_dwordx4 %0, %1, off" :: "v"(sp), "v"(ks) : "memory");
                    else *(u32x4*)sp = ks; }
#pragma unroll
                for (int k = 0; k < 4; ++k) { const unsigned a = kk[k] & 0xffffu, c = kk[k] >> 16;
                    if (a) __hip_atomic_fetch_add(&hist[lane * HS + (a >> 8)], 1u, __ATOMIC_RELAXED, __HIP_MEMORY_SCOPE_WORKGROUP);
                    if (c) __hip_atomic_fetch_add(&hist[lane * HS + (c >> 8)], 1u, __ATOMIC_RELAXED, __HIP_MEMORY_SCOPE_WORKGROUP); }
            }
            if (kt == NT) break;
            { const int t = kt + D < NT ? kt + D : NT - 1; glds16(ksrc + (size_t)t * 64 * QP, kdst0 + siss * 8192); }
            const LAS unsigned char* kimg = ring + scur * 8192;
            const bool diag = kt == NT - 1;
#pragma unroll
            for (int rb = 0; rb < 2; ++rb)
#pragma unroll
                for (int kb = 0; kb < 2; ++kb) {
                    f32x16 d = splat16(0.f);
#pragma unroll
                    for (int ks = 0; ks < 4; ++ks) { __builtin_amdgcn_s_setprio(1); d = mfma32(aq[rb][ks], *(const LAS bf16x8*)(kimg + kimg_off(32 * kb + r32, 2 * ks + hi)), d); __builtin_amdgcn_s_setprio(0); }
#pragma unroll
                    for (int hf = 0; hf < 2; ++hf) {
                        float sc = 0.f;
#pragma unroll
                        for (int t = 0; t < 8; ++t) { const float mx_ = fmaxf(d[8 * hf + t], 0.f); asm("v_fma_f32 %0, %1, %2, %0" : "+v"(sc) : "v"(wv[rb][hf][t]), "v"(mx_)); }
                        const int ql = 8 * w + 4 * rb + 2 * hf + hi;
                        const unsigned u = (unsigned)__builtin_bit_cast(unsigned short, (_Float16)sc);
                        unsigned key = u ^ ((u & 0x8000u) ? 0xffffu : 0x8000u);
                        if (diag && 32 * kb + r32 > ql) key = 0u;
                        *(LAS unsigned short*)(lds + TOFF + (kt & 1) * 9216 + ql * TROW + (32 * kb + r32) * 2) = (unsigned short)key;
                    }
                }
            scur = scur + 1 == NS ? 0 : scur + 1; siss = siss + 1 == NS ? 0 : siss + 1;
        }
        asm volatile("s_waitcnt vmcnt(0)" ::: "memory");
        __syncthreads();
    }
#define IDX_SEARCH(STAGE) do { _Pragma("unroll 1") for (int qq = 0; qq < 8; ++qq) { const int q = 8 * w + qq; int target; \
        if (STAGE == 0) { if (q0 + q + 1 <= 256) { if (lane == 0) { thrB1[q] = 0x10000; thrRem[q] = 0; } continue; } target = 256; } \
        else { if (thrB1[q] == 0x10000) { if (lane == 0) { thrT[q] = 0; thrNeed[q] = 0; } continue; } target = thrRem[q]; } \
        const LAS unsigned* hp = hist + q * HS + 4 * lane; const int h0 = (int)hp[0], h1 = (int)hp[1], h2 = (int)hp[2], h3 = (int)hp[3]; \
        int P = h0 + h1 + h2 + h3; const int s_ = P; \
        _Pragma("unroll") for (int o = 1; o < 64; o <<= 1) { const int t_ = lane_val(P, (lane - o) & 63); if (lane >= o) P += t_; } \
        const int above = __builtin_amdgcn_readlane(P, 63) - P; (void)s_; \
        const int c3 = above + h3, c2 = c3 + h2, c1 = c2 + h1, c0 = c1 + h0; int bin = -1, ab = 0; \
        if (above < target && c3 >= target) { bin = 4 * lane + 3; ab = above; } else if (c3 < target && c2 >= target) { bin = 4 * lane + 2; ab = c3; } \
        else if (c2 < target && c1 >= target) { bin = 4 * lane + 1; ab = c2; } else if (c1 < target && c0 >= target) { bin = 4 * lane; ab = c1; } \
        if (bin >= 0) { if (STAGE == 0) { thrB1[q] = bin; thrRem[q] = target - ab; } else { thrT[q] = (thrB1[q] << 8) | bin; thrNeed[q] = target - ab; } } } \
        __syncthreads(); } while (0)
    IDX_SEARCH(0);
    const int qs = 8 * w + (lane >> 3), pc = lane & 7;
    const unsigned char* rrow = scr + (size_t)qs * 8192 + pc * 16;
    {
        __builtin_amdgcn_fence(__ATOMIC_ACQUIRE, "agent");
        asm volatile("s_waitcnt vmcnt(0)" ::: "memory");
        const int b1 = thrB1[qs];
        for (int i = tid; i < 4112; i += 512) ((LAS u32x4*)hist)[i] = (u32x4){0u, 0u, 0u, 0u};
        __syncthreads();
#pragma unroll 4
        for (int it = 0; it < NT; ++it) { const u32x4 kk = *(const u32x4*)(rrow + (size_t)it * 128);
#pragma unroll
            for (int k = 0; k < 4; ++k) { const unsigned a = kk[k] & 0xffffu, c = kk[k] >> 16;
                if ((int)(a >> 8) == b1) __hip_atomic_fetch_add(&hist[qs * HS + (a & 255u)], 1u, __ATOMIC_RELAXED, __HIP_MEMORY_SCOPE_WORKGROUP);
                if ((int)(c >> 8) == b1) __hip_atomic_fetch_add(&hist[qs * HS + (c & 255u)], 1u, __ATOMIC_RELAXED, __HIP_MEMORY_SCOPE_WORKGROUP); } }
        __syncthreads();
    }
    IDX_SEARCH(1);
    {
        const unsigned T = (unsigned)thrT[qs]; const int need = thrNeed[qs]; int tc = 0;
        __syncthreads();
#pragma unroll 2
        for (int it = 0; it < NT; ++it) { const u32x4 kk = *(const u32x4*)(rrow + (size_t)it * 128);
            unsigned sel = 0, eq = 0;
#pragma unroll
            for (int k = 0; k < 4; ++k) { const unsigned a = kk[k] & 0xffffu, c = kk[k] >> 16;
                sel |= (a > T ? 1u : 0u) << (2 * k); sel |= (c > T ? 1u : 0u) << (2 * k + 1); eq |= (a == T ? 1u : 0u) << (2 * k); eq |= (c == T ? 1u : 0u) << (2 * k + 1); }
            if (T == 0u) eq = 0u;
            if (__ballot(eq != 0u) != 0ull) {
                const int n = __popc(eq); int P = n;
#pragma unroll
                for (int o = 1; o < 8; o <<= 1) { const int t_ = lane_val(P, (lane - o) & 63); if ((lane & 7) >= o) P += t_; }
                int allow = need - tc - (P - n);
#pragma unroll
                for (int k = 0; k < 8; ++k) if (((eq >> k) & 1u) && allow > 0) { sel |= 1u << k; --allow; }
                tc += lane_val(P, (lane & ~7) + 7);
            }
            mb8[qs * 512 + it * 8 + pc] = (unsigned char)sel;
        }
        __syncthreads();
    }
#undef IDX_SEARCH
    for (int idx = tid; idx < 64 * 2 * NT; idx += 512) { const int q = idx / (2 * NT), wd = idx - q * 2 * NT; maskg[(rowbase + q0 + q) * 128 + wd] = ((const LAS unsigned*)mb8)[q * 128 + wd]; }
}

__device__ __forceinline__ int next_unit(unsigned* ctr, LAS unsigned char* lds, int tid) {
    volatile LAS int* bc = (volatile LAS int*)(lds + LX_BC);
    __syncthreads();
    if (tid == 0) *bc = (int)__hip_atomic_fetch_add(ctr, 1u, __ATOMIC_RELAXED, __HIP_MEMORY_SCOPE_AGENT);
    __syncthreads();
    return __builtin_amdgcn_readfirstlane(*bc);
}

__device__ __forceinline__ void m1_phase(const Args& a, unsigned char* ws, int lc, LAS unsigned char* lds, int lane, int wave, int vcu, int G) {
    const int l = lc & 1;
    const float* wrt = (const float*)(ws + WS_WRT);
    const float* bg = a.in[I_B_GROUP] + l * 4; const float* br = a.in[I_B_ROUTER] + l * 32;
    unsigned* cnt = (unsigned*)(ws + WS_CTL) + CW_CNT + 2048 * lc;
    unsigned* rt0 = (unsigned*)(ws + WS_RT0); unsigned* rt1 = (unsigned*)(ws + WS_RT1); f32x2* rtw = (f32x2*)(ws + WS_RTW);
    int* tokl = (int*)(ws + WS_TOKL); bf16_t* xg = (bf16_t*)(ws + WS_XG); float* rstdg = (float*)(ws + WS_RSTD); const float* gain = a.in[I_NORM_FFN] + (size_t)l * DM;
    const int r32 = lane & 31, kh = lane >> 5, wq = wave & 3, kpart = wave >> 2;
    LAS float* tl = (LAS float*)(lds + wq * 8192);
    LAS float* tss = tl + 32 * 40;
    LAS float* xs = (LAS float*)(lds + 32768 + wave * 8704);
#pragma unroll 1
    for (int t = wq * G + vcu; t < MTOK / 32; t += 4 * G) {
        const float* xbase = a.out + (size_t)(32 * t + (lane >> 4)) * DM + 512 * kpart + 4 * (lane & 15);
        bf16_t* xobase = xg + (size_t)(32 * t + (lane >> 4)) * DM + 512 * kpart + 4 * (lane & 15); const float* gbase = gain + 512 * kpart + 4 * (lane & 15);
        const float* wp0 = wrt + (size_t)r32 * DM + 512 * kpart + 4 * kh; const float* wp1 = wrt + (size_t)(32 + (r32 & 3)) * DM + 512 * kpart + 4 * kh;
        f32x16 d0 = splat16(0.f), d1 = splat16(0.f); float ss = 0.f;
        f32x4 xr[8];
#pragma unroll
        for (int j = 0; j < 8; ++j) xr[j] = *(const f32x4*)(xbase + (size_t)(4 * j) * DM);
#pragma unroll 1
        for (int c = 0; c < 8; ++c) {
            const f32x4 g4 = *(const f32x4*)(gbase + 64 * c);
#pragma unroll
            for (int j = 0; j < 8; ++j) { *(LAS f32x4*)(xs + (4 * j + (lane >> 4)) * 68 + 4 * (lane & 15)) = xr[j];
                const f32x4 o = xr[j] * g4; *(u32x2*)(xobase + (size_t)(4 * j) * DM + 64 * c) = (u32x2){cvt_pk_bf16(o[0], o[1]), cvt_pk_bf16(o[2], o[3])}; }
            if (c < 7) {
#pragma unroll
                for (int j = 0; j < 8; ++j) xr[j] = *(const f32x4*)(xbase + (size_t)(4 * j) * DM + 64 * (c + 1)); }
            LDS_WAIT(); asm volatile("" ::: "memory");
#pragma unroll
            for (int mm = 0; mm < 8; ++mm) {
                const f32x4 xa = *(const LAS f32x4*)(xs + r32 * 68 + 8 * mm + 4 * kh), b0 = *(const f32x4*)(wp0 + 64 * c + 8 * mm), b1 = *(const f32x4*)(wp1 + 64 * c + 8 * mm);
                ss += (xa[0] * xa[0] + xa[1] * xa[1]) + (xa[2] * xa[2] + xa[3] * xa[3]);
#pragma unroll
                for (int i = 0; i < 4; ++i) { d0 = __builtin_amdgcn_mfma_f32_32x32x2f32(xa[i], b0[i], d0, 0, 0, 0); d1 = __builtin_amdgcn_mfma_f32_32x32x2f32(xa[i], b1[i], d1, 0, 0, 0); }
            }
            LDS_WAIT(); asm volatile("" ::: "memory");
        }
        ss = sum_xor32(ss);
        if (kpart == 1) {
#pragma unroll
            for (int r = 0; r < 16; ++r) { tl[crow(r, kh) * 40 + r32] = d0[r]; if (r32 < 4) tl[crow(r, kh) * 40 + 32 + r32] = d1[r]; }
            if (kh == 0) tss[r32] = ss;
        }
        __syncthreads();
        if (kpart == 0) {
#pragma unroll
            for (int r = 0; r < 16; ++r) { tl[crow(r, kh) * 40 + r32] += d0[r]; if (r32 < 4) tl[crow(r, kh) * 40 + 32 + r32] += d1[r]; }
            ss += tss[r32];
            LDS_WAIT(); asm volatile("" ::: "memory");
            const float rstd = 1.0f / sqrtf(ss * (1.0f / DM) + EPS);
            const LAS float* my = tl + r32 * 40;
            float gl[4];
#pragma unroll
            for (int c = 0; c < 4; ++c) gl[c] = my[c] * rstd + bg[c];
            int g = 0; float gm = gl[0];
#pragma unroll
            for (int c = 1; c < 4; ++c) if (gl[c] > gm) { gm = gl[c]; g = c; }
            float den = 0.f;
#pragma unroll
            for (int c = 0; c < 4; ++c) den += __expf(gl[c] - gm);
            const float gwt = 1.0f / den;
            float le[8];
#pragma unroll
            for (int e = 0; e < 8; ++e) le[e] = my[4 + 8 * g + e] * rstd + br[8 * g + e];
            int i1 = 0; float v1 = le[0];
#pragma unroll
            for (int e = 1; e < 8; ++e) if (le[e] > v1) { v1 = le[e]; i1 = e; }
            int i2 = -1; float v2 = NEG_INF;
#pragma unroll
            for (int e = 0; e < 8; ++e) if (e != i1 && le[e] > v2) { v2 = le[e]; i2 = e; }
            const float ex = __expf(v2 - v1), w1 = 1.0f / (1.0f + ex), w2 = ex * w1;
            if (kh == 0) { const int e0 = g * 8 + i1, e1 = g * 8 + i2, m = 32 * t + r32;
                const unsigned r0 = atomicAdd(cnt + 64 * e0, 1u), r1 = atomicAdd(cnt + 64 * e1, 1u);
                rt0[m] = ((unsigned)e0 << 24) | r0; rt1[m] = ((unsigned)e1 << 24) | r1; rtw[m] = (f32x2){gwt * w1, gwt * w2};
                tokl[e0 * 32768 + (int)r0] = m; tokl[e1 * 32768 + (int)r1] = m; }
            if (kh == 0) rstdg[32 * t + r32] = rstd;
        }
        __syncthreads();
    }
}
__device__ __forceinline__ void moe_tables(const unsigned* cnt, const int* tokl, const float* rstdg, LAS unsigned char* lds, int tid, int c, int G) {
    LAS int* pstart = (LAS int*)(lds + LX_PSTART); LAS int* blk2e = (LAS int*)(lds + LX_BLK2E); LAS int* cntl = (LAS int*)(lds + LX_CNT); LAS int* tok = (LAS int*)(lds + LX_TOK);
    if (tid < 64) {
        const int cn = tid < NEXP ? (int)cnt[64 * tid] : 0, nb = (cn + 255) >> 8;
        int P = nb;
#pragma unroll
        for (int o = 1; o < 64; o <<= 1) { const int t = lane_val(P, (tid - o) & 63); if (tid >= o) P += t; }
        const int pb = P - nb;
        if (tid <= NEXP) pstart[tid] = pb * 256;
        if (tid < NEXP) cntl[tid] = cn;
        if (tid == NEXP) *(LAS int*)(lds + LX_NBLK) = pb < MAXBLK ? pb : MAXBLK;
#pragma unroll 1
        for (int k = 0; k < nb; ++k) if (pb + k < MAXBLK) blk2e[pb + k] = tid;
    }
    __syncthreads();
    const int nblk = *(const LAS int*)(lds + LX_NBLK), rbs = G / 4;
    LAS float* rst = (LAS float*)(lds + LX_RST);
    for (int k = 0; k < 6; ++k) { const int rb = c / 4 + k * rbs; if (rb >= nblk) break;
        const int e = blk2e[rb], r = rb * 256 - pstart[e] + (tid & 255);
        if (tid < 256) { const int tk = r < cntl[e] ? tokl[e * 32768 + r] : 0; tok[k * 256 + tid] = tk; rst[k * 256 + tid] = rstdg[tk]; } }
    __syncthreads();
}

#ifndef PHASES
#define PHASES 0xFFFF
#endif
#define PH(n) if constexpr (((PHASES) >> (n)) & 1)
#ifndef REPEAT_MASK
#define REPEAT_MASK 0
#endif
#define REP(k) for (int rep_ = 0; rep_ < 1 + (((REPEAT_MASK) >> (k)) & 1); ++rep_)
#ifndef GEMM_ALIGN
#define GEMM_ALIGN true
#endif
#ifndef GEMM_SP2
#define GEMM_SP2 true
#endif
#define PHASE_ENV() unsigned long long wsi_ = (unsigned long long)args.ws; int G = (int)gridDim.x, bx = (int)blockIdx.x; asm volatile("" : "+s"(wsi_), "+s"(G), "+s"(bx)); \
    unsigned char* const ws = (unsigned char*)(GAS unsigned char*)wsi_; const int vcu = (G % 8 == 0) ? (bx % 8) * (G / 8) + bx / 8 : bx;   \
    int tid = (int)threadIdx.x; asm volatile("" : "+v"(tid)); const int lane = tid & 63, wave = __builtin_amdgcn_readfirstlane(tid >> 6); \
    unsigned* const ctl = (unsigned*)(ws + WS_CTL); bf16_t* const QKV = (bf16_t*)(ws + WS_QKV); unsigned char* const SG = ws + WS_SG; unsigned* const MASK = (unsigned*)(ws + WS_MASK); float* const KMEAN = (float*)(ws + WS_KMEAN); \
    (void)lane; (void)wave; (void)ctl; (void)QKV; (void)SG; (void)MASK; (void)KMEAN; (void)vcu
#define GRID_BAR() do { unsigned long long wb_ = (unsigned long long)args.ws; asm volatile("" : "+s"(wb_)); XcdBarrier b_ = bar0; b_.bar = (unsigned*)((GAS unsigned char*)wb_ + WS_CTL) + CW_BAR; asm volatile("" : "+s"(b_.x)); xcd_barrier(b_); if (((REPEAT_MASK) >> 12) & 1) xcd_barrier(b_); } while (0)


template <int L> __device__ __forceinline__ void layer_body(const Args& args, LAS unsigned char* lds, const XcdBarrier& bar0) {
    constexpr int l = L;

        PH(0) for (int rep_ = 0; rep_ < 1 + ((((REPEAT_MASK) >> 0) & 1) && l == 0); ++rep_) { PHASE_ENV(); p0_phase(args, ws, l, lds, tid, lane, wave, vcu, G); }
        GRID_BAR();
        PH(1) REP(1) { PHASE_ENV();
            pg8::Gemm g{(const bf16_t*)(ws + WS_HN), (const bf16_t*)(ws + WS_WIN), MTOK, NT_IN * 256, DM}; pg8::StaticOrder S; S.init(MTOK, NT_IN * 256, G, bx);
            pg8::EpiInProj E{QKV, SG, (const float*)(ws + WS_COS), (const float*)(ws + WS_SIN), args.in[I_QK_GAIN] + l * 6 * 64, args.in[I_IDX_K_GAIN] + l * 64};
            pg8::gemm_phase<pg8::EpiInProj, pg8::StaticOrder, GEMM_ALIGN, GEMM_SP2>(lds, g, S, E);
        }
        GRID_BAR();
        { PHASE_ENV();
            LAS float* red = (LAS float*)lds;
            for (int it = bx; it < NBATCH * 4 * 16; it += G) { const int b = it >> 6, h = (it >> 4) & 3, blk = it & 15, d = tid & 63, rg = tid >> 6;
                const bf16_t* kp = QKV + ((size_t)b * SEQ + blk * 256 + rg * 32) * QP + C_KA + 64 * h + d; float s = 0.f;
#pragma unroll 8
                for (int r = 0; r < 32; ++r) s += __builtin_bit_cast(float, (unsigned)kp[(size_t)r * QP] << 16);
                __syncthreads(); red[tid] = s; __syncthreads();
                if (tid < 64) { float t = 0.f;
#pragma unroll
                    for (int k = 0; k < 8; ++k) t += red[k * 64 + tid];
                    KMEAN[(size_t)it * 64 + tid] = t * (1.0f / 256.0f); } }
            __syncthreads();
        }
        PH(2) REP(2) { PHASE_ENV();
            const float* dl = args.in[I_DIFF_LAMBDA] + l * 256;
            const float lam_init = 0.8f - 0.6f * __expf(-0.3f * (float)l);
            const float lam = __expf(wave_sum(dl[lane] * dl[64 + lane])) - __expf(wave_sum(dl[128 + lane] * dl[192 + lane])) + lam_init;
            const float* subg = args.in[I_DIFF_SUBLN] + l * 128;
            unsigned* qc = ctl + CW_QUEUE + 64 * (l * 4 + 0 + 8 * rep_);
            const float* qkg = args.in[I_QK_GAIN] + l * 6 * 64;
            if (softmax_ref0_ok(qkg + 4 * 64, qkg + 5 * 64, lane)) { for (;;) { const int u = next_unit(qc, lds, tid); if (u >= 512) break; const int r = u & 31; attn_c_unit<true>(r >> 2, r & 3, 15 - (u >> 5), QKV, (bf16_t*)(ws + WS_OC), lam, subg, 1.0f - lam_init, lds, tid, lane, wave); } }
            else { for (;;) { const int u = next_unit(qc, lds, tid); if (u >= 512) break; const int r = u & 31; attn_c_unit<false>(r >> 2, r & 3, 15 - (u >> 5), QKV, (bf16_t*)(ws + WS_OC), lam, subg, 1.0f - lam_init, lds, tid, lane, wave); } }
        }
        PH(3) REP(3) { PHASE_ENV();
            unsigned* qi = ctl + CW_QUEUE + 64 * (l * 4 + 1 + 8 * rep_);
            for (;;) { const int u = next_unit(qi, lds, tid); if (u >= 512) break; index_unit(u & 7, 63 - (u >> 3), QKV, MASK, ws + WS_WGU + (size_t)bx * 524288, lds, tid, lane, wave); }
        }
        GRID_BAR();
        PH(4) REP(4) { PHASE_ENV();
            unsigned* qa = ctl + CW_QUEUE + 64 * (l * 4 + 2 + 8 * rep_);
            const float* qkg = args.in[I_QK_GAIN] + l * 6 * 64;
            if (softmax_ref0_ok(qkg, qkg + 64, lane)) { for (;;) { const int u = next_unit(qa, lds, tid); if (u >= 512) break; const int r = u & 31; attn_ab_unit<0, true>(r >> 2, r & 3, 15 - (u >> 5), QKV, (bf16_t*)(ws + WS_OA), KMEAN, MASK, lds, tid, lane, wave); } }
            else { for (;;) { const int u = next_unit(qa, lds, tid); if (u >= 512) break; const int r = u & 31; attn_ab_unit<0, false>(r >> 2, r & 3, 15 - (u >> 5), QKV, (bf16_t*)(ws + WS_OA), KMEAN, MASK, lds, tid, lane, wave); } }
        }
        PH(5) REP(5) { PHASE_ENV();
            unsigned* qb = ctl + CW_QUEUE + 64 * (l * 4 + 3 + 8 * rep_);
            const float* qkg = args.in[I_QK_GAIN] + l * 6 * 64;
            if (softmax_ref0_ok(qkg + 2 * 64, qkg + 3 * 64, lane)) { for (;;) { const int u = next_unit(qb, lds, tid); if (u >= 512) break; const int r = u & 31; attn_ab_unit<1, true>(r >> 2, r & 3, 15 - (u >> 5), QKV, (bf16_t*)(ws + WS_OB), KMEAN, MASK, lds, tid, lane, wave); } }
            else { for (;;) { const int u = next_unit(qb, lds, tid); if (u >= 512) break; const int r = u & 31; attn_ab_unit<1, false>(r >> 2, r & 3, 15 - (u >> 5), QKV, (bf16_t*)(ws + WS_OB), KMEAN, MASK, lds, tid, lane, wave); } }
        }
        { PHASE_ENV();
            unsigned* qw = ctl + CW_QUEUE + 64 * (16 + l);
            for (;;) { const int c = next_unit(qw, lds, tid); if (c >= (32 * 32 * 16 + 32 * 32 * 8) / 128) break; convert_weights<true>(args, ws, l, lds, lane, wave, vcu, G, c); }
        }
        GRID_BAR();
        PH(6) REP(6) {
            { PHASE_ENV(); pg8::StaticOrder S; S.init(MTOK, DM, G, bx); pg8::Gemm g{(const bf16_t*)(ws + WS_OA), (const bf16_t*)(ws + WS_WPA), MTOK, DM, 256}; pg8::EpiMerge<0> E{(bf16_t*)(ws + WS_MERGED), SG}; pg8::gemm_phase<pg8::EpiMerge<0>, pg8::StaticOrder, GEMM_ALIGN, GEMM_SP2>(lds, g, S, E); }
            { PHASE_ENV(); pg8::StaticOrder S; S.init(MTOK, DM, G, bx); pg8::Gemm g{(const bf16_t*)(ws + WS_OB), (const bf16_t*)(ws + WS_WPB), MTOK, DM, 256}; pg8::EpiMerge<1> E{(bf16_t*)(ws + WS_MERGED), SG}; pg8::gemm_phase<pg8::EpiMerge<1>, pg8::StaticOrder, GEMM_ALIGN, GEMM_SP2>(lds, g, S, E); }
            { PHASE_ENV(); pg8::StaticOrder S; S.init(MTOK, DM, G, bx); pg8::Gemm g{(const bf16_t*)(ws + WS_OC), (const bf16_t*)(ws + WS_WPC), MTOK, DM, 512}; pg8::EpiMerge<2> E{(bf16_t*)(ws + WS_MERGED), SG}; pg8::gemm_phase<pg8::EpiMerge<2>, pg8::StaticOrder, GEMM_ALIGN, GEMM_SP2>(lds, g, S, E); }
        }
        GRID_BAR();
        PH(7) for (int rep_ = 0; rep_ < 1 + ((((REPEAT_MASK) >> 7) & 1) && l == 0); ++rep_) { PHASE_ENV();
            pg8::Gemm g{(const bf16_t*)(ws + WS_MERGED), (const bf16_t*)(ws + WS_WO), MTOK, DM, DM}; pg8::StaticOrder S; S.init(MTOK, DM, G, bx);
            pg8::EpiResid E{l == 0 ? args.in[I_X] : args.out, args.out};
            pg8::gemm_phase<pg8::EpiResid, pg8::StaticOrder, GEMM_ALIGN, GEMM_SP2>(lds, g, S, E);
        }
        GRID_BAR();
        PH(8) REP(8) { PHASE_ENV(); m1_phase(args, ws, l + 2 * rep_, lds, lane, wave, vcu, G); }
        GRID_BAR();
        { PHASE_ENV(); moe_tables(ctl + CW_CNT + 2048 * (l + 2 * (((REPEAT_MASK) >> 8) & 1)), (const int*)(ws + WS_TOKL), (const float*)(ws + WS_RSTD), lds, tid, vcu, G); }
        PH(10) REP(10) { PHASE_ENV();
            const int nblk = *(const LAS int*)(lds + LX_NBLK);
            pg8::Gemm g{(const bf16_t*)(ws + WS_XG), (const bf16_t*)(ws + WS_WGU), MTOK, NEXP * 1024, DM};
            pg8::MoeOrder S{nblk * 4, G, vcu, (const LAS int*)(lds + LX_BLK2E)};
            pg8::EpiGateUp E{(bf16_t*)(ws + WS_HID), (const LAS float*)(lds + LX_RST), G / 4}; pg8::AMapMoe AM{(const LAS int*)(lds + LX_TOK), G / 4};
            pg8::gemm_phase<pg8::EpiGateUp, pg8::MoeOrder, GEMM_ALIGN, GEMM_SP2, pg8::AMapMoe>(lds, g, S, E, AM);
        }
        GRID_BAR();
        PH(11) REP(11) { PHASE_ENV();
            const int nblk = *(const LAS int*)(lds + LX_NBLK);
            pg8::Gemm g{(const bf16_t*)(ws + WS_HID), (const bf16_t*)(ws + WS_WD), MAXBLK * 256, NEXP * 1024, DEXP};
            pg8::MoeOrder S{nblk * 4, G, vcu, (const LAS int*)(lds + LX_BLK2E)};
            pg8::EpiDown E{(bf16_t*)(ws + WS_Y)};
            pg8::gemm_phase<pg8::EpiDown, pg8::MoeOrder, GEMM_ALIGN, GEMM_SP2>(lds, g, S, E);
        }
        GRID_BAR();
    }

__global__ void __launch_bounds__(512, 2) fwd_kernel(Args args) {
    extern __shared__ __attribute__((aligned(16))) unsigned char lds_raw[];
    LAS unsigned char* lds = (LAS unsigned char*)lds_raw;
    for (int u = threadIdx.x; u < (LDS_BYTES - LDSX) / 4; u += 512) ((LAS unsigned*)(lds + LDSX))[u] = 0u;
    __syncthreads();
    const XcdBarrier bar0 = xcd_barrier_post((unsigned*)(args.ws + WS_CTL) + CW_BAR, (volatile LAS unsigned*)(lds + LX_BAR));
    layer_body<0>(args, lds, bar0);
    layer_body<1>(args, lds, bar0);
    { PHASE_ENV();
        const int gw = vcu * 8 + wave, NGW = G * 8; const LAS int* pstart = (const LAS int*)(lds + LX_PSTART);
        for (int m = gw; m < MTOK; m += NGW) token_row<true, false>(args.out, args.out, (const bf16_t*)(ws + WS_Y), (const unsigned*)(ws + WS_RT0), (const unsigned*)(ws + WS_RT1), (const f32x2*)(ws + WS_RTW), pstart, nullptr, nullptr, m, lane);
    }
}

extern "C" void kernel_launch(void* const* d_in, const int* in_sizes, int n_in, void* d_out, int out_size, void* d_ws, size_t ws_size, hipStream_t stream) {
    static int grid = 0;
    if (grid == 0) {
        if (n_in != N_INPUTS || in_sizes[0] != MTOK * DM || out_size != MTOK * DM || ws_size < WS_END) {
            fprintf(stderr, "kernel_launch: built for %d inputs, x/out of %d floats, >= %zu bytes of workspace; got n_in %d, in0 %d, out %d, ws %zu; nothing launched\n", (int)N_INPUTS, MTOK * DM, (size_t)WS_END, n_in, n_in > 0 ? in_sizes[0] : -1, out_size, ws_size);
            grid = -1; return; }
        int dev = 0, cus = 0;
        if (hipGetDevice(&dev) != hipSuccess || hipDeviceGetAttribute(&cus, hipDeviceAttributeMultiprocessorCount, dev) != hipSuccess) { fprintf(stderr, "kernel_launch: device query failed\n"); grid = -1; return; }
        if (hipFuncSetAttribute((const void*)fwd_kernel, hipFuncAttributeMaxDynamicSharedMemorySize, LDS_BYTES) != hipSuccess) { fprintf(stderr, "kernel_launch: hipFuncSetAttribute failed\n"); grid = -1; return; }
        int per_cu = 0;
        if (hipOccupancyMaxActiveBlocksPerMultiprocessor(&per_cu, (const void*)fwd_kernel, 512, LDS_BYTES) != hipSuccess || per_cu < 1) fprintf(stderr, "kernel_launch: note: occupancy query reports %d workgroups per CU\n", per_cu);
        (void)hipGetLastError();
        grid = cus;
    }
    if (grid < 0) return;
    if (hipMemsetAsync((char*)d_ws + WS_CTL, 0, CTL_BYTES, stream) != hipSuccess) { fprintf(stderr, "kernel_launch: memset failed\n"); return; }
    Args a{};
    for (int i = 0; i < N_INPUTS; ++i) a.in[i] = (const float*)d_in[i];
    a.out = (float*)d_out; a.ws = (unsigned char*)d_ws;
    hipLaunchKernelGGL(fwd_kernel, dim3(grid), dim3(512), LDS_BYTES, stream, a);
    const hipError_t le = hipPeekAtLastError();
    if (le != hipSuccess) fprintf(stderr, "kernel_launch: launch failed: %s\n", hipGetErrorName(le));
}
```

```cpp
#include <hip/hip_runtime.h>
#include <cstdio>
#include <cstdint>

#define LAS __attribute__((address_space(3)))
#define GAS __attribute__((address_space(1)))
typedef unsigned short bf16_t;
typedef short bf16x8 __attribute__((ext_vector_type(8)));
typedef short s16x4 __attribute__((ext_vector_type(4)));
typedef float f32x4 __attribute__((ext_vector_type(4)));
typedef float f32x2 __attribute__((ext_vector_type(2)));
typedef float f32x16 __attribute__((ext_vector_type(16)));
typedef unsigned u32x4 __attribute__((ext_vector_type(4)));
typedef unsigned u32x2 __attribute__((ext_vector_type(2)));

constexpr int NBATCH = 8, SEQ = 4096, MTOK = NBATCH * SEQ, DM = 1024, NLAYER = 2;
constexpr int QP = 3656;
constexpr int C_QA = 0, C_KA = 256, C_VA = 512, C_QB = 768, C_KB = 1024, C_VB = 1280, C_QI = 1536, C_KI = 2048, C_WI = 2112,
              C_Q1 = 2120, C_Q2 = 2376, C_K1 = 2632, C_K2 = 2888, C_VC = 3144, C_G = 3656, D_IN = 6728;
constexpr int NT_IN = 27;
constexpr int NEXP = 32, DEXP = 512, MAXBLK = 288;
constexpr float C2 = 0.125f * 1.4426950408889634f;
constexpr float EPS = 1e-6f;
#ifndef REF0_ENABLE
#define REF0_ENABLE 1
#endif

constexpr size_t MiB = 1u << 20;
constexpr size_t WS_CTL = 0, CTL_BYTES = 1 * MiB;
constexpr size_t WS_COS = 1 * MiB, WS_SIN = WS_COS + 512 * 1024;
constexpr size_t WS_SMALL = 2 * MiB;
constexpr size_t WS_RSTD1 = WS_SMALL + 128 * 1024;
constexpr size_t WS_KMEAN = WS_SMALL, WS_RT0 = WS_SMALL + 256 * 1024, WS_RT1 = WS_SMALL + 384 * 1024, WS_RTW = WS_SMALL + 512 * 1024, WS_WRT = WS_SMALL + 768 * 1024;
constexpr size_t WS_WIN = 3 * MiB;
constexpr size_t WS_WPA = 17 * MiB, WS_WPB = WS_WPA + 512 * 1024, WS_WPC = 18 * MiB;
constexpr size_t WS_WO = 19 * MiB;
constexpr size_t WS_WGU = 21 * MiB;
constexpr size_t WS_WD = 85 * MiB;
constexpr size_t WS_X16 = 117 * MiB;
constexpr size_t OUT_OA = 0, OUT_OB = 16 * MiB, OUT_OC = 32 * MiB, OUT_SCR = 64 * MiB;
constexpr size_t WS_QKV = 181 * MiB;
constexpr size_t WS_MERGED = WS_QKV, WS_Y = WS_QKV, WS_HID = WS_QKV + 144 * MiB;
constexpr size_t WS_TOKL = WS_QKV + 64 * MiB, WS_RSTD = WS_QKV + 68 * MiB;
constexpr size_t WS_SG = 410 * MiB;
constexpr size_t WS_MASK = 506 * MiB;
constexpr size_t WS_END = 522 * MiB;
static_assert((size_t)MTOK * QP * 2 <= 229 * MiB && (size_t)MAXBLK * 256 * 1024 * 2 <= 144 * MiB && (size_t)MAXBLK * 256 * 512 * 2 <= 72 * MiB, "ws map");
constexpr int CW_BAR = 4096;
constexpr int CW_QUEUE = 8192;
constexpr int CW_CNT = 16384;

constexpr int LDSX = 131072;
constexpr int LX_BAR = LDSX, LX_BC = LDSX + 16, LX_NBLK = LDSX + 32, LX_PSTART = LDSX + 64, LX_BLK2E = LDSX + 256, LX_CNT = LDSX + 1536, LX_TOK = LDSX + 2048, LX_RST = LDSX + 2048 + 6144;
constexpr int LDS_BYTES = 147456;

typedef __bf16 bf16x2_t __attribute__((ext_vector_type(2)));
__device__ __forceinline__ unsigned cvt_pk_bf16(float lo, float hi) { const f32x2 v = {lo, hi}; const bf16x2_t b = __builtin_convertvector(v, bf16x2_t); return __builtin_bit_cast(unsigned, b); }
typedef _Float16 f16x2_t __attribute__((ext_vector_type(2)));
__device__ __forceinline__ unsigned cvt_pk_f16(float lo, float hi) { const f32x2 v = {__builtin_amdgcn_fmed3f(lo, -65504.f, 65504.f), __builtin_amdgcn_fmed3f(hi, -65504.f, 65504.f)}; return __builtin_bit_cast(unsigned, __builtin_convertvector(v, f16x2_t)); }
__device__ __forceinline__ float h_lo(unsigned w) { return (float)__builtin_bit_cast(f16x2_t, w)[0]; }
__device__ __forceinline__ float h_hi(unsigned w) { return (float)__builtin_bit_cast(f16x2_t, w)[1]; }
__device__ __forceinline__ float bf_lo(unsigned w) { return __builtin_bit_cast(float, w << 16); }
__device__ __forceinline__ float bf_hi(unsigned w) { return __builtin_bit_cast(float, w & 0xffff0000u); }
template <int M> __device__ __forceinline__ float xor_lane(float v) {
    return __builtin_bit_cast(float, __builtin_amdgcn_ds_swizzle(__builtin_bit_cast(int, v), (M << 10) | 0x1f)); }
__device__ __forceinline__ float sum_xor32(float v) {
    const unsigned u = __builtin_bit_cast(unsigned, v); const auto rr = __builtin_amdgcn_permlane32_swap(u, u, false, false);
    return __builtin_bit_cast(float, (unsigned)rr[0]) + __builtin_bit_cast(float, (unsigned)rr[1]); }
__device__ __forceinline__ float max_xor32(float v) {
    const unsigned u = __builtin_bit_cast(unsigned, v); const auto rr = __builtin_amdgcn_permlane32_swap(u, u, false, false);
    return fmaxf(__builtin_bit_cast(float, (unsigned)rr[0]), __builtin_bit_cast(float, (unsigned)rr[1])); }
__device__ __forceinline__ int lane_val(int v, int src_lane) { return __builtin_amdgcn_ds_bpermute(src_lane << 2, v); }
__device__ __forceinline__ float wave_sum(float v) {
    v += xor_lane<1>(v); v += xor_lane<2>(v); v += xor_lane<4>(v); v += xor_lane<8>(v); v += xor_lane<16>(v);
    return sum_xor32(v);
}
__device__ __forceinline__ float fast_exp2(float x) { return __builtin_amdgcn_exp2f(x); }
__device__ __forceinline__ float fast_rcp(float x) { return __builtin_amdgcn_rcpf(x); }

namespace pg8 {
#define PG8_LAS __attribute__((address_space(3)))
typedef unsigned short bf16_t;
typedef short bf16x8 __attribute__((ext_vector_type(8)));
typedef float f32x4 __attribute__((ext_vector_type(4)));
typedef unsigned u32x4 __attribute__((ext_vector_type(4)));
constexpr int BM = 256, BK = 64, HALF = 128, HTB = HALF * BK * 2  , STAGE_BYTES = 8 * HTB, NXCD = 8, WGM = 8;

__host__ __device__ __forceinline__ int lds_byte(int r, int c) { const int st = (r >> 4) * 2 + (c >> 5), rr = r & 15, cc = c & 31, ob = rr * 64 + cc * 2; return st * 1024 + (ob ^ (((ob >> 9) & 1) << 5)); }
__host__ __device__ __forceinline__ void stage_rc(int b, int& R, int& C) { const int st = b / 1024, sb = b % 1024, swz = sb ^ (((sb >> 9) & 1) << 5); R = (st >> 1) * 16 + swz / 64; C = (st & 1) * 32 + (swz % 64) / 2; }
__host__ __device__ __forceinline__ int perm32(int rho) { const int n = rho >> 4, i = rho & 15; return 8 * (i >> 2) + 4 * n + (i & 3); }
struct Unit { int pm, pn; };
struct Gemm { const bf16_t* A; const bf16_t* Bt; int M, N, K; };

struct StaticOrder {
    int nM, nN, nwg, G, c;
    __host__ __device__ void init(int M, int N, int G_, int c_) { nM = M / BM; nN = N / BM; nwg = nM * nN; G = G_; c = c_; }
    __host__ __device__ bool next(int i, Unit& u) const {
        const long L = (long)i * G + c; if (L >= nwg) return false;
        int wgid = (int)L; { const int q = nwg / NXCD, r = nwg % NXCD, xcd = wgid % NXCD, off = wgid / NXCD; wgid = (xcd < r ? xcd * (q + 1) : r * (q + 1) + (xcd - r) * q) + off; }
        const int nig = WGM * nN, gid = wgid / nig, fm = gid * WGM, gsz = (nM - fm) < WGM ? (nM - fm) : WGM;
        u.pm = fm + ((wgid % nig) % gsz); u.pn = (wgid % nig) / gsz; return true;
    }
    __device__ __forceinline__ void a_ready(const Unit&) const {}
    __device__ __forceinline__ void done(const Unit&) const {}
};


struct EpiInProj {
    static constexpr bool PERM = false, AFTER_DRAIN = false, F16 = true;
    bf16_t* qkv; unsigned char* sg; const float* cosT; const float* sinT; const float* qkg; const float* ikg; const float* rstd;
    __device__ __forceinline__ void operator()(const f32x4 (&acc)[2][2][4][2], const Unit& u, int wr, int wc, int fr, int fq) const {
        const int pn = u.pn, row0 = u.pm * BM + wr * 64 + fr;
        if (pn >= 15) {
            unsigned char* base = sg + (size_t)row0 * 3072 + (pn - 15) * 256 + wc * 64 + fq * 16;
#pragma unroll
            for (int ai = 0; ai < 2; ++ai)
#pragma unroll
                for (int m = 0; m < 4; ++m) {
                    unsigned w[2][2]; const float rs = -1.4426950408889634f * rstd[row0 + ai * HALF + m * 16];
#pragma unroll
                    for (int bj = 0; bj < 2; ++bj)
#pragma unroll
                        for (int n = 0; n < 2; ++n) { unsigned pk = 0;
#pragma unroll
                            for (int i = 0; i < 4; i += 2) { const float x0 = fminf(fmaxf(acc[ai][bj][m][n][i] * rs, -43.f), 43.f), x1 = fminf(fmaxf(acc[ai][bj][m][n][i + 1] * rs, -43.f), 43.f);
                                const float a = 1.0f + fast_exp2(x0), b = 1.0f + fast_exp2(x1), r = 255.0f * fast_rcp(a * b);
                                pk = __builtin_amdgcn_cvt_pk_u8_f32(floorf(b * r + 0.5f), i, pk); pk = __builtin_amdgcn_cvt_pk_u8_f32(floorf(a * r + 0.5f), i + 1, pk); }
                            w[bj][n] = pk; }
                    *(u32x4*)(base + (size_t)(ai * HALF + m * 16) * 3072) = (u32x4){w[0][0], w[0][1], w[1][0], w[1][1]};
                }
            return;
        }
        int type = 0, gi = 0; bool qscale = false;
        int ocol = (pn < 8 ? 256 * pn : C_Q1 + 256 * (pn - 9)) + 64 * wc;
        switch (pn) {
            case 0: type = 2; gi = 0; qscale = true; break;
            case 1: type = 2; gi = 1; break;
            case 3: type = 2; gi = 2; qscale = true; break;
            case 4: type = 2; gi = 3; break;
            case 6: case 7: type = 1; break;
            case 8: if (wc == 0) { type = 2; ocol = C_KI; } else if (wc == 1) { type = 3; ocol = C_WI; } else type = 4; break;
            case 9: case 10: type = 2; gi = 4; qscale = true; break;
            case 11: case 12: type = 2; gi = 5; break;
            default: type = 0; break;
        }
        if (type == 4) return;
        if (type == 3) {
            if (fq == 0) {
#pragma unroll
                for (int ai = 0; ai < 2; ++ai)
#pragma unroll
                    for (int m = 0; m < 4; ++m) { const float rs = 0.35355339059327373f * rstd[row0 + ai * HALF + m * 16]; const f32x4 a = acc[ai][0][m][0] * rs, b = acc[ai][0][m][1] * rs;
                        *(u32x4*)(qkv + (size_t)(row0 + ai * HALF + m * 16) * QP + C_WI) = (u32x4){cvt_pk_bf16(a[0], a[1]), cvt_pk_bf16(a[2], a[3]), cvt_pk_bf16(b[0], b[1]), cvt_pk_bf16(b[2], b[3])}; }
            }
            return;
        }
        const float* gp = (pn == 8) ? ikg : qkg + 64 * gi;
        if (type == 2) { if (qscale) body<2, true>(acc, row0, ocol, gp, fq); else body<2, false>(acc, row0, ocol, gp, fq); }
        else if (type == 1) body<1, false>(acc, row0, ocol, gp, fq);
        else body<0, false>(acc, row0, ocol, gp, fq);
    }
    template <int TYPE, bool QS>
    __device__ __forceinline__ void body(const f32x4 (&acc)[2][2][4][2], int row0, int ocol, const float* gp, int fq) const {
#pragma unroll
        for (int ai = 0; ai < 2; ++ai)
#pragma unroll
            for (int m = 0; m < 4; ++m) {
                const int row = row0 + ai * HALF + m * 16; const float rs = rstd[row];
                f32x4 x[2][2];
#pragma unroll
                for (int bj = 0; bj < 2; ++bj)
#pragma unroll
                    for (int n = 0; n < 2; ++n) x[bj][n] = acc[ai][bj][m][n] * rs;
                if (TYPE == 2) {
                    float ss = 0.f;
#pragma unroll
                    for (int bj = 0; bj < 2; ++bj)
#pragma unroll
                        for (int n = 0; n < 2; ++n) ss += (x[bj][n][0] * x[bj][n][0] + x[bj][n][1] * x[bj][n][1]) + (x[bj][n][2] * x[bj][n][2] + x[bj][n][3] * x[bj][n][3]);
                    ss += xor_lane<16>(ss); ss = sum_xor32(ss);
                    const float inv = (QS ? C2 : 1.0f) / sqrtf(ss * (1.0f / 64.0f) + EPS);
#pragma unroll
                    for (int bj = 0; bj < 2; ++bj)
#pragma unroll
                        for (int n = 0; n < 2; ++n) x[bj][n] = x[bj][n] * inv * *(const f32x4*)(gp + 32 * bj + 8 * fq + 4 * n);
                }
                if (TYPE >= 1) {
                    const int pos = row & (SEQ - 1);
#pragma unroll
                    for (int n = 0; n < 2; ++n) {
                        const f32x4 c = *(const f32x4*)(cosT + pos * 32 + 8 * fq + 4 * n), s = *(const f32x4*)(sinT + pos * 32 + 8 * fq + 4 * n);
                        const f32x4 a = x[0][n], b = x[1][n];
                        x[0][n] = a * c - b * s; x[1][n] = b * c + a * s;
                    }
                }
#pragma unroll
                for (int bj = 0; bj < 2; ++bj)
                    *(u32x4*)(qkv + (size_t)row * QP + ocol + 32 * bj + 8 * fq) = (u32x4){cvt_pk_bf16(x[bj][0][0], x[bj][0][1]), cvt_pk_bf16(x[bj][0][2], x[bj][0][3]), cvt_pk_bf16(x[bj][1][0], x[bj][1][1]), cvt_pk_bf16(x[bj][1][2], x[bj][1][3])};
                asm volatile("" ::: "memory");
            }
    }
};

template <int BR> struct EpiMerge {
    static constexpr bool PERM = false, AFTER_DRAIN = false, F16 = false;
    bf16_t* merged; const unsigned char* sg;
    __device__ __forceinline__ void operator()(const f32x4 (&acc)[2][2][4][2], const Unit& u, int wr, int wc, int fr, int fq) const {
        const int row0 = u.pm * BM + wr * 64 + fr, col0 = u.pn * BM + wc * 64 + fq * 16;
#pragma unroll
        for (int ai = 0; ai < 2; ++ai)
#pragma unroll
            for (int m = 0; m < 4; ++m) { const size_t row = (size_t)(row0 + ai * HALF + m * 16);
                const u32x4 gq = *(const u32x4*)(sg + row * 3072 + BR * 1024 + col0);
                bf16_t* mp = merged + row * 1024 + col0;
                float v[16];
#pragma unroll
                for (int bj = 0; bj < 2; ++bj)
#pragma unroll
                    for (int n = 0; n < 2; ++n)
#pragma unroll
                        for (int i = 0; i < 4; ++i) v[8 * bj + 4 * n + i] = acc[ai][bj][m][n][i] * ((float)((gq[2 * bj + n] >> (8 * i)) & 255u) * (1.0f / 255.0f));
                if (BR > 0) { const u32x4 o0 = *(const u32x4*)mp, o1 = *(const u32x4*)(mp + 8);
#pragma unroll
                    for (int k = 0; k < 4; ++k) { v[2 * k] += bf_lo(o0[k]); v[2 * k + 1] += bf_hi(o0[k]); v[8 + 2 * k] += bf_lo(o1[k]); v[8 + 2 * k + 1] += bf_hi(o1[k]); } }
                *(u32x4*)mp = (u32x4){cvt_pk_bf16(v[0], v[1]), cvt_pk_bf16(v[2], v[3]), cvt_pk_bf16(v[4], v[5]), cvt_pk_bf16(v[6], v[7])};
                *(u32x4*)(mp + 8) = (u32x4){cvt_pk_bf16(v[8], v[9]), cvt_pk_bf16(v[10], v[11]), cvt_pk_bf16(v[12], v[13]), cvt_pk_bf16(v[14], v[15])};
                asm volatile("" ::: "memory"); }
    }
};

struct EpiResid {
    static constexpr bool PERM = false, AFTER_DRAIN = false, F16 = false;
    unsigned char* x16;
    __device__ __forceinline__ void operator()(const f32x4 (&acc)[2][2][4][2], const Unit& u, int wr, int wc, int fr, int fq) const {
        const int row0 = u.pm * BM + wr * 64 + fr, col0 = u.pn * BM + wc * 32 + fq * 8;
#pragma unroll
        for (int ai = 0; ai < 2; ++ai)
#pragma unroll
            for (int m = 0; m < 4; ++m) { unsigned char* xp = x16 + ((size_t)(row0 + ai * HALF + m * 16) * 1024 + col0) * 2;
#pragma unroll
                for (int bj = 0; bj < 2; ++bj) { const u32x4 r = *(const u32x4*)(xp + bj * HALF * 2); const f32x4 a = acc[ai][bj][m][0], b = acc[ai][bj][m][1];
                    *(u32x4*)(xp + bj * HALF * 2) = (u32x4){cvt_pk_f16(h_lo(r[0]) + a[0], h_hi(r[0]) + a[1]), cvt_pk_f16(h_lo(r[1]) + a[2], h_hi(r[1]) + a[3]), cvt_pk_f16(h_lo(r[2]) + b[0], h_hi(r[2]) + b[1]), cvt_pk_f16(h_lo(r[3]) + b[2], h_hi(r[3]) + b[3])}; }
                if (m & 1) asm volatile("" ::: "memory"); }
    }
};

struct EpiGateUp {
    static constexpr bool PERM = false, AFTER_DRAIN = false, F16 = true;
    bf16_t* hid; const PG8_LAS float* rst; int rbs;
    __device__ __forceinline__ void operator()(const f32x4 (&acc)[2][2][4][2], const Unit& u, int wr, int wc, int fr, int fq) const {
        const int row0 = u.pm * BM + wr * 64 + fr, col0 = (u.pn & 3) * HALF + wc * 32 + fq * 8;
        const PG8_LAS float* rs = rst + (u.pm / rbs) * 256 + wr * 64 + fr;
#pragma unroll
        for (int ai = 0; ai < 2; ++ai)
#pragma unroll
            for (int m = 0; m < 4; ++m) { float v[8]; const float r = rs[ai * HALF + m * 16];
#pragma unroll
                for (int n = 0; n < 2; ++n)
#pragma unroll
                    for (int i = 0; i < 4; ++i) { const float gt = acc[ai][0][m][n][i] * r, up = acc[ai][1][m][n][i] * r; v[4 * n + i] = gt * fast_rcp(1.0f + fast_exp2(-1.4426950408889634f * gt)) * up; }
                *(u32x4*)(hid + (size_t)(row0 + ai * HALF + m * 16) * DEXP + col0) = (u32x4){cvt_pk_bf16(v[0], v[1]), cvt_pk_bf16(v[2], v[3]), cvt_pk_bf16(v[4], v[5]), cvt_pk_bf16(v[6], v[7])}; }
    }
};

struct EpiDown {
    static constexpr bool PERM = false, AFTER_DRAIN = false, F16 = false;
    bf16_t* y;
    __device__ __forceinline__ void operator()(const f32x4 (&acc)[2][2][4][2], const Unit& u, int wr, int wc, int fr, int fq) const {
        const int row0 = u.pm * BM + wr * 64 + fr, col0 = (u.pn & 3) * BM + wc * 64 + fq * 16;
#pragma unroll
        for (int ai = 0; ai < 2; ++ai)
#pragma unroll
            for (int m = 0; m < 4; ++m) { bf16_t* yp = y + (size_t)(row0 + ai * HALF + m * 16) * 1024 + col0;
#pragma unroll
                for (int bj = 0; bj < 2; ++bj) { const f32x4 a = acc[ai][bj][m][0], b = acc[ai][bj][m][1];
                    *(u32x4*)(yp + 8 * bj) = (u32x4){cvt_pk_bf16(a[0], a[1]), cvt_pk_bf16(a[2], a[3]), cvt_pk_bf16(b[0], b[1]), cvt_pk_bf16(b[2], b[3])}; } }
    }
};

struct AMapMoe { static constexpr bool GATHER = true; const PG8_LAS int* tok; int rbs;
    __device__ __forceinline__ unsigned row(const Unit& u, int R) const { return (unsigned)tok[(u.pm / rbs) * 256 + R]; } };
struct MoeOrder {
    int nunits, G, c; const PG8_LAS int* blk2e;
    __device__ __forceinline__ bool next(int i, Unit& u) const { const int L = i * G + c; if (L >= nunits) return false; const int rb = L >> 2; u.pm = rb; u.pn = blk2e[rb] * 4 + (L & 3); return true; }
    __device__ __forceinline__ void a_ready(const Unit&) const {}
    __device__ __forceinline__ void done(const Unit&) const {}
};

typedef _Float16 f16x8 __attribute__((ext_vector_type(8)));
template <bool F16> __device__ __forceinline__ f32x4 mma16x(bf16x8 a, bf16x8 b, f32x4 c) {
    if constexpr (F16) return __builtin_amdgcn_mfma_f32_16x16x32_f16(__builtin_bit_cast(f16x8, a), __builtin_bit_cast(f16x8, b), c, 0, 0, 0);
    else return __builtin_amdgcn_mfma_f32_16x16x32_bf16(a, b, c, 0, 0, 0); }
struct NoAMap { static constexpr bool GATHER = false; __device__ __forceinline__ unsigned row(const Unit&, int) const { return 0u; } };
template <class Epi, class Sched, bool ALIGN_EPI = false, bool SP2 = false, class AMap = NoAMap>
__device__ __forceinline__ void gemm_phase(PG8_LAS unsigned char* lds, const Gemm g, const Sched& S, const Epi& E, const AMap& AM = AMap()) {
    static_assert(!AMap::GATHER || SP2, "the row gather is wired into the SP2 loop only");
#define mma16 mma16x<Epi::F16>
    int tid_l = (int)threadIdx.x; asm volatile("" : "+v"(tid_l));
    const int tid = tid_l, wid = __builtin_amdgcn_readfirstlane(tid >> 6), lane = tid & 63, wr = wid >> 2, wc = wid & 3, fr = lane & 15, fq = lane >> 4;
    const int K = g.K, nt = K / BK;
    unsigned voffA[2], voffB[2];
#pragma unroll
    for (int i = 0; i < 2; ++i) { int R, C; stage_rc(tid * 16 + i * 8192, R, C); const int Rb = Epi::PERM ? ((R & ~31) + perm32(R & 31)) : R;
        voffA[i] = (unsigned)(R * K + C) * 2u; voffB[i] = (unsigned)(Rb * K + C) * 2u; }
    int RA[2], CA[2];
#pragma unroll
    for (int i = 0; i < 2; ++i) stage_rc(tid * 16 + i * 8192, RA[i], CA[i]);
    unsigned vC0[2] = {0u, 0u}, vC1[2] = {0u, 0u}, vN0[2] = {0u, 0u}, vN1[2] = {0u, 0u};
#define PG8_AOFFS(v0, v1, unit) do { if constexpr (AMap::GATHER) { _Pragma("unroll") for (int _i = 0; _i < 2; ++_i) { \
        v0[_i] = (AM.row(unit, RA[_i]) * (unsigned)K + (unsigned)CA[_i]) * 2u; v1[_i] = (AM.row(unit, HALF + RA[_i]) * (unsigned)K + (unsigned)CA[_i]) * 2u; } } } while (0)
#define PG8_STAGE_A(bufoff, base, half, usenext) do { if constexpr (AMap::GATHER) { unsigned vv_[2]; _Pragma("unroll") for (int _j = 0; _j < 2; ++_j) vv_[_j] = (usenext) ? ((half) ? vN1[_j] : vN0[_j]) : ((half) ? vC1[_j] : vC0[_j]); \
        PG8_STAGE(bufoff, base, vv_); } else { PG8_STAGE(bufoff, (base) + (half) * hstep, voffA); } } while (0)
    const size_t kstep = (size_t)(BK * 2);
    const size_t hstep = (size_t)HALF * K * 2;
    const size_t tstep = 2 * hstep;
    const unsigned ldsw = (unsigned)wid * 1024u;
    const int aoff = lds_byte(wr * 64 + fr, fq * 8), boff = lds_byte(wc * 32 + fr, fq * 8);
#define PG8_SA(b, h) (((b) * 2 + (h)) * HTB)
#define PG8_SB(b, h) ((4 + (b) * 2 + (h)) * HTB)
#define PG8_STAGE(bufoff, gbase, voff) do { _Pragma("unroll") for (int _i = 0; _i < 2; ++_i) \
        __builtin_amdgcn_global_load_lds((const unsigned*)((const char*)(gbase) + (voff)[_i]), (PG8_LAS unsigned*)(lds + (bufoff) + ldsw + _i * 8192), 16, 0, 0); } while (0)
#define PG8_LDA(dst, b, h) do { _Pragma("unroll") for (int m = 0; m < 4; ++m) _Pragma("unroll") for (int k = 0; k < 2; ++k) dst[m][k] = *(const PG8_LAS bf16x8*)(lds + PG8_SA(b, h) + aoff + m * 2048 + k * 1024); } while (0)
#define PG8_LDB(dst, b, h) do { _Pragma("unroll") for (int n = 0; n < 2; ++n) _Pragma("unroll") for (int k = 0; k < 2; ++k) dst[n][k] = *(const PG8_LAS bf16x8*)(lds + PG8_SB(b, h) + boff + n * 2048 + k * 1024); } while (0)
#define PG8_MMA(ai, bj, At, Bt) do { __builtin_amdgcn_s_setprio(1); _Pragma("unroll") for (int m = 0; m < 4; ++m) _Pragma("unroll") for (int n = 0; n < 2; ++n) _Pragma("unroll") for (int k = 0; k < 2; ++k) \
        acc[ai][bj][m][n] = mma16(Bt[n][k], At[m][k], acc[ai][bj][m][n]); __builtin_amdgcn_s_setprio(0); } while (0)
#define PG8_WAIT_V(n) asm volatile("s_waitcnt vmcnt(" #n ")" ::: "memory")
#define PG8_WAIT_L(n) asm volatile("s_waitcnt lgkmcnt(" #n ")" ::: "memory")
#define PG8_BAR __builtin_amdgcn_s_barrier()
#define PG8_SCHED __builtin_amdgcn_sched_barrier(0)
    Unit cur, nxt; int ui = 0;
    if (!S.next(0, cur)) return;
    f32x4 acc[2][2][4][2];
#pragma unroll
    for (int a = 0; a < 2; ++a)
#pragma unroll
        for (int b = 0; b < 2; ++b)
#pragma unroll
            for (int m = 0; m < 4; ++m)
#pragma unroll
                for (int n = 0; n < 2; ++n) acc[a][b][m][n] = (f32x4){0.f, 0.f, 0.f, 0.f};
    bf16x8 At[4][2], B0[2][2], B1[2][2];
    const char* cA = (const char*)g.A + (AMap::GATHER ? (size_t)0 : (size_t)cur.pm * tstep); const char* cB = (const char*)g.Bt + (size_t)cur.pn * tstep;
    PG8_AOFFS(vC0, vC1, cur);
    S.a_ready(cur);
    if constexpr (SP2) {
        PG8_STAGE(PG8_SB(0, 0), cB, voffB); PG8_STAGE(PG8_SB(0, 1), cB + hstep, voffB); PG8_STAGE_A(PG8_SA(0, 0), cA, 0, false); PG8_STAGE_A(PG8_SA(0, 1), cA, 1, false);
        if (wr == 1) PG8_BAR;
        PG8_WAIT_V(2); PG8_BAR;
        PG8_STAGE(PG8_SB(1, 0), cB + kstep, voffB); PG8_STAGE_A(PG8_SA(1, 0), cA + kstep, 0, false); PG8_STAGE(PG8_SB(1, 1), cB + hstep + kstep, voffB);
        PG8_WAIT_V(6); PG8_BAR;
    } else {
        PG8_STAGE(PG8_SB(0, 0), cB, voffB); PG8_STAGE(PG8_SA(0, 0), cA, voffA); PG8_STAGE(PG8_SB(0, 1), cB + hstep, voffB); PG8_STAGE(PG8_SA(0, 1), cA + hstep, voffA);
        if (wr == 1) PG8_BAR;
        PG8_WAIT_V(4); PG8_BAR;
        PG8_STAGE(PG8_SB(1, 0), cB + kstep, voffB); PG8_STAGE(PG8_SA(1, 0), cA + kstep, voffA); PG8_STAGE(PG8_SB(1, 1), cB + hstep + kstep, voffB);
        PG8_WAIT_V(6); PG8_BAR;
    }
    for (;;) {
        const bool has_next = S.next(ui + 1, nxt);
        const char* nA = (has_next && !AMap::GATHER) ? (const char*)g.A + (size_t)nxt.pm * tstep : cA; const char* nB = has_next ? (const char*)g.Bt + (size_t)nxt.pn * tstep : cB;
        if constexpr (AMap::GATHER) { if (has_next) PG8_AOFFS(vN0, vN1, nxt); else { vN0[0] = vC0[0]; vN0[1] = vC0[1]; vN1[0] = vC1[0]; vN1[1] = vC1[1]; } }
#pragma unroll 1
        for (int t = 0; t < nt; t += 2) {
            const bool last = (t == nt - 2);
            const char* a1 = cA + (size_t)(t + 1) * kstep;
            const char* a2 = last ? nA : cA + (size_t)(t + 2) * kstep; const char* b2 = last ? nB : cB + (size_t)(t + 2) * kstep;
            const char* a3 = a2 + kstep; const char* b3 = b2 + kstep;
            if (last && has_next) S.a_ready(nxt);
            if constexpr (SP2) {
            PG8_LDB(B0, 0, 0); PG8_LDB(B1, 0, 1); PG8_SCHED; PG8_LDA(At, 0, 0); PG8_STAGE_A(PG8_SA(1, 1), a1, 1, false);
            PG8_WAIT_V(8); PG8_WAIT_L(0); PG8_BAR; PG8_MMA(0, 0, At, B0); PG8_MMA(0, 1, At, B1); PG8_BAR; PG8_SCHED;
            PG8_LDA(At, 0, 1); PG8_STAGE(PG8_SB(0, 0), b2, voffB); PG8_STAGE(PG8_SB(0, 1), b2 + hstep, voffB); PG8_STAGE_A(PG8_SA(0, 0), a2, 0, last);
            PG8_WAIT_V(8); PG8_WAIT_L(0); PG8_BAR; PG8_MMA(1, 0, At, B0); PG8_MMA(1, 1, At, B1); PG8_BAR; PG8_SCHED;
            PG8_LDB(B0, 1, 0); PG8_LDB(B1, 1, 1); PG8_SCHED; PG8_LDA(At, 1, 0); PG8_STAGE_A(PG8_SA(0, 1), a2, 1, last);
            PG8_WAIT_V(8); PG8_WAIT_L(0); PG8_BAR; PG8_MMA(0, 0, At, B0); PG8_MMA(0, 1, At, B1); PG8_BAR; PG8_SCHED;
            PG8_LDA(At, 1, 1); PG8_STAGE(PG8_SB(1, 0), b3, voffB); PG8_STAGE(PG8_SB(1, 1), b3 + hstep, voffB); PG8_STAGE_A(PG8_SA(1, 0), a3, 0, last);
            PG8_WAIT_V(8); PG8_WAIT_L(0); PG8_BAR; PG8_MMA(1, 0, At, B0); PG8_MMA(1, 1, At, B1); PG8_BAR; PG8_SCHED;
            } else {
            PG8_LDB(B0, 0, 0); PG8_SCHED; PG8_LDA(At, 0, 0); PG8_STAGE(PG8_SA(1, 1), a1 + hstep, voffA);
            PG8_WAIT_L(8); PG8_BAR; PG8_WAIT_L(0); PG8_MMA(0, 0, At, B0); PG8_BAR; PG8_SCHED;
            PG8_LDB(B1, 0, 1); PG8_STAGE(PG8_SB(0, 0), b2, voffB);
            PG8_BAR; PG8_WAIT_L(0); PG8_MMA(0, 1, At, B1); PG8_BAR;
            PG8_LDA(At, 0, 1); PG8_STAGE(PG8_SA(0, 0), a2, voffA);
            PG8_BAR; PG8_WAIT_L(0); PG8_MMA(1, 0, At, B0); PG8_BAR; PG8_SCHED;
            PG8_STAGE(PG8_SB(0, 1), b2 + hstep, voffB);
            PG8_WAIT_V(6); PG8_BAR; PG8_MMA(1, 1, At, B1); PG8_BAR;
            PG8_LDB(B0, 1, 0); PG8_SCHED; PG8_LDA(At, 1, 0); PG8_STAGE(PG8_SA(0, 1), a2 + hstep, voffA);
            PG8_WAIT_L(8); PG8_BAR; PG8_WAIT_L(0); PG8_MMA(0, 0, At, B0); PG8_BAR; PG8_SCHED;
            PG8_LDB(B1, 1, 1); PG8_STAGE(PG8_SB(1, 0), b3, voffB);
            PG8_BAR; PG8_WAIT_L(0); PG8_MMA(0, 1, At, B1); PG8_BAR;
            PG8_LDA(At, 1, 1); PG8_STAGE(PG8_SA(1, 0), a3, voffA);
            PG8_BAR; PG8_WAIT_L(0); PG8_MMA(1, 0, At, B0); PG8_BAR; PG8_SCHED;
            PG8_STAGE(PG8_SB(1, 1), b3 + hstep, voffB);
            PG8_WAIT_V(6); PG8_BAR; PG8_MMA(1, 1, At, B1); PG8_BAR;
            }
        }
        if constexpr (ALIGN_EPI) { if (wr == 0) PG8_BAR; }
        if constexpr (!Epi::AFTER_DRAIN) { E(acc, cur, wr, wc, fr, fq); S.done(cur); }
        if (!has_next) break;
#pragma unroll
        for (int a = 0; a < 2; ++a)
#pragma unroll
            for (int b = 0; b < 2; ++b)
#pragma unroll
                for (int m = 0; m < 4; ++m)
#pragma unroll
                    for (int n = 0; n < 2; ++n) acc[a][b][m][n] = (f32x4){0.f, 0.f, 0.f, 0.f};
        cur = nxt; cA = nA; cB = nB; ++ui;
        if constexpr (AMap::GATHER) { vC0[0] = vN0[0]; vC0[1] = vN0[1]; vC1[0] = vN1[0]; vC1[1] = vN1[1]; }
        if constexpr (ALIGN_EPI) { if (wr == 1) PG8_BAR; }
    }
    PG8_WAIT_V(0);
    if constexpr (!ALIGN_EPI) { if (wr == 0) PG8_BAR; }
    PG8_BAR;
    if constexpr (Epi::AFTER_DRAIN) { E.fused(acc, cur, wr, wc, fr, fq, lds, wid, lane); S.done(cur); }
#undef mma16
#undef PG8_SA
#undef PG8_AOFFS
#undef PG8_STAGE_A
#undef PG8_SB
#undef PG8_STAGE
#undef PG8_LDA
#undef PG8_LDB
#undef PG8_MMA
#undef PG8_WAIT_V
#undef PG8_WAIT_L
#undef PG8_BAR
#undef PG8_SCHED
}
}
#define XB_TMO      128
#define XB_XCNT(j)  (256  + 64 * (j))
#define XB_XSUB(j)  (1280 + 64 * (j))
#define XB_XGEN(j)  (2304 + 64 * (j))
#define XB_TOP      3328
#define XB_TOPGEN   3392
#define XCD_BAR_WORDS 3456
#define XB_SPIN_CAP (1u << 21)

__device__ __forceinline__ unsigned xb_ld(unsigned* p)              { return __hip_atomic_load(p, __ATOMIC_RELAXED, __HIP_MEMORY_SCOPE_AGENT); }
__device__ __forceinline__ unsigned xb_add(unsigned* p, unsigned v) { return __hip_atomic_fetch_add(p, v, __ATOMIC_RELAXED, __HIP_MEMORY_SCOPE_AGENT); }
__device__ __forceinline__ unsigned xb_xcc_id() { return (unsigned)__builtin_amdgcn_s_getreg((3 << 11) | 20) & 0xFu; }
#define XB_SPIN(cond, bar) do { unsigned _sp = 0; while (cond) { __builtin_amdgcn_s_sleep(1); \
    if ((++_sp & 255u) == 0u) { if (xb_ld(&(bar)[XB_TMO])) break; if (_sp > XB_SPIN_CAP) { atomicAdd(&(bar)[XB_TMO], 1u); break; } } } } while (0)

struct XcdBarrier {
    unsigned* bar; unsigned x;
    volatile LAS unsigned* st;
};

__device__ __forceinline__ XcdBarrier xcd_barrier_post(unsigned* bar, volatile LAS unsigned* st) {
    XcdBarrier b; b.bar = bar; b.x = xb_xcc_id(); b.st = st;
    if (threadIdx.x == 0) (void)xb_add(&bar[XB_XCNT(b.x)], 1u);
    return b;
}
__device__ __forceinline__ void xcd_barrier_complete(unsigned* bar, unsigned x, unsigned& nloc, unsigned& nx) {
    const unsigned G = gridDim.x * gridDim.y * gridDim.z;
    unsigned sum, cnt, mine, sp = 0u;
    for (;;) {
        sum = 0u; cnt = 0u; mine = 0u;
#pragma unroll
        for (unsigned j = 0; j < 16; ++j) { const unsigned c = xb_ld(&bar[XB_XCNT(j)]); sum += c; cnt += (c > 0u) ? 1u : 0u; mine = (j == x) ? c : mine; }
        if (sum == G) break;
        __builtin_amdgcn_s_sleep(1);
        if ((++sp & 255u) == 0u) { if (xb_ld(&bar[XB_TMO])) break; if (sp > XB_SPIN_CAP) { atomicAdd(&bar[XB_TMO], 1u); break; } }
    }
    nloc = mine > 0u ? mine : 1u; nx = cnt > 0u ? cnt : 1u;
}

__device__ __forceinline__ void xcd_barrier(const XcdBarrier& b) {
    asm volatile("s_waitcnt vmcnt(0)" ::: "memory");
    __syncthreads();
    int tid_l = (int)threadIdx.x; asm volatile("" : "+v"(tid_l));
    if (tid_l == 0) {
        unsigned* bar = b.bar;
        __builtin_amdgcn_s_waitcnt(0);
        unsigned nloc = b.st[0], nx = b.st[1];
        if (nloc == 0u) { xcd_barrier_complete(bar, b.x, nloc, nx); b.st[0] = nloc; b.st[1] = nx; }
        const unsigned old = xb_add(&bar[XB_XSUB(b.x)], 1u);
        const unsigned gen = old / nloc;
        if (old + 1u == (gen + 1u) * nloc) {
            __builtin_amdgcn_fence(__ATOMIC_RELEASE, "agent");
            asm volatile("s_waitcnt vmcnt(0)" ::: "memory");
            const unsigned og = xb_add(&bar[XB_TOP], 1u);
            const unsigned tg = og / nx;
            if (og + 1u == (tg + 1u) * nx) xb_add(&bar[XB_TOPGEN], 1u);
            else XB_SPIN(xb_ld(&bar[XB_TOPGEN]) == tg, bar);
            __builtin_amdgcn_fence(__ATOMIC_ACQUIRE, "agent");
            xb_add(&bar[XB_XGEN(b.x)], 1u);
            asm volatile("s_waitcnt vmcnt(0)" ::: "memory");
        } else {
            XB_SPIN(xb_ld(&bar[XB_XGEN(b.x)]) == gen, bar);
            __builtin_amdgcn_fence(__ATOMIC_ACQUIRE, "agent");
            asm volatile("s_waitcnt vmcnt(0)" ::: "memory");
        }
    }
    __syncthreads();
}

enum { I_X = 0, I_NORM_ATTN, I_W_IN, I_QK_GAIN, I_IDX_K_GAIN, I_DIFF_LAMBDA, I_DIFF_SUBLN, I_W_PROJ_A, I_W_PROJ_B, I_W_PROJ_C, I_W_OUT, I_NORM_FFN, I_W_GROUP, I_B_GROUP, I_W_ROUTER, I_B_ROUTER,
       I_W_E_GATE, I_W_E_UP, I_W_E_DOWN, N_INPUTS };
struct Args { const float* in[N_INPUTS]; float* out; unsigned char* ws; };

#define LDS_WAIT() asm volatile("s_waitcnt lgkmcnt(0)" ::: "memory")

__device__ __forceinline__ int perm16col(int s) { return 64 * ((s >> 5) & 3) + 16 * ((s >> 2) & 3) + 8 * (s >> 7) + 4 * ((s >> 4) & 1) + (s & 3); }
__device__ __forceinline__ int inproj_src_col(int d) {
    const int pn = d >> 8, s = d & 255;
    if (pn >= 15) return C_G + 256 * (pn - 15) + perm16col(s);
    const int u = (s >> 5) & 3, e = 32 * (s >> 7) + pg8::perm32(s & 31);
    if (pn < 8) return 256 * pn + 64 * u + e;
    if (pn == 8) { if (u == 0) return C_KI + e; if (u == 1) return e < 8 ? C_WI + e : -1; return -1; }
    return C_Q1 + 256 * (pn - 9) + 64 * u + e;
}
template <bool F16>
__device__ __forceinline__ void transpose_item(const float* W, int ldw, int K, bf16_t* WT, int drow0, int k0, int srccol, LAS float* scr, int lane, const float* kscale = nullptr) {
    const float* src = W + (size_t)k0 * ldw + (srccol >= 0 ? srccol : 0);
#pragma unroll 8
    for (int i = 0; i < 32; ++i) { const int kk = 2 * i + (lane >> 5); const float v = src[(size_t)kk * ldw]; scr[kk * 33 + (lane & 31)] = srccol >= 0 ? v : 0.f; }
    LDS_WAIT(); asm volatile("" ::: "memory");
    const int c = lane & 7;
    f32x4 g0 = {1.f, 1.f, 1.f, 1.f}, g1 = g0;
    if (F16) { g0 = *(const f32x4*)(kscale + k0 + 8 * c); g1 = *(const f32x4*)(kscale + k0 + 8 * c + 4); }
#pragma unroll
    for (int j = 0; j < 4; ++j) { const int n = (lane >> 3) + 8 * j; const LAS float* s = scr + (8 * c) * 33 + n;
        u32x4 o;
        if (F16) { o.x = cvt_pk_f16(s[0 * 33] * g0[0], s[1 * 33] * g0[1]); o.y = cvt_pk_f16(s[2 * 33] * g0[2], s[3 * 33] * g0[3]); o.z = cvt_pk_f16(s[4 * 33] * g1[0], s[5 * 33] * g1[1]); o.w = cvt_pk_f16(s[6 * 33] * g1[2], s[7 * 33] * g1[3]); }
        else { o.x = cvt_pk_bf16(s[0 * 33], s[1 * 33]); o.y = cvt_pk_bf16(s[2 * 33], s[3 * 33]); o.z = cvt_pk_bf16(s[4 * 33], s[5 * 33]); o.w = cvt_pk_bf16(s[6 * 33], s[7 * 33]); }
        *(u32x4*)(WT + (size_t)(drow0 + n) * K + k0 + 8 * c) = o; }
    LDS_WAIT(); asm volatile("" ::: "memory");
}

template <bool FIRST, bool COMBINE, bool FINAL>
__device__ __forceinline__ void token_row(const float* xin, unsigned char* x16, float* outf, const bf16_t* y, const unsigned* rt0, const unsigned* rt1, const f32x2* rtw, const LAS int* pstart,
                                          float* rstd1, int m, int lane) {
    float v[2][8];
#pragma unroll
    for (int j = 0; j < 2; ++j) {
        if (FIRST) { const f32x4 p = ((const f32x4*)(xin + (size_t)m * DM))[2 * (lane + 64 * j)], q = ((const f32x4*)(xin + (size_t)m * DM))[2 * (lane + 64 * j) + 1];
#pragma unroll
            for (int k = 0; k < 4; ++k) { v[j][k] = p[k]; v[j][4 + k] = q[k]; } }
        else { const u32x4 p = ((const u32x4*)(x16 + (size_t)m * (DM * 2)))[lane + 64 * j];
#pragma unroll
            for (int k = 0; k < 4; ++k) { v[j][2 * k] = h_lo(p[k]); v[j][2 * k + 1] = h_hi(p[k]); } }
    }
    if (COMBINE) {
        const unsigned a = rt0[m], b = rt1[m]; const f32x2 w = rtw[m];
        const size_t s0 = (size_t)(pstart[a >> 24] + (int)(a & 0xffffffu)), s1 = (size_t)(pstart[b >> 24] + (int)(b & 0xffffffu));
#pragma unroll
        for (int j = 0; j < 2; ++j) { const u32x4 p = ((const u32x4*)(y + s0 * DM))[lane + 64 * j], q = ((const u32x4*)(y + s1 * DM))[lane + 64 * j];
#pragma unroll
            for (int k = 0; k < 4; ++k) { v[j][2 * k] += w[0] * bf_lo(p[k]) + w[1] * bf_lo(q[k]); v[j][2 * k + 1] += w[0] * bf_hi(p[k]) + w[1] * bf_hi(q[k]); } }
    }
    if (FINAL) {
#pragma unroll
        for (int j = 0; j < 2; ++j) { ((f32x4*)(outf + (size_t)m * DM))[2 * (lane + 64 * j)] = (f32x4){v[j][0], v[j][1], v[j][2], v[j][3]}; ((f32x4*)(outf + (size_t)m * DM))[2 * (lane + 64 * j) + 1] = (f32x4){v[j][4], v[j][5], v[j][6], v[j][7]}; }
    } else {
        float ss = 0.f;
#pragma unroll
        for (int j = 0; j < 2; ++j) { ss += (v[j][0] * v[j][0] + v[j][1] * v[j][1]) + (v[j][2] * v[j][2] + v[j][3] * v[j][3]) + (v[j][4] * v[j][4] + v[j][5] * v[j][5]) + (v[j][6] * v[j][6] + v[j][7] * v[j][7]);
            ((u32x4*)(x16 + (size_t)m * (DM * 2)))[lane + 64 * j] = (u32x4){cvt_pk_f16(v[j][0], v[j][1]), cvt_pk_f16(v[j][2], v[j][3]), cvt_pk_f16(v[j][4], v[j][5]), cvt_pk_f16(v[j][6], v[j][7])}; }
        const float rstd = 1.0f / sqrtf(wave_sum(ss) * (1.0f / DM) + EPS);
        if (lane == 0) rstd1[m] = rstd;
    }
}

template <bool EXPERTS> __device__ __forceinline__ void convert_weights(const Args& a, unsigned char* ws, int l, LAS unsigned char* lds, int lane, int wave, int vcu, int G, int chunk = -1);
__device__ __forceinline__ void p0_phase(const Args& a, unsigned char* ws, int l, LAS unsigned char* lds, int tid, int lane, int wave, int vcu, int G) {
    convert_weights<false>(a, ws, l, lds, lane, wave, vcu, G);
    const int gw = vcu * 8 + wave, NGW = G * 8, gt = vcu * 512 + tid, NGT = G * 512;
    if (l == 0) {
        float* cosT = (float*)(ws + WS_COS); float* sinT = (float*)(ws + WS_SIN);
        for (int idx = gt; idx < SEQ * 32; idx += NGT) { const int pos = idx >> 5, j = idx & 31;
            const float inv_freq = 1.0f / powf(10000.0f, (float)(2 * j) * (1.0f / 64.0f));
            const float ang = (float)pos * inv_freq;
            const double rev = (double)ang * 0.15915494309189533577; const float fr = (float)(rev - rint(rev));
            cosT[idx] = __builtin_amdgcn_cosf(fr); sinT[idx] = __builtin_amdgcn_sinf(fr); }
    }
    { float* wrt = (float*)(ws + WS_WRT); const float* wg = a.in[I_W_GROUP] + (size_t)l * DM * 4; const float* wr = a.in[I_W_ROUTER] + (size_t)l * DM * 32;
      const float* g2 = a.in[I_NORM_FFN] + (size_t)l * DM;
      for (int idx = gt; idx < 36 * DM; idx += NGT) { const int c = idx >> 10, k = idx & 1023; wrt[idx] = g2[k] * (c < 4 ? wg[k * 4 + c] : wr[k * 32 + (c - 4)]); } }
    unsigned char* x16 = ws + WS_X16; float* rstd1 = (float*)(ws + WS_RSTD1);
    const LAS int* pstart = (const LAS int*)(lds + LX_PSTART);
    if (l == 0) { for (int m = gw; m < MTOK; m += NGW) token_row<true, false, false>(a.in[I_X], x16, nullptr, nullptr, nullptr, nullptr, nullptr, pstart, rstd1, m, lane); }
    else { for (int m = gw; m < MTOK; m += NGW) token_row<false, true, false>(nullptr, x16, nullptr, (const bf16_t*)(ws + WS_Y), (const unsigned*)(ws + WS_RT0), (const unsigned*)(ws + WS_RT1), (const f32x2*)(ws + WS_RTW), pstart, rstd1, m, lane); }
}

template <bool EXPERTS> __device__ __forceinline__ void convert_weights(const Args& a, unsigned char* ws, int l, LAS unsigned char* lds, int lane, int wave, int vcu, int G, int chunk) {
    LAS float* scr = (LAS float*)(lds + wave * 16384);
    int gw = vcu * 8 + wave, NGW = G * 8;
    constexpr int I_IN = 216 * 16, I_PA = 32 * 4, I_PC = 32 * 8, I_WO = 32 * 16, I_GU = 32 * 32 * 16, I_DN = 32 * 32 * 8, NIT = I_IN + 2 * I_PA + I_PC + I_WO + I_GU + I_DN;
    constexpr int I_SMALL = I_IN + 2 * I_PA + I_PC + I_WO;
    int it_end = EXPERTS ? NIT : I_SMALL;
    if (chunk >= 0) { gw = chunk * 128 + wave * 16; NGW = 1; it_end = I_SMALL + gw + 16 < NIT ? I_SMALL + gw + 16 : NIT; }
    for (int it = gw + (EXPERTS ? I_SMALL : 0); it < it_end; it += NGW) {
        int r = it; const int d31 = lane & 31;
        if (r < I_IN) { const int nb = r >> 4, kb = r & 15; transpose_item<true>(a.in[I_W_IN] + (size_t)l * DM * D_IN, D_IN, 1024, (bf16_t*)(ws + WS_WIN), nb * 32, kb * 64, inproj_src_col(nb * 32 + d31), scr, lane, a.in[I_NORM_ATTN] + (size_t)l * DM); continue; } r -= I_IN;
        const int pcol = pg8::perm32(d31);
        if (r < I_PA) { const int nb = r >> 2, kb = r & 3; transpose_item<false>(a.in[I_W_PROJ_A] + (size_t)l * 256 * DM, DM, 256, (bf16_t*)(ws + WS_WPA), nb * 32, kb * 64, ((nb * 32 + d31) & ~255) + perm16col((nb * 32 + d31) & 255), scr, lane); continue; } r -= I_PA;
        if (r < I_PA) { const int nb = r >> 2, kb = r & 3; transpose_item<false>(a.in[I_W_PROJ_B] + (size_t)l * 256 * DM, DM, 256, (bf16_t*)(ws + WS_WPB), nb * 32, kb * 64, ((nb * 32 + d31) & ~255) + perm16col((nb * 32 + d31) & 255), scr, lane); continue; } r -= I_PA;
        if (r < I_PC) { const int nb = r >> 3, kb = r & 7; transpose_item<false>(a.in[I_W_PROJ_C] + (size_t)l * 512 * DM, DM, 512, (bf16_t*)(ws + WS_WPC), nb * 32, kb * 64, ((nb * 32 + d31) & ~255) + perm16col((nb * 32 + d31) & 255), scr, lane); continue; } r -= I_PC;
        if (r < I_WO) { const int nb = r >> 4, kb = r & 15; transpose_item<false>(a.in[I_W_OUT] + (size_t)l * DM * DM, DM, 1024, (bf16_t*)(ws + WS_WO), nb * 32, kb * 64, nb * 32 + pcol, scr, lane); continue; } r -= I_WO;
        if (r < I_GU) { const int e = r >> 9, rr = r & 511, nb = rr >> 4, kb = rr & 15, dd = nb * 32, pn = dd >> 8, s = dd & 255, half = s >> 7;
            const float* src = (half ? a.in[I_W_E_UP] : a.in[I_W_E_GATE]) + (size_t)(l * NEXP + e) * DM * DEXP;
            transpose_item<true>(src, DEXP, 1024, (bf16_t*)(ws + WS_WGU) + (size_t)e * 1024 * 1024, nb * 32, kb * 64, 128 * pn + (s & 127) + pcol, scr, lane, a.in[I_NORM_FFN] + (size_t)l * DM); continue; } r -= I_GU;
        { const int e = r >> 8, rr = r & 255, nb = rr >> 3, kb = rr & 7;
            transpose_item<false>(a.in[I_W_E_DOWN] + (size_t)(l * NEXP + e) * DEXP * DM, DM, 512, (bf16_t*)(ws + WS_WD) + (size_t)e * 1024 * 512, nb * 32, kb * 64, ((nb * 32 + d31) & ~255) + perm16col((nb * 32 + d31) & 255), scr, lane); }
    }
}

__device__ __forceinline__ f32x16 mfma32(bf16x8 a, bf16x8 b, f32x16 c) { return __builtin_amdgcn_mfma_f32_32x32x16_bf16(a, b, c, 0, 0, 0); }
typedef short v4i16_t __attribute__((ext_vector_type(4)));
__device__ __forceinline__ s16x4 vtr(const LAS unsigned char* p) { return __builtin_bit_cast(s16x4, __builtin_amdgcn_ds_read_tr16_b64_v4i16((LAS v4i16_t*)p)); }
__device__ __forceinline__ int crow(int r, int hi) { return (r & 3) + 8 * (r >> 2) + 4 * hi; }
#define NEG_INF (-__builtin_inff())

__device__ __forceinline__ f32x16 splat16(float v) { f32x16 r;
#pragma unroll
    for (int i = 0; i < 16; ++i) r[i] = v;
    return r; }
__device__ __forceinline__ int kimg_off(int key, int ch) { return key * 128 + ((ch ^ ((key >> 1) & 7)) << 4); }
__device__ __forceinline__ int kdma_row(int w, int lane) { return 8 * w + (lane >> 3); }
__device__ __forceinline__ int kdma_chunk(int w, int lane) { return (lane & 7) ^ (((8 * w + (lane >> 3)) >> 1) & 7); }
struct QReg { const bf16x8 (&q)[4]; __device__ __forceinline__ bf16x8 operator()(int ks) const { return q[ks]; } };
struct QLds { const LAS unsigned char* p; __device__ __forceinline__ bf16x8 operator()(int ks) const { return *(const LAS bf16x8*)(p + ks * 1024); } };
template <int NDB, class QF, class MaskF>
__device__ __forceinline__ void flash_tile(float& m_run, float& l_run, f32x16 (&o)[NDB], const LAS unsigned char* kimg, const LAS unsigned char* vimg, const QF& qf, const MaskF& maskf, int r32, int hi, int vboff) {
    if (NDB == 4) __builtin_amdgcn_sched_barrier(0);
    f32x16 p0, p1; maskf.init(p0, p1);
#pragma unroll
    for (int ks = 0; ks < 4; ++ks) {
        const bf16x8 a0 = *(const LAS bf16x8*)(kimg + (NDB == 4 ? (2 * ks + hi) * 1024 + r32 * 16 : kimg_off(r32, 2 * ks + hi)));
        const bf16x8 a1 = *(const LAS bf16x8*)(kimg + (NDB == 4 ? (2 * ks + hi) * 1024 + 512 + r32 * 16 : kimg_off(r32, 2 * ks + hi) + 4096));
        const bf16x8 qk = qf(ks);
        p0 = mfma32(a0, qk, p0); p1 = mfma32(a1, qk, p1);
        if (NDB == 4 && (ks & 1)) __builtin_amdgcn_sched_barrier(0);
    }
    maskf(p0, p1);
    float mx = fmaxf(p0[0], p1[0]);
#pragma unroll
    for (int r = 1; r < 16; ++r) mx = fmaxf(mx, fmaxf(p0[r], p1[r]));
    mx = max_xor32(mx);
    const float mnew = fmaxf(m_run, mx);
    if (__ballot(mnew > m_run) != 0ull) {
        const float alpha = fast_exp2(m_run - mnew);
        l_run *= alpha;
#pragma unroll
        for (int db = 0; db < NDB; ++db) o[db] = o[db] * alpha;
    }
    m_run = mnew;
    float sum = 0.f;
#pragma unroll
    for (int r = 0; r < 16; ++r) { p0[r] = fast_exp2(p0[r] - mnew); p1[r] = fast_exp2(p1[r] - mnew); sum += p0[r] + p1[r]; }
    l_run += sum;
    bf16x8 pa[4];
    pa[0] = __builtin_bit_cast(bf16x8, (u32x4){cvt_pk_bf16(p0[0], p0[1]), cvt_pk_bf16(p0[2], p0[3]), cvt_pk_bf16(p0[4], p0[5]), cvt_pk_bf16(p0[6], p0[7])});
    pa[1] = __builtin_bit_cast(bf16x8, (u32x4){cvt_pk_bf16(p0[8], p0[9]), cvt_pk_bf16(p0[10], p0[11]), cvt_pk_bf16(p0[12], p0[13]), cvt_pk_bf16(p0[14], p0[15])});
    pa[2] = __builtin_bit_cast(bf16x8, (u32x4){cvt_pk_bf16(p1[0], p1[1]), cvt_pk_bf16(p1[2], p1[3]), cvt_pk_bf16(p1[4], p1[5]), cvt_pk_bf16(p1[6], p1[7])});
    pa[3] = __builtin_bit_cast(bf16x8, (u32x4){cvt_pk_bf16(p1[8], p1[9]), cvt_pk_bf16(p1[10], p1[11]), cvt_pk_bf16(p1[12], p1[13]), cvt_pk_bf16(p1[14], p1[15])});
#pragma unroll
    for (int db = 0; db < NDB; ++db)
#pragma unroll
        for (int s = 0; s < 4; ++s) {
            const s16x4 lo = vtr(vimg + vboff + db * 4096 + s * 1024), h4 = vtr(vimg + vboff + db * 4096 + s * 1024 + 512);
            const bf16x8 vt = (bf16x8){lo[0], lo[1], lo[2], lo[3], h4[0], h4[1], h4[2], h4[3]};
            o[db] = mfma32(vt, pa[s], o[db]);
            if (NDB == 4 && (s & 1)) __builtin_amdgcn_sched_barrier(0);
        }    __builtin_amdgcn_sched_barrier(0);
}
template <int NDB, class QF, class MaskF>
__device__ __forceinline__ void flash_tile_ref0(float& l_run, f32x16& lacc, f32x16 (&o)[NDB], const LAS unsigned char* kimg, const LAS unsigned char* vimg, const QF& qf, const MaskF& maskf, int r32, int hi, int vboff) {
    f32x16 p0, p1; maskf.init(p0, p1);
    bf16x8 kf[8];
#pragma unroll
    for (int ks = 0; ks < 4; ++ks) { kf[2 * ks] = *(const LAS bf16x8*)(kimg + kimg_off(r32, 2 * ks + hi)); kf[2 * ks + 1] = *(const LAS bf16x8*)(kimg + kimg_off(r32, 2 * ks + hi) + 4096); }
    __builtin_amdgcn_sched_barrier(0);
    __builtin_amdgcn_s_setprio(1);
#pragma unroll
    for (int ks = 0; ks < 4; ++ks) { const bf16x8 qk = qf(ks); p0 = mfma32(kf[2 * ks], qk, p0); p1 = mfma32(kf[2 * ks + 1], qk, p1); }
    __builtin_amdgcn_s_setprio(0);
    maskf(p0, p1);
    __builtin_amdgcn_sched_barrier(0);
    const bf16x8 ones = (bf16x8){0x3f80, 0x3f80, 0x3f80, 0x3f80, 0x3f80, 0x3f80, 0x3f80, 0x3f80};
#pragma unroll
    for (int r = 0; r < 16; ++r) p0[r] = fast_exp2(p0[r]);
    bf16x8 pa[4];
    pa[0] = __builtin_bit_cast(bf16x8, (u32x4){cvt_pk_bf16(p0[0], p0[1]), cvt_pk_bf16(p0[2], p0[3]), cvt_pk_bf16(p0[4], p0[5]), cvt_pk_bf16(p0[6], p0[7])});
    pa[1] = __builtin_bit_cast(bf16x8, (u32x4){cvt_pk_bf16(p0[8], p0[9]), cvt_pk_bf16(p0[10], p0[11]), cvt_pk_bf16(p0[12], p0[13]), cvt_pk_bf16(p0[14], p0[15])});
    maskf.pack(pa[0]); maskf.pack(pa[1]);
    __builtin_amdgcn_sched_barrier(0);
#pragma unroll
    for (int s = 0; s < 2; ++s) {
        lacc = mfma32(ones, pa[s], lacc);
#pragma unroll
        for (int db = 0; db < NDB; ++db) {
            const s16x4 lo = vtr(vimg + vboff + db * 4096 + s * 1024), h4 = vtr(vimg + vboff + db * 4096 + s * 1024 + 512);
            o[db] = mfma32((bf16x8){lo[0], lo[1], lo[2], lo[3], h4[0], h4[1], h4[2], h4[3]}, pa[s], o[db]);
        }
    }
#pragma unroll
    for (int r = 0; r < 16; ++r) p1[r] = fast_exp2(p1[r]);
    pa[2] = __builtin_bit_cast(bf16x8, (u32x4){cvt_pk_bf16(p1[0], p1[1]), cvt_pk_bf16(p1[2], p1[3]), cvt_pk_bf16(p1[4], p1[5]), cvt_pk_bf16(p1[6], p1[7])});
    pa[3] = __builtin_bit_cast(bf16x8, (u32x4){cvt_pk_bf16(p1[8], p1[9]), cvt_pk_bf16(p1[10], p1[11]), cvt_pk_bf16(p1[12], p1[13]), cvt_pk_bf16(p1[14], p1[15])});
    maskf.pack(pa[2]); maskf.pack(pa[3]);
    __builtin_amdgcn_sched_barrier(0);
#pragma unroll
    for (int s = 2; s < 4; ++s) {
        lacc = mfma32(ones, pa[s], lacc);
#pragma unroll
        for (int db = 0; db < NDB; ++db) {
            const s16x4 lo = vtr(vimg + vboff + db * 4096 + s * 1024), h4 = vtr(vimg + vboff + db * 4096 + s * 1024 + 512);
            o[db] = mfma32((bf16x8){lo[0], lo[1], lo[2], lo[3], h4[0], h4[1], h4[2], h4[3]}, pa[s], o[db]);
        }
    }
    __builtin_amdgcn_sched_barrier(0);
    (void)l_run;
}
template <bool KSWZ, class MaskF>
__device__ __forceinline__ void flash_tile_dual_ref0(float& l1, float& l2, f32x16 (&o1)[4], f32x16 (&o2)[4], const LAS unsigned char* k1img, const LAS unsigned char* k2img, const LAS unsigned char* vimg,
                                                     const LAS unsigned char* q1img, const LAS unsigned char* q2img, const MaskF& maskf, int r32, int hi, int vboff) {
    bf16x8 pa1[4], pa2[4];
#define DUAL_MAP_(kimg, qimg, pa, lsum) do { __builtin_amdgcn_sched_barrier(0); f32x16 p0, p1; maskf.init(p0, p1); \
        _Pragma("unroll") for (int ks = 0; ks < 4; ++ks) { const int ko = KSWZ ? kimg_off(r32, 2 * ks + hi) : (2 * ks + hi) * 1024 + r32 * 16; const bf16x8 qq = *(const LAS bf16x8*)(qimg + ks * 1024); \
            p0 = mfma32(*(const LAS bf16x8*)(kimg + ko), qq, p0); p1 = mfma32(*(const LAS bf16x8*)(kimg + ko + (KSWZ ? 4096 : 512)), qq, p1); if (ks & 1) __builtin_amdgcn_sched_barrier(0); } \
        maskf(p0, p1); float sm = 0.f; \
        _Pragma("unroll") for (int r = 0; r < 16; ++r) { p0[r] = fast_exp2(p0[r]); p1[r] = fast_exp2(p1[r]); sm += p0[r] + p1[r]; } \
        lsum += sm; \
        pa[0] = __builtin_bit_cast(bf16x8, (u32x4){cvt_pk_bf16(p0[0], p0[1]), cvt_pk_bf16(p0[2], p0[3]), cvt_pk_bf16(p0[4], p0[5]), cvt_pk_bf16(p0[6], p0[7])}); \
        pa[1] = __builtin_bit_cast(bf16x8, (u32x4){cvt_pk_bf16(p0[8], p0[9]), cvt_pk_bf16(p0[10], p0[11]), cvt_pk_bf16(p0[12], p0[13]), cvt_pk_bf16(p0[14], p0[15])}); \
        pa[2] = __builtin_bit_cast(bf16x8, (u32x4){cvt_pk_bf16(p1[0], p1[1]), cvt_pk_bf16(p1[2], p1[3]), cvt_pk_bf16(p1[4], p1[5]), cvt_pk_bf16(p1[6], p1[7])}); \
        pa[3] = __builtin_bit_cast(bf16x8, (u32x4){cvt_pk_bf16(p1[8], p1[9]), cvt_pk_bf16(p1[10], p1[11]), cvt_pk_bf16(p1[12], p1[13]), cvt_pk_bf16(p1[14], p1[15])}); } while (0)
    DUAL_MAP_(k1img, q1img, pa1, l1);
    DUAL_MAP_(k2img, q2img, pa2, l2);
#undef DUAL_MAP_
    __builtin_amdgcn_sched_barrier(0);
#pragma unroll
    for (int s = 0; s < 4; ++s) {
#pragma unroll
        for (int db = 0; db < 4; ++db) {
            const s16x4 lo = vtr(vimg + vboff + db * 4096 + s * 1024), h4 = vtr(vimg + vboff + db * 4096 + s * 1024 + 512);
            const bf16x8 vt = (bf16x8){lo[0], lo[1], lo[2], lo[3], h4[0], h4[1], h4[2], h4[3]};
            o1[db] = mfma32(vt, pa1[s], o1[db]); o2[db] = mfma32(vt, pa2[s], o2[db]);
            if (db & 1) __builtin_amdgcn_sched_barrier(0);
        }
    }
}
template <bool FAST, int NDB, class QF, class MaskF>
__device__ __forceinline__ void flash_step(float& m_run, float& l_run, f32x16& lacc, f32x16 (&o)[NDB], const LAS unsigned char* kimg, const LAS unsigned char* vimg, const QF& qf, const MaskF& maskf, int r32, int hi, int vboff) {
    if constexpr (FAST) flash_tile_ref0<NDB>(l_run, lacc, o, kimg, vimg, qf, maskf, r32, hi, vboff); else flash_tile<NDB>(m_run, l_run, o, kimg, vimg, qf, maskf, r32, hi, vboff);
}
__device__ __forceinline__ bool softmax_ref0_ok(const float* gq, const float* gk, int lane) {
    float a = fabsf(gq[lane]), b = fabsf(gk[lane]);
    a = fmaxf(a, xor_lane<1>(a)); a = fmaxf(a, xor_lane<2>(a)); a = fmaxf(a, xor_lane<4>(a)); a = fmaxf(a, xor_lane<8>(a)); a = fmaxf(a, xor_lane<16>(a)); a = max_xor32(a);
    b = fmaxf(b, xor_lane<1>(b)); b = fmaxf(b, xor_lane<2>(b)); b = fmaxf(b, xor_lane<4>(b)); b = fmaxf(b, xor_lane<8>(b)); b = fmaxf(b, xor_lane<16>(b)); b = max_xor32(b);
    return __builtin_amdgcn_readfirstlane(__builtin_bit_cast(int, a * b * (C2 * 64.0f * 1.02f))) < __builtin_bit_cast(int, 48.0f) && REF0_ENABLE;
}
#define MASK_INIT_ZERO __device__ __forceinline__ void init(f32x16& p0, f32x16& p1) const { p0 = splat16(0.f); p1 = splat16(0.f); }
#define MASK_PACK_NONE __device__ __forceinline__ void pack(bf16x8&) const {}
struct MaskNone { MASK_INIT_ZERO MASK_PACK_NONE __device__ __forceinline__ void operator()(f32x16&, f32x16&) const {} };
struct MaskCausal { int kb0, qloc, hi;
    MASK_INIT_ZERO MASK_PACK_NONE
    __device__ __forceinline__ void operator()(f32x16& p0, f32x16& p1) const {
#pragma unroll
        for (int r = 0; r < 16; ++r) { const int kv = kb0 + crow(r, hi); p0[r] = kv > qloc ? NEG_INF : p0[r]; p1[r] = kv + 32 > qloc ? NEG_INF : p1[r]; } } };
struct MaskCausalIf { bool on; int kb0, qloc, hi;
    MASK_INIT_ZERO MASK_PACK_NONE
    __device__ __forceinline__ void operator()(f32x16& p0, f32x16& p1) const { if (on) {
#pragma unroll
        for (int r = 0; r < 16; ++r) { const int kv = kb0 + crow(r, hi); p0[r] = kv > qloc ? NEG_INF : p0[r]; p1[r] = kv + 32 > qloc ? NEG_INF : p1[r]; } } } };
struct MaskLaneP { unsigned keep;
    MASK_INIT_ZERO
    __device__ __forceinline__ void operator()(f32x16&, f32x16&) const {}
    __device__ __forceinline__ void pack(bf16x8& pa) const { u32x4 v = __builtin_bit_cast(u32x4, pa); v = v & keep; pa = __builtin_bit_cast(bf16x8, v); } };
struct MaskLane { float ci;
    MASK_INIT_ZERO MASK_PACK_NONE
    __device__ __forceinline__ void operator()(f32x16& p0, f32x16& p1) const {
#pragma unroll
        for (int r = 0; r < 16; ++r) { p0[r] += ci; p1[r] += ci; } } };
template <int POS> __device__ __forceinline__ float neginf_if_bit(unsigned n) { float r; asm("v_bfe_i32 %0, %1, %2, 1\n\tv_and_b32 %0, 0xff800000, %0" : "=v"(r) : "v"(n), "n"(POS)); return r; }
struct MaskBits { unsigned n0, n1;
    __device__ __forceinline__ void init(f32x16& p0, f32x16& p1) const {
#define MB_(r) p0[r] = neginf_if_bit<((r) & 3) + 8 * ((r) >> 2)>(n0); p1[r] = neginf_if_bit<((r) & 3) + 8 * ((r) >> 2)>(n1);
        MB_(0) MB_(1) MB_(2) MB_(3) MB_(4) MB_(5) MB_(6) MB_(7) MB_(8) MB_(9) MB_(10) MB_(11) MB_(12) MB_(13) MB_(14) MB_(15)
#undef MB_
        asm volatile("s_nop 1" ::: "memory"); }
    MASK_PACK_NONE
    __device__ __forceinline__ void operator()(f32x16&, f32x16&) const {} };
__device__ __forceinline__ void dma16(const void* g, LAS unsigned char* l) { __builtin_amdgcn_global_load_lds((const unsigned*)g, (LAS unsigned*)l, 16, 0, 0); }
#define DMA_WAIT_SYNC() do { asm volatile("s_waitcnt vmcnt(0)" ::: "memory"); __syncthreads(); } while (0)

__device__ __forceinline__ void glds16(const void* gsrc, unsigned lds_dst) { unsigned keep;
    asm volatile("s_mov_b32 %0, m0\n\ts_mov_b32 m0, %2\n\ts_nop 0\n\tglobal_load_lds_dwordx4 %1, off\n\ts_mov_b32 m0, %0" : "=&s"(keep) : "v"(gsrc), "s"(lds_dst) : "memory"); }
__device__ __forceinline__ void glds4(const void* gsrc, unsigned lds_dst) { unsigned keep;
    asm volatile("s_mov_b32 %0, m0\n\ts_mov_b32 m0, %2\n\ts_nop 0\n\tglobal_load_lds_dword %1, off\n\ts_mov_b32 m0, %0" : "=&s"(keep) : "v"(gsrc), "s"(lds_dst) : "memory"); }
#define WAITV_BAR(N) asm volatile("s_waitcnt vmcnt(" #N ") lgkmcnt(0)\n\ts_barrier" ::: "memory")

template <int MODE, bool FAST>
__device__ __forceinline__ void attn_ab_unit(int b, int h, int qt, const bf16_t* qkv, bf16_t* obuf, const float* kmean, const unsigned* maskg, LAS unsigned char* lds, int tid, int lane, int w) {
    constexpr int CQ = MODE == 0 ? C_QA : C_QB, CK = MODE == 0 ? C_KA : C_KB, CV = MODE == 0 ? C_VA : C_VB;
    constexpr int NS = 4, D = 3, SLOT = 16384;
    const int r32 = lane & 31, hi = lane >> 5;
    const size_t rowbase = (size_t)b * SEQ; const int q0 = 256 * qt, qloc = 32 * w + r32; const size_t qrow = rowbase + q0 + qloc;
    const unsigned lds0 = (unsigned)(size_t)lds;
    LAS float* kml = (LAS float*)(lds + 73728); LAS unsigned* mwl = (LAS unsigned*)(lds + 65536);
    bf16x8 qf[4];
#pragma unroll
    for (int ks = 0; ks < 4; ++ks) qf[ks] = *(const bf16x8*)(qkv + qrow * QP + CQ + 64 * h + 16 * ks + 8 * hi);
    const bf16_t* ksrc = qkv + (rowbase + kdma_row(w, lane)) * QP + CK + 64 * h + 8 * kdma_chunk(w, lane);
    const bf16_t* vsrc = qkv + (rowbase + 16 * (w & 3) + (lane >> 2)) * QP + CV + 64 * h + 32 * (w >> 2) + 8 * (lane & 3);
    const unsigned* msrc = maskg + qrow * 128 + hi;
    const int NT = 4 * qt + 4, wlim = 4 * qt + (w >> 1);
    const unsigned kdst0 = (unsigned)__builtin_amdgcn_readfirstlane(lds0 + w * 1024), mdst0 = (unsigned)__builtin_amdgcn_readfirstlane(lds0 + 65536 + w * 256);
    __syncthreads();
#pragma unroll
    for (int d = 0; d < D; ++d) { const int t = d < NT ? d : NT - 1;
        glds16(ksrc + (size_t)t * 64 * QP, kdst0 + d * SLOT); glds16(vsrc + (size_t)t * 64 * QP, kdst0 + d * SLOT + 8192);
        if (MODE == 1) glds4(msrc + 2 * t, mdst0 + d * 2048); }
    unsigned selbits = 0;
    if (MODE == 0) {
        if (tid < 256) ((LAS f32x4*)kml)[tid] = ((const f32x4*)(kmean + (size_t)((b * 4 + h) * 16) * 64))[tid];
        __syncthreads();
        if (qt > 0) {
            float qv[32];
#pragma unroll
            for (int ks = 0; ks < 4; ++ks) { const u32x4 qq = __builtin_bit_cast(u32x4, qf[ks]);
#pragma unroll
                for (int k = 0; k < 4; ++k) { qv[8 * ks + 2 * k] = bf_lo(qq[k]); qv[8 * ks + 2 * k + 1] = bf_hi(qq[k]); } }
            float v1 = NEG_INF, v2 = NEG_INF, v3 = NEG_INF; int i1 = -1, i2 = -1, i3 = -1;
#pragma unroll 1
            for (int j = 0; j < qt; ++j) {
                float g = 0.f;
#pragma unroll
                for (int ks = 0; ks < 4; ++ks) { const f32x4 k0 = *(const LAS f32x4*)(kml + j * 64 + 16 * ks + 8 * hi), k1 = *(const LAS f32x4*)(kml + j * 64 + 16 * ks + 8 * hi + 4);
                    g += qv[8 * ks + 0] * k0[0] + qv[8 * ks + 1] * k0[1] + qv[8 * ks + 2] * k0[2] + qv[8 * ks + 3] * k0[3] + qv[8 * ks + 4] * k1[0] + qv[8 * ks + 5] * k1[1] + qv[8 * ks + 6] * k1[2] + qv[8 * ks + 7] * k1[3]; }
                g = sum_xor32(g);
                if (g > v1) { v3 = v2; i3 = i2; v2 = v1; i2 = i1; v1 = g; i1 = j; }
                else if (g > v2) { v3 = v2; i3 = i2; v2 = g; i2 = j; }
                else if (g > v3) { v3 = g; i3 = j; }
            }
            if (i1 >= 0) selbits |= 1u << i1; if (i2 >= 0) selbits |= 1u << i2; if (i3 >= 0) selbits |= 1u << i3;
        }
    }
    const int vboff = (4 * hi + ((lane & 15) >> 2)) * 64 + ((lane >> 4) & 1) * 32 + (lane & 3) * 8;
    float m_run = -1e30f, l_run = 0.f; f32x16 o[2], lacc = splat16(0.f); o[0] = splat16(0.f); o[1] = splat16(0.f);
    int scur = 0, siss = D;
    asm volatile("s_waitcnt vmcnt(0)" ::: "memory");
    asm volatile("" : "+v"(qf[0]), "+v"(qf[1]), "+v"(qf[2]), "+v"(qf[3]));
#pragma unroll 1
    for (int kt = 0; kt < NT; ++kt) {
        if (MODE == 1) WAITV_BAR(6); else WAITV_BAR(4);
        { const int t = kt + D < NT ? kt + D : NT - 1;
          glds16(ksrc + (size_t)t * 64 * QP, kdst0 + siss * SLOT); glds16(vsrc + (size_t)t * 64 * QP, kdst0 + siss * SLOT + 8192);
          if (MODE == 1) glds4(msrc + 2 * t, mdst0 + siss * 2048); }
        const LAS unsigned char* cur = lds + scur * SLOT;
        if (MODE == 0) {
            const int j = kt >> 2;
            if (j < qt) { const bool sel = (selbits >> j) & 1u; if (__ballot(sel) != 0ull) { if (FAST) flash_step<FAST, 2>(m_run, l_run, lacc, o, cur, cur + 8192, QReg{qf}, MaskLaneP{sel ? 0xffffffffu : 0u}, r32, hi, vboff); else flash_step<FAST, 2>(m_run, l_run, lacc, o, cur, cur + 8192, QReg{qf}, MaskLane{sel ? 0.f : NEG_INF}, r32, hi, vboff); } }
            else { const int kb0 = 64 * (kt & 3); if (kb0 <= 32 * w + 31) flash_step<FAST, 2>(m_run, l_run, lacc, o, cur, cur + 8192, QReg{qf}, MaskCausal{kb0, qloc, hi}, r32, hi, vboff); }
        } else {
            if (kt <= wlim) { const LAS unsigned* mp = mwl + scur * 512 + w * 64; const unsigned cw0 = mp[r32], cw1 = mp[32 + r32];
                flash_step<FAST, 2>(m_run, l_run, lacc, o, cur, cur + 8192, QReg{qf}, MaskBits{~cw0 >> (4 * hi), ~cw1 >> (4 * hi)}, r32, hi, vboff); }
        }
        scur = scur + 1 == NS ? 0 : scur + 1; siss = siss + 1 == NS ? 0 : siss + 1;
    }
    asm volatile("s_waitcnt vmcnt(0)" ::: "memory");
    const float inv = 1.0f / (FAST ? lacc[0] : sum_xor32(l_run));
    bf16_t* orow = obuf + qrow * 256 + 64 * h;
#pragma unroll
    for (int db = 0; db < 2; ++db)
#pragma unroll
        for (int g = 0; g < 4; ++g)
            *(u32x2*)(orow + 32 * db + 8 * g + 4 * hi) = (u32x2){cvt_pk_bf16(o[db][4 * g] * inv, o[db][4 * g + 1] * inv), cvt_pk_bf16(o[db][4 * g + 2] * inv, o[db][4 * g + 3] * inv)};
}

template <bool FAST>
__device__ __forceinline__ void attn_c_unit(int b, int h, int qt, const bf16_t* qkv, bf16_t* oc, float lam, const float* subg, float coef, LAS unsigned char* lds, int tid, int lane, int w) {
    const int r32 = lane & 31, hi = lane >> 5;
    const size_t rowbase = (size_t)b * SEQ; const int q0 = 256 * qt, qloc = 32 * w + r32; const size_t qrow = rowbase + q0 + qloc;
    LAS unsigned char* qimg = lds + 65536 + w * 8192 + lane * 16;
    __syncthreads();
#pragma unroll
    for (int ks = 0; ks < 4; ++ks) { *(LAS bf16x8*)(qimg + ks * 1024) = *(const bf16x8*)(qkv + qrow * QP + C_Q1 + 64 * h + 16 * ks + 8 * hi); *(LAS bf16x8*)(qimg + 4096 + ks * 1024) = *(const bf16x8*)(qkv + qrow * QP + C_Q2 + 64 * h + 16 * ks + 8 * hi); }
    const bf16_t* k1src = FAST ? qkv + (rowbase + kdma_row(w, lane)) * QP + C_K1 + 64 * h + 8 * kdma_chunk(w, lane)
                               : qkv + (rowbase + lane) * QP + C_K1 + 64 * h + 8 * w;
    const bf16_t* k2src = k1src + (C_K2 - C_K1);
    const bf16_t* v0src = qkv + (rowbase + 16 * (w & 3) + (lane >> 2)) * QP + C_VC + 128 * h + 32 * (w >> 2) + 8 * (lane & 3);
    const bf16_t* v1src = v0src + 64;
    const int vboff = (4 * hi + ((lane & 15) >> 2)) * 64 + ((lane >> 4) & 1) * 32 + (lane & 3) * 8;
    const int NT = 4 * qt + 4;
    float m1 = -1e30f, l1 = 0.f, m2 = -1e30f, l2 = 0.f; f32x16 o1[4], o2[4];
#pragma unroll
    for (int i = 0; i < 4; ++i) { o1[i] = splat16(0.f); o2[i] = splat16(0.f); }
    dma16(k1src, lds + w * 1024); dma16(k2src, lds + 8192 + w * 1024); dma16(v0src, lds + 16384 + w * 1024); dma16(v1src, lds + 16384 + 8192 + w * 1024);
    DMA_WAIT_SYNC();
#pragma unroll 1
    for (int kt = 0; kt < NT; ++kt) {
        LAS unsigned char* cur = lds + (kt & 1) * 32768; LAS unsigned char* nxt = lds + ((kt + 1) & 1) * 32768;
        if (kt + 1 < NT) { const size_t adv = (size_t)(kt + 1) * 64 * QP;
            dma16(k1src + adv, nxt + w * 1024); dma16(k2src + adv, nxt + 8192 + w * 1024); dma16(v0src + adv, nxt + 16384 + w * 1024); dma16(v1src + adv, nxt + 16384 + 8192 + w * 1024); }
        const bool band = kt >= 4 * qt; const int kb0 = 64 * (kt & 3);
        if (!band || kb0 <= 32 * w + 31) { const MaskCausalIf mk{band, kb0, qloc, hi};
            if (FAST) flash_tile_dual_ref0<true>(l1, l2, o1, o2, cur, cur + 8192, cur + 16384, qimg, qimg + 4096, mk, r32, hi, vboff);
            else { flash_step<false, 4>(m1, l1, o1[0], o1, cur, cur + 16384, QLds{qimg}, mk, r32, hi, vboff); flash_step<false, 4>(m2, l2, o2[0], o2, cur + 8192, cur + 16384, QLds{qimg + 4096}, mk, r32, hi, vboff); } }
        DMA_WAIT_SYNC();
    }
    const float i1 = 1.0f / sum_xor32(l1), i2 = lam / sum_xor32(l2);
    float ss = 0.f;
#pragma unroll
    for (int db = 0; db < 4; ++db) { o1[db] = o1[db] * i1 - o2[db] * i2;
#pragma unroll
        for (int r = 0; r < 16; ++r) ss += o1[db][r] * o1[db][r]; }
    ss = sum_xor32(ss);
    const float rn = coef / sqrtf(ss * (1.0f / 128.0f) + EPS);
    bf16_t* orow = oc + qrow * 512 + 128 * h;
#pragma unroll
    for (int db = 0; db < 4; ++db)
#pragma unroll
        for (int g = 0; g < 4; ++g) { const int d = 32 * db + 8 * g + 4 * hi; const f32x4 gg = *(const f32x4*)(subg + d);
            *(u32x2*)(orow + d) = (u32x2){cvt_pk_bf16(o1[db][4 * g] * rn * gg[0], o1[db][4 * g + 1] * rn * gg[1]), cvt_pk_bf16(o1[db][4 * g + 2] * rn * gg[2], o1[db][4 * g + 3] * rn * gg[3])}; }
}

__device__ __forceinline__ void index_unit(int b, int i64, const bf16_t* qkv, unsigned* maskg, unsigned char* scr, LAS unsigned char* lds, int tid, int lane, int w) {
    constexpr int NS = 5, D = 4, HS = 257, RING = 84224, TOFF = 65792, TROW = 144;
    const int r32 = lane & 31, hi = lane >> 5;
    const unsigned lds0 = (unsigned)(size_t)lds;
    LAS unsigned* hist = (LAS unsigned*)lds; LAS unsigned char* ring = lds + RING; LAS unsigned char* mb8 = lds;
    LAS int* thrB1 = (LAS int*)(lds + 125184); LAS int* thrRem = thrB1 + 64; LAS int* thrT = thrB1 + 128; LAS int* thrNeed = thrB1 + 192;
    const size_t rowbase = (size_t)b * SEQ; const int q0 = 64 * i64, NT = i64 + 1;
    __syncthreads();
    {
        const int hh = 4 * ((r32 >> 3) & 1) + (r32 & 3), qp = 2 * (r32 >> 4) + ((r32 >> 2) & 1);
        bf16x8 aq[2][4]; float wv[2][2][8];
#pragma unroll
        for (int rb = 0; rb < 2; ++rb) {
            const size_t row = rowbase + q0 + 8 * w + 4 * rb + qp;
#pragma unroll
            for (int ks = 0; ks < 4; ++ks) aq[rb][ks] = *(const bf16x8*)(qkv + row * QP + C_QI + 64 * hh + 16 * ks + 8 * hi);
#pragma unroll
            for (int hf = 0; hf < 2; ++hf) { const u32x4 ww = *(const u32x4*)(qkv + (rowbase + q0 + 8 * w + 4 * rb + 2 * hf + hi) * QP + C_WI);
#pragma unroll
                for (int k = 0; k < 4; ++k) { wv[rb][hf][2 * k] = bf_lo(ww[k]); wv[rb][hf][2 * k + 1] = bf_hi(ww[k]); } }
        }
#pragma unroll
        for (int rb = 0; rb < 2; ++rb) { asm volatile("" : "+v"(aq[rb][0]), "+v"(aq[rb][1]), "+v"(aq[rb][2]), "+v"(aq[rb][3]));
#pragma unroll
            for (int hf = 0; hf < 2; ++hf) asm volatile("" : "+v"(wv[rb][hf][0]), "+v"(wv[rb][hf][1]), "+v"(wv[rb][hf][2]), "+v"(wv[rb][hf][3]), "+v"(wv[rb][hf][4]), "+v"(wv[rb][hf][5]), "+v"(wv[rb][hf][6]), "+v"(wv[rb][hf][7])); }
        const bf16_t* ksrc = qkv + (rowbase + kdma_row(w, lane)) * QP + C_KI + 8 * kdma_chunk(w, lane);
        const unsigned kdst0 = (unsigned)__builtin_amdgcn_readfirstlane(lds0 + RING + w * 1024);
#pragma unroll
        for (int d = 0; d < D; ++d) { const int t = d < NT ? d : NT - 1; glds16(ksrc + (size_t)t * 64 * QP, kdst0 + d * 8192); }
        for (int i = tid; i < 4112; i += 512) ((LAS u32x4*)hist)[i] = (u32x4){0u, 0u, 0u, 0u};
        asm volatile("s_waitcnt lgkmcnt(0)" ::: "memory");
        int scur = 0, siss = D;
#pragma unroll 1
        for (int kt = 0; kt <= NT; ++kt) {
            if (kt < NT) WAITV_BAR(3); else { asm volatile("s_waitcnt vmcnt(0)" ::: "memory"); __syncthreads(); }
            if (kt > 0) {
                const u32x4 kk = *(const LAS u32x4*)(lds + TOFF + ((kt - 1) & 1) * 9216 + lane * TROW + w * 16);
                {
                    const u32x4 ks = *(const LAS u32x4*)(lds + TOFF + ((kt - 1) & 1) * 9216 + (8 * w + (lane >> 3)) * TROW + (lane & 7) * 16);
                    unsigned char* sp = scr + (size_t)(8 * w + (lane >> 3)) * 8192 + (size_t)(kt - 1) * 128 + (lane & 7) * 16;
                    if (kt < NT) asm volatile("global_store_dwordx4 %0, %1, off" :: "v"(sp), "v"(ks) : "memory");
                    else *(u32x4*)sp = ks; }
#pragma unroll
                for (int k = 0; k < 4; ++k) { const unsigned a = kk[k] & 0xffffu, c = kk[k] >> 16;
                    if (a) __hip_atomic_fetch_add(&hist[lane * HS + (a >> 8)], 1u, __ATOMIC_RELAXED, __HIP_MEMORY_SCOPE_WORKGROUP);
                    if (c) __hip_atomic_fetch_add(&hist[lane * HS + (c >> 8)], 1u, __ATOMIC_RELAXED, __HIP_MEMORY_SCOPE_WORKGROUP); }
            }
            if (kt == NT) break;
            { const int t = kt + D < NT ? kt + D : NT - 1; glds16(ksrc + (size_t)t * 64 * QP, kdst0 + siss * 8192); }
            const LAS unsigned char* kimg = ring + scur * 8192;
            const bool diag = kt == NT - 1;
#pragma unroll
            for (int rb = 0; rb < 2; ++rb)
#pragma unroll
                for (int kb = 0; kb < 2; ++kb) {
                    f32x16 d = splat16(0.f);
#pragma unroll
                    for (int ks = 0; ks < 4; ++ks) { __builtin_amdgcn_s_setprio(1); d = mfma32(aq[rb][ks], *(const LAS bf16x8*)(kimg + kimg_off(32 * kb + r32, 2 * ks + hi)), d); __builtin_amdgcn_s_setprio(0); }
#pragma unroll
                    for (int hf = 0; hf < 2; ++hf) {
                        float sc = 0.f;
#pragma unroll
                        for (int t = 0; t < 8; ++t) { const float mx_ = fmaxf(d[8 * hf + t], 0.f); asm("v_fma_f32 %0, %1, %2, %0" : "+v"(sc) : "v"(wv[rb][hf][t]), "v"(mx_)); }
                        const int ql = 8 * w + 4 * rb + 2 * hf + hi;
                        const unsigned u = (unsigned)__builtin_bit_cast(unsigned short, (_Float16)sc);
                        unsigned key = u ^ ((u & 0x8000u) ? 0xffffu : 0x8000u);
                        if (diag && 32 * kb + r32 > ql) key = 0u;
                        *(LAS unsigned short*)(lds + TOFF + (kt & 1) * 9216 + ql * TROW + (32 * kb + r32) * 2) = (unsigned short)key;
                    }
                }
            scur = scur + 1 == NS ? 0 : scur + 1; siss = siss + 1 == NS ? 0 : siss + 1;
        }
        asm volatile("s_waitcnt vmcnt(0)" ::: "memory");
        __syncthreads();
    }
#define IDX_SEARCH(STAGE) do { _Pragma("unroll 1") for (int qq = 0; qq < 8; ++qq) { const int q = 8 * w + qq; int target; \
        if (STAGE == 0) { if (q0 + q + 1 <= 256) { if (lane == 0) { thrB1[q] = 0x10000; thrRem[q] = 0; } continue; } target = 256; } \
        else { if (thrB1[q] == 0x10000) { if (lane == 0) { thrT[q] = 0; thrNeed[q] = 0; } continue; } target = thrRem[q]; } \
        const LAS unsigned* hp = hist + q * HS + 4 * lane; const int h0 = (int)hp[0], h1 = (int)hp[1], h2 = (int)hp[2], h3 = (int)hp[3]; \
        int P = h0 + h1 + h2 + h3; const int s_ = P; \
        _Pragma("unroll") for (int o = 1; o < 64; o <<= 1) { const int t_ = lane_val(P, (lane - o) & 63); if (lane >= o) P += t_; } \
        const int above = __builtin_amdgcn_readlane(P, 63) - P; (void)s_; \
        const int c3 = above + h3, c2 = c3 + h2, c1 = c2 + h1, c0 = c1 + h0; int bin = -1, ab = 0; \
        if (above < target && c3 >= target) { bin = 4 * lane + 3; ab = above; } else if (c3 < target && c2 >= target) { bin = 4 * lane + 2; ab = c3; } \
        else if (c2 < target && c1 >= target) { bin = 4 * lane + 1; ab = c2; } else if (c1 < target && c0 >= target) { bin = 4 * lane; ab = c1; } \
        if (bin >= 0) { if (STAGE == 0) { thrB1[q] = bin; thrRem[q] = target - ab; } else { thrT[q] = (thrB1[q] << 8) | bin; thrNeed[q] = target - ab; } } } \
        __syncthreads(); } while (0)
    IDX_SEARCH(0);
    const int qs = 8 * w + (lane >> 3), pc = lane & 7;
    const unsigned char* rrow = scr + (size_t)qs * 8192 + pc * 16;
    {
        __builtin_amdgcn_fence(__ATOMIC_ACQUIRE, "agent");
        asm volatile("s_waitcnt vmcnt(0)" ::: "memory");
        const int b1 = thrB1[qs];
        for (int i = tid; i < 4112; i += 512) ((LAS u32x4*)hist)[i] = (u32x4){0u, 0u, 0u, 0u};
        __syncthreads();
#pragma unroll 4
        for (int it = 0; it < NT; ++it) { const u32x4 kk = *(const u32x4*)(rrow + (size_t)it * 128);
#pragma unroll
            for (int k = 0; k < 4; ++k) { const unsigned a = kk[k] & 0xffffu, c = kk[k] >> 16;
                if ((int)(a >> 8) == b1) __hip_atomic_fetch_add(&hist[qs * HS + (a & 255u)], 1u, __ATOMIC_RELAXED, __HIP_MEMORY_SCOPE_WORKGROUP);
                if ((int)(c >> 8) == b1) __hip_atomic_fetch_add(&hist[qs * HS + (c & 255u)], 1u, __ATOMIC_RELAXED, __HIP_MEMORY_SCOPE_WORKGROUP); } }
        __syncthreads();
    }
    IDX_SEARCH(1);
    {
        const unsigned T = (unsigned)thrT[qs]; const int need = thrNeed[qs]; int tc = 0;
        __syncthreads();
#pragma unroll 2
        for (int it = 0; it < NT; ++it) { const u32x4 kk = *(const u32x4*)(rrow + (size_t)it * 128);
            unsigned sel = 0, eq = 0;
#pragma unroll
            for (int k = 0; k < 4; ++k) { const unsigned a = kk[k] & 0xffffu, c = kk[k] >> 16;
                sel |= (a > T ? 1u : 0u) << (2 * k); sel |= (c > T ? 1u : 0u) << (2 * k + 1); eq |= (a == T ? 1u : 0u) << (2 * k); eq |= (c == T ? 1u : 0u) << (2 * k + 1); }
            if (T == 0u) eq = 0u;
            if (__ballot(eq != 0u) != 0ull) {
                const int n = __popc(eq); int P = n;
#pragma unroll
                for (int o = 1; o < 8; o <<= 1) { const int t_ = lane_val(P, (lane - o) & 63); if ((lane & 7) >= o) P += t_; }
                int allow = need - tc - (P - n);
#pragma unroll
                for (int k = 0; k < 8; ++k) if (((eq >> k) & 1u) && allow > 0) { sel |= 1u << k; --allow; }
                tc += lane_val(P, (lane & ~7) + 7);
            }
            mb8[qs * 512 + it * 8 + pc] = (unsigned char)sel;
        }
        __syncthreads();
    }
#undef IDX_SEARCH
    for (int idx = tid; idx < 64 * 2 * NT; idx += 512) { const int q = idx / (2 * NT), wd = idx - q * 2 * NT; maskg[(rowbase + q0 + q) * 128 + wd] = ((const LAS unsigned*)mb8)[q * 128 + wd]; }
}

__device__ __forceinline__ int next_unit(unsigned* ctr, LAS unsigned char* lds, int tid) {
    volatile LAS int* bc = (volatile LAS int*)(lds + LX_BC);
    __syncthreads();
    if (tid == 0) *bc = (int)__hip_atomic_fetch_add(ctr, 1u, __ATOMIC_RELAXED, __HIP_MEMORY_SCOPE_AGENT);
    __syncthreads();
    return __builtin_amdgcn_readfirstlane(*bc);
}

__device__ __forceinline__ void m1_phase(const Args& a, unsigned char* ws, int lc, LAS unsigned char* lds, int lane, int wave, int vcu, int G) {
    const int l = lc & 1;
    const float* wrt = (const float*)(ws + WS_WRT);
    const float* bg = a.in[I_B_GROUP] + l * 4; const float* br = a.in[I_B_ROUTER] + l * 32;
    unsigned* cnt = (unsigned*)(ws + WS_CTL) + CW_CNT + 2048 * lc;
    unsigned* rt0 = (unsigned*)(ws + WS_RT0); unsigned* rt1 = (unsigned*)(ws + WS_RT1); f32x2* rtw = (f32x2*)(ws + WS_RTW);
    int* tokl = (int*)(ws + WS_TOKL); float* rstdg = (float*)(ws + WS_RSTD); const unsigned char* x16 = ws + WS_X16;
    const int r32 = lane & 31, kh = lane >> 5, wq = wave & 3, kpart = wave >> 2;
    LAS float* tl = (LAS float*)(lds + wq * 8192);
    LAS float* tss = tl + 32 * 40;
    LAS float* xs = (LAS float*)(lds + 32768 + wave * 8704);
#pragma unroll 1
    for (int t = wq * G + vcu; t < MTOK / 32; t += 4 * G) {
        const unsigned char* xbase = x16 + ((size_t)(32 * t + (lane >> 3)) * DM + 512 * kpart + 8 * (lane & 7)) * 2;
        const float* wp0 = wrt + (size_t)r32 * DM + 512 * kpart + 4 * kh; const float* wp1 = wrt + (size_t)(32 + (r32 & 3)) * DM + 512 * kpart + 4 * kh;
        f32x16 d0 = splat16(0.f), d1 = splat16(0.f); float ss = 0.f;
        u32x4 xr[4];
#pragma unroll
        for (int j = 0; j < 4; ++j) xr[j] = *(const u32x4*)(xbase + (size_t)(8 * j) * (DM * 2));
#pragma unroll 1
        for (int c = 0; c < 8; ++c) {
#pragma unroll
            for (int j = 0; j < 4; ++j) { LAS float* d = xs + (8 * j + (lane >> 3)) * 68 + 8 * (lane & 7);
                *(LAS f32x4*)d = (f32x4){h_lo(xr[j][0]), h_hi(xr[j][0]), h_lo(xr[j][1]), h_hi(xr[j][1])}; *(LAS f32x4*)(d + 4) = (f32x4){h_lo(xr[j][2]), h_hi(xr[j][2]), h_lo(xr[j][3]), h_hi(xr[j][3])}; }
            if (c < 7) {
#pragma unroll
                for (int j = 0; j < 4; ++j) xr[j] = *(const u32x4*)(xbase + (size_t)(8 * j) * (DM * 2) + 128 * (c + 1)); }
            LDS_WAIT(); asm volatile("" ::: "memory");
#pragma unroll
            for (int mm = 0; mm < 8; ++mm) {
                const f32x4 xa = *(const LAS f32x4*)(xs + r32 * 68 + 8 * mm + 4 * kh), b0 = *(const f32x4*)(wp0 + 64 * c + 8 * mm), b1 = *(const f32x4*)(wp1 + 64 * c + 8 * mm);
                ss += (xa[0] * xa[0] + xa[1] * xa[1]) + (xa[2] * xa[2] + xa[3] * xa[3]);
#pragma unroll
                for (int i = 0; i < 4; ++i) { d0 = __builtin_amdgcn_mfma_f32_32x32x2f32(xa[i], b0[i], d0, 0, 0, 0); d1 = __builtin_amdgcn_mfma_f32_32x32x2f32(xa[i], b1[i], d1, 0, 0, 0); }
            }
            LDS_WAIT(); asm volatile("" ::: "memory");
        }
        ss = sum_xor32(ss);
        if (kpart == 1) {
#pragma unroll
            for (int r = 0; r < 16; ++r) { tl[crow(r, kh) * 40 + r32] = d0[r]; if (r32 < 4) tl[crow(r, kh) * 40 + 32 + r32] = d1[r]; }
            if (kh == 0) tss[r32] = ss;
        }
        __syncthreads();
        if (kpart == 0) {
#pragma unroll
            for (int r = 0; r < 16; ++r) { tl[crow(r, kh) * 40 + r32] += d0[r]; if (r32 < 4) tl[crow(r, kh) * 40 + 32 + r32] += d1[r]; }
            ss += tss[r32];
            LDS_WAIT(); asm volatile("" ::: "memory");
            const float rstd = 1.0f / sqrtf(ss * (1.0f / DM) + EPS);
            const LAS float* my = tl + r32 * 40;
            float gl[4];
#pragma unroll
            for (int c = 0; c < 4; ++c) gl[c] = my[c] * rstd + bg[c];
            int g = 0; float gm = gl[0];
#pragma unroll
            for (int c = 1; c < 4; ++c) if (gl[c] > gm) { gm = gl[c]; g = c; }
            float den = 0.f;
#pragma unroll
            for (int c = 0; c < 4; ++c) den += __expf(gl[c] - gm);
            const float gwt = 1.0f / den;
            float le[8];
#pragma unroll
            for (int e = 0; e < 8; ++e) le[e] = my[4 + 8 * g + e] * rstd + br[8 * g + e];
            int i1 = 0; float v1 = le[0];
#pragma unroll
            for (int e = 1; e < 8; ++e) if (le[e] > v1) { v1 = le[e]; i1 = e; }
            int i2 = -1; float v2 = NEG_INF;
#pragma unroll
            for (int e = 0; e < 8; ++e) if (e != i1 && le[e] > v2) { v2 = le[e]; i2 = e; }
            const float ex = __expf(v2 - v1), w1 = 1.0f / (1.0f + ex), w2 = ex * w1;
            if (kh == 0) { const int e0 = g * 8 + i1, e1 = g * 8 + i2, m = 32 * t + r32;
                const unsigned r0 = atomicAdd(cnt + 64 * e0, 1u), r1 = atomicAdd(cnt + 64 * e1, 1u);
                rt0[m] = ((unsigned)e0 << 24) | r0; rt1[m] = ((unsigned)e1 << 24) | r1; rtw[m] = (f32x2){gwt * w1, gwt * w2};
                tokl[e0 * 32768 + (int)r0] = m; tokl[e1 * 32768 + (int)r1] = m; }
            if (kh == 0) rstdg[32 * t + r32] = rstd;
        }
        __syncthreads();
    }
}
__device__ __forceinline__ void moe_tables(const unsigned* cnt, const int* tokl, const float* rstdg, LAS unsigned char* lds, int tid, int c, int G) {
    LAS int* pstart = (LAS int*)(lds + LX_PSTART); LAS int* blk2e = (LAS int*)(lds + LX_BLK2E); LAS int* cntl = (LAS int*)(lds + LX_CNT); LAS int* tok = (LAS int*)(lds + LX_TOK);
    if (tid < 64) {
        const int cn = tid < NEXP ? (int)cnt[64 * tid] : 0, nb = (cn + 255) >> 8;
        int P = nb;
#pragma unroll
        for (int o = 1; o < 64; o <<= 1) { const int t = lane_val(P, (tid - o) & 63); if (tid >= o) P += t; }
        const int pb = P - nb;
        if (tid <= NEXP) pstart[tid] = pb * 256;
        if (tid < NEXP) cntl[tid] = cn;
        if (tid == NEXP) *(LAS int*)(lds + LX_NBLK) = pb < MAXBLK ? pb : MAXBLK;
#pragma unroll 1
        for (int k = 0; k < nb; ++k) if (pb + k < MAXBLK) blk2e[pb + k] = tid;
    }
    __syncthreads();
    const int nblk = *(const LAS int*)(lds + LX_NBLK), rbs = G / 4;
    LAS float* rst = (LAS float*)(lds + LX_RST);
    for (int k = 0; k < 6; ++k) { const int rb = c / 4 + k * rbs; if (rb >= nblk) break;
        const int e = blk2e[rb], r = rb * 256 - pstart[e] + (tid & 255);
        if (tid < 256) { const int tk = r < cntl[e] ? tokl[e * 32768 + r] : 0; tok[k * 256 + tid] = tk; rst[k * 256 + tid] = rstdg[tk]; } }
    __syncthreads();
}

#ifndef PHASES
#define PHASES 0xFFFF
#endif
#define PH(n) if constexpr (((PHASES) >> (n)) & 1)
#ifndef REPEAT_MASK
#define REPEAT_MASK 0
#endif
#define REP(k) for (int rep_ = 0; rep_ < 1 + (((REPEAT_MASK) >> (k)) & 1); ++rep_)
#ifndef GEMM_ALIGN
#define GEMM_ALIGN true
#endif
#ifndef GEMM_SP2
#define GEMM_SP2 true
#endif
#define PHASE_ENV() unsigned long long wsi_ = (unsigned long long)args.ws; int G = (int)gridDim.x, bx = (int)blockIdx.x; asm volatile("" : "+s"(wsi_), "+s"(G), "+s"(bx)); \
    unsigned long long obi_ = (unsigned long long)args.out; asm volatile("" : "+s"(obi_)); unsigned char* const outb = (unsigned char*)(GAS unsigned char*)obi_; (void)outb;   \
    unsigned char* const ws = (unsigned char*)(GAS unsigned char*)wsi_; const int vcu = (G % 8 == 0) ? (bx % 8) * (G / 8) + bx / 8 : bx;   \
    int tid = (int)threadIdx.x; asm volatile("" : "+v"(tid)); const int lane = tid & 63, wave = __builtin_amdgcn_readfirstlane(tid >> 6); \
    unsigned* const ctl = (unsigned*)(ws + WS_CTL); bf16_t* const QKV = (bf16_t*)(ws + WS_QKV); unsigned char* const SG = ws + WS_SG; unsigned* const MASK = (unsigned*)(ws + WS_MASK); float* const KMEAN = (float*)(ws + WS_KMEAN); \
    (void)lane; (void)wave; (void)ctl; (void)QKV; (void)SG; (void)MASK; (void)KMEAN; (void)vcu
#define GRID_BAR() do { unsigned long long wb_ = (unsigned long long)args.ws; asm volatile("" : "+s"(wb_)); XcdBarrier b_ = bar0; b_.bar = (unsigned*)((GAS unsigned char*)wb_ + WS_CTL) + CW_BAR; asm volatile("" : "+s"(b_.x)); xcd_barrier(b_); if (((REPEAT_MASK) >> 12) & 1) xcd_barrier(b_); } while (0)


template <int L> __device__ __forceinline__ void layer_body(const Args& args, LAS unsigned char* lds, const XcdBarrier& bar0) {
    constexpr int l = L;

        PH(0) for (int rep_ = 0; rep_ < 1 + ((((REPEAT_MASK) >> 0) & 1) && l == 0); ++rep_) { PHASE_ENV(); p0_phase(args, ws, l, lds, tid, lane, wave, vcu, G); }
        GRID_BAR();
        PH(1) REP(1) { PHASE_ENV();
            pg8::Gemm g{(const bf16_t*)(ws + WS_X16), (const bf16_t*)(ws + WS_WIN), MTOK, NT_IN * 256, DM}; pg8::StaticOrder S; S.init(MTOK, NT_IN * 256, G, bx);
            pg8::EpiInProj E{QKV, SG, (const float*)(ws + WS_COS), (const float*)(ws + WS_SIN), args.in[I_QK_GAIN] + l * 6 * 64, args.in[I_IDX_K_GAIN] + l * 64, (const float*)(ws + WS_RSTD1)};
            pg8::gemm_phase<pg8::EpiInProj, pg8::StaticOrder, GEMM_ALIGN, GEMM_SP2>(lds, g, S, E);
        }
        GRID_BAR();
        { PHASE_ENV();
            LAS float* red = (LAS float*)lds;
            for (int it = bx; it < NBATCH * 4 * 16; it += G) { const int b = it >> 6, h = (it >> 4) & 3, blk = it & 15, d = tid & 63, rg = tid >> 6;
                const bf16_t* kp = QKV + ((size_t)b * SEQ + blk * 256 + rg * 32) * QP + C_KA + 64 * h + d; float s = 0.f;
#pragma unroll 8
                for (int r = 0; r < 32; ++r) s += __builtin_bit_cast(float, (unsigned)kp[(size_t)r * QP] << 16);
                __syncthreads(); red[tid] = s; __syncthreads();
                if (tid < 64) { float t = 0.f;
#pragma unroll
                    for (int k = 0; k < 8; ++k) t += red[k * 64 + tid];
                    KMEAN[(size_t)it * 64 + tid] = t * (1.0f / 256.0f); } }
            __syncthreads();
        }
        PH(2) REP(2) { PHASE_ENV();
            const float* dl = args.in[I_DIFF_LAMBDA] + l * 256;
            const float lam_init = 0.8f - 0.6f * __expf(-0.3f * (float)l);
            const float lam = __expf(wave_sum(dl[lane] * dl[64 + lane])) - __expf(wave_sum(dl[128 + lane] * dl[192 + lane])) + lam_init;
            const float* subg = args.in[I_DIFF_SUBLN] + l * 128;
            unsigned* qc = ctl + CW_QUEUE + 64 * (l * 4 + 0 + 8 * rep_);
            const float* qkg = args.in[I_QK_GAIN] + l * 6 * 64;
            if (softmax_ref0_ok(qkg + 4 * 64, qkg + 5 * 64, lane)) { for (;;) { const int u = next_unit(qc, lds, tid); if (u >= 512) break; const int r = u & 31; attn_c_unit<true>(r >> 2, r & 3, 15 - (u >> 5), QKV, (bf16_t*)(outb + OUT_OC), lam, subg, 1.0f - lam_init, lds, tid, lane, wave); } }
            else { for (;;) { const int u = next_unit(qc, lds, tid); if (u >= 512) break; const int r = u & 31; attn_c_unit<false>(r >> 2, r & 3, 15 - (u >> 5), QKV, (bf16_t*)(outb + OUT_OC), lam, subg, 1.0f - lam_init, lds, tid, lane, wave); } }
        }
        PH(3) REP(3) { PHASE_ENV();
            unsigned* qi = ctl + CW_QUEUE + 64 * (l * 4 + 1 + 8 * rep_);
            for (;;) { const int u = next_unit(qi, lds, tid); if (u >= 512) break; index_unit(u & 7, 63 - (u >> 3), QKV, MASK, bx < 192 ? ws + WS_WGU + (size_t)bx * 524288 : outb + OUT_SCR + (size_t)(bx - 192) * 524288, lds, tid, lane, wave); }
        }
        GRID_BAR();
        PH(4) REP(4) { PHASE_ENV();
            unsigned* qa = ctl + CW_QUEUE + 64 * (l * 4 + 2 + 8 * rep_);
            const float* qkg = args.in[I_QK_GAIN] + l * 6 * 64;
            if (softmax_ref0_ok(qkg, qkg + 64, lane)) { for (;;) { const int u = next_unit(qa, lds, tid); if (u >= 512) break; const int r = u & 31; attn_ab_unit<0, true>(r >> 2, r & 3, 15 - (u >> 5), QKV, (bf16_t*)(outb + OUT_OA), KMEAN, MASK, lds, tid, lane, wave); } }
            else { for (;;) { const int u = next_unit(qa, lds, tid); if (u >= 512) break; const int r = u & 31; attn_ab_unit<0, false>(r >> 2, r & 3, 15 - (u >> 5), QKV, (bf16_t*)(outb + OUT_OA), KMEAN, MASK, lds, tid, lane, wave); } }
        }
        PH(5) REP(5) { PHASE_ENV();
            unsigned* qb = ctl + CW_QUEUE + 64 * (l * 4 + 3 + 8 * rep_);
            const float* qkg = args.in[I_QK_GAIN] + l * 6 * 64;
            if (softmax_ref0_ok(qkg + 2 * 64, qkg + 3 * 64, lane)) { for (;;) { const int u = next_unit(qb, lds, tid); if (u >= 512) break; const int r = u & 31; attn_ab_unit<1, true>(r >> 2, r & 3, 15 - (u >> 5), QKV, (bf16_t*)(outb + OUT_OB), KMEAN, MASK, lds, tid, lane, wave); } }
            else { for (;;) { const int u = next_unit(qb, lds, tid); if (u >= 512) break; const int r = u & 31; attn_ab_unit<1, false>(r >> 2, r & 3, 15 - (u >> 5), QKV, (bf16_t*)(outb + OUT_OB), KMEAN, MASK, lds, tid, lane, wave); } }
        }
        { PHASE_ENV();
            unsigned* qw = ctl + CW_QUEUE + 64 * (16 + l);
            for (;;) { const int c = next_unit(qw, lds, tid); if (c >= (32 * 32 * 16 + 32 * 32 * 8) / 128) break; convert_weights<true>(args, ws, l, lds, lane, wave, vcu, G, c); }
        }
        GRID_BAR();
        PH(6) REP(6) {
            { PHASE_ENV(); pg8::StaticOrder S; S.init(MTOK, DM, G, bx); pg8::Gemm g{(const bf16_t*)(outb + OUT_OA), (const bf16_t*)(ws + WS_WPA), MTOK, DM, 256}; pg8::EpiMerge<0> E{(bf16_t*)(ws + WS_MERGED), SG}; pg8::gemm_phase<pg8::EpiMerge<0>, pg8::StaticOrder, GEMM_ALIGN, GEMM_SP2>(lds, g, S, E); }
            { PHASE_ENV(); pg8::StaticOrder S; S.init(MTOK, DM, G, bx); pg8::Gemm g{(const bf16_t*)(outb + OUT_OB), (const bf16_t*)(ws + WS_WPB), MTOK, DM, 256}; pg8::EpiMerge<1> E{(bf16_t*)(ws + WS_MERGED), SG}; pg8::gemm_phase<pg8::EpiMerge<1>, pg8::StaticOrder, GEMM_ALIGN, GEMM_SP2>(lds, g, S, E); }
            { PHASE_ENV(); pg8::StaticOrder S; S.init(MTOK, DM, G, bx); pg8::Gemm g{(const bf16_t*)(outb + OUT_OC), (const bf16_t*)(ws + WS_WPC), MTOK, DM, 512}; pg8::EpiMerge<2> E{(bf16_t*)(ws + WS_MERGED), SG}; pg8::gemm_phase<pg8::EpiMerge<2>, pg8::StaticOrder, GEMM_ALIGN, GEMM_SP2>(lds, g, S, E); }
        }
        GRID_BAR();
        PH(7) for (int rep_ = 0; rep_ < 1 + ((((REPEAT_MASK) >> 7) & 1) && l == 0); ++rep_) { PHASE_ENV();
            pg8::Gemm g{(const bf16_t*)(ws + WS_MERGED), (const bf16_t*)(ws + WS_WO), MTOK, DM, DM}; pg8::StaticOrder S; S.init(MTOK, DM, G, bx);
            pg8::EpiResid E{ws + WS_X16};
            pg8::gemm_phase<pg8::EpiResid, pg8::StaticOrder, GEMM_ALIGN, GEMM_SP2>(lds, g, S, E);
        }
        GRID_BAR();
        PH(8) REP(8) { PHASE_ENV(); m1_phase(args, ws, l + 2 * rep_, lds, lane, wave, vcu, G); }
        GRID_BAR();
        { PHASE_ENV(); moe_tables(ctl + CW_CNT + 2048 * (l + 2 * (((REPEAT_MASK) >> 8) & 1)), (const int*)(ws + WS_TOKL), (const float*)(ws + WS_RSTD), lds, tid, vcu, G); }
        PH(10) REP(10) { PHASE_ENV();
            const int nblk = *(const LAS int*)(lds + LX_NBLK);
            pg8::Gemm g{(const bf16_t*)(ws + WS_X16), (const bf16_t*)(ws + WS_WGU), MTOK, NEXP * 1024, DM};
            pg8::MoeOrder S{nblk * 4, G, vcu, (const LAS int*)(lds + LX_BLK2E)};
            pg8::EpiGateUp E{(bf16_t*)(ws + WS_HID), (const LAS float*)(lds + LX_RST), G / 4}; pg8::AMapMoe AM{(const LAS int*)(lds + LX_TOK), G / 4};
            pg8::gemm_phase<pg8::EpiGateUp, pg8::MoeOrder, GEMM_ALIGN, GEMM_SP2, pg8::AMapMoe>(lds, g, S, E, AM);
        }
        GRID_BAR();
        PH(11) REP(11) { PHASE_ENV();
            const int nblk = *(const LAS int*)(lds + LX_NBLK);
            pg8::Gemm g{(const bf16_t*)(ws + WS_HID), (const bf16_t*)(ws + WS_WD), MAXBLK * 256, NEXP * 1024, DEXP};
            pg8::MoeOrder S{nblk * 4, G, vcu, (const LAS int*)(lds + LX_BLK2E)};
            pg8::EpiDown E{(bf16_t*)(ws + WS_Y)};
            pg8::gemm_phase<pg8::EpiDown, pg8::MoeOrder, GEMM_ALIGN, GEMM_SP2>(lds, g, S, E);
        }
        GRID_BAR();
    }

__global__ void __launch_bounds__(512, 2) fwd_kernel(Args args) {
    extern __shared__ __attribute__((aligned(16))) unsigned char lds_raw[];
    LAS unsigned char* lds = (LAS unsigned char*)lds_raw;
    for (int u = threadIdx.x; u < (LDS_BYTES - LDSX) / 4; u += 512) ((LAS unsigned*)(lds + LDSX))[u] = 0u;
    __syncthreads();
    const XcdBarrier bar0 = xcd_barrier_post((unsigned*)(args.ws + WS_CTL) + CW_BAR, (volatile LAS unsigned*)(lds + LX_BAR));
    layer_body<0>(args, lds, bar0);
    layer_body<1>(args, lds, bar0);
    { PHASE_ENV();
        const int gw = vcu * 8 + wave, NGW = G * 8; const LAS int* pstart = (const LAS int*)(lds + LX_PSTART);
        for (int m = gw; m < MTOK; m += NGW) token_row<false, true, true>(nullptr, ws + WS_X16, args.out, (const bf16_t*)(ws + WS_Y), (const unsigned*)(ws + WS_RT0), (const unsigned*)(ws + WS_RT1), (const f32x2*)(ws + WS_RTW), pstart, nullptr, m, lane);
    }
}

extern "C" void kernel_launch(void* const* d_in, const int* in_sizes, int n_in, void* d_out, int out_size, void* d_ws, size_t ws_size, hipStream_t stream) {
    static int grid = 0;
    if (grid == 0) {
        if (n_in != N_INPUTS || in_sizes[0] != MTOK * DM || out_size != MTOK * DM || ws_size < WS_END) {
            fprintf(stderr, "kernel_launch: built for %d inputs, x/out of %d floats, >= %zu bytes of workspace; got n_in %d, in0 %d, out %d, ws %zu; nothing launched\n", (int)N_INPUTS, MTOK * DM, (size_t)WS_END, n_in, n_in > 0 ? in_sizes[0] : -1, out_size, ws_size);
            grid = -1; return; }
        int dev = 0, cus = 0;
        if (hipGetDevice(&dev) != hipSuccess || hipDeviceGetAttribute(&cus, hipDeviceAttributeMultiprocessorCount, dev) != hipSuccess) { fprintf(stderr, "kernel_launch: device query failed\n"); grid = -1; return; }
        if (hipFuncSetAttribute((const void*)fwd_kernel, hipFuncAttributeMaxDynamicSharedMemorySize, LDS_BYTES) != hipSuccess) { fprintf(stderr, "kernel_launch: hipFuncSetAttribute failed\n"); grid = -1; return; }
        int per_cu = 0;
        if (hipOccupancyMaxActiveBlocksPerMultiprocessor(&per_cu, (const void*)fwd_kernel, 512, LDS_BYTES) != hipSuccess || per_cu < 1) fprintf(stderr, "kernel_launch: note: occupancy query reports %d workgroups per CU\n", per_cu);
        (void)hipGetLastError();
        grid = cus < 256 ? cus : 256;
    }
    if (grid < 0) return;
    if (hipMemsetAsync((char*)d_ws + WS_CTL, 0, CTL_BYTES, stream) != hipSuccess) { fprintf(stderr, "kernel_launch: memset failed\n"); return; }
    Args a{};
    for (int i = 0; i < N_INPUTS; ++i) a.in[i] = (const float*)d_in[i];
    a.out = (float*)d_out; a.ws = (unsigned char*)d_ws;
    hipLaunchKernelGGL(fwd_kernel, dim3(grid), dim3(512), LDS_BYTES, stream, a);
    const hipError_t le = hipPeekAtLastError();
    if (le != hipSuccess) fprintf(stderr, "kernel_launch: launch failed: %s\n", hipGetErrorName(le));
}
```

```cpp
#include <hip/hip_runtime.h>
#include <cstdio>
#include <cstdint>

#define LAS __attribute__((address_space(3)))
#define GAS __attribute__((address_space(1)))
typedef unsigned short bf16_t;
typedef short bf16x8 __attribute__((ext_vector_type(8)));
typedef short s16x4 __attribute__((ext_vector_type(4)));
typedef float f32x4 __attribute__((ext_vector_type(4)));
typedef float f32x2 __attribute__((ext_vector_type(2)));
typedef float f32x16 __attribute__((ext_vector_type(16)));
typedef unsigned u32x4 __attribute__((ext_vector_type(4)));
typedef unsigned u32x2 __attribute__((ext_vector_type(2)));

constexpr int NBATCH = 8, SEQ = 4096, MTOK = NBATCH * SEQ, DM = 1024, NLAYER = 2;
constexpr int QP = 3656;
constexpr int C_QA = 0, C_KA = 256, C_VA = 512, C_QB = 768, C_KB = 1024, C_VB = 1280, C_QI = 1536, C_KI = 2048, C_WI = 2112,
              C_Q1 = 2120, C_Q2 = 2376, C_K1 = 2632, C_K2 = 2888, C_VC = 3144, C_G = 3656, D_IN = 6728;
constexpr int NT_IN = 27;
constexpr int NEXP = 32, DEXP = 512, MAXBLK = 288;
constexpr float C2 = 0.125f * 1.4426950408889634f;
constexpr float EPS = 1e-6f;
#ifndef REF0_ENABLE
#define REF0_ENABLE 1
#endif

constexpr size_t MiB = 1u << 20;
constexpr size_t WS_CTL = 0, CTL_BYTES = 1 * MiB;
constexpr size_t WS_COS = 1 * MiB, WS_SIN = WS_COS + 512 * 1024;
constexpr size_t WS_SMALL = 2 * MiB;
constexpr size_t WS_RSTD1 = WS_SMALL + 128 * 1024;
constexpr size_t WS_KMEAN = WS_SMALL, WS_RT0 = WS_SMALL + 256 * 1024, WS_RT1 = WS_SMALL + 384 * 1024, WS_RTW = WS_SMALL + 512 * 1024, WS_WRT = WS_SMALL + 768 * 1024;
constexpr size_t WS_WIN = 3 * MiB;
constexpr size_t WS_WPA = 17 * MiB, WS_WPB = WS_WPA + 512 * 1024, WS_WPC = 18 * MiB;
constexpr size_t WS_WO = 19 * MiB;
constexpr size_t WS_WGU = 21 * MiB;
constexpr size_t WS_WD = 85 * MiB;
constexpr size_t WS_X16 = 117 * MiB;
constexpr size_t OUT_OA = 0, OUT_OB = 16 * MiB, OUT_OC = 32 * MiB, OUT_SCR = 64 * MiB;
constexpr size_t WS_QKV = 181 * MiB;
constexpr size_t WS_MERGED = WS_QKV, WS_Y = WS_QKV, WS_HID = WS_QKV + 144 * MiB;
constexpr size_t WS_TOKL = WS_QKV + 64 * MiB, WS_RSTD = WS_QKV + 68 * MiB;
constexpr size_t WS_SG = 410 * MiB;
constexpr size_t WS_MASK = 506 * MiB;
constexpr size_t WS_END = 522 * MiB;
static_assert((size_t)MTOK * QP * 2 <= 229 * MiB && (size_t)MAXBLK * 256 * 1024 * 2 <= 144 * MiB && (size_t)MAXBLK * 256 * 512 * 2 <= 72 * MiB, "ws map");
constexpr int CW_BAR = 4096;
constexpr int CW_QUEUE = 8192;
constexpr int CW_CNT = 16384;

constexpr int LDSX = 131072;
constexpr int LX_BAR = LDSX, LX_BC = LDSX + 16, LX_NBLK = LDSX + 32, LX_PSTART = LDSX + 64, LX_BLK2E = LDSX + 256, LX_CNT = LDSX + 1536, LX_TOK = LDSX + 2048, LX_RST = LDSX + 2048 + 6144;
constexpr int LDS_BYTES = 147456;

typedef __bf16 bf16x2_t __attribute__((ext_vector_type(2)));
__device__ __forceinline__ unsigned cvt_pk_bf16(float lo, float hi) { const f32x2 v = {lo, hi}; const bf16x2_t b = __builtin_convertvector(v, bf16x2_t); return __builtin_bit_cast(unsigned, b); }
typedef _Float16 f16x2_t __attribute__((ext_vector_type(2)));
__device__ __forceinline__ unsigned cvt_pk_f16(float lo, float hi) { const f32x2 v = {__builtin_amdgcn_fmed3f(lo, -65504.f, 65504.f), __builtin_amdgcn_fmed3f(hi, -65504.f, 65504.f)}; return __builtin_bit_cast(unsigned, __builtin_convertvector(v, f16x2_t)); }
__device__ __forceinline__ float h_lo(unsigned w) { return (float)__builtin_bit_cast(f16x2_t, w)[0]; }
__device__ __forceinline__ float h_hi(unsigned w) { return (float)__builtin_bit_cast(f16x2_t, w)[1]; }
__device__ __forceinline__ float bf_lo(unsigned w) { return __builtin_bit_cast(float, w << 16); }
__device__ __forceinline__ float bf_hi(unsigned w) { return __builtin_bit_cast(float, w & 0xffff0000u); }
template <int M> __device__ __forceinline__ float xor_lane(float v) {
    return __builtin_bit_cast(float, __builtin_amdgcn_ds_swizzle(__builtin_bit_cast(int, v), (M << 10) | 0x1f)); }
__device__ __forceinline__ float sum_xor32(float v) {
    const unsigned u = __builtin_bit_cast(unsigned, v); const auto rr = __builtin_amdgcn_permlane32_swap(u, u, false, false);
    return __builtin_bit_cast(float, (unsigned)rr[0]) + __builtin_bit_cast(float, (unsigned)rr[1]); }
__device__ __forceinline__ float max_xor32(float v) {
    const unsigned u = __builtin_bit_cast(unsigned, v); const auto rr = __builtin_amdgcn_permlane32_swap(u, u, false, false);
    return fmaxf(__builtin_bit_cast(float, (unsigned)rr[0]), __builtin_bit_cast(float, (unsigned)rr[1])); }
__device__ __forceinline__ int lane_val(int v, int src_lane) { return __builtin_amdgcn_ds_bpermute(src_lane << 2, v); }
__device__ __forceinline__ float wave_sum(float v) {
    v += xor_lane<1>(v); v += xor_lane<2>(v); v += xor_lane<4>(v); v += xor_lane<8>(v); v += xor_lane<16>(v);
    return sum_xor32(v);
}
__device__ __forceinline__ float fast_exp2(float x) { return __builtin_amdgcn_exp2f(x); }
__device__ __forceinline__ float fast_rcp(float x) { return __builtin_amdgcn_rcpf(x); }

namespace pg8 {
#define PG8_LAS __attribute__((address_space(3)))
typedef unsigned short bf16_t;
typedef short bf16x8 __attribute__((ext_vector_type(8)));
typedef float f32x4 __attribute__((ext_vector_type(4)));
typedef unsigned u32x4 __attribute__((ext_vector_type(4)));
constexpr int BM = 256, BK = 64, HALF = 128, HTB = HALF * BK * 2  , STAGE_BYTES = 8 * HTB, NXCD = 8, WGM = 8;

__host__ __device__ __forceinline__ int lds_byte(int r, int c) { const int st = (r >> 4) * 2 + (c >> 5), rr = r & 15, cc = c & 31, ob = rr * 64 + cc * 2; return st * 1024 + (ob ^ (((ob >> 9) & 1) << 5)); }
__host__ __device__ __forceinline__ void stage_rc(int b, int& R, int& C) { const int st = b / 1024, sb = b % 1024, swz = sb ^ (((sb >> 9) & 1) << 5); R = (st >> 1) * 16 + swz / 64; C = (st & 1) * 32 + (swz % 64) / 2; }
__host__ __device__ __forceinline__ int perm32(int rho) { const int n = rho >> 4, i = rho & 15; return 8 * (i >> 2) + 4 * n + (i & 3); }
struct Unit { int pm, pn; };
struct Gemm { const bf16_t* A; const bf16_t* Bt; int M, N, K; };

struct StaticOrder {
    int nM, nN, nwg, G, c;
    __host__ __device__ void init(int M, int N, int G_, int c_) { nM = M / BM; nN = N / BM; nwg = nM * nN; G = G_; c = c_; }
    __host__ __device__ bool next(int i, Unit& u) const {
        const long L = (long)i * G + c; if (L >= nwg) return false;
        int wgid = (int)L; { const int q = nwg / NXCD, r = nwg % NXCD, xcd = wgid % NXCD, off = wgid / NXCD; wgid = (xcd < r ? xcd * (q + 1) : r * (q + 1) + (xcd - r) * q) + off; }
        const int nig = WGM * nN, gid = wgid / nig, fm = gid * WGM, gsz = (nM - fm) < WGM ? (nM - fm) : WGM;
        u.pm = fm + ((wgid % nig) % gsz); u.pn = (wgid % nig) / gsz; return true;
    }
    __device__ __forceinline__ void a_ready(const Unit&) const {}
    __device__ __forceinline__ void done(const Unit&) const {}
};
struct OneUnit {
    StaticOrder S; int i;
    __device__ __forceinline__ bool next(int k, Unit& u) const { return k == 0 && S.next(i, u); }
    __device__ __forceinline__ void a_ready(const Unit&) const {}
    __device__ __forceinline__ void done(const Unit&) const {}
};


struct EpiInProj {
    static constexpr bool PERM = false, AFTER_DRAIN = false, F16 = true;
    bf16_t* qkv; unsigned char* sg; const float* cosT; const float* sinT; const float* qkg; const float* ikg; const float* rstd;
    __device__ __forceinline__ void operator()(const f32x4 (&acc)[2][2][4][2], const Unit& u, int wr, int wc, int fr, int fq) const {
        const int pn = u.pn, row0 = u.pm * BM + wr * 64 + fr;
        if (pn >= 15) {
            unsigned char* base = sg + (size_t)row0 * 3072 + (pn - 15) * 256 + wc * 64 + fq * 16;
#pragma unroll
            for (int ai = 0; ai < 2; ++ai)
#pragma unroll
                for (int m = 0; m < 4; ++m) {
                    unsigned w[2][2]; const float rs = -1.4426950408889634f * rstd[row0 + ai * HALF + m * 16];
#pragma unroll
                    for (int bj = 0; bj < 2; ++bj)
#pragma unroll
                        for (int n = 0; n < 2; ++n) { unsigned pk = 0;
#pragma unroll
                            for (int i = 0; i < 4; i += 2) { const float x0 = fminf(fmaxf(acc[ai][bj][m][n][i] * rs, -43.f), 43.f), x1 = fminf(fmaxf(acc[ai][bj][m][n][i + 1] * rs, -43.f), 43.f);
                                const float a = 1.0f + fast_exp2(x0), b = 1.0f + fast_exp2(x1), r = 255.0f * fast_rcp(a * b);
                                pk = __builtin_amdgcn_cvt_pk_u8_f32(floorf(b * r + 0.5f), i, pk); pk = __builtin_amdgcn_cvt_pk_u8_f32(floorf(a * r + 0.5f), i + 1, pk); }
                            w[bj][n] = pk; }
                    *(u32x4*)(base + (size_t)(ai * HALF + m * 16) * 3072) = (u32x4){w[0][0], w[0][1], w[1][0], w[1][1]};
                }
            return;
        }
        int type = 0, gi = 0; bool qscale = false;
        int ocol = (pn < 8 ? 256 * pn : C_Q1 + 256 * (pn - 9)) + 64 * wc;
        switch (pn) {
            case 0: type = 2; gi = 0; qscale = true; break;
            case 1: type = 2; gi = 1; break;
            case 3: type = 2; gi = 2; qscale = true; break;
            case 4: type = 2; gi = 3; break;
            case 6: case 7: type = 1; break;
            case 8: if (wc == 0) { type = 2; ocol = C_KI; } else if (wc == 1) { type = 3; ocol = C_WI; } else type = 4; break;
            case 9: case 10: type = 2; gi = 4; qscale = true; break;
            case 11: case 12: type = 2; gi = 5; break;
            default: type = 0; break;
        }
        if (type == 4) return;
        if (type == 3) {
            if (fq == 0) {
#pragma unroll
                for (int ai = 0; ai < 2; ++ai)
#pragma unroll
                    for (int m = 0; m < 4; ++m) { const float rs = 0.35355339059327373f * rstd[row0 + ai * HALF + m * 16]; const f32x4 a = acc[ai][0][m][0] * rs, b = acc[ai][0][m][1] * rs;
                        *(u32x4*)(qkv + (size_t)(row0 + ai * HALF + m * 16) * QP + C_WI) = (u32x4){cvt_pk_bf16(a[0], a[1]), cvt_pk_bf16(a[2], a[3]), cvt_pk_bf16(b[0], b[1]), cvt_pk_bf16(b[2], b[3])}; }
            }
            return;
        }
        const float* gp = (pn == 8) ? ikg : qkg + 64 * gi;
        if (type == 2) { if (qscale) body<2, true>(acc, row0, ocol, gp, fq); else body<2, false>(acc, row0, ocol, gp, fq); }
        else if (type == 1) body<1, false>(acc, row0, ocol, gp, fq);
        else body<0, false>(acc, row0, ocol, gp, fq);
    }
    template <int TYPE, bool QS>
    __device__ __forceinline__ void body(const f32x4 (&acc)[2][2][4][2], int row0, int ocol, const float* gp, int fq) const {
#pragma unroll
        for (int ai = 0; ai < 2; ++ai)
#pragma unroll
            for (int m = 0; m < 4; ++m) {
                const int row = row0 + ai * HALF + m * 16; const float rs = rstd[row];
                f32x4 x[2][2];
#pragma unroll
                for (int bj = 0; bj < 2; ++bj)
#pragma unroll
                    for (int n = 0; n < 2; ++n) x[bj][n] = acc[ai][bj][m][n] * rs;
                if (TYPE == 2) {
                    float ss = 0.f;
#pragma unroll
                    for (int bj = 0; bj < 2; ++bj)
#pragma unroll
                        for (int n = 0; n < 2; ++n) ss += (x[bj][n][0] * x[bj][n][0] + x[bj][n][1] * x[bj][n][1]) + (x[bj][n][2] * x[bj][n][2] + x[bj][n][3] * x[bj][n][3]);
                    ss += xor_lane<16>(ss); ss = sum_xor32(ss);
                    const float inv = (QS ? C2 : 1.0f) / sqrtf(ss * (1.0f / 64.0f) + EPS);
#pragma unroll
                    for (int bj = 0; bj < 2; ++bj)
#pragma unroll
                        for (int n = 0; n < 2; ++n) x[bj][n] = x[bj][n] * inv * *(const f32x4*)(gp + 32 * bj + 8 * fq + 4 * n);
                }
                if (TYPE >= 1) {
                    const int pos = row & (SEQ - 1);
#pragma unroll
                    for (int n = 0; n < 2; ++n) {
                        const f32x4 c = *(const f32x4*)(cosT + pos * 32 + 8 * fq + 4 * n), s = *(const f32x4*)(sinT + pos * 32 + 8 * fq + 4 * n);
                        const f32x4 a = x[0][n], b = x[1][n];
                        x[0][n] = a * c - b * s; x[1][n] = b * c + a * s;
                    }
                }
#pragma unroll
                for (int bj = 0; bj < 2; ++bj)
                    *(u32x4*)(qkv + (size_t)row * QP + ocol + 32 * bj + 8 * fq) = (u32x4){cvt_pk_bf16(x[bj][0][0], x[bj][0][1]), cvt_pk_bf16(x[bj][0][2], x[bj][0][3]), cvt_pk_bf16(x[bj][1][0], x[bj][1][1]), cvt_pk_bf16(x[bj][1][2], x[bj][1][3])};
                asm volatile("" ::: "memory");
            }
    }
};

template <int BR> struct EpiMerge {
    static constexpr bool PERM = false, AFTER_DRAIN = false, F16 = false;
    bf16_t* merged; const unsigned char* sg;
    __device__ __forceinline__ void operator()(const f32x4 (&acc)[2][2][4][2], const Unit& u, int wr, int wc, int fr, int fq) const {
        const int row0 = u.pm * BM + wr * 64 + fr, col0 = u.pn * BM + wc * 64 + fq * 16;
#pragma unroll
        for (int ai = 0; ai < 2; ++ai)
#pragma unroll
            for (int m = 0; m < 4; ++m) { const size_t row = (size_t)(row0 + ai * HALF + m * 16);
                const u32x4 gq = *(const u32x4*)(sg + row * 3072 + BR * 1024 + col0);
                bf16_t* mp = merged + row * 1024 + col0;
                float v[16];
#pragma unroll
                for (int bj = 0; bj < 2; ++bj)
#pragma unroll
                    for (int n = 0; n < 2; ++n)
#pragma unroll
                        for (int i = 0; i < 4; ++i) v[8 * bj + 4 * n + i] = acc[ai][bj][m][n][i] * ((float)((gq[2 * bj + n] >> (8 * i)) & 255u) * (1.0f / 255.0f));
                if (BR > 0) { const u32x4 o0 = *(const u32x4*)mp, o1 = *(const u32x4*)(mp + 8);
#pragma unroll
                    for (int k = 0; k < 4; ++k) { v[2 * k] += bf_lo(o0[k]); v[2 * k + 1] += bf_hi(o0[k]); v[8 + 2 * k] += bf_lo(o1[k]); v[8 + 2 * k + 1] += bf_hi(o1[k]); } }
                *(u32x4*)mp = (u32x4){cvt_pk_bf16(v[0], v[1]), cvt_pk_bf16(v[2], v[3]), cvt_pk_bf16(v[4], v[5]), cvt_pk_bf16(v[6], v[7])};
                *(u32x4*)(mp + 8) = (u32x4){cvt_pk_bf16(v[8], v[9]), cvt_pk_bf16(v[10], v[11]), cvt_pk_bf16(v[12], v[13]), cvt_pk_bf16(v[14], v[15])};
                asm volatile("" ::: "memory"); }
    }
};

struct EpiResid {
    static constexpr bool PERM = false, AFTER_DRAIN = false, F16 = false;
    unsigned char* x16;
    __device__ __forceinline__ void operator()(const f32x4 (&acc)[2][2][4][2], const Unit& u, int wr, int wc, int fr, int fq) const {
        const int row0 = u.pm * BM + wr * 64 + fr, col0 = u.pn * BM + wc * 32 + fq * 8;
#pragma unroll
        for (int ai = 0; ai < 2; ++ai)
#pragma unroll
            for (int m = 0; m < 4; ++m) { unsigned char* xp = x16 + ((size_t)(row0 + ai * HALF + m * 16) * 1024 + col0) * 2;
#pragma unroll
                for (int bj = 0; bj < 2; ++bj) { const u32x4 r = *(const u32x4*)(xp + bj * HALF * 2); const f32x4 a = acc[ai][bj][m][0], b = acc[ai][bj][m][1];
                    *(u32x4*)(xp + bj * HALF * 2) = (u32x4){cvt_pk_f16(h_lo(r[0]) + a[0], h_hi(r[0]) + a[1]), cvt_pk_f16(h_lo(r[1]) + a[2], h_hi(r[1]) + a[3]), cvt_pk_f16(h_lo(r[2]) + b[0], h_hi(r[2]) + b[1]), cvt_pk_f16(h_lo(r[3]) + b[2], h_hi(r[3]) + b[3])}; }
                if (m & 1) asm volatile("" ::: "memory"); }
    }
};

struct EpiGateUp {
    static constexpr bool PERM = false, AFTER_DRAIN = false, F16 = true;
    bf16_t* hid; const PG8_LAS float* rst; int rbs;
    __device__ __forceinline__ void operator()(const f32x4 (&acc)[2][2][4][2], const Unit& u, int wr, int wc, int fr, int fq) const {
        const int row0 = u.pm * BM + wr * 64 + fr, col0 = (u.pn & 3) * HALF + wc * 32 + fq * 8;
        const PG8_LAS float* rs = rst + (u.pm / rbs) * 256 + wr * 64 + fr;
#pragma unroll
        for (int ai = 0; ai < 2; ++ai)
#pragma unroll
            for (int m = 0; m < 4; ++m) { float v[8]; const float r = rs[ai * HALF + m * 16];
#pragma unroll
                for (int n = 0; n < 2; ++n)
#pragma unroll
                    for (int i = 0; i < 4; ++i) { const float gt = acc[ai][0][m][n][i] * r, up = acc[ai][1][m][n][i] * r; v[4 * n + i] = gt * fast_rcp(1.0f + fast_exp2(-1.4426950408889634f * gt)) * up; }
                *(u32x4*)(hid + (size_t)(row0 + ai * HALF + m * 16) * DEXP + col0) = (u32x4){cvt_pk_bf16(v[0], v[1]), cvt_pk_bf16(v[2], v[3]), cvt_pk_bf16(v[4], v[5]), cvt_pk_bf16(v[6], v[7])}; }
    }
};

struct EpiDown {
    static constexpr bool PERM = false, AFTER_DRAIN = false, F16 = false;
    bf16_t* y;
    __device__ __forceinline__ void operator()(const f32x4 (&acc)[2][2][4][2], const Unit& u, int wr, int wc, int fr, int fq) const {
        const int row0 = u.pm * BM + wr * 64 + fr, col0 = (u.pn & 3) * BM + wc * 64 + fq * 16;
#pragma unroll
        for (int ai = 0; ai < 2; ++ai)
#pragma unroll
            for (int m = 0; m < 4; ++m) { bf16_t* yp = y + (size_t)(row0 + ai * HALF + m * 16) * 1024 + col0;
#pragma unroll
                for (int bj = 0; bj < 2; ++bj) { const f32x4 a = acc[ai][bj][m][0], b = acc[ai][bj][m][1];
                    *(u32x4*)(yp + 8 * bj) = (u32x4){cvt_pk_bf16(a[0], a[1]), cvt_pk_bf16(a[2], a[3]), cvt_pk_bf16(b[0], b[1]), cvt_pk_bf16(b[2], b[3])}; } }
    }
};

struct AMapMoe { static constexpr bool GATHER = true; const PG8_LAS int* tok; int rbs;
    __device__ __forceinline__ unsigned row(const Unit& u, int R) const { return (unsigned)tok[(u.pm / rbs) * 256 + R]; } };
struct MoeOrder {
    int nunits, G, c; const PG8_LAS int* blk2e;
    __device__ __forceinline__ bool next(int i, Unit& u) const { const int L = i * G + c; if (L >= nunits) return false; const int rb = L >> 2; u.pm = rb; u.pn = blk2e[rb] * 4 + (L & 3); return true; }
    __device__ __forceinline__ void a_ready(const Unit&) const {}
    __device__ __forceinline__ void done(const Unit&) const {}
};

typedef _Float16 f16x8 __attribute__((ext_vector_type(8)));
template <bool F16> __device__ __forceinline__ f32x4 mma16x(bf16x8 a, bf16x8 b, f32x4 c) {
    if constexpr (F16) return __builtin_amdgcn_mfma_f32_16x16x32_f16(__builtin_bit_cast(f16x8, a), __builtin_bit_cast(f16x8, b), c, 0, 0, 0);
    else return __builtin_amdgcn_mfma_f32_16x16x32_bf16(a, b, c, 0, 0, 0); }
struct NoAMap { static constexpr bool GATHER = false; __device__ __forceinline__ unsigned row(const Unit&, int) const { return 0u; } };
template <class Epi, class Sched, bool ALIGN_EPI = false, bool SP2 = false, class AMap = NoAMap>
__device__ __forceinline__ void gemm_phase(PG8_LAS unsigned char* lds, const Gemm g, const Sched& S, const Epi& E, const AMap& AM = AMap()) {
    static_assert(!AMap::GATHER || SP2, "the row gather is wired into the SP2 loop only");
#define mma16 mma16x<Epi::F16>
    int tid_l = (int)threadIdx.x; asm volatile("" : "+v"(tid_l));
    const int tid = tid_l, wid = __builtin_amdgcn_readfirstlane(tid >> 6), lane = tid & 63, wr = wid >> 2, wc = wid & 3, fr = lane & 15, fq = lane >> 4;
    const int K = g.K, nt = K / BK;
    unsigned voffA[2], voffB[2];
#pragma unroll
    for (int i = 0; i < 2; ++i) { int R, C; stage_rc(tid * 16 + i * 8192, R, C); const int Rb = Epi::PERM ? ((R & ~31) + perm32(R & 31)) : R;
        voffA[i] = (unsigned)(R * K + C) * 2u; voffB[i] = (unsigned)(Rb * K + C) * 2u; }
    int RA[2], CA[2];
#pragma unroll
    for (int i = 0; i < 2; ++i) stage_rc(tid * 16 + i * 8192, RA[i], CA[i]);
    unsigned vC0[2] = {0u, 0u}, vC1[2] = {0u, 0u}, vN0[2] = {0u, 0u}, vN1[2] = {0u, 0u};
#define PG8_AOFFS(v0, v1, unit) do { if constexpr (AMap::GATHER) { _Pragma("unroll") for (int _i = 0; _i < 2; ++_i) { \
        v0[_i] = (AM.row(unit, RA[_i]) * (unsigned)K + (unsigned)CA[_i]) * 2u; v1[_i] = (AM.row(unit, HALF + RA[_i]) * (unsigned)K + (unsigned)CA[_i]) * 2u; } } } while (0)
#define PG8_STAGE_A(bufoff, base, half, usenext) do { if constexpr (AMap::GATHER) { unsigned vv_[2]; _Pragma("unroll") for (int _j = 0; _j < 2; ++_j) vv_[_j] = (usenext) ? ((half) ? vN1[_j] : vN0[_j]) : ((half) ? vC1[_j] : vC0[_j]); \
        PG8_STAGE(bufoff, base, vv_); } else { PG8_STAGE(bufoff, (base) + (half) * hstep, voffA); } } while (0)
    const size_t kstep = (size_t)(BK * 2);
    const size_t hstep = (size_t)HALF * K * 2;
    const size_t tstep = 2 * hstep;
    const unsigned ldsw = (unsigned)wid * 1024u;
    const int aoff = lds_byte(wr * 64 + fr, fq * 8), boff = lds_byte(wc * 32 + fr, fq * 8);
#define PG8_SA(b, h) (((b) * 2 + (h)) * HTB)
#define PG8_SB(b, h) ((4 + (b) * 2 + (h)) * HTB)
#define PG8_STAGE(bufoff, gbase, voff) do { _Pragma("unroll") for (int _i = 0; _i < 2; ++_i) \
        __builtin_amdgcn_global_load_lds((const unsigned*)((const char*)(gbase) + (voff)[_i]), (PG8_LAS unsigned*)(lds + (bufoff) + ldsw + _i * 8192), 16, 0, 0); } while (0)
#define PG8_LDA(dst, b, h) do { _Pragma("unroll") for (int m = 0; m < 4; ++m) _Pragma("unroll") for (int k = 0; k < 2; ++k) dst[m][k] = *(const PG8_LAS bf16x8*)(lds + PG8_SA(b, h) + aoff + m * 2048 + k * 1024); } while (0)
#define PG8_LDB(dst, b, h) do { _Pragma("unroll") for (int n = 0; n < 2; ++n) _Pragma("unroll") for (int k = 0; k < 2; ++k) dst[n][k] = *(const PG8_LAS bf16x8*)(lds + PG8_SB(b, h) + boff + n * 2048 + k * 1024); } while (0)
#define PG8_MMA(ai, bj, At, Bt) do { __builtin_amdgcn_s_setprio(1); _Pragma("unroll") for (int m = 0; m < 4; ++m) _Pragma("unroll") for (int n = 0; n < 2; ++n) _Pragma("unroll") for (int k = 0; k < 2; ++k) \
        acc[ai][bj][m][n] = mma16(Bt[n][k], At[m][k], acc[ai][bj][m][n]); __builtin_amdgcn_s_setprio(0); } while (0)
#define PG8_WAIT_V(n) asm volatile("s_waitcnt vmcnt(" #n ")" ::: "memory")
#define PG8_WAIT_L(n) asm volatile("s_waitcnt lgkmcnt(" #n ")" ::: "memory")
#define PG8_BAR __builtin_amdgcn_s_barrier()
#define PG8_SCHED __builtin_amdgcn_sched_barrier(0)
    Unit cur, nxt; int ui = 0;
    if (!S.next(0, cur)) return;
    f32x4 acc[2][2][4][2];
#pragma unroll
    for (int a = 0; a < 2; ++a)
#pragma unroll
        for (int b = 0; b < 2; ++b)
#pragma unroll
            for (int m = 0; m < 4; ++m)
#pragma unroll
                for (int n = 0; n < 2; ++n) acc[a][b][m][n] = (f32x4){0.f, 0.f, 0.f, 0.f};
    bf16x8 At[4][2], B0[2][2], B1[2][2];
    const char* cA = (const char*)g.A + (AMap::GATHER ? (size_t)0 : (size_t)cur.pm * tstep); const char* cB = (const char*)g.Bt + (size_t)cur.pn * tstep;
    PG8_AOFFS(vC0, vC1, cur);
    S.a_ready(cur);
    if constexpr (SP2) {
        PG8_STAGE(PG8_SB(0, 0), cB, voffB); PG8_STAGE(PG8_SB(0, 1), cB + hstep, voffB); PG8_STAGE_A(PG8_SA(0, 0), cA, 0, false); PG8_STAGE_A(PG8_SA(0, 1), cA, 1, false);
        if (wr == 1) PG8_BAR;
        PG8_WAIT_V(2); PG8_BAR;
        PG8_STAGE(PG8_SB(1, 0), cB + kstep, voffB); PG8_STAGE_A(PG8_SA(1, 0), cA + kstep, 0, false); PG8_STAGE(PG8_SB(1, 1), cB + hstep + kstep, voffB);
        PG8_WAIT_V(6); PG8_BAR;
    } else {
        PG8_STAGE(PG8_SB(0, 0), cB, voffB); PG8_STAGE(PG8_SA(0, 0), cA, voffA); PG8_STAGE(PG8_SB(0, 1), cB + hstep, voffB); PG8_STAGE(PG8_SA(0, 1), cA + hstep, voffA);
        if (wr == 1) PG8_BAR;
        PG8_WAIT_V(4); PG8_BAR;
        PG8_STAGE(PG8_SB(1, 0), cB + kstep, voffB); PG8_STAGE(PG8_SA(1, 0), cA + kstep, voffA); PG8_STAGE(PG8_SB(1, 1), cB + hstep + kstep, voffB);
        PG8_WAIT_V(6); PG8_BAR;
    }
    for (;;) {
        const bool has_next = S.next(ui + 1, nxt);
        const char* nA = (has_next && !AMap::GATHER) ? (const char*)g.A + (size_t)nxt.pm * tstep : cA; const char* nB = has_next ? (const char*)g.Bt + (size_t)nxt.pn * tstep : cB;
        if constexpr (AMap::GATHER) { if (has_next) PG8_AOFFS(vN0, vN1, nxt); else { vN0[0] = vC0[0]; vN0[1] = vC0[1]; vN1[0] = vC1[0]; vN1[1] = vC1[1]; } }
#pragma unroll 1
        for (int t = 0; t < nt; t += 2) {
            const bool last = (t == nt - 2);
            const char* a1 = cA + (size_t)(t + 1) * kstep;
            const char* a2 = last ? nA : cA + (size_t)(t + 2) * kstep; const char* b2 = last ? nB : cB + (size_t)(t + 2) * kstep;
            const char* a3 = a2 + kstep; const char* b3 = b2 + kstep;
            if (last && has_next) S.a_ready(nxt);
            if constexpr (SP2) {
            PG8_LDB(B0, 0, 0); PG8_LDB(B1, 0, 1); PG8_SCHED; PG8_LDA(At, 0, 0); PG8_STAGE_A(PG8_SA(1, 1), a1, 1, false);
            PG8_WAIT_V(8); PG8_WAIT_L(0); PG8_BAR; PG8_MMA(0, 0, At, B0); PG8_MMA(0, 1, At, B1); PG8_BAR; PG8_SCHED;
            PG8_LDA(At, 0, 1); PG8_STAGE(PG8_SB(0, 0), b2, voffB); PG8_STAGE(PG8_SB(0, 1), b2 + hstep, voffB); PG8_STAGE_A(PG8_SA(0, 0), a2, 0, last);
            PG8_WAIT_V(8); PG8_WAIT_L(0); PG8_BAR; PG8_MMA(1, 0, At, B0); PG8_MMA(1, 1, At, B1); PG8_BAR; PG8_SCHED;
            PG8_LDB(B0, 1, 0); PG8_LDB(B1, 1, 1); PG8_SCHED; PG8_LDA(At, 1, 0); PG8_STAGE_A(PG8_SA(0, 1), a2, 1, last);
            PG8_WAIT_V(8); PG8_WAIT_L(0); PG8_BAR; PG8_MMA(0, 0, At, B0); PG8_MMA(0, 1, At, B1); PG8_BAR; PG8_SCHED;
            PG8_LDA(At, 1, 1); PG8_STAGE(PG8_SB(1, 0), b3, voffB); PG8_STAGE(PG8_SB(1, 1), b3 + hstep, voffB); PG8_STAGE_A(PG8_SA(1, 0), a3, 0, last);
            PG8_WAIT_V(8); PG8_WAIT_L(0); PG8_BAR; PG8_MMA(1, 0, At, B0); PG8_MMA(1, 1, At, B1); PG8_BAR; PG8_SCHED;
            } else {
            PG8_LDB(B0, 0, 0); PG8_SCHED; PG8_LDA(At, 0, 0); PG8_STAGE(PG8_SA(1, 1), a1 + hstep, voffA);
            PG8_WAIT_L(8); PG8_BAR; PG8_WAIT_L(0); PG8_MMA(0, 0, At, B0); PG8_BAR; PG8_SCHED;
            PG8_LDB(B1, 0, 1); PG8_STAGE(PG8_SB(0, 0), b2, voffB);
            PG8_BAR; PG8_WAIT_L(0); PG8_MMA(0, 1, At, B1); PG8_BAR;
            PG8_LDA(At, 0, 1); PG8_STAGE(PG8_SA(0, 0), a2, voffA);
            PG8_BAR; PG8_WAIT_L(0); PG8_MMA(1, 0, At, B0); PG8_BAR; PG8_SCHED;
            PG8_STAGE(PG8_SB(0, 1), b2 + hstep, voffB);
            PG8_WAIT_V(6); PG8_BAR; PG8_MMA(1, 1, At, B1); PG8_BAR;
            PG8_LDB(B0, 1, 0); PG8_SCHED; PG8_LDA(At, 1, 0); PG8_STAGE(PG8_SA(0, 1), a2 + hstep, voffA);
            PG8_WAIT_L(8); PG8_BAR; PG8_WAIT_L(0); PG8_MMA(0, 0, At, B0); PG8_BAR; PG8_SCHED;
            PG8_LDB(B1, 1, 1); PG8_STAGE(PG8_SB(1, 0), b3, voffB);
            PG8_BAR; PG8_WAIT_L(0); PG8_MMA(0, 1, At, B1); PG8_BAR;
            PG8_LDA(At, 1, 1); PG8_STAGE(PG8_SA(1, 0), a3, voffA);
            PG8_BAR; PG8_WAIT_L(0); PG8_MMA(1, 0, At, B0); PG8_BAR; PG8_SCHED;
            PG8_STAGE(PG8_SB(1, 1), b3 + hstep, voffB);
            PG8_WAIT_V(6); PG8_BAR; PG8_MMA(1, 1, At, B1); PG8_BAR;
            }
        }
        if constexpr (ALIGN_EPI) { if (wr == 0) PG8_BAR; }
        if constexpr (!Epi::AFTER_DRAIN) { E(acc, cur, wr, wc, fr, fq); S.done(cur); }
        if (!has_next) break;
#pragma unroll
        for (int a = 0; a < 2; ++a)
#pragma unroll
            for (int b = 0; b < 2; ++b)
#pragma unroll
                for (int m = 0; m < 4; ++m)
#pragma unroll
                    for (int n = 0; n < 2; ++n) acc[a][b][m][n] = (f32x4){0.f, 0.f, 0.f, 0.f};
        cur = nxt; cA = nA; cB = nB; ++ui;
        if constexpr (AMap::GATHER) { vC0[0] = vN0[0]; vC0[1] = vN0[1]; vC1[0] = vN1[0]; vC1[1] = vN1[1]; }
        if constexpr (ALIGN_EPI) { if (wr == 1) PG8_BAR; }
    }
    PG8_WAIT_V(0);
    if constexpr (!ALIGN_EPI) { if (wr == 0) PG8_BAR; }
    PG8_BAR;
    if constexpr (Epi::AFTER_DRAIN) { E.fused(acc, cur, wr, wc, fr, fq, lds, wid, lane); S.done(cur); }
#undef mma16
#undef PG8_SA
#undef PG8_AOFFS
#undef PG8_STAGE_A
#undef PG8_SB
#undef PG8_STAGE
#undef PG8_LDA
#undef PG8_LDB
#undef PG8_MMA
#undef PG8_WAIT_V
#undef PG8_WAIT_L
#undef PG8_BAR
#undef PG8_SCHED
}
}
#define XB_TMO      128
#define XB_XCNT(j)  (256  + 64 * (j))
#define XB_XSUB(j)  (1280 + 64 * (j))
#define XB_XGEN(j)  (2304 + 64 * (j))
#define XB_TOP      3328
#define XB_TOPGEN   3392
#define XCD_BAR_WORDS 3456
#define XB_SPIN_CAP (1u << 21)

__device__ __forceinline__ unsigned xb_ld(unsigned* p)              { return __hip_atomic_load(p, __ATOMIC_RELAXED, __HIP_MEMORY_SCOPE_AGENT); }
__device__ __forceinline__ unsigned xb_add(unsigned* p, unsigned v) { return __hip_atomic_fetch_add(p, v, __ATOMIC_RELAXED, __HIP_MEMORY_SCOPE_AGENT); }
__device__ __forceinline__ unsigned xb_xcc_id() { return (unsigned)__builtin_amdgcn_s_getreg((3 << 11) | 20) & 0xFu; }
#define XB_SPIN(cond, bar) do { unsigned _sp = 0; while (cond) { __builtin_amdgcn_s_sleep(1); \
    if ((++_sp & 255u) == 0u) { if (xb_ld(&(bar)[XB_TMO])) break; if (_sp > XB_SPIN_CAP) { atomicAdd(&(bar)[XB_TMO], 1u); break; } } } } while (0)

struct XcdBarrier {
    unsigned* bar; unsigned x;
    volatile LAS unsigned* st;
};

__device__ __forceinline__ XcdBarrier xcd_barrier_post(unsigned* bar, volatile LAS unsigned* st) {
    XcdBarrier b; b.bar = bar; b.x = xb_xcc_id(); b.st = st;
    if (threadIdx.x == 0) (void)xb_add(&bar[XB_XCNT(b.x)], 1u);
    return b;
}
__device__ __forceinline__ void xcd_barrier_complete(unsigned* bar, unsigned x, unsigned& nloc, unsigned& nx) {
    const unsigned G = gridDim.x * gridDim.y * gridDim.z;
    unsigned sum, cnt, mine, sp = 0u;
    for (;;) {
        sum = 0u; cnt = 0u; mine = 0u;
#pragma unroll
        for (unsigned j = 0; j < 16; ++j) { const unsigned c = xb_ld(&bar[XB_XCNT(j)]); sum += c; cnt += (c > 0u) ? 1u : 0u; mine = (j == x) ? c : mine; }
        if (sum == G) break;
        __builtin_amdgcn_s_sleep(1);
        if ((++sp & 255u) == 0u) { if (xb_ld(&bar[XB_TMO])) break; if (sp > XB_SPIN_CAP) { atomicAdd(&bar[XB_TMO], 1u); break; } }
    }
    nloc = mine > 0u ? mine : 1u; nx = cnt > 0u ? cnt : 1u;
}

__device__ __forceinline__ void xcd_barrier(const XcdBarrier& b) {
    asm volatile("s_waitcnt vmcnt(0)" ::: "memory");
    __syncthreads();
    int tid_l = (int)threadIdx.x; asm volatile("" : "+v"(tid_l));
    if (tid_l == 0) {
        unsigned* bar = b.bar;
        __builtin_amdgcn_s_waitcnt(0);
        unsigned nloc = b.st[0], nx = b.st[1];
        if (nloc == 0u) { xcd_barrier_complete(bar, b.x, nloc, nx); b.st[0] = nloc; b.st[1] = nx; }
        const unsigned old = xb_add(&bar[XB_XSUB(b.x)], 1u);
        const unsigned gen = old / nloc;
        if (old + 1u == (gen + 1u) * nloc) {
            __builtin_amdgcn_fence(__ATOMIC_RELEASE, "agent");
            asm volatile("s_waitcnt vmcnt(0)" ::: "memory");
            const unsigned og = xb_add(&bar[XB_TOP], 1u);
            const unsigned tg = og / nx;
            if (og + 1u == (tg + 1u) * nx) xb_add(&bar[XB_TOPGEN], 1u);
            else XB_SPIN(xb_ld(&bar[XB_TOPGEN]) == tg, bar);
            __builtin_amdgcn_fence(__ATOMIC_ACQUIRE, "agent");
            xb_add(&bar[XB_XGEN(b.x)], 1u);
            asm volatile("s_waitcnt vmcnt(0)" ::: "memory");
        } else {
            XB_SPIN(xb_ld(&bar[XB_XGEN(b.x)]) == gen, bar);
            __builtin_amdgcn_fence(__ATOMIC_ACQUIRE, "agent");
            asm volatile("s_waitcnt vmcnt(0)" ::: "memory");
        }
    }
    __syncthreads();
}

enum { I_X = 0, I_NORM_ATTN, I_W_IN, I_QK_GAIN, I_IDX_K_GAIN, I_DIFF_LAMBDA, I_DIFF_SUBLN, I_W_PROJ_A, I_W_PROJ_B, I_W_PROJ_C, I_W_OUT, I_NORM_FFN, I_W_GROUP, I_B_GROUP, I_W_ROUTER, I_B_ROUTER,
       I_W_E_GATE, I_W_E_UP, I_W_E_DOWN, N_INPUTS };
struct Args { const float* in[N_INPUTS]; float* out; unsigned char* ws; };

#define LDS_WAIT() asm volatile("s_waitcnt lgkmcnt(0)" ::: "memory")

__device__ __forceinline__ int perm16col(int s) { return 64 * ((s >> 5) & 3) + 16 * ((s >> 2) & 3) + 8 * (s >> 7) + 4 * ((s >> 4) & 1) + (s & 3); }
__device__ __forceinline__ int inproj_src_col(int d) {
    const int pn = d >> 8, s = d & 255;
    if (pn >= 15) return C_G + 256 * (pn - 15) + perm16col(s);
    const int u = (s >> 5) & 3, e = 32 * (s >> 7) + pg8::perm32(s & 31);
    if (pn < 8) return 256 * pn + 64 * u + e;
    if (pn == 8) { if (u == 0) return C_KI + e; if (u == 1) return e < 8 ? C_WI + e : -1; return -1; }
    return C_Q1 + 256 * (pn - 9) + 64 * u + e;
}
template <bool F16>
__device__ __forceinline__ void transpose_item(const float* W, int ldw, int K, bf16_t* WT, int drow0, int k0, int srccol, LAS float* scr, int lane, const float* kscale = nullptr) {
    const float* src = W + (size_t)k0 * ldw + (srccol >= 0 ? srccol : 0);
#pragma unroll 8
    for (int i = 0; i < 32; ++i) { const int kk = 2 * i + (lane >> 5); const float v = src[(size_t)kk * ldw]; scr[kk * 33 + (lane & 31)] = srccol >= 0 ? v : 0.f; }
    LDS_WAIT(); asm volatile("" ::: "memory");
    const int c = lane & 7;
    f32x4 g0 = {1.f, 1.f, 1.f, 1.f}, g1 = g0;
    if (F16) { g0 = *(const f32x4*)(kscale + k0 + 8 * c); g1 = *(const f32x4*)(kscale + k0 + 8 * c + 4); }
#pragma unroll
    for (int j = 0; j < 4; ++j) { const int n = (lane >> 3) + 8 * j; const LAS float* s = scr + (8 * c) * 33 + n;
        u32x4 o;
        if (F16) { o.x = cvt_pk_f16(s[0 * 33] * g0[0], s[1 * 33] * g0[1]); o.y = cvt_pk_f16(s[2 * 33] * g0[2], s[3 * 33] * g0[3]); o.z = cvt_pk_f16(s[4 * 33] * g1[0], s[5 * 33] * g1[1]); o.w = cvt_pk_f16(s[6 * 33] * g1[2], s[7 * 33] * g1[3]); }
        else { o.x = cvt_pk_bf16(s[0 * 33], s[1 * 33]); o.y = cvt_pk_bf16(s[2 * 33], s[3 * 33]); o.z = cvt_pk_bf16(s[4 * 33], s[5 * 33]); o.w = cvt_pk_bf16(s[6 * 33], s[7 * 33]); }
        *(u32x4*)(WT + (size_t)(drow0 + n) * K + k0 + 8 * c) = o; }
    LDS_WAIT(); asm volatile("" ::: "memory");
}

template <bool FIRST, bool COMBINE, bool FINAL>
__device__ __forceinline__ void token_row(const float* xin, unsigned char* x16, float* outf, const bf16_t* y, const unsigned* rt0, const unsigned* rt1, const f32x2* rtw, const LAS int* pstart,
                                          float* rstd1, int m, int lane) {
    float v[2][8];
#pragma unroll
    for (int j = 0; j < 2; ++j) {
        if (FIRST) { const f32x4 p = ((const f32x4*)(xin + (size_t)m * DM))[2 * (lane + 64 * j)], q = ((const f32x4*)(xin + (size_t)m * DM))[2 * (lane + 64 * j) + 1];
#pragma unroll
            for (int k = 0; k < 4; ++k) { v[j][k] = p[k]; v[j][4 + k] = q[k]; } }
        else { const u32x4 p = ((const u32x4*)(x16 + (size_t)m * (DM * 2)))[lane + 64 * j];
#pragma unroll
            for (int k = 0; k < 4; ++k) { v[j][2 * k] = h_lo(p[k]); v[j][2 * k + 1] = h_hi(p[k]); } }
    }
    if (COMBINE) {
        const unsigned a = rt0[m], b = rt1[m]; const f32x2 w = rtw[m];
        const size_t s0 = (size_t)(pstart[a >> 24] + (int)(a & 0xffffffu)), s1 = (size_t)(pstart[b >> 24] + (int)(b & 0xffffffu));
#pragma unroll
        for (int j = 0; j < 2; ++j) { const u32x4 p = ((const u32x4*)(y + s0 * DM))[lane + 64 * j], q = ((const u32x4*)(y + s1 * DM))[lane + 64 * j];
#pragma unroll
            for (int k = 0; k < 4; ++k) { v[j][2 * k] += w[0] * bf_lo(p[k]) + w[1] * bf_lo(q[k]); v[j][2 * k + 1] += w[0] * bf_hi(p[k]) + w[1] * bf_hi(q[k]); } }
    }
    if (FINAL) {
#pragma unroll
        for (int j = 0; j < 2; ++j) { ((f32x4*)(outf + (size_t)m * DM))[2 * (lane + 64 * j)] = (f32x4){v[j][0], v[j][1], v[j][2], v[j][3]}; ((f32x4*)(outf + (size_t)m * DM))[2 * (lane + 64 * j) + 1] = (f32x4){v[j][4], v[j][5], v[j][6], v[j][7]}; }
    } else {
        float ss = 0.f;
#pragma unroll
        for (int j = 0; j < 2; ++j) { ss += (v[j][0] * v[j][0] + v[j][1] * v[j][1]) + (v[j][2] * v[j][2] + v[j][3] * v[j][3]) + (v[j][4] * v[j][4] + v[j][5] * v[j][5]) + (v[j][6] * v[j][6] + v[j][7] * v[j][7]);
            ((u32x4*)(x16 + (size_t)m * (DM * 2)))[lane + 64 * j] = (u32x4){cvt_pk_f16(v[j][0], v[j][1]), cvt_pk_f16(v[j][2], v[j][3]), cvt_pk_f16(v[j][4], v[j][5]), cvt_pk_f16(v[j][6], v[j][7])}; }
        const float rstd = 1.0f / sqrtf(wave_sum(ss) * (1.0f / DM) + EPS);
        if (lane == 0) rstd1[m] = rstd;
    }
}

template <bool EXPERTS> __device__ __forceinline__ void convert_weights(const Args& a, unsigned char* ws, int l, LAS unsigned char* lds, int lane, int wave, int vcu, int G, int chunk = -1);
__device__ __forceinline__ void p0_phase(const Args& a, unsigned char* ws, int l, LAS unsigned char* lds, int tid, int lane, int wave, int vcu, int G) {
    convert_weights<false>(a, ws, l, lds, lane, wave, vcu, G);
    const int gw = vcu * 8 + wave, NGW = G * 8, gt = vcu * 512 + tid, NGT = G * 512;
    if (l == 0) {
        float* cosT = (float*)(ws + WS_COS); float* sinT = (float*)(ws + WS_SIN);
        for (int idx = gt; idx < SEQ * 32; idx += NGT) { const int pos = idx >> 5, j = idx & 31;
            const float inv_freq = 1.0f / powf(10000.0f, (float)(2 * j) * (1.0f / 64.0f));
            const float ang = (float)pos * inv_freq;
            const double rev = (double)ang * 0.15915494309189533577; const float fr = (float)(rev - rint(rev));
            cosT[idx] = __builtin_amdgcn_cosf(fr); sinT[idx] = __builtin_amdgcn_sinf(fr); }
    }
    { float* wrt = (float*)(ws + WS_WRT); const float* wg = a.in[I_W_GROUP] + (size_t)l * DM * 4; const float* wr = a.in[I_W_ROUTER] + (size_t)l * DM * 32;
      const float* g2 = a.in[I_NORM_FFN] + (size_t)l * DM;
      for (int idx = gt; idx < 36 * DM; idx += NGT) { const int c = idx >> 10, k = idx & 1023; wrt[idx] = g2[k] * (c < 4 ? wg[k * 4 + c] : wr[k * 32 + (c - 4)]); } }
    unsigned char* x16 = ws + WS_X16; float* rstd1 = (float*)(ws + WS_RSTD1);
    const LAS int* pstart = (const LAS int*)(lds + LX_PSTART);
    if (l == 0) { for (int m = gw; m < MTOK; m += NGW) token_row<true, false, false>(a.in[I_X], x16, nullptr, nullptr, nullptr, nullptr, nullptr, pstart, rstd1, m, lane); }
    else { for (int m = gw; m < MTOK; m += NGW) token_row<false, true, false>(nullptr, x16, nullptr, (const bf16_t*)(ws + WS_Y), (const unsigned*)(ws + WS_RT0), (const unsigned*)(ws + WS_RT1), (const f32x2*)(ws + WS_RTW), pstart, rstd1, m, lane); }
}

template <bool EXPERTS> __device__ __forceinline__ void convert_weights(const Args& a, unsigned char* ws, int l, LAS unsigned char* lds, int lane, int wave, int vcu, int G, int chunk) {
    LAS float* scr = (LAS float*)(lds + wave * 16384);
    int gw = vcu * 8 + wave, NGW = G * 8;
    constexpr int I_IN = 216 * 16, I_PA = 32 * 4, I_PC = 32 * 8, I_WO = 32 * 16, I_GU = 32 * 32 * 16, I_DN = 32 * 32 * 8, NIT = I_IN + 2 * I_PA + I_PC + I_WO + I_GU + I_DN;
    constexpr int I_SMALL = I_IN + 2 * I_PA + I_PC + I_WO;
    int it_end = EXPERTS ? NIT : I_SMALL;
    if (chunk >= 0) { gw = chunk * 128 + wave * 16; NGW = 1; it_end = I_SMALL + gw + 16 < NIT ? I_SMALL + gw + 16 : NIT; }
    for (int it = gw + (EXPERTS ? I_SMALL : 0); it < it_end; it += NGW) {
        int r = it; const int d31 = lane & 31;
        if (r < I_IN) { const int nb = r >> 4, kb = r & 15; transpose_item<true>(a.in[I_W_IN] + (size_t)l * DM * D_IN, D_IN, 1024, (bf16_t*)(ws + WS_WIN), nb * 32, kb * 64, inproj_src_col(nb * 32 + d31), scr, lane, a.in[I_NORM_ATTN] + (size_t)l * DM); continue; } r -= I_IN;
        const int pcol = pg8::perm32(d31);
        if (r < I_PA) { const int nb = r >> 2, kb = r & 3; transpose_item<false>(a.in[I_W_PROJ_A] + (size_t)l * 256 * DM, DM, 256, (bf16_t*)(ws + WS_WPA), nb * 32, kb * 64, ((nb * 32 + d31) & ~255) + perm16col((nb * 32 + d31) & 255), scr, lane); continue; } r -= I_PA;
        if (r < I_PA) { const int nb = r >> 2, kb = r & 3; transpose_item<false>(a.in[I_W_PROJ_B] + (size_t)l * 256 * DM, DM, 256, (bf16_t*)(ws + WS_WPB), nb * 32, kb * 64, ((nb * 32 + d31) & ~255) + perm16col((nb * 32 + d31) & 255), scr, lane); continue; } r -= I_PA;
        if (r < I_PC) { const int nb = r >> 3, kb = r & 7; transpose_item<false>(a.in[I_W_PROJ_C] + (size_t)l * 512 * DM, DM, 512, (bf16_t*)(ws + WS_WPC), nb * 32, kb * 64, ((nb * 32 + d31) & ~255) + perm16col((nb * 32 + d31) & 255), scr, lane); continue; } r -= I_PC;
        if (r < I_WO) { const int nb = r >> 4, kb = r & 15; transpose_item<false>(a.in[I_W_OUT] + (size_t)l * DM * DM, DM, 1024, (bf16_t*)(ws + WS_WO), nb * 32, kb * 64, nb * 32 + pcol, scr, lane); continue; } r -= I_WO;
        if (r < I_GU) { const int e = r >> 9, rr = r & 511, nb = rr >> 4, kb = rr & 15, dd = nb * 32, pn = dd >> 8, s = dd & 255, half = s >> 7;
            const float* src = (half ? a.in[I_W_E_UP] : a.in[I_W_E_GATE]) + (size_t)(l * NEXP + e) * DM * DEXP;
            transpose_item<true>(src, DEXP, 1024, (bf16_t*)(ws + WS_WGU) + (size_t)e * 1024 * 1024, nb * 32, kb * 64, 128 * pn + (s & 127) + pcol, scr, lane, a.in[I_NORM_FFN] + (size_t)l * DM); continue; } r -= I_GU;
        { const int e = r >> 8, rr = r & 255, nb = rr >> 3, kb = rr & 7;
            transpose_item<false>(a.in[I_W_E_DOWN] + (size_t)(l * NEXP + e) * DEXP * DM, DM, 512, (bf16_t*)(ws + WS_WD) + (size_t)e * 1024 * 512, nb * 32, kb * 64, ((nb * 32 + d31) & ~255) + perm16col((nb * 32 + d31) & 255), scr, lane); }
    }
}

__device__ __forceinline__ f32x16 mfma32(bf16x8 a, bf16x8 b, f32x16 c) { return __builtin_amdgcn_mfma_f32_32x32x16_bf16(a, b, c, 0, 0, 0); }
typedef short v4i16_t __attribute__((ext_vector_type(4)));
__device__ __forceinline__ s16x4 vtr(const LAS unsigned char* p) { return __builtin_bit_cast(s16x4, __builtin_amdgcn_ds_read_tr16_b64_v4i16((LAS v4i16_t*)p)); }
__device__ __forceinline__ int crow(int r, int hi) { return (r & 3) + 8 * (r >> 2) + 4 * hi; }
#define NEG_INF (-__builtin_inff())

__device__ __forceinline__ f32x16 splat16(float v) { f32x16 r;
#pragma unroll
    for (int i = 0; i < 16; ++i) r[i] = v;
    return r; }
__device__ __forceinline__ int kimg_off(int key, int ch) { return key * 128 + ((ch ^ ((key >> 1) & 7)) << 4); }
__device__ __forceinline__ int kdma_row(int w, int lane) { return 8 * w + (lane >> 3); }
__device__ __forceinline__ int kdma_chunk(int w, int lane) { return (lane & 7) ^ (((8 * w + (lane >> 3)) >> 1) & 7); }
struct QReg { const bf16x8 (&q)[4]; __device__ __forceinline__ bf16x8 operator()(int ks) const { return q[ks]; } };
struct QLds { const LAS unsigned char* p; __device__ __forceinline__ bf16x8 operator()(int ks) const { return *(const LAS bf16x8*)(p + ks * 1024); } };
template <int NDB, class QF, class MaskF>
__device__ __forceinline__ void flash_tile(float& m_run, float& l_run, f32x16 (&o)[NDB], const LAS unsigned char* kimg, const LAS unsigned char* vimg, const QF& qf, const MaskF& maskf, int r32, int hi, int vboff) {
    if (NDB == 4) __builtin_amdgcn_sched_barrier(0);
    f32x16 p0, p1; maskf.init(p0, p1);
#pragma unroll
    for (int ks = 0; ks < 4; ++ks) {
        const bf16x8 a0 = *(const LAS bf16x8*)(kimg + (NDB == 4 ? (2 * ks + hi) * 1024 + r32 * 16 : kimg_off(r32, 2 * ks + hi)));
        const bf16x8 a1 = *(const LAS bf16x8*)(kimg + (NDB == 4 ? (2 * ks + hi) * 1024 + 512 + r32 * 16 : kimg_off(r32, 2 * ks + hi) + 4096));
        const bf16x8 qk = qf(ks);
        p0 = mfma32(a0, qk, p0); p1 = mfma32(a1, qk, p1);
        if (NDB == 4 && (ks & 1)) __builtin_amdgcn_sched_barrier(0);
    }
    maskf(p0, p1);
    float mx = fmaxf(p0[0], p1[0]);
#pragma unroll
    for (int r = 1; r < 16; ++r) mx = fmaxf(mx, fmaxf(p0[r], p1[r]));
    mx = max_xor32(mx);
    const float mnew = fmaxf(m_run, mx);
    if (__ballot(mnew > m_run) != 0ull) {
        const float alpha = fast_exp2(m_run - mnew);
        l_run *= alpha;
#pragma unroll
        for (int db = 0; db < NDB; ++db) o[db] = o[db] * alpha;
    }
    m_run = mnew;
    float sum = 0.f;
#pragma unroll
    for (int r = 0; r < 16; ++r) { p0[r] = fast_exp2(p0[r] - mnew); p1[r] = fast_exp2(p1[r] - mnew); sum += p0[r] + p1[r]; }
    l_run += sum;
    bf16x8 pa[4];
    pa[0] = __builtin_bit_cast(bf16x8, (u32x4){cvt_pk_bf16(p0[0], p0[1]), cvt_pk_bf16(p0[2], p0[3]), cvt_pk_bf16(p0[4], p0[5]), cvt_pk_bf16(p0[6], p0[7])});
    pa[1] = __builtin_bit_cast(bf16x8, (u32x4){cvt_pk_bf16(p0[8], p0[9]), cvt_pk_bf16(p0[10], p0[11]), cvt_pk_bf16(p0[12], p0[13]), cvt_pk_bf16(p0[14], p0[15])});
    pa[2] = __builtin_bit_cast(bf16x8, (u32x4){cvt_pk_bf16(p1[0], p1[1]), cvt_pk_bf16(p1[2], p1[3]), cvt_pk_bf16(p1[4], p1[5]), cvt_pk_bf16(p1[6], p1[7])});
    pa[3] = __builtin_bit_cast(bf16x8, (u32x4){cvt_pk_bf16(p1[8], p1[9]), cvt_pk_bf16(p1[10], p1[11]), cvt_pk_bf16(p1[12], p1[13]), cvt_pk_bf16(p1[14], p1[15])});
#pragma unroll
    for (int db = 0; db < NDB; ++db)
#pragma unroll
        for (int s = 0; s < 4; ++s) {
            const s16x4 lo = vtr(vimg + vboff + db * 4096 + s * 1024), h4 = vtr(vimg + vboff + db * 4096 + s * 1024 + 512);
            const bf16x8 vt = (bf16x8){lo[0], lo[1], lo[2], lo[3], h4[0], h4[1], h4[2], h4[3]};
            o[db] = mfma32(vt, pa[s], o[db]);
            if (NDB == 4 && (s & 1)) __builtin_amdgcn_sched_barrier(0);
        }    __builtin_amdgcn_sched_barrier(0);
}
template <int NDB, class QF, class MaskF>
__device__ __forceinline__ void flash_tile_ref0(float& l_run, f32x16& lacc, f32x16 (&o)[NDB], const LAS unsigned char* kimg, const LAS unsigned char* vimg, const QF& qf, const MaskF& maskf, int r32, int hi, int vboff) {
    f32x16 p0, p1; maskf.init(p0, p1);
    bf16x8 kf[8];
#pragma unroll
    for (int ks = 0; ks < 4; ++ks) { kf[2 * ks] = *(const LAS bf16x8*)(kimg + kimg_off(r32, 2 * ks + hi)); kf[2 * ks + 1] = *(const LAS bf16x8*)(kimg + kimg_off(r32, 2 * ks + hi) + 4096); }
    __builtin_amdgcn_sched_barrier(0);
    __builtin_amdgcn_s_setprio(1);
#pragma unroll
    for (int ks = 0; ks < 4; ++ks) { const bf16x8 qk = qf(ks); p0 = mfma32(kf[2 * ks], qk, p0); p1 = mfma32(kf[2 * ks + 1], qk, p1); }
    __builtin_amdgcn_s_setprio(0);
    maskf(p0, p1);
    __builtin_amdgcn_sched_barrier(0);
    const bf16x8 ones = (bf16x8){0x3f80, 0x3f80, 0x3f80, 0x3f80, 0x3f80, 0x3f80, 0x3f80, 0x3f80};
#pragma unroll
    for (int r = 0; r < 16; ++r) p0[r] = fast_exp2(p0[r]);
    bf16x8 pa[4];
    pa[0] = __builtin_bit_cast(bf16x8, (u32x4){cvt_pk_bf16(p0[0], p0[1]), cvt_pk_bf16(p0[2], p0[3]), cvt_pk_bf16(p0[4], p0[5]), cvt_pk_bf16(p0[6], p0[7])});
    pa[1] = __builtin_bit_cast(bf16x8, (u32x4){cvt_pk_bf16(p0[8], p0[9]), cvt_pk_bf16(p0[10], p0[11]), cvt_pk_bf16(p0[12], p0[13]), cvt_pk_bf16(p0[14], p0[15])});
    maskf.pack(pa[0]); maskf.pack(pa[1]);
    __builtin_amdgcn_sched_barrier(0);
#pragma unroll
    for (int s = 0; s < 2; ++s) {
        lacc = mfma32(ones, pa[s], lacc);
#pragma unroll
        for (int db = 0; db < NDB; ++db) {
            const s16x4 lo = vtr(vimg + vboff + db * 4096 + s * 1024), h4 = vtr(vimg + vboff + db * 4096 + s * 1024 + 512);
            o[db] = mfma32((bf16x8){lo[0], lo[1], lo[2], lo[3], h4[0], h4[1], h4[2], h4[3]}, pa[s], o[db]);
        }
    }
#pragma unroll
    for (int r = 0; r < 16; ++r) p1[r] = fast_exp2(p1[r]);
    pa[2] = __builtin_bit_cast(bf16x8, (u32x4){cvt_pk_bf16(p1[0], p1[1]), cvt_pk_bf16(p1[2], p1[3]), cvt_pk_bf16(p1[4], p1[5]), cvt_pk_bf16(p1[6], p1[7])});
    pa[3] = __builtin_bit_cast(bf16x8, (u32x4){cvt_pk_bf16(p1[8], p1[9]), cvt_pk_bf16(p1[10], p1[11]), cvt_pk_bf16(p1[12], p1[13]), cvt_pk_bf16(p1[14], p1[15])});
    maskf.pack(pa[2]); maskf.pack(pa[3]);
    __builtin_amdgcn_sched_barrier(0);
#pragma unroll
    for (int s = 2; s < 4; ++s) {
        lacc = mfma32(ones, pa[s], lacc);
#pragma unroll
        for (int db = 0; db < NDB; ++db) {
            const s16x4 lo = vtr(vimg + vboff + db * 4096 + s * 1024), h4 = vtr(vimg + vboff + db * 4096 + s * 1024 + 512);
            o[db] = mfma32((bf16x8){lo[0], lo[1], lo[2], lo[3], h4[0], h4[1], h4[2], h4[3]}, pa[s], o[db]);
        }
    }
    __builtin_amdgcn_sched_barrier(0);
    (void)l_run;
}
template <bool KSWZ, class MaskF>
__device__ __forceinline__ void flash_tile_dual_ref0(float& l1, float& l2, f32x16 (&o1)[4], f32x16 (&o2)[4], const LAS unsigned char* k1img, const LAS unsigned char* k2img, const LAS unsigned char* vimg,
                                                     const LAS unsigned char* q1img, const LAS unsigned char* q2img, const MaskF& maskf, int r32, int hi, int vboff) {
    bf16x8 pa1[4], pa2[4];
#define DUAL_MAP_(kimg, qimg, pa, lsum) do { __builtin_amdgcn_sched_barrier(0); f32x16 p0, p1; maskf.init(p0, p1); \
        _Pragma("unroll") for (int ks = 0; ks < 4; ++ks) { const int ko = KSWZ ? kimg_off(r32, 2 * ks + hi) : (2 * ks + hi) * 1024 + r32 * 16; const bf16x8 qq = *(const LAS bf16x8*)(qimg + ks * 1024); \
            p0 = mfma32(*(const LAS bf16x8*)(kimg + ko), qq, p0); p1 = mfma32(*(const LAS bf16x8*)(kimg + ko + (KSWZ ? 4096 : 512)), qq, p1); if (ks & 1) __builtin_amdgcn_sched_barrier(0); } \
        maskf(p0, p1); float sm = 0.f; \
        _Pragma("unroll") for (int r = 0; r < 16; ++r) { p0[r] = fast_exp2(p0[r]); p1[r] = fast_exp2(p1[r]); sm += p0[r] + p1[r]; } \
        lsum += sm; \
        pa[0] = __builtin_bit_cast(bf16x8, (u32x4){cvt_pk_bf16(p0[0], p0[1]), cvt_pk_bf16(p0[2], p0[3]), cvt_pk_bf16(p0[4], p0[5]), cvt_pk_bf16(p0[6], p0[7])}); \
        pa[1] = __builtin_bit_cast(bf16x8, (u32x4){cvt_pk_bf16(p0[8], p0[9]), cvt_pk_bf16(p0[10], p0[11]), cvt_pk_bf16(p0[12], p0[13]), cvt_pk_bf16(p0[14], p0[15])}); \
        pa[2] = __builtin_bit_cast(bf16x8, (u32x4){cvt_pk_bf16(p1[0], p1[1]), cvt_pk_bf16(p1[2], p1[3]), cvt_pk_bf16(p1[4], p1[5]), cvt_pk_bf16(p1[6], p1[7])}); \
        pa[3] = __builtin_bit_cast(bf16x8, (u32x4){cvt_pk_bf16(p1[8], p1[9]), cvt_pk_bf16(p1[10], p1[11]), cvt_pk_bf16(p1[12], p1[13]), cvt_pk_bf16(p1[14], p1[15])}); } while (0)
    DUAL_MAP_(k1img, q1img, pa1, l1);
    DUAL_MAP_(k2img, q2img, pa2, l2);
#undef DUAL_MAP_
    __builtin_amdgcn_sched_barrier(0);
#pragma unroll
    for (int s = 0; s < 4; ++s) {
#pragma unroll
        for (int db = 0; db < 4; ++db) {
            const s16x4 lo = vtr(vimg + vboff + db * 4096 + s * 1024), h4 = vtr(vimg + vboff + db * 4096 + s * 1024 + 512);
            const bf16x8 vt = (bf16x8){lo[0], lo[1], lo[2], lo[3], h4[0], h4[1], h4[2], h4[3]};
            o1[db] = mfma32(vt, pa1[s], o1[db]); o2[db] = mfma32(vt, pa2[s], o2[db]);
            if (db & 1) __builtin_amdgcn_sched_barrier(0);
        }
    }
}
template <bool FAST, int NDB, class QF, class MaskF>
__device__ __forceinline__ void flash_step(float& m_run, float& l_run, f32x16& lacc, f32x16 (&o)[NDB], const LAS unsigned char* kimg, const LAS unsigned char* vimg, const QF& qf, const MaskF& maskf, int r32, int hi, int vboff) {
    if constexpr (FAST) flash_tile_ref0<NDB>(l_run, lacc, o, kimg, vimg, qf, maskf, r32, hi, vboff); else flash_tile<NDB>(m_run, l_run, o, kimg, vimg, qf, maskf, r32, hi, vboff);
}
__device__ __forceinline__ bool softmax_ref0_ok(const float* gq, const float* gk, int lane) {
    float a = fabsf(gq[lane]), b = fabsf(gk[lane]);
    a = fmaxf(a, xor_lane<1>(a)); a = fmaxf(a, xor_lane<2>(a)); a = fmaxf(a, xor_lane<4>(a)); a = fmaxf(a, xor_lane<8>(a)); a = fmaxf(a, xor_lane<16>(a)); a = max_xor32(a);
    b = fmaxf(b, xor_lane<1>(b)); b = fmaxf(b, xor_lane<2>(b)); b = fmaxf(b, xor_lane<4>(b)); b = fmaxf(b, xor_lane<8>(b)); b = fmaxf(b, xor_lane<16>(b)); b = max_xor32(b);
    return __builtin_amdgcn_readfirstlane(__builtin_bit_cast(int, a * b * (C2 * 64.0f * 1.02f))) < __builtin_bit_cast(int, 48.0f) && REF0_ENABLE;
}
#define MASK_INIT_ZERO __device__ __forceinline__ void init(f32x16& p0, f32x16& p1) const { p0 = splat16(0.f); p1 = splat16(0.f); }
#define MASK_PACK_NONE __device__ __forceinline__ void pack(bf16x8&) const {}
struct MaskNone { MASK_INIT_ZERO MASK_PACK_NONE __device__ __forceinline__ void operator()(f32x16&, f32x16&) const {} };
struct MaskCausal { int kb0, qloc, hi;
    MASK_INIT_ZERO MASK_PACK_NONE
    __device__ __forceinline__ void operator()(f32x16& p0, f32x16& p1) const {
#pragma unroll
        for (int r = 0; r < 16; ++r) { const int kv = kb0 + crow(r, hi); p0[r] = kv > qloc ? NEG_INF : p0[r]; p1[r] = kv + 32 > qloc ? NEG_INF : p1[r]; } } };
struct MaskCausalIf { bool on; int kb0, qloc, hi;
    MASK_INIT_ZERO MASK_PACK_NONE
    __device__ __forceinline__ void operator()(f32x16& p0, f32x16& p1) const { if (on) {
#pragma unroll
        for (int r = 0; r < 16; ++r) { const int kv = kb0 + crow(r, hi); p0[r] = kv > qloc ? NEG_INF : p0[r]; p1[r] = kv + 32 > qloc ? NEG_INF : p1[r]; } } } };
struct MaskLaneP { unsigned keep;
    MASK_INIT_ZERO
    __device__ __forceinline__ void operator()(f32x16&, f32x16&) const {}
    __device__ __forceinline__ void pack(bf16x8& pa) const { u32x4 v = __builtin_bit_cast(u32x4, pa); v = v & keep; pa = __builtin_bit_cast(bf16x8, v); } };
struct MaskLane { float ci;
    MASK_INIT_ZERO MASK_PACK_NONE
    __device__ __forceinline__ void operator()(f32x16& p0, f32x16& p1) const {
#pragma unroll
        for (int r = 0; r < 16; ++r) { p0[r] += ci; p1[r] += ci; } } };
template <int POS> __device__ __forceinline__ float neginf_if_bit(unsigned n) { float r; asm("v_bfe_i32 %0, %1, %2, 1\n\tv_and_b32 %0, 0xff800000, %0" : "=v"(r) : "v"(n), "n"(POS)); return r; }
struct MaskBits { unsigned n0, n1;
    __device__ __forceinline__ void init(f32x16& p0, f32x16& p1) const {
#define MB_(r) p0[r] = neginf_if_bit<((r) & 3) + 8 * ((r) >> 2)>(n0); p1[r] = neginf_if_bit<((r) & 3) + 8 * ((r) >> 2)>(n1);
        MB_(0) MB_(1) MB_(2) MB_(3) MB_(4) MB_(5) MB_(6) MB_(7) MB_(8) MB_(9) MB_(10) MB_(11) MB_(12) MB_(13) MB_(14) MB_(15)
#undef MB_
        asm volatile("s_nop 1" ::: "memory"); }
    MASK_PACK_NONE
    __device__ __forceinline__ void operator()(f32x16&, f32x16&) const {} };
__device__ __forceinline__ void dma16(const void* g, LAS unsigned char* l) { __builtin_amdgcn_global_load_lds((const unsigned*)g, (LAS unsigned*)l, 16, 0, 0); }
#define DMA_WAIT_SYNC() do { asm volatile("s_waitcnt vmcnt(0)" ::: "memory"); __syncthreads(); } while (0)

__device__ __forceinline__ void glds16(const void* gsrc, unsigned lds_dst) { unsigned keep;
    asm volatile("s_mov_b32 %0, m0\n\ts_mov_b32 m0, %2\n\ts_nop 0\n\tglobal_load_lds_dwordx4 %1, off\n\ts_mov_b32 m0, %0" : "=&s"(keep) : "v"(gsrc), "s"(lds_dst) : "memory"); }
__device__ __forceinline__ void glds4(const void* gsrc, unsigned lds_dst) { unsigned keep;
    asm volatile("s_mov_b32 %0, m0\n\ts_mov_b32 m0, %2\n\ts_nop 0\n\tglobal_load_lds_dword %1, off\n\ts_mov_b32 m0, %0" : "=&s"(keep) : "v"(gsrc), "s"(lds_dst) : "memory"); }
#define WAITV_BAR(N) asm volatile("s_waitcnt vmcnt(" #N ") lgkmcnt(0)\n\ts_barrier" ::: "memory")

template <int MODE, bool FAST>
__device__ __forceinline__ void attn_ab_unit(int b, int h, int qt, const bf16_t* qkv, bf16_t* obuf, const float* kmean, const unsigned* maskg, LAS unsigned char* lds, int tid, int lane, int w) {
    constexpr int CQ = MODE == 0 ? C_QA : C_QB, CK = MODE == 0 ? C_KA : C_KB, CV = MODE == 0 ? C_VA : C_VB;
    constexpr int NS = 4, D = 3, SLOT = 16384;
    const int r32 = lane & 31, hi = lane >> 5;
    const size_t rowbase = (size_t)b * SEQ; const int q0 = 256 * qt, qloc = 32 * w + r32; const size_t qrow = rowbase + q0 + qloc;
    const unsigned lds0 = (unsigned)(size_t)lds;
    LAS float* kml = (LAS float*)(lds + 73728); LAS unsigned* mwl = (LAS unsigned*)(lds + 65536);
    bf16x8 qf[4];
#pragma unroll
    for (int ks = 0; ks < 4; ++ks) qf[ks] = *(const bf16x8*)(qkv + qrow * QP + CQ + 64 * h + 16 * ks + 8 * hi);
    const bf16_t* ksrc = qkv + (rowbase + kdma_row(w, lane)) * QP + CK + 64 * h + 8 * kdma_chunk(w, lane);
    const bf16_t* vsrc = qkv + (rowbase + 16 * (w & 3) + (lane >> 2)) * QP + CV + 64 * h + 32 * (w >> 2) + 8 * (lane & 3);
    const unsigned* msrc = maskg + qrow * 128 + hi;
    const int NT = 4 * qt + 4, wlim = 4 * qt + (w >> 1);
    const unsigned kdst0 = (unsigned)__builtin_amdgcn_readfirstlane(lds0 + w * 1024), mdst0 = (unsigned)__builtin_amdgcn_readfirstlane(lds0 + 65536 + w * 256);
    __syncthreads();
#pragma unroll
    for (int d = 0; d < D; ++d) { const int t = d < NT ? d : NT - 1;
        glds16(ksrc + (size_t)t * 64 * QP, kdst0 + d * SLOT); glds16(vsrc + (size_t)t * 64 * QP, kdst0 + d * SLOT + 8192);
        if (MODE == 1) glds4(msrc + 2 * t, mdst0 + d * 2048); }
    unsigned selbits = 0;
    if (MODE == 0) {
        if (tid < 256) ((LAS f32x4*)kml)[tid] = ((const f32x4*)(kmean + (size_t)((b * 4 + h) * 16) * 64))[tid];
        __syncthreads();
        if (qt > 0) {
            float qv[32];
#pragma unroll
            for (int ks = 0; ks < 4; ++ks) { const u32x4 qq = __builtin_bit_cast(u32x4, qf[ks]);
#pragma unroll
                for (int k = 0; k < 4; ++k) { qv[8 * ks + 2 * k] = bf_lo(qq[k]); qv[8 * ks + 2 * k + 1] = bf_hi(qq[k]); } }
            float v1 = NEG_INF, v2 = NEG_INF, v3 = NEG_INF; int i1 = -1, i2 = -1, i3 = -1;
#pragma unroll 1
            for (int j = 0; j < qt; ++j) {
                float g = 0.f;
#pragma unroll
                for (int ks = 0; ks < 4; ++ks) { const f32x4 k0 = *(const LAS f32x4*)(kml + j * 64 + 16 * ks + 8 * hi), k1 = *(const LAS f32x4*)(kml + j * 64 + 16 * ks + 8 * hi + 4);
                    g += qv[8 * ks + 0] * k0[0] + qv[8 * ks + 1] * k0[1] + qv[8 * ks + 2] * k0[2] + qv[8 * ks + 3] * k0[3] + qv[8 * ks + 4] * k1[0] + qv[8 * ks + 5] * k1[1] + qv[8 * ks + 6] * k1[2] + qv[8 * ks + 7] * k1[3]; }
                g = sum_xor32(g);
                if (g > v1) { v3 = v2; i3 = i2; v2 = v1; i2 = i1; v1 = g; i1 = j; }
                else if (g > v2) { v3 = v2; i3 = i2; v2 = g; i2 = j; }
                else if (g > v3) { v3 = g; i3 = j; }
            }
            if (i1 >= 0) selbits |= 1u << i1; if (i2 >= 0) selbits |= 1u << i2; if (i3 >= 0) selbits |= 1u << i3;
        }
    }
    const int vboff = (4 * hi + ((lane & 15) >> 2)) * 64 + ((lane >> 4) & 1) * 32 + (lane & 3) * 8;
    float m_run = -1e30f, l_run = 0.f; f32x16 o[2], lacc = splat16(0.f); o[0] = splat16(0.f); o[1] = splat16(0.f);
    int scur = 0, siss = D;
    asm volatile("s_waitcnt vmcnt(0)" ::: "memory");
    asm volatile("" : "+v"(qf[0]), "+v"(qf[1]), "+v"(qf[2]), "+v"(qf[3]));
#pragma unroll 1
    for (int kt = 0; kt < NT; ++kt) {
        if (MODE == 1) WAITV_BAR(6); else WAITV_BAR(4);
        { const int t = kt + D < NT ? kt + D : NT - 1;
          glds16(ksrc + (size_t)t * 64 * QP, kdst0 + siss * SLOT); glds16(vsrc + (size_t)t * 64 * QP, kdst0 + siss * SLOT + 8192);
          if (MODE == 1) glds4(msrc + 2 * t, mdst0 + siss * 2048); }
        const LAS unsigned char* cur = lds + scur * SLOT;
        if (MODE == 0) {
            const int j = kt >> 2;
            if (j < qt) { const bool sel = (selbits >> j) & 1u; if (__ballot(sel) != 0ull) { if (FAST) flash_step<FAST, 2>(m_run, l_run, lacc, o, cur, cur + 8192, QReg{qf}, MaskLaneP{sel ? 0xffffffffu : 0u}, r32, hi, vboff); else flash_step<FAST, 2>(m_run, l_run, lacc, o, cur, cur + 8192, QReg{qf}, MaskLane{sel ? 0.f : NEG_INF}, r32, hi, vboff); } }
            else { const int kb0 = 64 * (kt & 3); if (kb0 <= 32 * w + 31) flash_step<FAST, 2>(m_run, l_run, lacc, o, cur, cur + 8192, QReg{qf}, MaskCausal{kb0, qloc, hi}, r32, hi, vboff); }
        } else {
            if (kt <= wlim) { const LAS unsigned* mp = mwl + scur * 512 + w * 64; const unsigned cw0 = mp[r32], cw1 = mp[32 + r32];
                flash_step<FAST, 2>(m_run, l_run, lacc, o, cur, cur + 8192, QReg{qf}, MaskBits{~cw0 >> (4 * hi), ~cw1 >> (4 * hi)}, r32, hi, vboff); }
        }
        scur = scur + 1 == NS ? 0 : scur + 1; siss = siss + 1 == NS ? 0 : siss + 1;
    }
    asm volatile("s_waitcnt vmcnt(0)" ::: "memory");
    const float inv = 1.0f / (FAST ? lacc[0] : sum_xor32(l_run));
    bf16_t* orow = obuf + qrow * 256 + 64 * h;
#pragma unroll
    for (int db = 0; db < 2; ++db)
#pragma unroll
        for (int g = 0; g < 4; ++g)
            *(u32x2*)(orow + 32 * db + 8 * g + 4 * hi) = (u32x2){cvt_pk_bf16(o[db][4 * g] * inv, o[db][4 * g + 1] * inv), cvt_pk_bf16(o[db][4 * g + 2] * inv, o[db][4 * g + 3] * inv)};
}

template <bool FAST>
__device__ __forceinline__ void attn_c_unit(int b, int h, int qt, const bf16_t* qkv, bf16_t* oc, float lam, const float* subg, float coef, LAS unsigned char* lds, int tid, int lane, int w) {
    const int r32 = lane & 31, hi = lane >> 5;
    const size_t rowbase = (size_t)b * SEQ; const int q0 = 256 * qt, qloc = 32 * w + r32; const size_t qrow = rowbase + q0 + qloc;
    LAS unsigned char* qimg = lds + 65536 + w * 8192 + lane * 16;
    __syncthreads();
#pragma unroll
    for (int ks = 0; ks < 4; ++ks) { *(LAS bf16x8*)(qimg + ks * 1024) = *(const bf16x8*)(qkv + qrow * QP + C_Q1 + 64 * h + 16 * ks + 8 * hi); *(LAS bf16x8*)(qimg + 4096 + ks * 1024) = *(const bf16x8*)(qkv + qrow * QP + C_Q2 + 64 * h + 16 * ks + 8 * hi); }
    const bf16_t* k1src = FAST ? qkv + (rowbase + kdma_row(w, lane)) * QP + C_K1 + 64 * h + 8 * kdma_chunk(w, lane)
                               : qkv + (rowbase + lane) * QP + C_K1 + 64 * h + 8 * w;
    const bf16_t* k2src = k1src + (C_K2 - C_K1);
    const bf16_t* v0src = qkv + (rowbase + 16 * (w & 3) + (lane >> 2)) * QP + C_VC + 128 * h + 32 * (w >> 2) + 8 * (lane & 3);
    const bf16_t* v1src = v0src + 64;
    const int vboff = (4 * hi + ((lane & 15) >> 2)) * 64 + ((lane >> 4) & 1) * 32 + (lane & 3) * 8;
    const int NT = 4 * qt + 4;
    float m1 = -1e30f, l1 = 0.f, m2 = -1e30f, l2 = 0.f; f32x16 o1[4], o2[4];
#pragma unroll
    for (int i = 0; i < 4; ++i) { o1[i] = splat16(0.f); o2[i] = splat16(0.f); }
    dma16(k1src, lds + w * 1024); dma16(k2src, lds + 8192 + w * 1024); dma16(v0src, lds + 16384 + w * 1024); dma16(v1src, lds + 16384 + 8192 + w * 1024);
    DMA_WAIT_SYNC();
#pragma unroll 1
    for (int kt = 0; kt < NT; ++kt) {
        LAS unsigned char* cur = lds + (kt & 1) * 32768; LAS unsigned char* nxt = lds + ((kt + 1) & 1) * 32768;
        if (kt + 1 < NT) { const size_t adv = (size_t)(kt + 1) * 64 * QP;
            dma16(k1src + adv, nxt + w * 1024); dma16(k2src + adv, nxt + 8192 + w * 1024); dma16(v0src + adv, nxt + 16384 + w * 1024); dma16(v1src + adv, nxt + 16384 + 8192 + w * 1024); }
        const bool band = kt >= 4 * qt; const int kb0 = 64 * (kt & 3);
        if (!band || kb0 <= 32 * w + 31) { const MaskCausalIf mk{band, kb0, qloc, hi};
            if (FAST) flash_tile_dual_ref0<true>(l1, l2, o1, o2, cur, cur + 8192, cur + 16384, qimg, qimg + 4096, mk, r32, hi, vboff);
            else { flash_step<false, 4>(m1, l1, o1[0], o1, cur, cur + 16384, QLds{qimg}, mk, r32, hi, vboff); flash_step<false, 4>(m2, l2, o2[0], o2, cur + 8192, cur + 16384, QLds{qimg + 4096}, mk, r32, hi, vboff); } }
        DMA_WAIT_SYNC();
    }
    const float i1 = 1.0f / sum_xor32(l1), i2 = lam / sum_xor32(l2);
    float ss = 0.f;
#pragma unroll
    for (int db = 0; db < 4; ++db) { o1[db] = o1[db] * i1 - o2[db] * i2;
#pragma unroll
        for (int r = 0; r < 16; ++r) ss += o1[db][r] * o1[db][r]; }
    ss = sum_xor32(ss);
    const float rn = coef / sqrtf(ss * (1.0f / 128.0f) + EPS);
    bf16_t* orow = oc + qrow * 512 + 128 * h;
#pragma unroll
    for (int db = 0; db < 4; ++db)
#pragma unroll
        for (int g = 0; g < 4; ++g) { const int d = 32 * db + 8 * g + 4 * hi; const f32x4 gg = *(const f32x4*)(subg + d);
            *(u32x2*)(orow + d) = (u32x2){cvt_pk_bf16(o1[db][4 * g] * rn * gg[0], o1[db][4 * g + 1] * rn * gg[1]), cvt_pk_bf16(o1[db][4 * g + 2] * rn * gg[2], o1[db][4 * g + 3] * rn * gg[3])}; }
}

__device__ __forceinline__ void index_unit(int b, int i64, const bf16_t* qkv, unsigned* maskg, unsigned char* scr, LAS unsigned char* lds, int tid, int lane, int w) {
    constexpr int NS = 5, D = 4, HS = 257, RING = 84224, TOFF = 65792, TROW = 144;
    const int r32 = lane & 31, hi = lane >> 5;
    const unsigned lds0 = (unsigned)(size_t)lds;
    LAS unsigned* hist = (LAS unsigned*)lds; LAS unsigned char* ring = lds + RING; LAS unsigned char* mb8 = lds;
    LAS int* thrB1 = (LAS int*)(lds + 125184); LAS int* thrRem = thrB1 + 64; LAS int* thrT = thrB1 + 128; LAS int* thrNeed = thrB1 + 192;
    const size_t rowbase = (size_t)b * SEQ; const int q0 = 64 * i64, NT = i64 + 1;
    __syncthreads();
    {
        const int hh = 4 * ((r32 >> 3) & 1) + (r32 & 3), qp = 2 * (r32 >> 4) + ((r32 >> 2) & 1);
        bf16x8 aq[2][4]; float wv[2][2][8];
#pragma unroll
        for (int rb = 0; rb < 2; ++rb) {
            const size_t row = rowbase + q0 + 8 * w + 4 * rb + qp;
#pragma unroll
            for (int ks = 0; ks < 4; ++ks) aq[rb][ks] = *(const bf16x8*)(qkv + row * QP + C_QI + 64 * hh + 16 * ks + 8 * hi);
#pragma unroll
            for (int hf = 0; hf < 2; ++hf) { const u32x4 ww = *(const u32x4*)(qkv + (rowbase + q0 + 8 * w + 4 * rb + 2 * hf + hi) * QP + C_WI);
#pragma unroll
                for (int k = 0; k < 4; ++k) { wv[rb][hf][2 * k] = bf_lo(ww[k]); wv[rb][hf][2 * k + 1] = bf_hi(ww[k]); } }
        }
#pragma unroll
        for (int rb = 0; rb < 2; ++rb) { asm volatile("" : "+v"(aq[rb][0]), "+v"(aq[rb][1]), "+v"(aq[rb][2]), "+v"(aq[rb][3]));
#pragma unroll
            for (int hf = 0; hf < 2; ++hf) asm volatile("" : "+v"(wv[rb][hf][0]), "+v"(wv[rb][hf][1]), "+v"(wv[rb][hf][2]), "+v"(wv[rb][hf][3]), "+v"(wv[rb][hf][4]), "+v"(wv[rb][hf][5]), "+v"(wv[rb][hf][6]), "+v"(wv[rb][hf][7])); }
        const bf16_t* ksrc = qkv + (rowbase + kdma_row(w, lane)) * QP + C_KI + 8 * kdma_chunk(w, lane);
        const unsigned kdst0 = (unsigned)__builtin_amdgcn_readfirstlane(lds0 + RING + w * 1024);
#pragma unroll
        for (int d = 0; d < D; ++d) { const int t = d < NT ? d : NT - 1; glds16(ksrc + (size_t)t * 64 * QP, kdst0 + d * 8192); }
        for (int i = tid; i < 4112; i += 512) ((LAS u32x4*)hist)[i] = (u32x4){0u, 0u, 0u, 0u};
        asm volatile("s_waitcnt lgkmcnt(0)" ::: "memory");
        int scur = 0, siss = D;
#pragma unroll 1
        for (int kt = 0; kt <= NT; ++kt) {
            if (kt < NT) WAITV_BAR(3); else { asm volatile("s_waitcnt vmcnt(0)" ::: "memory"); __syncthreads(); }
            if (kt > 0) {
                const u32x4 kk = *(const LAS u32x4*)(lds + TOFF + ((kt - 1) & 1) * 9216 + lane * TROW + w * 16);
                {
                    const u32x4 ks = *(const LAS u32x4*)(lds + TOFF + ((kt - 1) & 1) * 9216 + (8 * w + (lane >> 3)) * TROW + (lane & 7) * 16);
                    unsigned char* sp = scr + (size_t)(8 * w + (lane >> 3)) * 8192 + (size_t)(kt - 1) * 128 + (lane & 7) * 16;
                    if (kt < NT) asm volatile("global_store_dwordx4 %0, %1, off" :: "v"(sp), "v"(ks) : "memory");
                    else *(u32x4*)sp = ks; }
#pragma unroll
                for (int k = 0; k < 4; ++k) { const unsigned a = kk[k] & 0xffffu, c = kk[k] >> 16;
                    if (a) __hip_atomic_fetch_add(&hist[lane * HS + (a >> 8)], 1u, __ATOMIC_RELAXED, __HIP_MEMORY_SCOPE_WORKGROUP);
                    if (c) __hip_atomic_fetch_add(&hist[lane * HS + (c >> 8)], 1u, __ATOMIC_RELAXED, __HIP_MEMORY_SCOPE_WORKGROUP); }
            }
            if (kt == NT) break;
            { const int t = kt + D < NT ? kt + D : NT - 1; glds16(ksrc + (size_t)t * 64 * QP, kdst0 + siss * 8192); }
            const LAS unsigned char* kimg = ring + scur * 8192;
            const bool diag = kt == NT - 1;
#pragma unroll
            for (int rb = 0; rb < 2; ++rb)
#pragma unroll
                for (int kb = 0; kb < 2; ++kb) {
                    f32x16 d = splat16(0.f);
#pragma unroll
                    for (int ks = 0; ks < 4; ++ks) { __builtin_amdgcn_s_setprio(1); d = mfma32(aq[rb][ks], *(const LAS bf16x8*)(kimg + kimg_off(32 * kb + r32, 2 * ks + hi)), d); __builtin_amdgcn_s_setprio(0); }
#pragma unroll
                    for (int hf = 0; hf < 2; ++hf) {
                        float sc = 0.f;
#pragma unroll
                        for (int t = 0; t < 8; ++t) { const float mx_ = fmaxf(d[8 * hf + t], 0.f); asm("v_fma_f32 %0, %1, %2, %0" : "+v"(sc) : "v"(wv[rb][hf][t]), "v"(mx_)); }
                        const int ql = 8 * w + 4 * rb + 2 * hf + hi;
                        const unsigned u = (unsigned)__builtin_bit_cast(unsigned short, (_Float16)sc);
                        unsigned key = u ^ ((u & 0x8000u) ? 0xffffu : 0x8000u);
                        if (diag && 32 * kb + r32 > ql) key = 0u;
                        *(LAS unsigned short*)(lds + TOFF + (kt & 1) * 9216 + ql * TROW + (32 * kb + r32) * 2) = (unsigned short)key;
                    }
                }
            scur = scur + 1 == NS ? 0 : scur + 1; siss = siss + 1 == NS ? 0 : siss + 1;
        }
        asm volatile("s_waitcnt vmcnt(0)" ::: "memory");
        __syncthreads();
    }
#define IDX_SEARCH(STAGE) do { _Pragma("unroll 1") for (int qq = 0; qq < 8; ++qq) { const int q = 8 * w + qq; int target; \
        if (STAGE == 0) { if (q0 + q + 1 <= 256) { if (lane == 0) { thrB1[q] = 0x10000; thrRem[q] = 0; } continue; } target = 256; } \
        else { if (thrB1[q] == 0x10000) { if (lane == 0) { thrT[q] = 0; thrNeed[q] = 0; } continue; } target = thrRem[q]; } \
        const LAS unsigned* hp = hist + q * HS + 4 * lane; const int h0 = (int)hp[0], h1 = (int)hp[1], h2 = (int)hp[2], h3 = (int)hp[3]; \
        int P = h0 + h1 + h2 + h3; const int s_ = P; \
        _Pragma("unroll") for (int o = 1; o < 64; o <<= 1) { const int t_ = lane_val(P, (lane - o) & 63); if (lane >= o) P += t_; } \
        const int above = __builtin_amdgcn_readlane(P, 63) - P; (void)s_; \
        const int c3 = above + h3, c2 = c3 + h2, c1 = c2 + h1, c0 = c1 + h0; int bin = -1, ab = 0; \
        if (above < target && c3 >= target) { bin = 4 * lane + 3; ab = above; } else if (c3 < target && c2 >= target) { bin = 4 * lane + 2; ab = c3; } \
        else if (c2 < target && c1 >= target) { bin = 4 * lane + 1; ab = c2; } else if (c1 < target && c0 >= target) { bin = 4 * lane; ab = c1; } \
        if (bin >= 0) { if (STAGE == 0) { thrB1[q] = bin; thrRem[q] = target - ab; } else { thrT[q] = (thrB1[q] << 8) | bin; thrNeed[q] = target - ab; } } } \
        __syncthreads(); } while (0)
    IDX_SEARCH(0);
    const int qs = 8 * w + (lane >> 3), pc = lane & 7;
    const unsigned char* rrow = scr + (size_t)qs * 8192 + pc * 16;
    {
        __builtin_amdgcn_fence(__ATOMIC_ACQUIRE, "agent");
        asm volatile("s_waitcnt vmcnt(0)" ::: "memory");
        const int b1 = thrB1[qs];
        for (int i = tid; i < 4112; i += 512) ((LAS u32x4*)hist)[i] = (u32x4){0u, 0u, 0u, 0u};
        __syncthreads();
#pragma unroll 4
        for (int it = 0; it < NT; ++it) { const u32x4 kk = *(const u32x4*)(rrow + (size_t)it * 128);
#pragma unroll
            for (int k = 0; k < 4; ++k) { const unsigned a = kk[k] & 0xffffu, c = kk[k] >> 16;
                if ((int)(a >> 8) == b1) __hip_atomic_fetch_add(&hist[qs * HS + (a & 255u)], 1u, __ATOMIC_RELAXED, __HIP_MEMORY_SCOPE_WORKGROUP);
                if ((int)(c >> 8) == b1) __hip_atomic_fetch_add(&hist[qs * HS + (c & 255u)], 1u, __ATOMIC_RELAXED, __HIP_MEMORY_SCOPE_WORKGROUP); } }
        __syncthreads();
    }
    IDX_SEARCH(1);
    {
        const unsigned T = (unsigned)thrT[qs]; const int need = thrNeed[qs]; int tc = 0;
        __syncthreads();
#pragma unroll 2
        for (int it = 0; it < NT; ++it) { const u32x4 kk = *(const u32x4*)(rrow + (size_t)it * 128);
            unsigned sel = 0, eq = 0;
#pragma unroll
            for (int k = 0; k < 4; ++k) { const unsigned a = kk[k] & 0xffffu, c = kk[k] >> 16;
                sel |= (a > T ? 1u : 0u) << (2 * k); sel |= (c > T ? 1u : 0u) << (2 * k + 1); eq |= (a == T ? 1u : 0u) << (2 * k); eq |= (c == T ? 1u : 0u) << (2 * k + 1); }
            if (T == 0u) eq = 0u;
            if (__ballot(eq != 0u) != 0ull) {
                const int n = __popc(eq); int P = n;
#pragma unroll
                for (int o = 1; o < 8; o <<= 1) { const int t_ = lane_val(P, (lane - o) & 63); if ((lane & 7) >= o) P += t_; }
                int allow = need - tc - (P - n);
#pragma unroll
                for (int k = 0; k < 8; ++k) if (((eq >> k) & 1u) && allow > 0) { sel |= 1u << k; --allow; }
                tc += lane_val(P, (lane & ~7) + 7);
            }
            mb8[qs * 512 + it * 8 + pc] = (unsigned char)sel;
        }
        __syncthreads();
    }
#undef IDX_SEARCH
    for (int idx = tid; idx < 64 * 2 * NT; idx += 512) { const int q = idx / (2 * NT), wd = idx - q * 2 * NT; maskg[(rowbase + q0 + q) * 128 + wd] = ((const LAS unsigned*)mb8)[q * 128 + wd]; }
}

__device__ __forceinline__ int next_unit(unsigned* ctr, LAS unsigned char* lds, int tid) {
    volatile LAS int* bc = (volatile LAS int*)(lds + LX_BC);
    __syncthreads();
    if (tid == 0) *bc = (int)__hip_atomic_fetch_add(ctr, 1u, __ATOMIC_RELAXED, __HIP_MEMORY_SCOPE_AGENT);
    __syncthreads();
    return __builtin_amdgcn_readfirstlane(*bc);
}

__device__ __forceinline__ void m1_phase(const Args& a, unsigned char* ws, int lc, LAS unsigned char* lds, int lane, int wave, int vcu, int G) {
    const int l = lc & 1;
    const float* wrt = (const float*)(ws + WS_WRT);
    const float* bg = a.in[I_B_GROUP] + l * 4; const float* br = a.in[I_B_ROUTER] + l * 32;
    unsigned* cnt = (unsigned*)(ws + WS_CTL) + CW_CNT + 2048 * lc;
    unsigned* rt0 = (unsigned*)(ws + WS_RT0); unsigned* rt1 = (unsigned*)(ws + WS_RT1); f32x2* rtw = (f32x2*)(ws + WS_RTW);
    int* tokl = (int*)(ws + WS_TOKL); float* rstdg = (float*)(ws + WS_RSTD); const unsigned char* x16 = ws + WS_X16;
    const int r32 = lane & 31, kh = lane >> 5, wq = wave & 3, kpart = wave >> 2;
    LAS float* tl = (LAS float*)(lds + wq * 8192);
    LAS float* tss = tl + 32 * 40;
    LAS float* xs = (LAS float*)(lds + 32768 + wave * 8704);
#pragma unroll 1
    for (int t = wq * G + vcu; t < MTOK / 32; t += 4 * G) {
        const unsigned char* xbase = x16 + ((size_t)(32 * t + (lane >> 3)) * DM + 512 * kpart + 8 * (lane & 7)) * 2;
        const float* wp0 = wrt + (size_t)r32 * DM + 512 * kpart + 4 * kh; const float* wp1 = wrt + (size_t)(32 + (r32 & 3)) * DM + 512 * kpart + 4 * kh;
        f32x16 d0 = splat16(0.f), d1 = splat16(0.f); float ss = 0.f;
        u32x4 xr[4];
#pragma unroll
        for (int j = 0; j < 4; ++j) xr[j] = *(const u32x4*)(xbase + (size_t)(8 * j) * (DM * 2));
#pragma unroll 1
        for (int c = 0; c < 8; ++c) {
#pragma unroll
            for (int j = 0; j < 4; ++j) { LAS float* d = xs + (8 * j + (lane >> 3)) * 68 + 8 * (lane & 7);
                *(LAS f32x4*)d = (f32x4){h_lo(xr[j][0]), h_hi(xr[j][0]), h_lo(xr[j][1]), h_hi(xr[j][1])}; *(LAS f32x4*)(d + 4) = (f32x4){h_lo(xr[j][2]), h_hi(xr[j][2]), h_lo(xr[j][3]), h_hi(xr[j][3])}; }
            if (c < 7) {
#pragma unroll
                for (int j = 0; j < 4; ++j) xr[j] = *(const u32x4*)(xbase + (size_t)(8 * j) * (DM * 2) + 128 * (c + 1)); }
            LDS_WAIT(); asm volatile("" ::: "memory");
#pragma unroll
            for (int mm = 0; mm < 8; ++mm) {
                const f32x4 xa = *(const LAS f32x4*)(xs + r32 * 68 + 8 * mm + 4 * kh), b0 = *(const f32x4*)(wp0 + 64 * c + 8 * mm), b1 = *(const f32x4*)(wp1 + 64 * c + 8 * mm);
                ss += (xa[0] * xa[0] + xa[1] * xa[1]) + (xa[2] * xa[2] + xa[3] * xa[3]);
#pragma unroll
                for (int i = 0; i < 4; ++i) { d0 = __builtin_amdgcn_mfma_f32_32x32x2f32(xa[i], b0[i], d0, 0, 0, 0); d1 = __builtin_amdgcn_mfma_f32_32x32x2f32(xa[i], b1[i], d1, 0, 0, 0); }
            }
            LDS_WAIT(); asm volatile("" ::: "memory");
        }
        ss = sum_xor32(ss);
        if (kpart == 1) {
#pragma unroll
            for (int r = 0; r < 16; ++r) { tl[crow(r, kh) * 40 + r32] = d0[r]; if (r32 < 4) tl[crow(r, kh) * 40 + 32 + r32] = d1[r]; }
            if (kh == 0) tss[r32] = ss;
        }
        __syncthreads();
        if (kpart == 0) {
#pragma unroll
            for (int r = 0; r < 16; ++r) { tl[crow(r, kh) * 40 + r32] += d0[r]; if (r32 < 4) tl[crow(r, kh) * 40 + 32 + r32] += d1[r]; }
            ss += tss[r32];
            LDS_WAIT(); asm volatile("" ::: "memory");
            const float rstd = 1.0f / sqrtf(ss * (1.0f / DM) + EPS);
            const LAS float* my = tl + r32 * 40;
            float gl[4];
#pragma unroll
            for (int c = 0; c < 4; ++c) gl[c] = my[c] * rstd + bg[c];
            int g = 0; float gm = gl[0];
#pragma unroll
            for (int c = 1; c < 4; ++c) if (gl[c] > gm) { gm = gl[c]; g = c; }
            float den = 0.f;
#pragma unroll
            for (int c = 0; c < 4; ++c) den += __expf(gl[c] - gm);
            const float gwt = 1.0f / den;
            float le[8];
#pragma unroll
            for (int e = 0; e < 8; ++e) le[e] = my[4 + 8 * g + e] * rstd + br[8 * g + e];
            int i1 = 0; float v1 = le[0];
#pragma unroll
            for (int e = 1; e < 8; ++e) if (le[e] > v1) { v1 = le[e]; i1 = e; }
            int i2 = -1; float v2 = NEG_INF;
#pragma unroll
            for (int e = 0; e < 8; ++e) if (e != i1 && le[e] > v2) { v2 = le[e]; i2 = e; }
            const float ex = __expf(v2 - v1), w1 = 1.0f / (1.0f + ex), w2 = ex * w1;
            if (kh == 0) { const int e0 = g * 8 + i1, e1 = g * 8 + i2, m = 32 * t + r32;
                const unsigned r0 = atomicAdd(cnt + 64 * e0, 1u), r1 = atomicAdd(cnt + 64 * e1, 1u);
                rt0[m] = ((unsigned)e0 << 24) | r0; rt1[m] = ((unsigned)e1 << 24) | r1; rtw[m] = (f32x2){gwt * w1, gwt * w2};
                tokl[e0 * 32768 + (int)r0] = m; tokl[e1 * 32768 + (int)r1] = m; }
            if (kh == 0) rstdg[32 * t + r32] = rstd;
        }
        __syncthreads();
    }
}
__device__ __forceinline__ void moe_tables(const unsigned* cnt, const int* tokl, const float* rstdg, LAS unsigned char* lds, int tid, int c, int G) {
    LAS int* pstart = (LAS int*)(lds + LX_PSTART); LAS int* blk2e = (LAS int*)(lds + LX_BLK2E); LAS int* cntl = (LAS int*)(lds + LX_CNT); LAS int* tok = (LAS int*)(lds + LX_TOK);
    if (tid < 64) {
        const int cn = tid < NEXP ? (int)cnt[64 * tid] : 0, nb = (cn + 255) >> 8;
        int P = nb;
#pragma unroll
        for (int o = 1; o < 64; o <<= 1) { const int t = lane_val(P, (tid - o) & 63); if (tid >= o) P += t; }
        const int pb = P - nb;
        if (tid <= NEXP) pstart[tid] = pb * 256;
        if (tid < NEXP) cntl[tid] = cn;
        if (tid == NEXP) *(LAS int*)(lds + LX_NBLK) = pb < MAXBLK ? pb : MAXBLK;
#pragma unroll 1
        for (int k = 0; k < nb; ++k) if (pb + k < MAXBLK) blk2e[pb + k] = tid;
    }
    __syncthreads();
    const int nblk = *(const LAS int*)(lds + LX_NBLK), rbs = G / 4;
    LAS float* rst = (LAS float*)(lds + LX_RST);
    for (int k = 0; k < 6; ++k) { const int rb = c / 4 + k * rbs; if (rb >= nblk) break;
        const int e = blk2e[rb], r = rb * 256 - pstart[e] + (tid & 255);
        if (tid < 256) { const int tk = r < cntl[e] ? tokl[e * 32768 + r] : 0; tok[k * 256 + tid] = tk; rst[k * 256 + tid] = rstdg[tk]; } }
    __syncthreads();
}

#ifndef PHASES
#define PHASES 0xFFFF
#endif
#define PH(n) if constexpr (((PHASES) >> (n)) & 1)
#ifndef REPEAT_MASK
#define REPEAT_MASK 0
#endif
#define REP(k) for (int rep_ = 0; rep_ < 1 + (((REPEAT_MASK) >> (k)) & 1); ++rep_)
#ifndef PROBE_SEL
#define PROBE_SEL 0
#endif
#define PROBE_MUL 10
#define PT0(p) do { if constexpr (((PROBE_SEL) >> (9 * L + (p))) & 1) pt_ -= (long long)wall_clock64(); } while (0)
#define PT1(p) do { if constexpr (((PROBE_SEL) >> (9 * L + (p))) & 1) pt_ += (long long)wall_clock64(); } while (0)
#ifndef GEMM_ALIGN
#define GEMM_ALIGN true
#endif
#ifndef GEMM_SP2
#define GEMM_SP2 true
#endif
#define PHASE_ENV() unsigned long long wsi_ = (unsigned long long)args.ws; int G = (int)gridDim.x, bx = (int)blockIdx.x; asm volatile("" : "+s"(wsi_), "+s"(G), "+s"(bx)); \
    unsigned long long obi_ = (unsigned long long)args.out; asm volatile("" : "+s"(obi_)); unsigned char* const outb = (unsigned char*)(GAS unsigned char*)obi_; (void)outb;   \
    unsigned char* const ws = (unsigned char*)(GAS unsigned char*)wsi_; const int vcu = (G % 8 == 0) ? (bx % 8) * (G / 8) + bx / 8 : bx;   \
    int tid = (int)threadIdx.x; asm volatile("" : "+v"(tid)); const int lane = tid & 63, wave = __builtin_amdgcn_readfirstlane(tid >> 6); \
    unsigned* const ctl = (unsigned*)(ws + WS_CTL); bf16_t* const QKV = (bf16_t*)(ws + WS_QKV); unsigned char* const SG = ws + WS_SG; unsigned* const MASK = (unsigned*)(ws + WS_MASK); float* const KMEAN = (float*)(ws + WS_KMEAN); \
    (void)lane; (void)wave; (void)ctl; (void)QKV; (void)SG; (void)MASK; (void)KMEAN; (void)vcu
#define GRID_BAR() do { unsigned long long wb_ = (unsigned long long)args.ws; asm volatile("" : "+s"(wb_)); XcdBarrier b_ = bar0; b_.bar = (unsigned*)((GAS unsigned char*)wb_ + WS_CTL) + CW_BAR; asm volatile("" : "+s"(b_.x)); xcd_barrier(b_); if (((REPEAT_MASK) >> 12) & 1) xcd_barrier(b_); } while (0)


template <int L> __device__ __forceinline__ void layer_body(const Args& args, LAS unsigned char* lds, const XcdBarrier& bar0, long long& pt_) {
    constexpr int l = L;
        PT0(0);

        PH(0) for (int rep_ = 0; rep_ < 1 + ((((REPEAT_MASK) >> 0) & 1) && l == 0); ++rep_) { PHASE_ENV(); p0_phase(args, ws, l, lds, tid, lane, wave, vcu, G); }
        GRID_BAR(); PT1(0); PT0(1);
        PH(1) REP(1) { PHASE_ENV();
            pg8::Gemm g{(const bf16_t*)(ws + WS_X16), (const bf16_t*)(ws + WS_WIN), MTOK, NT_IN * 256, DM}; pg8::StaticOrder S; S.init(MTOK, NT_IN * 256, G, bx);
            pg8::EpiInProj E{QKV, SG, (const float*)(ws + WS_COS), (const float*)(ws + WS_SIN), args.in[I_QK_GAIN] + l * 6 * 64, args.in[I_IDX_K_GAIN] + l * 64, (const float*)(ws + WS_RSTD1)};
            pg8::gemm_phase<pg8::EpiInProj, pg8::StaticOrder, GEMM_ALIGN, GEMM_SP2>(lds, g, S, E);
        }
        GRID_BAR(); PT1(1); PT0(2);
        { PHASE_ENV();
            LAS float* red = (LAS float*)lds;
            for (int it = bx; it < NBATCH * 4 * 16; it += G) { const int b = it >> 6, h = (it >> 4) & 3, blk = it & 15, d = tid & 63, rg = tid >> 6;
                const bf16_t* kp = QKV + ((size_t)b * SEQ + blk * 256 + rg * 32) * QP + C_KA + 64 * h + d; float s = 0.f;
#pragma unroll 8
                for (int r = 0; r < 32; ++r) s += __builtin_bit_cast(float, (unsigned)kp[(size_t)r * QP] << 16);
                __syncthreads(); red[tid] = s; __syncthreads();
                if (tid < 64) { float t = 0.f;
#pragma unroll
                    for (int k = 0; k < 8; ++k) t += red[k * 64 + tid];
                    KMEAN[(size_t)it * 64 + tid] = t * (1.0f / 256.0f); } }
            __syncthreads();
        }
        PH(2) REP(2) { PHASE_ENV();
            const float* dl = args.in[I_DIFF_LAMBDA] + l * 256;
            const float lam_init = 0.8f - 0.6f * __expf(-0.3f * (float)l);
            const float lam = __expf(wave_sum(dl[lane] * dl[64 + lane])) - __expf(wave_sum(dl[128 + lane] * dl[192 + lane])) + lam_init;
            const float* subg = args.in[I_DIFF_SUBLN] + l * 128;
            unsigned* qc = ctl + CW_QUEUE + 64 * (l * 4 + 0 + 8 * rep_);
            const float* qkg = args.in[I_QK_GAIN] + l * 6 * 64;
            if (softmax_ref0_ok(qkg + 4 * 64, qkg + 5 * 64, lane)) { for (;;) { const int u = next_unit(qc, lds, tid); if (u >= 512) break; const int r = u & 31; attn_c_unit<true>(r >> 2, r & 3, 15 - (u >> 5), QKV, (bf16_t*)(outb + OUT_OC), lam, subg, 1.0f - lam_init, lds, tid, lane, wave); } }
            else { for (;;) { const int u = next_unit(qc, lds, tid); if (u >= 512) break; const int r = u & 31; attn_c_unit<false>(r >> 2, r & 3, 15 - (u >> 5), QKV, (bf16_t*)(outb + OUT_OC), lam, subg, 1.0f - lam_init, lds, tid, lane, wave); } }
        }
        PH(3) REP(3) { PHASE_ENV();
            unsigned* qi = ctl + CW_QUEUE + 64 * (l * 4 + 1 + 8 * rep_);
            for (;;) { const int u = next_unit(qi, lds, tid); if (u >= 512) break; index_unit(u & 7, 63 - (u >> 3), QKV, MASK, bx < 192 ? ws + WS_WGU + (size_t)bx * 524288 : outb + OUT_SCR + (size_t)(bx - 192) * 524288, lds, tid, lane, wave); }
        }
        GRID_BAR(); PT1(2); PT0(3);
        PH(4) REP(4) { PHASE_ENV();
            unsigned* qa = ctl + CW_QUEUE + 64 * (l * 4 + 2 + 8 * rep_);
            const float* qkg = args.in[I_QK_GAIN] + l * 6 * 64;
            if (softmax_ref0_ok(qkg, qkg + 64, lane)) { for (;;) { const int u = next_unit(qa, lds, tid); if (u >= 512) break; const int r = u & 31; attn_ab_unit<0, true>(r >> 2, r & 3, 15 - (u >> 5), QKV, (bf16_t*)(outb + OUT_OA), KMEAN, MASK, lds, tid, lane, wave); } }
            else { for (;;) { const int u = next_unit(qa, lds, tid); if (u >= 512) break; const int r = u & 31; attn_ab_unit<0, false>(r >> 2, r & 3, 15 - (u >> 5), QKV, (bf16_t*)(outb + OUT_OA), KMEAN, MASK, lds, tid, lane, wave); } }
        }
        PH(5) REP(5) { PHASE_ENV();
            unsigned* qb = ctl + CW_QUEUE + 64 * (l * 4 + 3 + 8 * rep_);
            const float* qkg = args.in[I_QK_GAIN] + l * 6 * 64;
            if (softmax_ref0_ok(qkg + 2 * 64, qkg + 3 * 64, lane)) { for (;;) { const int u = next_unit(qb, lds, tid); if (u >= 512) break; const int r = u & 31; attn_ab_unit<1, true>(r >> 2, r & 3, 15 - (u >> 5), QKV, (bf16_t*)(outb + OUT_OB), KMEAN, MASK, lds, tid, lane, wave); } }
            else { for (;;) { const int u = next_unit(qb, lds, tid); if (u >= 512) break; const int r = u & 31; attn_ab_unit<1, false>(r >> 2, r & 3, 15 - (u >> 5), QKV, (bf16_t*)(outb + OUT_OB), KMEAN, MASK, lds, tid, lane, wave); } }
        }
        { PHASE_ENV();
            unsigned* qw = ctl + CW_QUEUE + 64 * (16 + l);
            for (;;) { const int c = next_unit(qw, lds, tid); if (c >= (32 * 32 * 16 + 32 * 32 * 8) / 128) break; convert_weights<true>(args, ws, l, lds, lane, wave, vcu, G, c); }
        }
        GRID_BAR(); PT1(3); PT0(4);
        PH(6) REP(6) {
            int nr_; { PHASE_ENV(); nr_ = (MTOK / 256 * (DM / 256) + G - 1) / G; }
#pragma unroll 1
            for (int i_ = 0; i_ < nr_; ++i_) {
                { PHASE_ENV(); pg8::OneUnit S; S.S.init(MTOK, DM, G, bx); S.i = i_; pg8::Gemm g{(const bf16_t*)(outb + OUT_OA), (const bf16_t*)(ws + WS_WPA), MTOK, DM, 256}; pg8::EpiMerge<0> E{(bf16_t*)(ws + WS_MERGED), SG}; pg8::gemm_phase<pg8::EpiMerge<0>, pg8::OneUnit, GEMM_ALIGN, GEMM_SP2>(lds, g, S, E); }
                { PHASE_ENV(); pg8::OneUnit S; S.S.init(MTOK, DM, G, bx); S.i = i_; pg8::Gemm g{(const bf16_t*)(outb + OUT_OB), (const bf16_t*)(ws + WS_WPB), MTOK, DM, 256}; pg8::EpiMerge<1> E{(bf16_t*)(ws + WS_MERGED), SG}; pg8::gemm_phase<pg8::EpiMerge<1>, pg8::OneUnit, GEMM_ALIGN, GEMM_SP2>(lds, g, S, E); }
                { PHASE_ENV(); pg8::OneUnit S; S.S.init(MTOK, DM, G, bx); S.i = i_; pg8::Gemm g{(const bf16_t*)(outb + OUT_OC), (const bf16_t*)(ws + WS_WPC), MTOK, DM, 512}; pg8::EpiMerge<2> E{(bf16_t*)(ws + WS_MERGED), SG}; pg8::gemm_phase<pg8::EpiMerge<2>, pg8::OneUnit, GEMM_ALIGN, GEMM_SP2>(lds, g, S, E); }
            }
        }
        GRID_BAR(); PT1(4); PT0(5);
        PH(7) for (int rep_ = 0; rep_ < 1 + ((((REPEAT_MASK) >> 7) & 1) && l == 0); ++rep_) { PHASE_ENV();
            pg8::Gemm g{(const bf16_t*)(ws + WS_MERGED), (const bf16_t*)(ws + WS_WO), MTOK, DM, DM}; pg8::StaticOrder S; S.init(MTOK, DM, G, bx);
            pg8::EpiResid E{ws + WS_X16};
            pg8::gemm_phase<pg8::EpiResid, pg8::StaticOrder, GEMM_ALIGN, GEMM_SP2>(lds, g, S, E);
        }
        GRID_BAR(); PT1(5); PT0(6);
        PH(8) REP(8) { PHASE_ENV(); m1_phase(args, ws, l + 2 * rep_, lds, lane, wave, vcu, G); }
        GRID_BAR(); PT1(6); PT0(7);
        { PHASE_ENV(); moe_tables(ctl + CW_CNT + 2048 * (l + 2 * (((REPEAT_MASK) >> 8) & 1)), (const int*)(ws + WS_TOKL), (const float*)(ws + WS_RSTD), lds, tid, vcu, G); }
        PH(10) REP(10) { PHASE_ENV();
            const int nblk = *(const LAS int*)(lds + LX_NBLK);
            pg8::Gemm g{(const bf16_t*)(ws + WS_X16), (const bf16_t*)(ws + WS_WGU), MTOK, NEXP * 1024, DM};
            pg8::MoeOrder S{nblk * 4, G, vcu, (const LAS int*)(lds + LX_BLK2E)};
            pg8::EpiGateUp E{(bf16_t*)(ws + WS_HID), (const LAS float*)(lds + LX_RST), G / 4}; pg8::AMapMoe AM{(const LAS int*)(lds + LX_TOK), G / 4};
            pg8::gemm_phase<pg8::EpiGateUp, pg8::MoeOrder, GEMM_ALIGN, GEMM_SP2, pg8::AMapMoe>(lds, g, S, E, AM);
        }
        GRID_BAR(); PT1(7); PT0(8);
        PH(11) REP(11) { PHASE_ENV();
            const int nblk = *(const LAS int*)(lds + LX_NBLK);
            pg8::Gemm g{(const bf16_t*)(ws + WS_HID), (const bf16_t*)(ws + WS_WD), MAXBLK * 256, NEXP * 1024, DEXP};
            pg8::MoeOrder S{nblk * 4, G, vcu, (const LAS int*)(lds + LX_BLK2E)};
            pg8::EpiDown E{(bf16_t*)(ws + WS_Y)};
            pg8::gemm_phase<pg8::EpiDown, pg8::MoeOrder, GEMM_ALIGN, GEMM_SP2>(lds, g, S, E);
        }
        GRID_BAR(); PT1(8);
    }

__global__ void __launch_bounds__(512, 2) fwd_kernel(Args args) {
    extern __shared__ __attribute__((aligned(16))) unsigned char lds_raw[];
    LAS unsigned char* lds = (LAS unsigned char*)lds_raw;
    for (int u = threadIdx.x; u < (LDS_BYTES - LDSX) / 4; u += 512) ((LAS unsigned*)(lds + LDSX))[u] = 0u;
    __syncthreads();
    const XcdBarrier bar0 = xcd_barrier_post((unsigned*)(args.ws + WS_CTL) + CW_BAR, (volatile LAS unsigned*)(lds + LX_BAR));
    long long pt_ = 0;
    layer_body<0>(args, lds, bar0, pt_);
    layer_body<1>(args, lds, bar0, pt_);
    if constexpr (((PROBE_SEL) >> 18) & 1) pt_ -= (long long)wall_clock64();
    { PHASE_ENV();
        const int gw = vcu * 8 + wave, NGW = G * 8; const LAS int* pstart = (const LAS int*)(lds + LX_PSTART);
        for (int m = gw; m < MTOK; m += NGW) token_row<false, true, true>(nullptr, ws + WS_X16, args.out, (const bf16_t*)(ws + WS_Y), (const unsigned*)(ws + WS_RT0), (const unsigned*)(ws + WS_RT1), (const f32x2*)(ws + WS_RTW), pstart, nullptr, m, lane);
    }
    if constexpr ((PROBE_SEL) != 0) {
        if constexpr (((PROBE_SEL) >> 18) & 1) { __syncthreads(); pt_ += (long long)wall_clock64(); }
        if (blockIdx.x == 0) { const long long t_end = (long long)wall_clock64() + PROBE_MUL * pt_; while ((long long)wall_clock64() < t_end) __builtin_amdgcn_s_sleep(8); }
    }
}

extern "C" void kernel_launch(void* const* d_in, const int* in_sizes, int n_in, void* d_out, int out_size, void* d_ws, size_t ws_size, hipStream_t stream) {
    static int grid = 0;
    if (grid == 0) {
        if (n_in != N_INPUTS || in_sizes[0] != MTOK * DM || out_size != MTOK * DM || ws_size < WS_END) {
            fprintf(stderr, "kernel_launch: built for %d inputs, x/out of %d floats, >= %zu bytes of workspace; got n_in %d, in0 %d, out %d, ws %zu; nothing launched\n", (int)N_INPUTS, MTOK * DM, (size_t)WS_END, n_in, n_in > 0 ? in_sizes[0] : -1, out_size, ws_size);
            grid = -1; return; }
        int dev = 0, cus = 0;
        if (hipGetDevice(&dev) != hipSuccess || hipDeviceGetAttribute(&cus, hipDeviceAttributeMultiprocessorCount, dev) != hipSuccess) { fprintf(stderr, "kernel_launch: device query failed\n"); grid = -1; return; }
        if (hipFuncSetAttribute((const void*)fwd_kernel, hipFuncAttributeMaxDynamicSharedMemorySize, LDS_BYTES) != hipSuccess) { fprintf(stderr, "kernel_launch: hipFuncSetAttribute failed\n"); grid = -1; return; }
        int per_cu = 0;
        if (hipOccupancyMaxActiveBlocksPerMultiprocessor(&per_cu, (const void*)fwd_kernel, 512, LDS_BYTES) != hipSuccess || per_cu < 1) fprintf(stderr, "kernel_launch: note: occupancy query reports %d workgroups per CU\n", per_cu);
        (void)hipGetLastError();
        grid = cus < 256 ? cus : 256;
    }
    if (grid < 0) return;
    if (hipMemsetAsync((char*)d_ws + WS_CTL, 0, CTL_BYTES, stream) != hipSuccess) { fprintf(stderr, "kernel_launch: memset failed\n"); return; }
    Args a{};
    for (int i = 0; i < N_INPUTS; ++i) a.in[i] = (const float*)d_in[i];
    a.out = (float*)d_out; a.ws = (unsigned char*)d_ws;
    hipLaunchKernelGGL(fwd_kernel, dim3(grid), dim3(512), LDS_BYTES, stream, a);
    const hipError_t le = hipPeekAtLastError();
    if (le != hipSuccess) fprintf(stderr, "kernel_launch: launch failed: %s\n", hipGetErrorName(le));
}
```

```cpp
#include <hip/hip_runtime.h>
#include <cstdio>
#include <cstdint>

#define LAS __attribute__((address_space(3)))
#define GAS __attribute__((address_space(1)))
typedef unsigned short bf16_t;
typedef short bf16x8 __attribute__((ext_vector_type(8)));
typedef short s16x4 __attribute__((ext_vector_type(4)));
typedef float f32x4 __attribute__((ext_vector_type(4)));
typedef float f32x2 __attribute__((ext_vector_type(2)));
typedef float f32x16 __attribute__((ext_vector_type(16)));
typedef unsigned u32x4 __attribute__((ext_vector_type(4)));
typedef unsigned u32x2 __attribute__((ext_vector_type(2)));

constexpr int NBATCH = 8, SEQ = 4096, MTOK = NBATCH * SEQ, DM = 1024, NLAYER = 2;
constexpr int QP = 3656;
constexpr int C_QA = 0, C_KA = 256, C_VA = 512, C_QB = 768, C_KB = 1024, C_VB = 1280, C_QI = 1536, C_KI = 2048, C_WI = 2112,
              C_Q1 = 2120, C_Q2 = 2376, C_K1 = 2632, C_K2 = 2888, C_VC = 3144, C_G = 3656, D_IN = 6728;
constexpr int NT_IN = 27;
constexpr int NEXP = 32, DEXP = 512, MAXBLK = 288;
constexpr float C2 = 0.125f * 1.4426950408889634f;
constexpr float EPS = 1e-6f;
#ifndef PROBE_KL
#define PROBE_KL 0
#endif
#ifndef REF0_ENABLE
#define REF0_ENABLE 1
#endif

constexpr size_t MiB = 1u << 20;
constexpr size_t WS_CTL = 0, CTL_BYTES = 1 * MiB;
constexpr size_t WS_COS = 1 * MiB, WS_SIN = WS_COS + 512 * 1024;
constexpr size_t WS_SMALL = 2 * MiB;
constexpr size_t WS_RSTD1 = WS_SMALL + 128 * 1024;
constexpr size_t WS_KMEAN = WS_SMALL, WS_RT0 = WS_SMALL + 256 * 1024, WS_RT1 = WS_SMALL + 384 * 1024, WS_RTW = WS_SMALL + 512 * 1024, WS_WRT = WS_SMALL + 768 * 1024;
constexpr size_t WS_WIN = 3 * MiB;
constexpr size_t WS_WPA = 17 * MiB, WS_WPB = WS_WPA + 512 * 1024, WS_WPC = 18 * MiB;
constexpr size_t WS_WO = 19 * MiB;
constexpr size_t WS_WGU = 21 * MiB;
constexpr size_t WS_WD = 85 * MiB;
constexpr size_t WS_X16 = 117 * MiB;
constexpr size_t OUT_OA = 0, OUT_OB = 16 * MiB, OUT_OC = 32 * MiB, OUT_SCR = 64 * MiB;
constexpr size_t WS_QKV = 181 * MiB;
constexpr size_t WS_MERGED = WS_QKV, WS_Y = WS_QKV, WS_HID = WS_QKV + 144 * MiB;
constexpr size_t WS_TOKL = WS_QKV + 64 * MiB, WS_RSTD = WS_QKV + 68 * MiB;
constexpr size_t WS_SG = 410 * MiB;
constexpr size_t WS_MASK = 506 * MiB;
constexpr size_t WS_END = 522 * MiB;
static_assert((size_t)MTOK * QP * 2 <= 229 * MiB && (size_t)MAXBLK * 256 * 1024 * 2 <= 144 * MiB && (size_t)MAXBLK * 256 * 512 * 2 <= 72 * MiB, "ws map");
constexpr int CW_BAR = 4096;
constexpr int CW_QUEUE = 8192;
constexpr int CW_CNT = 16384;

constexpr int LDSX = 131072;
constexpr int LX_BAR = LDSX, LX_BC = LDSX + 16, LX_NBLK = LDSX + 32, LX_PSTART = LDSX + 64, LX_BLK2E = LDSX + 256, LX_CNT = LDSX + 1536, LX_TOK = LDSX + 2048, LX_RST = LDSX + 2048 + 6144;
constexpr int LDS_BYTES = 147456;

typedef __bf16 bf16x2_t __attribute__((ext_vector_type(2)));
__device__ __forceinline__ unsigned cvt_pk_bf16(float lo, float hi) { const f32x2 v = {lo, hi}; const bf16x2_t b = __builtin_convertvector(v, bf16x2_t); return __builtin_bit_cast(unsigned, b); }
typedef _Float16 f16x2_t __attribute__((ext_vector_type(2)));
__device__ __forceinline__ unsigned cvt_pk_f16(float lo, float hi) { const f32x2 v = {__builtin_amdgcn_fmed3f(lo, -65504.f, 65504.f), __builtin_amdgcn_fmed3f(hi, -65504.f, 65504.f)}; return __builtin_bit_cast(unsigned, __builtin_convertvector(v, f16x2_t)); }
__device__ __forceinline__ float h_lo(unsigned w) { return (float)__builtin_bit_cast(f16x2_t, w)[0]; }
__device__ __forceinline__ float h_hi(unsigned w) { return (float)__builtin_bit_cast(f16x2_t, w)[1]; }
__device__ __forceinline__ float bf_lo(unsigned w) { return __builtin_bit_cast(float, w << 16); }
__device__ __forceinline__ float bf_hi(unsigned w) { return __builtin_bit_cast(float, w & 0xffff0000u); }
template <int M> __device__ __forceinline__ float xor_lane(float v) {
    return __builtin_bit_cast(float, __builtin_amdgcn_ds_swizzle(__builtin_bit_cast(int, v), (M << 10) | 0x1f)); }
__device__ __forceinline__ float sum_xor32(float v) {
    const unsigned u = __builtin_bit_cast(unsigned, v); const auto rr = __builtin_amdgcn_permlane32_swap(u, u, false, false);
    return __builtin_bit_cast(float, (unsigned)rr[0]) + __builtin_bit_cast(float, (unsigned)rr[1]); }
__device__ __forceinline__ float max_xor32(float v) {
    const unsigned u = __builtin_bit_cast(unsigned, v); const auto rr = __builtin_amdgcn_permlane32_swap(u, u, false, false);
    return fmaxf(__builtin_bit_cast(float, (unsigned)rr[0]), __builtin_bit_cast(float, (unsigned)rr[1])); }
__device__ __forceinline__ int lane_val(int v, int src_lane) { return __builtin_amdgcn_ds_bpermute(src_lane << 2, v); }
__device__ __forceinline__ float wave_sum(float v) {
    v += xor_lane<1>(v); v += xor_lane<2>(v); v += xor_lane<4>(v); v += xor_lane<8>(v); v += xor_lane<16>(v);
    return sum_xor32(v);
}
__device__ __forceinline__ float fast_exp2(float x) { return __builtin_amdgcn_exp2f(x); }
__device__ __forceinline__ float fast_rcp(float x) { return __builtin_amdgcn_rcpf(x); }

namespace pg8 {
#define PG8_LAS __attribute__((address_space(3)))
typedef unsigned short bf16_t;
typedef short bf16x8 __attribute__((ext_vector_type(8)));
typedef float f32x4 __attribute__((ext_vector_type(4)));
typedef unsigned u32x4 __attribute__((ext_vector_type(4)));
constexpr int BM = 256, BK = 64, HALF = 128, HTB = HALF * BK * 2  , STAGE_BYTES = 8 * HTB, NXCD = 8, WGM = 8;

__host__ __device__ __forceinline__ int lds_byte(int r, int c) { const int st = (r >> 4) * 2 + (c >> 5), rr = r & 15, cc = c & 31, ob = rr * 64 + cc * 2; return st * 1024 + (ob ^ (((ob >> 9) & 1) << 5)); }
__host__ __device__ __forceinline__ void stage_rc(int b, int& R, int& C) { const int st = b / 1024, sb = b % 1024, swz = sb ^ (((sb >> 9) & 1) << 5); R = (st >> 1) * 16 + swz / 64; C = (st & 1) * 32 + (swz % 64) / 2; }
__host__ __device__ __forceinline__ int perm32(int rho) { const int n = rho >> 4, i = rho & 15; return 8 * (i >> 2) + 4 * n + (i & 3); }
struct Unit { int pm, pn; };
struct Gemm { const bf16_t* A; const bf16_t* Bt; int M, N, K; };

struct StaticOrder {
    int nM, nN, nwg, G, c;
    __host__ __device__ void init(int M, int N, int G_, int c_) { nM = M / BM; nN = N / BM; nwg = nM * nN; G = G_; c = c_; }
    __host__ __device__ bool next(int i, Unit& u) const {
        const long L = (long)i * G + c; if (L >= nwg) return false;
        int wgid = (int)L; { const int q = nwg / NXCD, r = nwg % NXCD, xcd = wgid % NXCD, off = wgid / NXCD; wgid = (xcd < r ? xcd * (q + 1) : r * (q + 1) + (xcd - r) * q) + off; }
        const int nig = WGM * nN, gid = wgid / nig, fm = gid * WGM, gsz = (nM - fm) < WGM ? (nM - fm) : WGM;
        u.pm = fm + ((wgid % nig) % gsz); u.pn = (wgid % nig) / gsz; return true;
    }
    __device__ __forceinline__ void a_ready(const Unit&) const {}
    __device__ __forceinline__ void done(const Unit&) const {}
};
struct OneUnit {
    StaticOrder S; int i;
    __device__ __forceinline__ bool next(int k, Unit& u) const { return k == 0 && S.next(i, u); }
    __device__ __forceinline__ void a_ready(const Unit&) const {}
    __device__ __forceinline__ void done(const Unit&) const {}
};


struct EpiInProj {
    static constexpr int KIND = 1; static constexpr bool PERM = false, AFTER_DRAIN = false, F16 = true;
    bf16_t* qkv; unsigned char* sg; const float* cosT; const float* sinT; const float* qkg; const float* ikg; const float* rstd;
    __device__ __forceinline__ void operator()(const f32x4 (&acc)[2][2][4][2], const Unit& u, int wr, int wc, int fr, int fq) const {
        const int pn = u.pn, row0 = u.pm * BM + wr * 64 + fr;
        float rsv[2][4];
#pragma unroll
        for (int ai = 0; ai < 2; ++ai)
#pragma unroll
            for (int m = 0; m < 4; ++m) rsv[ai][m] = rstd[row0 + ai * HALF + m * 16];
        if (pn >= 15) {
            unsigned char* base = sg + (size_t)row0 * 3072 + (pn - 15) * 256 + wc * 64 + fq * 16;
#pragma unroll
            for (int ai = 0; ai < 2; ++ai)
#pragma unroll
                for (int m = 0; m < 4; ++m) {
                    unsigned w[2][2]; const float rs = -1.4426950408889634f * rsv[ai][m];
#pragma unroll
                    for (int bj = 0; bj < 2; ++bj)
#pragma unroll
                        for (int n = 0; n < 2; ++n) { unsigned pk = 0;
#pragma unroll
                            for (int i = 0; i < 4; i += 2) { const float x0 = fminf(fmaxf(acc[ai][bj][m][n][i] * rs, -43.f), 43.f), x1 = fminf(fmaxf(acc[ai][bj][m][n][i + 1] * rs, -43.f), 43.f);
                                const float a = 1.0f + fast_exp2(x0), b = 1.0f + fast_exp2(x1), r = 255.0f * fast_rcp(a * b);
                                pk = __builtin_amdgcn_cvt_pk_u8_f32(floorf(b * r + 0.5f), i, pk); pk = __builtin_amdgcn_cvt_pk_u8_f32(floorf(a * r + 0.5f), i + 1, pk); }
                            w[bj][n] = pk; }
                    *(u32x4*)(base + (size_t)(ai * HALF + m * 16) * 3072) = (u32x4){w[0][0], w[0][1], w[1][0], w[1][1]};
                }
            return;
        }
        int type = 0, gi = 0; bool qscale = false;
        int ocol = (pn < 8 ? 256 * pn : C_Q1 + 256 * (pn - 9)) + 64 * wc;
        switch (pn) {
            case 0: type = 2; gi = 0; qscale = true; break;
            case 1: type = 2; gi = 1; break;
            case 3: type = 2; gi = 2; qscale = true; break;
            case 4: type = 2; gi = 3; break;
            case 6: case 7: type = 1; break;
            case 8: if (wc == 0) { type = 2; ocol = C_KI; } else if (wc == 1) { type = 3; ocol = C_WI; } else type = 4; break;
            case 9: case 10: type = 2; gi = 4; qscale = true; break;
            case 11: case 12: type = 2; gi = 5; break;
            default: type = 0; break;
        }
        if (type == 4) return;
        if (type == 3) {
            if (fq == 0) {
#pragma unroll
                for (int ai = 0; ai < 2; ++ai)
#pragma unroll
                    for (int m = 0; m < 4; ++m) { const float rs = 0.35355339059327373f * rsv[ai][m]; const f32x4 a = acc[ai][0][m][0] * rs, b = acc[ai][0][m][1] * rs;
                        *(u32x4*)(qkv + (size_t)(row0 + ai * HALF + m * 16) * QP + C_WI) = (u32x4){cvt_pk_bf16(a[0], a[1]), cvt_pk_bf16(a[2], a[3]), cvt_pk_bf16(b[0], b[1]), cvt_pk_bf16(b[2], b[3])}; }
            }
            return;
        }
        const float* gp = (pn == 8) ? ikg : qkg + 64 * gi;
        if (type == 2) { if (qscale) body<2, true>(acc, row0, ocol, gp, fq, rsv); else body<2, false>(acc, row0, ocol, gp, fq, rsv); }
        else if (type == 1) body<1, false>(acc, row0, ocol, gp, fq, rsv);
        else body<0, false>(acc, row0, ocol, gp, fq, rsv);
    }
    template <int TYPE, bool QS>
    __device__ __forceinline__ void body(const f32x4 (&acc)[2][2][4][2], int row0, int ocol, const float* gp, int fq, const float (&rsv)[2][4]) const {
#pragma unroll
        for (int ai = 0; ai < 2; ++ai)
#pragma unroll
            for (int m = 0; m < 4; ++m) {
                const int row = row0 + ai * HALF + m * 16; const float rs = rsv[ai][m];
                f32x4 x[2][2];
#pragma unroll
                for (int bj = 0; bj < 2; ++bj)
#pragma unroll
                    for (int n = 0; n < 2; ++n) x[bj][n] = acc[ai][bj][m][n] * rs;
                if (TYPE == 2) {
                    float ss = 0.f;
#pragma unroll
                    for (int bj = 0; bj < 2; ++bj)
#pragma unroll
                        for (int n = 0; n < 2; ++n) ss += (x[bj][n][0] * x[bj][n][0] + x[bj][n][1] * x[bj][n][1]) + (x[bj][n][2] * x[bj][n][2] + x[bj][n][3] * x[bj][n][3]);
                    ss += xor_lane<16>(ss); ss = sum_xor32(ss);
                    const float inv = (QS ? C2 : 1.0f) / sqrtf(ss * (1.0f / 64.0f) + EPS);
#pragma unroll
                    for (int bj = 0; bj < 2; ++bj)
#pragma unroll
                        for (int n = 0; n < 2; ++n) x[bj][n] = x[bj][n] * inv * *(const f32x4*)(gp + 32 * bj + 8 * fq + 4 * n);
                }
                if (TYPE >= 1) {
                    const int pos = row & (SEQ - 1);
#pragma unroll
                    for (int n = 0; n < 2; ++n) {
                        const f32x4 c = *(const f32x4*)(cosT + pos * 32 + 8 * fq + 4 * n), s = *(const f32x4*)(sinT + pos * 32 + 8 * fq + 4 * n);
                        const f32x4 a = x[0][n], b = x[1][n];
                        x[0][n] = a * c - b * s; x[1][n] = b * c + a * s;
                    }
                }
#pragma unroll
                for (int bj = 0; bj < 2; ++bj)
                    *(u32x4*)(qkv + (size_t)row * QP + ocol + 32 * bj + 8 * fq) = (u32x4){cvt_pk_bf16(x[bj][0][0], x[bj][0][1]), cvt_pk_bf16(x[bj][0][2], x[bj][0][3]), cvt_pk_bf16(x[bj][1][0], x[bj][1][1]), cvt_pk_bf16(x[bj][1][2], x[bj][1][3])};
                asm volatile("" ::: "memory");
            }
    }
};

template <int BR> struct EpiMerge {
    static constexpr int KIND = 2; static constexpr bool PERM = false, AFTER_DRAIN = false, F16 = false;
    bf16_t* merged; const unsigned char* sg;
    __device__ __forceinline__ void operator()(const f32x4 (&acc)[2][2][4][2], const Unit& u, int wr, int wc, int fr, int fq) const {
        const int row0 = u.pm * BM + wr * 64 + fr, col0 = u.pn * BM + wc * 64 + fq * 16;
#pragma unroll
        for (int ai = 0; ai < 2; ++ai) {
            u32x4 gq[4], om[4][2];
#pragma unroll
            for (int m = 0; m < 4; ++m) { const size_t row = (size_t)(row0 + ai * HALF + m * 16);
                gq[m] = *(const u32x4*)(sg + row * 3072 + BR * 1024 + col0);
                if (BR > 0) { om[m][0] = *(const u32x4*)(merged + row * 1024 + col0); om[m][1] = *(const u32x4*)(merged + row * 1024 + col0 + 8); } }
#pragma unroll
            for (int m = 0; m < 4; ++m) { const size_t row = (size_t)(row0 + ai * HALF + m * 16);
                bf16_t* mp = merged + row * 1024 + col0;
                float v[16];
#pragma unroll
                for (int bj = 0; bj < 2; ++bj)
#pragma unroll
                    for (int n = 0; n < 2; ++n)
#pragma unroll
                        for (int i = 0; i < 4; ++i) v[8 * bj + 4 * n + i] = acc[ai][bj][m][n][i] * ((float)((gq[m][2 * bj + n] >> (8 * i)) & 255u) * (1.0f / 255.0f));
                if (BR > 0) {
#pragma unroll
                    for (int k = 0; k < 4; ++k) { v[2 * k] += bf_lo(om[m][0][k]); v[2 * k + 1] += bf_hi(om[m][0][k]); v[8 + 2 * k] += bf_lo(om[m][1][k]); v[8 + 2 * k + 1] += bf_hi(om[m][1][k]); } }
                *(u32x4*)mp = (u32x4){cvt_pk_bf16(v[0], v[1]), cvt_pk_bf16(v[2], v[3]), cvt_pk_bf16(v[4], v[5]), cvt_pk_bf16(v[6], v[7])};
                *(u32x4*)(mp + 8) = (u32x4){cvt_pk_bf16(v[8], v[9]), cvt_pk_bf16(v[10], v[11]), cvt_pk_bf16(v[12], v[13]), cvt_pk_bf16(v[14], v[15])}; }
            asm volatile("" ::: "memory"); }
    }
};

struct EpiResid {
    static constexpr int KIND = 4; static constexpr bool PERM = false, AFTER_DRAIN = false, F16 = false;
    unsigned char* x16;
    __device__ __forceinline__ void operator()(const f32x4 (&acc)[2][2][4][2], const Unit& u, int wr, int wc, int fr, int fq) const {
        const int row0 = u.pm * BM + wr * 64 + fr, col0 = u.pn * BM + wc * 32 + fq * 8;
        u32x4 r[2][4][2];
#pragma unroll
        for (int ai = 0; ai < 2; ++ai)
#pragma unroll
            for (int m = 0; m < 4; ++m)
#pragma unroll
                for (int bj = 0; bj < 2; ++bj) r[ai][m][bj] = *(const u32x4*)(x16 + ((size_t)(row0 + ai * HALF + m * 16) * 1024 + col0) * 2 + bj * HALF * 2);
#pragma unroll
        for (int ai = 0; ai < 2; ++ai)
#pragma unroll
            for (int m = 0; m < 4; ++m) { unsigned char* xp = x16 + ((size_t)(row0 + ai * HALF + m * 16) * 1024 + col0) * 2;
#pragma unroll
                for (int bj = 0; bj < 2; ++bj) { const u32x4 q = r[ai][m][bj]; const f32x4 a = acc[ai][bj][m][0], b = acc[ai][bj][m][1];
                    *(u32x4*)(xp + bj * HALF * 2) = (u32x4){cvt_pk_f16(h_lo(q[0]) + a[0], h_hi(q[0]) + a[1]), cvt_pk_f16(h_lo(q[1]) + a[2], h_hi(q[1]) + a[3]), cvt_pk_f16(h_lo(q[2]) + b[0], h_hi(q[2]) + b[1]), cvt_pk_f16(h_lo(q[3]) + b[2], h_hi(q[3]) + b[3])}; } }
    }
};

struct EpiGateUp {
    static constexpr int KIND = 8; static constexpr bool PERM = false, AFTER_DRAIN = false, F16 = true;
    bf16_t* hid; const PG8_LAS float* rst; int rbs;
    __device__ __forceinline__ void operator()(const f32x4 (&acc)[2][2][4][2], const Unit& u, int wr, int wc, int fr, int fq) const {
        const int row0 = u.pm * BM + wr * 64 + fr, col0 = (u.pn & 3) * HALF + wc * 32 + fq * 8;
        const PG8_LAS float* rs = rst + (u.pm / rbs) * 256 + wr * 64 + fr;
#pragma unroll
        for (int ai = 0; ai < 2; ++ai)
#pragma unroll
            for (int m = 0; m < 4; ++m) { float v[8]; const float r = rs[ai * HALF + m * 16];
#pragma unroll
                for (int n = 0; n < 2; ++n)
#pragma unroll
                    for (int i = 0; i < 4; ++i) { const float gt = acc[ai][0][m][n][i] * r, up = acc[ai][1][m][n][i] * r; v[4 * n + i] = gt * fast_rcp(1.0f + fast_exp2(-1.4426950408889634f * gt)) * up; }
                *(u32x4*)(hid + (size_t)(row0 + ai * HALF + m * 16) * DEXP + col0) = (u32x4){cvt_pk_bf16(v[0], v[1]), cvt_pk_bf16(v[2], v[3]), cvt_pk_bf16(v[4], v[5]), cvt_pk_bf16(v[6], v[7])}; }
    }
};

struct EpiDown {
    static constexpr int KIND = 16; static constexpr bool PERM = false, AFTER_DRAIN = false, F16 = false;
    bf16_t* y;
    __device__ __forceinline__ void operator()(const f32x4 (&acc)[2][2][4][2], const Unit& u, int wr, int wc, int fr, int fq) const {
        const int row0 = u.pm * BM + wr * 64 + fr, col0 = (u.pn & 3) * BM + wc * 64 + fq * 16;
#pragma unroll
        for (int ai = 0; ai < 2; ++ai)
#pragma unroll
            for (int m = 0; m < 4; ++m) { bf16_t* yp = y + (size_t)(row0 + ai * HALF + m * 16) * 1024 + col0;
#pragma unroll
                for (int bj = 0; bj < 2; ++bj) { const f32x4 a = acc[ai][bj][m][0], b = acc[ai][bj][m][1];
                    *(u32x4*)(yp + 8 * bj) = (u32x4){cvt_pk_bf16(a[0], a[1]), cvt_pk_bf16(a[2], a[3]), cvt_pk_bf16(b[0], b[1]), cvt_pk_bf16(b[2], b[3])}; } }
    }
};

struct AMapMoe { static constexpr bool GATHER = true; const PG8_LAS int* tok; int rbs;
    __device__ __forceinline__ unsigned row(const Unit& u, int R) const { return (unsigned)tok[(u.pm / rbs) * 256 + R]; } };
struct MoeOrder {
    int nunits, G, c; const PG8_LAS int* blk2e;
    __device__ __forceinline__ bool next(int i, Unit& u) const { const int L = i * G + c; if (L >= nunits) return false; const int rb = L >> 2; u.pm = rb; u.pn = blk2e[rb] * 4 + (L & 3); return true; }
    __device__ __forceinline__ void a_ready(const Unit&) const {}
    __device__ __forceinline__ void done(const Unit&) const {}
};

typedef _Float16 f16x8 __attribute__((ext_vector_type(8)));
template <bool F16> __device__ __forceinline__ f32x4 mma16x(bf16x8 a, bf16x8 b, f32x4 c) {
    if constexpr (F16) return __builtin_amdgcn_mfma_f32_16x16x32_f16(__builtin_bit_cast(f16x8, a), __builtin_bit_cast(f16x8, b), c, 0, 0, 0);
    else return __builtin_amdgcn_mfma_f32_16x16x32_bf16(a, b, c, 0, 0, 0); }
struct NoAMap { static constexpr bool GATHER = false; __device__ __forceinline__ unsigned row(const Unit&, int) const { return 0u; } };
template <class Epi, class Sched, bool ALIGN_EPI = false, bool SP2 = false, class AMap = NoAMap>
__device__ __forceinline__ void gemm_phase(PG8_LAS unsigned char* lds, const Gemm g, const Sched& S, const Epi& E, const AMap& AM = AMap()) {
    static_assert(!AMap::GATHER || SP2, "the row gather is wired into the SP2 loop only");
#define mma16 mma16x<Epi::F16>
    int tid_l = (int)threadIdx.x; asm volatile("" : "+v"(tid_l));
    const int tid = tid_l, wid = __builtin_amdgcn_readfirstlane(tid >> 6), lane = tid & 63, wr = wid >> 2, wc = wid & 3, fr = lane & 15, fq = lane >> 4;
    const int K = g.K, nt = K / BK;
    unsigned voffA[2], voffB[2];
#pragma unroll
    for (int i = 0; i < 2; ++i) { int R, C; stage_rc(tid * 16 + i * 8192, R, C); const int Rb = Epi::PERM ? ((R & ~31) + perm32(R & 31)) : R;
        voffA[i] = (unsigned)(R * K + C) * 2u; voffB[i] = (unsigned)(Rb * K + C) * 2u; }
    int RA[2], CA[2];
#pragma unroll
    for (int i = 0; i < 2; ++i) stage_rc(tid * 16 + i * 8192, RA[i], CA[i]);
    unsigned vC0[2] = {0u, 0u}, vC1[2] = {0u, 0u}, vN0[2] = {0u, 0u}, vN1[2] = {0u, 0u};
#define PG8_AOFFS(v0, v1, unit) do { if constexpr (AMap::GATHER) { _Pragma("unroll") for (int _i = 0; _i < 2; ++_i) { \
        v0[_i] = (AM.row(unit, RA[_i]) * (unsigned)K + (unsigned)CA[_i]) * 2u; v1[_i] = (AM.row(unit, HALF + RA[_i]) * (unsigned)K + (unsigned)CA[_i]) * 2u; } } } while (0)
#define PG8_STAGE_A(bufoff, base, half, usenext) do { if constexpr (AMap::GATHER) { unsigned vv_[2]; _Pragma("unroll") for (int _j = 0; _j < 2; ++_j) vv_[_j] = (usenext) ? ((half) ? vN1[_j] : vN0[_j]) : ((half) ? vC1[_j] : vC0[_j]); \
        PG8_STAGE(bufoff, base, vv_); } else { PG8_STAGE(bufoff, (base) + (half) * hstep, voffA); } } while (0)
    const size_t kstep = (size_t)(BK * 2);
    const size_t hstep = (size_t)HALF * K * 2;
    const size_t tstep = 2 * hstep;
    const unsigned ldsw = (unsigned)wid * 1024u;
    const int aoff = lds_byte(wr * 64 + fr, fq * 8), boff = lds_byte(wc * 32 + fr, fq * 8);
#define PG8_SA(b, h) (((b) * 2 + (h)) * HTB)
#define PG8_SB(b, h) ((4 + (b) * 2 + (h)) * HTB)
#define PG8_STAGE(bufoff, gbase, voff) do { _Pragma("unroll") for (int _i = 0; _i < 2; ++_i) \
        __builtin_amdgcn_global_load_lds((const unsigned*)((const char*)(gbase) + (voff)[_i]), (PG8_LAS unsigned*)(lds + (bufoff) + ldsw + _i * 8192), 16, 0, 0); } while (0)
#define PG8_LDA(dst, b, h) do { _Pragma("unroll") for (int m = 0; m < 4; ++m) _Pragma("unroll") for (int k = 0; k < 2; ++k) dst[m][k] = *(const PG8_LAS bf16x8*)(lds + PG8_SA(b, h) + aoff + m * 2048 + k * 1024); } while (0)
#define PG8_LDB(dst, b, h) do { _Pragma("unroll") for (int n = 0; n < 2; ++n) _Pragma("unroll") for (int k = 0; k < 2; ++k) dst[n][k] = *(const PG8_LAS bf16x8*)(lds + PG8_SB(b, h) + boff + n * 2048 + k * 1024); } while (0)
#define PG8_MMA(ai, bj, At, Bt) do { __builtin_amdgcn_s_setprio(1); _Pragma("unroll") for (int m = 0; m < 4; ++m) _Pragma("unroll") for (int n = 0; n < 2; ++n) _Pragma("unroll") for (int k = 0; k < 2; ++k) \
        acc[ai][bj][m][n] = mma16(Bt[n][k], At[m][k], acc[ai][bj][m][n]); __builtin_amdgcn_s_setprio(0); } while (0)
#define PG8_WAIT_V(n) asm volatile("s_waitcnt vmcnt(" #n ")" ::: "memory")
#define PG8_WAIT_L(n) asm volatile("s_waitcnt lgkmcnt(" #n ")" ::: "memory")
#define PG8_BAR __builtin_amdgcn_s_barrier()
#define PG8_SCHED __builtin_amdgcn_sched_barrier(0)
    Unit cur, nxt; int ui = 0;
    if (!S.next(0, cur)) return;
    f32x4 acc[2][2][4][2];
#pragma unroll
    for (int a = 0; a < 2; ++a)
#pragma unroll
        for (int b = 0; b < 2; ++b)
#pragma unroll
            for (int m = 0; m < 4; ++m)
#pragma unroll
                for (int n = 0; n < 2; ++n) acc[a][b][m][n] = (f32x4){0.f, 0.f, 0.f, 0.f};
    bf16x8 At[4][2], B0[2][2], B1[2][2];
    const char* cA = (const char*)g.A + (AMap::GATHER ? (size_t)0 : (size_t)cur.pm * tstep); const char* cB = (const char*)g.Bt + (size_t)cur.pn * tstep;
    PG8_AOFFS(vC0, vC1, cur);
    S.a_ready(cur);
    if constexpr (SP2) {
        PG8_STAGE(PG8_SB(0, 0), cB, voffB); PG8_STAGE(PG8_SB(0, 1), cB + hstep, voffB); PG8_STAGE_A(PG8_SA(0, 0), cA, 0, false); PG8_STAGE_A(PG8_SA(0, 1), cA, 1, false);
        if (wr == 1) PG8_BAR;
        PG8_WAIT_V(2); PG8_BAR;
        PG8_STAGE(PG8_SB(1, 0), cB + kstep, voffB); PG8_STAGE_A(PG8_SA(1, 0), cA + kstep, 0, false); PG8_STAGE(PG8_SB(1, 1), cB + hstep + kstep, voffB);
        PG8_WAIT_V(6); PG8_BAR;
    } else {
        PG8_STAGE(PG8_SB(0, 0), cB, voffB); PG8_STAGE(PG8_SA(0, 0), cA, voffA); PG8_STAGE(PG8_SB(0, 1), cB + hstep, voffB); PG8_STAGE(PG8_SA(0, 1), cA + hstep, voffA);
        if (wr == 1) PG8_BAR;
        PG8_WAIT_V(4); PG8_BAR;
        PG8_STAGE(PG8_SB(1, 0), cB + kstep, voffB); PG8_STAGE(PG8_SA(1, 0), cA + kstep, voffA); PG8_STAGE(PG8_SB(1, 1), cB + hstep + kstep, voffB);
        PG8_WAIT_V(6); PG8_BAR;
    }
    for (;;) {
        const bool has_next = S.next(ui + 1, nxt);
        const char* nA = (has_next && !AMap::GATHER) ? (const char*)g.A + (size_t)nxt.pm * tstep : cA; const char* nB = has_next ? (const char*)g.Bt + (size_t)nxt.pn * tstep : cB;
        if constexpr (AMap::GATHER) { if (has_next) PG8_AOFFS(vN0, vN1, nxt); else { vN0[0] = vC0[0]; vN0[1] = vC0[1]; vN1[0] = vC1[0]; vN1[1] = vC1[1]; } }
        long long kl0_ = 0; if constexpr (((PROBE_KL) & Epi::KIND) != 0) { if (tid == 0) kl0_ = (long long)wall_clock64(); }
#pragma unroll 1
        for (int t = 0; t < nt; t += 2) {
            const bool last = (t == nt - 2);
            const char* a1 = cA + (size_t)(t + 1) * kstep;
            const char* a2 = last ? nA : cA + (size_t)(t + 2) * kstep; const char* b2 = last ? nB : cB + (size_t)(t + 2) * kstep;
            const char* a3 = a2 + kstep; const char* b3 = b2 + kstep;
            if (last && has_next) S.a_ready(nxt);
            if constexpr (SP2) {
            PG8_LDB(B0, 0, 0); PG8_LDB(B1, 0, 1); PG8_SCHED; PG8_LDA(At, 0, 0); PG8_STAGE_A(PG8_SA(1, 1), a1, 1, false);
            PG8_WAIT_V(8); PG8_WAIT_L(0); PG8_BAR; PG8_MMA(0, 0, At, B0); PG8_MMA(0, 1, At, B1); PG8_BAR; PG8_SCHED;
            PG8_LDA(At, 0, 1); PG8_STAGE(PG8_SB(0, 0), b2, voffB); PG8_STAGE(PG8_SB(0, 1), b2 + hstep, voffB); PG8_STAGE_A(PG8_SA(0, 0), a2, 0, last);
            PG8_WAIT_V(8); PG8_WAIT_L(0); PG8_BAR; PG8_MMA(1, 0, At, B0); PG8_MMA(1, 1, At, B1); PG8_BAR; PG8_SCHED;
            PG8_LDB(B0, 1, 0); PG8_LDB(B1, 1, 1); PG8_SCHED; PG8_LDA(At, 1, 0); PG8_STAGE_A(PG8_SA(0, 1), a2, 1, last);
            PG8_WAIT_V(8); PG8_WAIT_L(0); PG8_BAR; PG8_MMA(0, 0, At, B0); PG8_MMA(0, 1, At, B1); PG8_BAR; PG8_SCHED;
            PG8_LDA(At, 1, 1); PG8_STAGE(PG8_SB(1, 0), b3, voffB); PG8_STAGE(PG8_SB(1, 1), b3 + hstep, voffB); PG8_STAGE_A(PG8_SA(1, 0), a3, 0, last);
            PG8_WAIT_V(8); PG8_WAIT_L(0); PG8_BAR; PG8_MMA(1, 0, At, B0); PG8_MMA(1, 1, At, B1); PG8_BAR; PG8_SCHED;
            } else {
            PG8_LDB(B0, 0, 0); PG8_SCHED; PG8_LDA(At, 0, 0); PG8_STAGE(PG8_SA(1, 1), a1 + hstep, voffA);
            PG8_WAIT_L(8); PG8_BAR; PG8_WAIT_L(0); PG8_MMA(0, 0, At, B0); PG8_BAR; PG8_SCHED;
            PG8_LDB(B1, 0, 1); PG8_STAGE(PG8_SB(0, 0), b2, voffB);
            PG8_BAR; PG8_WAIT_L(0); PG8_MMA(0, 1, At, B1); PG8_BAR;
            PG8_LDA(At, 0, 1); PG8_STAGE(PG8_SA(0, 0), a2, voffA);
            PG8_BAR; PG8_WAIT_L(0); PG8_MMA(1, 0, At, B0); PG8_BAR; PG8_SCHED;
            PG8_STAGE(PG8_SB(0, 1), b2 + hstep, voffB);
            PG8_WAIT_V(6); PG8_BAR; PG8_MMA(1, 1, At, B1); PG8_BAR;
            PG8_LDB(B0, 1, 0); PG8_SCHED; PG8_LDA(At, 1, 0); PG8_STAGE(PG8_SA(0, 1), a2 + hstep, voffA);
            PG8_WAIT_L(8); PG8_BAR; PG8_WAIT_L(0); PG8_MMA(0, 0, At, B0); PG8_BAR; PG8_SCHED;
            PG8_LDB(B1, 1, 1); PG8_STAGE(PG8_SB(1, 0), b3, voffB);
            PG8_BAR; PG8_WAIT_L(0); PG8_MMA(0, 1, At, B1); PG8_BAR;
            PG8_LDA(At, 1, 1); PG8_STAGE(PG8_SA(1, 0), a3, voffA);
            PG8_BAR; PG8_WAIT_L(0); PG8_MMA(1, 0, At, B0); PG8_BAR; PG8_SCHED;
            PG8_STAGE(PG8_SB(1, 1), b3 + hstep, voffB);
            PG8_WAIT_V(6); PG8_BAR; PG8_MMA(1, 1, At, B1); PG8_BAR;
            }
        }
        if constexpr (((PROBE_KL) & Epi::KIND) != 0) { if (tid == 0) *(PG8_LAS long long*)(lds + 131072 + 14336) += (long long)wall_clock64() - kl0_; }
        if constexpr (ALIGN_EPI) { if (wr == 0) PG8_BAR; }
        if constexpr (!Epi::AFTER_DRAIN) { E(acc, cur, wr, wc, fr, fq); S.done(cur); }
        if (!has_next) break;
#pragma unroll
        for (int a = 0; a < 2; ++a)
#pragma unroll
            for (int b = 0; b < 2; ++b)
#pragma unroll
                for (int m = 0; m < 4; ++m)
#pragma unroll
                    for (int n = 0; n < 2; ++n) acc[a][b][m][n] = (f32x4){0.f, 0.f, 0.f, 0.f};
        cur = nxt; cA = nA; cB = nB; ++ui;
        if constexpr (AMap::GATHER) { vC0[0] = vN0[0]; vC0[1] = vN0[1]; vC1[0] = vN1[0]; vC1[1] = vN1[1]; }
        if constexpr (ALIGN_EPI) { if (wr == 1) PG8_BAR; }
    }
    PG8_WAIT_V(0);
    if constexpr (!ALIGN_EPI) { if (wr == 0) PG8_BAR; }
    PG8_BAR;
    if constexpr (Epi::AFTER_DRAIN) { E.fused(acc, cur, wr, wc, fr, fq, lds, wid, lane); S.done(cur); }
#undef mma16
#undef PG8_SA
#undef PG8_AOFFS
#undef PG8_STAGE_A
#undef PG8_SB
#undef PG8_STAGE
#undef PG8_LDA
#undef PG8_LDB
#undef PG8_MMA
#undef PG8_WAIT_V
#undef PG8_WAIT_L
#undef PG8_BAR
#undef PG8_SCHED
}
}
#define XB_TMO      128
#define XB_XCNT(j)  (256  + 64 * (j))
#define XB_XSUB(j)  (1280 + 64 * (j))
#define XB_XGEN(j)  (2304 + 64 * (j))
#define XB_TOP      3328
#define XB_TOPGEN   3392
#define XCD_BAR_WORDS 3456
#define XB_SPIN_CAP (1u << 21)

__device__ __forceinline__ unsigned xb_ld(unsigned* p)              { return __hip_atomic_load(p, __ATOMIC_RELAXED, __HIP_MEMORY_SCOPE_AGENT); }
__device__ __forceinline__ unsigned xb_add(unsigned* p, unsigned v) { return __hip_atomic_fetch_add(p, v, __ATOMIC_RELAXED, __HIP_MEMORY_SCOPE_AGENT); }
__device__ __forceinline__ unsigned xb_xcc_id() { return (unsigned)__builtin_amdgcn_s_getreg((3 << 11) | 20) & 0xFu; }
#define XB_SPIN(cond, bar) do { unsigned _sp = 0; while (cond) { __builtin_amdgcn_s_sleep(1); \
    if ((++_sp & 255u) == 0u) { if (xb_ld(&(bar)[XB_TMO])) break; if (_sp > XB_SPIN_CAP) { atomicAdd(&(bar)[XB_TMO], 1u); break; } } } } while (0)

struct XcdBarrier {
    unsigned* bar; unsigned x;
    volatile LAS unsigned* st;
};

__device__ __forceinline__ XcdBarrier xcd_barrier_post(unsigned* bar, volatile LAS unsigned* st) {
    XcdBarrier b; b.bar = bar; b.x = xb_xcc_id(); b.st = st;
    if (threadIdx.x == 0) (void)xb_add(&bar[XB_XCNT(b.x)], 1u);
    return b;
}
__device__ __forceinline__ void xcd_barrier_complete(unsigned* bar, unsigned x, unsigned& nloc, unsigned& nx) {
    const unsigned G = gridDim.x * gridDim.y * gridDim.z;
    unsigned sum, cnt, mine, sp = 0u;
    for (;;) {
        sum = 0u; cnt = 0u; mine = 0u;
#pragma unroll
        for (unsigned j = 0; j < 16; ++j) { const unsigned c = xb_ld(&bar[XB_XCNT(j)]); sum += c; cnt += (c > 0u) ? 1u : 0u; mine = (j == x) ? c : mine; }
        if (sum == G) break;
        __builtin_amdgcn_s_sleep(1);
        if ((++sp & 255u) == 0u) { if (xb_ld(&bar[XB_TMO])) break; if (sp > XB_SPIN_CAP) { atomicAdd(&bar[XB_TMO], 1u); break; } }
    }
    nloc = mine > 0u ? mine : 1u; nx = cnt > 0u ? cnt : 1u;
}

__device__ __forceinline__ void xcd_barrier(const XcdBarrier& b) {
    asm volatile("s_waitcnt vmcnt(0)" ::: "memory");
    __syncthreads();
    int tid_l = (int)threadIdx.x; asm volatile("" : "+v"(tid_l));
    if (tid_l == 0) {
        unsigned* bar = b.bar;
        __builtin_amdgcn_s_waitcnt(0);
        unsigned nloc = b.st[0], nx = b.st[1];
        if (nloc == 0u) { xcd_barrier_complete(bar, b.x, nloc, nx); b.st[0] = nloc; b.st[1] = nx; }
        const unsigned old = xb_add(&bar[XB_XSUB(b.x)], 1u);
        const unsigned gen = old / nloc;
        if (old + 1u == (gen + 1u) * nloc) {
            __builtin_amdgcn_fence(__ATOMIC_RELEASE, "agent");
            asm volatile("s_waitcnt vmcnt(0)" ::: "memory");
            const unsigned og = xb_add(&bar[XB_TOP], 1u);
            const unsigned tg = og / nx;
            if (og + 1u == (tg + 1u) * nx) xb_add(&bar[XB_TOPGEN], 1u);
            else XB_SPIN(xb_ld(&bar[XB_TOPGEN]) == tg, bar);
            __builtin_amdgcn_fence(__ATOMIC_ACQUIRE, "agent");
            xb_add(&bar[XB_XGEN(b.x)], 1u);
            asm volatile("s_waitcnt vmcnt(0)" ::: "memory");
        } else {
            XB_SPIN(xb_ld(&bar[XB_XGEN(b.x)]) == gen, bar);
            __builtin_amdgcn_fence(__ATOMIC_ACQUIRE, "agent");
            asm volatile("s_waitcnt vmcnt(0)" ::: "memory");
        }
    }
    __syncthreads();
}

enum { I_X = 0, I_NORM_ATTN, I_W_IN, I_QK_GAIN, I_IDX_K_GAIN, I_DIFF_LAMBDA, I_DIFF_SUBLN, I_W_PROJ_A, I_W_PROJ_B, I_W_PROJ_C, I_W_OUT, I_NORM_FFN, I_W_GROUP, I_B_GROUP, I_W_ROUTER, I_B_ROUTER,
       I_W_E_GATE, I_W_E_UP, I_W_E_DOWN, N_INPUTS };
struct Args { const float* in[N_INPUTS]; float* out; unsigned char* ws; };

#define LDS_WAIT() asm volatile("s_waitcnt lgkmcnt(0)" ::: "memory")

__device__ __forceinline__ int perm16col(int s) { return 64 * ((s >> 5) & 3) + 16 * ((s >> 2) & 3) + 8 * (s >> 7) + 4 * ((s >> 4) & 1) + (s & 3); }
__device__ __forceinline__ int inproj_src_col(int d) {
    const int pn = d >> 8, s = d & 255;
    if (pn >= 15) return C_G + 256 * (pn - 15) + perm16col(s);
    const int u = (s >> 5) & 3, e = 32 * (s >> 7) + pg8::perm32(s & 31);
    if (pn < 8) return 256 * pn + 64 * u + e;
    if (pn == 8) { if (u == 0) return C_KI + e; if (u == 1) return e < 8 ? C_WI + e : -1; return -1; }
    return C_Q1 + 256 * (pn - 9) + 64 * u + e;
}
template <bool F16>
__device__ __forceinline__ void transpose_item(const float* W, int ldw, int K, bf16_t* WT, int drow0, int k0, int srccol, LAS float* scr, int lane, const float* kscale = nullptr) {
    const float* src = W + (size_t)k0 * ldw + (srccol >= 0 ? srccol : 0);
#pragma unroll 8
    for (int i = 0; i < 32; ++i) { const int kk = 2 * i + (lane >> 5); const float v = src[(size_t)kk * ldw]; scr[kk * 33 + (lane & 31)] = srccol >= 0 ? v : 0.f; }
    LDS_WAIT(); asm volatile("" ::: "memory");
    const int c = lane & 7;
    f32x4 g0 = {1.f, 1.f, 1.f, 1.f}, g1 = g0;
    if (F16) { g0 = *(const f32x4*)(kscale + k0 + 8 * c); g1 = *(const f32x4*)(kscale + k0 + 8 * c + 4); }
#pragma unroll
    for (int j = 0; j < 4; ++j) { const int n = (lane >> 3) + 8 * j; const LAS float* s = scr + (8 * c) * 33 + n;
        u32x4 o;
        if (F16) { o.x = cvt_pk_f16(s[0 * 33] * g0[0], s[1 * 33] * g0[1]); o.y = cvt_pk_f16(s[2 * 33] * g0[2], s[3 * 33] * g0[3]); o.z = cvt_pk_f16(s[4 * 33] * g1[0], s[5 * 33] * g1[1]); o.w = cvt_pk_f16(s[6 * 33] * g1[2], s[7 * 33] * g1[3]); }
        else { o.x = cvt_pk_bf16(s[0 * 33], s[1 * 33]); o.y = cvt_pk_bf16(s[2 * 33], s[3 * 33]); o.z = cvt_pk_bf16(s[4 * 33], s[5 * 33]); o.w = cvt_pk_bf16(s[6 * 33], s[7 * 33]); }
        *(u32x4*)(WT + (size_t)(drow0 + n) * K + k0 + 8 * c) = o; }
    LDS_WAIT(); asm volatile("" ::: "memory");
}

template <bool FIRST, bool COMBINE, bool FINAL>
__device__ __forceinline__ void token_row(const float* xin, unsigned char* x16, float* outf, const bf16_t* y, const unsigned* rt0, const unsigned* rt1, const f32x2* rtw, const LAS int* pstart,
                                          float* rstd1, int m, int lane) {
    float v[2][8];
#pragma unroll
    for (int j = 0; j < 2; ++j) {
        if (FIRST) { const f32x4 p = ((const f32x4*)(xin + (size_t)m * DM))[2 * (lane + 64 * j)], q = ((const f32x4*)(xin + (size_t)m * DM))[2 * (lane + 64 * j) + 1];
#pragma unroll
            for (int k = 0; k < 4; ++k) { v[j][k] = p[k]; v[j][4 + k] = q[k]; } }
        else { const u32x4 p = ((const u32x4*)(x16 + (size_t)m * (DM * 2)))[lane + 64 * j];
#pragma unroll
            for (int k = 0; k < 4; ++k) { v[j][2 * k] = h_lo(p[k]); v[j][2 * k + 1] = h_hi(p[k]); } }
    }
    if (COMBINE) {
        const unsigned a = rt0[m], b = rt1[m]; const f32x2 w = rtw[m];
        const size_t s0 = (size_t)(pstart[a >> 24] + (int)(a & 0xffffffu)), s1 = (size_t)(pstart[b >> 24] + (int)(b & 0xffffffu));
#pragma unroll
        for (int j = 0; j < 2; ++j) { const u32x4 p = ((const u32x4*)(y + s0 * DM))[lane + 64 * j], q = ((const u32x4*)(y + s1 * DM))[lane + 64 * j];
#pragma unroll
            for (int k = 0; k < 4; ++k) { v[j][2 * k] += w[0] * bf_lo(p[k]) + w[1] * bf_lo(q[k]); v[j][2 * k + 1] += w[0] * bf_hi(p[k]) + w[1] * bf_hi(q[k]); } }
    }
    if (FINAL) {
#pragma unroll
        for (int j = 0; j < 2; ++j) { ((f32x4*)(outf + (size_t)m * DM))[2 * (lane + 64 * j)] = (f32x4){v[j][0], v[j][1], v[j][2], v[j][3]}; ((f32x4*)(outf + (size_t)m * DM))[2 * (lane + 64 * j) + 1] = (f32x4){v[j][4], v[j][5], v[j][6], v[j][7]}; }
    } else {
        float ss = 0.f;
#pragma unroll
        for (int j = 0; j < 2; ++j) { ss += (v[j][0] * v[j][0] + v[j][1] * v[j][1]) + (v[j][2] * v[j][2] + v[j][3] * v[j][3]) + (v[j][4] * v[j][4] + v[j][5] * v[j][5]) + (v[j][6] * v[j][6] + v[j][7] * v[j][7]);
            ((u32x4*)(x16 + (size_t)m * (DM * 2)))[lane + 64 * j] = (u32x4){cvt_pk_f16(v[j][0], v[j][1]), cvt_pk_f16(v[j][2], v[j][3]), cvt_pk_f16(v[j][4], v[j][5]), cvt_pk_f16(v[j][6], v[j][7])}; }
        const float rstd = 1.0f / sqrtf(wave_sum(ss) * (1.0f / DM) + EPS);
        if (lane == 0) rstd1[m] = rstd;
    }
}

template <bool EXPERTS> __device__ __forceinline__ void convert_weights(const Args& a, unsigned char* ws, int l, LAS unsigned char* lds, int lane, int wave, int vcu, int G, int chunk = -1);
__device__ __forceinline__ void p0_phase(const Args& a, unsigned char* ws, int l, LAS unsigned char* lds, int tid, int lane, int wave, int vcu, int G) {
    convert_weights<false>(a, ws, l, lds, lane, wave, vcu, G);
    const int gw = vcu * 8 + wave, NGW = G * 8, gt = vcu * 512 + tid, NGT = G * 512;
    if (l == 0) {
        float* cosT = (float*)(ws + WS_COS); float* sinT = (float*)(ws + WS_SIN);
        for (int idx = gt; idx < SEQ * 32; idx += NGT) { const int pos = idx >> 5, j = idx & 31;
            const float inv_freq = 1.0f / powf(10000.0f, (float)(2 * j) * (1.0f / 64.0f));
            const float ang = (float)pos * inv_freq;
            const double rev = (double)ang * 0.15915494309189533577; const float fr = (float)(rev - rint(rev));
            cosT[idx] = __builtin_amdgcn_cosf(fr); sinT[idx] = __builtin_amdgcn_sinf(fr); }
    }
    { float* wrt = (float*)(ws + WS_WRT); const float* wg = a.in[I_W_GROUP] + (size_t)l * DM * 4; const float* wr = a.in[I_W_ROUTER] + (size_t)l * DM * 32;
      const float* g2 = a.in[I_NORM_FFN] + (size_t)l * DM;
      for (int idx = gt; idx < 36 * DM; idx += NGT) { const int c = idx >> 10, k = idx & 1023; wrt[idx] = g2[k] * (c < 4 ? wg[k * 4 + c] : wr[k * 32 + (c - 4)]); } }
    unsigned char* x16 = ws + WS_X16; float* rstd1 = (float*)(ws + WS_RSTD1);
    const LAS int* pstart = (const LAS int*)(lds + LX_PSTART);
    if (l == 0) { for (int m = gw; m < MTOK; m += NGW) token_row<true, false, false>(a.in[I_X], x16, nullptr, nullptr, nullptr, nullptr, nullptr, pstart, rstd1, m, lane); }
    else { for (int m = gw; m < MTOK; m += NGW) token_row<false, true, false>(nullptr, x16, nullptr, (const bf16_t*)(ws + WS_Y), (const unsigned*)(ws + WS_RT0), (const unsigned*)(ws + WS_RT1), (const f32x2*)(ws + WS_RTW), pstart, rstd1, m, lane); }
}

template <bool EXPERTS> __device__ __forceinline__ void convert_weights(const Args& a, unsigned char* ws, int l, LAS unsigned char* lds, int lane, int wave, int vcu, int G, int chunk) {
    LAS float* scr = (LAS float*)(lds + wave * 16384);
    int gw = vcu * 8 + wave, NGW = G * 8;
    constexpr int I_IN = 216 * 16, I_PA = 32 * 4, I_PC = 32 * 8, I_WO = 32 * 16, I_GU = 32 * 32 * 16, I_DN = 32 * 32 * 8, NIT = I_IN + 2 * I_PA + I_PC + I_WO + I_GU + I_DN;
    constexpr int I_SMALL = I_IN + 2 * I_PA + I_PC + I_WO;
    int it_end = EXPERTS ? NIT : I_SMALL;
    if (chunk >= 0) { gw = chunk * 128 + wave * 16; NGW = 1; it_end = I_SMALL + gw + 16 < NIT ? I_SMALL + gw + 16 : NIT; }
    for (int it = gw + (EXPERTS ? I_SMALL : 0); it < it_end; it += NGW) {
        int r = it; const int d31 = lane & 31;
        if (r < I_IN) { const int nb = r >> 4, kb = r & 15; transpose_item<true>(a.in[I_W_IN] + (size_t)l * DM * D_IN, D_IN, 1024, (bf16_t*)(ws + WS_WIN), nb * 32, kb * 64, inproj_src_col(nb * 32 + d31), scr, lane, a.in[I_NORM_ATTN] + (size_t)l * DM); continue; } r -= I_IN;
        const int pcol = pg8::perm32(d31);
        if (r < I_PA) { const int nb = r >> 2, kb = r & 3; transpose_item<false>(a.in[I_W_PROJ_A] + (size_t)l * 256 * DM, DM, 256, (bf16_t*)(ws + WS_WPA), nb * 32, kb * 64, ((nb * 32 + d31) & ~255) + perm16col((nb * 32 + d31) & 255), scr, lane); continue; } r -= I_PA;
        if (r < I_PA) { const int nb = r >> 2, kb = r & 3; transpose_item<false>(a.in[I_W_PROJ_B] + (size_t)l * 256 * DM, DM, 256, (bf16_t*)(ws + WS_WPB), nb * 32, kb * 64, ((nb * 32 + d31) & ~255) + perm16col((nb * 32 + d31) & 255), scr, lane); continue; } r -= I_PA;
        if (r < I_PC) { const int nb = r >> 3, kb = r & 7; transpose_item<false>(a.in[I_W_PROJ_C] + (size_t)l * 512 * DM, DM, 512, (bf16_t*)(ws + WS_WPC), nb * 32, kb * 64, ((nb * 32 + d31) & ~255) + perm16col((nb * 32 + d31) & 255), scr, lane); continue; } r -= I_PC;
        if (r < I_WO) { const int nb = r >> 4, kb = r & 15; transpose_item<false>(a.in[I_W_OUT] + (size_t)l * DM * DM, DM, 1024, (bf16_t*)(ws + WS_WO), nb * 32, kb * 64, nb * 32 + pcol, scr, lane); continue; } r -= I_WO;
        if (r < I_GU) { const int e = r >> 9, rr = r & 511, nb = rr >> 4, kb = rr & 15, dd = nb * 32, pn = dd >> 8, s = dd & 255, half = s >> 7;
            const float* src = (half ? a.in[I_W_E_UP] : a.in[I_W_E_GATE]) + (size_t)(l * NEXP + e) * DM * DEXP;
            transpose_item<true>(src, DEXP, 1024, (bf16_t*)(ws + WS_WGU) + (size_t)e * 1024 * 1024, nb * 32, kb * 64, 128 * pn + (s & 127) + pcol, scr, lane, a.in[I_NORM_FFN] + (size_t)l * DM); continue; } r -= I_GU;
        { const int e = r >> 8, rr = r & 255, nb = rr >> 3, kb = rr & 7;
            transpose_item<false>(a.in[I_W_E_DOWN] + (size_t)(l * NEXP + e) * DEXP * DM, DM, 512, (bf16_t*)(ws + WS_WD) + (size_t)e * 1024 * 512, nb * 32, kb * 64, ((nb * 32 + d31) & ~255) + perm16col((nb * 32 + d31) & 255), scr, lane); }
    }
}

__device__ __forceinline__ f32x16 mfma32(bf16x8 a, bf16x8 b, f32x16 c) { return __builtin_amdgcn_mfma_f32_32x32x16_bf16(a, b, c, 0, 0, 0); }
typedef short v4i16_t __attribute__((ext_vector_type(4)));
__device__ __forceinline__ s16x4 vtr(const LAS unsigned char* p) { return __builtin_bit_cast(s16x4, __builtin_amdgcn_ds_read_tr16_b64_v4i16((LAS v4i16_t*)p)); }
__device__ __forceinline__ int crow(int r, int hi) { return (r & 3) + 8 * (r >> 2) + 4 * hi; }
#define NEG_INF (-__builtin_inff())

__device__ __forceinline__ f32x16 splat16(float v) { f32x16 r;
#pragma unroll
    for (int i = 0; i < 16; ++i) r[i] = v;
    return r; }
__device__ __forceinline__ int kimg_off(int key, int ch) { return key * 128 + ((ch ^ ((key >> 1) & 7)) << 4); }
__device__ __forceinline__ int kdma_row(int w, int lane) { return 8 * w + (lane >> 3); }
__device__ __forceinline__ int kdma_chunk(int w, int lane) { return (lane & 7) ^ (((8 * w + (lane >> 3)) >> 1) & 7); }
struct QReg { const bf16x8 (&q)[4]; __device__ __forceinline__ bf16x8 operator()(int ks) const { return q[ks]; } };
struct QLds { const LAS unsigned char* p; __device__ __forceinline__ bf16x8 operator()(int ks) const { return *(const LAS bf16x8*)(p + ks * 1024); } };
template <int NDB, class QF, class MaskF>
__device__ __forceinline__ void flash_tile(float& m_run, float& l_run, f32x16 (&o)[NDB], const LAS unsigned char* kimg, const LAS unsigned char* vimg, const QF& qf, const MaskF& maskf, int r32, int hi, int vboff) {
    if (NDB == 4) __builtin_amdgcn_sched_barrier(0);
    f32x16 p0, p1; maskf.init(p0, p1);
#pragma unroll
    for (int ks = 0; ks < 4; ++ks) {
        const bf16x8 a0 = *(const LAS bf16x8*)(kimg + (NDB == 4 ? (2 * ks + hi) * 1024 + r32 * 16 : kimg_off(r32, 2 * ks + hi)));
        const bf16x8 a1 = *(const LAS bf16x8*)(kimg + (NDB == 4 ? (2 * ks + hi) * 1024 + 512 + r32 * 16 : kimg_off(r32, 2 * ks + hi) + 4096));
        const bf16x8 qk = qf(ks);
        p0 = mfma32(a0, qk, p0); p1 = mfma32(a1, qk, p1);
        if (NDB == 4 && (ks & 1)) __builtin_amdgcn_sched_barrier(0);
    }
    maskf(p0, p1);
    float mx = fmaxf(p0[0], p1[0]);
#pragma unroll
    for (int r = 1; r < 16; ++r) mx = fmaxf(mx, fmaxf(p0[r], p1[r]));
    mx = max_xor32(mx);
    const float mnew = fmaxf(m_run, mx);
    if (__ballot(mnew > m_run) != 0ull) {
        const float alpha = fast_exp2(m_run - mnew);
        l_run *= alpha;
#pragma unroll
        for (int db = 0; db < NDB; ++db) o[db] = o[db] * alpha;
    }
    m_run = mnew;
    float sum = 0.f;
#pragma unroll
    for (int r = 0; r < 16; ++r) { p0[r] = fast_exp2(p0[r] - mnew); p1[r] = fast_exp2(p1[r] - mnew); sum += p0[r] + p1[r]; }
    l_run += sum;
    bf16x8 pa[4];
    pa[0] = __builtin_bit_cast(bf16x8, (u32x4){cvt_pk_bf16(p0[0], p0[1]), cvt_pk_bf16(p0[2], p0[3]), cvt_pk_bf16(p0[4], p0[5]), cvt_pk_bf16(p0[6], p0[7])});
    pa[1] = __builtin_bit_cast(bf16x8, (u32x4){cvt_pk_bf16(p0[8], p0[9]), cvt_pk_bf16(p0[10], p0[11]), cvt_pk_bf16(p0[12], p0[13]), cvt_pk_bf16(p0[14], p0[15])});
    pa[2] = __builtin_bit_cast(bf16x8, (u32x4){cvt_pk_bf16(p1[0], p1[1]), cvt_pk_bf16(p1[2], p1[3]), cvt_pk_bf16(p1[4], p1[5]), cvt_pk_bf16(p1[6], p1[7])});
    pa[3] = __builtin_bit_cast(bf16x8, (u32x4){cvt_pk_bf16(p1[8], p1[9]), cvt_pk_bf16(p1[10], p1[11]), cvt_pk_bf16(p1[12], p1[13]), cvt_pk_bf16(p1[14], p1[15])});
#pragma unroll
    for (int db = 0; db < NDB; ++db)
#pragma unroll
        for (int s = 0; s < 4; ++s) {
            const s16x4 lo = vtr(vimg + vboff + db * 4096 + s * 1024), h4 = vtr(vimg + vboff + db * 4096 + s * 1024 + 512);
            const bf16x8 vt = (bf16x8){lo[0], lo[1], lo[2], lo[3], h4[0], h4[1], h4[2], h4[3]};
            o[db] = mfma32(vt, pa[s], o[db]);
            if (NDB == 4 && (s & 1)) __builtin_amdgcn_sched_barrier(0);
        }    __builtin_amdgcn_sched_barrier(0);
}
template <int NDB, class QF, class MaskF>
__device__ __forceinline__ void flash_tile_ref0(float& l_run, f32x16& lacc, f32x16 (&o)[NDB], const LAS unsigned char* kimg, const LAS unsigned char* vimg, const QF& qf, const MaskF& maskf, int r32, int hi, int vboff) {
    f32x16 p0, p1; maskf.init(p0, p1);
    bf16x8 kf[8];
#pragma unroll
    for (int ks = 0; ks < 4; ++ks) { kf[2 * ks] = *(const LAS bf16x8*)(kimg + kimg_off(r32, 2 * ks + hi)); kf[2 * ks + 1] = *(const LAS bf16x8*)(kimg + kimg_off(r32, 2 * ks + hi) + 4096); }
    __builtin_amdgcn_sched_barrier(0);
    __builtin_amdgcn_s_setprio(1);
#pragma unroll
    for (int ks = 0; ks < 4; ++ks) { const bf16x8 qk = qf(ks); p0 = mfma32(kf[2 * ks], qk, p0); p1 = mfma32(kf[2 * ks + 1], qk, p1); }
    __builtin_amdgcn_s_setprio(0);
    maskf(p0, p1);
    __builtin_amdgcn_sched_barrier(0);
    const bf16x8 ones = (bf16x8){0x3f80, 0x3f80, 0x3f80, 0x3f80, 0x3f80, 0x3f80, 0x3f80, 0x3f80};
#pragma unroll
    for (int r = 0; r < 16; ++r) p0[r] = fast_exp2(p0[r]);
    bf16x8 pa[4];
    pa[0] = __builtin_bit_cast(bf16x8, (u32x4){cvt_pk_bf16(p0[0], p0[1]), cvt_pk_bf16(p0[2], p0[3]), cvt_pk_bf16(p0[4], p0[5]), cvt_pk_bf16(p0[6], p0[7])});
    pa[1] = __builtin_bit_cast(bf16x8, (u32x4){cvt_pk_bf16(p0[8], p0[9]), cvt_pk_bf16(p0[10], p0[11]), cvt_pk_bf16(p0[12], p0[13]), cvt_pk_bf16(p0[14], p0[15])});
    maskf.pack(pa[0]); maskf.pack(pa[1]);
    __builtin_amdgcn_sched_barrier(0);
#pragma unroll
    for (int s = 0; s < 2; ++s) {
        lacc = mfma32(ones, pa[s], lacc);
#pragma unroll
        for (int db = 0; db < NDB; ++db) {
            const s16x4 lo = vtr(vimg + vboff + db * 4096 + s * 1024), h4 = vtr(vimg + vboff + db * 4096 + s * 1024 + 512);
            o[db] = mfma32((bf16x8){lo[0], lo[1], lo[2], lo[3], h4[0], h4[1], h4[2], h4[3]}, pa[s], o[db]);
        }
    }
#pragma unroll
    for (int r = 0; r < 16; ++r) p1[r] = fast_exp2(p1[r]);
    pa[2] = __builtin_bit_cast(bf16x8, (u32x4){cvt_pk_bf16(p1[0], p1[1]), cvt_pk_bf16(p1[2], p1[3]), cvt_pk_bf16(p1[4], p1[5]), cvt_pk_bf16(p1[6], p1[7])});
    pa[3] = __builtin_bit_cast(bf16x8, (u32x4){cvt_pk_bf16(p1[8], p1[9]), cvt_pk_bf16(p1[10], p1[11]), cvt_pk_bf16(p1[12], p1[13]), cvt_pk_bf16(p1[14], p1[15])});
    maskf.pack(pa[2]); maskf.pack(pa[3]);
    __builtin_amdgcn_sched_barrier(0);
#pragma unroll
    for (int s = 2; s < 4; ++s) {
        lacc = mfma32(ones, pa[s], lacc);
#pragma unroll
        for (int db = 0; db < NDB; ++db) {
            const s16x4 lo = vtr(vimg + vboff + db * 4096 + s * 1024), h4 = vtr(vimg + vboff + db * 4096 + s * 1024 + 512);
            o[db] = mfma32((bf16x8){lo[0], lo[1], lo[2], lo[3], h4[0], h4[1], h4[2], h4[3]}, pa[s], o[db]);
        }
    }
    __builtin_amdgcn_sched_barrier(0);
    (void)l_run;
}
template <bool KSWZ, class MaskF>
__device__ __forceinline__ void flash_tile_dual_ref0(float& l1, float& l2, f32x16 (&o1)[4], f32x16 (&o2)[4], const LAS unsigned char* k1img, const LAS unsigned char* k2img, const LAS unsigned char* vimg,
                                                     const LAS unsigned char* q1img, const LAS unsigned char* q2img, const MaskF& maskf, int r32, int hi, int vboff) {
    bf16x8 pa1[4], pa2[4];
#define DUAL_MAP_(kimg, qimg, pa, lsum) do { __builtin_amdgcn_sched_barrier(0); f32x16 p0, p1; maskf.init(p0, p1); \
        _Pragma("unroll") for (int ks = 0; ks < 4; ++ks) { const int ko = KSWZ ? kimg_off(r32, 2 * ks + hi) : (2 * ks + hi) * 1024 + r32 * 16; const bf16x8 qq = *(const LAS bf16x8*)(qimg + ks * 1024); \
            p0 = mfma32(*(const LAS bf16x8*)(kimg + ko), qq, p0); p1 = mfma32(*(const LAS bf16x8*)(kimg + ko + (KSWZ ? 4096 : 512)), qq, p1); if (ks & 1) __builtin_amdgcn_sched_barrier(0); } \
        maskf(p0, p1); float sm = 0.f; \
        _Pragma("unroll") for (int r = 0; r < 16; ++r) { p0[r] = fast_exp2(p0[r]); p1[r] = fast_exp2(p1[r]); sm += p0[r] + p1[r]; } \
        lsum += sm; \
        pa[0] = __builtin_bit_cast(bf16x8, (u32x4){cvt_pk_bf16(p0[0], p0[1]), cvt_pk_bf16(p0[2], p0[3]), cvt_pk_bf16(p0[4], p0[5]), cvt_pk_bf16(p0[6], p0[7])}); \
        pa[1] = __builtin_bit_cast(bf16x8, (u32x4){cvt_pk_bf16(p0[8], p0[9]), cvt_pk_bf16(p0[10], p0[11]), cvt_pk_bf16(p0[12], p0[13]), cvt_pk_bf16(p0[14], p0[15])}); \
        pa[2] = __builtin_bit_cast(bf16x8, (u32x4){cvt_pk_bf16(p1[0], p1[1]), cvt_pk_bf16(p1[2], p1[3]), cvt_pk_bf16(p1[4], p1[5]), cvt_pk_bf16(p1[6], p1[7])}); \
        pa[3] = __builtin_bit_cast(bf16x8, (u32x4){cvt_pk_bf16(p1[8], p1[9]), cvt_pk_bf16(p1[10], p1[11]), cvt_pk_bf16(p1[12], p1[13]), cvt_pk_bf16(p1[14], p1[15])}); } while (0)
    DUAL_MAP_(k1img, q1img, pa1, l1);
    DUAL_MAP_(k2img, q2img, pa2, l2);
#undef DUAL_MAP_
    __builtin_amdgcn_sched_barrier(0);
#pragma unroll
    for (int s = 0; s < 4; ++s) {
#pragma unroll
        for (int db = 0; db < 4; ++db) {
            const s16x4 lo = vtr(vimg + vboff + db * 4096 + s * 1024), h4 = vtr(vimg + vboff + db * 4096 + s * 1024 + 512);
            const bf16x8 vt = (bf16x8){lo[0], lo[1], lo[2], lo[3], h4[0], h4[1], h4[2], h4[3]};
            o1[db] = mfma32(vt, pa1[s], o1[db]); o2[db] = mfma32(vt, pa2[s], o2[db]);
            if (db & 1) __builtin_amdgcn_sched_barrier(0);
        }
    }
}
template <bool FAST, int NDB, class QF, class MaskF>
__device__ __forceinline__ void flash_step(float& m_run, float& l_run, f32x16& lacc, f32x16 (&o)[NDB], const LAS unsigned char* kimg, const LAS unsigned char* vimg, const QF& qf, const MaskF& maskf, int r32, int hi, int vboff) {
    if constexpr (FAST) flash_tile_ref0<NDB>(l_run, lacc, o, kimg, vimg, qf, maskf, r32, hi, vboff); else flash_tile<NDB>(m_run, l_run, o, kimg, vimg, qf, maskf, r32, hi, vboff);
}
__device__ __forceinline__ bool softmax_ref0_ok(const float* gq, const float* gk, int lane) {
    float a = fabsf(gq[lane]), b = fabsf(gk[lane]);
    a = fmaxf(a, xor_lane<1>(a)); a = fmaxf(a, xor_lane<2>(a)); a = fmaxf(a, xor_lane<4>(a)); a = fmaxf(a, xor_lane<8>(a)); a = fmaxf(a, xor_lane<16>(a)); a = max_xor32(a);
    b = fmaxf(b, xor_lane<1>(b)); b = fmaxf(b, xor_lane<2>(b)); b = fmaxf(b, xor_lane<4>(b)); b = fmaxf(b, xor_lane<8>(b)); b = fmaxf(b, xor_lane<16>(b)); b = max_xor32(b);
    return __builtin_amdgcn_readfirstlane(__builtin_bit_cast(int, a * b * (C2 * 64.0f * 1.02f))) < __builtin_bit_cast(int, 48.0f) && REF0_ENABLE;
}
#define MASK_INIT_ZERO __device__ __forceinline__ void init(f32x16& p0, f32x16& p1) const { p0 = splat16(0.f); p1 = splat16(0.f); }
#define MASK_PACK_NONE __device__ __forceinline__ void pack(bf16x8&) const {}
struct MaskNone { MASK_INIT_ZERO MASK_PACK_NONE __device__ __forceinline__ void operator()(f32x16&, f32x16&) const {} };
struct MaskCausal { int kb0, qloc, hi;
    MASK_INIT_ZERO MASK_PACK_NONE
    __device__ __forceinline__ void operator()(f32x16& p0, f32x16& p1) const {
#pragma unroll
        for (int r = 0; r < 16; ++r) { const int kv = kb0 + crow(r, hi); p0[r] = kv > qloc ? NEG_INF : p0[r]; p1[r] = kv + 32 > qloc ? NEG_INF : p1[r]; } } };
struct MaskCausalIf { bool on; int kb0, qloc, hi;
    MASK_INIT_ZERO MASK_PACK_NONE
    __device__ __forceinline__ void operator()(f32x16& p0, f32x16& p1) const { if (on) {
#pragma unroll
        for (int r = 0; r < 16; ++r) { const int kv = kb0 + crow(r, hi); p0[r] = kv > qloc ? NEG_INF : p0[r]; p1[r] = kv + 32 > qloc ? NEG_INF : p1[r]; } } } };
struct MaskLaneP { unsigned keep;
    MASK_INIT_ZERO
    __device__ __forceinline__ void operator()(f32x16&, f32x16&) const {}
    __device__ __forceinline__ void pack(bf16x8& pa) const { u32x4 v = __builtin_bit_cast(u32x4, pa); v = v & keep; pa = __builtin_bit_cast(bf16x8, v); } };
struct MaskLane { float ci;
    MASK_INIT_ZERO MASK_PACK_NONE
    __device__ __forceinline__ void operator()(f32x16& p0, f32x16& p1) const {
#pragma unroll
        for (int r = 0; r < 16; ++r) { p0[r] += ci; p1[r] += ci; } } };
template <int POS> __device__ __forceinline__ float neginf_if_bit(unsigned n) { float r; asm("v_bfe_i32 %0, %1, %2, 1\n\tv_and_b32 %0, 0xff800000, %0" : "=v"(r) : "v"(n), "n"(POS)); return r; }
struct MaskBits { unsigned n0, n1;
    __device__ __forceinline__ void init(f32x16& p0, f32x16& p1) const {
#define MB_(r) p0[r] = neginf_if_bit<((r) & 3) + 8 * ((r) >> 2)>(n0); p1[r] = neginf_if_bit<((r) & 3) + 8 * ((r) >> 2)>(n1);
        MB_(0) MB_(1) MB_(2) MB_(3) MB_(4) MB_(5) MB_(6) MB_(7) MB_(8) MB_(9) MB_(10) MB_(11) MB_(12) MB_(13) MB_(14) MB_(15)
#undef MB_
        asm volatile("s_nop 1" ::: "memory"); }
    MASK_PACK_NONE
    __device__ __forceinline__ void operator()(f32x16&, f32x16&) const {} };
__device__ __forceinline__ void dma16(const void* g, LAS unsigned char* l) { __builtin_amdgcn_global_load_lds((const unsigned*)g, (LAS unsigned*)l, 16, 0, 0); }
#define DMA_WAIT_SYNC() do { asm volatile("s_waitcnt vmcnt(0)" ::: "memory"); __syncthreads(); } while (0)

__device__ __forceinline__ void glds16(const void* gsrc, unsigned lds_dst) { unsigned keep;
    asm volatile("s_mov_b32 %0, m0\n\ts_mov_b32 m0, %2\n\ts_nop 0\n\tglobal_load_lds_dwordx4 %1, off\n\ts_mov_b32 m0, %0" : "=&s"(keep) : "v"(gsrc), "s"(lds_dst) : "memory"); }
__device__ __forceinline__ void glds4(const void* gsrc, unsigned lds_dst) { unsigned keep;
    asm volatile("s_mov_b32 %0, m0\n\ts_mov_b32 m0, %2\n\ts_nop 0\n\tglobal_load_lds_dword %1, off\n\ts_mov_b32 m0, %0" : "=&s"(keep) : "v"(gsrc), "s"(lds_dst) : "memory"); }
#define WAITV_BAR(N) asm volatile("s_waitcnt vmcnt(" #N ") lgkmcnt(0)\n\ts_barrier" ::: "memory")

template <int MODE, bool FAST>
__device__ __forceinline__ void attn_ab_unit(int b, int h, int qt, const bf16_t* qkv, bf16_t* obuf, const float* kmean, const unsigned* maskg, LAS unsigned char* lds, int tid, int lane, int w) {
    constexpr int CQ = MODE == 0 ? C_QA : C_QB, CK = MODE == 0 ? C_KA : C_KB, CV = MODE == 0 ? C_VA : C_VB;
    constexpr int NS = 4, D = 3, SLOT = 16384;
    const int r32 = lane & 31, hi = lane >> 5;
    const size_t rowbase = (size_t)b * SEQ; const int q0 = 256 * qt, qloc = 32 * w + r32; const size_t qrow = rowbase + q0 + qloc;
    const unsigned lds0 = (unsigned)(size_t)lds;
    LAS float* kml = (LAS float*)(lds + 73728); LAS unsigned* mwl = (LAS unsigned*)(lds + 65536);
    bf16x8 qf[4];
#pragma unroll
    for (int ks = 0; ks < 4; ++ks) qf[ks] = *(const bf16x8*)(qkv + qrow * QP + CQ + 64 * h + 16 * ks + 8 * hi);
    const bf16_t* ksrc = qkv + (rowbase + kdma_row(w, lane)) * QP + CK + 64 * h + 8 * kdma_chunk(w, lane);
    const bf16_t* vsrc = qkv + (rowbase + 16 * (w & 3) + (lane >> 2)) * QP + CV + 64 * h + 32 * (w >> 2) + 8 * (lane & 3);
    const unsigned* msrc = maskg + qrow * 128 + hi;
    const int NT = 4 * qt + 4, wlim = 4 * qt + (w >> 1);
    const unsigned kdst0 = (unsigned)__builtin_amdgcn_readfirstlane(lds0 + w * 1024), mdst0 = (unsigned)__builtin_amdgcn_readfirstlane(lds0 + 65536 + w * 256);
    __syncthreads();
#pragma unroll
    for (int d = 0; d < D; ++d) { const int t = d < NT ? d : NT - 1;
        glds16(ksrc + (size_t)t * 64 * QP, kdst0 + d * SLOT); glds16(vsrc + (size_t)t * 64 * QP, kdst0 + d * SLOT + 8192);
        if (MODE == 1) glds4(msrc + 2 * t, mdst0 + d * 2048); }
    unsigned selbits = 0;
    if (MODE == 0) {
        if (tid < 256) ((LAS f32x4*)kml)[tid] = ((const f32x4*)(kmean + (size_t)((b * 4 + h) * 16) * 64))[tid];
        __syncthreads();
        if (qt > 0) {
            float qv[32];
#pragma unroll
            for (int ks = 0; ks < 4; ++ks) { const u32x4 qq = __builtin_bit_cast(u32x4, qf[ks]);
#pragma unroll
                for (int k = 0; k < 4; ++k) { qv[8 * ks + 2 * k] = bf_lo(qq[k]); qv[8 * ks + 2 * k + 1] = bf_hi(qq[k]); } }
            float v1 = NEG_INF, v2 = NEG_INF, v3 = NEG_INF; int i1 = -1, i2 = -1, i3 = -1;
#pragma unroll 1
            for (int j = 0; j < qt; ++j) {
                float g = 0.f;
#pragma unroll
                for (int ks = 0; ks < 4; ++ks) { const f32x4 k0 = *(const LAS f32x4*)(kml + j * 64 + 16 * ks + 8 * hi), k1 = *(const LAS f32x4*)(kml + j * 64 + 16 * ks + 8 * hi + 4);
                    g += qv[8 * ks + 0] * k0[0] + qv[8 * ks + 1] * k0[1] + qv[8 * ks + 2] * k0[2] + qv[8 * ks + 3] * k0[3] + qv[8 * ks + 4] * k1[0] + qv[8 * ks + 5] * k1[1] + qv[8 * ks + 6] * k1[2] + qv[8 * ks + 7] * k1[3]; }
                g = sum_xor32(g);
                if (g > v1) { v3 = v2; i3 = i2; v2 = v1; i2 = i1; v1 = g; i1 = j; }
                else if (g > v2) { v3 = v2; i3 = i2; v2 = g; i2 = j; }
                else if (g > v3) { v3 = g; i3 = j; }
            }
            if (i1 >= 0) selbits |= 1u << i1; if (i2 >= 0) selbits |= 1u << i2; if (i3 >= 0) selbits |= 1u << i3;
        }
    }
    const int vboff = (4 * hi + ((lane & 15) >> 2)) * 64 + ((lane >> 4) & 1) * 32 + (lane & 3) * 8;
    float m_run = -1e30f, l_run = 0.f; f32x16 o[2], lacc = splat16(0.f); o[0] = splat16(0.f); o[1] = splat16(0.f);
    int scur = 0, siss = D;
    asm volatile("s_waitcnt vmcnt(0)" ::: "memory");
    asm volatile("" : "+v"(qf[0]), "+v"(qf[1]), "+v"(qf[2]), "+v"(qf[3]));
#pragma unroll 1
    for (int kt = 0; kt < NT; ++kt) {
        if (MODE == 1) WAITV_BAR(6); else WAITV_BAR(4);
        { const int t = kt + D < NT ? kt + D : NT - 1;
          glds16(ksrc + (size_t)t * 64 * QP, kdst0 + siss * SLOT); glds16(vsrc + (size_t)t * 64 * QP, kdst0 + siss * SLOT + 8192);
          if (MODE == 1) glds4(msrc + 2 * t, mdst0 + siss * 2048); }
        const LAS unsigned char* cur = lds + scur * SLOT;
        if (MODE == 0) {
            const int j = kt >> 2;
            if (j < qt) { const bool sel = (selbits >> j) & 1u; if (__ballot(sel) != 0ull) { if (FAST) flash_step<FAST, 2>(m_run, l_run, lacc, o, cur, cur + 8192, QReg{qf}, MaskLaneP{sel ? 0xffffffffu : 0u}, r32, hi, vboff); else flash_step<FAST, 2>(m_run, l_run, lacc, o, cur, cur + 8192, QReg{qf}, MaskLane{sel ? 0.f : NEG_INF}, r32, hi, vboff); } }
            else { const int kb0 = 64 * (kt & 3); if (kb0 <= 32 * w + 31) flash_step<FAST, 2>(m_run, l_run, lacc, o, cur, cur + 8192, QReg{qf}, MaskCausal{kb0, qloc, hi}, r32, hi, vboff); }
        } else {
            if (kt <= wlim) { const LAS unsigned* mp = mwl + scur * 512 + w * 64; const unsigned cw0 = mp[r32], cw1 = mp[32 + r32];
                flash_step<FAST, 2>(m_run, l_run, lacc, o, cur, cur + 8192, QReg{qf}, MaskBits{~cw0 >> (4 * hi), ~cw1 >> (4 * hi)}, r32, hi, vboff); }
        }
        scur = scur + 1 == NS ? 0 : scur + 1; siss = siss + 1 == NS ? 0 : siss + 1;
    }
    asm volatile("s_waitcnt vmcnt(0)" ::: "memory");
    const float inv = 1.0f / (FAST ? lacc[0] : sum_xor32(l_run));
    bf16_t* orow = obuf + qrow * 256 + 64 * h;
#pragma unroll
    for (int db = 0; db < 2; ++db)
#pragma unroll
        for (int g = 0; g < 4; ++g)
            *(u32x2*)(orow + 32 * db + 8 * g + 4 * hi) = (u32x2){cvt_pk_bf16(o[db][4 * g] * inv, o[db][4 * g + 1] * inv), cvt_pk_bf16(o[db][4 * g + 2] * inv, o[db][4 * g + 3] * inv)};
}

template <bool FAST>
__device__ __forceinline__ void attn_c_unit(int b, int h, int qt, const bf16_t* qkv, bf16_t* oc, float lam, const float* subg, float coef, LAS unsigned char* lds, int tid, int lane, int w) {
    const int r32 = lane & 31, hi = lane >> 5;
    const size_t rowbase = (size_t)b * SEQ; const int q0 = 256 * qt, qloc = 32 * w + r32; const size_t qrow = rowbase + q0 + qloc;
    LAS unsigned char* qimg = lds + 65536 + w * 8192 + lane * 16;
    __syncthreads();
#pragma unroll
    for (int ks = 0; ks < 4; ++ks) { *(LAS bf16x8*)(qimg + ks * 1024) = *(const bf16x8*)(qkv + qrow * QP + C_Q1 + 64 * h + 16 * ks + 8 * hi); *(LAS bf16x8*)(qimg + 4096 + ks * 1024) = *(const bf16x8*)(qkv + qrow * QP + C_Q2 + 64 * h + 16 * ks + 8 * hi); }
    const bf16_t* k1src = FAST ? qkv + (rowbase + kdma_row(w, lane)) * QP + C_K1 + 64 * h + 8 * kdma_chunk(w, lane)
                               : qkv + (rowbase + lane) * QP + C_K1 + 64 * h + 8 * w;
    const bf16_t* k2src = k1src + (C_K2 - C_K1);
    const bf16_t* v0src = qkv + (rowbase + 16 * (w & 3) + (lane >> 2)) * QP + C_VC + 128 * h + 32 * (w >> 2) + 8 * (lane & 3);
    const bf16_t* v1src = v0src + 64;
    const int vboff = (4 * hi + ((lane & 15) >> 2)) * 64 + ((lane >> 4) & 1) * 32 + (lane & 3) * 8;
    const int NT = 4 * qt + 4;
    float m1 = -1e30f, l1 = 0.f, m2 = -1e30f, l2 = 0.f; f32x16 o1[4], o2[4];
#pragma unroll
    for (int i = 0; i < 4; ++i) { o1[i] = splat16(0.f); o2[i] = splat16(0.f); }
    dma16(k1src, lds + w * 1024); dma16(k2src, lds + 8192 + w * 1024); dma16(v0src, lds + 16384 + w * 1024); dma16(v1src, lds + 16384 + 8192 + w * 1024);
    DMA_WAIT_SYNC();
#pragma unroll 1
    for (int kt = 0; kt < NT; ++kt) {
        LAS unsigned char* cur = lds + (kt & 1) * 32768; LAS unsigned char* nxt = lds + ((kt + 1) & 1) * 32768;
        if (kt + 1 < NT) { const size_t adv = (size_t)(kt + 1) * 64 * QP;
            dma16(k1src + adv, nxt + w * 1024); dma16(k2src + adv, nxt + 8192 + w * 1024); dma16(v0src + adv, nxt + 16384 + w * 1024); dma16(v1src + adv, nxt + 16384 + 8192 + w * 1024); }
        const bool band = kt >= 4 * qt; const int kb0 = 64 * (kt & 3);
        if (!band || kb0 <= 32 * w + 31) { const MaskCausalIf mk{band, kb0, qloc, hi};
            if (FAST) flash_tile_dual_ref0<true>(l1, l2, o1, o2, cur, cur + 8192, cur + 16384, qimg, qimg + 4096, mk, r32, hi, vboff);
            else { flash_step<false, 4>(m1, l1, o1[0], o1, cur, cur + 16384, QLds{qimg}, mk, r32, hi, vboff); flash_step<false, 4>(m2, l2, o2[0], o2, cur + 8192, cur + 16384, QLds{qimg + 4096}, mk, r32, hi, vboff); } }
        DMA_WAIT_SYNC();
    }
    const float i1 = 1.0f / sum_xor32(l1), i2 = lam / sum_xor32(l2);
    float ss = 0.f;
#pragma unroll
    for (int db = 0; db < 4; ++db) { o1[db] = o1[db] * i1 - o2[db] * i2;
#pragma unroll
        for (int r = 0; r < 16; ++r) ss += o1[db][r] * o1[db][r]; }
    ss = sum_xor32(ss);
    const float rn = coef / sqrtf(ss * (1.0f / 128.0f) + EPS);
    bf16_t* orow = oc + qrow * 512 + 128 * h;
#pragma unroll
    for (int db = 0; db < 4; ++db)
#pragma unroll
        for (int g = 0; g < 4; ++g) { const int d = 32 * db + 8 * g + 4 * hi; const f32x4 gg = *(const f32x4*)(subg + d);
            *(u32x2*)(orow + d) = (u32x2){cvt_pk_bf16(o1[db][4 * g] * rn * gg[0], o1[db][4 * g + 1] * rn * gg[1]), cvt_pk_bf16(o1[db][4 * g + 2] * rn * gg[2], o1[db][4 * g + 3] * rn * gg[3])}; }
}

__device__ __forceinline__ void index_unit(int b, int i64, const bf16_t* qkv, unsigned* maskg, unsigned char* scr, LAS unsigned char* lds, int tid, int lane, int w) {
    constexpr int NS = 5, D = 4, HS = 257, RING = 84224, TOFF = 65792, TROW = 144;
    const int r32 = lane & 31, hi = lane >> 5;
    const unsigned lds0 = (unsigned)(size_t)lds;
    LAS unsigned* hist = (LAS unsigned*)lds; LAS unsigned char* ring = lds + RING; LAS unsigned char* mb8 = lds;
    LAS int* thrB1 = (LAS int*)(lds + 125184); LAS int* thrRem = thrB1 + 64; LAS int* thrT = thrB1 + 128; LAS int* thrNeed = thrB1 + 192;
    const size_t rowbase = (size_t)b * SEQ; const int q0 = 64 * i64, NT = i64 + 1;
    __syncthreads();
    {
        const int hh = 4 * ((r32 >> 3) & 1) + (r32 & 3), qp = 2 * (r32 >> 4) + ((r32 >> 2) & 1);
        bf16x8 aq[2][4]; float wv[2][2][8];
#pragma unroll
        for (int rb = 0; rb < 2; ++rb) {
            const size_t row = rowbase + q0 + 8 * w + 4 * rb + qp;
#pragma unroll
            for (int ks = 0; ks < 4; ++ks) aq[rb][ks] = *(const bf16x8*)(qkv + row * QP + C_QI + 64 * hh + 16 * ks + 8 * hi);
#pragma unroll
            for (int hf = 0; hf < 2; ++hf) { const u32x4 ww = *(const u32x4*)(qkv + (rowbase + q0 + 8 * w + 4 * rb + 2 * hf + hi) * QP + C_WI);
#pragma unroll
                for (int k = 0; k < 4; ++k) { wv[rb][hf][2 * k] = bf_lo(ww[k]); wv[rb][hf][2 * k + 1] = bf_hi(ww[k]); } }
        }
#pragma unroll
        for (int rb = 0; rb < 2; ++rb) { asm volatile("" : "+v"(aq[rb][0]), "+v"(aq[rb][1]), "+v"(aq[rb][2]), "+v"(aq[rb][3]));
#pragma unroll
            for (int hf = 0; hf < 2; ++hf) asm volatile("" : "+v"(wv[rb][hf][0]), "+v"(wv[rb][hf][1]), "+v"(wv[rb][hf][2]), "+v"(wv[rb][hf][3]), "+v"(wv[rb][hf][4]), "+v"(wv[rb][hf][5]), "+v"(wv[rb][hf][6]), "+v"(wv[rb][hf][7])); }
        const bf16_t* ksrc = qkv + (rowbase + kdma_row(w, lane)) * QP + C_KI + 8 * kdma_chunk(w, lane);
        const unsigned kdst0 = (unsigned)__builtin_amdgcn_readfirstlane(lds0 + RING + w * 1024);
#pragma unroll
        for (int d = 0; d < D; ++d) { const int t = d < NT ? d : NT - 1; glds16(ksrc + (size_t)t * 64 * QP, kdst0 + d * 8192); }
        for (int i = tid; i < 4112; i += 512) ((LAS u32x4*)hist)[i] = (u32x4){0u, 0u, 0u, 0u};
        asm volatile("s_waitcnt lgkmcnt(0)" ::: "memory");
        int scur = 0, siss = D;
#pragma unroll 1
        for (int kt = 0; kt <= NT; ++kt) {
            if (kt < NT) WAITV_BAR(3); else { asm volatile("s_waitcnt vmcnt(0)" ::: "memory"); __syncthreads(); }
            if (kt > 0) {
                const u32x4 kk = *(const LAS u32x4*)(lds + TOFF + ((kt - 1) & 1) * 9216 + lane * TROW + w * 16);
                {
                    const u32x4 ks = *(const LAS u32x4*)(lds + TOFF + ((kt - 1) & 1) * 9216 + (8 * w + (lane >> 3)) * TROW + (lane & 7) * 16);
                    unsigned char* sp = scr + (size_t)(8 * w + (lane >> 3)) * 8192 + (size_t)(kt - 1) * 128 + (lane & 7) * 16;
                    if (kt < NT) asm volatile("global_store_dwordx4 %0, %1, off" :: "v"(sp), "v"(ks) : "memory");
                    else *(u32x4*)sp = ks; }
#pragma unroll
                for (int k = 0; k < 4; ++k) { const unsigned a = kk[k] & 0xffffu, c = kk[k] >> 16;
                    if (a) __hip_atomic_fetch_add(&hist[lane * HS + (a >> 8)], 1u, __ATOMIC_RELAXED, __HIP_MEMORY_SCOPE_WORKGROUP);
                    if (c) __hip_atomic_fetch_add(&hist[lane * HS + (c >> 8)], 1u, __ATOMIC_RELAXED, __HIP_MEMORY_SCOPE_WORKGROUP); }
            }
            if (kt == NT) break;
            { const int t = kt + D < NT ? kt + D : NT - 1; glds16(ksrc + (size_t)t * 64 * QP, kdst0 + siss * 8192); }
            const LAS unsigned char* kimg = ring + scur * 8192;
            const bool diag = kt == NT - 1;
#pragma unroll
            for (int rb = 0; rb < 2; ++rb)
#pragma unroll
                for (int kb = 0; kb < 2; ++kb) {
                    f32x16 d = splat16(0.f);
#pragma unroll
                    for (int ks = 0; ks < 4; ++ks) { __builtin_amdgcn_s_setprio(1); d = mfma32(aq[rb][ks], *(const LAS bf16x8*)(kimg + kimg_off(32 * kb + r32, 2 * ks + hi)), d); __builtin_amdgcn_s_setprio(0); }
#pragma unroll
                    for (int hf = 0; hf < 2; ++hf) {
                        float sc = 0.f;
#pragma unroll
                        for (int t = 0; t < 8; ++t) { const float mx_ = fmaxf(d[8 * hf + t], 0.f); asm("v_fma_f32 %0, %1, %2, %0" : "+v"(sc) : "v"(wv[rb][hf][t]), "v"(mx_)); }
                        const int ql = 8 * w + 4 * rb + 2 * hf + hi;
                        const unsigned u = (unsigned)__builtin_bit_cast(unsigned short, (_Float16)sc);
                        unsigned key = u ^ ((u & 0x8000u) ? 0xffffu : 0x8000u);
                        if (diag && 32 * kb + r32 > ql) key = 0u;
                        *(LAS unsigned short*)(lds + TOFF + (kt & 1) * 9216 + ql * TROW + (32 * kb + r32) * 2) = (unsigned short)key;
                    }
                }
            scur = scur + 1 == NS ? 0 : scur + 1; siss = siss + 1 == NS ? 0 : siss + 1;
        }
        asm volatile("s_waitcnt vmcnt(0)" ::: "memory");
        __syncthreads();
    }
#define IDX_SEARCH(STAGE) do { _Pragma("unroll 1") for (int qq = 0; qq < 8; ++qq) { const int q = 8 * w + qq; int target; \
        if (STAGE == 0) { if (q0 + q + 1 <= 256) { if (lane == 0) { thrB1[q] = 0x10000; thrRem[q] = 0; } continue; } target = 256; } \
        else { if (thrB1[q] == 0x10000) { if (lane == 0) { thrT[q] = 0; thrNeed[q] = 0; } continue; } target = thrRem[q]; } \
        const LAS unsigned* hp = hist + q * HS + 4 * lane; const int h0 = (int)hp[0], h1 = (int)hp[1], h2 = (int)hp[2], h3 = (int)hp[3]; \
        int P = h0 + h1 + h2 + h3; const int s_ = P; \
        _Pragma("unroll") for (int o = 1; o < 64; o <<= 1) { const int t_ = lane_val(P, (lane - o) & 63); if (lane >= o) P += t_; } \
        const int above = __builtin_amdgcn_readlane(P, 63) - P; (void)s_; \
        const int c3 = above + h3, c2 = c3 + h2, c1 = c2 + h1, c0 = c1 + h0; int bin = -1, ab = 0; \
        if (above < target && c3 >= target) { bin = 4 * lane + 3; ab = above; } else if (c3 < target && c2 >= target) { bin = 4 * lane + 2; ab = c3; } \
        else if (c2 < target && c1 >= target) { bin = 4 * lane + 1; ab = c2; } else if (c1 < target && c0 >= target) { bin = 4 * lane; ab = c1; } \
        if (bin >= 0) { if (STAGE == 0) { thrB1[q] = bin; thrRem[q] = target - ab; } else { thrT[q] = (thrB1[q] << 8) | bin; thrNeed[q] = target - ab; } } } \
        __syncthreads(); } while (0)
    IDX_SEARCH(0);
    const int qs = 8 * w + (lane >> 3), pc = lane & 7;
    const unsigned char* rrow = scr + (size_t)qs * 8192 + pc * 16;
    {
        __builtin_amdgcn_fence(__ATOMIC_ACQUIRE, "agent");
        asm volatile("s_waitcnt vmcnt(0)" ::: "memory");
        const int b1 = thrB1[qs];
        for (int i = tid; i < 4112; i += 512) ((LAS u32x4*)hist)[i] = (u32x4){0u, 0u, 0u, 0u};
        __syncthreads();
#pragma unroll 4
        for (int it = 0; it < NT; ++it) { const u32x4 kk = *(const u32x4*)(rrow + (size_t)it * 128);
#pragma unroll
            for (int k = 0; k < 4; ++k) { const unsigned a = kk[k] & 0xffffu, c = kk[k] >> 16;
                if ((int)(a >> 8) == b1) __hip_atomic_fetch_add(&hist[qs * HS + (a & 255u)], 1u, __ATOMIC_RELAXED, __HIP_MEMORY_SCOPE_WORKGROUP);
                if ((int)(c >> 8) == b1) __hip_atomic_fetch_add(&hist[qs * HS + (c & 255u)], 1u, __ATOMIC_RELAXED, __HIP_MEMORY_SCOPE_WORKGROUP); } }
        __syncthreads();
    }
    IDX_SEARCH(1);
    {
        const unsigned T = (unsigned)thrT[qs]; const int need = thrNeed[qs]; int tc = 0;
        __syncthreads();
#pragma unroll 2
        for (int it = 0; it < NT; ++it) { const u32x4 kk = *(const u32x4*)(rrow + (size_t)it * 128);
            unsigned sel = 0, eq = 0;
#pragma unroll
            for (int k = 0; k < 4; ++k) { const unsigned a = kk[k] & 0xffffu, c = kk[k] >> 16;
                sel |= (a > T ? 1u : 0u) << (2 * k); sel |= (c > T ? 1u : 0u) << (2 * k + 1); eq |= (a == T ? 1u : 0u) << (2 * k); eq |= (c == T ? 1u : 0u) << (2 * k + 1); }
            if (T == 0u) eq = 0u;
            if (__ballot(eq != 0u) != 0ull) {
                const int n = __popc(eq); int P = n;
#pragma unroll
                for (int o = 1; o < 8; o <<= 1) { const int t_ = lane_val(P, (lane - o) & 63); if ((lane & 7) >= o) P += t_; }
                int allow = need - tc - (P - n);
#pragma unroll
                for (int k = 0; k < 8; ++k) if (((eq >> k) & 1u) && allow > 0) { sel |= 1u << k; --allow; }
                tc += lane_val(P, (lane & ~7) + 7);
            }
            mb8[qs * 512 + it * 8 + pc] = (unsigned char)sel;
        }
        __syncthreads();
    }
#undef IDX_SEARCH
    for (int idx = tid; idx < 64 * 2 * NT; idx += 512) { const int q = idx / (2 * NT), wd = idx - q * 2 * NT; maskg[(rowbase + q0 + q) * 128 + wd] = ((const LAS unsigned*)mb8)[q * 128 + wd]; }
}

__device__ __forceinline__ int next_unit(unsigned* ctr, LAS unsigned char* lds, int tid) {
    volatile LAS int* bc = (volatile LAS int*)(lds + LX_BC);
    __syncthreads();
    if (tid == 0) *bc = (int)__hip_atomic_fetch_add(ctr, 1u, __ATOMIC_RELAXED, __HIP_MEMORY_SCOPE_AGENT);
    __syncthreads();
    return __builtin_amdgcn_readfirstlane(*bc);
}

__device__ __forceinline__ void m1_phase(const Args& a, unsigned char* ws, int lc, LAS unsigned char* lds, int tid, int lane, int wave, int vcu, int G) {
    const int l = lc & 1;
    const float* wrt = (const float*)(ws + WS_WRT);
    const float* bg = a.in[I_B_GROUP] + l * 4; const float* br = a.in[I_B_ROUTER] + l * 32;
    unsigned* cnt = (unsigned*)(ws + WS_CTL) + CW_CNT + 2048 * lc;
    unsigned* rt0 = (unsigned*)(ws + WS_RT0); unsigned* rt1 = (unsigned*)(ws + WS_RT1); f32x2* rtw = (f32x2*)(ws + WS_RTW);
    int* tokl = (int*)(ws + WS_TOKL); float* rstdg = (float*)(ws + WS_RSTD); const unsigned char* x16 = ws + WS_X16;
    const int r32 = lane & 31, kh = lane >> 5, kbase = 128 * wave + 64 * kh;
    LAS float* wgl = (LAS float*)lds; LAS float* part = (LAS float*)(lds + 16384); LAS float* tlw = (LAS float*)(lds + 98304 + wave * 640);
    LAS unsigned* lcnt = (LAS unsigned*)(lds + 104448); LAS unsigned* lbase = lcnt + 32; LAS unsigned* pk0 = lcnt + 64; LAS unsigned* pk1 = lcnt + 192;
    __syncthreads();
    if (tid < 32) lcnt[tid] = 0u;
    for (int k = tid; k < DM; k += 512) *(LAS f32x4*)(wgl + 4 * k) = (f32x4){wrt[k], wrt[DM + k], wrt[2 * DM + k], wrt[3 * DM + k]};
    f32x4 bw[16];
#pragma unroll
    for (int j = 0; j < 16; ++j) bw[j] = *(const f32x4*)(wrt + (size_t)(4 + r32) * DM + kbase + 4 * j);
    u32x4 xr[8];
    { const unsigned char* xp = x16 + ((size_t)(32 * vcu + r32) * DM + kbase) * 2;
#pragma unroll
      for (int j = 0; j < 8; ++j) xr[j] = vcu < MTOK / 32 ? *(const u32x4*)(xp + 16 * j) : (u32x4){0u, 0u, 0u, 0u}; }
    __syncthreads();
    int buf = 0, it = 0;
#pragma unroll 1
    for (int t = vcu; t < MTOK / 32; t += G, ++it) {
        f32x16 d0 = splat16(0.f); float ss = 0.f; f32x4 gp = {0.f, 0.f, 0.f, 0.f};
#pragma unroll
        for (int j = 0; j < 8; ++j) {
            float f[8];
#pragma unroll
            for (int k = 0; k < 4; ++k) { f[2 * k] = h_lo(xr[j][k]); f[2 * k + 1] = h_hi(xr[j][k]); }
#pragma unroll
            for (int i = 0; i < 8; ++i) { const int s = 8 * j + i;
                d0 = __builtin_amdgcn_mfma_f32_32x32x2f32(f[i], bw[s >> 2][s & 3], d0, 0, 0, 0);
                ss += f[i] * f[i]; gp += f[i] * *(const LAS f32x4*)(wgl + 4 * (kbase + s)); }
        }
        { const int tn = t + G < MTOK / 32 ? t + G : t; const unsigned char* xp = x16 + ((size_t)(32 * tn + r32) * DM + kbase) * 2;
#pragma unroll
          for (int j = 0; j < 8; ++j) xr[j] = *(const u32x4*)(xp + 16 * j); }
        ss = sum_xor32(ss);
#pragma unroll
        for (int c = 0; c < 4; ++c) gp[c] = sum_xor32(gp[c]);
        LAS float* pw = part + ((buf * 8 + wave) * 32) * 40;
#pragma unroll
        for (int r = 0; r < 16; ++r) pw[crow(r, kh) * 40 + 4 + r32] = d0[r];
        if (kh == 0) { *(LAS f32x4*)(pw + r32 * 40) = gp; pw[r32 * 40 + 36] = ss; }
        __syncthreads();
        { const int tk = 4 * wave + (lane >> 4), cg = lane & 15; const LAS float* pr = part + (buf * 8 * 32 + tk) * 40;
            float s0 = 0.f, s1 = 0.f, s2 = 0.f;
#pragma unroll
            for (int w2 = 0; w2 < 8; ++w2) { s0 += pr[w2 * 1280 + cg]; s1 += pr[w2 * 1280 + 16 + cg]; if (cg < 5) s2 += pr[w2 * 1280 + 32 + cg]; }
            LAS float* tr = tlw + (lane >> 4) * 40; tr[cg] = s0; tr[16 + cg] = s1; if (cg < 5) tr[32 + cg] = s2; }
        LDS_WAIT(); asm volatile("" ::: "memory");
        if (lane < 4) {
            const LAS float* my = tlw + lane * 40; const int m = 32 * t + 4 * wave + lane;
            const float rstd = 1.0f / sqrtf(my[36] * (1.0f / DM) + EPS);
            float gl[4];
#pragma unroll
            for (int c = 0; c < 4; ++c) gl[c] = my[c] * rstd + bg[c];
            int g = 0; float gm = gl[0];
#pragma unroll
            for (int c = 1; c < 4; ++c) if (gl[c] > gm) { gm = gl[c]; g = c; }
            float den = 0.f;
#pragma unroll
            for (int c = 0; c < 4; ++c) den += __expf(gl[c] - gm);
            const float gwt = 1.0f / den;
            float le[8];
#pragma unroll
            for (int e = 0; e < 8; ++e) le[e] = my[4 + 8 * g + e] * rstd + br[8 * g + e];
            int i1 = 0; float v1 = le[0];
#pragma unroll
            for (int e = 1; e < 8; ++e) if (le[e] > v1) { v1 = le[e]; i1 = e; }
            int i2 = -1; float v2 = NEG_INF;
#pragma unroll
            for (int e = 0; e < 8; ++e) if (e != i1 && le[e] > v2) { v2 = le[e]; i2 = e; }
            const float ex = __expf(v2 - v1), w1 = 1.0f / (1.0f + ex), w2 = ex * w1;
            const int e0 = g * 8 + i1, e1 = g * 8 + i2, slot = (it & 3) * 32 + 4 * wave + lane;
            const unsigned r0 = __hip_atomic_fetch_add(lcnt + e0, 1u, __ATOMIC_RELAXED, __HIP_MEMORY_SCOPE_WORKGROUP), r1 = __hip_atomic_fetch_add(lcnt + e1, 1u, __ATOMIC_RELAXED, __HIP_MEMORY_SCOPE_WORKGROUP);
            pk0[slot] = ((unsigned)e0 << 24) | r0; pk1[slot] = ((unsigned)e1 << 24) | r1;
            rtw[m] = (f32x2){gwt * w1, gwt * w2}; rstdg[m] = rstd;
        }
        buf ^= 1;
        if ((it & 3) == 3 || t + G >= MTOK / 32) {
            __syncthreads();
            if (tid < 32) { const unsigned n = lcnt[tid]; lbase[tid] = n ? atomicAdd(cnt + 64 * tid, n) : 0u; lcnt[tid] = 0u; }
            __syncthreads();
            const int nt4 = (it & 3) + 1;
            if (tid < 32 * nt4) { const int j = tid >> 5, m = 32 * (t - (nt4 - 1 - j) * G) + (tid & 31);
                const unsigned a0 = pk0[tid], a1 = pk1[tid]; const unsigned e0 = a0 >> 24, e1 = a1 >> 24, r0 = lbase[e0] + (a0 & 0xffffffu), r1 = lbase[e1] + (a1 & 0xffffffu);
                rt0[m] = (e0 << 24) | r0; rt1[m] = (e1 << 24) | r1; tokl[e0 * 32768 + r0] = m; tokl[e1 * 32768 + r1] = m; }
        }
    }
    __syncthreads();
}
__device__ __forceinline__ void moe_tables(const unsigned* cnt, const int* tokl, const float* rstdg, LAS unsigned char* lds, int tid, int c, int G) {
    LAS int* pstart = (LAS int*)(lds + LX_PSTART); LAS int* blk2e = (LAS int*)(lds + LX_BLK2E); LAS int* cntl = (LAS int*)(lds + LX_CNT); LAS int* tok = (LAS int*)(lds + LX_TOK);
    if (tid < 64) {
        const int cn = tid < NEXP ? (int)cnt[64 * tid] : 0, nb = (cn + 255) >> 8;
        int P = nb;
#pragma unroll
        for (int o = 1; o < 64; o <<= 1) { const int t = lane_val(P, (tid - o) & 63); if (tid >= o) P += t; }
        const int pb = P - nb;
        if (tid <= NEXP) pstart[tid] = pb * 256;
        if (tid < NEXP) cntl[tid] = cn;
        if (tid == NEXP) *(LAS int*)(lds + LX_NBLK) = pb < MAXBLK ? pb : MAXBLK;
#pragma unroll 1
        for (int k = 0; k < nb; ++k) if (pb + k < MAXBLK) blk2e[pb + k] = tid;
    }
    __syncthreads();
    const int nblk = *(const LAS int*)(lds + LX_NBLK), rbs = G / 4;
    LAS float* rst = (LAS float*)(lds + LX_RST);
    for (int k = 0; k < 6; ++k) { const int rb = c / 4 + k * rbs; if (rb >= nblk) break;
        const int e = blk2e[rb], r = rb * 256 - pstart[e] + (tid & 255);
        if (tid < 256) { const int tk = r < cntl[e] ? tokl[e * 32768 + r] : 0; tok[k * 256 + tid] = tk; rst[k * 256 + tid] = rstdg[tk]; } }
    __syncthreads();
}

#ifndef PHASES
#define PHASES 0xFFFF
#endif
#define PH(n) if constexpr (((PHASES) >> (n)) & 1)
#ifndef REPEAT_MASK
#define REPEAT_MASK 0
#endif
#define REP(k) for (int rep_ = 0; rep_ < 1 + (((REPEAT_MASK) >> (k)) & 1); ++rep_)
#ifndef PROBE_SEL
#define PROBE_SEL 0
#endif
#define PROBE_MUL 10
#ifndef PROBE_CLK
#define PROBE_CLK -1
#endif
#define PT0(p) do { if constexpr (((PROBE_SEL) >> (9 * L + (p))) & 1) pt_ -= (long long)wall_clock64(); if constexpr ((PROBE_CLK) == 9 * L + (p)) { ck_ -= (long long)clock64(); kt_ -= (long long)wall_clock64(); } } while (0)
#define PT1(p) do { if constexpr (((PROBE_SEL) >> (9 * L + (p))) & 1) pt_ += (long long)wall_clock64(); if constexpr ((PROBE_CLK) == 9 * L + (p)) { ck_ += (long long)clock64(); kt_ += (long long)wall_clock64(); } } while (0)
#ifndef GEMM_ALIGN
#define GEMM_ALIGN true
#endif
#ifndef GEMM_SP2
#define GEMM_SP2 true
#endif
#define PHASE_ENV() unsigned long long wsi_ = (unsigned long long)args.ws; int G = (int)gridDim.x, bx = (int)blockIdx.x; asm volatile("" : "+s"(wsi_), "+s"(G), "+s"(bx)); \
    unsigned long long obi_ = (unsigned long long)args.out; asm volatile("" : "+s"(obi_)); unsigned char* const outb = (unsigned char*)(GAS unsigned char*)obi_; (void)outb;   \
    unsigned char* const ws = (unsigned char*)(GAS unsigned char*)wsi_; const int vcu = (G % 8 == 0) ? (bx % 8) * (G / 8) + bx / 8 : bx;   \
    int tid = (int)threadIdx.x; asm volatile("" : "+v"(tid)); const int lane = tid & 63, wave = __builtin_amdgcn_readfirstlane(tid >> 6); \
    unsigned* const ctl = (unsigned*)(ws + WS_CTL); bf16_t* const QKV = (bf16_t*)(ws + WS_QKV); unsigned char* const SG = ws + WS_SG; unsigned* const MASK = (unsigned*)(ws + WS_MASK); float* const KMEAN = (float*)(ws + WS_KMEAN); \
    (void)lane; (void)wave; (void)ctl; (void)QKV; (void)SG; (void)MASK; (void)KMEAN; (void)vcu
#define GRID_BAR() do { unsigned long long wb_ = (unsigned long long)args.ws; asm volatile("" : "+s"(wb_)); XcdBarrier b_ = bar0; b_.bar = (unsigned*)((GAS unsigned char*)wb_ + WS_CTL) + CW_BAR; asm volatile("" : "+s"(b_.x)); xcd_barrier(b_); if (((REPEAT_MASK) >> 12) & 1) xcd_barrier(b_); } while (0)


template <int L> __device__ __forceinline__ void layer_body(const Args& args, LAS unsigned char* lds, const XcdBarrier& bar0, long long& pt_, long long& ck_, long long& kt_) {
    constexpr int l = L;
        PT0(0);

        PH(0) for (int rep_ = 0; rep_ < 1 + ((((REPEAT_MASK) >> 0) & 1) && l == 0); ++rep_) { PHASE_ENV(); p0_phase(args, ws, l, lds, tid, lane, wave, vcu, G); }
        GRID_BAR(); PT1(0); PT0(1);
        PH(1) REP(1) { PHASE_ENV();
            pg8::Gemm g{(const bf16_t*)(ws + WS_X16), (const bf16_t*)(ws + WS_WIN), MTOK, NT_IN * 256, DM}; pg8::StaticOrder S; S.init(MTOK, NT_IN * 256, G, bx);
            pg8::EpiInProj E{QKV, SG, (const float*)(ws + WS_COS), (const float*)(ws + WS_SIN), args.in[I_QK_GAIN] + l * 6 * 64, args.in[I_IDX_K_GAIN] + l * 64, (const float*)(ws + WS_RSTD1)};
            pg8::gemm_phase<pg8::EpiInProj, pg8::StaticOrder, GEMM_ALIGN, GEMM_SP2>(lds, g, S, E);
        }
        GRID_BAR(); PT1(1); PT0(2);
        { PHASE_ENV();
            LAS float* red = (LAS float*)lds;
            for (int it = bx; it < NBATCH * 4 * 16; it += G) { const int b = it >> 6, h = (it >> 4) & 3, blk = it & 15, d = tid & 63, rg = tid >> 6;
                const bf16_t* kp = QKV + ((size_t)b * SEQ + blk * 256 + rg * 32) * QP + C_KA + 64 * h + d; float s = 0.f;
#pragma unroll 8
                for (int r = 0; r < 32; ++r) s += __builtin_bit_cast(float, (unsigned)kp[(size_t)r * QP] << 16);
                __syncthreads(); red[tid] = s; __syncthreads();
                if (tid < 64) { float t = 0.f;
#pragma unroll
                    for (int k = 0; k < 8; ++k) t += red[k * 64 + tid];
                    KMEAN[(size_t)it * 64 + tid] = t * (1.0f / 256.0f); } }
            __syncthreads();
        }
        PH(2) REP(2) { PHASE_ENV();
            const float* dl = args.in[I_DIFF_LAMBDA] + l * 256;
            const float lam_init = 0.8f - 0.6f * __expf(-0.3f * (float)l);
            const float lam = __expf(wave_sum(dl[lane] * dl[64 + lane])) - __expf(wave_sum(dl[128 + lane] * dl[192 + lane])) + lam_init;
            const float* subg = args.in[I_DIFF_SUBLN] + l * 128;
            unsigned* qc = ctl + CW_QUEUE + 64 * (l * 4 + 0 + 8 * rep_);
            const float* qkg = args.in[I_QK_GAIN] + l * 6 * 64;
            if (softmax_ref0_ok(qkg + 4 * 64, qkg + 5 * 64, lane)) { for (;;) { const int u = next_unit(qc, lds, tid); if (u >= 512) break; const int r = u & 31; attn_c_unit<true>(r >> 2, r & 3, 15 - (u >> 5), QKV, (bf16_t*)(outb + OUT_OC), lam, subg, 1.0f - lam_init, lds, tid, lane, wave); } }
            else { for (;;) { const int u = next_unit(qc, lds, tid); if (u >= 512) break; const int r = u & 31; attn_c_unit<false>(r >> 2, r & 3, 15 - (u >> 5), QKV, (bf16_t*)(outb + OUT_OC), lam, subg, 1.0f - lam_init, lds, tid, lane, wave); } }
        }
        PH(3) REP(3) { PHASE_ENV();
            unsigned* qi = ctl + CW_QUEUE + 64 * (l * 4 + 1 + 8 * rep_);
            for (;;) { const int u = next_unit(qi, lds, tid); if (u >= 512) break; index_unit(u & 7, 63 - (u >> 3), QKV, MASK, bx < 192 ? ws + WS_WGU + (size_t)bx * 524288 : outb + OUT_SCR + (size_t)(bx - 192) * 524288, lds, tid, lane, wave); }
        }
        GRID_BAR(); PT1(2); PT0(3);
        PH(4) REP(4) { PHASE_ENV();
            unsigned* qa = ctl + CW_QUEUE + 64 * (l * 4 + 2 + 8 * rep_);
            const float* qkg = args.in[I_QK_GAIN] + l * 6 * 64;
            if (softmax_ref0_ok(qkg, qkg + 64, lane)) { for (;;) { const int u = next_unit(qa, lds, tid); if (u >= 512) break; const int r = u & 31; attn_ab_unit<0, true>(r >> 2, r & 3, 15 - (u >> 5), QKV, (bf16_t*)(outb + OUT_OA), KMEAN, MASK, lds, tid, lane, wave); } }
            else { for (;;) { const int u = next_unit(qa, lds, tid); if (u >= 512) break; const int r = u & 31; attn_ab_unit<0, false>(r >> 2, r & 3, 15 - (u >> 5), QKV, (bf16_t*)(outb + OUT_OA), KMEAN, MASK, lds, tid, lane, wave); } }
        }
        PH(5) REP(5) { PHASE_ENV();
            unsigned* qb = ctl + CW_QUEUE + 64 * (l * 4 + 3 + 8 * rep_);
            const float* qkg = args.in[I_QK_GAIN] + l * 6 * 64;
            if (softmax_ref0_ok(qkg + 2 * 64, qkg + 3 * 64, lane)) { for (;;) { const int u = next_unit(qb, lds, tid); if (u >= 512) break; const int r = u & 31; attn_ab_unit<1, true>(r >> 2, r & 3, 15 - (u >> 5), QKV, (bf16_t*)(outb + OUT_OB), KMEAN, MASK, lds, tid, lane, wave); } }
            else { for (;;) { const int u = next_unit(qb, lds, tid); if (u >= 512) break; const int r = u & 31; attn_ab_unit<1, false>(r >> 2, r & 3, 15 - (u >> 5), QKV, (bf16_t*)(outb + OUT_OB), KMEAN, MASK, lds, tid, lane, wave); } }
        }
        { PHASE_ENV();
            unsigned* qw = ctl + CW_QUEUE + 64 * (16 + l);
            for (;;) { const int c = next_unit(qw, lds, tid); if (c >= (32 * 32 * 16 + 32 * 32 * 8) / 128) break; convert_weights<true>(args, ws, l, lds, lane, wave, vcu, G, c); }
        }
        GRID_BAR(); PT1(3); PT0(4);
        PH(6) REP(6) {
            int nr_; { PHASE_ENV(); nr_ = (MTOK / 256 * (DM / 256) + G - 1) / G; }
#pragma unroll 1
            for (int i_ = 0; i_ < nr_; ++i_) {
                { PHASE_ENV(); pg8::OneUnit S; S.S.init(MTOK, DM, G, bx); S.i = i_; pg8::Gemm g{(const bf16_t*)(outb + OUT_OA), (const bf16_t*)(ws + WS_WPA), MTOK, DM, 256}; pg8::EpiMerge<0> E{(bf16_t*)(ws + WS_MERGED), SG}; pg8::gemm_phase<pg8::EpiMerge<0>, pg8::OneUnit, GEMM_ALIGN, GEMM_SP2>(lds, g, S, E); }
                { PHASE_ENV(); pg8::OneUnit S; S.S.init(MTOK, DM, G, bx); S.i = i_; pg8::Gemm g{(const bf16_t*)(outb + OUT_OB), (const bf16_t*)(ws + WS_WPB), MTOK, DM, 256}; pg8::EpiMerge<1> E{(bf16_t*)(ws + WS_MERGED), SG}; pg8::gemm_phase<pg8::EpiMerge<1>, pg8::OneUnit, GEMM_ALIGN, GEMM_SP2>(lds, g, S, E); }
                { PHASE_ENV(); pg8::OneUnit S; S.S.init(MTOK, DM, G, bx); S.i = i_; pg8::Gemm g{(const bf16_t*)(outb + OUT_OC), (const bf16_t*)(ws + WS_WPC), MTOK, DM, 512}; pg8::EpiMerge<2> E{(bf16_t*)(ws + WS_MERGED), SG}; pg8::gemm_phase<pg8::EpiMerge<2>, pg8::OneUnit, GEMM_ALIGN, GEMM_SP2>(lds, g, S, E); }
            }
        }
        GRID_BAR(); PT1(4); PT0(5);
        PH(7) for (int rep_ = 0; rep_ < 1 + ((((REPEAT_MASK) >> 7) & 1) && l == 0); ++rep_) { PHASE_ENV();
            pg8::Gemm g{(const bf16_t*)(ws + WS_MERGED), (const bf16_t*)(ws + WS_WO), MTOK, DM, DM}; pg8::StaticOrder S; S.init(MTOK, DM, G, bx);
            pg8::EpiResid E{ws + WS_X16};
            pg8::gemm_phase<pg8::EpiResid, pg8::StaticOrder, GEMM_ALIGN, GEMM_SP2>(lds, g, S, E);
        }
        GRID_BAR(); PT1(5); PT0(6);
        PH(8) REP(8) { PHASE_ENV(); m1_phase(args, ws, l + 2 * rep_, lds, tid, lane, wave, vcu, G); }
        GRID_BAR(); PT1(6); PT0(7);
        { PHASE_ENV(); moe_tables(ctl + CW_CNT + 2048 * (l + 2 * (((REPEAT_MASK) >> 8) & 1)), (const int*)(ws + WS_TOKL), (const float*)(ws + WS_RSTD), lds, tid, vcu, G); }
        PH(10) REP(10) { PHASE_ENV();
            const int nblk = *(const LAS int*)(lds + LX_NBLK);
            pg8::Gemm g{(const bf16_t*)(ws + WS_X16), (const bf16_t*)(ws + WS_WGU), MTOK, NEXP * 1024, DM};
            pg8::MoeOrder S{nblk * 4, G, vcu, (const LAS int*)(lds + LX_BLK2E)};
            pg8::EpiGateUp E{(bf16_t*)(ws + WS_HID), (const LAS float*)(lds + LX_RST), G / 4}; pg8::AMapMoe AM{(const LAS int*)(lds + LX_TOK), G / 4};
            pg8::gemm_phase<pg8::EpiGateUp, pg8::MoeOrder, GEMM_ALIGN, GEMM_SP2, pg8::AMapMoe>(lds, g, S, E, AM);
        }
        GRID_BAR(); PT1(7); PT0(8);
        PH(11) REP(11) { PHASE_ENV();
            const int nblk = *(const LAS int*)(lds + LX_NBLK);
            pg8::Gemm g{(const bf16_t*)(ws + WS_HID), (const bf16_t*)(ws + WS_WD), MAXBLK * 256, NEXP * 1024, DEXP};
            pg8::MoeOrder S{nblk * 4, G, vcu, (const LAS int*)(lds + LX_BLK2E)};
            pg8::EpiDown E{(bf16_t*)(ws + WS_Y)};
            pg8::gemm_phase<pg8::EpiDown, pg8::MoeOrder, GEMM_ALIGN, GEMM_SP2>(lds, g, S, E);
        }
        GRID_BAR(); PT1(8);
    }

__global__ void __launch_bounds__(512, 2) fwd_kernel(Args args) {
    extern __shared__ __attribute__((aligned(16))) unsigned char lds_raw[];
    LAS unsigned char* lds = (LAS unsigned char*)lds_raw;
    for (int u = threadIdx.x; u < (LDS_BYTES - LDSX) / 4; u += 512) ((LAS unsigned*)(lds + LDSX))[u] = 0u;
    __syncthreads();
    const XcdBarrier bar0 = xcd_barrier_post((unsigned*)(args.ws + WS_CTL) + CW_BAR, (volatile LAS unsigned*)(lds + LX_BAR));
    long long pt_ = 0, ck_ = 0, kt_ = 0;
    layer_body<0>(args, lds, bar0, pt_, ck_, kt_);
    layer_body<1>(args, lds, bar0, pt_, ck_, kt_);
    if constexpr (((PROBE_SEL) >> 18) & 1) pt_ -= (long long)wall_clock64();
    { PHASE_ENV();
        const int gw = vcu * 8 + wave, NGW = G * 8; const LAS int* pstart = (const LAS int*)(lds + LX_PSTART);
        for (int m = gw; m < MTOK; m += NGW) token_row<false, true, true>(nullptr, ws + WS_X16, args.out, (const bf16_t*)(ws + WS_Y), (const unsigned*)(ws + WS_RT0), (const unsigned*)(ws + WS_RT1), (const f32x2*)(ws + WS_RTW), pstart, nullptr, m, lane);
    }
    if constexpr ((PROBE_KL) != 0) { __syncthreads(); pt_ += *(const LAS long long*)(lds + LDSX + 14336); }
    if constexpr ((PROBE_SEL) != 0 || (PROBE_KL) != 0) {
        if constexpr (((PROBE_SEL) >> 18) & 1) { __syncthreads(); pt_ += (long long)wall_clock64(); }
        if (blockIdx.x == 0) { const long long t_end = (long long)wall_clock64() + ((PROBE_CLK) >= 0 ? (ck_ * 10000) / (kt_ > 0 ? kt_ : 1) : PROBE_MUL * pt_); while ((long long)wall_clock64() < t_end) __builtin_amdgcn_s_sleep(8); }
    }
}

extern "C" void kernel_launch(void* const* d_in, const int* in_sizes, int n_in, void* d_out, int out_size, void* d_ws, size_t ws_size, hipStream_t stream) {
    static int grid = 0;
    if (grid == 0) {
        if (n_in != N_INPUTS || in_sizes[0] != MTOK * DM || out_size != MTOK * DM || ws_size < WS_END) {
            fprintf(stderr, "kernel_launch: built for %d inputs, x/out of %d floats, >= %zu bytes of workspace; got n_in %d, in0 %d, out %d, ws %zu; nothing launched\n", (int)N_INPUTS, MTOK * DM, (size_t)WS_END, n_in, n_in > 0 ? in_sizes[0] : -1, out_size, ws_size);
            grid = -1; return; }
        int dev = 0, cus = 0;
        if (hipGetDevice(&dev) != hipSuccess || hipDeviceGetAttribute(&cus, hipDeviceAttributeMultiprocessorCount, dev) != hipSuccess) { fprintf(stderr, "kernel_launch: device query failed\n"); grid = -1; return; }
        if (hipFuncSetAttribute((const void*)fwd_kernel, hipFuncAttributeMaxDynamicSharedMemorySize, LDS_BYTES) != hipSuccess) { fprintf(stderr, "kernel_launch: hipFuncSetAttribute failed\n"); grid = -1; return; }
        int per_cu = 0;
        if (hipOccupancyMaxActiveBlocksPerMultiprocessor(&per_cu, (const void*)fwd_kernel, 512, LDS_BYTES) != hipSuccess || per_cu < 1) fprintf(stderr, "kernel_launch: note: occupancy query reports %d workgroups per CU\n", per_cu);
        (void)hipGetLastError();
        grid = cus < 256 ? cus : 256;
    }
    if (grid < 0) return;
    if (hipMemsetAsync((char*)d_ws + WS_CTL, 0, CTL_BYTES, stream) != hipSuccess) { fprintf(stderr, "kernel_launch: memset failed\n"); return; }
    Args a{};
    for (int i = 0; i < N_INPUTS; ++i) a.in[i] = (const float*)d_in[i];
    a.out = (float*)d_out; a.ws = (unsigned char*)d_ws;
    hipLaunchKernelGGL(fwd_kernel, dim3(grid), dim3(512), LDS_BYTES, stream, a);
    const hipError_t le = hipPeekAtLastError();
    if (le != hipSuccess) fprintf(stderr, "kernel_launch: launch failed: %s\n", hipGetErrorName(le));
}
```

```cpp
#include <hip/hip_runtime.h>
#include <cstdio>
#include <cstdint>

#define LAS __attribute__((address_space(3)))
#define GAS __attribute__((address_space(1)))
typedef unsigned short bf16_t;
typedef short bf16x8 __attribute__((ext_vector_type(8)));
typedef short s16x4 __attribute__((ext_vector_type(4)));
typedef float f32x4 __attribute__((ext_vector_type(4)));
typedef float f32x2 __attribute__((ext_vector_type(2)));
typedef float f32x16 __attribute__((ext_vector_type(16)));
typedef unsigned u32x4 __attribute__((ext_vector_type(4)));
typedef unsigned u32x2 __attribute__((ext_vector_type(2)));

constexpr int NBATCH = 8, SEQ = 4096, MTOK = NBATCH * SEQ, DM = 1024, NLAYER = 2;
constexpr int QP = 3656;
constexpr int C_QA = 0, C_KA = 256, C_VA = 512, C_QB = 768, C_KB = 1024, C_VB = 1280, C_QI = 1536, C_KI = 2048, C_WI = 2112,
              C_Q1 = 2120, C_Q2 = 2376, C_K1 = 2632, C_K2 = 2888, C_VC = 3144, C_G = 3656, D_IN = 6728;
constexpr int NT_IN = 27;
constexpr int NEXP = 32, DEXP = 512, MAXBLK = 288;
constexpr float C2 = 0.125f * 1.4426950408889634f;
constexpr float EPS = 1e-6f;
#ifndef PROBE_KL
#define PROBE_KL 0
#endif
#ifndef REF0_ENABLE
#define REF0_ENABLE 1
#endif

constexpr size_t MiB = 1u << 20;
constexpr size_t WS_CTL = 0, CTL_BYTES = 1 * MiB;
constexpr size_t WS_COS = 1 * MiB, WS_SIN = WS_COS + 512 * 1024;
constexpr size_t WS_SMALL = 2 * MiB;
constexpr size_t WS_RSTD1 = WS_SMALL + 128 * 1024;
constexpr size_t WS_KMEAN = WS_SMALL, WS_RT0 = WS_SMALL + 256 * 1024, WS_RT1 = WS_SMALL + 384 * 1024, WS_RTW = WS_SMALL + 512 * 1024, WS_WRT = WS_SMALL + 768 * 1024;
constexpr size_t WS_WIN = 3 * MiB;
constexpr size_t WS_WPA = 17 * MiB, WS_WPB = WS_WPA + 512 * 1024, WS_WPC = 18 * MiB;
constexpr size_t WS_WO = 19 * MiB;
constexpr size_t WS_WGU = 21 * MiB;
constexpr size_t WS_WD = 85 * MiB;
constexpr size_t WS_X16 = 117 * MiB;
constexpr size_t OUT_OA = 0, OUT_OB = 16 * MiB, OUT_OC = 32 * MiB, OUT_SCR = 64 * MiB;
constexpr size_t WS_QKV = 181 * MiB;
constexpr size_t WS_MERGED = WS_QKV, WS_Y = WS_QKV, WS_HID = WS_QKV + 144 * MiB;
constexpr size_t WS_TOKL = WS_QKV + 64 * MiB, WS_RSTD = WS_QKV + 68 * MiB;
constexpr size_t WS_SG = 410 * MiB;
constexpr size_t WS_MASK = 506 * MiB;
constexpr size_t WS_END = 522 * MiB;
static_assert((size_t)MTOK * QP * 2 <= 229 * MiB && (size_t)MAXBLK * 256 * 1024 * 2 <= 144 * MiB && (size_t)MAXBLK * 256 * 512 * 2 <= 72 * MiB, "ws map");
constexpr int CW_BAR = 4096;
constexpr int CW_QUEUE = 8192;
constexpr int CW_CNT = 16384;

constexpr int LDSX = 131072;
constexpr int LX_BAR = LDSX, LX_BC = LDSX + 16, LX_NBLK = LDSX + 32, LX_PSTART = LDSX + 64, LX_BLK2E = LDSX + 256, LX_CNT = LDSX + 1536, LX_TOK = LDSX + 2048, LX_RST = LDSX + 2048 + 6144;
constexpr int LDS_BYTES = 147456;

typedef __bf16 bf16x2_t __attribute__((ext_vector_type(2)));
__device__ __forceinline__ unsigned cvt_pk_bf16(float lo, float hi) { const f32x2 v = {lo, hi}; const bf16x2_t b = __builtin_convertvector(v, bf16x2_t); return __builtin_bit_cast(unsigned, b); }
typedef _Float16 f16x2_t __attribute__((ext_vector_type(2)));
__device__ __forceinline__ unsigned cvt_pk_f16(float lo, float hi) { const f32x2 v = {__builtin_amdgcn_fmed3f(lo, -65504.f, 65504.f), __builtin_amdgcn_fmed3f(hi, -65504.f, 65504.f)}; return __builtin_bit_cast(unsigned, __builtin_convertvector(v, f16x2_t)); }
__device__ __forceinline__ float h_lo(unsigned w) { return (float)__builtin_bit_cast(f16x2_t, w)[0]; }
__device__ __forceinline__ float h_hi(unsigned w) { return (float)__builtin_bit_cast(f16x2_t, w)[1]; }
__device__ __forceinline__ float bf_lo(unsigned w) { return __builtin_bit_cast(float, w << 16); }
__device__ __forceinline__ float bf_hi(unsigned w) { return __builtin_bit_cast(float, w & 0xffff0000u); }
template <int M> __device__ __forceinline__ float xor_lane(float v) {
    return __builtin_bit_cast(float, __builtin_amdgcn_ds_swizzle(__builtin_bit_cast(int, v), (M << 10) | 0x1f)); }
__device__ __forceinline__ float sum_xor32(float v) {
    const unsigned u = __builtin_bit_cast(unsigned, v); const auto rr = __builtin_amdgcn_permlane32_swap(u, u, false, false);
    return __builtin_bit_cast(float, (unsigned)rr[0]) + __builtin_bit_cast(float, (unsigned)rr[1]); }
__device__ __forceinline__ float max_xor32(float v) {
    const unsigned u = __builtin_bit_cast(unsigned, v); const auto rr = __builtin_amdgcn_permlane32_swap(u, u, false, false);
    return fmaxf(__builtin_bit_cast(float, (unsigned)rr[0]), __builtin_bit_cast(float, (unsigned)rr[1])); }
__device__ __forceinline__ int lane_val(int v, int src_lane) { return __builtin_amdgcn_ds_bpermute(src_lane << 2, v); }
__device__ __forceinline__ float wave_sum(float v) {
    v += xor_lane<1>(v); v += xor_lane<2>(v); v += xor_lane<4>(v); v += xor_lane<8>(v); v += xor_lane<16>(v);
    return sum_xor32(v);
}
__device__ __forceinline__ float fast_exp2(float x) { return __builtin_amdgcn_exp2f(x); }
__device__ __forceinline__ float fast_rcp(float x) { return __builtin_amdgcn_rcpf(x); }

namespace pg8 {
#define PG8_LAS __attribute__((address_space(3)))
typedef unsigned short bf16_t;
typedef short bf16x8 __attribute__((ext_vector_type(8)));
typedef float f32x4 __attribute__((ext_vector_type(4)));
typedef unsigned u32x4 __attribute__((ext_vector_type(4)));
constexpr int BM = 256, BK = 64, HALF = 128, HTB = HALF * BK * 2  , STAGE_BYTES = 8 * HTB, NXCD = 8, WGM = 8;

__host__ __device__ __forceinline__ int lds_byte(int r, int c) { const int st = (r >> 4) * 2 + (c >> 5), rr = r & 15, cc = c & 31, ob = rr * 64 + cc * 2; return st * 1024 + (ob ^ (((ob >> 9) & 1) << 5)); }
__host__ __device__ __forceinline__ void stage_rc(int b, int& R, int& C) { const int st = b / 1024, sb = b % 1024, swz = sb ^ (((sb >> 9) & 1) << 5); R = (st >> 1) * 16 + swz / 64; C = (st & 1) * 32 + (swz % 64) / 2; }
__host__ __device__ __forceinline__ int perm32(int rho) { const int n = rho >> 4, i = rho & 15; return 8 * (i >> 2) + 4 * n + (i & 3); }
struct Unit { int pm, pn; };
struct Gemm { const bf16_t* A; const bf16_t* Bt; int M, N, K; };

struct StaticOrder {
    int nM, nN, nwg, G, c;
    __host__ __device__ void init(int M, int N, int G_, int c_) { nM = M / BM; nN = N / BM; nwg = nM * nN; G = G_; c = c_; }
    __host__ __device__ bool next(int i, Unit& u) const {
        const long L = (long)i * G + c; if (L >= nwg) return false;
        int wgid = (int)L; { const int q = nwg / NXCD, r = nwg % NXCD, xcd = wgid % NXCD, off = wgid / NXCD; wgid = (xcd < r ? xcd * (q + 1) : r * (q + 1) + (xcd - r) * q) + off; }
        const int nig = WGM * nN, gid = wgid / nig, fm = gid * WGM, gsz = (nM - fm) < WGM ? (nM - fm) : WGM;
        u.pm = fm + ((wgid % nig) % gsz); u.pn = (wgid % nig) / gsz; return true;
    }
    __device__ __forceinline__ void a_ready(const Unit&) const {}
    __device__ __forceinline__ void done(const Unit&) const {}
};
struct OneUnit {
    StaticOrder S; int i;
    __device__ __forceinline__ bool next(int k, Unit& u) const { return k == 0 && S.next(i, u); }
    __device__ __forceinline__ void a_ready(const Unit&) const {}
    __device__ __forceinline__ void done(const Unit&) const {}
};


struct EpiInProj {
    static constexpr int KIND = 1; static constexpr bool PERM = false, AFTER_DRAIN = false, F16 = true;
    bf16_t* qkv; unsigned char* sg; const float* cosT; const float* sinT; const float* qkg; const float* ikg; const float* rstd;
    __device__ __forceinline__ void operator()(const f32x4 (&acc)[2][2][4][2], const Unit& u, int wr, int wc, int fr, int fq) const {
        const int pn = u.pn, row0 = u.pm * BM + wr * 64 + fr;
        float rsv[2][4];
#pragma unroll
        for (int ai = 0; ai < 2; ++ai)
#pragma unroll
            for (int m = 0; m < 4; ++m) rsv[ai][m] = rstd[row0 + ai * HALF + m * 16];
        if (pn >= 15) {
            unsigned char* base = sg + (size_t)row0 * 3072 + (pn - 15) * 256 + wc * 64 + fq * 16;
#pragma unroll
            for (int ai = 0; ai < 2; ++ai)
#pragma unroll
                for (int m = 0; m < 4; ++m) {
                    unsigned w[2][2]; const float rs = -1.4426950408889634f * rsv[ai][m];
#pragma unroll
                    for (int bj = 0; bj < 2; ++bj)
#pragma unroll
                        for (int n = 0; n < 2; ++n) { unsigned pk = 0;
#pragma unroll
                            for (int i = 0; i < 4; i += 2) { const float x0 = fminf(fmaxf(acc[ai][bj][m][n][i] * rs, -43.f), 43.f), x1 = fminf(fmaxf(acc[ai][bj][m][n][i + 1] * rs, -43.f), 43.f);
                                const float a = 1.0f + fast_exp2(x0), b = 1.0f + fast_exp2(x1), r = 255.0f * fast_rcp(a * b);
                                pk = __builtin_amdgcn_cvt_pk_u8_f32(floorf(b * r + 0.5f), i, pk); pk = __builtin_amdgcn_cvt_pk_u8_f32(floorf(a * r + 0.5f), i + 1, pk); }
                            w[bj][n] = pk; }
                    *(u32x4*)(base + (size_t)(ai * HALF + m * 16) * 3072) = (u32x4){w[0][0], w[0][1], w[1][0], w[1][1]};
                }
            return;
        }
        int type = 0, gi = 0; bool qscale = false;
        int ocol = (pn < 8 ? 256 * pn : C_Q1 + 256 * (pn - 9)) + 64 * wc;
        switch (pn) {
            case 0: type = 2; gi = 0; qscale = true; break;
            case 1: type = 2; gi = 1; break;
            case 3: type = 2; gi = 2; qscale = true; break;
            case 4: type = 2; gi = 3; break;
            case 6: case 7: type = 1; break;
            case 8: if (wc == 0) { type = 2; ocol = C_KI; } else if (wc == 1) { type = 3; ocol = C_WI; } else type = 4; break;
            case 9: case 10: type = 2; gi = 4; qscale = true; break;
            case 11: case 12: type = 2; gi = 5; break;
            default: type = 0; break;
        }
        if (type == 4) return;
        if (type == 3) {
            if (fq == 0) {
#pragma unroll
                for (int ai = 0; ai < 2; ++ai)
#pragma unroll
                    for (int m = 0; m < 4; ++m) { const float rs = 0.35355339059327373f * rsv[ai][m]; const f32x4 a = acc[ai][0][m][0] * rs, b = acc[ai][0][m][1] * rs;
                        *(u32x4*)(qkv + (size_t)(row0 + ai * HALF + m * 16) * QP + C_WI) = (u32x4){cvt_pk_bf16(a[0], a[1]), cvt_pk_bf16(a[2], a[3]), cvt_pk_bf16(b[0], b[1]), cvt_pk_bf16(b[2], b[3])}; }
            }
            return;
        }
        const float* gp = (pn == 8) ? ikg : qkg + 64 * gi;
        if (type == 2) { if (qscale) body<2, true>(acc, row0, ocol, gp, fq, rsv); else body<2, false>(acc, row0, ocol, gp, fq, rsv); }
        else if (type == 1) body<1, false>(acc, row0, ocol, gp, fq, rsv);
        else body<0, false>(acc, row0, ocol, gp, fq, rsv);
    }
    template <int TYPE, bool QS>
    __device__ __forceinline__ void body(const f32x4 (&acc)[2][2][4][2], int row0, int ocol, const float* gp, int fq, const float (&rsv)[2][4]) const {
#pragma unroll
        for (int ai = 0; ai < 2; ++ai)
#pragma unroll
            for (int m = 0; m < 4; ++m) {
                const int row = row0 + ai * HALF + m * 16; const float rs = rsv[ai][m];
                f32x4 x[2][2];
#pragma unroll
                for (int bj = 0; bj < 2; ++bj)
#pragma unroll
                    for (int n = 0; n < 2; ++n) x[bj][n] = acc[ai][bj][m][n] * rs;
                if (TYPE == 2) {
                    float ss = 0.f;
#pragma unroll
                    for (int bj = 0; bj < 2; ++bj)
#pragma unroll
                        for (int n = 0; n < 2; ++n) ss += (x[bj][n][0] * x[bj][n][0] + x[bj][n][1] * x[bj][n][1]) + (x[bj][n][2] * x[bj][n][2] + x[bj][n][3] * x[bj][n][3]);
                    ss += xor_lane<16>(ss); ss = sum_xor32(ss);
                    const float inv = (QS ? C2 : 1.0f) / sqrtf(ss * (1.0f / 64.0f) + EPS);
#pragma unroll
                    for (int bj = 0; bj < 2; ++bj)
#pragma unroll
                        for (int n = 0; n < 2; ++n) x[bj][n] = x[bj][n] * inv * *(const f32x4*)(gp + 32 * bj + 8 * fq + 4 * n);
                }
                if (TYPE >= 1) {
                    const int pos = row & (SEQ - 1);
#pragma unroll
                    for (int n = 0; n < 2; ++n) {
                        const f32x4 c = *(const f32x4*)(cosT + pos * 32 + 8 * fq + 4 * n), s = *(const f32x4*)(sinT + pos * 32 + 8 * fq + 4 * n);
                        const f32x4 a = x[0][n], b = x[1][n];
                        x[0][n] = a * c - b * s; x[1][n] = b * c + a * s;
                    }
                }
#pragma unroll
                for (int bj = 0; bj < 2; ++bj)
                    *(u32x4*)(qkv + (size_t)row * QP + ocol + 32 * bj + 8 * fq) = (u32x4){cvt_pk_bf16(x[bj][0][0], x[bj][0][1]), cvt_pk_bf16(x[bj][0][2], x[bj][0][3]), cvt_pk_bf16(x[bj][1][0], x[bj][1][1]), cvt_pk_bf16(x[bj][1][2], x[bj][1][3])};
                asm volatile("" ::: "memory");
            }
    }
};

template <int BR> struct EpiMerge {
    static constexpr int KIND = 2; static constexpr bool PERM = false, AFTER_DRAIN = false, F16 = false;
    bf16_t* merged; const unsigned char* sg;
    __device__ __forceinline__ void operator()(const f32x4 (&acc)[2][2][4][2], const Unit& u, int wr, int wc, int fr, int fq) const {
        const int row0 = u.pm * BM + wr * 64 + fr, col0 = u.pn * BM + wc * 64 + fq * 16;
#pragma unroll
        for (int ai = 0; ai < 2; ++ai) {
            u32x4 gq[4], om[4][2];
#pragma unroll
            for (int m = 0; m < 4; ++m) { const size_t row = (size_t)(row0 + ai * HALF + m * 16);
                gq[m] = *(const u32x4*)(sg + row * 3072 + BR * 1024 + col0);
                if (BR > 0) { om[m][0] = *(const u32x4*)(merged + row * 1024 + col0); om[m][1] = *(const u32x4*)(merged + row * 1024 + col0 + 8); } }
#pragma unroll
            for (int m = 0; m < 4; ++m) { const size_t row = (size_t)(row0 + ai * HALF + m * 16);
                bf16_t* mp = merged + row * 1024 + col0;
                float v[16];
#pragma unroll
                for (int bj = 0; bj < 2; ++bj)
#pragma unroll
                    for (int n = 0; n < 2; ++n)
#pragma unroll
                        for (int i = 0; i < 4; ++i) v[8 * bj + 4 * n + i] = acc[ai][bj][m][n][i] * ((float)((gq[m][2 * bj + n] >> (8 * i)) & 255u) * (1.0f / 255.0f));
                if (BR > 0) {
#pragma unroll
                    for (int k = 0; k < 4; ++k) { v[2 * k] += bf_lo(om[m][0][k]); v[2 * k + 1] += bf_hi(om[m][0][k]); v[8 + 2 * k] += bf_lo(om[m][1][k]); v[8 + 2 * k + 1] += bf_hi(om[m][1][k]); } }
                *(u32x4*)mp = (u32x4){cvt_pk_bf16(v[0], v[1]), cvt_pk_bf16(v[2], v[3]), cvt_pk_bf16(v[4], v[5]), cvt_pk_bf16(v[6], v[7])};
                *(u32x4*)(mp + 8) = (u32x4){cvt_pk_bf16(v[8], v[9]), cvt_pk_bf16(v[10], v[11]), cvt_pk_bf16(v[12], v[13]), cvt_pk_bf16(v[14], v[15])}; }
            asm volatile("" ::: "memory"); }
    }
};

struct EpiResid {
    static constexpr int KIND = 4; static constexpr bool PERM = false, AFTER_DRAIN = false, F16 = false;
    unsigned char* x16;
    __device__ __forceinline__ void operator()(const f32x4 (&acc)[2][2][4][2], const Unit& u, int wr, int wc, int fr, int fq) const {
        const int row0 = u.pm * BM + wr * 64 + fr, col0 = u.pn * BM + wc * 32 + fq * 8;
        u32x4 r[2][4][2];
#pragma unroll
        for (int ai = 0; ai < 2; ++ai)
#pragma unroll
            for (int m = 0; m < 4; ++m)
#pragma unroll
                for (int bj = 0; bj < 2; ++bj) r[ai][m][bj] = *(const u32x4*)(x16 + ((size_t)(row0 + ai * HALF + m * 16) * 1024 + col0) * 2 + bj * HALF * 2);
#pragma unroll
        for (int ai = 0; ai < 2; ++ai)
#pragma unroll
            for (int m = 0; m < 4; ++m) { unsigned char* xp = x16 + ((size_t)(row0 + ai * HALF + m * 16) * 1024 + col0) * 2;
#pragma unroll
                for (int bj = 0; bj < 2; ++bj) { const u32x4 q = r[ai][m][bj]; const f32x4 a = acc[ai][bj][m][0], b = acc[ai][bj][m][1];
                    *(u32x4*)(xp + bj * HALF * 2) = (u32x4){cvt_pk_f16(h_lo(q[0]) + a[0], h_hi(q[0]) + a[1]), cvt_pk_f16(h_lo(q[1]) + a[2], h_hi(q[1]) + a[3]), cvt_pk_f16(h_lo(q[2]) + b[0], h_hi(q[2]) + b[1]), cvt_pk_f16(h_lo(q[3]) + b[2], h_hi(q[3]) + b[3])}; } }
    }
};

struct EpiGateUp {
    static constexpr int KIND = 8; static constexpr bool PERM = false, AFTER_DRAIN = false, F16 = true;
    bf16_t* hid; const PG8_LAS float* rst; int rbs;
    __device__ __forceinline__ void operator()(const f32x4 (&acc)[2][2][4][2], const Unit& u, int wr, int wc, int fr, int fq) const {
        const int row0 = u.pm * BM + wr * 64 + fr, col0 = (u.pn & 3) * HALF + wc * 32 + fq * 8;
        const PG8_LAS float* rs = rst + (u.pm / rbs) * 256 + wr * 64 + fr;
#pragma unroll
        for (int ai = 0; ai < 2; ++ai)
#pragma unroll
            for (int m = 0; m < 4; ++m) { float v[8]; const float r = rs[ai * HALF + m * 16];
#pragma unroll
                for (int n = 0; n < 2; ++n)
#pragma unroll
                    for (int i = 0; i < 4; ++i) { const float gt = acc[ai][0][m][n][i] * r, up = acc[ai][1][m][n][i] * r; v[4 * n + i] = gt * fast_rcp(1.0f + fast_exp2(-1.4426950408889634f * gt)) * up; }
                *(u32x4*)(hid + (size_t)(row0 + ai * HALF + m * 16) * DEXP + col0) = (u32x4){cvt_pk_bf16(v[0], v[1]), cvt_pk_bf16(v[2], v[3]), cvt_pk_bf16(v[4], v[5]), cvt_pk_bf16(v[6], v[7])}; }
    }
};

struct EpiDown {
    static constexpr int KIND = 16; static constexpr bool PERM = false, AFTER_DRAIN = false, F16 = false;
    bf16_t* y;
    __device__ __forceinline__ void operator()(const f32x4 (&acc)[2][2][4][2], const Unit& u, int wr, int wc, int fr, int fq) const {
        const int row0 = u.pm * BM + wr * 64 + fr, col0 = (u.pn & 3) * BM + wc * 64 + fq * 16;
#pragma unroll
        for (int ai = 0; ai < 2; ++ai)
#pragma unroll
            for (int m = 0; m < 4; ++m) { bf16_t* yp = y + (size_t)(row0 + ai * HALF + m * 16) * 1024 + col0;
#pragma unroll
                for (int bj = 0; bj < 2; ++bj) { const f32x4 a = acc[ai][bj][m][0], b = acc[ai][bj][m][1];
                    *(u32x4*)(yp + 8 * bj) = (u32x4){cvt_pk_bf16(a[0], a[1]), cvt_pk_bf16(a[2], a[3]), cvt_pk_bf16(b[0], b[1]), cvt_pk_bf16(b[2], b[3])}; } }
    }
};

struct AMapMoe { static constexpr bool GATHER = true; const PG8_LAS int* tok; int rbs;
    __device__ __forceinline__ unsigned row(const Unit& u, int R) const { return (unsigned)tok[(u.pm / rbs) * 256 + R]; } };
struct MoeOrder {
    int nunits, G, c; const PG8_LAS int* blk2e;
    __device__ __forceinline__ bool next(int i, Unit& u) const { const int L = i * G + c; if (L >= nunits) return false; const int rb = L >> 2; u.pm = rb; u.pn = blk2e[rb] * 4 + (L & 3); return true; }
    __device__ __forceinline__ void a_ready(const Unit&) const {}
    __device__ __forceinline__ void done(const Unit&) const {}
};

typedef _Float16 f16x8 __attribute__((ext_vector_type(8)));
template <bool F16> __device__ __forceinline__ f32x4 mma16x(bf16x8 a, bf16x8 b, f32x4 c) {
    if constexpr (F16) return __builtin_amdgcn_mfma_f32_16x16x32_f16(__builtin_bit_cast(f16x8, a), __builtin_bit_cast(f16x8, b), c, 0, 0, 0);
    else return __builtin_amdgcn_mfma_f32_16x16x32_bf16(a, b, c, 0, 0, 0); }
struct NoAMap { static constexpr bool GATHER = false; __device__ __forceinline__ unsigned row(const Unit&, int) const { return 0u; } };
template <class Epi, class Sched, bool ALIGN_EPI = false, bool SP2 = false, class AMap = NoAMap>
__device__ __forceinline__ void gemm_phase(PG8_LAS unsigned char* lds, const Gemm g, const Sched& S, const Epi& E, const AMap& AM = AMap()) {
    static_assert(!AMap::GATHER || SP2, "the row gather is wired into the SP2 loop only");
#define mma16 mma16x<Epi::F16>
    int tid_l = (int)threadIdx.x; asm volatile("" : "+v"(tid_l));
    const int tid = tid_l, wid = __builtin_amdgcn_readfirstlane(tid >> 6), lane = tid & 63, wr = wid >> 2, wc = wid & 3, fr = lane & 15, fq = lane >> 4;
    const int K = g.K, nt = K / BK;
    unsigned voffA[2], voffB[2];
#pragma unroll
    for (int i = 0; i < 2; ++i) { int R, C; stage_rc(tid * 16 + i * 8192, R, C); const int Rb = Epi::PERM ? ((R & ~31) + perm32(R & 31)) : R;
        voffA[i] = (unsigned)(R * K + C) * 2u; voffB[i] = (unsigned)(Rb * K + C) * 2u; }
    int RA[2], CA[2];
#pragma unroll
    for (int i = 0; i < 2; ++i) stage_rc(tid * 16 + i * 8192, RA[i], CA[i]);
    unsigned vC0[2] = {0u, 0u}, vC1[2] = {0u, 0u}, vN0[2] = {0u, 0u}, vN1[2] = {0u, 0u};
#define PG8_AOFFS(v0, v1, unit) do { if constexpr (AMap::GATHER) { _Pragma("unroll") for (int _i = 0; _i < 2; ++_i) { \
        v0[_i] = (AM.row(unit, RA[_i]) * (unsigned)K + (unsigned)CA[_i]) * 2u; v1[_i] = (AM.row(unit, HALF + RA[_i]) * (unsigned)K + (unsigned)CA[_i]) * 2u; } } } while (0)
#define PG8_STAGE_A(bufoff, base, half, usenext) do { if constexpr (AMap::GATHER) { unsigned vv_[2]; _Pragma("unroll") for (int _j = 0; _j < 2; ++_j) vv_[_j] = (usenext) ? ((half) ? vN1[_j] : vN0[_j]) : ((half) ? vC1[_j] : vC0[_j]); \
        PG8_STAGE(bufoff, base, vv_); } else { PG8_STAGE(bufoff, (base) + (half) * hstep, voffA); } } while (0)
    const size_t kstep = (size_t)(BK * 2);
    const size_t hstep = (size_t)HALF * K * 2;
    const size_t tstep = 2 * hstep;
    const unsigned ldsw = (unsigned)wid * 1024u;
    const int aoff = lds_byte(wr * 64 + fr, fq * 8), boff = lds_byte(wc * 32 + fr, fq * 8);
#define PG8_SA(b, h) (((b) * 2 + (h)) * HTB)
#define PG8_SB(b, h) ((4 + (b) * 2 + (h)) * HTB)
#define PG8_STAGE(bufoff, gbase, voff) do { _Pragma("unroll") for (int _i = 0; _i < 2; ++_i) \
        __builtin_amdgcn_global_load_lds((const unsigned*)((const char*)(gbase) + (voff)[_i]), (PG8_LAS unsigned*)(lds + (bufoff) + ldsw + _i * 8192), 16, 0, 0); } while (0)
#define PG8_LDA(dst, b, h) do { _Pragma("unroll") for (int m = 0; m < 4; ++m) _Pragma("unroll") for (int k = 0; k < 2; ++k) dst[m][k] = *(const PG8_LAS bf16x8*)(lds + PG8_SA(b, h) + aoff + m * 2048 + k * 1024); } while (0)
#define PG8_LDB(dst, b, h) do { _Pragma("unroll") for (int n = 0; n < 2; ++n) _Pragma("unroll") for (int k = 0; k < 2; ++k) dst[n][k] = *(const PG8_LAS bf16x8*)(lds + PG8_SB(b, h) + boff + n * 2048 + k * 1024); } while (0)
#define PG8_MMA(ai, bj, At, Bt) do { __builtin_amdgcn_s_setprio(1); _Pragma("unroll") for (int m = 0; m < 4; ++m) _Pragma("unroll") for (int n = 0; n < 2; ++n) _Pragma("unroll") for (int k = 0; k < 2; ++k) \
        acc[ai][bj][m][n] = mma16(Bt[n][k], At[m][k], acc[ai][bj][m][n]); __builtin_amdgcn_s_setprio(0); } while (0)
#define PG8_WAIT_V(n) asm volatile("s_waitcnt vmcnt(" #n ")" ::: "memory")
#define PG8_WAIT_L(n) asm volatile("s_waitcnt lgkmcnt(" #n ")" ::: "memory")
#define PG8_BAR __builtin_amdgcn_s_barrier()
#define PG8_SCHED __builtin_amdgcn_sched_barrier(0)
    Unit cur, nxt; int ui = 0;
    if (!S.next(0, cur)) return;
    f32x4 acc[2][2][4][2];
#pragma unroll
    for (int a = 0; a < 2; ++a)
#pragma unroll
        for (int b = 0; b < 2; ++b)
#pragma unroll
            for (int m = 0; m < 4; ++m)
#pragma unroll
                for (int n = 0; n < 2; ++n) acc[a][b][m][n] = (f32x4){0.f, 0.f, 0.f, 0.f};
    bf16x8 At[4][2], B0[2][2], B1[2][2];
    const char* cA = (const char*)g.A + (AMap::GATHER ? (size_t)0 : (size_t)cur.pm * tstep); const char* cB = (const char*)g.Bt + (size_t)cur.pn * tstep;
    PG8_AOFFS(vC0, vC1, cur);
    S.a_ready(cur);
    if constexpr (SP2) {
        PG8_STAGE(PG8_SB(0, 0), cB, voffB); PG8_STAGE(PG8_SB(0, 1), cB + hstep, voffB); PG8_STAGE_A(PG8_SA(0, 0), cA, 0, false); PG8_STAGE_A(PG8_SA(0, 1), cA, 1, false);
        if (wr == 1) PG8_BAR;
        PG8_WAIT_V(2); PG8_BAR;
        PG8_STAGE(PG8_SB(1, 0), cB + kstep, voffB); PG8_STAGE_A(PG8_SA(1, 0), cA + kstep, 0, false); PG8_STAGE(PG8_SB(1, 1), cB + hstep + kstep, voffB);
        PG8_WAIT_V(6); PG8_BAR;
    } else {
        PG8_STAGE(PG8_SB(0, 0), cB, voffB); PG8_STAGE(PG8_SA(0, 0), cA, voffA); PG8_STAGE(PG8_SB(0, 1), cB + hstep, voffB); PG8_STAGE(PG8_SA(0, 1), cA + hstep, voffA);
        if (wr == 1) PG8_BAR;
        PG8_WAIT_V(4); PG8_BAR;
        PG8_STAGE(PG8_SB(1, 0), cB + kstep, voffB); PG8_STAGE(PG8_SA(1, 0), cA + kstep, voffA); PG8_STAGE(PG8_SB(1, 1), cB + hstep + kstep, voffB);
        PG8_WAIT_V(6); PG8_BAR;
    }
    for (;;) {
        const bool has_next = S.next(ui + 1, nxt);
        const char* nA = (has_next && !AMap::GATHER) ? (const char*)g.A + (size_t)nxt.pm * tstep : cA; const char* nB = has_next ? (const char*)g.Bt + (size_t)nxt.pn * tstep : cB;
        if constexpr (AMap::GATHER) { if (has_next) PG8_AOFFS(vN0, vN1, nxt); else { vN0[0] = vC0[0]; vN0[1] = vC0[1]; vN1[0] = vC1[0]; vN1[1] = vC1[1]; } }
        long long kl0_ = 0; if constexpr (((PROBE_KL) & Epi::KIND) != 0) { if (tid == 0) kl0_ = (long long)wall_clock64(); }
#pragma unroll 1
        for (int t = 0; t < nt; t += 2) {
            const bool last = (t == nt - 2);
            const char* a1 = cA + (size_t)(t + 1) * kstep;
            const char* a2 = last ? nA : cA + (size_t)(t + 2) * kstep; const char* b2 = last ? nB : cB + (size_t)(t + 2) * kstep;
            const char* a3 = a2 + kstep; const char* b3 = b2 + kstep;
            if (last && has_next) S.a_ready(nxt);
            if constexpr (SP2) {
            PG8_LDB(B0, 0, 0); PG8_LDB(B1, 0, 1); PG8_SCHED; PG8_LDA(At, 0, 0); PG8_STAGE_A(PG8_SA(1, 1), a1, 1, false);
            PG8_WAIT_V(8); PG8_WAIT_L(0); PG8_BAR; PG8_MMA(0, 0, At, B0); PG8_MMA(0, 1, At, B1); PG8_BAR; PG8_SCHED;
            PG8_LDA(At, 0, 1); PG8_STAGE(PG8_SB(0, 0), b2, voffB); PG8_STAGE(PG8_SB(0, 1), b2 + hstep, voffB); PG8_STAGE_A(PG8_SA(0, 0), a2, 0, last);
            PG8_WAIT_V(8); PG8_WAIT_L(0); PG8_BAR; PG8_MMA(1, 0, At, B0); PG8_MMA(1, 1, At, B1); PG8_BAR; PG8_SCHED;
            PG8_LDB(B0, 1, 0); PG8_LDB(B1, 1, 1); PG8_SCHED; PG8_LDA(At, 1, 0); PG8_STAGE_A(PG8_SA(0, 1), a2, 1, last);
            PG8_WAIT_V(8); PG8_WAIT_L(0); PG8_BAR; PG8_MMA(0, 0, At, B0); PG8_MMA(0, 1, At, B1); PG8_BAR; PG8_SCHED;
            PG8_LDA(At, 1, 1); PG8_STAGE(PG8_SB(1, 0), b3, voffB); PG8_STAGE(PG8_SB(1, 1), b3 + hstep, voffB); PG8_STAGE_A(PG8_SA(1, 0), a3, 0, last);
            PG8_WAIT_V(8); PG8_WAIT_L(0); PG8_BAR; PG8_MMA(1, 0, At, B0); PG8_MMA(1, 1, At, B1); PG8_BAR; PG8_SCHED;
            } else {
            PG8_LDB(B0, 0, 0); PG8_SCHED; PG8_LDA(At, 0, 0); PG8_STAGE(PG8_SA(1, 1), a1 + hstep, voffA);
            PG8_WAIT_L(8); PG8_BAR; PG8_WAIT_L(0); PG8_MMA(0, 0, At, B0); PG8_BAR; PG8_SCHED;
            PG8_LDB(B1, 0, 1); PG8_STAGE(PG8_SB(0, 0), b2, voffB);
            PG8_BAR; PG8_WAIT_L(0); PG8_MMA(0, 1, At, B1); PG8_BAR;
            PG8_LDA(At, 0, 1); PG8_STAGE(PG8_SA(0, 0), a2, voffA);
            PG8_BAR; PG8_WAIT_L(0); PG8_MMA(1, 0, At, B0); PG8_BAR; PG8_SCHED;
            PG8_STAGE(PG8_SB(0, 1), b2 + hstep, voffB);
            PG8_WAIT_V(6); PG8_BAR; PG8_MMA(1, 1, At, B1); PG8_BAR;
            PG8_LDB(B0, 1, 0); PG8_SCHED; PG8_LDA(At, 1, 0); PG8_STAGE(PG8_SA(0, 1), a2 + hstep, voffA);
            PG8_WAIT_L(8); PG8_BAR; PG8_WAIT_L(0); PG8_MMA(0, 0, At, B0); PG8_BAR; PG8_SCHED;
            PG8_LDB(B1, 1, 1); PG8_STAGE(PG8_SB(1, 0), b3, voffB);
            PG8_BAR; PG8_WAIT_L(0); PG8_MMA(0, 1, At, B1); PG8_BAR;
            PG8_LDA(At, 1, 1); PG8_STAGE(PG8_SA(1, 0), a3, voffA);
            PG8_BAR; PG8_WAIT_L(0); PG8_MMA(1, 0, At, B0); PG8_BAR; PG8_SCHED;
            PG8_STAGE(PG8_SB(1, 1), b3 + hstep, voffB);
            PG8_WAIT_V(6); PG8_BAR; PG8_MMA(1, 1, At, B1); PG8_BAR;
            }
        }
        if constexpr (((PROBE_KL) & Epi::KIND) != 0) { if (tid == 0) *(PG8_LAS long long*)(lds + 131072 + 14336) += (long long)wall_clock64() - kl0_; }
        if constexpr (ALIGN_EPI) { if (wr == 0) PG8_BAR; }
        if constexpr (!Epi::AFTER_DRAIN) { E(acc, cur, wr, wc, fr, fq); S.done(cur); }
        if (!has_next) break;
#pragma unroll
        for (int a = 0; a < 2; ++a)
#pragma unroll
            for (int b = 0; b < 2; ++b)
#pragma unroll
                for (int m = 0; m < 4; ++m)
#pragma unroll
                    for (int n = 0; n < 2; ++n) acc[a][b][m][n] = (f32x4){0.f, 0.f, 0.f, 0.f};
        cur = nxt; cA = nA; cB = nB; ++ui;
        if constexpr (AMap::GATHER) { vC0[0] = vN0[0]; vC0[1] = vN0[1]; vC1[0] = vN1[0]; vC1[1] = vN1[1]; }
        if constexpr (ALIGN_EPI) { if (wr == 1) PG8_BAR; }
    }
    PG8_WAIT_V(0);
    if constexpr (!ALIGN_EPI) { if (wr == 0) PG8_BAR; }
    PG8_BAR;
    if constexpr (Epi::AFTER_DRAIN) { E.fused(acc, cur, wr, wc, fr, fq, lds, wid, lane); S.done(cur); }
#undef mma16
#undef PG8_SA
#undef PG8_AOFFS
#undef PG8_STAGE_A
#undef PG8_SB
#undef PG8_STAGE
#undef PG8_LDA
#undef PG8_LDB
#undef PG8_MMA
#undef PG8_WAIT_V
#undef PG8_WAIT_L
#undef PG8_BAR
#undef PG8_SCHED
}
}
#define XB_TMO      128
#define XB_XCNT(j)  (256  + 64 * (j))
#define XB_XSUB(j)  (1280 + 64 * (j))
#define XB_XGEN(j)  (2304 + 64 * (j))
#define XB_TOP      3328
#define XB_TOPGEN   3392
#define XCD_BAR_WORDS 3456
#define XB_SPIN_CAP (1u << 21)

__device__ __forceinline__ unsigned xb_ld(unsigned* p)              { return __hip_atomic_load(p, __ATOMIC_RELAXED, __HIP_MEMORY_SCOPE_AGENT); }
__device__ __forceinline__ unsigned xb_add(unsigned* p, unsigned v) { return __hip_atomic_fetch_add(p, v, __ATOMIC_RELAXED, __HIP_MEMORY_SCOPE_AGENT); }
__device__ __forceinline__ unsigned xb_xcc_id() { return (unsigned)__builtin_amdgcn_s_getreg((3 << 11) | 20) & 0xFu; }
#define XB_SPIN(cond, bar) do { unsigned _sp = 0; while (cond) { __builtin_amdgcn_s_sleep(1); \
    if ((++_sp & 255u) == 0u) { if (xb_ld(&(bar)[XB_TMO])) break; if (_sp > XB_SPIN_CAP) { atomicAdd(&(bar)[XB_TMO], 1u); break; } } } } while (0)

struct XcdBarrier {
    unsigned* bar; unsigned x;
    volatile LAS unsigned* st;
};

__device__ __forceinline__ XcdBarrier xcd_barrier_post(unsigned* bar, volatile LAS unsigned* st) {
    XcdBarrier b; b.bar = bar; b.x = xb_xcc_id(); b.st = st;
    if (threadIdx.x == 0) (void)xb_add(&bar[XB_XCNT(b.x)], 1u);
    return b;
}
__device__ __forceinline__ void xcd_barrier_complete(unsigned* bar, unsigned x, unsigned& nloc, unsigned& nx) {
    const unsigned G = gridDim.x * gridDim.y * gridDim.z;
    unsigned sum, cnt, mine, sp = 0u;
    for (;;) {
        sum = 0u; cnt = 0u; mine = 0u;
#pragma unroll
        for (unsigned j = 0; j < 16; ++j) { const unsigned c = xb_ld(&bar[XB_XCNT(j)]); sum += c; cnt += (c > 0u) ? 1u : 0u; mine = (j == x) ? c : mine; }
        if (sum == G) break;
        __builtin_amdgcn_s_sleep(1);
        if ((++sp & 255u) == 0u) { if (xb_ld(&bar[XB_TMO])) break; if (sp > XB_SPIN_CAP) { atomicAdd(&bar[XB_TMO], 1u); break; } }
    }
    nloc = mine > 0u ? mine : 1u; nx = cnt > 0u ? cnt : 1u;
}

__device__ __forceinline__ void xcd_barrier(const XcdBarrier& b) {
    asm volatile("s_waitcnt vmcnt(0)" ::: "memory");
    __syncthreads();
    int tid_l = (int)threadIdx.x; asm volatile("" : "+v"(tid_l));
    if (tid_l == 0) {
        unsigned* bar = b.bar;
        __builtin_amdgcn_s_waitcnt(0);
        unsigned nloc = b.st[0], nx = b.st[1];
        if (nloc == 0u) { xcd_barrier_complete(bar, b.x, nloc, nx); b.st[0] = nloc; b.st[1] = nx; }
        const unsigned old = xb_add(&bar[XB_XSUB(b.x)], 1u);
        const unsigned gen = old / nloc;
        if (old + 1u == (gen + 1u) * nloc) {
            __builtin_amdgcn_fence(__ATOMIC_RELEASE, "agent");
            asm volatile("s_waitcnt vmcnt(0)" ::: "memory");
            const unsigned og = xb_add(&bar[XB_TOP], 1u);
            const unsigned tg = og / nx;
            if (og + 1u == (tg + 1u) * nx) xb_add(&bar[XB_TOPGEN], 1u);
            else XB_SPIN(xb_ld(&bar[XB_TOPGEN]) == tg, bar);
            __builtin_amdgcn_fence(__ATOMIC_ACQUIRE, "agent");
            xb_add(&bar[XB_XGEN(b.x)], 1u);
            asm volatile("s_waitcnt vmcnt(0)" ::: "memory");
        } else {
            XB_SPIN(xb_ld(&bar[XB_XGEN(b.x)]) == gen, bar);
            __builtin_amdgcn_fence(__ATOMIC_ACQUIRE, "agent");
            asm volatile("s_waitcnt vmcnt(0)" ::: "memory");
        }
    }
    __syncthreads();
}

enum { I_X = 0, I_NORM_ATTN, I_W_IN, I_QK_GAIN, I_IDX_K_GAIN, I_DIFF_LAMBDA, I_DIFF_SUBLN, I_W_PROJ_A, I_W_PROJ_B, I_W_PROJ_C, I_W_OUT, I_NORM_FFN, I_W_GROUP, I_B_GROUP, I_W_ROUTER, I_B_ROUTER,
       I_W_E_GATE, I_W_E_UP, I_W_E_DOWN, N_INPUTS };
struct Args { const float* in[N_INPUTS]; float* out; unsigned char* ws; };

#define LDS_WAIT() asm volatile("s_waitcnt lgkmcnt(0)" ::: "memory")

__device__ __forceinline__ int perm16col(int s) { return 64 * ((s >> 5) & 3) + 16 * ((s >> 2) & 3) + 8 * (s >> 7) + 4 * ((s >> 4) & 1) + (s & 3); }
__device__ __forceinline__ int inproj_src_col(int d) {
    const int pn = d >> 8, s = d & 255;
    if (pn >= 15) return C_G + 256 * (pn - 15) + perm16col(s);
    const int u = (s >> 5) & 3, e = 32 * (s >> 7) + pg8::perm32(s & 31);
    if (pn < 8) return 256 * pn + 64 * u + e;
    if (pn == 8) { if (u == 0) return C_KI + e; if (u == 1) return e < 8 ? C_WI + e : -1; return -1; }
    return C_Q1 + 256 * (pn - 9) + 64 * u + e;
}
template <bool F16>
__device__ __forceinline__ void transpose_item(const float* W, int ldw, int K, bf16_t* WT, int drow0, int k0, int srccol, LAS float* scr, int lane, const float* kscale = nullptr) {
    const float* src = W + (size_t)k0 * ldw + (srccol >= 0 ? srccol : 0);
#pragma unroll
    for (int hb = 0; hb < 2; ++hb) {
        float tv[16];
#pragma unroll
        for (int i = 0; i < 16; ++i) tv[i] = src[(size_t)(2 * (16 * hb + i) + (lane >> 5)) * ldw];
#pragma unroll
        for (int i = 0; i < 16; ++i) scr[(2 * (16 * hb + i) + (lane >> 5)) * 33 + (lane & 31)] = srccol >= 0 ? tv[i] : 0.f;
    }
    LDS_WAIT(); asm volatile("" ::: "memory");
    const int c = lane & 7;
    f32x4 g0 = {1.f, 1.f, 1.f, 1.f}, g1 = g0;
    if (F16) { g0 = *(const f32x4*)(kscale + k0 + 8 * c); g1 = *(const f32x4*)(kscale + k0 + 8 * c + 4); }
#pragma unroll
    for (int j = 0; j < 4; ++j) { const int n = (lane >> 3) + 8 * j; const LAS float* s = scr + (8 * c) * 33 + n;
        u32x4 o;
        if (F16) { o.x = cvt_pk_f16(s[0 * 33] * g0[0], s[1 * 33] * g0[1]); o.y = cvt_pk_f16(s[2 * 33] * g0[2], s[3 * 33] * g0[3]); o.z = cvt_pk_f16(s[4 * 33] * g1[0], s[5 * 33] * g1[1]); o.w = cvt_pk_f16(s[6 * 33] * g1[2], s[7 * 33] * g1[3]); }
        else { o.x = cvt_pk_bf16(s[0 * 33], s[1 * 33]); o.y = cvt_pk_bf16(s[2 * 33], s[3 * 33]); o.z = cvt_pk_bf16(s[4 * 33], s[5 * 33]); o.w = cvt_pk_bf16(s[6 * 33], s[7 * 33]); }
        *(u32x4*)(WT + (size_t)(drow0 + n) * K + k0 + 8 * c) = o; }
    LDS_WAIT(); asm volatile("" ::: "memory");
}

template <bool FIRST, bool COMBINE, bool FINAL>
__device__ __forceinline__ void token_row(const float* xin, unsigned char* x16, float* outf, const bf16_t* y, const unsigned* rt0, const unsigned* rt1, const f32x2* rtw, const LAS int* pstart,
                                          float* rstd1, int m, int lane) {
    float v[2][8];
#pragma unroll
    for (int j = 0; j < 2; ++j) {
        if (FIRST) { const f32x4 p = ((const f32x4*)(xin + (size_t)m * DM))[2 * (lane + 64 * j)], q = ((const f32x4*)(xin + (size_t)m * DM))[2 * (lane + 64 * j) + 1];
#pragma unroll
            for (int k = 0; k < 4; ++k) { v[j][k] = p[k]; v[j][4 + k] = q[k]; } }
        else { const u32x4 p = ((const u32x4*)(x16 + (size_t)m * (DM * 2)))[lane + 64 * j];
#pragma unroll
            for (int k = 0; k < 4; ++k) { v[j][2 * k] = h_lo(p[k]); v[j][2 * k + 1] = h_hi(p[k]); } }
    }
    if (COMBINE) {
        const unsigned a = rt0[m], b = rt1[m]; const f32x2 w = rtw[m];
        const size_t s0 = (size_t)(pstart[a >> 24] + (int)(a & 0xffffffu)), s1 = (size_t)(pstart[b >> 24] + (int)(b & 0xffffffu));
#pragma unroll
        for (int j = 0; j < 2; ++j) { const u32x4 p = ((const u32x4*)(y + s0 * DM))[lane + 64 * j], q = ((const u32x4*)(y + s1 * DM))[lane + 64 * j];
#pragma unroll
            for (int k = 0; k < 4; ++k) { v[j][2 * k] += w[0] * bf_lo(p[k]) + w[1] * bf_lo(q[k]); v[j][2 * k + 1] += w[0] * bf_hi(p[k]) + w[1] * bf_hi(q[k]); } }
    }
    if (FINAL) {
#pragma unroll
        for (int j = 0; j < 2; ++j) { ((f32x4*)(outf + (size_t)m * DM))[2 * (lane + 64 * j)] = (f32x4){v[j][0], v[j][1], v[j][2], v[j][3]}; ((f32x4*)(outf + (size_t)m * DM))[2 * (lane + 64 * j) + 1] = (f32x4){v[j][4], v[j][5], v[j][6], v[j][7]}; }
    } else {
        float ss = 0.f;
#pragma unroll
        for (int j = 0; j < 2; ++j) { ss += (v[j][0] * v[j][0] + v[j][1] * v[j][1]) + (v[j][2] * v[j][2] + v[j][3] * v[j][3]) + (v[j][4] * v[j][4] + v[j][5] * v[j][5]) + (v[j][6] * v[j][6] + v[j][7] * v[j][7]);
            ((u32x4*)(x16 + (size_t)m * (DM * 2)))[lane + 64 * j] = (u32x4){cvt_pk_f16(v[j][0], v[j][1]), cvt_pk_f16(v[j][2], v[j][3]), cvt_pk_f16(v[j][4], v[j][5]), cvt_pk_f16(v[j][6], v[j][7])}; }
        const float rstd = 1.0f / sqrtf(wave_sum(ss) * (1.0f / DM) + EPS);
        if (lane == 0) rstd1[m] = rstd;
    }
}

template <bool EXPERTS> __device__ __forceinline__ void convert_weights(const Args& a, unsigned char* ws, int l, LAS unsigned char* lds, int lane, int wave, int vcu, int G, int chunk = -1);
__device__ __forceinline__ void p0_phase(const Args& a, unsigned char* ws, int l, LAS unsigned char* lds, int tid, int lane, int wave, int vcu, int G) {
    convert_weights<false>(a, ws, l, lds, lane, wave, vcu, G);
    const int gw = vcu * 8 + wave, NGW = G * 8, gt = vcu * 512 + tid, NGT = G * 512;
    if (l == 0) {
        float* cosT = (float*)(ws + WS_COS); float* sinT = (float*)(ws + WS_SIN);
        for (int idx = gt; idx < SEQ * 32; idx += NGT) { const int pos = idx >> 5, j = idx & 31;
            const float inv_freq = 1.0f / powf(10000.0f, (float)(2 * j) * (1.0f / 64.0f));
            const float ang = (float)pos * inv_freq;
            const double rev = (double)ang * 0.15915494309189533577; const float fr = (float)(rev - rint(rev));
            cosT[idx] = __builtin_amdgcn_cosf(fr); sinT[idx] = __builtin_amdgcn_sinf(fr); }
    }
    { float* wrt = (float*)(ws + WS_WRT); const float* wg = a.in[I_W_GROUP] + (size_t)l * DM * 4; const float* wr = a.in[I_W_ROUTER] + (size_t)l * DM * 32;
      const float* g2 = a.in[I_NORM_FFN] + (size_t)l * DM;
      for (int idx = gt; idx < 36 * DM; idx += NGT) { const int c = idx >> 10, k = idx & 1023; wrt[idx] = g2[k] * (c < 4 ? wg[k * 4 + c] : wr[k * 32 + (c - 4)]); } }
    unsigned char* x16 = ws + WS_X16; float* rstd1 = (float*)(ws + WS_RSTD1);
    const LAS int* pstart = (const LAS int*)(lds + LX_PSTART);
    if (l == 0) { for (int m = gw; m < MTOK; m += NGW) token_row<true, false, false>(a.in[I_X], x16, nullptr, nullptr, nullptr, nullptr, nullptr, pstart, rstd1, m, lane); }
    else { for (int m = gw; m < MTOK; m += NGW) token_row<false, true, false>(nullptr, x16, nullptr, (const bf16_t*)(ws + WS_Y), (const unsigned*)(ws + WS_RT0), (const unsigned*)(ws + WS_RT1), (const f32x2*)(ws + WS_RTW), pstart, rstd1, m, lane); }
}

template <bool EXPERTS> __device__ __forceinline__ void convert_weights(const Args& a, unsigned char* ws, int l, LAS unsigned char* lds, int lane, int wave, int vcu, int G, int chunk) {
    LAS float* scr = (LAS float*)(lds + wave * 16384);
    int gw = vcu * 8 + wave, NGW = G * 8;
    constexpr int I_IN = 216 * 16, I_PA = 32 * 4, I_PC = 32 * 8, I_WO = 32 * 16, I_GU = 32 * 32 * 16, I_DN = 32 * 32 * 8, NIT = I_IN + 2 * I_PA + I_PC + I_WO + I_GU + I_DN;
    constexpr int I_SMALL = I_IN + 2 * I_PA + I_PC + I_WO;
    int it_end = EXPERTS ? NIT : I_SMALL;
    if (chunk >= 0) { gw = chunk * 128 + wave * 16; NGW = 1; it_end = I_SMALL + gw + 16 < NIT ? I_SMALL + gw + 16 : NIT; }
    for (int it = gw + (EXPERTS ? I_SMALL : 0); it < it_end; it += NGW) {
        int r = it; const int d31 = lane & 31;
        if (r < I_IN) { const int nb = r >> 4, kb = r & 15; transpose_item<true>(a.in[I_W_IN] + (size_t)l * DM * D_IN, D_IN, 1024, (bf16_t*)(ws + WS_WIN), nb * 32, kb * 64, inproj_src_col(nb * 32 + d31), scr, lane, a.in[I_NORM_ATTN] + (size_t)l * DM); continue; } r -= I_IN;
        const int pcol = pg8::perm32(d31);
        if (r < I_PA) { const int nb = r >> 2, kb = r & 3; transpose_item<false>(a.in[I_W_PROJ_A] + (size_t)l * 256 * DM, DM, 256, (bf16_t*)(ws + WS_WPA), nb * 32, kb * 64, ((nb * 32 + d31) & ~255) + perm16col((nb * 32 + d31) & 255), scr, lane); continue; } r -= I_PA;
        if (r < I_PA) { const int nb = r >> 2, kb = r & 3; transpose_item<false>(a.in[I_W_PROJ_B] + (size_t)l * 256 * DM, DM, 256, (bf16_t*)(ws + WS_WPB), nb * 32, kb * 64, ((nb * 32 + d31) & ~255) + perm16col((nb * 32 + d31) & 255), scr, lane); continue; } r -= I_PA;
        if (r < I_PC) { const int nb = r >> 3, kb = r & 7; transpose_item<false>(a.in[I_W_PROJ_C] + (size_t)l * 512 * DM, DM, 512, (bf16_t*)(ws + WS_WPC), nb * 32, kb * 64, ((nb * 32 + d31) & ~255) + perm16col((nb * 32 + d31) & 255), scr, lane); continue; } r -= I_PC;
        if (r < I_WO) { const int nb = r >> 4, kb = r & 15; transpose_item<false>(a.in[I_W_OUT] + (size_t)l * DM * DM, DM, 1024, (bf16_t*)(ws + WS_WO), nb * 32, kb * 64, nb * 32 + pcol, scr, lane); continue; } r -= I_WO;
        if (r < I_GU) { const int e = r >> 9, rr = r & 511, nb = rr >> 4, kb = rr & 15, dd = nb * 32, pn = dd >> 8, s = dd & 255, half = s >> 7;
            const float* src = (half ? a.in[I_W_E_UP] : a.in[I_W_E_GATE]) + (size_t)(l * NEXP + e) * DM * DEXP;
            transpose_item<true>(src, DEXP, 1024, (bf16_t*)(ws + WS_WGU) + (size_t)e * 1024 * 1024, nb * 32, kb * 64, 128 * pn + (s & 127) + pcol, scr, lane, a.in[I_NORM_FFN] + (size_t)l * DM); continue; } r -= I_GU;
        { const int e = r >> 8, rr = r & 255, nb = rr >> 3, kb = rr & 7;
            transpose_item<false>(a.in[I_W_E_DOWN] + (size_t)(l * NEXP + e) * DEXP * DM, DM, 512, (bf16_t*)(ws + WS_WD) + (size_t)e * 1024 * 512, nb * 32, kb * 64, ((nb * 32 + d31) & ~255) + perm16col((nb * 32 + d31) & 255), scr, lane); }
    }
}

__device__ __forceinline__ f32x16 mfma32(bf16x8 a, bf16x8 b, f32x16 c) { return __builtin_amdgcn_mfma_f32_32x32x16_bf16(a, b, c, 0, 0, 0); }
typedef short v4i16_t __attribute__((ext_vector_type(4)));
__device__ __forceinline__ s16x4 vtr(const LAS unsigned char* p) { return __builtin_bit_cast(s16x4, __builtin_amdgcn_ds_read_tr16_b64_v4i16((LAS v4i16_t*)p)); }
__device__ __forceinline__ int crow(int r, int hi) { return (r & 3) + 8 * (r >> 2) + 4 * hi; }
#define NEG_INF (-__builtin_inff())

__device__ __forceinline__ f32x16 splat16(float v) { f32x16 r;
#pragma unroll
    for (int i = 0; i < 16; ++i) r[i] = v;
    return r; }
__device__ __forceinline__ int kimg_off(int key, int ch) { return key * 128 + ((ch ^ ((key >> 1) & 7)) << 4); }
__device__ __forceinline__ int kdma_row(int w, int lane) { return 8 * w + (lane >> 3); }
__device__ __forceinline__ int kdma_chunk(int w, int lane) { return (lane & 7) ^ (((8 * w + (lane >> 3)) >> 1) & 7); }
struct QReg { const bf16x8 (&q)[4]; __device__ __forceinline__ bf16x8 operator()(int ks) const { return q[ks]; } };
struct QLds { const LAS unsigned char* p; __device__ __forceinline__ bf16x8 operator()(int ks) const { return *(const LAS bf16x8*)(p + ks * 1024); } };
template <int NDB, class QF, class MaskF>
__device__ __forceinline__ void flash_tile(float& m_run, float& l_run, f32x16 (&o)[NDB], const LAS unsigned char* kimg, const LAS unsigned char* vimg, const QF& qf, const MaskF& maskf, int r32, int hi, int vboff) {
    if (NDB == 4) __builtin_amdgcn_sched_barrier(0);
    f32x16 p0, p1; maskf.init(p0, p1);
#pragma unroll
    for (int ks = 0; ks < 4; ++ks) {
        const bf16x8 a0 = *(const LAS bf16x8*)(kimg + (NDB == 4 ? (2 * ks + hi) * 1024 + r32 * 16 : kimg_off(r32, 2 * ks + hi)));
        const bf16x8 a1 = *(const LAS bf16x8*)(kimg + (NDB == 4 ? (2 * ks + hi) * 1024 + 512 + r32 * 16 : kimg_off(r32, 2 * ks + hi) + 4096));
        const bf16x8 qk = qf(ks);
        p0 = mfma32(a0, qk, p0); p1 = mfma32(a1, qk, p1);
        if (NDB == 4 && (ks & 1)) __builtin_amdgcn_sched_barrier(0);
    }
    maskf(p0, p1);
    float mx = fmaxf(p0[0], p1[0]);
#pragma unroll
    for (int r = 1; r < 16; ++r) mx = fmaxf(mx, fmaxf(p0[r], p1[r]));
    mx = max_xor32(mx);
    const float mnew = fmaxf(m_run, mx);
    if (__ballot(mnew > m_run) != 0ull) {
        const float alpha = fast_exp2(m_run - mnew);
        l_run *= alpha;
#pragma unroll
        for (int db = 0; db < NDB; ++db) o[db] = o[db] * alpha;
    }
    m_run = mnew;
    float sum = 0.f;
#pragma unroll
    for (int r = 0; r < 16; ++r) { p0[r] = fast_exp2(p0[r] - mnew); p1[r] = fast_exp2(p1[r] - mnew); sum += p0[r] + p1[r]; }
    l_run += sum;
    bf16x8 pa[4];
    pa[0] = __builtin_bit_cast(bf16x8, (u32x4){cvt_pk_bf16(p0[0], p0[1]), cvt_pk_bf16(p0[2], p0[3]), cvt_pk_bf16(p0[4], p0[5]), cvt_pk_bf16(p0[6], p0[7])});
    pa[1] = __builtin_bit_cast(bf16x8, (u32x4){cvt_pk_bf16(p0[8], p0[9]), cvt_pk_bf16(p0[10], p0[11]), cvt_pk_bf16(p0[12], p0[13]), cvt_pk_bf16(p0[14], p0[15])});
    pa[2] = __builtin_bit_cast(bf16x8, (u32x4){cvt_pk_bf16(p1[0], p1[1]), cvt_pk_bf16(p1[2], p1[3]), cvt_pk_bf16(p1[4], p1[5]), cvt_pk_bf16(p1[6], p1[7])});
    pa[3] = __builtin_bit_cast(bf16x8, (u32x4){cvt_pk_bf16(p1[8], p1[9]), cvt_pk_bf16(p1[10], p1[11]), cvt_pk_bf16(p1[12], p1[13]), cvt_pk_bf16(p1[14], p1[15])});
#pragma unroll
    for (int db = 0; db < NDB; ++db)
#pragma unroll
        for (int s = 0; s < 4; ++s) {
            const s16x4 lo = vtr(vimg + vboff + db * 4096 + s * 1024), h4 = vtr(vimg + vboff + db * 4096 + s * 1024 + 512);
            const bf16x8 vt = (bf16x8){lo[0], lo[1], lo[2], lo[3], h4[0], h4[1], h4[2], h4[3]};
            o[db] = mfma32(vt, pa[s], o[db]);
            if (NDB == 4 && (s & 1)) __builtin_amdgcn_sched_barrier(0);
        }    __builtin_amdgcn_sched_barrier(0);
}
template <int NDB, class QF, class MaskF>
__device__ __forceinline__ void flash_tile_ref0(float& l_run, f32x16& lacc, f32x16 (&o)[NDB], const LAS unsigned char* kimg, const LAS unsigned char* vimg, const QF& qf, const MaskF& maskf, int r32, int hi, int vboff) {
    f32x16 p0, p1; maskf.init(p0, p1);
    bf16x8 kf[8];
#pragma unroll
    for (int ks = 0; ks < 4; ++ks) { kf[2 * ks] = *(const LAS bf16x8*)(kimg + kimg_off(r32, 2 * ks + hi)); kf[2 * ks + 1] = *(const LAS bf16x8*)(kimg + kimg_off(r32, 2 * ks + hi) + 4096); }
    __builtin_amdgcn_sched_barrier(0);
    __builtin_amdgcn_s_setprio(1);
#pragma unroll
    for (int ks = 0; ks < 4; ++ks) { const bf16x8 qk = qf(ks); p0 = mfma32(kf[2 * ks], qk, p0); p1 = mfma32(kf[2 * ks + 1], qk, p1); }
    __builtin_amdgcn_s_setprio(0);
    maskf(p0, p1);
    __builtin_amdgcn_sched_barrier(0);
    const bf16x8 ones = (bf16x8){0x3f80, 0x3f80, 0x3f80, 0x3f80, 0x3f80, 0x3f80, 0x3f80, 0x3f80};
#pragma unroll
    for (int r = 0; r < 16; ++r) p0[r] = fast_exp2(p0[r]);
    bf16x8 pa[4];
    pa[0] = __builtin_bit_cast(bf16x8, (u32x4){cvt_pk_bf16(p0[0], p0[1]), cvt_pk_bf16(p0[2], p0[3]), cvt_pk_bf16(p0[4], p0[5]), cvt_pk_bf16(p0[6], p0[7])});
    pa[1] = __builtin_bit_cast(bf16x8, (u32x4){cvt_pk_bf16(p0[8], p0[9]), cvt_pk_bf16(p0[10], p0[11]), cvt_pk_bf16(p0[12], p0[13]), cvt_pk_bf16(p0[14], p0[15])});
    maskf.pack(pa[0]); maskf.pack(pa[1]);
    __builtin_amdgcn_sched_barrier(0);
#pragma unroll
    for (int s = 0; s < 2; ++s) {
        lacc = mfma32(ones, pa[s], lacc);
#pragma unroll
        for (int db = 0; db < NDB; ++db) {
            const s16x4 lo = vtr(vimg + vboff + db * 4096 + s * 1024), h4 = vtr(vimg + vboff + db * 4096 + s * 1024 + 512);
            o[db] = mfma32((bf16x8){lo[0], lo[1], lo[2], lo[3], h4[0], h4[1], h4[2], h4[3]}, pa[s], o[db]);
        }
    }
#pragma unroll
    for (int r = 0; r < 16; ++r) p1[r] = fast_exp2(p1[r]);
    pa[2] = __builtin_bit_cast(bf16x8, (u32x4){cvt_pk_bf16(p1[0], p1[1]), cvt_pk_bf16(p1[2], p1[3]), cvt_pk_bf16(p1[4], p1[5]), cvt_pk_bf16(p1[6], p1[7])});
    pa[3] = __builtin_bit_cast(bf16x8, (u32x4){cvt_pk_bf16(p1[8], p1[9]), cvt_pk_bf16(p1[10], p1[11]), cvt_pk_bf16(p1[12], p1[13]), cvt_pk_bf16(p1[14], p1[15])});
    maskf.pack(pa[2]); maskf.pack(pa[3]);
    __builtin_amdgcn_sched_barrier(0);
#pragma unroll
    for (int s = 2; s < 4; ++s) {
        lacc = mfma32(ones, pa[s], lacc);
#pragma unroll
        for (int db = 0; db < NDB; ++db) {
            const s16x4 lo = vtr(vimg + vboff + db * 4096 + s * 1024), h4 = vtr(vimg + vboff + db * 4096 + s * 1024 + 512);
            o[db] = mfma32((bf16x8){lo[0], lo[1], lo[2], lo[3], h4[0], h4[1], h4[2], h4[3]}, pa[s], o[db]);
        }
    }
    __builtin_amdgcn_sched_barrier(0);
    (void)l_run;
}
template <bool KSWZ, class MaskF>
__device__ __forceinline__ void flash_tile_dual_ref0(float& l1, float& l2, f32x16 (&o1)[4], f32x16 (&o2)[4], const LAS unsigned char* k1img, const LAS unsigned char* k2img, const LAS unsigned char* vimg,
                                                     const LAS unsigned char* q1img, const LAS unsigned char* q2img, const MaskF& maskf, int r32, int hi, int vboff) {
    bf16x8 pa1[4], pa2[4];
#define DUAL_MAP_(kimg, qimg, pa, lsum) do { __builtin_amdgcn_sched_barrier(0); f32x16 p0, p1; maskf.init(p0, p1); \
        _Pragma("unroll") for (int ks = 0; ks < 4; ++ks) { const int ko = KSWZ ? kimg_off(r32, 2 * ks + hi) : (2 * ks + hi) * 1024 + r32 * 16; const bf16x8 qq = *(const LAS bf16x8*)(qimg + ks * 1024); \
            p0 = mfma32(*(const LAS bf16x8*)(kimg + ko), qq, p0); p1 = mfma32(*(const LAS bf16x8*)(kimg + ko + (KSWZ ? 4096 : 512)), qq, p1); if (ks & 1) __builtin_amdgcn_sched_barrier(0); } \
        maskf(p0, p1); float sm = 0.f; \
        _Pragma("unroll") for (int r = 0; r < 16; ++r) { p0[r] = fast_exp2(p0[r]); p1[r] = fast_exp2(p1[r]); sm += p0[r] + p1[r]; } \
        lsum += sm; \
        pa[0] = __builtin_bit_cast(bf16x8, (u32x4){cvt_pk_bf16(p0[0], p0[1]), cvt_pk_bf16(p0[2], p0[3]), cvt_pk_bf16(p0[4], p0[5]), cvt_pk_bf16(p0[6], p0[7])}); \
        pa[1] = __builtin_bit_cast(bf16x8, (u32x4){cvt_pk_bf16(p0[8], p0[9]), cvt_pk_bf16(p0[10], p0[11]), cvt_pk_bf16(p0[12], p0[13]), cvt_pk_bf16(p0[14], p0[15])}); \
        pa[2] = __builtin_bit_cast(bf16x8, (u32x4){cvt_pk_bf16(p1[0], p1[1]), cvt_pk_bf16(p1[2], p1[3]), cvt_pk_bf16(p1[4], p1[5]), cvt_pk_bf16(p1[6], p1[7])}); \
        pa[3] = __builtin_bit_cast(bf16x8, (u32x4){cvt_pk_bf16(p1[8], p1[9]), cvt_pk_bf16(p1[10], p1[11]), cvt_pk_bf16(p1[12], p1[13]), cvt_pk_bf16(p1[14], p1[15])}); } while (0)
    DUAL_MAP_(k1img, q1img, pa1, l1);
    DUAL_MAP_(k2img, q2img, pa2, l2);
#undef DUAL_MAP_
    __builtin_amdgcn_sched_barrier(0);
#pragma unroll
    for (int s = 0; s < 4; ++s) {
#pragma unroll
        for (int db = 0; db < 4; ++db) {
            const s16x4 lo = vtr(vimg + vboff + db * 4096 + s * 1024), h4 = vtr(vimg + vboff + db * 4096 + s * 1024 + 512);
            const bf16x8 vt = (bf16x8){lo[0], lo[1], lo[2], lo[3], h4[0], h4[1], h4[2], h4[3]};
            o1[db] = mfma32(vt, pa1[s], o1[db]); o2[db] = mfma32(vt, pa2[s], o2[db]);
            if (db & 1) __builtin_amdgcn_sched_barrier(0);
        }
    }
}
template <bool FAST, int NDB, class QF, class MaskF>
__device__ __forceinline__ void flash_step(float& m_run, float& l_run, f32x16& lacc, f32x16 (&o)[NDB], const LAS unsigned char* kimg, const LAS unsigned char* vimg, const QF& qf, const MaskF& maskf, int r32, int hi, int vboff) {
    if constexpr (FAST) flash_tile_ref0<NDB>(l_run, lacc, o, kimg, vimg, qf, maskf, r32, hi, vboff); else flash_tile<NDB>(m_run, l_run, o, kimg, vimg, qf, maskf, r32, hi, vboff);
}
__device__ __forceinline__ bool softmax_ref0_ok(const float* gq, const float* gk, int lane) {
    float a = fabsf(gq[lane]), b = fabsf(gk[lane]);
    a = fmaxf(a, xor_lane<1>(a)); a = fmaxf(a, xor_lane<2>(a)); a = fmaxf(a, xor_lane<4>(a)); a = fmaxf(a, xor_lane<8>(a)); a = fmaxf(a, xor_lane<16>(a)); a = max_xor32(a);
    b = fmaxf(b, xor_lane<1>(b)); b = fmaxf(b, xor_lane<2>(b)); b = fmaxf(b, xor_lane<4>(b)); b = fmaxf(b, xor_lane<8>(b)); b = fmaxf(b, xor_lane<16>(b)); b = max_xor32(b);
    return __builtin_amdgcn_readfirstlane(__builtin_bit_cast(int, a * b * (C2 * 64.0f * 1.02f))) < __builtin_bit_cast(int, 48.0f) && REF0_ENABLE;
}
#define MASK_INIT_ZERO __device__ __forceinline__ void init(f32x16& p0, f32x16& p1) const { p0 = splat16(0.f); p1 = splat16(0.f); }
#define MASK_PACK_NONE __device__ __forceinline__ void pack(bf16x8&) const {}
struct MaskNone { MASK_INIT_ZERO MASK_PACK_NONE __device__ __forceinline__ void operator()(f32x16&, f32x16&) const {} };
struct MaskCausal { int kb0, qloc, hi;
    MASK_INIT_ZERO MASK_PACK_NONE
    __device__ __forceinline__ void operator()(f32x16& p0, f32x16& p1) const {
#pragma unroll
        for (int r = 0; r < 16; ++r) { const int kv = kb0 + crow(r, hi); p0[r] = kv > qloc ? NEG_INF : p0[r]; p1[r] = kv + 32 > qloc ? NEG_INF : p1[r]; } } };
struct MaskCausalIf { bool on; int kb0, qloc, hi;
    MASK_INIT_ZERO MASK_PACK_NONE
    __device__ __forceinline__ void operator()(f32x16& p0, f32x16& p1) const { if (on) {
#pragma unroll
        for (int r = 0; r < 16; ++r) { const int kv = kb0 + crow(r, hi); p0[r] = kv > qloc ? NEG_INF : p0[r]; p1[r] = kv + 32 > qloc ? NEG_INF : p1[r]; } } } };
struct MaskLaneP { unsigned keep;
    MASK_INIT_ZERO
    __device__ __forceinline__ void operator()(f32x16&, f32x16&) const {}
    __device__ __forceinline__ void pack(bf16x8& pa) const { u32x4 v = __builtin_bit_cast(u32x4, pa); v = v & keep; pa = __builtin_bit_cast(bf16x8, v); } };
struct MaskLane { float ci;
    MASK_INIT_ZERO MASK_PACK_NONE
    __device__ __forceinline__ void operator()(f32x16& p0, f32x16& p1) const {
#pragma unroll
        for (int r = 0; r < 16; ++r) { p0[r] += ci; p1[r] += ci; } } };
template <int POS> __device__ __forceinline__ float neginf_if_bit(unsigned n) { float r; asm("v_bfe_i32 %0, %1, %2, 1\n\tv_and_b32 %0, 0xff800000, %0" : "=v"(r) : "v"(n), "n"(POS)); return r; }
struct MaskBits { unsigned n0, n1;
    __device__ __forceinline__ void init(f32x16& p0, f32x16& p1) const {
#define MB_(r) p0[r] = neginf_if_bit<((r) & 3) + 8 * ((r) >> 2)>(n0); p1[r] = neginf_if_bit<((r) & 3) + 8 * ((r) >> 2)>(n1);
        MB_(0) MB_(1) MB_(2) MB_(3) MB_(4) MB_(5) MB_(6) MB_(7) MB_(8) MB_(9) MB_(10) MB_(11) MB_(12) MB_(13) MB_(14) MB_(15)
#undef MB_
        asm volatile("s_nop 1" ::: "memory"); }
    MASK_PACK_NONE
    __device__ __forceinline__ void operator()(f32x16&, f32x16&) const {} };
__device__ __forceinline__ void dma16(const void* g, LAS unsigned char* l) { __builtin_amdgcn_global_load_lds((const unsigned*)g, (LAS unsigned*)l, 16, 0, 0); }
#define DMA_WAIT_SYNC() do { asm volatile("s_waitcnt vmcnt(0)" ::: "memory"); __syncthreads(); } while (0)

__device__ __forceinline__ void glds16(const void* gsrc, unsigned lds_dst) { unsigned keep;
    asm volatile("s_mov_b32 %0, m0\n\ts_mov_b32 m0, %2\n\ts_nop 0\n\tglobal_load_lds_dwordx4 %1, off\n\ts_mov_b32 m0, %0" : "=&s"(keep) : "v"(gsrc), "s"(lds_dst) : "memory"); }
__device__ __forceinline__ void glds4(const void* gsrc, unsigned lds_dst) { unsigned keep;
    asm volatile("s_mov_b32 %0, m0\n\ts_mov_b32 m0, %2\n\ts_nop 0\n\tglobal_load_lds_dword %1, off\n\ts_mov_b32 m0, %0" : "=&s"(keep) : "v"(gsrc), "s"(lds_dst) : "memory"); }
#define WAITV_BAR(N) asm volatile("s_waitcnt vmcnt(" #N ") lgkmcnt(0)\n\ts_barrier" ::: "memory")

template <int MODE, bool FAST>
__device__ __forceinline__ void attn_ab_unit(int b, int h, int qt, const bf16_t* qkv, bf16_t* obuf, const float* kmean, const unsigned* maskg, LAS unsigned char* lds, int tid, int lane, int w) {
    constexpr int CQ = MODE == 0 ? C_QA : C_QB, CK = MODE == 0 ? C_KA : C_KB, CV = MODE == 0 ? C_VA : C_VB;
    constexpr int NS = 4, D = 3, SLOT = 16384;
    const int r32 = lane & 31, hi = lane >> 5;
    const size_t rowbase = (size_t)b * SEQ; const int q0 = 256 * qt, qloc = 32 * w + r32; const size_t qrow = rowbase + q0 + qloc;
    const unsigned lds0 = (unsigned)(size_t)lds;
    LAS float* kml = (LAS float*)(lds + 73728); LAS unsigned* mwl = (LAS unsigned*)(lds + 65536);
    bf16x8 qf[4];
#pragma unroll
    for (int ks = 0; ks < 4; ++ks) qf[ks] = *(const bf16x8*)(qkv + qrow * QP + CQ + 64 * h + 16 * ks + 8 * hi);
    const bf16_t* ksrc = qkv + (rowbase + kdma_row(w, lane)) * QP + CK + 64 * h + 8 * kdma_chunk(w, lane);
    const bf16_t* vsrc = qkv + (rowbase + 16 * (w & 3) + (lane >> 2)) * QP + CV + 64 * h + 32 * (w >> 2) + 8 * (lane & 3);
    const unsigned* msrc = maskg + qrow * 128 + hi;
    const int NT = 4 * qt + 4, wlim = 4 * qt + (w >> 1);
    const unsigned kdst0 = (unsigned)__builtin_amdgcn_readfirstlane(lds0 + w * 1024), mdst0 = (unsigned)__builtin_amdgcn_readfirstlane(lds0 + 65536 + w * 256);
    __syncthreads();
#pragma unroll
    for (int d = 0; d < D; ++d) { const int t = d < NT ? d : NT - 1;
        glds16(ksrc + (size_t)t * 64 * QP, kdst0 + d * SLOT); glds16(vsrc + (size_t)t * 64 * QP, kdst0 + d * SLOT + 8192);
        if (MODE == 1) glds4(msrc + 2 * t, mdst0 + d * 2048); }
    unsigned selbits = 0;
    if (MODE == 0) {
        if (tid < 256) ((LAS f32x4*)kml)[tid] = ((const f32x4*)(kmean + (size_t)((b * 4 + h) * 16) * 64))[tid];
        __syncthreads();
        if (qt > 0) {
            float qv[32];
#pragma unroll
            for (int ks = 0; ks < 4; ++ks) { const u32x4 qq = __builtin_bit_cast(u32x4, qf[ks]);
#pragma unroll
                for (int k = 0; k < 4; ++k) { qv[8 * ks + 2 * k] = bf_lo(qq[k]); qv[8 * ks + 2 * k + 1] = bf_hi(qq[k]); } }
            float v1 = NEG_INF, v2 = NEG_INF, v3 = NEG_INF; int i1 = -1, i2 = -1, i3 = -1;
#pragma unroll 1
            for (int j = 0; j < qt; ++j) {
                float g = 0.f;
#pragma unroll
                for (int ks = 0; ks < 4; ++ks) { const f32x4 k0 = *(const LAS f32x4*)(kml + j * 64 + 16 * ks + 8 * hi), k1 = *(const LAS f32x4*)(kml + j * 64 + 16 * ks + 8 * hi + 4);
                    g += qv[8 * ks + 0] * k0[0] + qv[8 * ks + 1] * k0[1] + qv[8 * ks + 2] * k0[2] + qv[8 * ks + 3] * k0[3] + qv[8 * ks + 4] * k1[0] + qv[8 * ks + 5] * k1[1] + qv[8 * ks + 6] * k1[2] + qv[8 * ks + 7] * k1[3]; }
                g = sum_xor32(g);
                if (g > v1) { v3 = v2; i3 = i2; v2 = v1; i2 = i1; v1 = g; i1 = j; }
                else if (g > v2) { v3 = v2; i3 = i2; v2 = g; i2 = j; }
                else if (g > v3) { v3 = g; i3 = j; }
            }
            if (i1 >= 0) selbits |= 1u << i1; if (i2 >= 0) selbits |= 1u << i2; if (i3 >= 0) selbits |= 1u << i3;
        }
    }
    const int vboff = (4 * hi + ((lane & 15) >> 2)) * 64 + ((lane >> 4) & 1) * 32 + (lane & 3) * 8;
    float m_run = -1e30f, l_run = 0.f; f32x16 o[2], lacc = splat16(0.f); o[0] = splat16(0.f); o[1] = splat16(0.f);
    int scur = 0, siss = D;
    asm volatile("s_waitcnt vmcnt(0)" ::: "memory");
    asm volatile("" : "+v"(qf[0]), "+v"(qf[1]), "+v"(qf[2]), "+v"(qf[3]));
#pragma unroll 1
    for (int kt = 0; kt < NT; ++kt) {
        if (MODE == 1) WAITV_BAR(6); else WAITV_BAR(4);
        { const int t = kt + D < NT ? kt + D : NT - 1;
          glds16(ksrc + (size_t)t * 64 * QP, kdst0 + siss * SLOT); glds16(vsrc + (size_t)t * 64 * QP, kdst0 + siss * SLOT + 8192);
          if (MODE == 1) glds4(msrc + 2 * t, mdst0 + siss * 2048); }
        const LAS unsigned char* cur = lds + scur * SLOT;
        if (MODE == 0) {
            const int j = kt >> 2;
            if (j < qt) { const bool sel = (selbits >> j) & 1u; if (__ballot(sel) != 0ull) { if (FAST) flash_step<FAST, 2>(m_run, l_run, lacc, o, cur, cur + 8192, QReg{qf}, MaskLaneP{sel ? 0xffffffffu : 0u}, r32, hi, vboff); else flash_step<FAST, 2>(m_run, l_run, lacc, o, cur, cur + 8192, QReg{qf}, MaskLane{sel ? 0.f : NEG_INF}, r32, hi, vboff); } }
            else { const int kb0 = 64 * (kt & 3); if (kb0 <= 32 * w + 31) flash_step<FAST, 2>(m_run, l_run, lacc, o, cur, cur + 8192, QReg{qf}, MaskCausal{kb0, qloc, hi}, r32, hi, vboff); }
        } else {
            if (kt <= wlim) { const LAS unsigned* mp = mwl + scur * 512 + w * 64; const unsigned cw0 = mp[r32], cw1 = mp[32 + r32];
                flash_step<FAST, 2>(m_run, l_run, lacc, o, cur, cur + 8192, QReg{qf}, MaskBits{~cw0 >> (4 * hi), ~cw1 >> (4 * hi)}, r32, hi, vboff); }
        }
        scur = scur + 1 == NS ? 0 : scur + 1; siss = siss + 1 == NS ? 0 : siss + 1;
    }
    asm volatile("s_waitcnt vmcnt(0)" ::: "memory");
    const float inv = 1.0f / (FAST ? lacc[0] : sum_xor32(l_run));
    bf16_t* orow = obuf + qrow * 256 + 64 * h;
#pragma unroll
    for (int db = 0; db < 2; ++db)
#pragma unroll
        for (int g = 0; g < 4; ++g)
            *(u32x2*)(orow + 32 * db + 8 * g + 4 * hi) = (u32x2){cvt_pk_bf16(o[db][4 * g] * inv, o[db][4 * g + 1] * inv), cvt_pk_bf16(o[db][4 * g + 2] * inv, o[db][4 * g + 3] * inv)};
}

template <bool FAST>
__device__ __forceinline__ void attn_c_unit(int b, int h, int qt, const bf16_t* qkv, bf16_t* oc, float lam, const float* subg, float coef, LAS unsigned char* lds, int tid, int lane, int w) {
    const int r32 = lane & 31, hi = lane >> 5;
    const size_t rowbase = (size_t)b * SEQ; const int q0 = 256 * qt, qloc = 32 * w + r32; const size_t qrow = rowbase + q0 + qloc;
    LAS unsigned char* qimg = lds + 65536 + w * 8192 + lane * 16;
    __syncthreads();
#pragma unroll
    for (int ks = 0; ks < 4; ++ks) { *(LAS bf16x8*)(qimg + ks * 1024) = *(const bf16x8*)(qkv + qrow * QP + C_Q1 + 64 * h + 16 * ks + 8 * hi); *(LAS bf16x8*)(qimg + 4096 + ks * 1024) = *(const bf16x8*)(qkv + qrow * QP + C_Q2 + 64 * h + 16 * ks + 8 * hi); }
    const bf16_t* k1src = FAST ? qkv + (rowbase + kdma_row(w, lane)) * QP + C_K1 + 64 * h + 8 * kdma_chunk(w, lane)
                               : qkv + (rowbase + lane) * QP + C_K1 + 64 * h + 8 * w;
    const bf16_t* k2src = k1src + (C_K2 - C_K1);
    const bf16_t* v0src = qkv + (rowbase + 16 * (w & 3) + (lane >> 2)) * QP + C_VC + 128 * h + 32 * (w >> 2) + 8 * (lane & 3);
    const bf16_t* v1src = v0src + 64;
    const int vboff = (4 * hi + ((lane & 15) >> 2)) * 64 + ((lane >> 4) & 1) * 32 + (lane & 3) * 8;
    const int NT = 4 * qt + 4;
    float m1 = -1e30f, l1 = 0.f, m2 = -1e30f, l2 = 0.f; f32x16 o1[4], o2[4];
#pragma unroll
    for (int i = 0; i < 4; ++i) { o1[i] = splat16(0.f); o2[i] = splat16(0.f); }
    dma16(k1src, lds + w * 1024); dma16(k2src, lds + 8192 + w * 1024); dma16(v0src, lds + 16384 + w * 1024); dma16(v1src, lds + 16384 + 8192 + w * 1024);
    DMA_WAIT_SYNC();
#pragma unroll 1
    for (int kt = 0; kt < NT; ++kt) {
        LAS unsigned char* cur = lds + (kt & 1) * 32768; LAS unsigned char* nxt = lds + ((kt + 1) & 1) * 32768;
        if (kt + 1 < NT) { const size_t adv = (size_t)(kt + 1) * 64 * QP;
            dma16(k1src + adv, nxt + w * 1024); dma16(k2src + adv, nxt + 8192 + w * 1024); dma16(v0src + adv, nxt + 16384 + w * 1024); dma16(v1src + adv, nxt + 16384 + 8192 + w * 1024); }
        const bool band = kt >= 4 * qt; const int kb0 = 64 * (kt & 3);
        if (!band || kb0 <= 32 * w + 31) { const MaskCausalIf mk{band, kb0, qloc, hi};
            if (FAST) flash_tile_dual_ref0<true>(l1, l2, o1, o2, cur, cur + 8192, cur + 16384, qimg, qimg + 4096, mk, r32, hi, vboff);
            else { flash_step<false, 4>(m1, l1, o1[0], o1, cur, cur + 16384, QLds{qimg}, mk, r32, hi, vboff); flash_step<false, 4>(m2, l2, o2[0], o2, cur + 8192, cur + 16384, QLds{qimg + 4096}, mk, r32, hi, vboff); } }
        DMA_WAIT_SYNC();
    }
    const float i1 = 1.0f / sum_xor32(l1), i2 = lam / sum_xor32(l2);
    float ss = 0.f;
#pragma unroll
    for (int db = 0; db < 4; ++db) { o1[db] = o1[db] * i1 - o2[db] * i2;
#pragma unroll
        for (int r = 0; r < 16; ++r) ss += o1[db][r] * o1[db][r]; }
    ss = sum_xor32(ss);
    const float rn = coef / sqrtf(ss * (1.0f / 128.0f) + EPS);
    bf16_t* orow = oc + qrow * 512 + 128 * h;
#pragma unroll
    for (int db = 0; db < 4; ++db)
#pragma unroll
        for (int g = 0; g < 4; ++g) { const int d = 32 * db + 8 * g + 4 * hi; const f32x4 gg = *(const f32x4*)(subg + d);
            *(u32x2*)(orow + d) = (u32x2){cvt_pk_bf16(o1[db][4 * g] * rn * gg[0], o1[db][4 * g + 1] * rn * gg[1]), cvt_pk_bf16(o1[db][4 * g + 2] * rn * gg[2], o1[db][4 * g + 3] * rn * gg[3])}; }
}

__device__ __forceinline__ void index_unit(int b, int i64, const bf16_t* qkv, unsigned* maskg, unsigned char* scr, LAS unsigned char* lds, int tid, int lane, int w) {
    constexpr int NS = 5, D = 4, HS = 257, RING = 84224, TOFF = 65792, TROW = 144;
    const int r32 = lane & 31, hi = lane >> 5;
    const unsigned lds0 = (unsigned)(size_t)lds;
    LAS unsigned* hist = (LAS unsigned*)lds; LAS unsigned char* ring = lds + RING; LAS unsigned char* mb8 = lds;
    LAS int* thrB1 = (LAS int*)(lds + 125184); LAS int* thrRem = thrB1 + 64; LAS int* thrT = thrB1 + 128; LAS int* thrNeed = thrB1 + 192;
    const size_t rowbase = (size_t)b * SEQ; const int q0 = 64 * i64, NT = i64 + 1;
    __syncthreads();
    {
        const int hh = 4 * ((r32 >> 3) & 1) + (r32 & 3), qp = 2 * (r32 >> 4) + ((r32 >> 2) & 1);
        bf16x8 aq[2][4]; float wv[2][2][8];
#pragma unroll
        for (int rb = 0; rb < 2; ++rb) {
            const size_t row = rowbase + q0 + 8 * w + 4 * rb + qp;
#pragma unroll
            for (int ks = 0; ks < 4; ++ks) aq[rb][ks] = *(const bf16x8*)(qkv + row * QP + C_QI + 64 * hh + 16 * ks + 8 * hi);
#pragma unroll
            for (int hf = 0; hf < 2; ++hf) { const u32x4 ww = *(const u32x4*)(qkv + (rowbase + q0 + 8 * w + 4 * rb + 2 * hf + hi) * QP + C_WI);
#pragma unroll
                for (int k = 0; k < 4; ++k) { wv[rb][hf][2 * k] = bf_lo(ww[k]); wv[rb][hf][2 * k + 1] = bf_hi(ww[k]); } }
        }
#pragma unroll
        for (int rb = 0; rb < 2; ++rb) { asm volatile("" : "+v"(aq[rb][0]), "+v"(aq[rb][1]), "+v"(aq[rb][2]), "+v"(aq[rb][3]));
#pragma unroll
            for (int hf = 0; hf < 2; ++hf) asm volatile("" : "+v"(wv[rb][hf][0]), "+v"(wv[rb][hf][1]), "+v"(wv[rb][hf][2]), "+v"(wv[rb][hf][3]), "+v"(wv[rb][hf][4]), "+v"(wv[rb][hf][5]), "+v"(wv[rb][hf][6]), "+v"(wv[rb][hf][7])); }
        const bf16_t* ksrc = qkv + (rowbase + kdma_row(w, lane)) * QP + C_KI + 8 * kdma_chunk(w, lane);
        const unsigned kdst0 = (unsigned)__builtin_amdgcn_readfirstlane(lds0 + RING + w * 1024);
#pragma unroll
        for (int d = 0; d < D; ++d) { const int t = d < NT ? d : NT - 1; glds16(ksrc + (size_t)t * 64 * QP, kdst0 + d * 8192); }
        for (int i = tid; i < 4112; i += 512) ((LAS u32x4*)hist)[i] = (u32x4){0u, 0u, 0u, 0u};
        asm volatile("s_waitcnt lgkmcnt(0)" ::: "memory");
        int scur = 0, siss = D;
#pragma unroll 1
        for (int kt = 0; kt <= NT; ++kt) {
            if (kt < NT) WAITV_BAR(3); else { asm volatile("s_waitcnt vmcnt(0)" ::: "memory"); __syncthreads(); }
            if (kt > 0) {
                const u32x4 kk = *(const LAS u32x4*)(lds + TOFF + ((kt - 1) & 1) * 9216 + lane * TROW + w * 16);
                {
                    const u32x4 ks = *(const LAS u32x4*)(lds + TOFF + ((kt - 1) & 1) * 9216 + (8 * w + (lane >> 3)) * TROW + (lane & 7) * 16);
                    unsigned char* sp = scr + (size_t)(8 * w + (lane >> 3)) * 8192 + (size_t)(kt - 1) * 128 + (lane & 7) * 16;
                    if (kt < NT) asm volatile("global_store_dwordx4 %0, %1, off" :: "v"(sp), "v"(ks) : "memory");
                    else *(u32x4*)sp = ks; }
#pragma unroll
                for (int k = 0; k < 4; ++k) { const unsigned a = kk[k] & 0xffffu, c = kk[k] >> 16;
                    if (a) __hip_atomic_fetch_add(&hist[lane * HS + (a >> 8)], 1u, __ATOMIC_RELAXED, __HIP_MEMORY_SCOPE_WORKGROUP);
                    if (c) __hip_atomic_fetch_add(&hist[lane * HS + (c >> 8)], 1u, __ATOMIC_RELAXED, __HIP_MEMORY_SCOPE_WORKGROUP); }
            }
            if (kt == NT) break;
            { const int t = kt + D < NT ? kt + D : NT - 1; glds16(ksrc + (size_t)t * 64 * QP, kdst0 + siss * 8192); }
            const LAS unsigned char* kimg = ring + scur * 8192;
            const bool diag = kt == NT - 1;
#pragma unroll
            for (int rb = 0; rb < 2; ++rb)
#pragma unroll
                for (int kb = 0; kb < 2; ++kb) {
                    f32x16 d = splat16(0.f);
#pragma unroll
                    for (int ks = 0; ks < 4; ++ks) { __builtin_amdgcn_s_setprio(1); d = mfma32(aq[rb][ks], *(const LAS bf16x8*)(kimg + kimg_off(32 * kb + r32, 2 * ks + hi)), d); __builtin_amdgcn_s_setprio(0); }
#pragma unroll
                    for (int hf = 0; hf < 2; ++hf) {
                        float sc = 0.f;
#pragma unroll
                        for (int t = 0; t < 8; ++t) { const float mx_ = fmaxf(d[8 * hf + t], 0.f); asm("v_fma_f32 %0, %1, %2, %0" : "+v"(sc) : "v"(wv[rb][hf][t]), "v"(mx_)); }
                        const int ql = 8 * w + 4 * rb + 2 * hf + hi;
                        const unsigned u = (unsigned)__builtin_bit_cast(unsigned short, (_Float16)sc);
                        unsigned key = u ^ ((u & 0x8000u) ? 0xffffu : 0x8000u);
                        if (diag && 32 * kb + r32 > ql) key = 0u;
                        *(LAS unsigned short*)(lds + TOFF + (kt & 1) * 9216 + ql * TROW + (32 * kb + r32) * 2) = (unsigned short)key;
                    }
                }
            scur = scur + 1 == NS ? 0 : scur + 1; siss = siss + 1 == NS ? 0 : siss + 1;
        }
        asm volatile("s_waitcnt vmcnt(0)" ::: "memory");
        __syncthreads();
    }
#define IDX_SEARCH(STAGE) do { _Pragma("unroll 1") for (int qq = 0; qq < 8; ++qq) { const int q = 8 * w + qq; int target; \
        if (STAGE == 0) { if (q0 + q + 1 <= 256) { if (lane == 0) { thrB1[q] = 0x10000; thrRem[q] = 0; } continue; } target = 256; } \
        else { if (thrB1[q] == 0x10000) { if (lane == 0) { thrT[q] = 0; thrNeed[q] = 0; } continue; } target = thrRem[q]; } \
        const LAS unsigned* hp = hist + q * HS + 4 * lane; const int h0 = (int)hp[0], h1 = (int)hp[1], h2 = (int)hp[2], h3 = (int)hp[3]; \
        int P = h0 + h1 + h2 + h3; const int s_ = P; \
        _Pragma("unroll") for (int o = 1; o < 64; o <<= 1) { const int t_ = lane_val(P, (lane - o) & 63); if (lane >= o) P += t_; } \
        const int above = __builtin_amdgcn_readlane(P, 63) - P; (void)s_; \
        const int c3 = above + h3, c2 = c3 + h2, c1 = c2 + h1, c0 = c1 + h0; int bin = -1, ab = 0; \
        if (above < target && c3 >= target) { bin = 4 * lane + 3; ab = above; } else if (c3 < target && c2 >= target) { bin = 4 * lane + 2; ab = c3; } \
        else if (c2 < target && c1 >= target) { bin = 4 * lane + 1; ab = c2; } else if (c1 < target && c0 >= target) { bin = 4 * lane; ab = c1; } \
        if (bin >= 0) { if (STAGE == 0) { thrB1[q] = bin; thrRem[q] = target - ab; } else { thrT[q] = (thrB1[q] << 8) | bin; thrNeed[q] = target - ab; } } } \
        __syncthreads(); } while (0)
    IDX_SEARCH(0);
    const int qs = 8 * w + (lane >> 3), pc = lane & 7;
    const unsigned char* rrow = scr + (size_t)qs * 8192 + pc * 16;
    {
        __builtin_amdgcn_fence(__ATOMIC_ACQUIRE, "agent");
        asm volatile("s_waitcnt vmcnt(0)" ::: "memory");
        const int b1 = thrB1[qs];
        for (int i = tid; i < 4112; i += 512) ((LAS u32x4*)hist)[i] = (u32x4){0u, 0u, 0u, 0u};
        __syncthreads();
#pragma unroll 4
        for (int it = 0; it < NT; ++it) { const u32x4 kk = *(const u32x4*)(rrow + (size_t)it * 128);
#pragma unroll
            for (int k = 0; k < 4; ++k) { const unsigned a = kk[k] & 0xffffu, c = kk[k] >> 16;
                if ((int)(a >> 8) == b1) __hip_atomic_fetch_add(&hist[qs * HS + (a & 255u)], 1u, __ATOMIC_RELAXED, __HIP_MEMORY_SCOPE_WORKGROUP);
                if ((int)(c >> 8) == b1) __hip_atomic_fetch_add(&hist[qs * HS + (c & 255u)], 1u, __ATOMIC_RELAXED, __HIP_MEMORY_SCOPE_WORKGROUP); } }
        __syncthreads();
    }
    IDX_SEARCH(1);
    {
        const unsigned T = (unsigned)thrT[qs]; const int need = thrNeed[qs]; int tc = 0;
        __syncthreads();
#pragma unroll 2
        for (int it = 0; it < NT; ++it) { const u32x4 kk = *(const u32x4*)(rrow + (size_t)it * 128);
            unsigned sel = 0, eq = 0;
#pragma unroll
            for (int k = 0; k < 4; ++k) { const unsigned a = kk[k] & 0xffffu, c = kk[k] >> 16;
                sel |= (a > T ? 1u : 0u) << (2 * k); sel |= (c > T ? 1u : 0u) << (2 * k + 1); eq |= (a == T ? 1u : 0u) << (2 * k); eq |= (c == T ? 1u : 0u) << (2 * k + 1); }
            if (T == 0u) eq = 0u;
            if (__ballot(eq != 0u) != 0ull) {
                const int n = __popc(eq); int P = n;
#pragma unroll
                for (int o = 1; o < 8; o <<= 1) { const int t_ = lane_val(P, (lane - o) & 63); if ((lane & 7) >= o) P += t_; }
                int allow = need - tc - (P - n);
#pragma unroll
                for (int k = 0; k < 8; ++k) if (((eq >> k) & 1u) && allow > 0) { sel |= 1u << k; --allow; }
                tc += lane_val(P, (lane & ~7) + 7);
            }
            mb8[qs * 512 + it * 8 + pc] = (unsigned char)sel;
        }
        __syncthreads();
    }
#undef IDX_SEARCH
    for (int idx = tid; idx < 64 * 2 * NT; idx += 512) { const int q = idx / (2 * NT), wd = idx - q * 2 * NT; maskg[(rowbase + q0 + q) * 128 + wd] = ((const LAS unsigned*)mb8)[q * 128 + wd]; }
}

__device__ __forceinline__ int next_unit(unsigned* ctr, LAS unsigned char* lds, int tid) {
    volatile LAS int* bc = (volatile LAS int*)(lds + LX_BC);
    __syncthreads();
    if (tid == 0) *bc = (int)__hip_atomic_fetch_add(ctr, 1u, __ATOMIC_RELAXED, __HIP_MEMORY_SCOPE_AGENT);
    __syncthreads();
    return __builtin_amdgcn_readfirstlane(*bc);
}

__device__ __forceinline__ void m1_phase(const Args& a, unsigned char* ws, int lc, LAS unsigned char* lds, int tid, int lane, int wave, int vcu, int G) {
    const int l = lc & 1;
    const float* wrt = (const float*)(ws + WS_WRT);
    const float* bg = a.in[I_B_GROUP] + l * 4; const float* br = a.in[I_B_ROUTER] + l * 32;
    unsigned* cnt = (unsigned*)(ws + WS_CTL) + CW_CNT + 2048 * lc;
    unsigned* rt0 = (unsigned*)(ws + WS_RT0); unsigned* rt1 = (unsigned*)(ws + WS_RT1); f32x2* rtw = (f32x2*)(ws + WS_RTW);
    int* tokl = (int*)(ws + WS_TOKL); float* rstdg = (float*)(ws + WS_RSTD); const unsigned char* x16 = ws + WS_X16;
    const int r32 = lane & 31, kh = lane >> 5, kbase = 128 * wave + 64 * kh;
    LAS float* wgl = (LAS float*)lds; LAS float* part = (LAS float*)(lds + 16384); LAS float* tlw = (LAS float*)(lds + 98304 + wave * 640);
    LAS unsigned* lcnt = (LAS unsigned*)(lds + 104448); LAS unsigned* lbase = lcnt + 32; LAS unsigned* pk0 = lcnt + 64; LAS unsigned* pk1 = lcnt + 192;
    __syncthreads();
    if (tid < 32) lcnt[tid] = 0u;
    for (int k = tid; k < DM; k += 512) *(LAS f32x4*)(wgl + 4 * k) = (f32x4){wrt[k], wrt[DM + k], wrt[2 * DM + k], wrt[3 * DM + k]};
    f32x4 bw[16];
#pragma unroll
    for (int j = 0; j < 16; ++j) bw[j] = *(const f32x4*)(wrt + (size_t)(4 + r32) * DM + kbase + 4 * j);
    u32x4 xr[8];
    { const unsigned char* xp = x16 + ((size_t)(32 * vcu + r32) * DM + kbase) * 2;
#pragma unroll
      for (int j = 0; j < 8; ++j) xr[j] = vcu < MTOK / 32 ? *(const u32x4*)(xp + 16 * j) : (u32x4){0u, 0u, 0u, 0u}; }
    __syncthreads();
    int buf = 0, it = 0;
#pragma unroll 1
    for (int t = vcu; t < MTOK / 32; t += G, ++it) {
        f32x16 d0 = splat16(0.f); float ss = 0.f; f32x4 gp = {0.f, 0.f, 0.f, 0.f};
#pragma unroll
        for (int j = 0; j < 8; ++j) {
            float f[8];
#pragma unroll
            for (int k = 0; k < 4; ++k) { f[2 * k] = h_lo(xr[j][k]); f[2 * k + 1] = h_hi(xr[j][k]); }
#pragma unroll
            for (int i = 0; i < 8; ++i) { const int s = 8 * j + i;
                d0 = __builtin_amdgcn_mfma_f32_32x32x2f32(f[i], bw[s >> 2][s & 3], d0, 0, 0, 0);
                ss += f[i] * f[i]; gp += f[i] * *(const LAS f32x4*)(wgl + 4 * (kbase + s)); }
        }
        { const int tn = t + G < MTOK / 32 ? t + G : t; const unsigned char* xp = x16 + ((size_t)(32 * tn + r32) * DM + kbase) * 2;
#pragma unroll
          for (int j = 0; j < 8; ++j) xr[j] = *(const u32x4*)(xp + 16 * j); }
        ss = sum_xor32(ss);
#pragma unroll
        for (int c = 0; c < 4; ++c) gp[c] = sum_xor32(gp[c]);
        LAS float* pw = part + ((buf * 8 + wave) * 32) * 40;
#pragma unroll
        for (int r = 0; r < 16; ++r) pw[crow(r, kh) * 40 + 4 + r32] = d0[r];
        if (kh == 0) { *(LAS f32x4*)(pw + r32 * 40) = gp; pw[r32 * 40 + 36] = ss; }
        __syncthreads();
        { const int tk = 4 * wave + (lane >> 4), cg = lane & 15; const LAS float* pr = part + (buf * 8 * 32 + tk) * 40;
            float s0 = 0.f, s1 = 0.f, s2 = 0.f;
#pragma unroll
            for (int w2 = 0; w2 < 8; ++w2) { s0 += pr[w2 * 1280 + cg]; s1 += pr[w2 * 1280 + 16 + cg]; if (cg < 5) s2 += pr[w2 * 1280 + 32 + cg]; }
            LAS float* tr = tlw + (lane >> 4) * 40; tr[cg] = s0; tr[16 + cg] = s1; if (cg < 5) tr[32 + cg] = s2; }
        LDS_WAIT(); asm volatile("" ::: "memory");
        if (lane < 4) {
            const LAS float* my = tlw + lane * 40; const int m = 32 * t + 4 * wave + lane;
            const float rstd = 1.0f / sqrtf(my[36] * (1.0f / DM) + EPS);
            float gl[4];
#pragma unroll
            for (int c = 0; c < 4; ++c) gl[c] = my[c] * rstd + bg[c];
            int g = 0; float gm = gl[0];
#pragma unroll
            for (int c = 1; c < 4; ++c) if (gl[c] > gm) { gm = gl[c]; g = c; }
            float den = 0.f;
#pragma unroll
            for (int c = 0; c < 4; ++c) den += __expf(gl[c] - gm);
            const float gwt = 1.0f / den;
            float le[8];
#pragma unroll
            for (int e = 0; e < 8; ++e) le[e] = my[4 + 8 * g + e] * rstd + br[8 * g + e];
            int i1 = 0; float v1 = le[0];
#pragma unroll
            for (int e = 1; e < 8; ++e) if (le[e] > v1) { v1 = le[e]; i1 = e; }
            int i2 = -1; float v2 = NEG_INF;
#pragma unroll
            for (int e = 0; e < 8; ++e) if (e != i1 && le[e] > v2) { v2 = le[e]; i2 = e; }
            const float ex = __expf(v2 - v1), w1 = 1.0f / (1.0f + ex), w2 = ex * w1;
            const int e0 = g * 8 + i1, e1 = g * 8 + i2, slot = (it & 3) * 32 + 4 * wave + lane;
            const unsigned r0 = __hip_atomic_fetch_add(lcnt + e0, 1u, __ATOMIC_RELAXED, __HIP_MEMORY_SCOPE_WORKGROUP), r1 = __hip_atomic_fetch_add(lcnt + e1, 1u, __ATOMIC_RELAXED, __HIP_MEMORY_SCOPE_WORKGROUP);
            pk0[slot] = ((unsigned)e0 << 24) | r0; pk1[slot] = ((unsigned)e1 << 24) | r1;
            rtw[m] = (f32x2){gwt * w1, gwt * w2}; rstdg[m] = rstd;
        }
        buf ^= 1;
        if ((it & 3) == 3 || t + G >= MTOK / 32) {
            __syncthreads();
            if (tid < 32) { const unsigned n = lcnt[tid]; lbase[tid] = n ? atomicAdd(cnt + 64 * tid, n) : 0u; lcnt[tid] = 0u; }
            __syncthreads();
            const int nt4 = (it & 3) + 1;
            if (tid < 32 * nt4) { const int j = tid >> 5, m = 32 * (t - (nt4 - 1 - j) * G) + (tid & 31);
                const unsigned a0 = pk0[tid], a1 = pk1[tid]; const unsigned e0 = a0 >> 24, e1 = a1 >> 24, r0 = lbase[e0] + (a0 & 0xffffffu), r1 = lbase[e1] + (a1 & 0xffffffu);
                rt0[m] = (e0 << 24) | r0; rt1[m] = (e1 << 24) | r1; tokl[e0 * 32768 + r0] = m; tokl[e1 * 32768 + r1] = m; }
        }
    }
    __syncthreads();
}
__device__ __forceinline__ void moe_tables(const unsigned* cnt, const int* tokl, const float* rstdg, LAS unsigned char* lds, int tid, int c, int G) {
    LAS int* pstart = (LAS int*)(lds + LX_PSTART); LAS int* blk2e = (LAS int*)(lds + LX_BLK2E); LAS int* cntl = (LAS int*)(lds + LX_CNT); LAS int* tok = (LAS int*)(lds + LX_TOK);
    if (tid < 64) {
        const int cn = tid < NEXP ? (int)cnt[64 * tid] : 0, nb = (cn + 255) >> 8;
        int P = nb;
#pragma unroll
        for (int o = 1; o < 64; o <<= 1) { const int t = lane_val(P, (tid - o) & 63); if (tid >= o) P += t; }
        const int pb = P - nb;
        if (tid <= NEXP) pstart[tid] = pb * 256;
        if (tid < NEXP) cntl[tid] = cn;
        if (tid == NEXP) *(LAS int*)(lds + LX_NBLK) = pb < MAXBLK ? pb : MAXBLK;
#pragma unroll 1
        for (int k = 0; k < nb; ++k) if (pb + k < MAXBLK) blk2e[pb + k] = tid;
    }
    __syncthreads();
    const int nblk = *(const LAS int*)(lds + LX_NBLK), rbs = G / 4;
    LAS float* rst = (LAS float*)(lds + LX_RST);
    for (int k = 0; k < 6; ++k) { const int rb = c / 4 + k * rbs; if (rb >= nblk) break;
        const int e = blk2e[rb], r = rb * 256 - pstart[e] + (tid & 255);
        if (tid < 256) { const int tk = r < cntl[e] ? tokl[e * 32768 + r] : 0; tok[k * 256 + tid] = tk; rst[k * 256 + tid] = rstdg[tk]; } }
    __syncthreads();
}

#ifndef PHASES
#define PHASES 0xFFFF
#endif
#define PH(n) if constexpr (((PHASES) >> (n)) & 1)
#ifndef REPEAT_MASK
#define REPEAT_MASK 0
#endif
#define REP(k) for (int rep_ = 0; rep_ < 1 + (((REPEAT_MASK) >> (k)) & 1); ++rep_)
#ifndef PROBE_SEL
#define PROBE_SEL 0
#endif
#define PROBE_MUL 10
#ifndef PROBE_CLK
#define PROBE_CLK -1
#endif
#define PT0(p) do { if constexpr (((PROBE_SEL) >> (9 * L + (p))) & 1) pt_ -= (long long)wall_clock64(); if constexpr ((PROBE_CLK) == 9 * L + (p)) { ck_ -= (long long)clock64(); kt_ -= (long long)wall_clock64(); } } while (0)
#define PT1(p) do { if constexpr (((PROBE_SEL) >> (9 * L + (p))) & 1) pt_ += (long long)wall_clock64(); if constexpr ((PROBE_CLK) == 9 * L + (p)) { ck_ += (long long)clock64(); kt_ += (long long)wall_clock64(); } } while (0)
#ifndef GEMM_ALIGN
#define GEMM_ALIGN true
#endif
#ifndef GEMM_SP2
#define GEMM_SP2 true
#endif
#define PHASE_ENV() unsigned long long wsi_ = (unsigned long long)args.ws; int G = (int)gridDim.x, bx = (int)blockIdx.x; asm volatile("" : "+s"(wsi_), "+s"(G), "+s"(bx)); \
    unsigned long long obi_ = (unsigned long long)args.out; asm volatile("" : "+s"(obi_)); unsigned char* const outb = (unsigned char*)(GAS unsigned char*)obi_; (void)outb;   \
    unsigned char* const ws = (unsigned char*)(GAS unsigned char*)wsi_; const int vcu = (G % 8 == 0) ? (bx % 8) * (G / 8) + bx / 8 : bx;   \
    int tid = (int)threadIdx.x; asm volatile("" : "+v"(tid)); const int lane = tid & 63, wave = __builtin_amdgcn_readfirstlane(tid >> 6); \
    unsigned* const ctl = (unsigned*)(ws + WS_CTL); bf16_t* const QKV = (bf16_t*)(ws + WS_QKV); unsigned char* const SG = ws + WS_SG; unsigned* const MASK = (unsigned*)(ws + WS_MASK); float* const KMEAN = (float*)(ws + WS_KMEAN); \
    (void)lane; (void)wave; (void)ctl; (void)QKV; (void)SG; (void)MASK; (void)KMEAN; (void)vcu
#define GRID_BAR() do { unsigned long long wb_ = (unsigned long long)args.ws; asm volatile("" : "+s"(wb_)); XcdBarrier b_ = bar0; b_.bar = (unsigned*)((GAS unsigned char*)wb_ + WS_CTL) + CW_BAR; asm volatile("" : "+s"(b_.x)); xcd_barrier(b_); if (((REPEAT_MASK) >> 12) & 1) xcd_barrier(b_); } while (0)


template <int L> __device__ __forceinline__ void layer_body(const Args& args, LAS unsigned char* lds, const XcdBarrier& bar0, long long& pt_, long long& ck_, long long& kt_) {
    constexpr int l = L;
        PT0(0);

        PH(0) for (int rep_ = 0; rep_ < 1 + ((((REPEAT_MASK) >> 0) & 1) && l == 0); ++rep_) { PHASE_ENV(); p0_phase(args, ws, l, lds, tid, lane, wave, vcu, G); }
        GRID_BAR(); PT1(0); PT0(1);
        PH(1) REP(1) { PHASE_ENV();
            pg8::Gemm g{(const bf16_t*)(ws + WS_X16), (const bf16_t*)(ws + WS_WIN), MTOK, NT_IN * 256, DM}; pg8::StaticOrder S; S.init(MTOK, NT_IN * 256, G, bx);
            pg8::EpiInProj E{QKV, SG, (const float*)(ws + WS_COS), (const float*)(ws + WS_SIN), args.in[I_QK_GAIN] + l * 6 * 64, args.in[I_IDX_K_GAIN] + l * 64, (const float*)(ws + WS_RSTD1)};
            pg8::gemm_phase<pg8::EpiInProj, pg8::StaticOrder, GEMM_ALIGN, GEMM_SP2>(lds, g, S, E);
        }
        GRID_BAR(); PT1(1); PT0(2);
        { PHASE_ENV();
            LAS float* red = (LAS float*)lds;
            for (int it = bx; it < NBATCH * 4 * 16; it += G) { const int b = it >> 6, h = (it >> 4) & 3, blk = it & 15, d = tid & 63, rg = tid >> 6;
                const bf16_t* kp = QKV + ((size_t)b * SEQ + blk * 256 + rg * 32) * QP + C_KA + 64 * h + d; float s = 0.f;
#pragma unroll 8
                for (int r = 0; r < 32; ++r) s += __builtin_bit_cast(float, (unsigned)kp[(size_t)r * QP] << 16);
                __syncthreads(); red[tid] = s; __syncthreads();
                if (tid < 64) { float t = 0.f;
#pragma unroll
                    for (int k = 0; k < 8; ++k) t += red[k * 64 + tid];
                    KMEAN[(size_t)it * 64 + tid] = t * (1.0f / 256.0f); } }
            __syncthreads();
        }
        PH(2) REP(2) { PHASE_ENV();
            const float* dl = args.in[I_DIFF_LAMBDA] + l * 256;
            const float lam_init = 0.8f - 0.6f * __expf(-0.3f * (float)l);
            const float lam = __expf(wave_sum(dl[lane] * dl[64 + lane])) - __expf(wave_sum(dl[128 + lane] * dl[192 + lane])) + lam_init;
            const float* subg = args.in[I_DIFF_SUBLN] + l * 128;
            unsigned* qc = ctl + CW_QUEUE + 64 * (l * 4 + 0 + 8 * rep_);
            const float* qkg = args.in[I_QK_GAIN] + l * 6 * 64;
            if (softmax_ref0_ok(qkg + 4 * 64, qkg + 5 * 64, lane)) { for (;;) { const int u = next_unit(qc, lds, tid); if (u >= 512) break; const int r = u & 31; attn_c_unit<true>(r >> 2, r & 3, 15 - (u >> 5), QKV, (bf16_t*)(outb + OUT_OC), lam, subg, 1.0f - lam_init, lds, tid, lane, wave); } }
            else { for (;;) { const int u = next_unit(qc, lds, tid); if (u >= 512) break; const int r = u & 31; attn_c_unit<false>(r >> 2, r & 3, 15 - (u >> 5), QKV, (bf16_t*)(outb + OUT_OC), lam, subg, 1.0f - lam_init, lds, tid, lane, wave); } }
        }
        PH(3) REP(3) { PHASE_ENV();
            unsigned* qi = ctl + CW_QUEUE + 64 * (l * 4 + 1 + 8 * rep_);
            for (;;) { const int u = next_unit(qi, lds, tid); if (u >= 512) break; index_unit(u & 7, 63 - (u >> 3), QKV, MASK, bx < 192 ? ws + WS_WGU + (size_t)bx * 524288 : outb + OUT_SCR + (size_t)(bx - 192) * 524288, lds, tid, lane, wave); }
        }
        GRID_BAR(); PT1(2); PT0(3);
#define CONV_CHUNKS ((32 * 32 * 16 + 32 * 32 * 8) / 128)
        PH(4) REP(4) {
            bool fast_, convleft = true;
            { PHASE_ENV(); const float* qkg = args.in[I_QK_GAIN] + l * 6 * 64; fast_ = softmax_ref0_ok(qkg, qkg + 64, lane); }
            for (;;) {
                { PHASE_ENV(); unsigned* qa = ctl + CW_QUEUE + 64 * (l * 4 + 2 + 8 * rep_);
                  const int u = next_unit(qa, lds, tid); if (u >= 512) break; const int r = u & 31;
                  if (fast_) attn_ab_unit<0, true>(r >> 2, r & 3, 15 - (u >> 5), QKV, (bf16_t*)(outb + OUT_OA), KMEAN, MASK, lds, tid, lane, wave);
                  else attn_ab_unit<0, false>(r >> 2, r & 3, 15 - (u >> 5), QKV, (bf16_t*)(outb + OUT_OA), KMEAN, MASK, lds, tid, lane, wave); }
                if (convleft) { PHASE_ENV(); unsigned* qw = ctl + CW_QUEUE + 64 * (16 + l);
                  const int c_ = next_unit(qw, lds, tid); if (c_ < CONV_CHUNKS) convert_weights<true>(args, ws, l, lds, lane, wave, vcu, G, c_); else convleft = false; }
            }
        }
        PH(5) REP(5) { PHASE_ENV();
            unsigned* qb = ctl + CW_QUEUE + 64 * (l * 4 + 3 + 8 * rep_);
            const float* qkg = args.in[I_QK_GAIN] + l * 6 * 64;
            if (softmax_ref0_ok(qkg + 2 * 64, qkg + 3 * 64, lane)) { for (;;) { const int u = next_unit(qb, lds, tid); if (u >= 512) break; const int r = u & 31; attn_ab_unit<1, true>(r >> 2, r & 3, 15 - (u >> 5), QKV, (bf16_t*)(outb + OUT_OB), KMEAN, MASK, lds, tid, lane, wave); } }
            else { for (;;) { const int u = next_unit(qb, lds, tid); if (u >= 512) break; const int r = u & 31; attn_ab_unit<1, false>(r >> 2, r & 3, 15 - (u >> 5), QKV, (bf16_t*)(outb + OUT_OB), KMEAN, MASK, lds, tid, lane, wave); } }
        }
        { PHASE_ENV();
            unsigned* qw = ctl + CW_QUEUE + 64 * (16 + l);
            for (;;) { const int c = next_unit(qw, lds, tid); if (c >= (32 * 32 * 16 + 32 * 32 * 8) / 128) break; convert_weights<true>(args, ws, l, lds, lane, wave, vcu, G, c); }
        }
        GRID_BAR(); PT1(3); PT0(4);
        PH(6) REP(6) {
            int nr_; { PHASE_ENV(); nr_ = (MTOK / 256 * (DM / 256) + G - 1) / G; }
#pragma unroll 1
            for (int i_ = 0; i_ < nr_; ++i_) {
                { PHASE_ENV(); pg8::OneUnit S; S.S.init(MTOK, DM, G, bx); S.i = i_; pg8::Gemm g{(const bf16_t*)(outb + OUT_OA), (const bf16_t*)(ws + WS_WPA), MTOK, DM, 256}; pg8::EpiMerge<0> E{(bf16_t*)(ws + WS_MERGED), SG}; pg8::gemm_phase<pg8::EpiMerge<0>, pg8::OneUnit, GEMM_ALIGN, GEMM_SP2>(lds, g, S, E); }
                { PHASE_ENV(); pg8::OneUnit S; S.S.init(MTOK, DM, G, bx); S.i = i_; pg8::Gemm g{(const bf16_t*)(outb + OUT_OB), (const bf16_t*)(ws + WS_WPB), MTOK, DM, 256}; pg8::EpiMerge<1> E{(bf16_t*)(ws + WS_MERGED), SG}; pg8::gemm_phase<pg8::EpiMerge<1>, pg8::OneUnit, GEMM_ALIGN, GEMM_SP2>(lds, g, S, E); }
                { PHASE_ENV(); pg8::OneUnit S; S.S.init(MTOK, DM, G, bx); S.i = i_; pg8::Gemm g{(const bf16_t*)(outb + OUT_OC), (const bf16_t*)(ws + WS_WPC), MTOK, DM, 512}; pg8::EpiMerge<2> E{(bf16_t*)(ws + WS_MERGED), SG}; pg8::gemm_phase<pg8::EpiMerge<2>, pg8::OneUnit, GEMM_ALIGN, GEMM_SP2>(lds, g, S, E); }
            }
        }
        GRID_BAR(); PT1(4); PT0(5);
        PH(7) for (int rep_ = 0; rep_ < 1 + ((((REPEAT_MASK) >> 7) & 1) && l == 0); ++rep_) { PHASE_ENV();
            pg8::Gemm g{(const bf16_t*)(ws + WS_MERGED), (const bf16_t*)(ws + WS_WO), MTOK, DM, DM}; pg8::StaticOrder S; S.init(MTOK, DM, G, bx);
            pg8::EpiResid E{ws + WS_X16};
            pg8::gemm_phase<pg8::EpiResid, pg8::StaticOrder, GEMM_ALIGN, GEMM_SP2>(lds, g, S, E);
        }
        GRID_BAR(); PT1(5); PT0(6);
        PH(8) REP(8) { PHASE_ENV(); m1_phase(args, ws, l + 2 * rep_, lds, tid, lane, wave, vcu, G); }
        GRID_BAR(); PT1(6); PT0(7);
        { PHASE_ENV(); moe_tables(ctl + CW_CNT + 2048 * (l + 2 * (((REPEAT_MASK) >> 8) & 1)), (const int*)(ws + WS_TOKL), (const float*)(ws + WS_RSTD), lds, tid, vcu, G); }
        PH(10) REP(10) { PHASE_ENV();
            const int nblk = *(const LAS int*)(lds + LX_NBLK);
            pg8::Gemm g{(const bf16_t*)(ws + WS_X16), (const bf16_t*)(ws + WS_WGU), MTOK, NEXP * 1024, DM};
            pg8::MoeOrder S{nblk * 4, G, vcu, (const LAS int*)(lds + LX_BLK2E)};
            pg8::EpiGateUp E{(bf16_t*)(ws + WS_HID), (const LAS float*)(lds + LX_RST), G / 4}; pg8::AMapMoe AM{(const LAS int*)(lds + LX_TOK), G / 4};
            pg8::gemm_phase<pg8::EpiGateUp, pg8::MoeOrder, GEMM_ALIGN, GEMM_SP2, pg8::AMapMoe>(lds, g, S, E, AM);
        }
        GRID_BAR(); PT1(7); PT0(8);
        PH(11) REP(11) { PHASE_ENV();
            const int nblk = *(const LAS int*)(lds + LX_NBLK);
            pg8::Gemm g{(const bf16_t*)(ws + WS_HID), (const bf16_t*)(ws + WS_WD), MAXBLK * 256, NEXP * 1024, DEXP};
            pg8::MoeOrder S{nblk * 4, G, vcu, (const LAS int*)(lds + LX_BLK2E)};
            pg8::EpiDown E{(bf16_t*)(ws + WS_Y)};
            pg8::gemm_phase<pg8::EpiDown, pg8::MoeOrder, GEMM_ALIGN, GEMM_SP2>(lds, g, S, E);
        }
        GRID_BAR(); PT1(8);
    }

__global__ void __launch_bounds__(512, 2) fwd_kernel(Args args) {
    extern __shared__ __attribute__((aligned(16))) unsigned char lds_raw[];
    LAS unsigned char* lds = (LAS unsigned char*)lds_raw;
    for (int u = threadIdx.x; u < (LDS_BYTES - LDSX) / 4; u += 512) ((LAS unsigned*)(lds + LDSX))[u] = 0u;
    __syncthreads();
    const XcdBarrier bar0 = xcd_barrier_post((unsigned*)(args.ws + WS_CTL) + CW_BAR, (volatile LAS unsigned*)(lds + LX_BAR));
    long long pt_ = 0, ck_ = 0, kt_ = 0;
    layer_body<0>(args, lds, bar0, pt_, ck_, kt_);
    layer_body<1>(args, lds, bar0, pt_, ck_, kt_);
    if constexpr (((PROBE_SEL) >> 18) & 1) pt_ -= (long long)wall_clock64();
    { PHASE_ENV();
        const int gw = vcu * 8 + wave, NGW = G * 8; const LAS int* pstart = (const LAS int*)(lds + LX_PSTART);
        for (int m = gw; m < MTOK; m += NGW) token_row<false, true, true>(nullptr, ws + WS_X16, args.out, (const bf16_t*)(ws + WS_Y), (const unsigned*)(ws + WS_RT0), (const unsigned*)(ws + WS_RT1), (const f32x2*)(ws + WS_RTW), pstart, nullptr, m, lane);
    }
    if constexpr ((PROBE_KL) != 0) { __syncthreads(); pt_ += *(const LAS long long*)(lds + LDSX + 14336); }
    if constexpr ((PROBE_SEL) != 0 || (PROBE_KL) != 0) {
        if constexpr (((PROBE_SEL) >> 18) & 1) { __syncthreads(); pt_ += (long long)wall_clock64(); }
        if (blockIdx.x == 0) { const long long t_end = (long long)wall_clock64() + ((PROBE_CLK) >= 0 ? (ck_ * 10000) / (kt_ > 0 ? kt_ : 1) : PROBE_MUL * pt_); while ((long long)wall_clock64() < t_end) __builtin_amdgcn_s_sleep(8); }
    }
}

extern "C" void kernel_launch(void* const* d_in, const int* in_sizes, int n_in, void* d_out, int out_size, void* d_ws, size_t ws_size, hipStream_t stream) {
    static int grid = 0;
    if (grid == 0) {
        if (n_in != N_INPUTS || in_sizes[0] != MTOK * DM || out_size != MTOK * DM || ws_size < WS_END) {
            fprintf(stderr, "kernel_launch: built for %d inputs, x/out of %d floats, >= %zu bytes of workspace; got n_in %d, in0 %d, out %d, ws %zu; nothing launched\n", (int)N_INPUTS, MTOK * DM, (size_t)WS_END, n_in, n_in > 0 ? in_sizes[0] : -1, out_size, ws_size);
            grid = -1; return; }
        int dev = 0, cus = 0;
        if (hipGetDevice(&dev) != hipSuccess || hipDeviceGetAttribute(&cus, hipDeviceAttributeMultiprocessorCount, dev) != hipSuccess) { fprintf(stderr, "kernel_launch: device query failed\n"); grid = -1; return; }
        if (hipFuncSetAttribute((const void*)fwd_kernel, hipFuncAttributeMaxDynamicSharedMemorySize, LDS_BYTES) != hipSuccess) { fprintf(stderr, "kernel_launch: hipFuncSetAttribute failed\n"); grid = -1; return; }
        int per_cu = 0;
        if (hipOccupancyMaxActiveBlocksPerMultiprocessor(&per_cu, (const void*)fwd_kernel, 512, LDS_BYTES) != hipSuccess || per_cu < 1) fprintf(stderr, "kernel_launch: note: occupancy query reports %d workgroups per CU\n", per_cu);
        (void)hipGetLastError();
        grid = cus < 256 ? cus : 256;
    }
    if (grid < 0) return;
    if (hipMemsetAsync((char*)d_ws + WS_CTL, 0, CTL_BYTES, stream) != hipSuccess) { fprintf(stderr, "kernel_launch: memset failed\n"); return; }
    Args a{};
    for (int i = 0; i < N_INPUTS; ++i) a.in[i] = (const float*)d_in[i];
    a.out = (float*)d_out; a.ws = (unsigned char*)d_ws;
    hipLaunchKernelGGL(fwd_kernel, dim3(grid), dim3(512), LDS_BYTES, stream, a);
    const hipError_t le = hipPeekAtLastError();
    if (le != hipSuccess) fprintf(stderr, "kernel_launch: launch failed: %s\n", hipGetErrorName(le));
}
```
